# Optimizing an MI355X kernel written in HIP

```python
import math
import jax
import jax.numpy as jnp
from jax import lax
import numpy as np

D_MODEL = 1024
BATCH = 8
SEQ = 2048
DEPTH = 2

GRID_W = 64
CTX_LEN = 256
N_MIXERS = 2
N_MLA = (DEPTH + 1) // 2
N_HYENA = DEPTH // 2

MLA_HEADS = 16
QK_NOPE = 64
QK_ROPE = 32
QK_DIM = QK_NOPE + QK_ROPE
V_HEAD = 64
Q_LORA = 512
KV_LORA = 256
ROPE_THETA = 10000.0
Q_BLOCK = 128

HY_BANDS = 16
HY_POS_DIM = 1 + 2 * HY_BANDS
HY_FILTER_HIDDEN = 64
HY_DECAY_SLOW = math.log(100.0) / 1.5
HY_DECAY_FAST = math.log(100.0) / 0.3
HY_FILTER_INIT = 0.02

D_FF = 2816

EPS = 1e-6
F32 = jnp.float32

kernel_name = 'hybrid_mla_hyena_prefix_dit'


def rmsnorm(x, g):
    xf = x.astype(F32)
    y = xf * lax.rsqrt(jnp.mean(xf * xf, axis=-1, keepdims=True) + EPS)
    return (y * g.astype(F32)).astype(x.dtype)


def modulate(h, shift, scale):
    return h * (1 + scale) + shift


def dwconv3(x, w, b):
    xp = jnp.pad(x, ((0, 0), (1, 1), (0, 0)))
    return xp[:, :-2] * w[0] + xp[:, 1:-1] * w[1] + xp[:, 2:] * w[2] + b


def axial_rope_tables(rows):
    row = jnp.repeat(jnp.arange(rows, dtype=F32), GRID_W)
    col = jnp.tile(jnp.arange(GRID_W, dtype=F32), rows)
    half = QK_ROPE // 2
    inv_freq = ROPE_THETA ** (-jnp.arange(0, half, 2, dtype=F32) / half)
    ang_r = row[:, None] * inv_freq
    ang_c = col[:, None] * inv_freq
    ang = jnp.concatenate([ang_r, ang_r, ang_c, ang_c], axis=-1)
    return jnp.cos(ang), jnp.sin(ang)


def apply_axial_rope(x, cos, sin):
    q = QK_ROPE // 4
    xf = x.astype(F32)
    rot = jnp.concatenate([-xf[..., q:2 * q], xf[..., :q], -xf[..., 3 * q:], xf[..., 2 * q:3 * q]], axis=-1)
    return (xf * cos + rot * sin).astype(x.dtype)


def mla_queries(h, w_dq, g_q, w_uq, cos, sin):
    B, L, _ = h.shape
    cq = rmsnorm(h @ w_dq, g_q)
    q = (cq @ w_uq).reshape(B, L, MLA_HEADS, QK_DIM)
    q_nope, q_pe = q[..., :QK_NOPE], q[..., QK_NOPE:]
    if cos is not None:
        q_pe = apply_axial_rope(q_pe, cos[None, :, None, :], sin[None, :, None, :])
    return jnp.concatenate([q_nope, q_pe], axis=-1)


def mla_keys_values(h, w_dkv, g_kv, w_uk, w_uv, cos, sin):
    B, L, _ = h.shape
    kv = h @ w_dkv
    ckv = rmsnorm(kv[..., :KV_LORA], g_kv)
    k_pe = kv[..., KV_LORA:]
    if cos is not None:
        k_pe = apply_axial_rope(k_pe, cos[None], sin[None])
    k_nope = (ckv @ w_uk).reshape(B, L, MLA_HEADS, QK_NOPE)
    v = (ckv @ w_uv).reshape(B, L, MLA_HEADS, V_HEAD)
    k_pe = jnp.broadcast_to(k_pe[:, :, None, :], (B, L, MLA_HEADS, QK_ROPE))
    return jnp.concatenate([k_nope, k_pe], axis=-1), v


def block_attention(q, k, v):
    B, Lq, H, dk = q.shape
    nblk = Lq // Q_BLOCK
    scale = 1.0 / math.sqrt(dk)
    qb = q.reshape(B, nblk, Q_BLOCK, H, dk).transpose(1, 0, 2, 3, 4)

    def one_block(qblk):
        s = jnp.einsum('bqhd,bkhd->bhqk', qblk, k).astype(F32) * scale
        p = jax.nn.softmax(s, axis=-1).astype(v.dtype)
        return jnp.einsum('bhqk,bkhd->bqhd', p, v)

    o = lax.map(one_block, qb)
    return o.transpose(1, 0, 2, 3, 4).reshape(B, Lq, H * v.shape[-1])


def hyena_pos_features(L):
    t = jnp.linspace(0.0, 1.0, L, dtype=F32)
    w = 2.0 * math.pi * jnp.arange(L, dtype=F32) / L
    f = jnp.linspace(1e-4, HY_BANDS - 1, HY_BANDS, dtype=F32)
    z = jnp.concatenate([t[:, None], jnp.cos(w[:, None] * f), -jnp.sin(w[:, None] * f)], axis=-1)
    return t, z


def hyena_filters(L, f_w1, f_b1, f_freq1, f_w2, f_b2, f_freq2, f_w3, decay):
    t, z = hyena_pos_features(L)
    h = jnp.sin(f_freq1.astype(F32) * (z @ f_w1.astype(F32) + f_b1.astype(F32)))
    h = jnp.sin(f_freq2.astype(F32) * (h @ f_w2.astype(F32) + f_b2.astype(F32)))
    h = h @ f_w3.astype(F32)
    window = jnp.exp(-t[:, None] * jnp.abs(decay.astype(F32))[None, :])
    d = h.shape[1] // 2
    return h[:, :d] * window, h[:, d:] * window


def two_sided_fftconv(u, h_fwd, h_bwd):
    L = u.shape[1]
    filt = jnp.concatenate([h_fwd, jnp.zeros((1, h_fwd.shape[1]), F32), h_bwd[1:][::-1]], axis=0)
    filt_f = jnp.fft.rfft(filt, n=2 * L, axis=0)
    u_f = jnp.fft.rfft(u.astype(F32), n=2 * L, axis=1)
    y = jnp.fft.irfft(u_f * filt_f[None], n=2 * L, axis=1)[:, :L]
    return y.astype(u.dtype)


def hyena_mixer(u, w_in, b_in, conv_w, conv_b, f_w1, f_b1, f_freq1, f_w2, f_b2, f_freq2, f_w3, decay, d_bias, w_out, b_out):
    L = u.shape[1]
    z = dwconv3(u @ w_in + b_in, conv_w, conv_b)
    x1, x2, v = jnp.split(z, 3, axis=-1)
    h_fwd, h_bwd = hyena_filters(L, f_w1, f_b1, f_freq1, f_w2, f_b2, f_freq2, f_w3, decay)
    v = v * x2
    y = (two_sided_fftconv(v, h_fwd, h_bwd) + v * d_bias) * x1
    return y @ w_out + b_out


def conv_ffn(h, w_up, conv_w, conv_b, w_down):
    z = dwconv3(h @ w_up, conv_w, conv_b)
    a, g = jnp.split(z, 2, axis=-1)
    return (jax.nn.silu(g) * a) @ w_down


def setup_inputs(seed: int = 0) -> dict:
    key = jax.random.key(seed)
    ks = jax.random.split(key, 40)
    D = D_MODEL

    def nrm(i, shape, scale):
        return jax.random.normal(ks[i], shape, F32) * scale

    def gain(i, shape):
        return 1.0 + nrm(i, shape, 0.05)

    decay_base = jnp.linspace(HY_DECAY_SLOW, HY_DECAY_FAST, D, dtype=F32)
    return {
        'x': nrm(0, (BATCH, SEQ, D), 1.0),
        'c': nrm(1, (BATCH, D), 1.0),
        'ctx': nrm(2, (BATCH, CTX_LEN, D), 1.0),
        'c_ctx': nrm(3, (D,), 1.0),
        'mod_w': nrm(4, (DEPTH, D, 6 * D), D ** -0.5),
        'mod_b': nrm(5, (DEPTH, 6 * D), 0.02),
        'norm_mix_g': gain(6, (DEPTH, D)),
        'norm_ffn_g': gain(7, (DEPTH, D)),
        'mla_w_dq': nrm(8, (N_MLA, D, Q_LORA), D ** -0.5),
        'mla_g_q': gain(9, (N_MLA, Q_LORA)),
        'mla_w_uq': nrm(10, (N_MLA, Q_LORA, MLA_HEADS * QK_DIM), Q_LORA ** -0.5),
        'mla_w_dkv': nrm(11, (N_MLA, D, KV_LORA + QK_ROPE), D ** -0.5),
        'mla_g_kv': gain(12, (N_MLA, KV_LORA)),
        'mla_w_uk': nrm(13, (N_MLA, KV_LORA, MLA_HEADS * QK_NOPE), KV_LORA ** -0.5),
        'mla_w_uv': nrm(14, (N_MLA, KV_LORA, MLA_HEADS * V_HEAD), KV_LORA ** -0.5),
        'mla_w_o': nrm(15, (N_MLA, MLA_HEADS * V_HEAD, D), (MLA_HEADS * V_HEAD) ** -0.5),
        'hy_w_in': nrm(16, (N_HYENA, D, 3 * D), D ** -0.5),
        'hy_b_in': nrm(17, (N_HYENA, 3 * D), 0.02),
        'hy_conv_w': nrm(18, (N_HYENA, 3, 3 * D), 3 ** -0.5),
        'hy_conv_b': nrm(19, (N_HYENA, 3 * D), 0.02),
        'hy_f_w1': nrm(20, (N_HYENA, HY_POS_DIM, HY_FILTER_HIDDEN), HY_POS_DIM ** -0.5),
        'hy_f_b1': nrm(21, (N_HYENA, HY_FILTER_HIDDEN), 0.1),
        'hy_f_freq1': gain(22, (N_HYENA, HY_FILTER_HIDDEN)),
        'hy_f_w2': nrm(23, (N_HYENA, HY_FILTER_HIDDEN, HY_FILTER_HIDDEN), HY_FILTER_HIDDEN ** -0.5),
        'hy_f_b2': nrm(24, (N_HYENA, HY_FILTER_HIDDEN), 0.1),
        'hy_f_freq2': gain(25, (N_HYENA, HY_FILTER_HIDDEN)),
        'hy_f_w3': nrm(26, (N_HYENA, HY_FILTER_HIDDEN, 2 * D), HY_FILTER_INIT),
        'hy_decay': decay_base[None, :] * (1.0 + nrm(27, (N_HYENA, D), 0.05)),
        'hy_d_bias': nrm(28, (N_HYENA, D), 1.0),
        'hy_w_out': nrm(29, (N_HYENA, D, D), D ** -0.5),
        'hy_b_out': nrm(30, (N_HYENA, D), 0.02),
        'ffn_w_up': nrm(31, (DEPTH, D, 2 * D_FF), D ** -0.5),
        'ffn_conv_w': nrm(32, (DEPTH, 3, 2 * D_FF), 3 ** -0.5),
        'ffn_conv_b': nrm(33, (DEPTH, 2 * D_FF), 0.02),
        'ffn_w_down': nrm(34, (DEPTH, D_FF, D), D_FF ** -0.5),
        'final_g': gain(35, (D,)),
    }


def reference(x, c, ctx, c_ctx, mod_w, mod_b, norm_mix_g, norm_ffn_g,
              mla_w_dq, mla_g_q, mla_w_uq, mla_w_dkv, mla_g_kv, mla_w_uk, mla_w_uv, mla_w_o,
              hy_w_in, hy_b_in, hy_conv_w, hy_conv_b, hy_f_w1, hy_f_b1, hy_f_freq1, hy_f_w2, hy_f_b2,
              hy_f_freq2, hy_f_w3, hy_decay, hy_d_bias, hy_w_out, hy_b_out,
              ffn_w_up, ffn_conv_w, ffn_conv_b, ffn_w_down, final_g):
    L = x.shape[1]
    ROWS = L // GRID_W
    cos, sin = axial_rope_tables(ROWS)
    silu_c = jax.nn.silu(c)
    silu_cc = jax.nn.silu(c_ctx)
    h_ctx = ctx
    for i in range(DEPTH):
        last = i == DEPTH - 1
        j = i // N_MIXERS
        mod_x = silu_c @ mod_w[i] + mod_b[i]
        mod_c = silu_cc @ mod_w[i] + mod_b[i]
        sh1, sc1, g1, sh2, sc2, g2 = [m[:, None, :] for m in jnp.split(mod_x, 6, axis=-1)]
        csh1, csc1, cg1, csh2, csc2, cg2 = jnp.split(mod_c, 6, axis=-1)
        hx = modulate(rmsnorm(x, norm_mix_g[i]), sh1, sc1)
        if i % N_MIXERS == 0:
            hc = modulate(rmsnorm(h_ctx, norm_mix_g[i]), csh1, csc1)
            qx = mla_queries(hx, mla_w_dq[j], mla_g_q[j], mla_w_uq[j], cos, sin)
            kx, vx = mla_keys_values(hx, mla_w_dkv[j], mla_g_kv[j], mla_w_uk[j], mla_w_uv[j], cos, sin)
            kc, vc = mla_keys_values(hc, mla_w_dkv[j], mla_g_kv[j], mla_w_uk[j], mla_w_uv[j], None, None)
            ox = block_attention(qx, jnp.concatenate([kc, kx], axis=1), jnp.concatenate([vc, vx], axis=1))
            x = x + g1 * (ox @ mla_w_o[j])
            if not last:
                qc = mla_queries(hc, mla_w_dq[j], mla_g_q[j], mla_w_uq[j], None, None)
                oc = block_attention(qc, kc, vc)
                h_ctx = h_ctx + cg1 * (oc @ mla_w_o[j])
        else:
            hy = (hy_w_in[j], hy_b_in[j], hy_conv_w[j], hy_conv_b[j], hy_f_w1[j], hy_f_b1[j], hy_f_freq1[j],
                  hy_f_w2[j], hy_f_b2[j], hy_f_freq2[j], hy_f_w3[j], hy_decay[j], hy_d_bias[j],
                  hy_w_out[j], hy_b_out[j])
            x = x + g1 * hyena_mixer(hx, *hy)
            if not last:
                hc = modulate(rmsnorm(h_ctx, norm_mix_g[i]), csh1, csc1)
                h_ctx = h_ctx + cg1 * hyena_mixer(hc, *hy)
        ffn = (ffn_w_up[i], ffn_conv_w[i], ffn_conv_b[i], ffn_w_down[i])
        x = x + g2 * conv_ffn(modulate(rmsnorm(x, norm_ffn_g[i]), sh2, sc2), *ffn)
        if not last:
            h_ctx = h_ctx + cg2 * conv_ffn(modulate(rmsnorm(h_ctx, norm_ffn_g[i]), csh2, csc2), *ffn)
    return rmsnorm(x, final_g)
```

```cpp
#include <hip/hip_runtime.h>
#include <hip/hip_cooperative_groups.h>
#include <cstdio>
namespace cg = cooperative_groups;

typedef unsigned short bf16_t;
typedef short bf16x8 __attribute__((ext_vector_type(8)));
typedef float f32x4 __attribute__((ext_vector_type(4)));
typedef float f32x16 __attribute__((ext_vector_type(16)));

#define LDS_BYTES 73728
#define NPHASE 19

struct P {
  const float *x, *c, *ctx, *c_ctx, *mod_w, *mod_b, *norm_mix_g, *norm_ffn_g;
  const float *w_dq, *g_q, *w_uq, *w_dkv, *g_kv, *w_uk, *w_uv, *w_o;
  const float *hy_w_in, *hy_b_in, *hy_conv_w, *hy_conv_b, *f_w1, *f_b1, *f_freq1, *f_w2, *f_b2, *f_freq2, *f_w3, *hy_decay, *hy_d_bias, *hy_w_out, *hy_b_out;
  const float *ffn_w_up, *ffn_conv_w, *ffn_conv_b, *ffn_w_down, *final_g;
  float* X;
  bf16_t *wt_dq, *wt_dkv, *wt_uq, *wt_uk, *wt_uv, *wt_o, *wt_hin, *wt_hout, *wt_up0, *wt_up1, *wt_dn0, *wt_dn1;
  float *modv, *rq, *rkv;
  bf16_t *Rf, *kpe, *hxc, *cq, *kv, *Q, *Kn, *Vt, *act, *x1h, *vvT, *Yp;
  int ph0, ph1;
};

typedef const __attribute__((address_space(4))) P CP;
__device__ __forceinline__ int get_tid() { int t = threadIdx.x; asm volatile("" : "+v"(t)); return t; }
__device__ __forceinline__ int get_bid() { int t = blockIdx.x; asm volatile("" : "+s"(t)); return t; }

__device__ __forceinline__ bf16_t f2bf(float f) { unsigned u = __float_as_uint(f); u += 0x7fffu + ((u >> 16) & 1u); return (bf16_t)(u >> 16); }
__device__ __forceinline__ float bf2f(bf16_t h) { return __uint_as_float(((unsigned)h) << 16); }
__device__ __forceinline__ unsigned pack2(float a, float b) { return (unsigned)f2bf(a) | ((unsigned)f2bf(b) << 16); }
__device__ __forceinline__ float wave_sum(float v) {
#pragma unroll
  for (int o = 32; o; o >>= 1) v += __shfl_xor(v, o);
  return v;
}

__device__ __forceinline__ void prep_weight_tile(CP& p, char* smem, int wt) {
  const int tid = get_tid();
  int id = 0;
  {
    const int cnt[12] = {256, 144, 384, 128, 128, 512, 1536, 512, 2816, 2816, 1408, 1408};
#pragma unroll
    for (int i = 0; i < 11; ++i) { if (id == i && wt >= cnt[i]) { wt -= cnt[i]; id = i + 1; } }
  }
  const float* src; int K, N; bf16_t* dst; const float* scale = nullptr; int perm = 0;
  switch (id) {
    case 0: src = p.w_dq; K = 1024; N = 512; dst = p.wt_dq; break;
    case 1: src = p.w_dkv; K = 1024; N = 288; dst = p.wt_dkv; break;
    case 2: src = p.w_uq; K = 512; N = 1536; dst = p.wt_uq; scale = p.g_q; break;
    case 3: src = p.w_uk; K = 256; N = 1024; dst = p.wt_uk; scale = p.g_kv; break;
    case 4: src = p.w_uv; K = 256; N = 1024; dst = p.wt_uv; scale = p.g_kv; break;
    case 5: src = p.w_o; K = 1024; N = 1024; dst = p.wt_o; break;
    case 6: src = p.hy_w_in; K = 1024; N = 3072; dst = p.wt_hin; perm = 2; break;
    case 7: src = p.hy_w_out; K = 1024; N = 1024; dst = p.wt_hout; break;
    case 8: src = p.ffn_w_up; K = 1024; N = 5632; dst = p.wt_up0; perm = 1; break;
    case 9: src = p.ffn_w_up + (size_t)1024 * 5632; K = 1024; N = 5632; dst = p.wt_up1; perm = 1; break;
    case 10: src = p.ffn_w_down; K = 2816; N = 1024; dst = p.wt_dn0; break;
    default: src = p.ffn_w_down + (size_t)2816 * 1024; K = 2816; N = 1024; dst = p.wt_dn1; break;
  }
  const int ntn = N >> 5;
  const int kt = wt / ntn, nt = wt - kt * ntn;
  const int k0 = kt * 64, n0 = nt * 32;
  int np0;
  if (perm == 1) { const int half = n0 / 2816, f = n0 - half * 2816; np0 = (f >> 6) * 128 + half * 64 + (f & 63); }
  else if (perm == 2) { if (n0 < 1024) np0 = n0; else { const int m = n0 - 1024, half = m >> 10, f = m & 1023; np0 = 1024 + (f >> 6) * 128 + half * 64 + (f & 63); } }
  else np0 = n0;
  bf16_t* t16 = (bf16_t*)smem;
  const int nl = tid & 31, kr = tid >> 5;
#pragma unroll
  for (int i = 0; i < 8; ++i) {
    const int k = k0 + kr + 8 * i;
    float v = src[(size_t)k * N + n0 + nl];
    if (scale) v *= scale[k];
    t16[nl * 72 + kr + 8 * i] = f2bf(v);
  }
  __syncthreads();
  {
    const int n = tid >> 3, ch = tid & 7;
    const uint4 v = *(const uint4*)(t16 + n * 72 + ch * 8);
    *(uint4*)(dst + (size_t)(np0 + n) * K + k0 + ch * 8) = v;
  }
  __syncthreads();
}

__device__ __forceinline__ void prep_modvec(CP& p, char* smem, int it) {
  const int tid = get_tid();
  const int layer = it / 96, cb = it - layer * 96;
  float* s_lds = (float*)smem;
  float* red = (float*)(smem + 49152);
  for (int idx = tid; idx < 9 * 1024; idx += 256) {
    const int r = idx >> 10, k = idx & 1023;
    const float v = r < 8 ? p.c[r * 1024 + k] : p.c_ctx[k];
    s_lds[k * 12 + r] = v / (1.f + __expf(-v));
  }
  __syncthreads();
  const int col = cb * 64 + (tid & 63), kg = tid >> 6;
  const float* W = p.mod_w + (size_t)layer * 1024 * 6144 + col;
  float acc[9];
#pragma unroll
  for (int r = 0; r < 9; ++r) acc[r] = 0.f;
  for (int k = kg * 256; k < kg * 256 + 256; k += 8) {
    float w[8];
#pragma unroll
    for (int u = 0; u < 8; ++u) w[u] = W[(size_t)(k + u) * 6144];
#pragma unroll
    for (int u = 0; u < 8; ++u) {
      const f32x4 s0 = *(const f32x4*)(s_lds + (k + u) * 12), s1 = *(const f32x4*)(s_lds + (k + u) * 12 + 4);
      const float s2 = s_lds[(k + u) * 12 + 8];
      acc[0] += s0[0] * w[u]; acc[1] += s0[1] * w[u]; acc[2] += s0[2] * w[u]; acc[3] += s0[3] * w[u];
      acc[4] += s1[0] * w[u]; acc[5] += s1[1] * w[u]; acc[6] += s1[2] * w[u]; acc[7] += s1[3] * w[u];
      acc[8] += s2 * w[u];
    }
  }
#pragma unroll
  for (int r = 0; r < 9; ++r) red[(kg * 9 + r) * 64 + (tid & 63)] = acc[r];
  __syncthreads();
  for (int o = tid; o < 9 * 64; o += 256) {
    const int r = o >> 6, cl = o & 63;
    const float s = red[(0 * 9 + r) * 64 + cl] + red[(1 * 9 + r) * 64 + cl] + red[(2 * 9 + r) * 64 + cl] + red[(3 * 9 + r) * 64 + cl];
    p.modv[(size_t)(layer * 9 + r) * 6144 + cb * 64 + cl] = s + p.mod_b[layer * 6144 + cb * 64 + cl];
  }
  __syncthreads();
}

__device__ __forceinline__ void prep_filter(CP& p, char* smem, int it) {
  const int tid = get_tid();
  float* z = (float*)smem;
  float* h1 = z + 8 * 33;
  float* h2 = h1 + 8 * 64;
  const int t0 = it * 8;
  for (int idx = tid; idx < 8 * 33; idx += 256) {
    const int pp = idx / 33, i = idx - pp * 33;
    const int t = t0 + pp;
    float v;
    if (i == 0) v = (float)t * (1.0f / 2047.0f);
    else {
      const int k = (i - 1) & 15;
      const float w = (6.283185307179586f * (float)t) / 2048.0f;
      const float f = 1e-4f + (float)k * ((15.0f - 1e-4f) / 15.0f);
      const float a = w * f;
      v = (i <= 16) ? __cosf(a) : -__sinf(a);
    }
    z[idx] = v;
  }
  __syncthreads();
  for (int idx = tid; idx < 8 * 64; idx += 256) {
    const int pp = idx >> 6, j = idx & 63;
    float s = p.f_b1[j];
#pragma unroll 1
    for (int i = 0; i < 33; ++i) s += z[pp * 33 + i] * p.f_w1[i * 64 + j];
    h1[idx] = __sinf(p.f_freq1[j] * s);
  }
  __syncthreads();
  for (int idx = tid; idx < 8 * 64; idx += 256) {
    const int pp = idx >> 6, j = idx & 63;
    float s = p.f_b2[j];
#pragma unroll 1
    for (int i = 0; i < 64; ++i) s += h1[pp * 64 + i] * p.f_w2[i * 64 + j];
    h2[idx] = __sinf(p.f_freq2[j] * s);
  }
  __syncthreads();
#pragma unroll 1
  for (int hf = 0; hf < 2; ++hf) {
    float acc[8][4];
#pragma unroll
    for (int a = 0; a < 8; ++a)
#pragma unroll
      for (int b = 0; b < 4; ++b) acc[a][b] = 0.f;
#pragma unroll 1
    for (int k = 0; k < 64; ++k) {
      float w[4], hv[8];
#pragma unroll
      for (int q = 0; q < 4; ++q) w[q] = p.f_w3[k * 2048 + tid + 256 * (hf * 4 + q)];
#pragma unroll
      for (int pp = 0; pp < 8; ++pp) hv[pp] = h2[pp * 64 + k];
#pragma unroll
      for (int pp = 0; pp < 8; ++pp)
#pragma unroll
        for (int q = 0; q < 4; ++q) acc[pp][q] += hv[pp] * w[q];
    }
#pragma unroll
    for (int q = 0; q < 4; ++q) {
      const int n = tid + 256 * (hf * 4 + q);
      const int c = n & 1023;
      const float dec = fabsf(p.hy_decay[c]);
      bf16_t* rp = p.Rf + (size_t)c * 4096;
#pragma unroll
      for (int pp = 0; pp < 8; ++pp) {
        const int t = t0 + pp;
        const float tl = (float)t * (1.0f / 2047.0f);
        const float val = acc[pp][q] * __expf(-tl * dec);
        if (hf == 0) rp[2048 - t] = f2bf(val);
        else if (t > 0) rp[2048 + t] = f2bf(val);
        else rp[0] = 0;
      }
    }
  }
  __syncthreads();
}

__device__ __forceinline__ void phase_prep(CP& p, char* smem) {
  const int total = 192 + 256 + 12048;
  for (int it = get_bid(); it < total; it += gridDim.x) {
    if (it < 192) prep_modvec(p, smem, it);
    else if (it < 448) prep_filter(p, smem, it - 192);
    else prep_weight_tile(p, smem, it - 448);
  }
}

__device__ __forceinline__ void normmod_row(const float* __restrict__ src, const float* __restrict__ g, const float* __restrict__ sh, const float* __restrict__ sc, bf16_t* __restrict__ dst, int lane) {
  f32x4 v[4]; float ss = 0.f;
#pragma unroll
  for (int i = 0; i < 4; ++i) { v[i] = *(const f32x4*)(src + lane * 4 + 256 * i); ss += v[i][0] * v[i][0] + v[i][1] * v[i][1] + v[i][2] * v[i][2] + v[i][3] * v[i][3]; }
  ss = wave_sum(ss);
  const float r = rsqrtf(ss * (1.0f / 1024.0f) + 1e-6f);
#pragma unroll
  for (int i = 0; i < 4; ++i) {
    const int k = lane * 4 + 256 * i;
    const f32x4 g4 = *(const f32x4*)(g + k), s4 = *(const f32x4*)(sh + k), c4 = *(const f32x4*)(sc + k);
    float y[4];
#pragma unroll
    for (int j = 0; j < 4; ++j) y[j] = (v[i][j] * r * g4[j]) * (1.f + c4[j]) + s4[j];
    uint2 u; u.x = pack2(y[0], y[1]); u.y = pack2(y[2], y[3]);
    *(uint2*)(dst + k) = u;
  }
}

__device__ __forceinline__ void phase_normmod_kv(CP& p) {
  const int lane = get_tid() & 63, wv = get_tid() >> 6;
  const float* g = p.norm_mix_g;
  for (int r = get_bid() * 4 + wv; r < 18432; r += gridDim.x * 4) {
    const int b = r / 2304, pp = r - b * 2304;
    const float* src; const float* mv;
    if (pp < 256) { src = p.ctx + ((size_t)b * 256 + pp) * 1024; mv = p.modv + (size_t)8 * 6144; }
    else { src = p.x + ((size_t)b * 2048 + pp - 256) * 1024; mv = p.modv + (size_t)b * 6144; }
    normmod_row(src, g, mv, mv + 1024, p.hxc + (size_t)r * 1024, lane);
  }
}
__device__ __forceinline__ void phase_normmod_x(CP& p, const float* g, int layer, int chunk) {
  const int lane = get_tid() & 63, wv = get_tid() >> 6;
  for (int r = get_bid() * 4 + wv; r < 16384; r += gridDim.x * 4) {
    const int b = r >> 11;
    const float* mv = p.modv + (size_t)(layer * 9 + b) * 6144 + chunk * 1024;
    normmod_row(p.X + (size_t)r * 1024, g, mv, mv + 1024, p.hxc + (size_t)r * 1024, lane);
  }
}
__device__ __forceinline__ void phase_final_norm(CP& p) {
  const int lane = get_tid() & 63, wv = get_tid() >> 6;
  for (int r = get_bid() * 4 + wv; r < 16384; r += gridDim.x * 4) {
    float* row = p.X + (size_t)r * 1024;
    f32x4 v[4]; float ss = 0.f;
#pragma unroll
    for (int i = 0; i < 4; ++i) { v[i] = *(const f32x4*)(row + lane * 4 + 256 * i); ss += v[i][0] * v[i][0] + v[i][1] * v[i][1] + v[i][2] * v[i][2] + v[i][3] * v[i][3]; }
    ss = wave_sum(ss);
    const float rr = rsqrtf(ss * (1.0f / 1024.0f) + 1e-6f);
#pragma unroll
    for (int i = 0; i < 4; ++i) {
      const int k = lane * 4 + 256 * i;
      const f32x4 g4 = *(const f32x4*)(p.final_g + k);
      f32x4 o; o[0] = v[i][0] * rr * g4[0]; o[1] = v[i][1] * rr * g4[1]; o[2] = v[i][2] * rr * g4[2]; o[3] = v[i][3] * rr * g4[3];
      *(f32x4*)(row + k) = o;
    }
  }
}

__device__ __forceinline__ void phase_rowstat(CP& p) {
  const int lane = get_tid() & 63, wv = get_tid() >> 6;
  for (int r = get_bid() * 4 + wv; r < 18432; r += gridDim.x * 4) {
    const int b = r / 2304, pp = r - b * 2304;
    const bf16_t* kvr = p.kv + (size_t)r * 288;
    {
      const uint2 u = *(const uint2*)(kvr + lane * 4);
      const float a0 = bf2f((bf16_t)(u.x & 0xffff)), a1 = bf2f((bf16_t)(u.x >> 16)), a2 = bf2f((bf16_t)(u.y & 0xffff)), a3 = bf2f((bf16_t)(u.y >> 16));
      float ss = a0 * a0 + a1 * a1 + a2 * a2 + a3 * a3;
      ss = wave_sum(ss);
      if (lane == 0) p.rkv[r] = rsqrtf(ss * (1.0f / 256.0f) + 1e-6f);
    }
    {
      const int i = lane & 31;
      const float xv = bf2f(kvr[256 + i]);
      const float ov = __shfl_xor(xv, 8);
      float res = xv;
      if (pp >= 256) {
        const int t = pp - 256;
        const int quarter = i >> 3, idx = i & 7;
        const float pos = (quarter < 2) ? (float)(t >> 6) : (float)(t & 63);
        const float inv = exp2f(-(float)idx * (13.287712379549449f / 8.0f));
        const float ang = pos * inv;
        const float cs = __cosf(ang), sn = __sinf(ang);
        res = xv * cs + ((quarter & 1) ? ov : -ov) * sn;
      }
      if (lane < 32) p.kpe[(size_t)r * 32 + i] = f2bf(res);
    }
    if (pp >= 256) {
      const int xr = b * 2048 + pp - 256;
      const uint4 u = *(const uint4*)(p.cq + (size_t)xr * 512 + lane * 8);
      const unsigned uu[4] = {u.x, u.y, u.z, u.w};
      float ss = 0.f;
#pragma unroll
      for (int j = 0; j < 4; ++j) { const float a = bf2f((bf16_t)(uu[j] & 0xffff)), bb = bf2f((bf16_t)(uu[j] >> 16)); ss += a * a + bb * bb; }
      ss = wave_sum(ss);
      if (lane == 0) p.rq[xr] = rsqrtf(ss * (1.0f / 512.0f) + 1e-6f);
    }
  }
}

struct EpiStore {
  static constexpr int KIND = 0;
  bf16_t* out; int ld; int ostride; const float* rs;
  __device__ __forceinline__ void c4(int g, int rig, int col, f32x4 v) const {
    const size_t row = (size_t)g * ostride + rig;
    const float s = rs ? rs[row] : 1.f;
    uint2 u; u.x = pack2(v[0] * s, v[1] * s); u.y = pack2(v[2] * s, v[3] * s);
    *(uint2*)(out + row * ld + col) = u;
  }
};
struct EpiVt {
  static constexpr int KIND = 1;
  bf16_t* out; const float* rs;
  __device__ __forceinline__ void r4(int g, int rig, int col, f32x4 v) const {
    const size_t row = (size_t)g * 2304 + rig;
    const f32x4 s = *(const f32x4*)(rs + row);
    uint2 u; u.x = pack2(v[0] * s[0], v[1] * s[1]); u.y = pack2(v[2] * s[2], v[3] * s[3]);
    *(uint2*)(out + ((size_t)g * 1024 + col) * 2304 + rig) = u;
  }
};
struct EpiResid {
  static constexpr int KIND = 0;
  float* X; const float* base; const float* gate; const float* bias;
  __device__ __forceinline__ void c4(int g, int rig, int col, f32x4 v) const {
    const size_t o = ((size_t)g * 2048 + rig) * 1024 + col;
    const f32x4 bs = *(const f32x4*)(base + o);
    const f32x4 gt = *(const f32x4*)(gate + (size_t)g * 6144 + col);
    f32x4 bi = {0.f, 0.f, 0.f, 0.f};
    if (bias) bi = *(const f32x4*)(bias + col);
    f32x4 r;
#pragma unroll
    for (int j = 0; j < 4; ++j) r[j] = bs[j] + gt[j] * (v[j] + bi[j]);
    *(f32x4*)(X + o) = r;
  }
};
template <int MODE>
struct EpiConv {
  static constexpr int KIND = 2;
  const float* cw; const float* cb; int NC; const float* pre_bias;
  bf16_t* o0; bf16_t* o1;
  __device__ __forceinline__ int norig(int nt, int cl) const {
    if (MODE == 0) return (cl >> 6) * 2816 + nt * 64 + (cl & 63);
    if (nt < 8) return nt * 128 + cl;
    return 1024 + (cl >> 6) * 1024 + (nt - 8) * 64 + (cl & 63);
  }
  __device__ __forceinline__ void finish(const float* Z, int g, int rig0, int nt) const {
    const int tid = get_tid();
    if (MODE == 0 || nt < 8) {
      const int f = tid & 63, q = tid >> 6;
      const int p0 = 1 + 32 * q, p1 = (p0 + 32 < 127) ? p0 + 32 : 127;
      if (MODE == 0) {
        const int na = norig(nt, f), ng = norig(nt, 64 + f);
        const float a0 = cw[na], a1 = cw[NC + na], a2 = cw[2 * NC + na], ab = cb[na];
        const float g0 = cw[ng], g1 = cw[NC + ng], g2 = cw[2 * NC + ng], gb = cb[ng];
        float am = Z[(p0 - 1) * 132 + f], ac = Z[p0 * 132 + f], gm = Z[(p0 - 1) * 132 + 64 + f], gc = Z[p0 * 132 + 64 + f];
        for (int pl = p0; pl < p1; ++pl) {
          const float an = Z[(pl + 1) * 132 + f], gn = Z[(pl + 1) * 132 + 64 + f];
          const int pos = rig0 + pl;
          if (pos < 2048) {
            const float av = a0 * am + a1 * ac + a2 * an + ab;
            const float gv = g0 * gm + g1 * gc + g2 * gn + gb;
            o0[((size_t)g * 2048 + pos) * 2816 + nt * 64 + f] = f2bf(av * gv / (1.f + __expf(-gv)));
          }
          am = ac; ac = an; gm = gc; gc = gn;
        }
      } else {
#pragma unroll
        for (int fh = 0; fh < 2; ++fh) {
          const int cl = fh * 64 + f;
          const int na = norig(nt, cl);
          const float a0 = cw[na], a1 = cw[NC + na], a2 = cw[2 * NC + na], ab = cb[na];
          float am = Z[(p0 - 1) * 132 + cl], ac = Z[p0 * 132 + cl];
          for (int pl = p0; pl < p1; ++pl) {
            const float an = Z[(pl + 1) * 132 + cl];
            const int pos = rig0 + pl;
            if (pos < 2048) o0[((size_t)g * 2048 + pos) * 1024 + nt * 128 + cl] = f2bf(a0 * am + a1 * ac + a2 * an + ab);
            am = ac; ac = an;
          }
        }
      }
    } else {
      const int pl = tid & 127, fh = tid >> 7;
      const int pos = rig0 + pl;
      if (pl >= 1 && pl <= 126 && pos < 2048) {
        const int fb = nt - 8;
        for (int f = fh * 32; f < fh * 32 + 32; ++f) {
          const int na = norig(nt, f), nb = norig(nt, 64 + f);
          const float va = cw[na] * Z[(pl - 1) * 132 + f] + cw[NC + na] * Z[pl * 132 + f] + cw[2 * NC + na] * Z[(pl + 1) * 132 + f] + cb[na];
          const float vb = cw[nb] * Z[(pl - 1) * 132 + 64 + f] + cw[NC + nb] * Z[pl * 132 + 64 + f] + cw[2 * NC + nb] * Z[(pl + 1) * 132 + 64 + f] + cb[nb];
          o1[(size_t)(fb * 64 + f) * 16384 + g * 2048 + pos] = f2bf(va * vb);
        }
      }
    }
  }
};

#define GLDS16(gp, lp) __builtin_amdgcn_global_load_lds((const unsigned*)(gp), (__attribute__((address_space(3))) unsigned*)(lp), 16, 0, 0)

template <bool SWAP, class Epi>
__device__ __forceinline__ void gemm_job(char* smem, const bf16_t* __restrict__ A, int lda, const bf16_t* __restrict__ Bt, int K, int N,
                                         int tpg, int a_gstride, int a_goff, int step, int halo, int grows, int MT, int voff, int vid0, int grid, const Epi& epi) {
  const int tid = get_tid(), lane = tid & 63, wid = tid >> 6, wr = wid >> 1, wc = wid & 1, fr = lane & 15, fq = lane >> 4;
  const int NT = (N + 127) >> 7, ntiles = MT * NT, nk = K >> 5;
  int v = vid0;
  if (v < voff) v += ((voff - v + grid - 1) / grid) * grid;
  const int rdoff = ((fq ^ ((fr >> 2) & 3)) << 4);
  for (; v < voff + ntiles; v += grid) {
    const int w = v - voff;
    const int sr = w / (8 * NT), rem = w - sr * 8 * NT;
    const int nt = rem >> 3, mt = sr * 8 + (rem & 7);
    const int g = mt / tpg, ti = mt - g * tpg;
    const int rig0 = ti * step - halo;
    const bf16_t* ap[2]; const bf16_t* bp[2];
#pragma unroll
    for (int i = 0; i < 2; ++i) {
      const int b = tid * 16 + i * 4096;
      const int r = b >> 6;
      const int cs = (b & 63) >> 4;
      const int c = ((cs ^ ((r >> 2) & 3)) << 3);
      int rig = rig0 + r; rig = rig < 0 ? 0 : (rig > grows - 1 ? grows - 1 : rig);
      ap[i] = A + (size_t)(g * a_gstride + a_goff + rig) * lda + c;
      int br = nt * 128 + r; br = br > N - 1 ? N - 1 : br;
      bp[i] = Bt + (size_t)br * K + c;
    }
    f32x4 acc[4][4];
#pragma unroll
    for (int m = 0; m < 4; ++m)
#pragma unroll
      for (int n = 0; n < 4; ++n) acc[m][n] = (f32x4){0.f, 0.f, 0.f, 0.f};
#pragma unroll
    for (int i = 0; i < 2; ++i) { GLDS16(ap[i], smem + tid * 16 + i * 4096); GLDS16(bp[i], smem + 8192 + tid * 16 + i * 4096); }
    for (int t = 0; t < nk; ++t) {
      asm volatile("s_waitcnt vmcnt(0)" ::: "memory");
      __syncthreads();
      if (t + 1 < nk) {
        char* nb = smem + ((t + 1) & 1) * 16384;
        const int ko = (t + 1) * 32;
#pragma unroll
        for (int i = 0; i < 2; ++i) { GLDS16(ap[i] + ko, nb + tid * 16 + i * 4096); GLDS16(bp[i] + ko, nb + 8192 + tid * 16 + i * 4096); }
      }
      const char* sa = smem + (t & 1) * 16384; const char* sb = sa + 8192;
      bf16x8 af[4], bf[4];
#pragma unroll
      for (int m = 0; m < 4; ++m) af[m] = *(const bf16x8*)(sa + (wr * 64 + m * 16 + fr) * 64 + rdoff);
#pragma unroll
      for (int n = 0; n < 4; ++n) bf[n] = *(const bf16x8*)(sb + (wc * 64 + n * 16 + fr) * 64 + rdoff);
#pragma unroll
      for (int m = 0; m < 4; ++m)
#pragma unroll
        for (int n = 0; n < 4; ++n)
          acc[m][n] = SWAP ? __builtin_amdgcn_mfma_f32_16x16x32_bf16(bf[n], af[m], acc[m][n], 0, 0, 0)
                           : __builtin_amdgcn_mfma_f32_16x16x32_bf16(af[m], bf[n], acc[m][n], 0, 0, 0);
    }
    __syncthreads();
    if constexpr (Epi::KIND == 0) {
#pragma unroll
      for (int m = 0; m < 4; ++m) {
        const int rig = rig0 + wr * 64 + m * 16 + fr;
#pragma unroll
        for (int n = 0; n < 4; ++n) {
          const int col = nt * 128 + wc * 64 + n * 16 + fq * 4;
          if (col < N) epi.c4(g, rig, col, acc[m][n]);
        }
      }
    } else if constexpr (Epi::KIND == 1) {
#pragma unroll
      for (int m = 0; m < 4; ++m) {
        const int rig = rig0 + wr * 64 + m * 16 + fq * 4;
#pragma unroll
        for (int n = 0; n < 4; ++n) {
          const int col = nt * 128 + wc * 64 + n * 16 + fr;
          if (col < N) epi.r4(g, rig, col, acc[m][n]);
        }
      }
    } else {
      float* Z = (float*)smem;
#pragma unroll
      for (int m = 0; m < 4; ++m) {
        const int rl = wr * 64 + m * 16 + fr;
        const int pos = rig0 + rl;
        const bool ok = pos >= 0 && pos < grows;
#pragma unroll
        for (int n = 0; n < 4; ++n) {
          const int cl = wc * 64 + n * 16 + fq * 4;
          f32x4 vv = acc[m][n];
          if (epi.pre_bias) {
#pragma unroll
            for (int j = 0; j < 4; ++j) vv[j] += epi.pre_bias[epi.norig(nt, cl + j)];
          }
          if (!ok) vv = (f32x4){0.f, 0.f, 0.f, 0.f};
          *(f32x4*)(Z + rl * 132 + cl) = vv;
        }
      }
      __syncthreads();
      epi.finish(Z, g, rig0, nt);
      __syncthreads();
    }
  }
}

__device__ __forceinline__ void phase_attn(CP& p, char* smem, int vid0, int grid) {
  bf16_t* Ks = (bf16_t*)smem;
  bf16_t* Vs = (bf16_t*)(smem + 64 * 104 * 2);
  const int tid = get_tid(), lane = tid & 63, w = tid >> 6, r = lane & 31, hh = lane >> 5;
  const float cs = 1.4426950408889634f * 0.10206207261596577f;
  for (int it = vid0; it < 2048; it += grid) {
    const int qt = it & 15, h = (it >> 4) & 15, b = it >> 8;
    const int t = qt * 128 + w * 32 + r;
    const size_t xrow = (size_t)b * 2048 + t;
    const bf16_t* qp = p.Q + xrow * 1536 + h * 96;
    bf16x8 qf[6];
#pragma unroll
    for (int kk = 0; kk < 4; ++kk) qf[kk] = *(const bf16x8*)(qp + 16 * kk + 8 * hh);
#pragma unroll
    for (int part = 0; part < 2; ++part) {
      const bf16_t* pp = qp + 64 + 16 * part;
      const bf16x8 mine = *(const bf16x8*)(pp + 8 * hh), oth = *(const bf16x8*)(pp + 8 * (1 - hh));
      const float posf = part == 0 ? (float)(t >> 6) : (float)(t & 63);
      bf16x8 o;
#pragma unroll
      for (int j = 0; j < 8; ++j) {
        const float inv = exp2f(-(float)j * (13.287712379549449f / 8.0f));
        const float ang = posf * inv;
        const float c = __cosf(ang), s = __sinf(ang);
        const float m = bf2f((bf16_t)mine[j]), ov = bf2f((bf16_t)oth[j]);
        o[j] = (short)f2bf(m * c + (hh ? ov : -ov) * s);
      }
      qf[4 + part] = o;
    }
    f32x16 oacc[2];
#pragma unroll
    for (int i = 0; i < 16; ++i) { oacc[0][i] = 0.f; oacc[1][i] = 0.f; }
    float mrun = -INFINITY, lrun = 0.f;
    const size_t kvrow0 = (size_t)b * 2304;
    const bf16_t* kn_base = p.Kn + kvrow0 * 1024 + h * 64;
    const bf16_t* kpe_base = p.kpe + kvrow0 * 32;
    const bf16_t* vt_base = p.Vt + ((size_t)(b * 16 + h) * 64) * 2304;
    uint4 rk[2], rp, rv[2];
    auto gload = [&](int kt) {
#pragma unroll
      for (int i = 0; i < 2; ++i) {
        const int ci = tid + 256 * i; const int row = ci >> 3, ch = ci & 7;
        rk[i] = *(const uint4*)(kn_base + (size_t)(kt * 64 + row) * 1024 + ch * 8);
        rv[i] = *(const uint4*)(vt_base + (size_t)row * 2304 + kt * 64 + ch * 8);
      }
      rp = *(const uint4*)(kpe_base + (size_t)(kt * 64 + (tid >> 2)) * 32 + (tid & 3) * 8);
    };
    gload(0);
    for (int kt = 0; kt < 36; ++kt) {
      __syncthreads();
#pragma unroll
      for (int i = 0; i < 2; ++i) {
        const int ci = tid + 256 * i; const int row = ci >> 3, ch = ci & 7;
        *(uint4*)(Ks + row * 104 + ch * 8) = rk[i];
        uint2 lo; lo.x = rv[i].x; lo.y = rv[i].y; uint2 hi; hi.x = rv[i].z; hi.y = rv[i].w;
        *(uint2*)(Vs + row * 68 + ch * 8) = lo;
        *(uint2*)(Vs + row * 68 + ch * 8 + 4) = hi;
      }
      *(uint4*)(Ks + (tid >> 2) * 104 + 64 + (tid & 3) * 8) = rp;
      __syncthreads();
      if (kt + 1 < 36) gload(kt + 1);
      f32x16 s[2];
#pragma unroll
      for (int t2 = 0; t2 < 2; ++t2) {
#pragma unroll
        for (int i = 0; i < 16; ++i) s[t2][i] = 0.f;
#pragma unroll
        for (int kk = 0; kk < 6; ++kk) {
          const bf16x8 a = *(const bf16x8*)(Ks + (32 * t2 + r) * 104 + 16 * kk + 8 * hh);
          s[t2] = __builtin_amdgcn_mfma_f32_32x32x16_bf16(a, qf[kk], s[t2], 0, 0, 0);
        }
      }
      float mx = s[0][0];
#pragma unroll
      for (int i = 1; i < 16; ++i) mx = fmaxf(mx, s[0][i]);
#pragma unroll
      for (int i = 0; i < 16; ++i) mx = fmaxf(mx, s[1][i]);
      mx = fmaxf(mx, __shfl_xor(mx, 32));
      const float mnew = fmaxf(mrun, mx * cs);
      const float alpha = __builtin_amdgcn_exp2f(mrun - mnew);
      mrun = mnew;
      float psum = 0.f;
      bf16x8 pf[4];
#pragma unroll
      for (int t2 = 0; t2 < 2; ++t2)
#pragma unroll
        for (int i = 0; i < 16; ++i) {
          const float pv = __builtin_amdgcn_exp2f(s[t2][i] * cs - mnew);
          psum += pv;
          pf[t2 * 2 + (i >> 3)][i & 7] = (short)f2bf(pv);
        }
      lrun = lrun * alpha + psum;
#pragma unroll
      for (int i = 0; i < 16; ++i) { oacc[0][i] *= alpha; oacc[1][i] *= alpha; }
#pragma unroll
      for (int dt = 0; dt < 2; ++dt)
#pragma unroll
        for (int s4 = 0; s4 < 4; ++s4) {
          const bf16_t* vp = Vs + (32 * dt + r) * 68 + 16 * s4 + 4 * hh;
          const uint2 lo = *(const uint2*)vp, hi = *(const uint2*)(vp + 8);
          union { uint4 u; bf16x8 v; } cv; cv.u.x = lo.x; cv.u.y = lo.y; cv.u.z = hi.x; cv.u.w = hi.y;
          oacc[dt] = __builtin_amdgcn_mfma_f32_32x32x16_bf16(cv.v, pf[s4], oacc[dt], 0, 0, 0);
        }
    }
    const float ltot = lrun + __shfl_xor(lrun, 32);
    const float inv = 1.f / ltot;
    bf16_t* op = p.hxc + xrow * 1024 + h * 64;
#pragma unroll
    for (int dt = 0; dt < 2; ++dt)
#pragma unroll
      for (int i4 = 0; i4 < 4; ++i4) {
        const int d = 32 * dt + 8 * i4 + 4 * hh;
        uint2 u; u.x = pack2(oacc[dt][4 * i4] * inv, oacc[dt][4 * i4 + 1] * inv); u.y = pack2(oacc[dt][4 * i4 + 2] * inv, oacc[dt][4 * i4 + 3] * inv);
        *(uint2*)(op + d) = u;
      }
  }
}

__device__ __forceinline__ void phase_hyconv(CP& p, char* smem) {
  bf16_t* cp = (bf16_t*)smem;
  bf16_t* Vl = (bf16_t*)(smem + 4 * 8208);
  const int tid = get_tid(), lane = tid & 63, w = tid >> 6, i16 = lane & 15, g4 = lane >> 4;
  const int si = (-i16) & 3;
  const int ocb = 64 * w;
  for (int c = get_bid(); c < 1024; c += gridDim.x) {
    __syncthreads();
#pragma unroll
    for (int i = 0; i < 2; ++i) { const int ch = tid + 256 * i; *(uint4*)(cp + ch * 8) = *(const uint4*)(p.Rf + (size_t)c * 4096 + ch * 8); }
#pragma unroll
    for (int i = 0; i < 8; ++i) {
      const int q = tid + 256 * i; const int b = q >> 8, l8 = q & 255; const int m1 = l8 >> 3, m2 = (l8 & 7) * 8;
      *(uint4*)(Vl + (8 + m1 * 8 + b) * 72 + m2) = *(const uint4*)(p.vvT + (size_t)c * 16384 + b * 2048 + l8 * 8);
    }
    if (tid < 144) {
      const int colp = tid / 9, part = tid - colp * 9;
      const int col = colp < 8 ? colp : 256 + colp;
      uint4 zz; zz.x = 0; zz.y = 0; zz.z = 0; zz.w = 0;
      *(uint4*)(Vl + col * 72 + part * 8) = zz;
    }
    __syncthreads();
#pragma unroll
    for (int s = 1; s < 4; ++s)
#pragma unroll
      for (int i = 0; i < 2; ++i) {
        const int ch = tid + 256 * i;
        unsigned e[8];
#pragma unroll
        for (int j = 0; j < 8; ++j) { const int idx = 8 * ch + s + j; e[j] = idx < 4096 ? (unsigned)cp[idx] : 0u; }
        uint4 u; u.x = e[0] | (e[1] << 16); u.y = e[2] | (e[3] << 16); u.z = e[4] | (e[5] << 16); u.w = e[6] | (e[7] << 16);
        *(uint4*)(cp + s * 4104 + 8 * ch) = u;
      }
    __syncthreads();
    const bf16_t* abase = cp + si * 4104 + (2048 - i16 - si + 8 * g4);
    f32x4 acc[4][4];
#pragma unroll
    for (int m = 0; m < 4; ++m)
#pragma unroll
      for (int n = 0; n < 4; ++n) acc[m][n] = (f32x4){0.f, 0.f, 0.f, 0.f};
    for (int dl = -31; dl <= 31; ++dl) {
      bf16x8 af[4][2];
#pragma unroll
      for (int mt = 0; mt < 4; ++mt)
#pragma unroll
        for (int kk = 0; kk < 2; ++kk) {
          const bf16_t* ap = abase - 64 * dl - 16 * mt + 32 * kk;
          const uint2 lo = *(const uint2*)ap, hi = *(const uint2*)(ap + 4);
          union { uint4 u; bf16x8 v; } cv; cv.u.x = lo.x; cv.u.y = lo.y; cv.u.z = hi.x; cv.u.w = hi.y;
          af[mt][kk] = cv.v;
        }
#pragma unroll
      for (int jt = 0; jt < 4; ++jt) {
        const int in0 = ocb + 16 * jt - 8 * dl;
        if (in0 >= -8 && in0 <= 248) {
          const bf16_t* bp = Vl + (in0 + 8 + i16) * 72 + 8 * g4;
          const bf16x8 b0 = *(const bf16x8*)bp, b1 = *(const bf16x8*)(bp + 32);
#pragma unroll
          for (int mt = 0; mt < 4; ++mt) {
            acc[mt][jt] = __builtin_amdgcn_mfma_f32_16x16x32_bf16(af[mt][0], b0, acc[mt][jt], 0, 0, 0);
            acc[mt][jt] = __builtin_amdgcn_mfma_f32_16x16x32_bf16(af[mt][1], b1, acc[mt][jt], 0, 0, 0);
          }
        }
      }
    }
    const float db = p.hy_d_bias[c];
#pragma unroll
    for (int mt = 0; mt < 4; ++mt)
#pragma unroll
      for (int jt = 0; jt < 4; ++jt) {
        const int col = ocb + 16 * jt + i16;
        const int n1 = col >> 3, b = col & 7;
        const int n2 = 16 * mt + 4 * g4;
        const uint2 vv = *(const uint2*)(Vl + (col + 8) * 72 + n2);
        const float y0 = acc[mt][jt][0] + bf2f((bf16_t)(vv.x & 0xffff)) * db;
        const float y1 = acc[mt][jt][1] + bf2f((bf16_t)(vv.x >> 16)) * db;
        const float y2 = acc[mt][jt][2] + bf2f((bf16_t)(vv.y & 0xffff)) * db;
        const float y3 = acc[mt][jt][3] + bf2f((bf16_t)(vv.y >> 16)) * db;
        uint2 u; u.x = pack2(y0, y1); u.y = pack2(y2, y3);
        *(uint2*)(p.Yp + (size_t)c * 16384 + b * 2048 + n1 * 64 + n2) = u;
      }
  }
}

__device__ __forceinline__ void phase_transmul(CP& p, char* smem) {
  bf16_t* tl = (bf16_t*)smem;
  const int tid = get_tid();
  for (int it = get_bid(); it < 4096; it += gridDim.x) {
    const int ct = it & 15, rt = it >> 4;
    const int c0 = ct * 64, r0 = rt * 64;
    __syncthreads();
#pragma unroll
    for (int i = 0; i < 2; ++i) {
      const int ci = tid + 256 * i; const int cc = ci >> 3, ch = ci & 7;
      const uint4 u = *(const uint4*)(p.Yp + (size_t)(c0 + cc) * 16384 + r0 + ch * 8);
      unsigned* d = (unsigned*)(tl + cc * 66 + ch * 8);
      d[0] = u.x; d[1] = u.y; d[2] = u.z; d[3] = u.w;
    }
    __syncthreads();
    const int row = tid >> 2, cq = tid & 3;
    const bf16_t* xp = p.x1h + (size_t)(r0 + row) * 1024 + c0 + cq * 16;
    const uint4 xa = *(const uint4*)xp, xb = *(const uint4*)(xp + 8);
    const unsigned xs[8] = {xa.x, xa.y, xa.z, xa.w, xb.x, xb.y, xb.z, xb.w};
    unsigned o[8];
#pragma unroll
    for (int j = 0; j < 8; ++j) {
      const float y0 = bf2f(tl[(cq * 16 + 2 * j) * 66 + row]) * bf2f((bf16_t)(xs[j] & 0xffff));
      const float y1 = bf2f(tl[(cq * 16 + 2 * j + 1) * 66 + row]) * bf2f((bf16_t)(xs[j] >> 16));
      o[j] = pack2(y0, y1);
    }
    bf16_t* op = p.hxc + (size_t)(r0 + row) * 1024 + c0 + cq * 16;
    uint4 oa; oa.x = o[0]; oa.y = o[1]; oa.z = o[2]; oa.w = o[3];
    uint4 ob; ob.x = o[4]; ob.y = o[5]; ob.z = o[6]; ob.w = o[7];
    *(uint4*)op = oa; *(uint4*)(op + 8) = ob;
  }
}

__global__ void __launch_bounds__(256, 2) mega(P p_arg) {
  __shared__ __attribute__((aligned(16))) char smem[LDS_BYTES];
  cg::grid_group grid = cg::this_grid();
  const int G = gridDim.x;
  CP* pp = (CP*)__builtin_amdgcn_kernarg_segment_ptr();
  const int ph0 = pp->ph0, ph1 = pp->ph1;
  for (int ph = ph0; ph < ph1; ++ph) {
    asm volatile("" : "+s"(pp));
    CP& p = *pp;
    const int bid = get_bid();
    const int vid0 = (G & 7) ? bid : ((bid & 7) * (G >> 3) + (bid >> 3));
    const float* mv0 = p.modv; const float* mv1 = p.modv + (size_t)9 * 6144;
    switch (ph) {
      case 0: phase_prep(p, smem); break;
      case 1: phase_normmod_kv(p); break;
      case 2: {
        EpiStore e1{p.cq, 512, 2048, nullptr};
        gemm_job<true>(smem, p.hxc, 1024, p.wt_dq, 1024, 512, 16, 2304, 256, 128, 0, 2048, 128, 0, vid0, G, e1);
        EpiStore e2{p.kv, 288, 2304, nullptr};
        gemm_job<true>(smem, p.hxc, 1024, p.wt_dkv, 1024, 288, 18, 2304, 0, 128, 0, 2304, 144, 128 * 4, vid0, G, e2);
      } break;
      case 3: phase_rowstat(p); break;
      case 4: {
        EpiStore e1{p.Q, 1536, 2048, p.rq};
        gemm_job<true>(smem, p.cq, 512, p.wt_uq, 512, 1536, 16, 2048, 0, 128, 0, 2048, 128, 0, vid0, G, e1);
        EpiStore e2{p.Kn, 1024, 2304, p.rkv};
        gemm_job<true>(smem, p.kv, 288, p.wt_uk, 256, 1024, 18, 2304, 0, 128, 0, 2304, 144, 128 * 12, vid0, G, e2);
        EpiVt e3{p.Vt, p.rkv};
        gemm_job<false>(smem, p.kv, 288, p.wt_uv, 256, 1024, 18, 2304, 0, 128, 0, 2304, 144, 128 * 12 + 144 * 8, vid0, G, e3);
      } break;
      case 5: phase_attn(p, smem, vid0, G); break;
      case 6: {
        EpiResid e{p.X, p.x, mv0 + 2 * 1024, nullptr};
        gemm_job<true>(smem, p.hxc, 1024, p.wt_o, 1024, 1024, 16, 2048, 0, 128, 0, 2048, 128, 0, vid0, G, e);
      } break;
      case 7: phase_normmod_x(p, p.norm_ffn_g, 0, 3); break;
      case 8: {
        EpiConv<0> e{p.ffn_conv_w, p.ffn_conv_b, 5632, nullptr, p.act, nullptr};
        gemm_job<true>(smem, p.hxc, 1024, p.wt_up0, 1024, 5632, 17, 2048, 0, 126, 1, 2048, 136, 0, vid0, G, e);
      } break;
      case 9: {
        EpiResid e{p.X, p.X, mv0 + 5 * 1024, nullptr};
        gemm_job<true>(smem, p.act, 2816, p.wt_dn0, 2816, 1024, 16, 2048, 0, 128, 0, 2048, 128, 0, vid0, G, e);
      } break;
      case 10: phase_normmod_x(p, p.norm_mix_g + 1024, 1, 0); break;
      case 11: {
        EpiConv<1> e{p.hy_conv_w, p.hy_conv_b, 3072, p.hy_b_in, p.x1h, p.vvT};
        gemm_job<true>(smem, p.hxc, 1024, p.wt_hin, 1024, 3072, 17, 2048, 0, 126, 1, 2048, 136, 0, vid0, G, e);
      } break;
      case 12: phase_hyconv(p, smem); break;
      case 13: phase_transmul(p, smem); break;
      case 14: {
        EpiResid e{p.X, p.X, mv1 + 2 * 1024, p.hy_b_out};
        gemm_job<true>(smem, p.hxc, 1024, p.wt_hout, 1024, 1024, 16, 2048, 0, 128, 0, 2048, 128, 0, vid0, G, e);
      } break;
      case 15: phase_normmod_x(p, p.norm_ffn_g + 1024, 1, 3); break;
      case 16: {
        EpiConv<0> e{p.ffn_conv_w + (size_t)3 * 5632, p.ffn_conv_b + 5632, 5632, nullptr, p.act, nullptr};
        gemm_job<true>(smem, p.hxc, 1024, p.wt_up1, 1024, 5632, 17, 2048, 0, 126, 1, 2048, 136, 0, vid0, G, e);
      } break;
      case 17: {
        EpiResid e{p.X, p.X, mv1 + 5 * 1024, nullptr};
        gemm_job<true>(smem, p.act, 2816, p.wt_dn1, 2816, 1024, 16, 2048, 0, 128, 0, 2048, 128, 0, vid0, G, e);
      } break;
      default: phase_final_norm(p); break;
    }
    if (ph + 1 < ph1) grid.sync();
  }
}

extern "C" void kernel_launch(void* const* d_in, const int* in_sizes, int n_in, void* d_out, int out_size, void* d_ws, size_t ws_size, hipStream_t stream) {
  static int grid_blocks = 0;
  if (!grid_blocks) {
    int dev = 0, cus = 0, per_cu = 0;
    hipGetDevice(&dev);
    hipDeviceGetAttribute(&cus, hipDeviceAttributeMultiprocessorCount, dev);
    hipOccupancyMaxActiveBlocksPerMultiprocessor(&per_cu, (const void*)mega, 256, 0);
    if (per_cu < 1) per_cu = 1;
    if (per_cu > 2) per_cu = 2;
    grid_blocks = cus * per_cu;
  }
  P p{};
  const float** in = (const float**)&p;
  for (int i = 0; i < 36; ++i) in[i] = (const float*)d_in[i];
  p.X = (float*)d_out;
  char* ws = (char*)d_ws; size_t off = 0;
  auto take = [&](size_t bytes) { char* r = ws + off; off += (bytes + 255) & ~(size_t)255; return r; };
  p.wt_dq = (bf16_t*)take((size_t)512 * 1024 * 2);
  p.wt_dkv = (bf16_t*)take((size_t)288 * 1024 * 2);
  p.wt_uq = (bf16_t*)take((size_t)1536 * 512 * 2);
  p.wt_uk = (bf16_t*)take((size_t)1024 * 256 * 2);
  p.wt_uv = (bf16_t*)take((size_t)1024 * 256 * 2);
  p.wt_o = (bf16_t*)take((size_t)1024 * 1024 * 2);
  p.wt_hin = (bf16_t*)take((size_t)3072 * 1024 * 2);
  p.wt_hout = (bf16_t*)take((size_t)1024 * 1024 * 2);
  p.wt_up0 = (bf16_t*)take((size_t)5632 * 1024 * 2);
  p.wt_up1 = (bf16_t*)take((size_t)5632 * 1024 * 2);
  p.wt_dn0 = (bf16_t*)take((size_t)1024 * 2816 * 2);
  p.wt_dn1 = (bf16_t*)take((size_t)1024 * 2816 * 2);
  p.modv = (float*)take((size_t)2 * 9 * 6144 * 4);
  p.rq = (float*)take((size_t)16384 * 4);
  p.rkv = (float*)take((size_t)18432 * 4);
  p.Rf = (bf16_t*)take((size_t)1024 * 4096 * 2);
  p.kpe = (bf16_t*)take((size_t)18432 * 32 * 2);
  p.hxc = (bf16_t*)take((size_t)18432 * 1024 * 2);
  const size_t ubase = off;
  p.cq = (bf16_t*)take((size_t)16384 * 512 * 2);
  p.kv = (bf16_t*)take((size_t)18432 * 288 * 2);
  p.Q = (bf16_t*)take((size_t)16384 * 1536 * 2);
  p.Kn = (bf16_t*)take((size_t)18432 * 1024 * 2);
  p.Vt = (bf16_t*)take((size_t)18432 * 1024 * 2);
  const size_t uend1 = off;
  off = ubase;
  p.act = (bf16_t*)take((size_t)16384 * 2816 * 2);
  off = ubase;
  p.x1h = (bf16_t*)take((size_t)16384 * 1024 * 2);
  p.vvT = (bf16_t*)take((size_t)16384 * 1024 * 2);
  p.Yp = (bf16_t*)take((size_t)16384 * 1024 * 2);
  if (uend1 > ws_size) { fprintf(stderr, "workspace too small: need %zu have %zu\n", uend1, ws_size); return; }
  p.ph0 = 0; p.ph1 = NPHASE;
  void* args[] = {&p};
  hipError_t e = hipLaunchCooperativeKernel((const void*)mega, dim3(grid_blocks), dim3(256), args, 0, stream);
  if (e != hipSuccess) fprintf(stderr, "cooperative launch failed: %s (grid %d)\n", hipGetErrorString(e), grid_blocks);
}
```

```cpp
#include <hip/hip_runtime.h>
#include <hip/hip_cooperative_groups.h>
#include <cstdio>
namespace cg = cooperative_groups;

typedef unsigned short bf16_t;
typedef short bf16x8 __attribute__((ext_vector_type(8)));
typedef float f32x4 __attribute__((ext_vector_type(4)));
typedef float f32x16 __attribute__((ext_vector_type(16)));

#define LDS_BYTES 73728
#define NPHASE 19

struct P {
  const float *x, *c, *ctx, *c_ctx, *mod_w, *mod_b, *norm_mix_g, *norm_ffn_g;
  const float *w_dq, *g_q, *w_uq, *w_dkv, *g_kv, *w_uk, *w_uv, *w_o;
  const float *hy_w_in, *hy_b_in, *hy_conv_w, *hy_conv_b, *f_w1, *f_b1, *f_freq1, *f_w2, *f_b2, *f_freq2, *f_w3, *hy_decay, *hy_d_bias, *hy_w_out, *hy_b_out;
  const float *ffn_w_up, *ffn_conv_w, *ffn_conv_b, *ffn_w_down, *final_g;
  float* X;
  bf16_t *wt_dq, *wt_dkv, *wt_uq, *wt_uk, *wt_uv, *wt_o, *wt_hin, *wt_hout, *wt_up0, *wt_up1, *wt_dn0, *wt_dn1;
  float *modv, *rq, *rkv, *modp;
  unsigned* bar;
  bf16_t *wt_f3, *h2bf;
  bf16_t *Rf, *kpe, *hxc, *cq, *kv, *Q, *Kn, *Vt, *act, *x1h, *vvT, *Yp;
  int ph0, ph1;
};

typedef const __attribute__((address_space(4))) P CP;
__device__ __forceinline__ int get_tid() { int t = threadIdx.x; asm volatile("" : "+v"(t)); return t; }
__device__ __forceinline__ int get_bid() { int t = blockIdx.x; asm volatile("" : "+s"(t)); return t; }

__device__ __forceinline__ bf16_t f2bf(float f) { unsigned u = __float_as_uint(f); u += 0x7fffu + ((u >> 16) & 1u); return (bf16_t)(u >> 16); }
__device__ __forceinline__ float bf2f(bf16_t h) { return __uint_as_float(((unsigned)h) << 16); }
__device__ __forceinline__ unsigned pack2(float a, float b) { return (unsigned)f2bf(a) | ((unsigned)f2bf(b) << 16); }
__device__ __forceinline__ float wave_sum(float v) {
#pragma unroll
  for (int o = 32; o; o >>= 1) v += __shfl_xor(v, o);
  return v;
}


#define XB_TMO      128
#define XB_XCNT(j)  (256  + 64 * (j))
#define XB_XSUB(j)  (1280 + 64 * (j))
#define XB_XGEN(j)  (2304 + 64 * (j))
#define XB_TOP      3328
#define XB_TOPGEN   3392
#define XCD_BAR_WORDS 3456
#define XB_SPIN_CAP (1u << 18)
#define LAS __attribute__((address_space(3)))
__device__ __forceinline__ unsigned xb_ld(unsigned* p)              { return __hip_atomic_load(p, __ATOMIC_RELAXED, __HIP_MEMORY_SCOPE_AGENT); }
__device__ __forceinline__ unsigned xb_add(unsigned* p, unsigned v) { return __hip_atomic_fetch_add(p, v, __ATOMIC_RELAXED, __HIP_MEMORY_SCOPE_AGENT); }
__device__ __forceinline__ unsigned xb_xcc_id() { return (unsigned)__builtin_amdgcn_s_getreg((3 << 11) | 20) & 0xFu; }
#define XB_SPIN(cond, bar) do { unsigned _sp = 0; while (cond) { __builtin_amdgcn_s_sleep(1); \
    if ((++_sp & 255u) == 0u) { if (xb_ld(&(bar)[XB_TMO])) break; if (_sp > XB_SPIN_CAP) { atomicAdd(&(bar)[XB_TMO], 1u); break; } } } } while (0)
struct XcdBarrier { unsigned* bar; unsigned x; volatile LAS unsigned* st; };
__device__ __forceinline__ XcdBarrier xcd_barrier_post(unsigned* bar, volatile LAS unsigned* st) {
    XcdBarrier b; b.bar = bar; b.x = xb_xcc_id(); b.st = st;
    if (threadIdx.x == 0) (void)xb_add(&bar[XB_XCNT(b.x)], 1u);
    return b;
}
__device__ __forceinline__ void xcd_barrier_complete(unsigned* bar, unsigned x, unsigned& nloc, unsigned& nx) {
    const unsigned G = gridDim.x * gridDim.y * gridDim.z;
    unsigned sum, cnt, mine, sp = 0u;
    for (;;) {
        sum = 0u; cnt = 0u; mine = 0u;
#pragma unroll
        for (unsigned j = 0; j < 16; ++j) { const unsigned c = xb_ld(&bar[XB_XCNT(j)]); sum += c; cnt += (c > 0u) ? 1u : 0u; mine = (j == x) ? c : mine; }
        if (sum == G) break;
        __builtin_amdgcn_s_sleep(1);
        if ((++sp & 255u) == 0u) { if (xb_ld(&bar[XB_TMO])) break; if (sp > XB_SPIN_CAP) { atomicAdd(&bar[XB_TMO], 1u); break; } }
    }
    nloc = mine > 0u ? mine : 1u; nx = cnt > 0u ? cnt : 1u;
}
__device__ __forceinline__ void xcd_barrier(const XcdBarrier& b) {
    asm volatile("s_waitcnt vmcnt(0)" ::: "memory");
    __syncthreads();
    if (threadIdx.x == 0) {
        unsigned* bar = b.bar;
        __builtin_amdgcn_s_waitcnt(0);
        unsigned nloc = b.st[0], nx = b.st[1];
        if (nloc == 0u) { xcd_barrier_complete(bar, b.x, nloc, nx); b.st[0] = nloc; b.st[1] = nx; }
        const unsigned old = xb_add(&bar[XB_XSUB(b.x)], 1u);
        const unsigned gen = old / nloc;
        if (old + 1u == (gen + 1u) * nloc) {
            __builtin_amdgcn_fence(__ATOMIC_RELEASE, "agent");
            asm volatile("s_waitcnt vmcnt(0)" ::: "memory");
            const unsigned og = xb_add(&bar[XB_TOP], 1u);
            const unsigned tg = og / nx;
            if (og + 1u == (tg + 1u) * nx) xb_add(&bar[XB_TOPGEN], 1u);
            else XB_SPIN(xb_ld(&bar[XB_TOPGEN]) == tg, bar);
            __builtin_amdgcn_fence(__ATOMIC_ACQUIRE, "agent");
            xb_add(&bar[XB_XGEN(b.x)], 1u);
            asm volatile("s_waitcnt vmcnt(0)" ::: "memory");
        } else {
            XB_SPIN(xb_ld(&bar[XB_XGEN(b.x)]) == gen, bar);
            __builtin_amdgcn_fence(__ATOMIC_ACQUIRE, "agent");
            asm volatile("s_waitcnt vmcnt(0)" ::: "memory");
        }
    }
    __syncthreads();
}

__device__ __forceinline__ void prep_weight_tile(CP& p, char* smem, int wt) {
  const int tid = get_tid();
  int id = 0;
  {
    const int cnt[13] = {128, 80, 192, 64, 64, 256, 768, 256, 1408, 1408, 704, 704, 32};
#pragma unroll
    for (int i = 0; i < 12; ++i) { if (id == i && wt >= cnt[i]) { wt -= cnt[i]; id = i + 1; } }
  }
  const float* src; int K, N; bf16_t* dst; const float* scale = nullptr; int perm = 0;
  switch (id) {
    case 0: src = p.w_dq; K = 1024; N = 512; dst = p.wt_dq; break;
    case 1: src = p.w_dkv; K = 1024; N = 288; dst = p.wt_dkv; break;
    case 2: src = p.w_uq; K = 512; N = 1536; dst = p.wt_uq; scale = p.g_q; break;
    case 3: src = p.w_uk; K = 256; N = 1024; dst = p.wt_uk; scale = p.g_kv; break;
    case 4: src = p.w_uv; K = 256; N = 1024; dst = p.wt_uv; scale = p.g_kv; break;
    case 5: src = p.w_o; K = 1024; N = 1024; dst = p.wt_o; break;
    case 6: src = p.hy_w_in; K = 1024; N = 3072; dst = p.wt_hin; perm = 2; break;
    case 7: src = p.hy_w_out; K = 1024; N = 1024; dst = p.wt_hout; break;
    case 8: src = p.ffn_w_up; K = 1024; N = 5632; dst = p.wt_up0; perm = 1; break;
    case 9: src = p.ffn_w_up + (size_t)1024 * 5632; K = 1024; N = 5632; dst = p.wt_up1; perm = 1; break;
    case 10: src = p.ffn_w_down; K = 2816; N = 1024; dst = p.wt_dn0; break;
    case 11: src = p.ffn_w_down + (size_t)2816 * 1024; K = 2816; N = 1024; dst = p.wt_dn1; break;
    default: src = p.f_w3; K = 64; N = 2048; dst = p.wt_f3; break;
  }
  const int ntn = (N + 63) >> 6;
  const int kt = wt / ntn, nt = wt - kt * ntn;
  const int k0 = kt * 64, n0 = nt * 64;
  int np0;
  if (perm == 1) { const int half = n0 / 2816, f = n0 - half * 2816; np0 = (f >> 6) * 128 + half * 64; }
  else if (perm == 2) { if (n0 < 1024) np0 = n0; else { const int m = n0 - 1024, half = m >> 10, f = m & 1023; np0 = 1024 + (f >> 6) * 128 + half * 64; } }
  else np0 = n0;
  bf16_t* t16 = (bf16_t*)smem;
  f32x4 v[4];
#pragma unroll
  for (int i = 0; i < 4; ++i) {
    const int idx = tid + 256 * i; const int kr = idx >> 4, c4 = idx & 15;
    v[i] = (f32x4){0.f, 0.f, 0.f, 0.f};
    if (n0 + 4 * c4 < N) v[i] = *(const f32x4*)(src + (size_t)(k0 + kr) * N + n0 + 4 * c4);
  }
#pragma unroll
  for (int i = 0; i < 4; ++i) {
    const int idx = tid + 256 * i; const int kr = idx >> 4, c4 = idx & 15;
    const float sc = scale ? scale[k0 + kr] : 1.f;
#pragma unroll
    for (int j = 0; j < 4; ++j) t16[(4 * c4 + j) * 72 + kr] = f2bf(v[i][j] * sc);
  }
  __syncthreads();
#pragma unroll
  for (int i = 0; i < 2; ++i) {
    const int idx = tid + 256 * i; const int n = idx >> 3, ch = idx & 7;
    if (n0 + n < N) *(uint4*)(dst + (size_t)(np0 + n) * K + k0 + ch * 8) = *(const uint4*)(t16 + n * 72 + ch * 8);
  }
  __syncthreads();
}

__device__ __forceinline__ void prep_modvec(CP& p, char* smem, int it) {
  const int tid = get_tid();
  const int layer = it / 384, rem = it - layer * 384, cb = rem >> 2, ks = rem & 3;
  float* s_lds = (float*)smem;
  float* red = (float*)(smem + 12288);
  const int kbase = ks * 256;
  for (int idx = tid; idx < 9 * 256; idx += 256) {
    const int r = idx >> 8, k = idx & 255;
    const float v = r < 8 ? p.c[r * 1024 + kbase + k] : p.c_ctx[kbase + k];
    s_lds[k * 12 + r] = v / (1.f + __expf(-v));
  }
  __syncthreads();
  const int col = cb * 64 + (tid & 63), kg = tid >> 6;
  const float* W = p.mod_w + (size_t)layer * 1024 * 6144 + (size_t)kbase * 6144 + col;
  float acc[9];
#pragma unroll
  for (int r = 0; r < 9; ++r) acc[r] = 0.f;
#pragma unroll
  for (int kb = 0; kb < 4; ++kb) {
    float w[16];
#pragma unroll
    for (int u = 0; u < 16; ++u) w[u] = W[(size_t)(kg * 64 + kb * 16 + u) * 6144];
#pragma unroll
    for (int u = 0; u < 16; ++u) {
      const int k = kg * 64 + kb * 16 + u;
      const f32x4 s0 = *(const f32x4*)(s_lds + k * 12), s1 = *(const f32x4*)(s_lds + k * 12 + 4);
      const float s2 = s_lds[k * 12 + 8];
      acc[0] += s0[0] * w[u]; acc[1] += s0[1] * w[u]; acc[2] += s0[2] * w[u]; acc[3] += s0[3] * w[u];
      acc[4] += s1[0] * w[u]; acc[5] += s1[1] * w[u]; acc[6] += s1[2] * w[u]; acc[7] += s1[3] * w[u];
      acc[8] += s2 * w[u];
    }
  }
#pragma unroll
  for (int r = 0; r < 9; ++r) red[(kg * 9 + r) * 64 + (tid & 63)] = acc[r];
  __syncthreads();
  for (int o = tid; o < 9 * 64; o += 256) {
    const int r = o >> 6, cl = o & 63;
    const float sm = red[(0 * 9 + r) * 64 + cl] + red[(1 * 9 + r) * 64 + cl] + red[(2 * 9 + r) * 64 + cl] + red[(3 * 9 + r) * 64 + cl];
    p.modp[(size_t)ks * 110592 + (size_t)(layer * 9 + r) * 6144 + cb * 64 + cl] = sm;
  }
  __syncthreads();
}

__device__ __forceinline__ void prep_filter(CP& p, char* smem, int it) {
  const int tid = get_tid();
  float* z = (float*)smem;
  float* h1 = z + 8 * 33;
  float* h2 = h1 + 8 * 64;
  const int t0 = it * 8;
  for (int idx = tid; idx < 8 * 33; idx += 256) {
    const int pp = idx / 33, i = idx - pp * 33;
    const int t = t0 + pp;
    float v;
    if (i == 0) v = (float)t * (1.0f / 2047.0f);
    else {
      const int k = (i - 1) & 15;
      const float w = (6.283185307179586f * (float)t) / 2048.0f;
      const float f = 1e-4f + (float)k * ((15.0f - 1e-4f) / 15.0f);
      const float a = w * f;
      v = (i <= 16) ? __cosf(a) : -__sinf(a);
    }
    z[idx] = v;
  }
  __syncthreads();
  for (int idx = tid; idx < 8 * 64; idx += 256) {
    const int pp = idx >> 6, j = idx & 63;
    float s = p.f_b1[j];
#pragma unroll
    for (int i = 0; i < 33; ++i) s += z[pp * 33 + i] * p.f_w1[i * 64 + j];
    h1[idx] = __sinf(p.f_freq1[j] * s);
  }
  __syncthreads();
  for (int idx = tid; idx < 8 * 64; idx += 256) {
    const int pp = idx >> 6, j = idx & 63;
    float s = p.f_b2[j];
#pragma unroll 16
    for (int i = 0; i < 64; ++i) s += h1[pp * 64 + i] * p.f_w2[i * 64 + j];
    h2[idx] = __sinf(p.f_freq2[j] * s);
  }
  __syncthreads();
  for (int idx = tid; idx < 8 * 64; idx += 256) p.h2bf[(size_t)t0 * 64 + idx] = f2bf(h2[idx]);
  __syncthreads();
}

__device__ __forceinline__ void phase_prep(CP& p, char* smem) {
  const int total = 768 + 256 + 6064;
  for (int it = get_bid(); it < total; it += gridDim.x) {
    if (it < 768) prep_modvec(p, smem, it);
    else if (it < 1024) prep_filter(p, smem, it - 768);
    else prep_weight_tile(p, smem, it - 1024);
  }
}

template <bool PART>
__device__ __forceinline__ void normmod_row(const float* __restrict__ src, const float* __restrict__ g, const float* __restrict__ sh, const float* __restrict__ sc, bf16_t* __restrict__ dst, int lane, const float* __restrict__ bsh = nullptr) {
  f32x4 v[4]; float ss = 0.f;
#pragma unroll
  for (int i = 0; i < 4; ++i) { v[i] = *(const f32x4*)(src + lane * 4 + 256 * i); ss += v[i][0] * v[i][0] + v[i][1] * v[i][1] + v[i][2] * v[i][2] + v[i][3] * v[i][3]; }
  ss = wave_sum(ss);
  const float r = rsqrtf(ss * (1.0f / 1024.0f) + 1e-6f);
#pragma unroll
  for (int i = 0; i < 4; ++i) {
    const int k = lane * 4 + 256 * i;
    const f32x4 g4 = *(const f32x4*)(g + k);
    f32x4 s4 = *(const f32x4*)(sh + k), c4 = *(const f32x4*)(sc + k);
    if (PART) {
#pragma unroll
      for (int q = 1; q < 4; ++q) { s4 += *(const f32x4*)(sh + (size_t)q * 110592 + k); c4 += *(const f32x4*)(sc + (size_t)q * 110592 + k); }
      s4 += *(const f32x4*)(bsh + k); c4 += *(const f32x4*)(bsh + 1024 + k);
    }
    float y[4];
#pragma unroll
    for (int j = 0; j < 4; ++j) y[j] = (v[i][j] * r * g4[j]) * (1.f + c4[j]) + s4[j];
    uint2 u; u.x = pack2(y[0], y[1]); u.y = pack2(y[2], y[3]);
    *(uint2*)(dst + k) = u;
  }
}

__device__ __forceinline__ void phase_normmod_kv(CP& p) {
  const int lane = get_tid() & 63, wv = get_tid() >> 6;
  const float* g = p.norm_mix_g;
  for (int idx = get_bid() * 256 + get_tid(); idx < 110592; idx += gridDim.x * 256) {
    const int lr = idx / 6144; const int n = idx - lr * 6144; const int layer = lr / 9;
    p.modv[idx] = p.modp[idx] + p.modp[110592 + idx] + p.modp[2 * 110592 + idx] + p.modp[3 * 110592 + idx] + p.mod_b[layer * 6144 + n];
  }
  for (int r = get_bid() * 4 + wv; r < 18432; r += gridDim.x * 4) {
    const int b = r / 2304, pp = r - b * 2304;
    const float* src; const float* mv;
    if (pp < 256) { src = p.ctx + ((size_t)b * 256 + pp) * 1024; mv = p.modp + (size_t)8 * 6144; }
    else { src = p.x + ((size_t)b * 2048 + pp - 256) * 1024; mv = p.modp + (size_t)b * 6144; }
    normmod_row<true>(src, g, mv, mv + 1024, p.hxc + (size_t)r * 1024, lane, p.mod_b);
  }
}
__device__ __forceinline__ void phase_normmod_x(CP& p, const float* g, int layer, int chunk) {
  const int lane = get_tid() & 63, wv = get_tid() >> 6;
  for (int r = get_bid() * 4 + wv; r < 16384; r += gridDim.x * 4) {
    const int b = r >> 11;
    const float* mv = p.modv + (size_t)(layer * 9 + b) * 6144 + chunk * 1024;
    normmod_row<false>(p.X + (size_t)r * 1024, g, mv, mv + 1024, p.hxc + (size_t)r * 1024, lane);
  }
}
__device__ __forceinline__ void phase_final_norm(CP& p) {
  const int lane = get_tid() & 63, wv = get_tid() >> 6;
  for (int r = get_bid() * 4 + wv; r < 16384; r += gridDim.x * 4) {
    float* row = p.X + (size_t)r * 1024;
    f32x4 v[4]; float ss = 0.f;
#pragma unroll
    for (int i = 0; i < 4; ++i) { v[i] = *(const f32x4*)(row + lane * 4 + 256 * i); ss += v[i][0] * v[i][0] + v[i][1] * v[i][1] + v[i][2] * v[i][2] + v[i][3] * v[i][3]; }
    ss = wave_sum(ss);
    const float rr = rsqrtf(ss * (1.0f / 1024.0f) + 1e-6f);
#pragma unroll
    for (int i = 0; i < 4; ++i) {
      const int k = lane * 4 + 256 * i;
      const f32x4 g4 = *(const f32x4*)(p.final_g + k);
      f32x4 o; o[0] = v[i][0] * rr * g4[0]; o[1] = v[i][1] * rr * g4[1]; o[2] = v[i][2] * rr * g4[2]; o[3] = v[i][3] * rr * g4[3];
      *(f32x4*)(row + k) = o;
    }
  }
}

__device__ __forceinline__ void phase_rowstat(CP& p) {
  const int lane = get_tid() & 63, wv = get_tid() >> 6;
  for (int r = get_bid() * 4 + wv; r < 18432; r += gridDim.x * 4) {
    const int b = r / 2304, pp = r - b * 2304;
    const bf16_t* kvr = p.kv + (size_t)r * 288;
    {
      const uint2 u = *(const uint2*)(kvr + lane * 4);
      const float a0 = bf2f((bf16_t)(u.x & 0xffff)), a1 = bf2f((bf16_t)(u.x >> 16)), a2 = bf2f((bf16_t)(u.y & 0xffff)), a3 = bf2f((bf16_t)(u.y >> 16));
      float ss = a0 * a0 + a1 * a1 + a2 * a2 + a3 * a3;
      ss = wave_sum(ss);
      if (lane == 0) p.rkv[r] = rsqrtf(ss * (1.0f / 256.0f) + 1e-6f);
    }
    {
      const int i = lane & 31;
      const float xv = bf2f(kvr[256 + i]);
      const float ov = __shfl_xor(xv, 8);
      float res = xv;
      if (pp >= 256) {
        const int t = pp - 256;
        const int quarter = i >> 3, idx = i & 7;
        const float pos = (quarter < 2) ? (float)(t >> 6) : (float)(t & 63);
        const float inv = exp2f(-(float)idx * (13.287712379549449f / 8.0f));
        const float ang = pos * inv;
        const float cs = __cosf(ang), sn = __sinf(ang);
        res = xv * cs + ((quarter & 1) ? ov : -ov) * sn;
      }
      if (lane < 32) p.kpe[(size_t)r * 32 + i] = f2bf(res);
    }
    if (pp >= 256) {
      const int xr = b * 2048 + pp - 256;
      const uint4 u = *(const uint4*)(p.cq + (size_t)xr * 512 + lane * 8);
      const unsigned uu[4] = {u.x, u.y, u.z, u.w};
      float ss = 0.f;
#pragma unroll
      for (int j = 0; j < 4; ++j) { const float a = bf2f((bf16_t)(uu[j] & 0xffff)), bb = bf2f((bf16_t)(uu[j] >> 16)); ss += a * a + bb * bb; }
      ss = wave_sum(ss);
      if (lane == 0) p.rq[xr] = rsqrtf(ss * (1.0f / 512.0f) + 1e-6f);
    }
  }
}

struct EpiStore {
  static constexpr int KIND = 0;
  bf16_t* out; int ld; int ostride; const float* rs;
  __device__ __forceinline__ void c4(int g, int rig, int col, f32x4 v) const {
    const size_t row = (size_t)g * ostride + rig;
    const float s = rs ? rs[row] : 1.f;
    uint2 u; u.x = pack2(v[0] * s, v[1] * s); u.y = pack2(v[2] * s, v[3] * s);
    *(uint2*)(out + row * ld + col) = u;
  }
};
struct EpiVt {
  static constexpr int KIND = 1;
  bf16_t* out; const float* rs;
  __device__ __forceinline__ void r4(int g, int rig, int col, f32x4 v) const {
    const size_t row = (size_t)g * 2304 + rig;
    const f32x4 s = *(const f32x4*)(rs + row);
    uint2 u; u.x = pack2(v[0] * s[0], v[1] * s[1]); u.y = pack2(v[2] * s[2], v[3] * s[3]);
    *(uint2*)(out + ((size_t)g * 1024 + col) * 2304 + rig) = u;
  }
};
struct EpiFilt {
  static constexpr int KIND = 1;
  bf16_t* Rf; const float* decay;
  __device__ __forceinline__ void r4(int g, int rig, int col, f32x4 v) const {
    const int c = col & 1023; const bool bwd = col >= 1024;
    const float dec = fabsf(decay[c]);
    bf16_t* rp = Rf + (size_t)c * 4096;
#pragma unroll
    for (int j = 0; j < 4; ++j) {
      const int t = rig + j;
      const float val = v[j] * __expf(-(float)t * (1.0f / 2047.0f) * dec);
      if (!bwd) rp[2048 - t] = f2bf(val);
      else if (t > 0) rp[2048 + t] = f2bf(val);
      else rp[0] = 0;
    }
  }
};
struct EpiResid {
  static constexpr int KIND = 0;
  float* X; const float* base; const float* gate; const float* bias;
  __device__ __forceinline__ void c4(int g, int rig, int col, f32x4 v) const {
    const size_t o = ((size_t)g * 2048 + rig) * 1024 + col;
    const f32x4 bs = *(const f32x4*)(base + o);
    const f32x4 gt = *(const f32x4*)(gate + (size_t)g * 6144 + col);
    f32x4 bi = {0.f, 0.f, 0.f, 0.f};
    if (bias) bi = *(const f32x4*)(bias + col);
    f32x4 r;
#pragma unroll
    for (int j = 0; j < 4; ++j) r[j] = bs[j] + gt[j] * (v[j] + bi[j]);
    *(f32x4*)(X + o) = r;
  }
};
template <int MODE>
struct EpiConv {
  static constexpr int KIND = 2;
  const float* cw; const float* cb; int NC; const float* pre_bias;
  bf16_t* o0; bf16_t* o1;
  __device__ __forceinline__ int norig(int nt, int cl) const {
    if (MODE == 0) return (cl >> 6) * 2816 + nt * 64 + (cl & 63);
    if (nt < 8) return nt * 128 + cl;
    return 1024 + (cl >> 6) * 1024 + (nt - 8) * 64 + (cl & 63);
  }
  __device__ __forceinline__ void finish(const float* Z, int g, int rig0, int nt) const {
    const int tid = get_tid();
    if (MODE == 0 || nt < 8) {
      const int f = tid & 63, q = tid >> 6;
      const int p0 = 1 + 32 * q, p1 = (p0 + 32 < 127) ? p0 + 32 : 127;
      if (MODE == 0) {
        const int na = norig(nt, f), ng = norig(nt, 64 + f);
        const float a0 = cw[na], a1 = cw[NC + na], a2 = cw[2 * NC + na], ab = cb[na];
        const float g0 = cw[ng], g1 = cw[NC + ng], g2 = cw[2 * NC + ng], gb = cb[ng];
        float am = Z[(p0 - 1) * 132 + f], ac = Z[p0 * 132 + f], gm = Z[(p0 - 1) * 132 + 64 + f], gc = Z[p0 * 132 + 64 + f];
        for (int pl = p0; pl < p1; ++pl) {
          const float an = Z[(pl + 1) * 132 + f], gn = Z[(pl + 1) * 132 + 64 + f];
          const int pos = rig0 + pl;
          if (pos < 2048) {
            const float av = a0 * am + a1 * ac + a2 * an + ab;
            const float gv = g0 * gm + g1 * gc + g2 * gn + gb;
            o0[((size_t)g * 2048 + pos) * 2816 + nt * 64 + f] = f2bf(av * gv / (1.f + __expf(-gv)));
          }
          am = ac; ac = an; gm = gc; gc = gn;
        }
      } else {
#pragma unroll
        for (int fh = 0; fh < 2; ++fh) {
          const int cl = fh * 64 + f;
          const int na = norig(nt, cl);
          const float a0 = cw[na], a1 = cw[NC + na], a2 = cw[2 * NC + na], ab = cb[na];
          float am = Z[(p0 - 1) * 132 + cl], ac = Z[p0 * 132 + cl];
          for (int pl = p0; pl < p1; ++pl) {
            const float an = Z[(pl + 1) * 132 + cl];
            const int pos = rig0 + pl;
            if (pos < 2048) o0[((size_t)g * 2048 + pos) * 1024 + nt * 128 + cl] = f2bf(a0 * am + a1 * ac + a2 * an + ab);
            am = ac; ac = an;
          }
        }
      }
    } else {
      const int pl = tid & 127, fh = tid >> 7;
      const int pos = rig0 + pl;
      if (pl >= 1 && pl <= 126 && pos < 2048) {
        const int fb = nt - 8;
        for (int f = fh * 32; f < fh * 32 + 32; ++f) {
          const int na = norig(nt, f), nb = norig(nt, 64 + f);
          const float va = cw[na] * Z[(pl - 1) * 132 + f] + cw[NC + na] * Z[pl * 132 + f] + cw[2 * NC + na] * Z[(pl + 1) * 132 + f] + cb[na];
          const float vb = cw[nb] * Z[(pl - 1) * 132 + 64 + f] + cw[NC + nb] * Z[pl * 132 + 64 + f] + cw[2 * NC + nb] * Z[(pl + 1) * 132 + 64 + f] + cb[nb];
          o1[(size_t)(fb * 64 + f) * 16384 + g * 2048 + pos] = f2bf(va * vb);
        }
      }
    }
  }
};

#define GLDS16(gp, lp) __builtin_amdgcn_global_load_lds((const unsigned*)(gp), (__attribute__((address_space(3))) unsigned*)(lp), 16, 0, 0)

template <bool SWAP, class Epi>
__device__ __forceinline__ void gemm_job(char* smem, const bf16_t* __restrict__ A, int lda, const bf16_t* __restrict__ Bt, int K, int N,
                                         int tpg, int a_gstride, int a_goff, int step, int halo, int grows, int MT, int voff, int vid0, int grid, const Epi& epi) {
  const int tid = get_tid(), lane = tid & 63, wid = tid >> 6, wr = wid >> 1, wc = wid & 1, fr = lane & 15, fq = lane >> 4;
  const int NT = (N + 127) >> 7, ntiles = MT * NT, nk = K >> 5;
  int v = vid0;
  if (v < voff) v += ((voff - v + grid - 1) / grid) * grid;
  const int rdoff = ((fq ^ ((fr >> 2) & 3)) << 4);
  for (; v < voff + ntiles; v += grid) {
    const int w = v - voff;
    const int sr = w / (8 * NT), rem = w - sr * 8 * NT;
    const int nt = rem >> 3, mt = sr * 8 + (rem & 7);
    const int g = mt / tpg, ti = mt - g * tpg;
    const int rig0 = ti * step - halo;
    const bf16_t* ap[2]; const bf16_t* bp[2];
#pragma unroll
    for (int i = 0; i < 2; ++i) {
      const int b = tid * 16 + i * 4096;
      const int r = b >> 6;
      const int cs = (b & 63) >> 4;
      const int c = ((cs ^ ((r >> 2) & 3)) << 3);
      int rig = rig0 + r; rig = rig < 0 ? 0 : (rig > grows - 1 ? grows - 1 : rig);
      ap[i] = A + (size_t)(g * a_gstride + a_goff + rig) * lda + c;
      int br = nt * 128 + r; br = br > N - 1 ? N - 1 : br;
      bp[i] = Bt + (size_t)br * K + c;
    }
    f32x4 acc[4][4];
#pragma unroll
    for (int m = 0; m < 4; ++m)
#pragma unroll
      for (int n = 0; n < 4; ++n) acc[m][n] = (f32x4){0.f, 0.f, 0.f, 0.f};
#pragma unroll
    for (int i = 0; i < 2; ++i) { GLDS16(ap[i], smem + tid * 16 + i * 4096); GLDS16(bp[i], smem + 8192 + tid * 16 + i * 4096); }
    for (int t = 0; t < nk; ++t) {
      asm volatile("s_waitcnt vmcnt(0)" ::: "memory");
      __syncthreads();
      if (t + 1 < nk) {
        char* nb = smem + ((t + 1) & 1) * 16384;
        const int ko = (t + 1) * 32;
#pragma unroll
        for (int i = 0; i < 2; ++i) { GLDS16(ap[i] + ko, nb + tid * 16 + i * 4096); GLDS16(bp[i] + ko, nb + 8192 + tid * 16 + i * 4096); }
      }
      const char* sa = smem + (t & 1) * 16384; const char* sb = sa + 8192;
      bf16x8 af[4], bf[4];
#pragma unroll
      for (int m = 0; m < 4; ++m) af[m] = *(const bf16x8*)(sa + (wr * 64 + m * 16 + fr) * 64 + rdoff);
#pragma unroll
      for (int n = 0; n < 4; ++n) bf[n] = *(const bf16x8*)(sb + (wc * 64 + n * 16 + fr) * 64 + rdoff);
#pragma unroll
      for (int m = 0; m < 4; ++m)
#pragma unroll
        for (int n = 0; n < 4; ++n)
          acc[m][n] = SWAP ? __builtin_amdgcn_mfma_f32_16x16x32_bf16(bf[n], af[m], acc[m][n], 0, 0, 0)
                           : __builtin_amdgcn_mfma_f32_16x16x32_bf16(af[m], bf[n], acc[m][n], 0, 0, 0);
    }
    __syncthreads();
    if constexpr (Epi::KIND == 0) {
#pragma unroll
      for (int m = 0; m < 4; ++m) {
        const int rig = rig0 + wr * 64 + m * 16 + fr;
#pragma unroll
        for (int n = 0; n < 4; ++n) {
          const int col = nt * 128 + wc * 64 + n * 16 + fq * 4;
          if (col < N) epi.c4(g, rig, col, acc[m][n]);
        }
      }
    } else if constexpr (Epi::KIND == 1) {
#pragma unroll
      for (int m = 0; m < 4; ++m) {
        const int rig = rig0 + wr * 64 + m * 16 + fq * 4;
#pragma unroll
        for (int n = 0; n < 4; ++n) {
          const int col = nt * 128 + wc * 64 + n * 16 + fr;
          if (col < N) epi.r4(g, rig, col, acc[m][n]);
        }
      }
    } else {
      float* Z = (float*)smem;
#pragma unroll
      for (int m = 0; m < 4; ++m) {
        const int rl = wr * 64 + m * 16 + fr;
        const int pos = rig0 + rl;
        const bool ok = pos >= 0 && pos < grows;
#pragma unroll
        for (int n = 0; n < 4; ++n) {
          const int cl = wc * 64 + n * 16 + fq * 4;
          f32x4 vv = acc[m][n];
          if (epi.pre_bias) {
#pragma unroll
            for (int j = 0; j < 4; ++j) vv[j] += epi.pre_bias[epi.norig(nt, cl + j)];
          }
          if (!ok) vv = (f32x4){0.f, 0.f, 0.f, 0.f};
          *(f32x4*)(Z + rl * 132 + cl) = vv;
        }
      }
      __syncthreads();
      epi.finish(Z, g, rig0, nt);
      __syncthreads();
    }
  }
}

__device__ __forceinline__ void phase_attn(CP& p, char* smem, int vid0, int grid) {
  bf16_t* Ks = (bf16_t*)smem;
  bf16_t* Vs = (bf16_t*)(smem + 64 * 104 * 2);
  const int tid = get_tid(), lane = tid & 63, w = tid >> 6, r = lane & 31, hh = lane >> 5;
  const float cs = 1.4426950408889634f * 0.10206207261596577f;
  for (int it = vid0; it < 2048; it += grid) {
    const int qt = it & 15, h = (it >> 4) & 15, b = it >> 8;
    const int t = qt * 128 + w * 32 + r;
    const size_t xrow = (size_t)b * 2048 + t;
    const bf16_t* qp = p.Q + xrow * 1536 + h * 96;
    bf16x8 qf[6];
#pragma unroll
    for (int kk = 0; kk < 4; ++kk) qf[kk] = *(const bf16x8*)(qp + 16 * kk + 8 * hh);
#pragma unroll
    for (int part = 0; part < 2; ++part) {
      const bf16_t* pp = qp + 64 + 16 * part;
      const bf16x8 mine = *(const bf16x8*)(pp + 8 * hh), oth = *(const bf16x8*)(pp + 8 * (1 - hh));
      const float posf = part == 0 ? (float)(t >> 6) : (float)(t & 63);
      bf16x8 o;
#pragma unroll
      for (int j = 0; j < 8; ++j) {
        const float inv = exp2f(-(float)j * (13.287712379549449f / 8.0f));
        const float ang = posf * inv;
        const float c = __cosf(ang), s = __sinf(ang);
        const float m = bf2f((bf16_t)mine[j]), ov = bf2f((bf16_t)oth[j]);
        o[j] = (short)f2bf(m * c + (hh ? ov : -ov) * s);
      }
      qf[4 + part] = o;
    }
    f32x16 oacc[2];
#pragma unroll
    for (int i = 0; i < 16; ++i) { oacc[0][i] = 0.f; oacc[1][i] = 0.f; }
    float mrun = -INFINITY, lrun = 0.f;
    const size_t kvrow0 = (size_t)b * 2304;
    const bf16_t* kn_base = p.Kn + kvrow0 * 1024 + h * 64;
    const bf16_t* kpe_base = p.kpe + kvrow0 * 32;
    const bf16_t* vt_base = p.Vt + ((size_t)(b * 16 + h) * 64) * 2304;
    uint4 rk[2], rp, rv[2];
    auto gload = [&](int kt) {
#pragma unroll
      for (int i = 0; i < 2; ++i) {
        const int ci = tid + 256 * i; const int row = ci >> 3, ch = ci & 7;
        rk[i] = *(const uint4*)(kn_base + (size_t)(kt * 64 + row) * 1024 + ch * 8);
        rv[i] = *(const uint4*)(vt_base + (size_t)row * 2304 + kt * 64 + ch * 8);
      }
      rp = *(const uint4*)(kpe_base + (size_t)(kt * 64 + (tid >> 2)) * 32 + (tid & 3) * 8);
    };
    gload(0);
    for (int kt = 0; kt < 36; ++kt) {
      __syncthreads();
#pragma unroll
      for (int i = 0; i < 2; ++i) {
        const int ci = tid + 256 * i; const int row = ci >> 3, ch = ci & 7;
        *(uint4*)(Ks + row * 104 + ch * 8) = rk[i];
        uint2 lo; lo.x = rv[i].x; lo.y = rv[i].y; uint2 hi; hi.x = rv[i].z; hi.y = rv[i].w;
        *(uint2*)(Vs + row * 68 + ch * 8) = lo;
        *(uint2*)(Vs + row * 68 + ch * 8 + 4) = hi;
      }
      *(uint4*)(Ks + (tid >> 2) * 104 + 64 + (tid & 3) * 8) = rp;
      __syncthreads();
      if (kt + 1 < 36) gload(kt + 1);
      f32x16 s[2];
#pragma unroll
      for (int t2 = 0; t2 < 2; ++t2) {
#pragma unroll
        for (int i = 0; i < 16; ++i) s[t2][i] = 0.f;
#pragma unroll
        for (int kk = 0; kk < 6; ++kk) {
          const bf16x8 a = *(const bf16x8*)(Ks + (32 * t2 + r) * 104 + 16 * kk + 8 * hh);
          s[t2] = __builtin_amdgcn_mfma_f32_32x32x16_bf16(a, qf[kk], s[t2], 0, 0, 0);
        }
      }
      float mx = s[0][0];
#pragma unroll
      for (int i = 1; i < 16; ++i) mx = fmaxf(mx, s[0][i]);
#pragma unroll
      for (int i = 0; i < 16; ++i) mx = fmaxf(mx, s[1][i]);
      mx = fmaxf(mx, __shfl_xor(mx, 32));
      const float mnew = fmaxf(mrun, mx * cs);
      const float alpha = __builtin_amdgcn_exp2f(mrun - mnew);
      mrun = mnew;
      float psum = 0.f;
      bf16x8 pf[4];
#pragma unroll
      for (int t2 = 0; t2 < 2; ++t2)
#pragma unroll
        for (int i = 0; i < 16; ++i) {
          const float pv = __builtin_amdgcn_exp2f(s[t2][i] * cs - mnew);
          psum += pv;
          pf[t2 * 2 + (i >> 3)][i & 7] = (short)f2bf(pv);
        }
      lrun = lrun * alpha + psum;
#pragma unroll
      for (int i = 0; i < 16; ++i) { oacc[0][i] *= alpha; oacc[1][i] *= alpha; }
#pragma unroll
      for (int dt = 0; dt < 2; ++dt)
#pragma unroll
        for (int s4 = 0; s4 < 4; ++s4) {
          const bf16_t* vp = Vs + (32 * dt + r) * 68 + 16 * s4 + 4 * hh;
          const uint2 lo = *(const uint2*)vp, hi = *(const uint2*)(vp + 8);
          union { uint4 u; bf16x8 v; } cv; cv.u.x = lo.x; cv.u.y = lo.y; cv.u.z = hi.x; cv.u.w = hi.y;
          oacc[dt] = __builtin_amdgcn_mfma_f32_32x32x16_bf16(cv.v, pf[s4], oacc[dt], 0, 0, 0);
        }
    }
    const float ltot = lrun + __shfl_xor(lrun, 32);
    const float inv = 1.f / ltot;
    bf16_t* op = p.hxc + xrow * 1024 + h * 64;
#pragma unroll
    for (int dt = 0; dt < 2; ++dt)
#pragma unroll
      for (int i4 = 0; i4 < 4; ++i4) {
        const int d = 32 * dt + 8 * i4 + 4 * hh;
        uint2 u; u.x = pack2(oacc[dt][4 * i4] * inv, oacc[dt][4 * i4 + 1] * inv); u.y = pack2(oacc[dt][4 * i4 + 2] * inv, oacc[dt][4 * i4 + 3] * inv);
        *(uint2*)(op + d) = u;
      }
  }
}

__device__ __forceinline__ void phase_hyconv(CP& p, char* smem) {
  bf16_t* cp = (bf16_t*)smem;
  bf16_t* Vl = (bf16_t*)(smem + 4 * 8208);
  const int tid = get_tid(), lane = tid & 63, w = tid >> 6, i16 = lane & 15, g4 = lane >> 4;
  const int si = (-i16) & 3;
  const int ocb = 64 * w;
  for (int c = get_bid(); c < 1024; c += gridDim.x) {
    __syncthreads();
#pragma unroll
    for (int i = 0; i < 2; ++i) { const int ch = tid + 256 * i; *(uint4*)(cp + ch * 8) = *(const uint4*)(p.Rf + (size_t)c * 4096 + ch * 8); }
#pragma unroll
    for (int i = 0; i < 8; ++i) {
      const int q = tid + 256 * i; const int b = q >> 8, l8 = q & 255; const int m1 = l8 >> 3, m2 = (l8 & 7) * 8;
      *(uint4*)(Vl + (8 + m1 * 8 + b) * 72 + m2) = *(const uint4*)(p.vvT + (size_t)c * 16384 + b * 2048 + l8 * 8);
    }
    if (tid < 144) {
      const int colp = tid / 9, part = tid - colp * 9;
      const int col = colp < 8 ? colp : 256 + colp;
      uint4 zz; zz.x = 0; zz.y = 0; zz.z = 0; zz.w = 0;
      *(uint4*)(Vl + col * 72 + part * 8) = zz;
    }
    __syncthreads();
#pragma unroll
    for (int s = 1; s < 4; ++s)
#pragma unroll
      for (int i = 0; i < 2; ++i) {
        const int ch = tid + 256 * i;
        unsigned e[8];
#pragma unroll
        for (int j = 0; j < 8; ++j) { const int idx = 8 * ch + s + j; e[j] = idx < 4096 ? (unsigned)cp[idx] : 0u; }
        uint4 u; u.x = e[0] | (e[1] << 16); u.y = e[2] | (e[3] << 16); u.z = e[4] | (e[5] << 16); u.w = e[6] | (e[7] << 16);
        *(uint4*)(cp + s * 4104 + 8 * ch) = u;
      }
    __syncthreads();
    const bf16_t* abase = cp + si * 4104 + (2048 - i16 - si + 8 * g4);
    f32x4 acc[4][4];
#pragma unroll
    for (int m = 0; m < 4; ++m)
#pragma unroll
      for (int n = 0; n < 4; ++n) acc[m][n] = (f32x4){0.f, 0.f, 0.f, 0.f};
    for (int dl = -31; dl <= 31; ++dl) {
      bf16x8 af[4][2];
#pragma unroll
      for (int mt = 0; mt < 4; ++mt)
#pragma unroll
        for (int kk = 0; kk < 2; ++kk) {
          const bf16_t* ap = abase - 64 * dl - 16 * mt + 32 * kk;
          const uint2 lo = *(const uint2*)ap, hi = *(const uint2*)(ap + 4);
          union { uint4 u; bf16x8 v; } cv; cv.u.x = lo.x; cv.u.y = lo.y; cv.u.z = hi.x; cv.u.w = hi.y;
          af[mt][kk] = cv.v;
        }
#pragma unroll
      for (int jt = 0; jt < 4; ++jt) {
        const int in0 = ocb + 16 * jt - 8 * dl;
        if (in0 >= -8 && in0 <= 248) {
          const bf16_t* bp = Vl + (in0 + 8 + i16) * 72 + 8 * g4;
          const bf16x8 b0 = *(const bf16x8*)bp, b1 = *(const bf16x8*)(bp + 32);
#pragma unroll
          for (int mt = 0; mt < 4; ++mt) {
            acc[mt][jt] = __builtin_amdgcn_mfma_f32_16x16x32_bf16(af[mt][0], b0, acc[mt][jt], 0, 0, 0);
            acc[mt][jt] = __builtin_amdgcn_mfma_f32_16x16x32_bf16(af[mt][1], b1, acc[mt][jt], 0, 0, 0);
          }
        }
      }
    }
    const float db = p.hy_d_bias[c];
#pragma unroll
    for (int mt = 0; mt < 4; ++mt)
#pragma unroll
      for (int jt = 0; jt < 4; ++jt) {
        const int col = ocb + 16 * jt + i16;
        const int n1 = col >> 3, b = col & 7;
        const int n2 = 16 * mt + 4 * g4;
        const uint2 vv = *(const uint2*)(Vl + (col + 8) * 72 + n2);
        const float y0 = acc[mt][jt][0] + bf2f((bf16_t)(vv.x & 0xffff)) * db;
        const float y1 = acc[mt][jt][1] + bf2f((bf16_t)(vv.x >> 16)) * db;
        const float y2 = acc[mt][jt][2] + bf2f((bf16_t)(vv.y & 0xffff)) * db;
        const float y3 = acc[mt][jt][3] + bf2f((bf16_t)(vv.y >> 16)) * db;
        uint2 u; u.x = pack2(y0, y1); u.y = pack2(y2, y3);
        *(uint2*)(p.Yp + (size_t)c * 16384 + b * 2048 + n1 * 64 + n2) = u;
      }
  }
}

__device__ __forceinline__ void phase_transmul(CP& p, char* smem) {
  bf16_t* tl = (bf16_t*)smem;
  const int tid = get_tid();
  for (int it = get_bid(); it < 4096; it += gridDim.x) {
    const int ct = it & 15, rt = it >> 4;
    const int c0 = ct * 64, r0 = rt * 64;
    __syncthreads();
#pragma unroll
    for (int i = 0; i < 2; ++i) {
      const int ci = tid + 256 * i; const int cc = ci >> 3, ch = ci & 7;
      const uint4 u = *(const uint4*)(p.Yp + (size_t)(c0 + cc) * 16384 + r0 + ch * 8);
      unsigned* d = (unsigned*)(tl + cc * 66 + ch * 8);
      d[0] = u.x; d[1] = u.y; d[2] = u.z; d[3] = u.w;
    }
    __syncthreads();
    const int row = tid >> 2, cq = tid & 3;
    const bf16_t* xp = p.x1h + (size_t)(r0 + row) * 1024 + c0 + cq * 16;
    const uint4 xa = *(const uint4*)xp, xb = *(const uint4*)(xp + 8);
    const unsigned xs[8] = {xa.x, xa.y, xa.z, xa.w, xb.x, xb.y, xb.z, xb.w};
    unsigned o[8];
#pragma unroll
    for (int j = 0; j < 8; ++j) {
      const float y0 = bf2f(tl[(cq * 16 + 2 * j) * 66 + row]) * bf2f((bf16_t)(xs[j] & 0xffff));
      const float y1 = bf2f(tl[(cq * 16 + 2 * j + 1) * 66 + row]) * bf2f((bf16_t)(xs[j] >> 16));
      o[j] = pack2(y0, y1);
    }
    bf16_t* op = p.hxc + (size_t)(r0 + row) * 1024 + c0 + cq * 16;
    uint4 oa; oa.x = o[0]; oa.y = o[1]; oa.z = o[2]; oa.w = o[3];
    uint4 ob; ob.x = o[4]; ob.y = o[5]; ob.z = o[6]; ob.w = o[7];
    *(uint4*)op = oa; *(uint4*)(op + 8) = ob;
  }
}

__global__ void __launch_bounds__(256, 2) mega(P p_arg) {
  __shared__ __attribute__((aligned(16))) char smem[LDS_BYTES];
  cg::grid_group grid = cg::this_grid();
  const int G = gridDim.x;
  CP* pp = (CP*)__builtin_amdgcn_kernarg_segment_ptr();
  const int ph0 = pp->ph0, ph1 = pp->ph1;
  volatile LAS unsigned* xst = (volatile LAS unsigned*)(smem + LDS_BYTES - 16);
  if (threadIdx.x == 0) { xst[0] = 0u; xst[1] = 0u; }
  __syncthreads();
  const XcdBarrier xb = xcd_barrier_post(pp->bar, xst);
  for (int ph = ph0; ph < ph1; ++ph) {
    asm volatile("" : "+s"(pp));
    CP& p = *pp;
    const int bid = get_bid();
    const int vid0 = (G & 7) ? bid : ((bid & 7) * (G >> 3) + (bid >> 3));
    const float* mv0 = p.modv; const float* mv1 = p.modv + (size_t)9 * 6144;
    switch (ph) {
      case 0: phase_prep(p, smem); break;
      case 1: phase_normmod_kv(p); break;
      case 2: {
        EpiStore e1{p.cq, 512, 2048, nullptr};
        gemm_job<true>(smem, p.hxc, 1024, p.wt_dq, 1024, 512, 16, 2304, 256, 128, 0, 2048, 128, 0, vid0, G, e1);
        EpiStore e2{p.kv, 288, 2304, nullptr};
        gemm_job<true>(smem, p.hxc, 1024, p.wt_dkv, 1024, 288, 18, 2304, 0, 128, 0, 2304, 144, 128 * 4, vid0, G, e2);
        EpiFilt e3{p.Rf, p.hy_decay};
        gemm_job<false>(smem, p.h2bf, 64, p.wt_f3, 64, 2048, 16, 0, 0, 128, 0, 2048, 16, 128 * 4 + 144 * 3, vid0, G, e3);
      } break;
      case 3: phase_rowstat(p); break;
      case 4: {
        EpiStore e1{p.Q, 1536, 2048, p.rq};
        gemm_job<true>(smem, p.cq, 512, p.wt_uq, 512, 1536, 16, 2048, 0, 128, 0, 2048, 128, 0, vid0, G, e1);
        EpiStore e2{p.Kn, 1024, 2304, p.rkv};
        gemm_job<true>(smem, p.kv, 288, p.wt_uk, 256, 1024, 18, 2304, 0, 128, 0, 2304, 144, 128 * 12, vid0, G, e2);
        EpiVt e3{p.Vt, p.rkv};
        gemm_job<false>(smem, p.kv, 288, p.wt_uv, 256, 1024, 18, 2304, 0, 128, 0, 2304, 144, 128 * 12 + 144 * 8, vid0, G, e3);
      } break;
      case 5: phase_attn(p, smem, vid0, G); break;
      case 6: {
        EpiResid e{p.X, p.x, mv0 + 2 * 1024, nullptr};
        gemm_job<true>(smem, p.hxc, 1024, p.wt_o, 1024, 1024, 16, 2048, 0, 128, 0, 2048, 128, 0, vid0, G, e);
      } break;
      case 7: phase_normmod_x(p, p.norm_ffn_g, 0, 3); break;
      case 8: {
        EpiConv<0> e{p.ffn_conv_w, p.ffn_conv_b, 5632, nullptr, p.act, nullptr};
        gemm_job<true>(smem, p.hxc, 1024, p.wt_up0, 1024, 5632, 17, 2048, 0, 126, 1, 2048, 136, 0, vid0, G, e);
      } break;
      case 9: {
        EpiResid e{p.X, p.X, mv0 + 5 * 1024, nullptr};
        gemm_job<true>(smem, p.act, 2816, p.wt_dn0, 2816, 1024, 16, 2048, 0, 128, 0, 2048, 128, 0, vid0, G, e);
      } break;
      case 10: phase_normmod_x(p, p.norm_mix_g + 1024, 1, 0); break;
      case 11: {
        EpiConv<1> e{p.hy_conv_w, p.hy_conv_b, 3072, p.hy_b_in, p.x1h, p.vvT};
        gemm_job<true>(smem, p.hxc, 1024, p.wt_hin, 1024, 3072, 17, 2048, 0, 126, 1, 2048, 136, 0, vid0, G, e);
      } break;
      case 12: phase_hyconv(p, smem); break;
      case 13: phase_transmul(p, smem); break;
      case 14: {
        EpiResid e{p.X, p.X, mv1 + 2 * 1024, p.hy_b_out};
        gemm_job<true>(smem, p.hxc, 1024, p.wt_hout, 1024, 1024, 16, 2048, 0, 128, 0, 2048, 128, 0, vid0, G, e);
      } break;
      case 15: phase_normmod_x(p, p.norm_ffn_g + 1024, 1, 3); break;
      case 16: {
        EpiConv<0> e{p.ffn_conv_w + (size_t)3 * 5632, p.ffn_conv_b + 5632, 5632, nullptr, p.act, nullptr};
        gemm_job<true>(smem, p.hxc, 1024, p.wt_up1, 1024, 5632, 17, 2048, 0, 126, 1, 2048, 136, 0, vid0, G, e);
      } break;
      case 17: {
        EpiResid e{p.X, p.X, mv1 + 5 * 1024, nullptr};
        gemm_job<true>(smem, p.act, 2816, p.wt_dn1, 2816, 1024, 16, 2048, 0, 128, 0, 2048, 128, 0, vid0, G, e);
      } break;
      default: phase_final_norm(p); break;
    }
    if (ph + 1 < ph1) { if (ph1 > 1000) grid.sync(); else xcd_barrier(xb); }
  }
}

extern "C" void kernel_launch(void* const* d_in, const int* in_sizes, int n_in, void* d_out, int out_size, void* d_ws, size_t ws_size, hipStream_t stream) {
  static int grid_blocks = 0;
  if (!grid_blocks) {
    int dev = 0, cus = 0, per_cu = 0;
    hipGetDevice(&dev);
    hipDeviceGetAttribute(&cus, hipDeviceAttributeMultiprocessorCount, dev);
    hipOccupancyMaxActiveBlocksPerMultiprocessor(&per_cu, (const void*)mega, 256, 0);
    if (per_cu < 1) per_cu = 1;
    if (per_cu > 2) per_cu = 2;
    grid_blocks = cus * per_cu;
  }
  P p{};
  const float** in = (const float**)&p;
  for (int i = 0; i < 36; ++i) in[i] = (const float*)d_in[i];
  p.X = (float*)d_out;
  char* ws = (char*)d_ws; size_t off = 0;
  auto take = [&](size_t bytes) { char* r = ws + off; off += (bytes + 255) & ~(size_t)255; return r; };
  p.wt_dq = (bf16_t*)take((size_t)512 * 1024 * 2);
  p.wt_dkv = (bf16_t*)take((size_t)288 * 1024 * 2);
  p.wt_uq = (bf16_t*)take((size_t)1536 * 512 * 2);
  p.wt_uk = (bf16_t*)take((size_t)1024 * 256 * 2);
  p.wt_uv = (bf16_t*)take((size_t)1024 * 256 * 2);
  p.wt_o = (bf16_t*)take((size_t)1024 * 1024 * 2);
  p.wt_hin = (bf16_t*)take((size_t)3072 * 1024 * 2);
  p.wt_hout = (bf16_t*)take((size_t)1024 * 1024 * 2);
  p.wt_up0 = (bf16_t*)take((size_t)5632 * 1024 * 2);
  p.wt_up1 = (bf16_t*)take((size_t)5632 * 1024 * 2);
  p.wt_dn0 = (bf16_t*)take((size_t)1024 * 2816 * 2);
  p.wt_dn1 = (bf16_t*)take((size_t)1024 * 2816 * 2);
  p.modv = (float*)take((size_t)2 * 9 * 6144 * 4);
  p.rq = (float*)take((size_t)16384 * 4);
  p.rkv = (float*)take((size_t)18432 * 4);
  p.modp = (float*)take((size_t)4 * 110592 * 4);
  p.bar = (unsigned*)take((size_t)XCD_BAR_WORDS * 4);
  p.wt_f3 = (bf16_t*)take((size_t)2048 * 64 * 2);
  p.h2bf = (bf16_t*)take((size_t)2048 * 64 * 2);
  p.Rf = (bf16_t*)take((size_t)1024 * 4096 * 2);
  p.kpe = (bf16_t*)take((size_t)18432 * 32 * 2);
  p.hxc = (bf16_t*)take((size_t)18432 * 1024 * 2);
  const size_t ubase = off;
  p.cq = (bf16_t*)take((size_t)16384 * 512 * 2);
  p.kv = (bf16_t*)take((size_t)18432 * 288 * 2);
  p.Q = (bf16_t*)take((size_t)16384 * 1536 * 2);
  p.Kn = (bf16_t*)take((size_t)18432 * 1024 * 2);
  p.Vt = (bf16_t*)take((size_t)18432 * 1024 * 2);
  const size_t uend1 = off;
  off = ubase;
  p.act = (bf16_t*)take((size_t)16384 * 2816 * 2);
  off = ubase;
  p.x1h = (bf16_t*)take((size_t)16384 * 1024 * 2);
  p.vvT = (bf16_t*)take((size_t)16384 * 1024 * 2);
  p.Yp = (bf16_t*)take((size_t)16384 * 1024 * 2);
  if (uend1 > ws_size) { fprintf(stderr, "workspace too small: need %zu have %zu\n", uend1, ws_size); return; }
  p.ph0 = 0; p.ph1 = NPHASE;
  if (hipMemsetAsync(p.bar, 0, (size_t)XCD_BAR_WORDS * 4, stream) != hipSuccess) { fprintf(stderr, "memset failed\n"); return; }
  void* args[] = {&p};
  hipError_t e = hipLaunchCooperativeKernel((const void*)mega, dim3(grid_blocks), dim3(256), args, 0, stream);
  if (e != hipSuccess) fprintf(stderr, "cooperative launch failed: %s (grid %d)\n", hipGetErrorString(e), grid_blocks);
}
```

```cpp
#include <hip/hip_runtime.h>
#include <hip/hip_cooperative_groups.h>
#include <cstdio>
namespace cg = cooperative_groups;

typedef unsigned short bf16_t;
typedef short bf16x8 __attribute__((ext_vector_type(8)));
typedef float f32x4 __attribute__((ext_vector_type(4)));
typedef float f32x16 __attribute__((ext_vector_type(16)));

#define LDS_BYTES 73792
#define NPHASE 19

struct P {
  const float *x, *c, *ctx, *c_ctx, *mod_w, *mod_b, *norm_mix_g, *norm_ffn_g;
  const float *w_dq, *g_q, *w_uq, *w_dkv, *g_kv, *w_uk, *w_uv, *w_o;
  const float *hy_w_in, *hy_b_in, *hy_conv_w, *hy_conv_b, *f_w1, *f_b1, *f_freq1, *f_w2, *f_b2, *f_freq2, *f_w3, *hy_decay, *hy_d_bias, *hy_w_out, *hy_b_out;
  const float *ffn_w_up, *ffn_conv_w, *ffn_conv_b, *ffn_w_down, *final_g;
  float* X;
  bf16_t *wt_dq, *wt_dkv, *wt_uq, *wt_uk, *wt_uv, *wt_o, *wt_hin, *wt_hout, *wt_up0, *wt_up1, *wt_dn0, *wt_dn1;
  float *modv, *rq, *rkv, *modp;
  unsigned* bar;
  bf16_t *wt_f3, *h2bf;
  bf16_t *Rf, *kpe, *hxc, *cq, *kv, *Q, *Kn, *Vt, *act, *x1h, *vvT, *Yp;
  int ph0, ph1;
};

typedef const __attribute__((address_space(4))) P CP;
__device__ __forceinline__ int get_tid() { int t = threadIdx.x; asm volatile("" : "+v"(t)); return t; }
__device__ __forceinline__ int get_bid() { int t = blockIdx.x; asm volatile("" : "+s"(t)); return t; }

__device__ __forceinline__ bf16_t f2bf(float f) { unsigned u = __float_as_uint(f); u += 0x7fffu + ((u >> 16) & 1u); return (bf16_t)(u >> 16); }
__device__ __forceinline__ float bf2f(bf16_t h) { return __uint_as_float(((unsigned)h) << 16); }
__device__ __forceinline__ unsigned pack2(float a, float b) { return (unsigned)f2bf(a) | ((unsigned)f2bf(b) << 16); }
__device__ __forceinline__ float wave_sum(float v) {
#pragma unroll
  for (int o = 32; o; o >>= 1) v += __shfl_xor(v, o);
  return v;
}


#define XB_TMO      128
#define XB_XCNT(j)  (256  + 64 * (j))
#define XB_XSUB(j)  (1280 + 64 * (j))
#define XB_XGEN(j)  (2304 + 64 * (j))
#define XB_TOP      3328
#define XB_TOPGEN   3392
#define XCD_BAR_WORDS 3456
#define XB_SPIN_CAP (1u << 18)
#define LAS __attribute__((address_space(3)))
__device__ __forceinline__ unsigned xb_ld(unsigned* p)              { return __hip_atomic_load(p, __ATOMIC_RELAXED, __HIP_MEMORY_SCOPE_AGENT); }
__device__ __forceinline__ unsigned xb_add(unsigned* p, unsigned v) { return __hip_atomic_fetch_add(p, v, __ATOMIC_RELAXED, __HIP_MEMORY_SCOPE_AGENT); }
__device__ __forceinline__ unsigned xb_xcc_id() { return (unsigned)__builtin_amdgcn_s_getreg((3 << 11) | 20) & 0xFu; }
#define XB_SPIN(cond, bar) do { unsigned _sp = 0; while (cond) { __builtin_amdgcn_s_sleep(1); \
    if ((++_sp & 255u) == 0u) { if (xb_ld(&(bar)[XB_TMO])) break; if (_sp > XB_SPIN_CAP) { atomicAdd(&(bar)[XB_TMO], 1u); break; } } } } while (0)
struct XcdBarrier { unsigned* bar; unsigned x; volatile LAS unsigned* st; };
__device__ __forceinline__ XcdBarrier xcd_barrier_post(unsigned* bar, volatile LAS unsigned* st) {
    XcdBarrier b; b.bar = bar; b.x = xb_xcc_id(); b.st = st;
    if (threadIdx.x == 0) (void)xb_add(&bar[XB_XCNT(b.x)], 1u);
    return b;
}
__device__ __forceinline__ void xcd_barrier_complete(unsigned* bar, unsigned x, unsigned& nloc, unsigned& nx) {
    const unsigned G = gridDim.x * gridDim.y * gridDim.z;
    unsigned sum, cnt, mine, sp = 0u;
    for (;;) {
        sum = 0u; cnt = 0u; mine = 0u;
#pragma unroll
        for (unsigned j = 0; j < 16; ++j) { const unsigned c = xb_ld(&bar[XB_XCNT(j)]); sum += c; cnt += (c > 0u) ? 1u : 0u; mine = (j == x) ? c : mine; }
        if (sum == G) break;
        __builtin_amdgcn_s_sleep(1);
        if ((++sp & 255u) == 0u) { if (xb_ld(&bar[XB_TMO])) break; if (sp > XB_SPIN_CAP) { atomicAdd(&bar[XB_TMO], 1u); break; } }
    }
    nloc = mine > 0u ? mine : 1u; nx = cnt > 0u ? cnt : 1u;
}
__device__ __forceinline__ void xcd_barrier(const XcdBarrier& b) {
    asm volatile("s_waitcnt vmcnt(0)" ::: "memory");
    __syncthreads();
    if (threadIdx.x == 0) {
        unsigned* bar = b.bar;
        __builtin_amdgcn_s_waitcnt(0);
        unsigned nloc = b.st[0], nx = b.st[1];
        if (nloc == 0u) { xcd_barrier_complete(bar, b.x, nloc, nx); b.st[0] = nloc; b.st[1] = nx; }
        const unsigned old = xb_add(&bar[XB_XSUB(b.x)], 1u);
        const unsigned gen = old / nloc;
        if (old + 1u == (gen + 1u) * nloc) {
            __builtin_amdgcn_fence(__ATOMIC_RELEASE, "agent");
            asm volatile("s_waitcnt vmcnt(0)" ::: "memory");
            const unsigned og = xb_add(&bar[XB_TOP], 1u);
            const unsigned tg = og / nx;
            if (og + 1u == (tg + 1u) * nx) xb_add(&bar[XB_TOPGEN], 1u);
            else XB_SPIN(xb_ld(&bar[XB_TOPGEN]) == tg, bar);
            __builtin_amdgcn_fence(__ATOMIC_ACQUIRE, "agent");
            xb_add(&bar[XB_XGEN(b.x)], 1u);
            asm volatile("s_waitcnt vmcnt(0)" ::: "memory");
        } else {
            XB_SPIN(xb_ld(&bar[XB_XGEN(b.x)]) == gen, bar);
            __builtin_amdgcn_fence(__ATOMIC_ACQUIRE, "agent");
            asm volatile("s_waitcnt vmcnt(0)" ::: "memory");
        }
    }
    __syncthreads();
}

__device__ __forceinline__ void prep_weight_tile(CP& p, char* smem, int wt) {
  const int tid = get_tid();
  int id = 0;
  {
    const int cnt[13] = {128, 80, 192, 64, 64, 256, 768, 256, 1408, 1408, 704, 704, 32};
#pragma unroll
    for (int i = 0; i < 12; ++i) { if (id == i && wt >= cnt[i]) { wt -= cnt[i]; id = i + 1; } }
  }
  const float* src; int K, N; bf16_t* dst; const float* scale = nullptr; int perm = 0;
  switch (id) {
    case 0: src = p.w_dq; K = 1024; N = 512; dst = p.wt_dq; break;
    case 1: src = p.w_dkv; K = 1024; N = 288; dst = p.wt_dkv; break;
    case 2: src = p.w_uq; K = 512; N = 1536; dst = p.wt_uq; scale = p.g_q; break;
    case 3: src = p.w_uk; K = 256; N = 1024; dst = p.wt_uk; scale = p.g_kv; break;
    case 4: src = p.w_uv; K = 256; N = 1024; dst = p.wt_uv; scale = p.g_kv; break;
    case 5: src = p.w_o; K = 1024; N = 1024; dst = p.wt_o; break;
    case 6: src = p.hy_w_in; K = 1024; N = 3072; dst = p.wt_hin; perm = 2; break;
    case 7: src = p.hy_w_out; K = 1024; N = 1024; dst = p.wt_hout; break;
    case 8: src = p.ffn_w_up; K = 1024; N = 5632; dst = p.wt_up0; perm = 1; break;
    case 9: src = p.ffn_w_up + (size_t)1024 * 5632; K = 1024; N = 5632; dst = p.wt_up1; perm = 1; break;
    case 10: src = p.ffn_w_down; K = 2816; N = 1024; dst = p.wt_dn0; break;
    case 11: src = p.ffn_w_down + (size_t)2816 * 1024; K = 2816; N = 1024; dst = p.wt_dn1; break;
    default: src = p.f_w3; K = 64; N = 2048; dst = p.wt_f3; break;
  }
  const int ntn = (N + 63) >> 6;
  const int kt = wt / ntn, nt = wt - kt * ntn;
  const int k0 = kt * 64, n0 = nt * 64;
  int np0;
  if (perm == 1) { const int half = n0 / 2816, f = n0 - half * 2816; np0 = (f >> 6) * 128 + half * 64; }
  else if (perm == 2) { if (n0 < 1024) np0 = n0; else { const int m = n0 - 1024, half = m >> 10, f = m & 1023; np0 = 1024 + (f >> 6) * 128 + half * 64; } }
  else np0 = n0;
  bf16_t* t16 = (bf16_t*)smem;
  f32x4 v[4];
#pragma unroll
  for (int i = 0; i < 4; ++i) {
    const int idx = tid + 256 * i; const int kr = idx >> 4, c4 = idx & 15;
    v[i] = (f32x4){0.f, 0.f, 0.f, 0.f};
    if (n0 + 4 * c4 < N) v[i] = *(const f32x4*)(src + (size_t)(k0 + kr) * N + n0 + 4 * c4);
  }
#pragma unroll
  for (int i = 0; i < 4; ++i) {
    const int idx = tid + 256 * i; const int kr = idx >> 4, c4 = idx & 15;
    const float sc = scale ? scale[k0 + kr] : 1.f;
#pragma unroll
    for (int j = 0; j < 4; ++j) t16[(4 * c4 + j) * 72 + kr] = f2bf(v[i][j] * sc);
  }
  __syncthreads();
#pragma unroll
  for (int i = 0; i < 2; ++i) {
    const int idx = tid + 256 * i; const int n = idx >> 3, ch = idx & 7;
    if (n0 + n < N) *(uint4*)(dst + (size_t)(np0 + n) * K + k0 + ch * 8) = *(const uint4*)(t16 + n * 72 + ch * 8);
  }
  __syncthreads();
}

__device__ __forceinline__ void prep_modvec(CP& p, char* smem, int it) {
  const int tid = get_tid();
  const int layer = it / 384, rem = it - layer * 384, cb = rem >> 2, ks = rem & 3;
  float* s_lds = (float*)smem;
  float* red = (float*)(smem + 12288);
  const int kbase = ks * 256;
  for (int idx = tid; idx < 9 * 256; idx += 256) {
    const int r = idx >> 8, k = idx & 255;
    const float v = r < 8 ? p.c[r * 1024 + kbase + k] : p.c_ctx[kbase + k];
    s_lds[k * 12 + r] = v / (1.f + __expf(-v));
  }
  __syncthreads();
  const int col = cb * 64 + (tid & 63), kg = tid >> 6;
  const float* W = p.mod_w + (size_t)layer * 1024 * 6144 + (size_t)kbase * 6144 + col;
  float acc[9];
#pragma unroll
  for (int r = 0; r < 9; ++r) acc[r] = 0.f;
#pragma unroll
  for (int kb = 0; kb < 4; ++kb) {
    float w[16];
#pragma unroll
    for (int u = 0; u < 16; ++u) w[u] = W[(size_t)(kg * 64 + kb * 16 + u) * 6144];
#pragma unroll
    for (int u = 0; u < 16; ++u) {
      const int k = kg * 64 + kb * 16 + u;
      const f32x4 s0 = *(const f32x4*)(s_lds + k * 12), s1 = *(const f32x4*)(s_lds + k * 12 + 4);
      const float s2 = s_lds[k * 12 + 8];
      acc[0] += s0[0] * w[u]; acc[1] += s0[1] * w[u]; acc[2] += s0[2] * w[u]; acc[3] += s0[3] * w[u];
      acc[4] += s1[0] * w[u]; acc[5] += s1[1] * w[u]; acc[6] += s1[2] * w[u]; acc[7] += s1[3] * w[u];
      acc[8] += s2 * w[u];
    }
  }
#pragma unroll
  for (int r = 0; r < 9; ++r) red[(kg * 9 + r) * 64 + (tid & 63)] = acc[r];
  __syncthreads();
  for (int o = tid; o < 9 * 64; o += 256) {
    const int r = o >> 6, cl = o & 63;
    const float sm = red[(0 * 9 + r) * 64 + cl] + red[(1 * 9 + r) * 64 + cl] + red[(2 * 9 + r) * 64 + cl] + red[(3 * 9 + r) * 64 + cl];
    p.modp[(size_t)ks * 110592 + (size_t)(layer * 9 + r) * 6144 + cb * 64 + cl] = sm;
  }
  __syncthreads();
}

__device__ __forceinline__ void prep_filter(CP& p, char* smem, int it) {
  const int tid = get_tid();
  float* z = (float*)smem;
  float* h1 = z + 8 * 33;
  float* h2 = h1 + 8 * 64;
  const int t0 = it * 8;
  for (int idx = tid; idx < 8 * 33; idx += 256) {
    const int pp = idx / 33, i = idx - pp * 33;
    const int t = t0 + pp;
    float v;
    if (i == 0) v = (float)t * (1.0f / 2047.0f);
    else {
      const int k = (i - 1) & 15;
      const float w = (6.283185307179586f * (float)t) / 2048.0f;
      const float f = 1e-4f + (float)k * ((15.0f - 1e-4f) / 15.0f);
      const float a = w * f;
      v = (i <= 16) ? __cosf(a) : -__sinf(a);
    }
    z[idx] = v;
  }
  __syncthreads();
  for (int idx = tid; idx < 8 * 64; idx += 256) {
    const int pp = idx >> 6, j = idx & 63;
    float s = p.f_b1[j];
#pragma unroll
    for (int i = 0; i < 33; ++i) s += z[pp * 33 + i] * p.f_w1[i * 64 + j];
    h1[idx] = __sinf(p.f_freq1[j] * s);
  }
  __syncthreads();
  for (int idx = tid; idx < 8 * 64; idx += 256) {
    const int pp = idx >> 6, j = idx & 63;
    float s = p.f_b2[j];
#pragma unroll 16
    for (int i = 0; i < 64; ++i) s += h1[pp * 64 + i] * p.f_w2[i * 64 + j];
    h2[idx] = __sinf(p.f_freq2[j] * s);
  }
  __syncthreads();
  for (int idx = tid; idx < 8 * 64; idx += 256) p.h2bf[(size_t)t0 * 64 + idx] = f2bf(h2[idx]);
  __syncthreads();
}

__device__ __forceinline__ void phase_prep(CP& p, char* smem) {
  const int total = 768 + 256 + 6064;
  for (int it = get_bid(); it < total; it += gridDim.x) {
    if (it < 768) prep_modvec(p, smem, it);
    else if (it < 1024) prep_filter(p, smem, it - 768);
    else prep_weight_tile(p, smem, it - 1024);
  }
}

template <bool PART>
__device__ __forceinline__ void normmod_row(const float* __restrict__ src, const float* __restrict__ g, const float* __restrict__ sh, const float* __restrict__ sc, bf16_t* __restrict__ dst, int lane, const float* __restrict__ bsh = nullptr) {
  f32x4 v[4]; float ss = 0.f;
#pragma unroll
  for (int i = 0; i < 4; ++i) { v[i] = *(const f32x4*)(src + lane * 4 + 256 * i); ss += v[i][0] * v[i][0] + v[i][1] * v[i][1] + v[i][2] * v[i][2] + v[i][3] * v[i][3]; }
  ss = wave_sum(ss);
  const float r = rsqrtf(ss * (1.0f / 1024.0f) + 1e-6f);
#pragma unroll
  for (int i = 0; i < 4; ++i) {
    const int k = lane * 4 + 256 * i;
    const f32x4 g4 = *(const f32x4*)(g + k);
    f32x4 s4 = *(const f32x4*)(sh + k), c4 = *(const f32x4*)(sc + k);
    if (PART) {
#pragma unroll
      for (int q = 1; q < 4; ++q) { s4 += *(const f32x4*)(sh + (size_t)q * 110592 + k); c4 += *(const f32x4*)(sc + (size_t)q * 110592 + k); }
      s4 += *(const f32x4*)(bsh + k); c4 += *(const f32x4*)(bsh + 1024 + k);
    }
    float y[4];
#pragma unroll
    for (int j = 0; j < 4; ++j) y[j] = (v[i][j] * r * g4[j]) * (1.f + c4[j]) + s4[j];
    uint2 u; u.x = pack2(y[0], y[1]); u.y = pack2(y[2], y[3]);
    *(uint2*)(dst + k) = u;
  }
}

__device__ __forceinline__ void phase_normmod_kv(CP& p) {
  const int lane = get_tid() & 63, wv = get_tid() >> 6;
  const float* g = p.norm_mix_g;
  for (int idx = get_bid() * 256 + get_tid(); idx < 110592; idx += gridDim.x * 256) {
    const int lr = idx / 6144; const int n = idx - lr * 6144; const int layer = lr / 9;
    p.modv[idx] = p.modp[idx] + p.modp[110592 + idx] + p.modp[2 * 110592 + idx] + p.modp[3 * 110592 + idx] + p.mod_b[layer * 6144 + n];
  }
  for (int r = get_bid() * 4 + wv; r < 18432; r += gridDim.x * 4) {
    const int b = r / 2304, pp = r - b * 2304;
    const float* src; const float* mv;
    if (pp < 256) { src = p.ctx + ((size_t)b * 256 + pp) * 1024; mv = p.modp + (size_t)8 * 6144; }
    else { src = p.x + ((size_t)b * 2048 + pp - 256) * 1024; mv = p.modp + (size_t)b * 6144; }
    normmod_row<true>(src, g, mv, mv + 1024, p.hxc + (size_t)r * 1024, lane, p.mod_b);
  }
}
__device__ __forceinline__ void phase_normmod_x(CP& p, const float* g, int layer, int chunk) {
  const int lane = get_tid() & 63, wv = get_tid() >> 6;
  for (int r = get_bid() * 4 + wv; r < 16384; r += gridDim.x * 4) {
    const int b = r >> 11;
    const float* mv = p.modv + (size_t)(layer * 9 + b) * 6144 + chunk * 1024;
    normmod_row<false>(p.X + (size_t)r * 1024, g, mv, mv + 1024, p.hxc + (size_t)r * 1024, lane);
  }
}
__device__ __forceinline__ void phase_final_norm(CP& p) {
  const int lane = get_tid() & 63, wv = get_tid() >> 6;
  for (int r = get_bid() * 4 + wv; r < 16384; r += gridDim.x * 4) {
    float* row = p.X + (size_t)r * 1024;
    f32x4 v[4]; float ss = 0.f;
#pragma unroll
    for (int i = 0; i < 4; ++i) { v[i] = *(const f32x4*)(row + lane * 4 + 256 * i); ss += v[i][0] * v[i][0] + v[i][1] * v[i][1] + v[i][2] * v[i][2] + v[i][3] * v[i][3]; }
    ss = wave_sum(ss);
    const float rr = rsqrtf(ss * (1.0f / 1024.0f) + 1e-6f);
#pragma unroll
    for (int i = 0; i < 4; ++i) {
      const int k = lane * 4 + 256 * i;
      const f32x4 g4 = *(const f32x4*)(p.final_g + k);
      f32x4 o; o[0] = v[i][0] * rr * g4[0]; o[1] = v[i][1] * rr * g4[1]; o[2] = v[i][2] * rr * g4[2]; o[3] = v[i][3] * rr * g4[3];
      *(f32x4*)(row + k) = o;
    }
  }
}

__device__ __forceinline__ void phase_rowstat(CP& p) {
  const int lane = get_tid() & 63, wv = get_tid() >> 6;
  for (int r = get_bid() * 4 + wv; r < 18432; r += gridDim.x * 4) {
    const int b = r / 2304, pp = r - b * 2304;
    const bf16_t* kvr = p.kv + (size_t)r * 288;
    {
      const uint2 u = *(const uint2*)(kvr + lane * 4);
      const float a0 = bf2f((bf16_t)(u.x & 0xffff)), a1 = bf2f((bf16_t)(u.x >> 16)), a2 = bf2f((bf16_t)(u.y & 0xffff)), a3 = bf2f((bf16_t)(u.y >> 16));
      float ss = a0 * a0 + a1 * a1 + a2 * a2 + a3 * a3;
      ss = wave_sum(ss);
      if (lane == 0) p.rkv[r] = rsqrtf(ss * (1.0f / 256.0f) + 1e-6f);
    }
    {
      const int i = lane & 31;
      const float xv = bf2f(kvr[256 + i]);
      const float ov = __shfl_xor(xv, 8);
      float res = xv;
      if (pp >= 256) {
        const int t = pp - 256;
        const int quarter = i >> 3, idx = i & 7;
        const float pos = (quarter < 2) ? (float)(t >> 6) : (float)(t & 63);
        const float inv = exp2f(-(float)idx * (13.287712379549449f / 8.0f));
        const float ang = pos * inv;
        const float cs = __cosf(ang), sn = __sinf(ang);
        res = xv * cs + ((quarter & 1) ? ov : -ov) * sn;
      }
      if (lane < 32) p.kpe[(size_t)r * 32 + i] = f2bf(res);
    }
    if (pp >= 256) {
      const int xr = b * 2048 + pp - 256;
      const uint4 u = *(const uint4*)(p.cq + (size_t)xr * 512 + lane * 8);
      const unsigned uu[4] = {u.x, u.y, u.z, u.w};
      float ss = 0.f;
#pragma unroll
      for (int j = 0; j < 4; ++j) { const float a = bf2f((bf16_t)(uu[j] & 0xffff)), bb = bf2f((bf16_t)(uu[j] >> 16)); ss += a * a + bb * bb; }
      ss = wave_sum(ss);
      if (lane == 0) p.rq[xr] = rsqrtf(ss * (1.0f / 512.0f) + 1e-6f);
    }
  }
}

struct EpiStore {
  static constexpr int KIND = 0;
  bf16_t* out; int ld; int ostride; const float* rs;
  __device__ __forceinline__ void c4(int g, int rig, int col, f32x4 v) const {
    const size_t row = (size_t)g * ostride + rig;
    const float s = rs ? rs[row] : 1.f;
    uint2 u; u.x = pack2(v[0] * s, v[1] * s); u.y = pack2(v[2] * s, v[3] * s);
    *(uint2*)(out + row * ld + col) = u;
  }
};
struct EpiVt {
  static constexpr int KIND = 1;
  bf16_t* out; const float* rs;
  __device__ __forceinline__ void r4(int g, int rig, int col, f32x4 v) const {
    const size_t row = (size_t)g * 2304 + rig;
    const f32x4 s = *(const f32x4*)(rs + row);
    uint2 u; u.x = pack2(v[0] * s[0], v[1] * s[1]); u.y = pack2(v[2] * s[2], v[3] * s[3]);
    *(uint2*)(out + ((size_t)g * 1024 + col) * 2304 + rig) = u;
  }
};
struct EpiFilt {
  static constexpr int KIND = 1;
  bf16_t* Rf; const float* decay;
  __device__ __forceinline__ void r4(int g, int rig, int col, f32x4 v) const {
    const int c = col & 1023; const bool bwd = col >= 1024;
    const float dec = fabsf(decay[c]);
    bf16_t* rp = Rf + (size_t)c * 4096;
#pragma unroll
    for (int j = 0; j < 4; ++j) {
      const int t = rig + j;
      const float val = v[j] * __expf(-(float)t * (1.0f / 2047.0f) * dec);
      if (!bwd) rp[2048 - t] = f2bf(val);
      else if (t > 0) rp[2048 + t] = f2bf(val);
      else rp[0] = 0;
    }
  }
};
struct EpiResid {
  static constexpr int KIND = 0;
  float* X; const float* base; const float* gate; const float* bias;
  __device__ __forceinline__ void c4(int g, int rig, int col, f32x4 v) const {
    const size_t o = ((size_t)g * 2048 + rig) * 1024 + col;
    const f32x4 bs = *(const f32x4*)(base + o);
    const f32x4 gt = *(const f32x4*)(gate + (size_t)g * 6144 + col);
    f32x4 bi = {0.f, 0.f, 0.f, 0.f};
    if (bias) bi = *(const f32x4*)(bias + col);
    f32x4 r;
#pragma unroll
    for (int j = 0; j < 4; ++j) r[j] = bs[j] + gt[j] * (v[j] + bi[j]);
    *(f32x4*)(X + o) = r;
  }
};
template <int MODE>
struct EpiConv {
  static constexpr int KIND = 2;
  const float* cw; const float* cb; int NC; const float* pre_bias;
  bf16_t* o0; bf16_t* o1;
  __device__ __forceinline__ int norig(int nt, int cl) const {
    if (MODE == 0) return (cl >> 6) * 2816 + nt * 64 + (cl & 63);
    if (nt < 8) return nt * 128 + cl;
    return 1024 + (cl >> 6) * 1024 + (nt - 8) * 64 + (cl & 63);
  }
  __device__ __forceinline__ void finish(const float* Z, int g, int rig0, int nt) const {
    const int tid = get_tid();
    if (MODE == 0 || nt < 8) {
      const int f = tid & 63, q = tid >> 6;
      const int p0 = 1 + 32 * q, p1 = (p0 + 32 < 127) ? p0 + 32 : 127;
      if (MODE == 0) {
        const int na = norig(nt, f), ng = norig(nt, 64 + f);
        const float a0 = cw[na], a1 = cw[NC + na], a2 = cw[2 * NC + na], ab = cb[na];
        const float g0 = cw[ng], g1 = cw[NC + ng], g2 = cw[2 * NC + ng], gb = cb[ng];
        float am = Z[(p0 - 1) * 132 + f], ac = Z[p0 * 132 + f], gm = Z[(p0 - 1) * 132 + 64 + f], gc = Z[p0 * 132 + 64 + f];
#pragma unroll 2
        for (int pl = p0; pl < p1; ++pl) {
          const float an = Z[(pl + 1) * 132 + f], gn = Z[(pl + 1) * 132 + 64 + f];
          const int pos = rig0 + pl;
          if (pos < 2048) {
            const float av = a0 * am + a1 * ac + a2 * an + ab;
            const float gv = g0 * gm + g1 * gc + g2 * gn + gb;
            o0[((size_t)g * 2048 + pos) * 2816 + nt * 64 + f] = f2bf(av * gv / (1.f + __expf(-gv)));
          }
          am = ac; ac = an; gm = gc; gc = gn;
        }
      } else {
#pragma unroll
        for (int fh = 0; fh < 2; ++fh) {
          const int cl = fh * 64 + f;
          const int na = norig(nt, cl);
          const float a0 = cw[na], a1 = cw[NC + na], a2 = cw[2 * NC + na], ab = cb[na];
          float am = Z[(p0 - 1) * 132 + cl], ac = Z[p0 * 132 + cl];
#pragma unroll 2
          for (int pl = p0; pl < p1; ++pl) {
            const float an = Z[(pl + 1) * 132 + cl];
            const int pos = rig0 + pl;
            if (pos < 2048) o0[((size_t)g * 2048 + pos) * 1024 + nt * 128 + cl] = f2bf(a0 * am + a1 * ac + a2 * an + ab);
            am = ac; ac = an;
          }
        }
      }
    } else {
      const int pl = tid & 127, fh = tid >> 7;
      const int pos = rig0 + pl;
      if (pl >= 1 && pl <= 126 && pos < 2048) {
        const int fb = nt - 8;
#pragma unroll 2
        for (int f = fh * 32; f < fh * 32 + 32; ++f) {
          const int na = norig(nt, f), nb = norig(nt, 64 + f);
          const float va = cw[na] * Z[(pl - 1) * 132 + f] + cw[NC + na] * Z[pl * 132 + f] + cw[2 * NC + na] * Z[(pl + 1) * 132 + f] + cb[na];
          const float vb = cw[nb] * Z[(pl - 1) * 132 + 64 + f] + cw[NC + nb] * Z[pl * 132 + 64 + f] + cw[2 * NC + nb] * Z[(pl + 1) * 132 + 64 + f] + cb[nb];
          o1[(size_t)(fb * 64 + f) * 16384 + g * 2048 + pos] = f2bf(va * vb);
        }
      }
    }
  }
};

#define GLDS16(gp, lp) __builtin_amdgcn_global_load_lds((const unsigned*)(gp), (__attribute__((address_space(3))) unsigned*)(lp), 16, 0, 0)

template <bool SWAP, class Epi>
__device__ __forceinline__ void gemm_job(char* smem, const bf16_t* __restrict__ A, int lda, const bf16_t* __restrict__ Bt, int K, int N,
                                         int tpg, int a_gstride, int a_goff, int step, int halo, int grows, int MT, int voff, int vid0, int grid, const Epi& epi) {
  const int tid = get_tid(), lane = tid & 63, wid = tid >> 6, wr = wid >> 1, wc = wid & 1, fr = lane & 15, fq = lane >> 4;
  const int NT = (N + 255) >> 8, ntiles = MT * NT, nk = K >> 5;
  int v = vid0;
  if (v < voff) v += ((voff - v + grid - 1) / grid) * grid;
  const int rdoff = ((fq ^ ((fr >> 2) & 3)) << 4);
  for (; v < voff + ntiles; v += grid) {
    const int w = v - voff;
    const int sr = w / (8 * NT), rem = w - sr * 8 * NT;
    const int nt = rem >> 3, mt = sr * 8 + (rem & 7);
    const int g = mt / tpg, ti = mt - g * tpg;
    const int rig0 = ti * step - halo;
    unsigned ap[2], bp[4];
#pragma unroll
    for (int i = 0; i < 4; ++i) {
      const int b = tid * 16 + i * 4096;
      const int r = b >> 6;
      const int cs = (b & 63) >> 4;
      const int c = ((cs ^ ((r >> 2) & 3)) << 3);
      if (i < 2) {
        int rig = rig0 + r; rig = rig < 0 ? 0 : (rig > grows - 1 ? grows - 1 : rig);
        ap[i] = (unsigned)((g * a_gstride + a_goff + rig) * lda + c);
      }
      int br = nt * 256 + r; br = br > N - 1 ? N - 1 : br;
      bp[i] = (unsigned)(br * K + c);
    }
    f32x4 acc[4][8];
#pragma unroll
    for (int m = 0; m < 4; ++m)
#pragma unroll
      for (int n = 0; n < 8; ++n) acc[m][n] = (f32x4){0.f, 0.f, 0.f, 0.f};
#pragma unroll
    for (int st = 0; st < 2; ++st) {
      if (st < nk) {
        char* nb = smem + st * 24576;
#pragma unroll
        for (int i = 0; i < 2; ++i) GLDS16(A + (size_t)(ap[i] + st * 32), nb + tid * 16 + i * 4096);
#pragma unroll
        for (int i = 0; i < 4; ++i) GLDS16(Bt + (size_t)(bp[i] + st * 32), nb + 8192 + tid * 16 + i * 4096);
      }
    }
    int cur = 0;
    for (int t = 0; t < nk; ++t) {
      if (t + 1 < nk) asm volatile("s_waitcnt vmcnt(6)" ::: "memory");
      else asm volatile("s_waitcnt vmcnt(0)" ::: "memory");
      __builtin_amdgcn_s_barrier();
      asm volatile("" ::: "memory");
      if (t + 2 < nk) {
        int nbi = cur + 2; nbi = nbi >= 3 ? nbi - 3 : nbi;
        char* nb = smem + nbi * 24576;
        const int ko = (t + 2) * 32;
#pragma unroll
        for (int i = 0; i < 2; ++i) GLDS16(A + (size_t)(ap[i] + ko), nb + tid * 16 + i * 4096);
#pragma unroll
        for (int i = 0; i < 4; ++i) GLDS16(Bt + (size_t)(bp[i] + ko), nb + 8192 + tid * 16 + i * 4096);
      }
      const char* sa = smem + cur * 24576; const char* sb = sa + 8192;
      cur = cur == 2 ? 0 : cur + 1;
      bf16x8 af[4];
#pragma unroll
      for (int m = 0; m < 4; ++m) af[m] = *(const bf16x8*)(sa + (wr * 64 + m * 16 + fr) * 64 + rdoff);
#pragma unroll
      for (int nh = 0; nh < 4; ++nh) {
        bf16x8 bf[2];
#pragma unroll
        for (int n = 0; n < 2; ++n) bf[n] = *(const bf16x8*)(sb + (wc * 128 + (nh * 2 + n) * 16 + fr) * 64 + rdoff);
#pragma unroll
        for (int m = 0; m < 4; ++m)
#pragma unroll
          for (int n = 0; n < 2; ++n)
            acc[m][nh * 2 + n] = SWAP ? __builtin_amdgcn_mfma_f32_16x16x32_bf16(bf[n], af[m], acc[m][nh * 2 + n], 0, 0, 0)
                                      : __builtin_amdgcn_mfma_f32_16x16x32_bf16(af[m], bf[n], acc[m][nh * 2 + n], 0, 0, 0);
      }
    }
    __syncthreads();
    if constexpr (Epi::KIND == 0) {
#pragma unroll
      for (int m = 0; m < 4; ++m) {
        const int rig = rig0 + wr * 64 + m * 16 + fr;
#pragma unroll
        for (int n = 0; n < 8; ++n) {
          const int col = nt * 256 + wc * 128 + n * 16 + fq * 4;
          if (col < N) epi.c4(g, rig, col, acc[m][n]);
        }
      }
    } else if constexpr (Epi::KIND == 1) {
#pragma unroll
      for (int m = 0; m < 4; ++m) {
        const int rig = rig0 + wr * 64 + m * 16 + fq * 4;
#pragma unroll
        for (int n = 0; n < 8; ++n) {
          const int col = nt * 256 + wc * 128 + n * 16 + fr;
          if (col < N) epi.r4(g, rig, col, acc[m][n]);
        }
      }
    } else {
      float* Z = (float*)smem;
#pragma unroll
      for (int h = 0; h < 2; ++h) {
        const int nt2 = nt * 2 + h;
        if (wc == h) {
#pragma unroll
          for (int n = 0; n < 8; ++n) {
            const int cl = n * 16 + fq * 4;
            f32x4 b4 = {0.f, 0.f, 0.f, 0.f};
            if (epi.pre_bias) b4 = *(const f32x4*)(epi.pre_bias + epi.norig(nt2, cl));
#pragma unroll
            for (int m = 0; m < 4; ++m) {
              const int rl = wr * 64 + m * 16 + fr;
              const int pos = rig0 + rl;
              const bool ok = pos >= 0 && pos < grows;
              f32x4 vv = acc[m][n] + b4;
              if (!ok) vv = (f32x4){0.f, 0.f, 0.f, 0.f};
              *(f32x4*)(Z + rl * 132 + cl) = vv;
            }
          }
        }
        __syncthreads();
        epi.finish(Z, g, rig0, nt2);
        __syncthreads();
      }
    }
    asm volatile("s_waitcnt vmcnt(0)" ::: "memory");
    __syncthreads();
  }
}

__device__ __forceinline__ void phase_attn(CP& p, char* smem, int vid0, int grid) {
  bf16_t* Ks = (bf16_t*)smem;
  bf16_t* Vs = (bf16_t*)(smem + 64 * 104 * 2);
  const int tid = get_tid(), lane = tid & 63, w = tid >> 6, r = lane & 31, hh = lane >> 5;
  const float cs = 1.4426950408889634f * 0.10206207261596577f;
  for (int it = vid0; it < 2048; it += grid) {
    const int qt = it & 15, h = (it >> 4) & 15, b = it >> 8;
    const int t = qt * 128 + w * 32 + r;
    const size_t xrow = (size_t)b * 2048 + t;
    const bf16_t* qp = p.Q + xrow * 1536 + h * 96;
    bf16x8 qf[6];
#pragma unroll
    for (int kk = 0; kk < 4; ++kk) qf[kk] = *(const bf16x8*)(qp + 16 * kk + 8 * hh);
#pragma unroll
    for (int part = 0; part < 2; ++part) {
      const bf16_t* pp = qp + 64 + 16 * part;
      const bf16x8 mine = *(const bf16x8*)(pp + 8 * hh), oth = *(const bf16x8*)(pp + 8 * (1 - hh));
      const float posf = part == 0 ? (float)(t >> 6) : (float)(t & 63);
      bf16x8 o;
#pragma unroll
      for (int j = 0; j < 8; ++j) {
        const float inv = exp2f(-(float)j * (13.287712379549449f / 8.0f));
        const float ang = posf * inv;
        const float c = __cosf(ang), s = __sinf(ang);
        const float m = bf2f((bf16_t)mine[j]), ov = bf2f((bf16_t)oth[j]);
        o[j] = (short)f2bf(m * c + (hh ? ov : -ov) * s);
      }
      qf[4 + part] = o;
    }
    f32x16 oacc[2];
#pragma unroll
    for (int i = 0; i < 16; ++i) { oacc[0][i] = 0.f; oacc[1][i] = 0.f; }
    float mrun = -INFINITY, lrun = 0.f;
    const size_t kvrow0 = (size_t)b * 2304;
    const bf16_t* kn_base = p.Kn + kvrow0 * 1024 + h * 64;
    const bf16_t* kpe_base = p.kpe + kvrow0 * 32;
    const bf16_t* vt_base = p.Vt + ((size_t)(b * 16 + h) * 64) * 2304;
    uint4 rk0, rk1, rp, rv0, rv1;
    const int srow = tid >> 3, sch = tid & 7;
#define ATT_GLOAD(kt) do { \
      rk0 = *(const uint4*)(kn_base + (size_t)((kt) * 64 + srow) * 1024 + sch * 8); \
      rk1 = *(const uint4*)(kn_base + (size_t)((kt) * 64 + srow + 32) * 1024 + sch * 8); \
      rv0 = *(const uint4*)(vt_base + (size_t)srow * 2304 + (kt) * 64 + sch * 8); \
      rv1 = *(const uint4*)(vt_base + (size_t)(srow + 32) * 2304 + (kt) * 64 + sch * 8); \
      rp = *(const uint4*)(kpe_base + (size_t)((kt) * 64 + (tid >> 2)) * 32 + (tid & 3) * 8); } while (0)
    ATT_GLOAD(0);
    for (int kt = 0; kt < 36; ++kt) {
      __syncthreads();
      {
        *(uint4*)(Ks + srow * 104 + sch * 8) = rk0;
        *(uint4*)(Ks + (srow + 32) * 104 + sch * 8) = rk1;
        uint2 lo, hi;
        lo.x = rv0.x; lo.y = rv0.y; hi.x = rv0.z; hi.y = rv0.w;
        *(uint2*)(Vs + srow * 68 + sch * 8) = lo; *(uint2*)(Vs + srow * 68 + sch * 8 + 4) = hi;
        lo.x = rv1.x; lo.y = rv1.y; hi.x = rv1.z; hi.y = rv1.w;
        *(uint2*)(Vs + (srow + 32) * 68 + sch * 8) = lo; *(uint2*)(Vs + (srow + 32) * 68 + sch * 8 + 4) = hi;
      }
      *(uint4*)(Ks + (tid >> 2) * 104 + 64 + (tid & 3) * 8) = rp;
      __syncthreads();
      if (kt + 1 < 36) ATT_GLOAD(kt + 1);
      f32x16 s[2];
#pragma unroll
      for (int t2 = 0; t2 < 2; ++t2) {
#pragma unroll
        for (int i = 0; i < 16; ++i) s[t2][i] = 0.f;
#pragma unroll
        for (int kk = 0; kk < 6; ++kk) {
          const bf16x8 a = *(const bf16x8*)(Ks + (32 * t2 + r) * 104 + 16 * kk + 8 * hh);
          s[t2] = __builtin_amdgcn_mfma_f32_32x32x16_bf16(a, qf[kk], s[t2], 0, 0, 0);
        }
      }
      float mx = s[0][0];
#pragma unroll
      for (int i = 1; i < 16; ++i) mx = fmaxf(mx, s[0][i]);
#pragma unroll
      for (int i = 0; i < 16; ++i) mx = fmaxf(mx, s[1][i]);
      mx = fmaxf(mx, __shfl_xor(mx, 32));
      const float mnew = fmaxf(mrun, mx * cs);
      const float alpha = __builtin_amdgcn_exp2f(mrun - mnew);
      mrun = mnew;
      float psum = 0.f;
      bf16x8 pf[4];
#pragma unroll
      for (int t2 = 0; t2 < 2; ++t2)
#pragma unroll
        for (int i = 0; i < 16; ++i) {
          const float pv = __builtin_amdgcn_exp2f(s[t2][i] * cs - mnew);
          psum += pv;
          pf[t2 * 2 + (i >> 3)][i & 7] = (short)f2bf(pv);
        }
      lrun = lrun * alpha + psum;
#pragma unroll
      for (int i = 0; i < 16; ++i) { oacc[0][i] *= alpha; oacc[1][i] *= alpha; }
#pragma unroll
      for (int dt = 0; dt < 2; ++dt)
#pragma unroll
        for (int s4 = 0; s4 < 4; ++s4) {
          const bf16_t* vp = Vs + (32 * dt + r) * 68 + 16 * s4 + 4 * hh;
          const uint2 lo = *(const uint2*)vp, hi = *(const uint2*)(vp + 8);
          union { uint4 u; bf16x8 v; } cv; cv.u.x = lo.x; cv.u.y = lo.y; cv.u.z = hi.x; cv.u.w = hi.y;
          oacc[dt] = __builtin_amdgcn_mfma_f32_32x32x16_bf16(cv.v, pf[s4], oacc[dt], 0, 0, 0);
        }
    }
    const float ltot = lrun + __shfl_xor(lrun, 32);
    const float inv = 1.f / ltot;
    bf16_t* op = p.hxc + xrow * 1024 + h * 64;
#pragma unroll
    for (int dt = 0; dt < 2; ++dt)
#pragma unroll
      for (int i4 = 0; i4 < 4; ++i4) {
        const int d = 32 * dt + 8 * i4 + 4 * hh;
        uint2 u; u.x = pack2(oacc[dt][4 * i4] * inv, oacc[dt][4 * i4 + 1] * inv); u.y = pack2(oacc[dt][4 * i4 + 2] * inv, oacc[dt][4 * i4 + 3] * inv);
        *(uint2*)(op + d) = u;
      }
  }
}

__device__ __forceinline__ void phase_hyconv(CP& p, char* smem) {
  bf16_t* cp = (bf16_t*)smem;
  bf16_t* Vl = (bf16_t*)(smem + 4 * 8208);
  const int tid = get_tid(), lane = tid & 63, w = tid >> 6, i16 = lane & 15, g4 = lane >> 4;
  const int si = (-i16) & 3;
  const int ocb = 64 * w;
  for (int c = get_bid(); c < 1024; c += gridDim.x) {
    __syncthreads();
#pragma unroll
    for (int i = 0; i < 2; ++i) { const int ch = tid + 256 * i; *(uint4*)(cp + ch * 8) = *(const uint4*)(p.Rf + (size_t)c * 4096 + ch * 8); }
#pragma unroll
    for (int i = 0; i < 8; ++i) {
      const int q = tid + 256 * i; const int b = q >> 8, l8 = q & 255; const int m1 = l8 >> 3, m2 = (l8 & 7) * 8;
      *(uint4*)(Vl + (8 + m1 * 8 + b) * 72 + m2) = *(const uint4*)(p.vvT + (size_t)c * 16384 + b * 2048 + l8 * 8);
    }
    if (tid < 144) {
      const int colp = tid / 9, part = tid - colp * 9;
      const int col = colp < 8 ? colp : 256 + colp;
      uint4 zz; zz.x = 0; zz.y = 0; zz.z = 0; zz.w = 0;
      *(uint4*)(Vl + col * 72 + part * 8) = zz;
    }
    __syncthreads();
#pragma unroll
    for (int s = 1; s < 4; ++s)
#pragma unroll
      for (int i = 0; i < 2; ++i) {
        const int ch = tid + 256 * i;
        unsigned e[8];
#pragma unroll
        for (int j = 0; j < 8; ++j) { const int idx = 8 * ch + s + j; e[j] = idx < 4096 ? (unsigned)cp[idx] : 0u; }
        uint4 u; u.x = e[0] | (e[1] << 16); u.y = e[2] | (e[3] << 16); u.z = e[4] | (e[5] << 16); u.w = e[6] | (e[7] << 16);
        *(uint4*)(cp + s * 4104 + 8 * ch) = u;
      }
    __syncthreads();
    const bf16_t* abase = cp + si * 4104 + (2048 - i16 - si + 8 * g4);
    f32x4 acc[4][4];
#pragma unroll
    for (int m = 0; m < 4; ++m)
#pragma unroll
      for (int n = 0; n < 4; ++n) acc[m][n] = (f32x4){0.f, 0.f, 0.f, 0.f};
    for (int dl = -31; dl <= 31; ++dl) {
      bf16x8 af[4][2];
#pragma unroll
      for (int mt = 0; mt < 4; ++mt)
#pragma unroll
        for (int kk = 0; kk < 2; ++kk) {
          const bf16_t* ap = abase - 64 * dl - 16 * mt + 32 * kk;
          const uint2 lo = *(const uint2*)ap, hi = *(const uint2*)(ap + 4);
          union { uint4 u; bf16x8 v; } cv; cv.u.x = lo.x; cv.u.y = lo.y; cv.u.z = hi.x; cv.u.w = hi.y;
          af[mt][kk] = cv.v;
        }
#pragma unroll
      for (int jt = 0; jt < 4; ++jt) {
        const int in0 = ocb + 16 * jt - 8 * dl;
        if (in0 >= -8 && in0 <= 248) {
          const bf16_t* bp = Vl + (in0 + 8 + i16) * 72 + 8 * g4;
          const bf16x8 b0 = *(const bf16x8*)bp, b1 = *(const bf16x8*)(bp + 32);
#pragma unroll
          for (int mt = 0; mt < 4; ++mt) {
            acc[mt][jt] = __builtin_amdgcn_mfma_f32_16x16x32_bf16(af[mt][0], b0, acc[mt][jt], 0, 0, 0);
            acc[mt][jt] = __builtin_amdgcn_mfma_f32_16x16x32_bf16(af[mt][1], b1, acc[mt][jt], 0, 0, 0);
          }
        }
      }
    }
    const float db = p.hy_d_bias[c];
#pragma unroll
    for (int mt = 0; mt < 4; ++mt)
#pragma unroll
      for (int jt = 0; jt < 4; ++jt) {
        const int col = ocb + 16 * jt + i16;
        const int n1 = col >> 3, b = col & 7;
        const int n2 = 16 * mt + 4 * g4;
        const uint2 vv = *(const uint2*)(Vl + (col + 8) * 72 + n2);
        const float y0 = acc[mt][jt][0] + bf2f((bf16_t)(vv.x & 0xffff)) * db;
        const float y1 = acc[mt][jt][1] + bf2f((bf16_t)(vv.x >> 16)) * db;
        const float y2 = acc[mt][jt][2] + bf2f((bf16_t)(vv.y & 0xffff)) * db;
        const float y3 = acc[mt][jt][3] + bf2f((bf16_t)(vv.y >> 16)) * db;
        uint2 u; u.x = pack2(y0, y1); u.y = pack2(y2, y3);
        *(uint2*)(p.Yp + (size_t)c * 16384 + b * 2048 + n1 * 64 + n2) = u;
      }
  }
}

__device__ __forceinline__ void phase_transmul(CP& p, char* smem) {
  bf16_t* tl = (bf16_t*)smem;
  const int tid = get_tid();
  for (int it = get_bid(); it < 4096; it += gridDim.x) {
    const int ct = it & 15, rt = it >> 4;
    const int c0 = ct * 64, r0 = rt * 64;
    __syncthreads();
#pragma unroll
    for (int i = 0; i < 2; ++i) {
      const int ci = tid + 256 * i; const int cc = ci >> 3, ch = ci & 7;
      const uint4 u = *(const uint4*)(p.Yp + (size_t)(c0 + cc) * 16384 + r0 + ch * 8);
      unsigned* d = (unsigned*)(tl + cc * 66 + ch * 8);
      d[0] = u.x; d[1] = u.y; d[2] = u.z; d[3] = u.w;
    }
    __syncthreads();
    const int row = tid >> 2, cq = tid & 3;
    const bf16_t* xp = p.x1h + (size_t)(r0 + row) * 1024 + c0 + cq * 16;
    const uint4 xa = *(const uint4*)xp, xb = *(const uint4*)(xp + 8);
    const unsigned xs[8] = {xa.x, xa.y, xa.z, xa.w, xb.x, xb.y, xb.z, xb.w};
    unsigned o[8];
#pragma unroll
    for (int j = 0; j < 8; ++j) {
      const float y0 = bf2f(tl[(cq * 16 + 2 * j) * 66 + row]) * bf2f((bf16_t)(xs[j] & 0xffff));
      const float y1 = bf2f(tl[(cq * 16 + 2 * j + 1) * 66 + row]) * bf2f((bf16_t)(xs[j] >> 16));
      o[j] = pack2(y0, y1);
    }
    bf16_t* op = p.hxc + (size_t)(r0 + row) * 1024 + c0 + cq * 16;
    uint4 oa; oa.x = o[0]; oa.y = o[1]; oa.z = o[2]; oa.w = o[3];
    uint4 ob; ob.x = o[4]; ob.y = o[5]; ob.z = o[6]; ob.w = o[7];
    *(uint4*)op = oa; *(uint4*)(op + 8) = ob;
  }
}

__global__ void __launch_bounds__(256, 2) mega(P p_arg) {
  __shared__ __attribute__((aligned(16))) char smem[LDS_BYTES];
  cg::grid_group grid = cg::this_grid();
  const int G = gridDim.x;
  CP* pp = (CP*)__builtin_amdgcn_kernarg_segment_ptr();
  const int ph0 = pp->ph0, ph1 = pp->ph1;
  volatile LAS unsigned* xst = (volatile LAS unsigned*)(smem + LDS_BYTES - 16);
  if (threadIdx.x == 0) { xst[0] = 0u; xst[1] = 0u; }
  __syncthreads();
  const XcdBarrier xb = xcd_barrier_post(pp->bar, xst);
  if (ph0 <= 0 && 0 < ph1) {
    asm volatile("" : "+s"(pp));
    CP& p = *pp;
    const int bid = get_bid();
    const int vid0 = (G & 7) ? bid : ((bid & 7) * (G >> 3) + (bid >> 3));
    const float* mv0 = p.modv; const float* mv1 = p.modv + (size_t)9 * 6144;
    (void)mv0; (void)mv1; (void)vid0;
    phase_prep(p, smem);
    if (0 + 1 < ph1) { if (ph1 > 1000) grid.sync(); else xcd_barrier(xb); }
  }
  if (ph0 <= 1 && 1 < ph1) {
    asm volatile("" : "+s"(pp));
    CP& p = *pp;
    const int bid = get_bid();
    const int vid0 = (G & 7) ? bid : ((bid & 7) * (G >> 3) + (bid >> 3));
    const float* mv0 = p.modv; const float* mv1 = p.modv + (size_t)9 * 6144;
    (void)mv0; (void)mv1; (void)vid0;
    phase_normmod_kv(p);
    if (1 + 1 < ph1) { if (ph1 > 1000) grid.sync(); else xcd_barrier(xb); }
  }
  if (ph0 <= 2 && 2 < ph1) {
    asm volatile("" : "+s"(pp));
    CP& p = *pp;
    const int bid = get_bid();
    const int vid0 = (G & 7) ? bid : ((bid & 7) * (G >> 3) + (bid >> 3));
    const float* mv0 = p.modv; const float* mv1 = p.modv + (size_t)9 * 6144;
    (void)mv0; (void)mv1; (void)vid0;
    {
        EpiStore e1{p.cq, 512, 2048, nullptr};
        gemm_job<true>(smem, p.hxc, 1024, p.wt_dq, 1024, 512, 16, 2304, 256, 128, 0, 2048, 128, 0, vid0, G, e1);
        EpiStore e2{p.kv, 288, 2304, nullptr};
        gemm_job<true>(smem, p.hxc, 1024, p.wt_dkv, 1024, 288, 18, 2304, 0, 128, 0, 2304, 144, 128 * 2, vid0, G, e2);
        EpiFilt e3{p.Rf, p.hy_decay};
        gemm_job<false>(smem, p.h2bf, 64, p.wt_f3, 64, 2048, 16, 0, 0, 128, 0, 2048, 16, 128 * 2 + 144 * 2, vid0, G, e3);
      }
    if (2 + 1 < ph1) { if (ph1 > 1000) grid.sync(); else xcd_barrier(xb); }
  }
  if (ph0 <= 3 && 3 < ph1) {
    asm volatile("" : "+s"(pp));
    CP& p = *pp;
    const int bid = get_bid();
    const int vid0 = (G & 7) ? bid : ((bid & 7) * (G >> 3) + (bid >> 3));
    const float* mv0 = p.modv; const float* mv1 = p.modv + (size_t)9 * 6144;
    (void)mv0; (void)mv1; (void)vid0;
    phase_rowstat(p);
    if (3 + 1 < ph1) { if (ph1 > 1000) grid.sync(); else xcd_barrier(xb); }
  }
  if (ph0 <= 4 && 4 < ph1) {
    asm volatile("" : "+s"(pp));
    CP& p = *pp;
    const int bid = get_bid();
    const int vid0 = (G & 7) ? bid : ((bid & 7) * (G >> 3) + (bid >> 3));
    const float* mv0 = p.modv; const float* mv1 = p.modv + (size_t)9 * 6144;
    (void)mv0; (void)mv1; (void)vid0;
    {
        EpiStore e1{p.Q, 1536, 2048, p.rq};
        gemm_job<true>(smem, p.cq, 512, p.wt_uq, 512, 1536, 16, 2048, 0, 128, 0, 2048, 128, 0, vid0, G, e1);
        EpiStore e2{p.Kn, 1024, 2304, p.rkv};
        gemm_job<true>(smem, p.kv, 288, p.wt_uk, 256, 1024, 18, 2304, 0, 128, 0, 2304, 144, 128 * 6, vid0, G, e2);
        EpiVt e3{p.Vt, p.rkv};
        gemm_job<false>(smem, p.kv, 288, p.wt_uv, 256, 1024, 18, 2304, 0, 128, 0, 2304, 144, 128 * 6 + 144 * 4, vid0, G, e3);
      }
    if (4 + 1 < ph1) { if (ph1 > 1000) grid.sync(); else xcd_barrier(xb); }
  }
  if (ph0 <= 5 && 5 < ph1) {
    asm volatile("" : "+s"(pp));
    CP& p = *pp;
    const int bid = get_bid();
    const int vid0 = (G & 7) ? bid : ((bid & 7) * (G >> 3) + (bid >> 3));
    const float* mv0 = p.modv; const float* mv1 = p.modv + (size_t)9 * 6144;
    (void)mv0; (void)mv1; (void)vid0;
    phase_attn(p, smem, vid0, G);
    if (5 + 1 < ph1) { if (ph1 > 1000) grid.sync(); else xcd_barrier(xb); }
  }
  if (ph0 <= 6 && 6 < ph1) {
    asm volatile("" : "+s"(pp));
    CP& p = *pp;
    const int bid = get_bid();
    const int vid0 = (G & 7) ? bid : ((bid & 7) * (G >> 3) + (bid >> 3));
    const float* mv0 = p.modv; const float* mv1 = p.modv + (size_t)9 * 6144;
    (void)mv0; (void)mv1; (void)vid0;
    {
        EpiResid e{p.X, p.x, mv0 + 2 * 1024, nullptr};
        gemm_job<true>(smem, p.hxc, 1024, p.wt_o, 1024, 1024, 16, 2048, 0, 128, 0, 2048, 128, 0, vid0, G, e);
      }
    if (6 + 1 < ph1) { if (ph1 > 1000) grid.sync(); else xcd_barrier(xb); }
  }
  if (ph0 <= 7 && 7 < ph1) {
    asm volatile("" : "+s"(pp));
    CP& p = *pp;
    const int bid = get_bid();
    const int vid0 = (G & 7) ? bid : ((bid & 7) * (G >> 3) + (bid >> 3));
    const float* mv0 = p.modv; const float* mv1 = p.modv + (size_t)9 * 6144;
    (void)mv0; (void)mv1; (void)vid0;
    phase_normmod_x(p, p.norm_ffn_g, 0, 3);
    if (7 + 1 < ph1) { if (ph1 > 1000) grid.sync(); else xcd_barrier(xb); }
  }
  if (ph0 <= 8 && 8 < ph1) {
    asm volatile("" : "+s"(pp));
    CP& p = *pp;
    const int bid = get_bid();
    const int vid0 = (G & 7) ? bid : ((bid & 7) * (G >> 3) + (bid >> 3));
    const float* mv0 = p.modv; const float* mv1 = p.modv + (size_t)9 * 6144;
    (void)mv0; (void)mv1; (void)vid0;
    {
        EpiConv<0> e{p.ffn_conv_w, p.ffn_conv_b, 5632, nullptr, p.act, nullptr};
        gemm_job<true>(smem, p.hxc, 1024, p.wt_up0, 1024, 5632, 17, 2048, 0, 126, 1, 2048, 136, 0, vid0, G, e);
      }
    if (8 + 1 < ph1) { if (ph1 > 1000) grid.sync(); else xcd_barrier(xb); }
  }
  if (ph0 <= 9 && 9 < ph1) {
    asm volatile("" : "+s"(pp));
    CP& p = *pp;
    const int bid = get_bid();
    const int vid0 = (G & 7) ? bid : ((bid & 7) * (G >> 3) + (bid >> 3));
    const float* mv0 = p.modv; const float* mv1 = p.modv + (size_t)9 * 6144;
    (void)mv0; (void)mv1; (void)vid0;
    {
        EpiResid e{p.X, p.X, mv0 + 5 * 1024, nullptr};
        gemm_job<true>(smem, p.act, 2816, p.wt_dn0, 2816, 1024, 16, 2048, 0, 128, 0, 2048, 128, 0, vid0, G, e);
      }
    if (9 + 1 < ph1) { if (ph1 > 1000) grid.sync(); else xcd_barrier(xb); }
  }
  if (ph0 <= 10 && 10 < ph1) {
    asm volatile("" : "+s"(pp));
    CP& p = *pp;
    const int bid = get_bid();
    const int vid0 = (G & 7) ? bid : ((bid & 7) * (G >> 3) + (bid >> 3));
    const float* mv0 = p.modv; const float* mv1 = p.modv + (size_t)9 * 6144;
    (void)mv0; (void)mv1; (void)vid0;
    phase_normmod_x(p, p.norm_mix_g + 1024, 1, 0);
    if (10 + 1 < ph1) { if (ph1 > 1000) grid.sync(); else xcd_barrier(xb); }
  }
  if (ph0 <= 11 && 11 < ph1) {
    asm volatile("" : "+s"(pp));
    CP& p = *pp;
    const int bid = get_bid();
    const int vid0 = (G & 7) ? bid : ((bid & 7) * (G >> 3) + (bid >> 3));
    const float* mv0 = p.modv; const float* mv1 = p.modv + (size_t)9 * 6144;
    (void)mv0; (void)mv1; (void)vid0;
    {
        EpiConv<1> e{p.hy_conv_w, p.hy_conv_b, 3072, p.hy_b_in, p.x1h, p.vvT};
        gemm_job<true>(smem, p.hxc, 1024, p.wt_hin, 1024, 3072, 17, 2048, 0, 126, 1, 2048, 136, 0, vid0, G, e);
      }
    if (11 + 1 < ph1) { if (ph1 > 1000) grid.sync(); else xcd_barrier(xb); }
  }
  if (ph0 <= 12 && 12 < ph1) {
    asm volatile("" : "+s"(pp));
    CP& p = *pp;
    const int bid = get_bid();
    const int vid0 = (G & 7) ? bid : ((bid & 7) * (G >> 3) + (bid >> 3));
    const float* mv0 = p.modv; const float* mv1 = p.modv + (size_t)9 * 6144;
    (void)mv0; (void)mv1; (void)vid0;
    phase_hyconv(p, smem);
    if (12 + 1 < ph1) { if (ph1 > 1000) grid.sync(); else xcd_barrier(xb); }
  }
  if (ph0 <= 13 && 13 < ph1) {
    asm volatile("" : "+s"(pp));
    CP& p = *pp;
    const int bid = get_bid();
    const int vid0 = (G & 7) ? bid : ((bid & 7) * (G >> 3) + (bid >> 3));
    const float* mv0 = p.modv; const float* mv1 = p.modv + (size_t)9 * 6144;
    (void)mv0; (void)mv1; (void)vid0;
    phase_transmul(p, smem);
    if (13 + 1 < ph1) { if (ph1 > 1000) grid.sync(); else xcd_barrier(xb); }
  }
  if (ph0 <= 14 && 14 < ph1) {
    asm volatile("" : "+s"(pp));
    CP& p = *pp;
    const int bid = get_bid();
    const int vid0 = (G & 7) ? bid : ((bid & 7) * (G >> 3) + (bid >> 3));
    const float* mv0 = p.modv; const float* mv1 = p.modv + (size_t)9 * 6144;
    (void)mv0; (void)mv1; (void)vid0;
    {
        EpiResid e{p.X, p.X, mv1 + 2 * 1024, p.hy_b_out};
        gemm_job<true>(smem, p.hxc, 1024, p.wt_hout, 1024, 1024, 16, 2048, 0, 128, 0, 2048, 128, 0, vid0, G, e);
      }
    if (14 + 1 < ph1) { if (ph1 > 1000) grid.sync(); else xcd_barrier(xb); }
  }
  if (ph0 <= 15 && 15 < ph1) {
    asm volatile("" : "+s"(pp));
    CP& p = *pp;
    const int bid = get_bid();
    const int vid0 = (G & 7) ? bid : ((bid & 7) * (G >> 3) + (bid >> 3));
    const float* mv0 = p.modv; const float* mv1 = p.modv + (size_t)9 * 6144;
    (void)mv0; (void)mv1; (void)vid0;
    phase_normmod_x(p, p.norm_ffn_g + 1024, 1, 3);
    if (15 + 1 < ph1) { if (ph1 > 1000) grid.sync(); else xcd_barrier(xb); }
  }
  if (ph0 <= 16 && 16 < ph1) {
    asm volatile("" : "+s"(pp));
    CP& p = *pp;
    const int bid = get_bid();
    const int vid0 = (G & 7) ? bid : ((bid & 7) * (G >> 3) + (bid >> 3));
    const float* mv0 = p.modv; const float* mv1 = p.modv + (size_t)9 * 6144;
    (void)mv0; (void)mv1; (void)vid0;
    {
        EpiConv<0> e{p.ffn_conv_w + (size_t)3 * 5632, p.ffn_conv_b + 5632, 5632, nullptr, p.act, nullptr};
        gemm_job<true>(smem, p.hxc, 1024, p.wt_up1, 1024, 5632, 17, 2048, 0, 126, 1, 2048, 136, 0, vid0, G, e);
      }
    if (16 + 1 < ph1) { if (ph1 > 1000) grid.sync(); else xcd_barrier(xb); }
  }
  if (ph0 <= 17 && 17 < ph1) {
    asm volatile("" : "+s"(pp));
    CP& p = *pp;
    const int bid = get_bid();
    const int vid0 = (G & 7) ? bid : ((bid & 7) * (G >> 3) + (bid >> 3));
    const float* mv0 = p.modv; const float* mv1 = p.modv + (size_t)9 * 6144;
    (void)mv0; (void)mv1; (void)vid0;
    {
        EpiResid e{p.X, p.X, mv1 + 5 * 1024, nullptr};
        gemm_job<true>(smem, p.act, 2816, p.wt_dn1, 2816, 1024, 16, 2048, 0, 128, 0, 2048, 128, 0, vid0, G, e);
      }
    if (17 + 1 < ph1) { if (ph1 > 1000) grid.sync(); else xcd_barrier(xb); }
  }
  if (ph0 <= 18 && 18 < ph1) {
    asm volatile("" : "+s"(pp));
    CP& p = *pp;
    const int bid = get_bid();
    const int vid0 = (G & 7) ? bid : ((bid & 7) * (G >> 3) + (bid >> 3));
    const float* mv0 = p.modv; const float* mv1 = p.modv + (size_t)9 * 6144;
    (void)mv0; (void)mv1; (void)vid0;
    phase_final_norm(p);
    if (18 + 1 < ph1) { if (ph1 > 1000) grid.sync(); else xcd_barrier(xb); }
  }
}

extern "C" void kernel_launch(void* const* d_in, const int* in_sizes, int n_in, void* d_out, int out_size, void* d_ws, size_t ws_size, hipStream_t stream) {
  static int grid_blocks = 0;
  if (!grid_blocks) {
    int dev = 0, cus = 0, per_cu = 0;
    hipGetDevice(&dev);
    hipDeviceGetAttribute(&cus, hipDeviceAttributeMultiprocessorCount, dev);
    hipOccupancyMaxActiveBlocksPerMultiprocessor(&per_cu, (const void*)mega, 256, 0);
    if (per_cu < 1) per_cu = 1;
    if (per_cu > 2) per_cu = 2;
    grid_blocks = cus * per_cu;
  }
  P p{};
  const float** in = (const float**)&p;
  for (int i = 0; i < 36; ++i) in[i] = (const float*)d_in[i];
  p.X = (float*)d_out;
  char* ws = (char*)d_ws; size_t off = 0;
  auto take = [&](size_t bytes) { char* r = ws + off; off += (bytes + 255) & ~(size_t)255; return r; };
  p.wt_dq = (bf16_t*)take((size_t)512 * 1024 * 2);
  p.wt_dkv = (bf16_t*)take((size_t)288 * 1024 * 2);
  p.wt_uq = (bf16_t*)take((size_t)1536 * 512 * 2);
  p.wt_uk = (bf16_t*)take((size_t)1024 * 256 * 2);
  p.wt_uv = (bf16_t*)take((size_t)1024 * 256 * 2);
  p.wt_o = (bf16_t*)take((size_t)1024 * 1024 * 2);
  p.wt_hin = (bf16_t*)take((size_t)3072 * 1024 * 2);
  p.wt_hout = (bf16_t*)take((size_t)1024 * 1024 * 2);
  p.wt_up0 = (bf16_t*)take((size_t)5632 * 1024 * 2);
  p.wt_up1 = (bf16_t*)take((size_t)5632 * 1024 * 2);
  p.wt_dn0 = (bf16_t*)take((size_t)1024 * 2816 * 2);
  p.wt_dn1 = (bf16_t*)take((size_t)1024 * 2816 * 2);
  p.modv = (float*)take((size_t)2 * 9 * 6144 * 4);
  p.rq = (float*)take((size_t)16384 * 4);
  p.rkv = (float*)take((size_t)18432 * 4);
  p.modp = (float*)take((size_t)4 * 110592 * 4);
  p.bar = (unsigned*)take((size_t)XCD_BAR_WORDS * 4);
  p.wt_f3 = (bf16_t*)take((size_t)2048 * 64 * 2);
  p.h2bf = (bf16_t*)take((size_t)2048 * 64 * 2);
  p.Rf = (bf16_t*)take((size_t)1024 * 4096 * 2);
  p.kpe = (bf16_t*)take((size_t)18432 * 32 * 2);
  p.hxc = (bf16_t*)take((size_t)18432 * 1024 * 2);
  const size_t ubase = off;
  p.cq = (bf16_t*)take((size_t)16384 * 512 * 2);
  p.kv = (bf16_t*)take((size_t)18432 * 288 * 2);
  p.Q = (bf16_t*)take((size_t)16384 * 1536 * 2);
  p.Kn = (bf16_t*)take((size_t)18432 * 1024 * 2);
  p.Vt = (bf16_t*)take((size_t)18432 * 1024 * 2);
  const size_t uend1 = off;
  off = ubase;
  p.act = (bf16_t*)take((size_t)16384 * 2816 * 2);
  off = ubase;
  p.x1h = (bf16_t*)take((size_t)16384 * 1024 * 2);
  p.vvT = (bf16_t*)take((size_t)16384 * 1024 * 2);
  p.Yp = (bf16_t*)take((size_t)16384 * 1024 * 2);
  if (uend1 > ws_size) { fprintf(stderr, "workspace too small: need %zu have %zu\n", uend1, ws_size); return; }
  p.ph0 = 0; p.ph1 = NPHASE;
  if (hipMemsetAsync(p.bar, 0, (size_t)XCD_BAR_WORDS * 4, stream) != hipSuccess) { fprintf(stderr, "memset failed\n"); return; }
  void* args[] = {&p};
  hipError_t e = hipLaunchCooperativeKernel((const void*)mega, dim3(grid_blocks), dim3(256), args, 0, stream);
  if (e != hipSuccess) fprintf(stderr, "cooperative launch failed: %s (grid %d)\n", hipGetErrorString(e), grid_blocks);
}
```

```cpp
#include <hip/hip_runtime.h>
#include <hip/hip_cooperative_groups.h>
#include <cstdio>
namespace cg = cooperative_groups;

typedef unsigned short bf16_t;
typedef short bf16x8 __attribute__((ext_vector_type(8)));
typedef float f32x4 __attribute__((ext_vector_type(4)));
typedef float f32x16 __attribute__((ext_vector_type(16)));

#define LDS_BYTES 73792
#define NPHASE 19

struct P {
  const float *x, *c, *ctx, *c_ctx, *mod_w, *mod_b, *norm_mix_g, *norm_ffn_g;
  const float *w_dq, *g_q, *w_uq, *w_dkv, *g_kv, *w_uk, *w_uv, *w_o;
  const float *hy_w_in, *hy_b_in, *hy_conv_w, *hy_conv_b, *f_w1, *f_b1, *f_freq1, *f_w2, *f_b2, *f_freq2, *f_w3, *hy_decay, *hy_d_bias, *hy_w_out, *hy_b_out;
  const float *ffn_w_up, *ffn_conv_w, *ffn_conv_b, *ffn_w_down, *final_g;
  float* X;
  bf16_t *wt_dq, *wt_dkv, *wt_uq, *wt_uk, *wt_uv, *wt_o, *wt_hin, *wt_hout, *wt_up0, *wt_up1, *wt_dn0, *wt_dn1;
  float *modv, *rq, *rkv, *modp;
  unsigned* bar;
  bf16_t *wt_f3, *h2bf;
  bf16_t *Rf, *kpe, *hxc, *cq, *kv, *Q, *Kn, *Vt, *act, *x1h, *vvT, *Yp;
  int ph0, ph1;
};

typedef const __attribute__((address_space(4))) P CP;
__device__ __forceinline__ int get_tid() { int t = threadIdx.x; asm volatile("" : "+v"(t)); return t; }
__device__ __forceinline__ int get_bid() { int t = blockIdx.x; asm volatile("" : "+s"(t)); return t; }

__device__ __forceinline__ unsigned pack2(float a, float b) { unsigned r; asm("v_cvt_pk_bf16_f32 %0, %1, %2" : "=v"(r) : "v"(a), "v"(b)); return r; }
__device__ __forceinline__ bf16_t f2bf(float f) { return (bf16_t)(pack2(f, f) & 0xffffu); }
__device__ __forceinline__ float bf2f(bf16_t h) { return __uint_as_float(((unsigned)h) << 16); }
__device__ __forceinline__ float wave_sum(float v) {
#pragma unroll
  for (int o = 32; o; o >>= 1) v += __shfl_xor(v, o);
  return v;
}


#define XB_TMO      128
#define XB_XCNT(j)  (256  + 64 * (j))
#define XB_XSUB(j)  (1280 + 64 * (j))
#define XB_XGEN(j)  (2304 + 64 * (j))
#define XB_TOP      3328
#define XB_TOPGEN   3392
#define XCD_BAR_WORDS 3456
#define XB_SPIN_CAP (1u << 18)
#define LAS __attribute__((address_space(3)))
__device__ __forceinline__ unsigned xb_ld(unsigned* p)              { return __hip_atomic_load(p, __ATOMIC_RELAXED, __HIP_MEMORY_SCOPE_AGENT); }
__device__ __forceinline__ unsigned xb_add(unsigned* p, unsigned v) { return __hip_atomic_fetch_add(p, v, __ATOMIC_RELAXED, __HIP_MEMORY_SCOPE_AGENT); }
__device__ __forceinline__ unsigned xb_xcc_id() { return (unsigned)__builtin_amdgcn_s_getreg((3 << 11) | 20) & 0xFu; }
#define XB_SPIN(cond, bar) do { unsigned _sp = 0; while (cond) { __builtin_amdgcn_s_sleep(1); \
    if ((++_sp & 255u) == 0u) { if (xb_ld(&(bar)[XB_TMO])) break; if (_sp > XB_SPIN_CAP) { atomicAdd(&(bar)[XB_TMO], 1u); break; } } } } while (0)
struct XcdBarrier { unsigned* bar; unsigned x; volatile LAS unsigned* st; };
__device__ __forceinline__ XcdBarrier xcd_barrier_post(unsigned* bar, volatile LAS unsigned* st) {
    XcdBarrier b; b.bar = bar; b.x = xb_xcc_id(); b.st = st;
    if (threadIdx.x == 0) (void)xb_add(&bar[XB_XCNT(b.x)], 1u);
    return b;
}
__device__ __forceinline__ void xcd_barrier_complete(unsigned* bar, unsigned x, unsigned& nloc, unsigned& nx) {
    const unsigned G = gridDim.x * gridDim.y * gridDim.z;
    unsigned sum, cnt, mine, sp = 0u;
    for (;;) {
        sum = 0u; cnt = 0u; mine = 0u;
#pragma unroll
        for (unsigned j = 0; j < 16; ++j) { const unsigned c = xb_ld(&bar[XB_XCNT(j)]); sum += c; cnt += (c > 0u) ? 1u : 0u; mine = (j == x) ? c : mine; }
        if (sum == G) break;
        __builtin_amdgcn_s_sleep(1);
        if ((++sp & 255u) == 0u) { if (xb_ld(&bar[XB_TMO])) break; if (sp > XB_SPIN_CAP) { atomicAdd(&bar[XB_TMO], 1u); break; } }
    }
    nloc = mine > 0u ? mine : 1u; nx = cnt > 0u ? cnt : 1u;
}
__device__ __forceinline__ void xcd_barrier(const XcdBarrier& b) {
    asm volatile("s_waitcnt vmcnt(0)" ::: "memory");
    __syncthreads();
    if (threadIdx.x == 0) {
        unsigned* bar = b.bar;
        __builtin_amdgcn_s_waitcnt(0);
        unsigned nloc = b.st[0], nx = b.st[1];
        if (nloc == 0u) { xcd_barrier_complete(bar, b.x, nloc, nx); b.st[0] = nloc; b.st[1] = nx; }
        const unsigned old = xb_add(&bar[XB_XSUB(b.x)], 1u);
        const unsigned gen = old / nloc;
        if (old + 1u == (gen + 1u) * nloc) {
            __builtin_amdgcn_fence(__ATOMIC_RELEASE, "agent");
            asm volatile("s_waitcnt vmcnt(0)" ::: "memory");
            const unsigned og = xb_add(&bar[XB_TOP], 1u);
            const unsigned tg = og / nx;
            if (og + 1u == (tg + 1u) * nx) xb_add(&bar[XB_TOPGEN], 1u);
            else XB_SPIN(xb_ld(&bar[XB_TOPGEN]) == tg, bar);
            __builtin_amdgcn_fence(__ATOMIC_ACQUIRE, "agent");
            xb_add(&bar[XB_XGEN(b.x)], 1u);
            asm volatile("s_waitcnt vmcnt(0)" ::: "memory");
        } else {
            XB_SPIN(xb_ld(&bar[XB_XGEN(b.x)]) == gen, bar);
            __builtin_amdgcn_fence(__ATOMIC_ACQUIRE, "agent");
            asm volatile("s_waitcnt vmcnt(0)" ::: "memory");
        }
    }
    __syncthreads();
}

__device__ __forceinline__ void prep_weight_tile(CP& p, char* smem, int wt) {
  const int tid = get_tid();
  int id = 0;
  {
    const int cnt[13] = {128, 80, 192, 64, 64, 256, 768, 256, 1408, 1408, 704, 704, 32};
#pragma unroll
    for (int i = 0; i < 12; ++i) { if (id == i && wt >= cnt[i]) { wt -= cnt[i]; id = i + 1; } }
  }
  const float* src; int K, N; bf16_t* dst; const float* scale = nullptr; int perm = 0;
  switch (id) {
    case 0: src = p.w_dq; K = 1024; N = 512; dst = p.wt_dq; break;
    case 1: src = p.w_dkv; K = 1024; N = 288; dst = p.wt_dkv; break;
    case 2: src = p.w_uq; K = 512; N = 1536; dst = p.wt_uq; scale = p.g_q; break;
    case 3: src = p.w_uk; K = 256; N = 1024; dst = p.wt_uk; scale = p.g_kv; break;
    case 4: src = p.w_uv; K = 256; N = 1024; dst = p.wt_uv; scale = p.g_kv; break;
    case 5: src = p.w_o; K = 1024; N = 1024; dst = p.wt_o; break;
    case 6: src = p.hy_w_in; K = 1024; N = 3072; dst = p.wt_hin; perm = 2; break;
    case 7: src = p.hy_w_out; K = 1024; N = 1024; dst = p.wt_hout; break;
    case 8: src = p.ffn_w_up; K = 1024; N = 5632; dst = p.wt_up0; perm = 1; break;
    case 9: src = p.ffn_w_up + (size_t)1024 * 5632; K = 1024; N = 5632; dst = p.wt_up1; perm = 1; break;
    case 10: src = p.ffn_w_down; K = 2816; N = 1024; dst = p.wt_dn0; break;
    case 11: src = p.ffn_w_down + (size_t)2816 * 1024; K = 2816; N = 1024; dst = p.wt_dn1; break;
    default: src = p.f_w3; K = 64; N = 2048; dst = p.wt_f3; break;
  }
  const int ntn = (N + 63) >> 6;
  const int kt = wt / ntn, nt = wt - kt * ntn;
  const int k0 = kt * 64, n0 = nt * 64;
  int np0;
  if (perm == 1) { const int half = n0 / 2816, f = n0 - half * 2816; np0 = (f >> 6) * 128 + half * 64; }
  else if (perm == 2) { if (n0 < 1024) np0 = n0; else { const int m = n0 - 1024, half = m >> 10, f = m & 1023; np0 = 1024 + (f >> 6) * 128 + half * 64; } }
  else np0 = n0;
  bf16_t* t16 = (bf16_t*)smem;
  f32x4 v[4];
#pragma unroll
  for (int i = 0; i < 4; ++i) {
    const int idx = tid + 256 * i; const int kr = idx >> 4, c4 = idx & 15;
    v[i] = (f32x4){0.f, 0.f, 0.f, 0.f};
    if (n0 + 4 * c4 < N) v[i] = *(const f32x4*)(src + (size_t)(k0 + kr) * N + n0 + 4 * c4);
  }
#pragma unroll
  for (int i = 0; i < 4; ++i) {
    const int idx = tid + 256 * i; const int kr = idx >> 4, c4 = idx & 15;
    const float sc = scale ? scale[k0 + kr] : 1.f;
#pragma unroll
    for (int j = 0; j < 4; ++j) t16[(4 * c4 + j) * 72 + kr] = f2bf(v[i][j] * sc);
  }
  __syncthreads();
#pragma unroll
  for (int i = 0; i < 2; ++i) {
    const int idx = tid + 256 * i; const int n = idx >> 3, ch = idx & 7;
    if (n0 + n < N) *(uint4*)(dst + (size_t)(np0 + n) * K + k0 + ch * 8) = *(const uint4*)(t16 + n * 72 + ch * 8);
  }
  __syncthreads();
}

__device__ __forceinline__ void prep_modvec(CP& p, char* smem, int it) {
  const int tid = get_tid();
  const int layer = it / 384, rem = it - layer * 384, cb = rem >> 2, ks = rem & 3;
  float* s_lds = (float*)smem;
  float* red = (float*)(smem + 12288);
  const int kbase = ks * 256;
  for (int idx = tid; idx < 9 * 256; idx += 256) {
    const int r = idx >> 8, k = idx & 255;
    const float v = r < 8 ? p.c[r * 1024 + kbase + k] : p.c_ctx[kbase + k];
    s_lds[k * 12 + r] = v / (1.f + __expf(-v));
  }
  __syncthreads();
  const int col = cb * 64 + (tid & 63), kg = tid >> 6;
  const float* W = p.mod_w + (size_t)layer * 1024 * 6144 + (size_t)kbase * 6144 + col;
  float acc[9];
#pragma unroll
  for (int r = 0; r < 9; ++r) acc[r] = 0.f;
#pragma unroll
  for (int kb = 0; kb < 4; ++kb) {
    float w[16];
#pragma unroll
    for (int u = 0; u < 16; ++u) w[u] = W[(size_t)(kg * 64 + kb * 16 + u) * 6144];
#pragma unroll
    for (int u = 0; u < 16; ++u) {
      const int k = kg * 64 + kb * 16 + u;
      const f32x4 s0 = *(const f32x4*)(s_lds + k * 12), s1 = *(const f32x4*)(s_lds + k * 12 + 4);
      const float s2 = s_lds[k * 12 + 8];
      acc[0] += s0[0] * w[u]; acc[1] += s0[1] * w[u]; acc[2] += s0[2] * w[u]; acc[3] += s0[3] * w[u];
      acc[4] += s1[0] * w[u]; acc[5] += s1[1] * w[u]; acc[6] += s1[2] * w[u]; acc[7] += s1[3] * w[u];
      acc[8] += s2 * w[u];
    }
  }
#pragma unroll
  for (int r = 0; r < 9; ++r) red[(kg * 9 + r) * 64 + (tid & 63)] = acc[r];
  __syncthreads();
  for (int o = tid; o < 9 * 64; o += 256) {
    const int r = o >> 6, cl = o & 63;
    const float sm = red[(0 * 9 + r) * 64 + cl] + red[(1 * 9 + r) * 64 + cl] + red[(2 * 9 + r) * 64 + cl] + red[(3 * 9 + r) * 64 + cl];
    p.modp[(size_t)ks * 110592 + (size_t)(layer * 9 + r) * 6144 + cb * 64 + cl] = sm;
  }
  __syncthreads();
}

__device__ __forceinline__ void prep_filter(CP& p, char* smem, int it) {
  const int tid = get_tid();
  float* z = (float*)smem;
  float* h1 = z + 8 * 33;
  float* h2 = h1 + 8 * 64;
  const int t0 = it * 8;
  for (int idx = tid; idx < 8 * 33; idx += 256) {
    const int pp = idx / 33, i = idx - pp * 33;
    const int t = t0 + pp;
    float v;
    if (i == 0) v = (float)t * (1.0f / 2047.0f);
    else {
      const int k = (i - 1) & 15;
      const float w = (6.283185307179586f * (float)t) / 2048.0f;
      const float f = 1e-4f + (float)k * ((15.0f - 1e-4f) / 15.0f);
      const float a = w * f;
      v = (i <= 16) ? __cosf(a) : -__sinf(a);
    }
    z[idx] = v;
  }
  __syncthreads();
  for (int idx = tid; idx < 8 * 64; idx += 256) {
    const int pp = idx >> 6, j = idx & 63;
    float s = p.f_b1[j];
#pragma unroll
    for (int i = 0; i < 33; ++i) s += z[pp * 33 + i] * p.f_w1[i * 64 + j];
    h1[idx] = __sinf(p.f_freq1[j] * s);
  }
  __syncthreads();
  for (int idx = tid; idx < 8 * 64; idx += 256) {
    const int pp = idx >> 6, j = idx & 63;
    float s = p.f_b2[j];
#pragma unroll 16
    for (int i = 0; i < 64; ++i) s += h1[pp * 64 + i] * p.f_w2[i * 64 + j];
    h2[idx] = __sinf(p.f_freq2[j] * s);
  }
  __syncthreads();
  for (int idx = tid; idx < 8 * 64; idx += 256) p.h2bf[(size_t)t0 * 64 + idx] = f2bf(h2[idx]);
  __syncthreads();
}

__device__ __forceinline__ void phase_prep(CP& p, char* smem) {
  const int total = 768 + 256 + 6064;
  for (int it = get_bid(); it < total; it += gridDim.x) {
    if (it < 768) prep_modvec(p, smem, it);
    else if (it < 1024) prep_filter(p, smem, it - 768);
    else prep_weight_tile(p, smem, it - 1024);
  }
}

template <bool PART>
__device__ __forceinline__ void normmod_row2(const float* __restrict__ src, const float* __restrict__ g, const float* __restrict__ sh, const float* __restrict__ sc, bf16_t* __restrict__ dst, int lane, const float* __restrict__ bsh = nullptr) {
  f32x4 v[2][4]; float ss0 = 0.f, ss1 = 0.f;
#pragma unroll
  for (int i = 0; i < 4; ++i) { v[0][i] = *(const f32x4*)(src + lane * 4 + 256 * i); v[1][i] = *(const f32x4*)(src + 1024 + lane * 4 + 256 * i); }
#pragma unroll
  for (int i = 0; i < 4; ++i) {
    ss0 += v[0][i][0] * v[0][i][0] + v[0][i][1] * v[0][i][1] + v[0][i][2] * v[0][i][2] + v[0][i][3] * v[0][i][3];
    ss1 += v[1][i][0] * v[1][i][0] + v[1][i][1] * v[1][i][1] + v[1][i][2] * v[1][i][2] + v[1][i][3] * v[1][i][3];
  }
  ss0 = wave_sum(ss0); ss1 = wave_sum(ss1);
  const float r0 = rsqrtf(ss0 * (1.0f / 1024.0f) + 1e-6f), r1 = rsqrtf(ss1 * (1.0f / 1024.0f) + 1e-6f);
#pragma unroll
  for (int i = 0; i < 4; ++i) {
    const int k = lane * 4 + 256 * i;
    const f32x4 g4 = *(const f32x4*)(g + k);
    f32x4 s4 = *(const f32x4*)(sh + k), c4 = *(const f32x4*)(sc + k);
    if (PART) {
#pragma unroll
      for (int q = 1; q < 4; ++q) { s4 += *(const f32x4*)(sh + (size_t)q * 110592 + k); c4 += *(const f32x4*)(sc + (size_t)q * 110592 + k); }
      s4 += *(const f32x4*)(bsh + k); c4 += *(const f32x4*)(bsh + 1024 + k);
    }
    float y[4], z[4];
#pragma unroll
    for (int j = 0; j < 4; ++j) { const float gm = g4[j] * (1.f + c4[j]); y[j] = (v[0][i][j] * r0) * gm + s4[j]; z[j] = (v[1][i][j] * r1) * gm + s4[j]; }
    uint2 u; u.x = pack2(y[0], y[1]); u.y = pack2(y[2], y[3]);
    *(uint2*)(dst + k) = u;
    u.x = pack2(z[0], z[1]); u.y = pack2(z[2], z[3]);
    *(uint2*)(dst + 1024 + k) = u;
  }
}

__device__ __forceinline__ void phase_normmod_kv(CP& p) {
  const int lane = get_tid() & 63, wv = get_tid() >> 6;
  const float* g = p.norm_mix_g;
  for (int idx = get_bid() * 256 + get_tid(); idx < 110592; idx += gridDim.x * 256) {
    const int lr = idx / 6144; const int n = idx - lr * 6144; const int layer = lr / 9;
    p.modv[idx] = p.modp[idx] + p.modp[110592 + idx] + p.modp[2 * 110592 + idx] + p.modp[3 * 110592 + idx] + p.mod_b[layer * 6144 + n];
  }
  for (int r = (get_bid() * 4 + wv) * 2; r < 18432; r += gridDim.x * 8) {
    const int b = r / 2304, pp = r - b * 2304;
    const float* src; const float* mv;
    if (pp < 256) { src = p.ctx + ((size_t)b * 256 + pp) * 1024; mv = p.modp + (size_t)8 * 6144; }
    else { src = p.x + ((size_t)b * 2048 + pp - 256) * 1024; mv = p.modp + (size_t)b * 6144; }
    normmod_row2<true>(src, g, mv, mv + 1024, p.hxc + (size_t)r * 1024, lane, p.mod_b);
  }
}
__device__ __forceinline__ void phase_normmod_x(CP& p, const float* g, int layer, int chunk) {
  const int lane = get_tid() & 63, wv = get_tid() >> 6;
  for (int r = (get_bid() * 4 + wv) * 2; r < 16384; r += gridDim.x * 8) {
    const int b = r >> 11;
    const float* mv = p.modv + (size_t)(layer * 9 + b) * 6144 + chunk * 1024;
    normmod_row2<false>(p.X + (size_t)r * 1024, g, mv, mv + 1024, p.hxc + (size_t)r * 1024, lane);
  }
}
__device__ __forceinline__ void phase_final_norm(CP& p) {
  const int lane = get_tid() & 63, wv = get_tid() >> 6;
  for (int r = get_bid() * 4 + wv; r < 16384; r += gridDim.x * 4) {
    float* row = p.X + (size_t)r * 1024;
    f32x4 v[4]; float ss = 0.f;
#pragma unroll
    for (int i = 0; i < 4; ++i) { v[i] = *(const f32x4*)(row + lane * 4 + 256 * i); ss += v[i][0] * v[i][0] + v[i][1] * v[i][1] + v[i][2] * v[i][2] + v[i][3] * v[i][3]; }
    ss = wave_sum(ss);
    const float rr = rsqrtf(ss * (1.0f / 1024.0f) + 1e-6f);
#pragma unroll
    for (int i = 0; i < 4; ++i) {
      const int k = lane * 4 + 256 * i;
      const f32x4 g4 = *(const f32x4*)(p.final_g + k);
      f32x4 o; o[0] = v[i][0] * rr * g4[0]; o[1] = v[i][1] * rr * g4[1]; o[2] = v[i][2] * rr * g4[2]; o[3] = v[i][3] * rr * g4[3];
      *(f32x4*)(row + k) = o;
    }
  }
}

__device__ __forceinline__ void phase_rowstat(CP& p) {
  const int lane = get_tid() & 63, wv = get_tid() >> 6;
  for (int r = get_bid() * 4 + wv; r < 18432; r += gridDim.x * 4) {
    const int b = r / 2304, pp = r - b * 2304;
    const bf16_t* kvr = p.kv + (size_t)r * 288;
    {
      const uint2 u = *(const uint2*)(kvr + lane * 4);
      const float a0 = bf2f((bf16_t)(u.x & 0xffff)), a1 = bf2f((bf16_t)(u.x >> 16)), a2 = bf2f((bf16_t)(u.y & 0xffff)), a3 = bf2f((bf16_t)(u.y >> 16));
      float ss = a0 * a0 + a1 * a1 + a2 * a2 + a3 * a3;
      ss = wave_sum(ss);
      if (lane == 0) p.rkv[r] = rsqrtf(ss * (1.0f / 256.0f) + 1e-6f);
    }
    {
      const int i = lane & 31;
      const float xv = bf2f(kvr[256 + i]);
      const float ov = __shfl_xor(xv, 8);
      float res = xv;
      if (pp >= 256) {
        const int t = pp - 256;
        const int quarter = i >> 3, idx = i & 7;
        const float pos = (quarter < 2) ? (float)(t >> 6) : (float)(t & 63);
        const float inv = exp2f(-(float)idx * (13.287712379549449f / 8.0f));
        const float ang = pos * inv;
        const float cs = __cosf(ang), sn = __sinf(ang);
        res = xv * cs + ((quarter & 1) ? ov : -ov) * sn;
      }
      if (lane < 32) p.kpe[(size_t)r * 32 + i] = f2bf(res);
    }
    if (pp >= 256) {
      const int xr = b * 2048 + pp - 256;
      const uint4 u = *(const uint4*)(p.cq + (size_t)xr * 512 + lane * 8);
      const unsigned uu[4] = {u.x, u.y, u.z, u.w};
      float ss = 0.f;
#pragma unroll
      for (int j = 0; j < 4; ++j) { const float a = bf2f((bf16_t)(uu[j] & 0xffff)), bb = bf2f((bf16_t)(uu[j] >> 16)); ss += a * a + bb * bb; }
      ss = wave_sum(ss);
      if (lane == 0) p.rq[xr] = rsqrtf(ss * (1.0f / 512.0f) + 1e-6f);
    }
  }
}

struct EpiStore {
  static constexpr int KIND = 0;
  bf16_t* out; int ld; int ostride; const float* rs;
  __device__ __forceinline__ void c4(int g, int rig, int col, f32x4 v) const {
    const size_t row = (size_t)g * ostride + rig;
    const float s = rs ? rs[row] : 1.f;
    uint2 u; u.x = pack2(v[0] * s, v[1] * s); u.y = pack2(v[2] * s, v[3] * s);
    *(uint2*)(out + row * ld + col) = u;
  }
};
struct EpiVt {
  static constexpr int KIND = 1;
  bf16_t* out; const float* rs;
  __device__ __forceinline__ void r4(int g, int rig, int col, f32x4 v) const {
    const size_t row = (size_t)g * 2304 + rig;
    const f32x4 s = *(const f32x4*)(rs + row);
    uint2 u; u.x = pack2(v[0] * s[0], v[1] * s[1]); u.y = pack2(v[2] * s[2], v[3] * s[3]);
    *(uint2*)(out + ((size_t)g * 1024 + col) * 2304 + rig) = u;
  }
};
struct EpiFilt {
  static constexpr int KIND = 1;
  bf16_t* Rf; const float* decay;
  __device__ __forceinline__ void r4(int g, int rig, int col, f32x4 v) const {
    const int c = col & 1023; const bool bwd = col >= 1024;
    const float dec = fabsf(decay[c]);
    bf16_t* rp = Rf + (size_t)c * 4096;
#pragma unroll
    for (int j = 0; j < 4; ++j) {
      const int t = rig + j;
      const float val = v[j] * __expf(-(float)t * (1.0f / 2047.0f) * dec);
      if (!bwd) rp[2048 - t] = f2bf(val);
      else if (t > 0) rp[2048 + t] = f2bf(val);
      else rp[0] = 0;
    }
  }
};
struct EpiResid {
  static constexpr int KIND = 0;
  float* X; const float* base; const float* gate; const float* bias;
  __device__ __forceinline__ void c4(int g, int rig, int col, f32x4 v) const {
    const size_t o = ((size_t)g * 2048 + rig) * 1024 + col;
    const f32x4 bs = *(const f32x4*)(base + o);
    const f32x4 gt = *(const f32x4*)(gate + (size_t)g * 6144 + col);
    f32x4 bi = {0.f, 0.f, 0.f, 0.f};
    if (bias) bi = *(const f32x4*)(bias + col);
    f32x4 r;
#pragma unroll
    for (int j = 0; j < 4; ++j) r[j] = bs[j] + gt[j] * (v[j] + bi[j]);
    *(f32x4*)(X + o) = r;
  }
};
template <int MODE>
struct EpiConv {
  static constexpr int KIND = 2;
  const float* cw; const float* cb; int NC; const float* pre_bias;
  bf16_t* o0; bf16_t* o1;
  __device__ __forceinline__ int norig(int nt, int cl) const {
    if (MODE == 0) return (cl >> 6) * 2816 + nt * 64 + (cl & 63);
    if (nt < 8) return nt * 128 + cl;
    return 1024 + (cl >> 6) * 1024 + (nt - 8) * 64 + (cl & 63);
  }
  __device__ __forceinline__ void finish(const float* Z, int g, int rig0, int nt) const {
    const int tid = get_tid();
    if (MODE == 0 || nt < 8) {
      const int f = tid & 63, q = tid >> 6;
      const int p0 = 1 + 32 * q, p1 = (p0 + 32 < 127) ? p0 + 32 : 127;
      if (MODE == 0) {
        const int na = norig(nt, f), ng = norig(nt, 64 + f);
        const float a0 = cw[na], a1 = cw[NC + na], a2 = cw[2 * NC + na], ab = cb[na];
        const float g0 = cw[ng], g1 = cw[NC + ng], g2 = cw[2 * NC + ng], gb = cb[ng];
        float am = Z[(p0 - 1) * 132 + f], ac = Z[p0 * 132 + f], gm = Z[(p0 - 1) * 132 + 64 + f], gc = Z[p0 * 132 + 64 + f];
#pragma unroll 2
        for (int pl = p0; pl < p1; ++pl) {
          const float an = Z[(pl + 1) * 132 + f], gn = Z[(pl + 1) * 132 + 64 + f];
          const int pos = rig0 + pl;
          if (pos < 2048) {
            const float av = a0 * am + a1 * ac + a2 * an + ab;
            const float gv = g0 * gm + g1 * gc + g2 * gn + gb;
            o0[((size_t)g * 2048 + pos) * 2816 + nt * 64 + f] = f2bf(av * gv / (1.f + __expf(-gv)));
          }
          am = ac; ac = an; gm = gc; gc = gn;
        }
      } else {
#pragma unroll
        for (int fh = 0; fh < 2; ++fh) {
          const int cl = fh * 64 + f;
          const int na = norig(nt, cl);
          const float a0 = cw[na], a1 = cw[NC + na], a2 = cw[2 * NC + na], ab = cb[na];
          float am = Z[(p0 - 1) * 132 + cl], ac = Z[p0 * 132 + cl];
#pragma unroll 2
          for (int pl = p0; pl < p1; ++pl) {
            const float an = Z[(pl + 1) * 132 + cl];
            const int pos = rig0 + pl;
            if (pos < 2048) o0[((size_t)g * 2048 + pos) * 1024 + nt * 128 + cl] = f2bf(a0 * am + a1 * ac + a2 * an + ab);
            am = ac; ac = an;
          }
        }
      }
    } else {
      const int pl = tid & 127, fh = tid >> 7;
      const int pos = rig0 + pl;
      if (pl >= 1 && pl <= 126 && pos < 2048) {
        const int fb = nt - 8;
#pragma unroll 2
        for (int f = fh * 32; f < fh * 32 + 32; ++f) {
          const int na = norig(nt, f), nb = norig(nt, 64 + f);
          const float va = cw[na] * Z[(pl - 1) * 132 + f] + cw[NC + na] * Z[pl * 132 + f] + cw[2 * NC + na] * Z[(pl + 1) * 132 + f] + cb[na];
          const float vb = cw[nb] * Z[(pl - 1) * 132 + 64 + f] + cw[NC + nb] * Z[pl * 132 + 64 + f] + cw[2 * NC + nb] * Z[(pl + 1) * 132 + 64 + f] + cb[nb];
          o1[(size_t)(fb * 64 + f) * 16384 + g * 2048 + pos] = f2bf(va * vb);
        }
      }
    }
  }
};

#define GLDS16(gp, lp) __builtin_amdgcn_global_load_lds((const unsigned*)(gp), (__attribute__((address_space(3))) unsigned*)(lp), 16, 0, 0)

template <bool SWAP, class Epi>
__device__ __forceinline__ void gemm_job(char* smem, const bf16_t* __restrict__ A, int lda, const bf16_t* __restrict__ Bt, int K, int N,
                                         int tpg, int a_gstride, int a_goff, int step, int halo, int grows, int MT, int voff, int vid0, int grid, const Epi& epi) {
  const int tid = get_tid(), lane = tid & 63, wid = tid >> 6, wr = wid >> 1, wc = wid & 1, fr = lane & 15, fq = lane >> 4;
  const int NT = (N + 255) >> 8, ntiles = MT * NT, nk = K >> 5;
  int v = vid0;
  if (v < voff) v += ((voff - v + grid - 1) / grid) * grid;
  const int rdoff = ((fq ^ ((fr >> 2) & 3)) << 4);
  for (; v < voff + ntiles; v += grid) {
    const int w = v - voff;
    const int sr = w / (8 * NT), rem = w - sr * 8 * NT;
    const int nt = rem >> 3, mt = sr * 8 + (rem & 7);
    const int g = mt / tpg, ti = mt - g * tpg;
    const int rig0 = ti * step - halo;
    unsigned ap[2], bp[4];
#pragma unroll
    for (int i = 0; i < 4; ++i) {
      const int b = tid * 16 + i * 4096;
      const int r = b >> 6;
      const int cs = (b & 63) >> 4;
      const int c = ((cs ^ ((r >> 2) & 3)) << 3);
      if (i < 2) {
        int rig = rig0 + r; rig = rig < 0 ? 0 : (rig > grows - 1 ? grows - 1 : rig);
        ap[i] = (unsigned)((g * a_gstride + a_goff + rig) * lda + c);
      }
      int br = nt * 256 + r; br = br > N - 1 ? N - 1 : br;
      bp[i] = (unsigned)(br * K + c);
    }
    f32x4 acc[4][8];
#pragma unroll
    for (int m = 0; m < 4; ++m)
#pragma unroll
      for (int n = 0; n < 8; ++n) acc[m][n] = (f32x4){0.f, 0.f, 0.f, 0.f};
#pragma unroll
    for (int st = 0; st < 2; ++st) {
      if (st < nk) {
        char* nb = smem + st * 24576;
#pragma unroll
        for (int i = 0; i < 2; ++i) GLDS16(A + (size_t)(ap[i] + st * 32), nb + tid * 16 + i * 4096);
#pragma unroll
        for (int i = 0; i < 4; ++i) GLDS16(Bt + (size_t)(bp[i] + st * 32), nb + 8192 + tid * 16 + i * 4096);
      }
    }
    int cur = 0;
    for (int t = 0; t < nk; ++t) {
      if (t + 1 < nk) asm volatile("s_waitcnt vmcnt(6)" ::: "memory");
      else asm volatile("s_waitcnt vmcnt(0)" ::: "memory");
      __builtin_amdgcn_s_barrier();
      asm volatile("" ::: "memory");
      if (t + 2 < nk) {
        int nbi = cur + 2; nbi = nbi >= 3 ? nbi - 3 : nbi;
        char* nb = smem + nbi * 24576;
        const int ko = (t + 2) * 32;
#pragma unroll
        for (int i = 0; i < 2; ++i) GLDS16(A + (size_t)(ap[i] + ko), nb + tid * 16 + i * 4096);
#pragma unroll
        for (int i = 0; i < 4; ++i) GLDS16(Bt + (size_t)(bp[i] + ko), nb + 8192 + tid * 16 + i * 4096);
      }
      const char* sa = smem + cur * 24576; const char* sb = sa + 8192;
      cur = cur == 2 ? 0 : cur + 1;
      bf16x8 af[4];
#pragma unroll
      for (int m = 0; m < 4; ++m) af[m] = *(const bf16x8*)(sa + (wr * 64 + m * 16 + fr) * 64 + rdoff);
#pragma unroll
      for (int nh = 0; nh < 4; ++nh) {
        bf16x8 bf[2];
#pragma unroll
        for (int n = 0; n < 2; ++n) bf[n] = *(const bf16x8*)(sb + (wc * 128 + (nh * 2 + n) * 16 + fr) * 64 + rdoff);
#pragma unroll
        for (int m = 0; m < 4; ++m)
#pragma unroll
          for (int n = 0; n < 2; ++n)
            acc[m][nh * 2 + n] = SWAP ? __builtin_amdgcn_mfma_f32_16x16x32_bf16(bf[n], af[m], acc[m][nh * 2 + n], 0, 0, 0)
                                      : __builtin_amdgcn_mfma_f32_16x16x32_bf16(af[m], bf[n], acc[m][nh * 2 + n], 0, 0, 0);
      }
    }
    __syncthreads();
    if constexpr (Epi::KIND == 0) {
#pragma unroll
      for (int m = 0; m < 4; ++m) {
        const int rig = rig0 + wr * 64 + m * 16 + fr;
#pragma unroll
        for (int n = 0; n < 8; ++n) {
          const int col = nt * 256 + wc * 128 + n * 16 + fq * 4;
          if (col < N) epi.c4(g, rig, col, acc[m][n]);
        }
      }
    } else if constexpr (Epi::KIND == 1) {
#pragma unroll
      for (int m = 0; m < 4; ++m) {
        const int rig = rig0 + wr * 64 + m * 16 + fq * 4;
#pragma unroll
        for (int n = 0; n < 8; ++n) {
          const int col = nt * 256 + wc * 128 + n * 16 + fr;
          if (col < N) epi.r4(g, rig, col, acc[m][n]);
        }
      }
    } else {
      float* Z = (float*)smem;
#pragma unroll
      for (int h = 0; h < 2; ++h) {
        const int nt2 = nt * 2 + h;
        if (wc == h) {
#pragma unroll
          for (int n = 0; n < 8; ++n) {
            const int cl = n * 16 + fq * 4;
            f32x4 b4 = {0.f, 0.f, 0.f, 0.f};
            if (epi.pre_bias) b4 = *(const f32x4*)(epi.pre_bias + epi.norig(nt2, cl));
#pragma unroll
            for (int m = 0; m < 4; ++m) {
              const int rl = wr * 64 + m * 16 + fr;
              const int pos = rig0 + rl;
              const bool ok = pos >= 0 && pos < grows;
              f32x4 vv = acc[m][n] + b4;
              if (!ok) vv = (f32x4){0.f, 0.f, 0.f, 0.f};
              *(f32x4*)(Z + rl * 132 + cl) = vv;
            }
          }
        }
        __syncthreads();
        epi.finish(Z, g, rig0, nt2);
        __syncthreads();
      }
    }
    asm volatile("s_waitcnt vmcnt(0)" ::: "memory");
    __syncthreads();
  }
}

__device__ __forceinline__ void phase_attn(CP& p, char* smem, int vid0, int grid) {
  bf16_t* Ks = (bf16_t*)smem;
  bf16_t* Vs = (bf16_t*)(smem + 64 * 104 * 2);
  const int tid = get_tid(), lane = tid & 63, w = tid >> 6, r = lane & 31, hh = lane >> 5;
  const float cs = 1.4426950408889634f * 0.10206207261596577f;
  for (int it = vid0; it < 2048; it += grid) {
    const int qt = it & 15, h = (it >> 4) & 15, b = it >> 8;
    const int t = qt * 128 + w * 32 + r;
    const size_t xrow = (size_t)b * 2048 + t;
    const bf16_t* qp = p.Q + xrow * 1536 + h * 96;
    bf16x8 qf[6];
#pragma unroll
    for (int kk = 0; kk < 4; ++kk) qf[kk] = *(const bf16x8*)(qp + 16 * kk + 8 * hh);
#pragma unroll
    for (int part = 0; part < 2; ++part) {
      const bf16_t* pp = qp + 64 + 16 * part;
      const bf16x8 mine = *(const bf16x8*)(pp + 8 * hh), oth = *(const bf16x8*)(pp + 8 * (1 - hh));
      const float posf = part == 0 ? (float)(t >> 6) : (float)(t & 63);
      union { unsigned u[4]; bf16x8 v; } o;
      float res[8];
#pragma unroll
      for (int j = 0; j < 8; ++j) {
        const float inv = exp2f(-(float)j * (13.287712379549449f / 8.0f));
        const float ang = posf * inv;
        const float c = __cosf(ang), s = __sinf(ang);
        const float m = bf2f((bf16_t)mine[j]), ov = bf2f((bf16_t)oth[j]);
        res[j] = m * c + (hh ? ov : -ov) * s;
      }
#pragma unroll
      for (int j = 0; j < 4; ++j) o.u[j] = pack2(res[2 * j], res[2 * j + 1]);
      qf[4 + part] = o.v;
    }
    f32x16 oacc[2];
#pragma unroll
    for (int i = 0; i < 16; ++i) { oacc[0][i] = 0.f; oacc[1][i] = 0.f; }
    float mrun = -INFINITY, lrun = 0.f;
    const size_t kvrow0 = (size_t)b * 2304;
    const bf16_t* kn_base = p.Kn + kvrow0 * 1024 + h * 64;
    const bf16_t* kpe_base = p.kpe + kvrow0 * 32;
    const bf16_t* vt_base = p.Vt + ((size_t)(b * 16 + h) * 64) * 2304;
    uint4 rk0, rk1, rp, rv0, rv1;
    const int srow = tid >> 3, sch = tid & 7;
#define ATT_GLOAD(kt) do { \
      rk0 = *(const uint4*)(kn_base + (size_t)((kt) * 64 + srow) * 1024 + sch * 8); \
      rk1 = *(const uint4*)(kn_base + (size_t)((kt) * 64 + srow + 32) * 1024 + sch * 8); \
      rv0 = *(const uint4*)(vt_base + (size_t)srow * 2304 + (kt) * 64 + sch * 8); \
      rv1 = *(const uint4*)(vt_base + (size_t)(srow + 32) * 2304 + (kt) * 64 + sch * 8); \
      rp = *(const uint4*)(kpe_base + (size_t)((kt) * 64 + (tid >> 2)) * 32 + (tid & 3) * 8); } while (0)
    ATT_GLOAD(0);
    for (int kt = 0; kt < 36; ++kt) {
      __syncthreads();
      {
        *(uint4*)(Ks + srow * 104 + sch * 8) = rk0;
        *(uint4*)(Ks + (srow + 32) * 104 + sch * 8) = rk1;
        uint2 lo, hi;
        lo.x = rv0.x; lo.y = rv0.y; hi.x = rv0.z; hi.y = rv0.w;
        *(uint2*)(Vs + srow * 68 + sch * 8) = lo; *(uint2*)(Vs + srow * 68 + sch * 8 + 4) = hi;
        lo.x = rv1.x; lo.y = rv1.y; hi.x = rv1.z; hi.y = rv1.w;
        *(uint2*)(Vs + (srow + 32) * 68 + sch * 8) = lo; *(uint2*)(Vs + (srow + 32) * 68 + sch * 8 + 4) = hi;
      }
      *(uint4*)(Ks + (tid >> 2) * 104 + 64 + (tid & 3) * 8) = rp;
      __syncthreads();
      if (kt + 1 < 36) ATT_GLOAD(kt + 1);
      f32x16 s[2];
#pragma unroll
      for (int t2 = 0; t2 < 2; ++t2) {
#pragma unroll
        for (int i = 0; i < 16; ++i) s[t2][i] = 0.f;
#pragma unroll
        for (int kk = 0; kk < 6; ++kk) {
          const bf16x8 a = *(const bf16x8*)(Ks + (32 * t2 + r) * 104 + 16 * kk + 8 * hh);
          s[t2] = __builtin_amdgcn_mfma_f32_32x32x16_bf16(a, qf[kk], s[t2], 0, 0, 0);
        }
      }
      float mx = s[0][0];
#pragma unroll
      for (int i = 1; i < 16; ++i) mx = fmaxf(mx, s[0][i]);
#pragma unroll
      for (int i = 0; i < 16; ++i) mx = fmaxf(mx, s[1][i]);
      mx = fmaxf(mx, __shfl_xor(mx, 32));
      const float mnew = fmaxf(mrun, mx * cs);
      const float alpha = __builtin_amdgcn_exp2f(mrun - mnew);
      mrun = mnew;
      float psum = 0.f;
      bf16x8 pf[4];
#pragma unroll
      for (int t2 = 0; t2 < 2; ++t2)
#pragma unroll
        for (int hf = 0; hf < 2; ++hf) {
          union { unsigned u[4]; bf16x8 v; } cvp;
#pragma unroll
          for (int i = 0; i < 4; ++i) {
            const float p0 = __builtin_amdgcn_exp2f(s[t2][hf * 8 + 2 * i] * cs - mnew);
            const float p1 = __builtin_amdgcn_exp2f(s[t2][hf * 8 + 2 * i + 1] * cs - mnew);
            psum += p0 + p1;
            cvp.u[i] = pack2(p0, p1);
          }
          pf[t2 * 2 + hf] = cvp.v;
        }
      lrun = lrun * alpha + psum;
#pragma unroll
      for (int i = 0; i < 16; ++i) { oacc[0][i] *= alpha; oacc[1][i] *= alpha; }
#pragma unroll
      for (int dt = 0; dt < 2; ++dt)
#pragma unroll
        for (int s4 = 0; s4 < 4; ++s4) {
          const bf16_t* vp = Vs + (32 * dt + r) * 68 + 16 * s4 + 4 * hh;
          const uint2 lo = *(const uint2*)vp, hi = *(const uint2*)(vp + 8);
          union { uint4 u; bf16x8 v; } cv; cv.u.x = lo.x; cv.u.y = lo.y; cv.u.z = hi.x; cv.u.w = hi.y;
          oacc[dt] = __builtin_amdgcn_mfma_f32_32x32x16_bf16(cv.v, pf[s4], oacc[dt], 0, 0, 0);
        }
    }
    const float ltot = lrun + __shfl_xor(lrun, 32);
    const float inv = 1.f / ltot;
    bf16_t* op = p.hxc + xrow * 1024 + h * 64;
#pragma unroll
    for (int dt = 0; dt < 2; ++dt)
#pragma unroll
      for (int i4 = 0; i4 < 4; ++i4) {
        const int d = 32 * dt + 8 * i4 + 4 * hh;
        uint2 u; u.x = pack2(oacc[dt][4 * i4] * inv, oacc[dt][4 * i4 + 1] * inv); u.y = pack2(oacc[dt][4 * i4 + 2] * inv, oacc[dt][4 * i4 + 3] * inv);
        *(uint2*)(op + d) = u;
      }
  }
}

__device__ __forceinline__ void phase_hyconv(CP& p, char* smem) {
  bf16_t* cp = (bf16_t*)smem;
  bf16_t* Vl = (bf16_t*)(smem + 4 * 8208);
  const int tid = get_tid(), lane = tid & 63, w = tid >> 6, i16 = lane & 15, g4 = lane >> 4;
  const int si = (-i16) & 3;
  const int ocb = 64 * w;
  for (int c = get_bid(); c < 1024; c += gridDim.x) {
    __syncthreads();
#pragma unroll
    for (int i = 0; i < 2; ++i) { const int ch = tid + 256 * i; *(uint4*)(cp + ch * 8) = *(const uint4*)(p.Rf + (size_t)c * 4096 + ch * 8); }
#pragma unroll
    for (int i = 0; i < 8; ++i) {
      const int q = tid + 256 * i; const int b = q >> 8, l8 = q & 255; const int m1 = l8 >> 3, m2 = (l8 & 7) * 8;
      *(uint4*)(Vl + (8 + m1 * 8 + b) * 72 + m2) = *(const uint4*)(p.vvT + (size_t)c * 16384 + b * 2048 + l8 * 8);
    }
    if (tid < 144) {
      const int colp = tid / 9, part = tid - colp * 9;
      const int col = colp < 8 ? colp : 256 + colp;
      uint4 zz; zz.x = 0; zz.y = 0; zz.z = 0; zz.w = 0;
      *(uint4*)(Vl + col * 72 + part * 8) = zz;
    }
    __syncthreads();
#pragma unroll
    for (int s = 1; s < 4; ++s)
#pragma unroll
      for (int i = 0; i < 2; ++i) {
        const int ch = tid + 256 * i;
        unsigned e[8];
#pragma unroll
        for (int j = 0; j < 8; ++j) { const int idx = 8 * ch + s + j; e[j] = idx < 4096 ? (unsigned)cp[idx] : 0u; }
        uint4 u; u.x = e[0] | (e[1] << 16); u.y = e[2] | (e[3] << 16); u.z = e[4] | (e[5] << 16); u.w = e[6] | (e[7] << 16);
        *(uint4*)(cp + s * 4104 + 8 * ch) = u;
      }
    __syncthreads();
    const bf16_t* abase = cp + si * 4104 + (2048 - i16 - si + 8 * g4);
    f32x4 acc[4][4];
#pragma unroll
    for (int m = 0; m < 4; ++m)
#pragma unroll
      for (int n = 0; n < 4; ++n) acc[m][n] = (f32x4){0.f, 0.f, 0.f, 0.f};
    for (int dl = -31; dl <= 31; ++dl) {
      bf16x8 af[4][2];
#pragma unroll
      for (int mt = 0; mt < 4; ++mt)
#pragma unroll
        for (int kk = 0; kk < 2; ++kk) {
          const bf16_t* ap = abase - 64 * dl - 16 * mt + 32 * kk;
          const uint2 lo = *(const uint2*)ap, hi = *(const uint2*)(ap + 4);
          union { uint4 u; bf16x8 v; } cv; cv.u.x = lo.x; cv.u.y = lo.y; cv.u.z = hi.x; cv.u.w = hi.y;
          af[mt][kk] = cv.v;
        }
#pragma unroll
      for (int jt = 0; jt < 4; ++jt) {
        const int in0 = ocb + 16 * jt - 8 * dl;
        if (in0 >= -8 && in0 <= 248) {
          const bf16_t* bp = Vl + (in0 + 8 + i16) * 72 + 8 * g4;
          const bf16x8 b0 = *(const bf16x8*)bp, b1 = *(const bf16x8*)(bp + 32);
#pragma unroll
          for (int mt = 0; mt < 4; ++mt) {
            acc[mt][jt] = __builtin_amdgcn_mfma_f32_16x16x32_bf16(af[mt][0], b0, acc[mt][jt], 0, 0, 0);
            acc[mt][jt] = __builtin_amdgcn_mfma_f32_16x16x32_bf16(af[mt][1], b1, acc[mt][jt], 0, 0, 0);
          }
        }
      }
    }
    const float db = p.hy_d_bias[c];
#pragma unroll
    for (int mt = 0; mt < 4; ++mt)
#pragma unroll
      for (int jt = 0; jt < 4; ++jt) {
        const int col = ocb + 16 * jt + i16;
        const int n1 = col >> 3, b = col & 7;
        const int n2 = 16 * mt + 4 * g4;
        const uint2 vv = *(const uint2*)(Vl + (col + 8) * 72 + n2);
        const float y0 = acc[mt][jt][0] + bf2f((bf16_t)(vv.x & 0xffff)) * db;
        const float y1 = acc[mt][jt][1] + bf2f((bf16_t)(vv.x >> 16)) * db;
        const float y2 = acc[mt][jt][2] + bf2f((bf16_t)(vv.y & 0xffff)) * db;
        const float y3 = acc[mt][jt][3] + bf2f((bf16_t)(vv.y >> 16)) * db;
        uint2 u; u.x = pack2(y0, y1); u.y = pack2(y2, y3);
        *(uint2*)(p.Yp + (size_t)c * 16384 + b * 2048 + n1 * 64 + n2) = u;
      }
  }
}

__device__ __forceinline__ void phase_transmul(CP& p, char* smem) {
  bf16_t* tl = (bf16_t*)smem;
  const int tid = get_tid();
  for (int it = get_bid(); it < 4096; it += gridDim.x) {
    const int ct = it & 15, rt = it >> 4;
    const int c0 = ct * 64, r0 = rt * 64;
    __syncthreads();
#pragma unroll
    for (int i = 0; i < 2; ++i) {
      const int ci = tid + 256 * i; const int cc = ci >> 3, ch = ci & 7;
      const uint4 u = *(const uint4*)(p.Yp + (size_t)(c0 + cc) * 16384 + r0 + ch * 8);
      unsigned* d = (unsigned*)(tl + cc * 66 + ch * 8);
      d[0] = u.x; d[1] = u.y; d[2] = u.z; d[3] = u.w;
    }
    __syncthreads();
    const int row = tid >> 2, cq = tid & 3;
    const bf16_t* xp = p.x1h + (size_t)(r0 + row) * 1024 + c0 + cq * 16;
    const uint4 xa = *(const uint4*)xp, xb = *(const uint4*)(xp + 8);
    const unsigned xs[8] = {xa.x, xa.y, xa.z, xa.w, xb.x, xb.y, xb.z, xb.w};
    unsigned o[8];
#pragma unroll
    for (int j = 0; j < 8; ++j) {
      const float y0 = bf2f(tl[(cq * 16 + 2 * j) * 66 + row]) * bf2f((bf16_t)(xs[j] & 0xffff));
      const float y1 = bf2f(tl[(cq * 16 + 2 * j + 1) * 66 + row]) * bf2f((bf16_t)(xs[j] >> 16));
      o[j] = pack2(y0, y1);
    }
    bf16_t* op = p.hxc + (size_t)(r0 + row) * 1024 + c0 + cq * 16;
    uint4 oa; oa.x = o[0]; oa.y = o[1]; oa.z = o[2]; oa.w = o[3];
    uint4 ob; ob.x = o[4]; ob.y = o[5]; ob.z = o[6]; ob.w = o[7];
    *(uint4*)op = oa; *(uint4*)(op + 8) = ob;
  }
}

__global__ void __launch_bounds__(256, 2) mega(P p_arg) {
  __shared__ __attribute__((aligned(16))) char smem[LDS_BYTES];
  cg::grid_group grid = cg::this_grid();
  const int G = gridDim.x;
  CP* pp = (CP*)__builtin_amdgcn_kernarg_segment_ptr();
  const int ph0 = pp->ph0, ph1 = pp->ph1;
  volatile LAS unsigned* xst = (volatile LAS unsigned*)(smem + LDS_BYTES - 16);
  if (threadIdx.x == 0) { xst[0] = 0u; xst[1] = 0u; }
  __syncthreads();
  const XcdBarrier xb = xcd_barrier_post(pp->bar, xst);
  if (ph0 <= 0 && 0 < ph1) {
    asm volatile("" : "+s"(pp));
    CP& p = *pp;
    const int bid = get_bid();
    const int vid0 = (G & 7) ? bid : ((bid & 7) * (G >> 3) + (bid >> 3));
    const float* mv0 = p.modv; const float* mv1 = p.modv + (size_t)9 * 6144;
    (void)mv0; (void)mv1; (void)vid0;
    phase_prep(p, smem);
    if (0 + 1 < ph1) { if (ph1 > 1000) grid.sync(); else xcd_barrier(xb); }
  }
  if (ph0 <= 1 && 1 < ph1) {
    asm volatile("" : "+s"(pp));
    CP& p = *pp;
    const int bid = get_bid();
    const int vid0 = (G & 7) ? bid : ((bid & 7) * (G >> 3) + (bid >> 3));
    const float* mv0 = p.modv; const float* mv1 = p.modv + (size_t)9 * 6144;
    (void)mv0; (void)mv1; (void)vid0;
    phase_normmod_kv(p);
    if (1 + 1 < ph1) { if (ph1 > 1000) grid.sync(); else xcd_barrier(xb); }
  }
  if (ph0 <= 2 && 2 < ph1) {
    asm volatile("" : "+s"(pp));
    CP& p = *pp;
    const int bid = get_bid();
    const int vid0 = (G & 7) ? bid : ((bid & 7) * (G >> 3) + (bid >> 3));
    const float* mv0 = p.modv; const float* mv1 = p.modv + (size_t)9 * 6144;
    (void)mv0; (void)mv1; (void)vid0;
    {
        EpiStore e1{p.cq, 512, 2048, nullptr};
        gemm_job<true>(smem, p.hxc, 1024, p.wt_dq, 1024, 512, 16, 2304, 256, 128, 0, 2048, 128, 0, vid0, G, e1);
        EpiStore e2{p.kv, 288, 2304, nullptr};
        gemm_job<true>(smem, p.hxc, 1024, p.wt_dkv, 1024, 288, 18, 2304, 0, 128, 0, 2304, 144, 128 * 2, vid0, G, e2);
        EpiFilt e3{p.Rf, p.hy_decay};
        gemm_job<false>(smem, p.h2bf, 64, p.wt_f3, 64, 2048, 16, 0, 0, 128, 0, 2048, 16, 128 * 2 + 144 * 2, vid0, G, e3);
      }
    if (2 + 1 < ph1) { if (ph1 > 1000) grid.sync(); else xcd_barrier(xb); }
  }
  if (ph0 <= 3 && 3 < ph1) {
    asm volatile("" : "+s"(pp));
    CP& p = *pp;
    const int bid = get_bid();
    const int vid0 = (G & 7) ? bid : ((bid & 7) * (G >> 3) + (bid >> 3));
    const float* mv0 = p.modv; const float* mv1 = p.modv + (size_t)9 * 6144;
    (void)mv0; (void)mv1; (void)vid0;
    phase_rowstat(p);
    if (3 + 1 < ph1) { if (ph1 > 1000) grid.sync(); else xcd_barrier(xb); }
  }
  if (ph0 <= 4 && 4 < ph1) {
    asm volatile("" : "+s"(pp));
    CP& p = *pp;
    const int bid = get_bid();
    const int vid0 = (G & 7) ? bid : ((bid & 7) * (G >> 3) + (bid >> 3));
    const float* mv0 = p.modv; const float* mv1 = p.modv + (size_t)9 * 6144;
    (void)mv0; (void)mv1; (void)vid0;
    {
        EpiStore e1{p.Q, 1536, 2048, p.rq};
        gemm_job<true>(smem, p.cq, 512, p.wt_uq, 512, 1536, 16, 2048, 0, 128, 0, 2048, 128, 0, vid0, G, e1);
        EpiStore e2{p.Kn, 1024, 2304, p.rkv};
        gemm_job<true>(smem, p.kv, 288, p.wt_uk, 256, 1024, 18, 2304, 0, 128, 0, 2304, 144, 128 * 6, vid0, G, e2);
        EpiVt e3{p.Vt, p.rkv};
        gemm_job<false>(smem, p.kv, 288, p.wt_uv, 256, 1024, 18, 2304, 0, 128, 0, 2304, 144, 128 * 6 + 144 * 4, vid0, G, e3);
      }
    if (4 + 1 < ph1) { if (ph1 > 1000) grid.sync(); else xcd_barrier(xb); }
  }
  if (ph0 <= 5 && 5 < ph1) {
    asm volatile("" : "+s"(pp));
    CP& p = *pp;
    const int bid = get_bid();
    const int vid0 = (G & 7) ? bid : ((bid & 7) * (G >> 3) + (bid >> 3));
    const float* mv0 = p.modv; const float* mv1 = p.modv + (size_t)9 * 6144;
    (void)mv0; (void)mv1; (void)vid0;
    phase_attn(p, smem, vid0, G);
    if (5 + 1 < ph1) { if (ph1 > 1000) grid.sync(); else xcd_barrier(xb); }
  }
  if (ph0 <= 6 && 6 < ph1) {
    asm volatile("" : "+s"(pp));
    CP& p = *pp;
    const int bid = get_bid();
    const int vid0 = (G & 7) ? bid : ((bid & 7) * (G >> 3) + (bid >> 3));
    const float* mv0 = p.modv; const float* mv1 = p.modv + (size_t)9 * 6144;
    (void)mv0; (void)mv1; (void)vid0;
    {
        EpiResid e{p.X, p.x, mv0 + 2 * 1024, nullptr};
        gemm_job<true>(smem, p.hxc, 1024, p.wt_o, 1024, 1024, 16, 2048, 0, 128, 0, 2048, 128, 0, vid0, G, e);
      }
    if (6 + 1 < ph1) { if (ph1 > 1000) grid.sync(); else xcd_barrier(xb); }
  }
  if (ph0 <= 7 && 7 < ph1) {
    asm volatile("" : "+s"(pp));
    CP& p = *pp;
    const int bid = get_bid();
    const int vid0 = (G & 7) ? bid : ((bid & 7) * (G >> 3) + (bid >> 3));
    const float* mv0 = p.modv; const float* mv1 = p.modv + (size_t)9 * 6144;
    (void)mv0; (void)mv1; (void)vid0;
    phase_normmod_x(p, p.norm_ffn_g, 0, 3);
    if (7 + 1 < ph1) { if (ph1 > 1000) grid.sync(); else xcd_barrier(xb); }
  }
  if (ph0 <= 8 && 8 < ph1) {
    asm volatile("" : "+s"(pp));
    CP& p = *pp;
    const int bid = get_bid();
    const int vid0 = (G & 7) ? bid : ((bid & 7) * (G >> 3) + (bid >> 3));
    const float* mv0 = p.modv; const float* mv1 = p.modv + (size_t)9 * 6144;
    (void)mv0; (void)mv1; (void)vid0;
    {
        EpiConv<0> e{p.ffn_conv_w, p.ffn_conv_b, 5632, nullptr, p.act, nullptr};
        gemm_job<true>(smem, p.hxc, 1024, p.wt_up0, 1024, 5632, 17, 2048, 0, 126, 1, 2048, 136, 0, vid0, G, e);
      }
    if (8 + 1 < ph1) { if (ph1 > 1000) grid.sync(); else xcd_barrier(xb); }
  }
  if (ph0 <= 9 && 9 < ph1) {
    asm volatile("" : "+s"(pp));
    CP& p = *pp;
    const int bid = get_bid();
    const int vid0 = (G & 7) ? bid : ((bid & 7) * (G >> 3) + (bid >> 3));
    const float* mv0 = p.modv; const float* mv1 = p.modv + (size_t)9 * 6144;
    (void)mv0; (void)mv1; (void)vid0;
    {
        EpiResid e{p.X, p.X, mv0 + 5 * 1024, nullptr};
        gemm_job<true>(smem, p.act, 2816, p.wt_dn0, 2816, 1024, 16, 2048, 0, 128, 0, 2048, 128, 0, vid0, G, e);
      }
    if (9 + 1 < ph1) { if (ph1 > 1000) grid.sync(); else xcd_barrier(xb); }
  }
  if (ph0 <= 10 && 10 < ph1) {
    asm volatile("" : "+s"(pp));
    CP& p = *pp;
    const int bid = get_bid();
    const int vid0 = (G & 7) ? bid : ((bid & 7) * (G >> 3) + (bid >> 3));
    const float* mv0 = p.modv; const float* mv1 = p.modv + (size_t)9 * 6144;
    (void)mv0; (void)mv1; (void)vid0;
    phase_normmod_x(p, p.norm_mix_g + 1024, 1, 0);
    if (10 + 1 < ph1) { if (ph1 > 1000) grid.sync(); else xcd_barrier(xb); }
  }
  if (ph0 <= 11 && 11 < ph1) {
    asm volatile("" : "+s"(pp));
    CP& p = *pp;
    const int bid = get_bid();
    const int vid0 = (G & 7) ? bid : ((bid & 7) * (G >> 3) + (bid >> 3));
    const float* mv0 = p.modv; const float* mv1 = p.modv + (size_t)9 * 6144;
    (void)mv0; (void)mv1; (void)vid0;
    {
        EpiConv<1> e{p.hy_conv_w, p.hy_conv_b, 3072, p.hy_b_in, p.x1h, p.vvT};
        gemm_job<true>(smem, p.hxc, 1024, p.wt_hin, 1024, 3072, 17, 2048, 0, 126, 1, 2048, 136, 0, vid0, G, e);
      }
    if (11 + 1 < ph1) { if (ph1 > 1000) grid.sync(); else xcd_barrier(xb); }
  }
  if (ph0 <= 12 && 12 < ph1) {
    asm volatile("" : "+s"(pp));
    CP& p = *pp;
    const int bid = get_bid();
    const int vid0 = (G & 7) ? bid : ((bid & 7) * (G >> 3) + (bid >> 3));
    const float* mv0 = p.modv; const float* mv1 = p.modv + (size_t)9 * 6144;
    (void)mv0; (void)mv1; (void)vid0;
    phase_hyconv(p, smem);
    if (12 + 1 < ph1) { if (ph1 > 1000) grid.sync(); else xcd_barrier(xb); }
  }
  if (ph0 <= 13 && 13 < ph1) {
    asm volatile("" : "+s"(pp));
    CP& p = *pp;
    const int bid = get_bid();
    const int vid0 = (G & 7) ? bid : ((bid & 7) * (G >> 3) + (bid >> 3));
    const float* mv0 = p.modv; const float* mv1 = p.modv + (size_t)9 * 6144;
    (void)mv0; (void)mv1; (void)vid0;
    phase_transmul(p, smem);
    if (13 + 1 < ph1) { if (ph1 > 1000) grid.sync(); else xcd_barrier(xb); }
  }
  if (ph0 <= 14 && 14 < ph1) {
    asm volatile("" : "+s"(pp));
    CP& p = *pp;
    const int bid = get_bid();
    const int vid0 = (G & 7) ? bid : ((bid & 7) * (G >> 3) + (bid >> 3));
    const float* mv0 = p.modv; const float* mv1 = p.modv + (size_t)9 * 6144;
    (void)mv0; (void)mv1; (void)vid0;
    {
        EpiResid e{p.X, p.X, mv1 + 2 * 1024, p.hy_b_out};
        gemm_job<true>(smem, p.hxc, 1024, p.wt_hout, 1024, 1024, 16, 2048, 0, 128, 0, 2048, 128, 0, vid0, G, e);
      }
    if (14 + 1 < ph1) { if (ph1 > 1000) grid.sync(); else xcd_barrier(xb); }
  }
  if (ph0 <= 15 && 15 < ph1) {
    asm volatile("" : "+s"(pp));
    CP& p = *pp;
    const int bid = get_bid();
    const int vid0 = (G & 7) ? bid : ((bid & 7) * (G >> 3) + (bid >> 3));
    const float* mv0 = p.modv; const float* mv1 = p.modv + (size_t)9 * 6144;
    (void)mv0; (void)mv1; (void)vid0;
    phase_normmod_x(p, p.norm_ffn_g + 1024, 1, 3);
    if (15 + 1 < ph1) { if (ph1 > 1000) grid.sync(); else xcd_barrier(xb); }
  }
  if (ph0 <= 16 && 16 < ph1) {
    asm volatile("" : "+s"(pp));
    CP& p = *pp;
    const int bid = get_bid();
    const int vid0 = (G & 7) ? bid : ((bid & 7) * (G >> 3) + (bid >> 3));
    const float* mv0 = p.modv; const float* mv1 = p.modv + (size_t)9 * 6144;
    (void)mv0; (void)mv1; (void)vid0;
    {
        EpiConv<0> e{p.ffn_conv_w + (size_t)3 * 5632, p.ffn_conv_b + 5632, 5632, nullptr, p.act, nullptr};
        gemm_job<true>(smem, p.hxc, 1024, p.wt_up1, 1024, 5632, 17, 2048, 0, 126, 1, 2048, 136, 0, vid0, G, e);
      }
    if (16 + 1 < ph1) { if (ph1 > 1000) grid.sync(); else xcd_barrier(xb); }
  }
  if (ph0 <= 17 && 17 < ph1) {
    asm volatile("" : "+s"(pp));
    CP& p = *pp;
    const int bid = get_bid();
    const int vid0 = (G & 7) ? bid : ((bid & 7) * (G >> 3) + (bid >> 3));
    const float* mv0 = p.modv; const float* mv1 = p.modv + (size_t)9 * 6144;
    (void)mv0; (void)mv1; (void)vid0;
    {
        EpiResid e{p.X, p.X, mv1 + 5 * 1024, nullptr};
        gemm_job<true>(smem, p.act, 2816, p.wt_dn1, 2816, 1024, 16, 2048, 0, 128, 0, 2048, 128, 0, vid0, G, e);
      }
    if (17 + 1 < ph1) { if (ph1 > 1000) grid.sync(); else xcd_barrier(xb); }
  }
  if (ph0 <= 18 && 18 < ph1) {
    asm volatile("" : "+s"(pp));
    CP& p = *pp;
    const int bid = get_bid();
    const int vid0 = (G & 7) ? bid : ((bid & 7) * (G >> 3) + (bid >> 3));
    const float* mv0 = p.modv; const float* mv1 = p.modv + (size_t)9 * 6144;
    (void)mv0; (void)mv1; (void)vid0;
    phase_final_norm(p);
    if (18 + 1 < ph1) { if (ph1 > 1000) grid.sync(); else xcd_barrier(xb); }
  }
}

extern "C" void kernel_launch(void* const* d_in, const int* in_sizes, int n_in, void* d_out, int out_size, void* d_ws, size_t ws_size, hipStream_t stream) {
  static int grid_blocks = 0;
  if (!grid_blocks) {
    int dev = 0, cus = 0, per_cu = 0;
    hipGetDevice(&dev);
    hipDeviceGetAttribute(&cus, hipDeviceAttributeMultiprocessorCount, dev);
    hipOccupancyMaxActiveBlocksPerMultiprocessor(&per_cu, (const void*)mega, 256, 0);
    if (per_cu < 1) per_cu = 1;
    if (per_cu > 2) per_cu = 2;
    grid_blocks = cus * per_cu;
  }
  P p{};
  const float** in = (const float**)&p;
  for (int i = 0; i < 36; ++i) in[i] = (const float*)d_in[i];
  p.X = (float*)d_out;
  char* ws = (char*)d_ws; size_t off = 0;
  auto take = [&](size_t bytes) { char* r = ws + off; off += (bytes + 255) & ~(size_t)255; return r; };
  p.wt_dq = (bf16_t*)take((size_t)512 * 1024 * 2);
  p.wt_dkv = (bf16_t*)take((size_t)288 * 1024 * 2);
  p.wt_uq = (bf16_t*)take((size_t)1536 * 512 * 2);
  p.wt_uk = (bf16_t*)take((size_t)1024 * 256 * 2);
  p.wt_uv = (bf16_t*)take((size_t)1024 * 256 * 2);
  p.wt_o = (bf16_t*)take((size_t)1024 * 1024 * 2);
  p.wt_hin = (bf16_t*)take((size_t)3072 * 1024 * 2);
  p.wt_hout = (bf16_t*)take((size_t)1024 * 1024 * 2);
  p.wt_up0 = (bf16_t*)take((size_t)5632 * 1024 * 2);
  p.wt_up1 = (bf16_t*)take((size_t)5632 * 1024 * 2);
  p.wt_dn0 = (bf16_t*)take((size_t)1024 * 2816 * 2);
  p.wt_dn1 = (bf16_t*)take((size_t)1024 * 2816 * 2);
  p.modv = (float*)take((size_t)2 * 9 * 6144 * 4);
  p.rq = (float*)take((size_t)16384 * 4);
  p.rkv = (float*)take((size_t)18432 * 4);
  p.modp = (float*)take((size_t)4 * 110592 * 4);
  p.bar = (unsigned*)take((size_t)XCD_BAR_WORDS * 4);
  p.wt_f3 = (bf16_t*)take((size_t)2048 * 64 * 2);
  p.h2bf = (bf16_t*)take((size_t)2048 * 64 * 2);
  p.Rf = (bf16_t*)take((size_t)1024 * 4096 * 2);
  p.kpe = (bf16_t*)take((size_t)18432 * 32 * 2);
  p.hxc = (bf16_t*)take((size_t)18432 * 1024 * 2);
  const size_t ubase = off;
  p.cq = (bf16_t*)take((size_t)16384 * 512 * 2);
  p.kv = (bf16_t*)take((size_t)18432 * 288 * 2);
  p.Q = (bf16_t*)take((size_t)16384 * 1536 * 2);
  p.Kn = (bf16_t*)take((size_t)18432 * 1024 * 2);
  p.Vt = (bf16_t*)take((size_t)18432 * 1024 * 2);
  const size_t uend1 = off;
  off = ubase;
  p.act = (bf16_t*)take((size_t)16384 * 2816 * 2);
  off = ubase;
  p.x1h = (bf16_t*)take((size_t)16384 * 1024 * 2);
  p.vvT = (bf16_t*)take((size_t)16384 * 1024 * 2);
  p.Yp = (bf16_t*)take((size_t)16384 * 1024 * 2);
  if (uend1 > ws_size) { fprintf(stderr, "workspace too small: need %zu have %zu\n", uend1, ws_size); return; }
  p.ph0 = 0; p.ph1 = NPHASE;
  if (hipMemsetAsync(p.bar, 0, (size_t)XCD_BAR_WORDS * 4, stream) != hipSuccess) { fprintf(stderr, "memset failed\n"); return; }
  void* args[] = {&p};
  hipError_t e = hipLaunchCooperativeKernel((const void*)mega, dim3(grid_blocks), dim3(256), args, 0, stream);
  if (e != hipSuccess) fprintf(stderr, "cooperative launch failed: %s (grid %d)\n", hipGetErrorString(e), grid_blocks);
}
```

```cpp
#include <hip/hip_runtime.h>
#include <hip/hip_cooperative_groups.h>
#include <cstdio>
namespace cg = cooperative_groups;

typedef unsigned short bf16_t;
typedef short bf16x8 __attribute__((ext_vector_type(8)));
typedef float f32x4 __attribute__((ext_vector_type(4)));
typedef float f32x16 __attribute__((ext_vector_type(16)));

#define LDS_BYTES 163840
#define HALF_LDS 81920
#define NPHASE 19

struct P {
  const float *x, *c, *ctx, *c_ctx, *mod_w, *mod_b, *norm_mix_g, *norm_ffn_g;
  const float *w_dq, *g_q, *w_uq, *w_dkv, *g_kv, *w_uk, *w_uv, *w_o;
  const float *hy_w_in, *hy_b_in, *hy_conv_w, *hy_conv_b, *f_w1, *f_b1, *f_freq1, *f_w2, *f_b2, *f_freq2, *f_w3, *hy_decay, *hy_d_bias, *hy_w_out, *hy_b_out;
  const float *ffn_w_up, *ffn_conv_w, *ffn_conv_b, *ffn_w_down, *final_g;
  float* X;
  bf16_t *wt_dq, *wt_dkv, *wt_uq, *wt_uk, *wt_uv, *wt_o, *wt_hin, *wt_hout, *wt_up0, *wt_up1, *wt_dn0, *wt_dn1;
  float *modv, *rq, *rkv, *modp;
  unsigned* bar;
  bf16_t *wt_f3, *h2bf;
  bf16_t *Rf, *kpe, *hxc, *cq, *kv, *Q, *Kn, *Vt, *act, *x1h, *vvT, *Yp;
  int ph0, ph1;
};

typedef const __attribute__((address_space(4))) P CP;
__device__ __forceinline__ int get_tid512() { int t = threadIdx.x; asm volatile("" : "+v"(t)); return t; }
__device__ __forceinline__ int get_tid() { int t = threadIdx.x & 255; asm volatile("" : "+v"(t)); return t; }
__device__ __forceinline__ int get_hb() { int t = __builtin_amdgcn_readfirstlane((int)(threadIdx.x >> 8)); asm volatile("" : "+s"(t)); return t; }
__device__ __forceinline__ int get_rbid() { int t = blockIdx.x; asm volatile("" : "+s"(t)); return t; }
__device__ __forceinline__ int get_bid() { return 2 * get_rbid() + get_hb(); }
#define VGRID (2 * (int)gridDim.x)

__device__ __forceinline__ unsigned pack2(float a, float b) { unsigned r; asm("v_cvt_pk_bf16_f32 %0, %1, %2" : "=v"(r) : "v"(a), "v"(b)); return r; }
__device__ __forceinline__ bf16_t f2bf(float f) { return (bf16_t)(pack2(f, f) & 0xffffu); }
__device__ __forceinline__ float bf2f(bf16_t h) { return __uint_as_float(((unsigned)h) << 16); }
__device__ __forceinline__ float wave_sum(float v) {
#pragma unroll
  for (int o = 32; o; o >>= 1) v += __shfl_xor(v, o);
  return v;
}


#define XB_TMO      128
#define XB_XCNT(j)  (256  + 64 * (j))
#define XB_XSUB(j)  (1280 + 64 * (j))
#define XB_XGEN(j)  (2304 + 64 * (j))
#define XB_TOP      3328
#define XB_TOPGEN   3392
#define XCD_BAR_WORDS 3456
#define XB_SPIN_CAP (1u << 18)
#define LAS __attribute__((address_space(3)))
__device__ __forceinline__ unsigned xb_ld(unsigned* p)              { return __hip_atomic_load(p, __ATOMIC_RELAXED, __HIP_MEMORY_SCOPE_AGENT); }
__device__ __forceinline__ unsigned xb_add(unsigned* p, unsigned v) { return __hip_atomic_fetch_add(p, v, __ATOMIC_RELAXED, __HIP_MEMORY_SCOPE_AGENT); }
__device__ __forceinline__ unsigned xb_xcc_id() { return (unsigned)__builtin_amdgcn_s_getreg((3 << 11) | 20) & 0xFu; }
#define XB_SPIN(cond, bar) do { unsigned _sp = 0; while (cond) { __builtin_amdgcn_s_sleep(1); \
    if ((++_sp & 255u) == 0u) { if (xb_ld(&(bar)[XB_TMO])) break; if (_sp > XB_SPIN_CAP) { atomicAdd(&(bar)[XB_TMO], 1u); break; } } } } while (0)
struct XcdBarrier { unsigned* bar; unsigned x; volatile LAS unsigned* st; };
__device__ __forceinline__ XcdBarrier xcd_barrier_post(unsigned* bar, volatile LAS unsigned* st) {
    XcdBarrier b; b.bar = bar; b.x = xb_xcc_id(); b.st = st;
    if (threadIdx.x == 0) (void)xb_add(&bar[XB_XCNT(b.x)], 1u);
    return b;
}
__device__ __forceinline__ void xcd_barrier_complete(unsigned* bar, unsigned x, unsigned& nloc, unsigned& nx) {
    const unsigned G = gridDim.x * gridDim.y * gridDim.z;
    unsigned sum, cnt, mine, sp = 0u;
    for (;;) {
        sum = 0u; cnt = 0u; mine = 0u;
#pragma unroll
        for (unsigned j = 0; j < 16; ++j) { const unsigned c = xb_ld(&bar[XB_XCNT(j)]); sum += c; cnt += (c > 0u) ? 1u : 0u; mine = (j == x) ? c : mine; }
        if (sum == G) break;
        __builtin_amdgcn_s_sleep(1);
        if ((++sp & 255u) == 0u) { if (xb_ld(&bar[XB_TMO])) break; if (sp > XB_SPIN_CAP) { atomicAdd(&bar[XB_TMO], 1u); break; } }
    }
    nloc = mine > 0u ? mine : 1u; nx = cnt > 0u ? cnt : 1u;
}
__device__ __forceinline__ void xcd_barrier(const XcdBarrier& b) {
    asm volatile("s_waitcnt vmcnt(0)" ::: "memory");
    __syncthreads();
    if (threadIdx.x == 0) {
        unsigned* bar = b.bar;
        __builtin_amdgcn_s_waitcnt(0);
        unsigned nloc = b.st[0], nx = b.st[1];
        if (nloc == 0u) { xcd_barrier_complete(bar, b.x, nloc, nx); b.st[0] = nloc; b.st[1] = nx; }
        const unsigned old = xb_add(&bar[XB_XSUB(b.x)], 1u);
        const unsigned gen = old / nloc;
        if (old + 1u == (gen + 1u) * nloc) {
            __builtin_amdgcn_fence(__ATOMIC_RELEASE, "agent");
            asm volatile("s_waitcnt vmcnt(0)" ::: "memory");
            const unsigned og = xb_add(&bar[XB_TOP], 1u);
            const unsigned tg = og / nx;
            if (og + 1u == (tg + 1u) * nx) xb_add(&bar[XB_TOPGEN], 1u);
            else XB_SPIN(xb_ld(&bar[XB_TOPGEN]) == tg, bar);
            __builtin_amdgcn_fence(__ATOMIC_ACQUIRE, "agent");
            xb_add(&bar[XB_XGEN(b.x)], 1u);
            asm volatile("s_waitcnt vmcnt(0)" ::: "memory");
        } else {
            XB_SPIN(xb_ld(&bar[XB_XGEN(b.x)]) == gen, bar);
            __builtin_amdgcn_fence(__ATOMIC_ACQUIRE, "agent");
            asm volatile("s_waitcnt vmcnt(0)" ::: "memory");
        }
    }
    __syncthreads();
}

__device__ __forceinline__ void prep_weight_tile(CP& p, char* smem, int wt) {
  const int tid = get_tid();
  int id = 0;
  {
    const int cnt[13] = {128, 80, 192, 64, 64, 256, 768, 256, 1408, 1408, 704, 704, 32};
#pragma unroll
    for (int i = 0; i < 12; ++i) { if (id == i && wt >= cnt[i]) { wt -= cnt[i]; id = i + 1; } }
  }
  const float* src; int K, N; bf16_t* dst; const float* scale = nullptr; int perm = 0;
  switch (id) {
    case 0: src = p.w_dq; K = 1024; N = 512; dst = p.wt_dq; break;
    case 1: src = p.w_dkv; K = 1024; N = 288; dst = p.wt_dkv; break;
    case 2: src = p.w_uq; K = 512; N = 1536; dst = p.wt_uq; scale = p.g_q; break;
    case 3: src = p.w_uk; K = 256; N = 1024; dst = p.wt_uk; scale = p.g_kv; break;
    case 4: src = p.w_uv; K = 256; N = 1024; dst = p.wt_uv; scale = p.g_kv; break;
    case 5: src = p.w_o; K = 1024; N = 1024; dst = p.wt_o; break;
    case 6: src = p.hy_w_in; K = 1024; N = 3072; dst = p.wt_hin; perm = 2; break;
    case 7: src = p.hy_w_out; K = 1024; N = 1024; dst = p.wt_hout; break;
    case 8: src = p.ffn_w_up; K = 1024; N = 5632; dst = p.wt_up0; perm = 1; break;
    case 9: src = p.ffn_w_up + (size_t)1024 * 5632; K = 1024; N = 5632; dst = p.wt_up1; perm = 1; break;
    case 10: src = p.ffn_w_down; K = 2816; N = 1024; dst = p.wt_dn0; break;
    case 11: src = p.ffn_w_down + (size_t)2816 * 1024; K = 2816; N = 1024; dst = p.wt_dn1; break;
    default: src = p.f_w3; K = 64; N = 2048; dst = p.wt_f3; break;
  }
  const int ntn = (N + 63) >> 6;
  const int kt = wt / ntn, nt = wt - kt * ntn;
  const int k0 = kt * 64, n0 = nt * 64;
  int np0;
  if (perm == 1) { const int half = n0 / 2816, f = n0 - half * 2816; np0 = (f >> 6) * 128 + half * 64; }
  else if (perm == 2) { if (n0 < 1024) np0 = n0; else { const int m = n0 - 1024, half = m >> 10, f = m & 1023; np0 = 1024 + (f >> 6) * 128 + half * 64; } }
  else np0 = n0;
  bf16_t* t16 = (bf16_t*)smem;
  f32x4 v[4];
#pragma unroll
  for (int i = 0; i < 4; ++i) {
    const int idx = tid + 256 * i; const int kr = idx >> 4, c4 = idx & 15;
    v[i] = (f32x4){0.f, 0.f, 0.f, 0.f};
    if (n0 + 4 * c4 < N) v[i] = *(const f32x4*)(src + (size_t)(k0 + kr) * N + n0 + 4 * c4);
  }
#pragma unroll
  for (int i = 0; i < 4; ++i) {
    const int idx = tid + 256 * i; const int kr = idx >> 4, c4 = idx & 15;
    const float sc = scale ? scale[k0 + kr] : 1.f;
#pragma unroll
    for (int j = 0; j < 4; ++j) t16[(4 * c4 + j) * 72 + kr] = f2bf(v[i][j] * sc);
  }
  __syncthreads();
#pragma unroll
  for (int i = 0; i < 2; ++i) {
    const int idx = tid + 256 * i; const int n = idx >> 3, ch = idx & 7;
    if (n0 + n < N) *(uint4*)(dst + (size_t)(np0 + n) * K + k0 + ch * 8) = *(const uint4*)(t16 + n * 72 + ch * 8);
  }
  __syncthreads();
}

__device__ __forceinline__ void prep_modvec(CP& p, char* smem, int it) {
  const int tid = get_tid();
  const int layer = it / 384, rem = it - layer * 384, cb = rem >> 2, ks = rem & 3;
  float* s_lds = (float*)smem;
  float* red = (float*)(smem + 12288);
  const int kbase = ks * 256;
  for (int idx = tid; idx < 9 * 256; idx += 256) {
    const int r = idx >> 8, k = idx & 255;
    const float v = r < 8 ? p.c[r * 1024 + kbase + k] : p.c_ctx[kbase + k];
    s_lds[k * 12 + r] = v / (1.f + __expf(-v));
  }
  __syncthreads();
  const int col = cb * 64 + (tid & 63), kg = tid >> 6;
  const float* W = p.mod_w + (size_t)layer * 1024 * 6144 + (size_t)kbase * 6144 + col;
  float acc[9];
#pragma unroll
  for (int r = 0; r < 9; ++r) acc[r] = 0.f;
#pragma unroll
  for (int kb = 0; kb < 4; ++kb) {
    float w[16];
#pragma unroll
    for (int u = 0; u < 16; ++u) w[u] = W[(size_t)(kg * 64 + kb * 16 + u) * 6144];
#pragma unroll
    for (int u = 0; u < 16; ++u) {
      const int k = kg * 64 + kb * 16 + u;
      const f32x4 s0 = *(const f32x4*)(s_lds + k * 12), s1 = *(const f32x4*)(s_lds + k * 12 + 4);
      const float s2 = s_lds[k * 12 + 8];
      acc[0] += s0[0] * w[u]; acc[1] += s0[1] * w[u]; acc[2] += s0[2] * w[u]; acc[3] += s0[3] * w[u];
      acc[4] += s1[0] * w[u]; acc[5] += s1[1] * w[u]; acc[6] += s1[2] * w[u]; acc[7] += s1[3] * w[u];
      acc[8] += s2 * w[u];
    }
  }
#pragma unroll
  for (int r = 0; r < 9; ++r) red[(kg * 9 + r) * 64 + (tid & 63)] = acc[r];
  __syncthreads();
  for (int o = tid; o < 9 * 64; o += 256) {
    const int r = o >> 6, cl = o & 63;
    const float sm = red[(0 * 9 + r) * 64 + cl] + red[(1 * 9 + r) * 64 + cl] + red[(2 * 9 + r) * 64 + cl] + red[(3 * 9 + r) * 64 + cl];
    p.modp[(size_t)ks * 110592 + (size_t)(layer * 9 + r) * 6144 + cb * 64 + cl] = sm;
  }
  __syncthreads();
}

__device__ __forceinline__ void prep_filter(CP& p, char* smem, int it) {
  const int tid = get_tid();
  float* z = (float*)smem;
  float* h1 = z + 8 * 33;
  float* h2 = h1 + 8 * 64;
  const int t0 = it * 8;
  for (int idx = tid; idx < 8 * 33; idx += 256) {
    const int pp = idx / 33, i = idx - pp * 33;
    const int t = t0 + pp;
    float v;
    if (i == 0) v = (float)t * (1.0f / 2047.0f);
    else {
      const int k = (i - 1) & 15;
      const float w = (6.283185307179586f * (float)t) / 2048.0f;
      const float f = 1e-4f + (float)k * ((15.0f - 1e-4f) / 15.0f);
      const float a = w * f;
      v = (i <= 16) ? __cosf(a) : -__sinf(a);
    }
    z[idx] = v;
  }
  __syncthreads();
  for (int idx = tid; idx < 8 * 64; idx += 256) {
    const int pp = idx >> 6, j = idx & 63;
    float s = p.f_b1[j];
#pragma unroll
    for (int i = 0; i < 33; ++i) s += z[pp * 33 + i] * p.f_w1[i * 64 + j];
    h1[idx] = __sinf(p.f_freq1[j] * s);
  }
  __syncthreads();
  for (int idx = tid; idx < 8 * 64; idx += 256) {
    const int pp = idx >> 6, j = idx & 63;
    float s = p.f_b2[j];
#pragma unroll 16
    for (int i = 0; i < 64; ++i) s += h1[pp * 64 + i] * p.f_w2[i * 64 + j];
    h2[idx] = __sinf(p.f_freq2[j] * s);
  }
  __syncthreads();
  for (int idx = tid; idx < 8 * 64; idx += 256) p.h2bf[(size_t)t0 * 64 + idx] = f2bf(h2[idx]);
  __syncthreads();
}

__device__ __forceinline__ void phase_prep(CP& p, char* smem) {
  const int total = 768 + 256 + 6064;
  for (int it = get_bid(); it < total; it += VGRID) {
    if (it < 768) prep_modvec(p, smem, it);
    else if (it < 1024) prep_filter(p, smem, it - 768);
    else prep_weight_tile(p, smem, it - 1024);
  }
}

template <bool PART>
__device__ __forceinline__ void normmod_row2(const float* __restrict__ src, const float* __restrict__ g, const float* __restrict__ sh, const float* __restrict__ sc, bf16_t* __restrict__ dst, int lane, const float* __restrict__ bsh = nullptr) {
  f32x4 v[2][4]; float ss0 = 0.f, ss1 = 0.f;
#pragma unroll
  for (int i = 0; i < 4; ++i) { v[0][i] = *(const f32x4*)(src + lane * 4 + 256 * i); v[1][i] = *(const f32x4*)(src + 1024 + lane * 4 + 256 * i); }
#pragma unroll
  for (int i = 0; i < 4; ++i) {
    ss0 += v[0][i][0] * v[0][i][0] + v[0][i][1] * v[0][i][1] + v[0][i][2] * v[0][i][2] + v[0][i][3] * v[0][i][3];
    ss1 += v[1][i][0] * v[1][i][0] + v[1][i][1] * v[1][i][1] + v[1][i][2] * v[1][i][2] + v[1][i][3] * v[1][i][3];
  }
  ss0 = wave_sum(ss0); ss1 = wave_sum(ss1);
  const float r0 = rsqrtf(ss0 * (1.0f / 1024.0f) + 1e-6f), r1 = rsqrtf(ss1 * (1.0f / 1024.0f) + 1e-6f);
#pragma unroll
  for (int i = 0; i < 4; ++i) {
    const int k = lane * 4 + 256 * i;
    const f32x4 g4 = *(const f32x4*)(g + k);
    f32x4 s4 = *(const f32x4*)(sh + k), c4 = *(const f32x4*)(sc + k);
    if (PART) {
#pragma unroll
      for (int q = 1; q < 4; ++q) { s4 += *(const f32x4*)(sh + (size_t)q * 110592 + k); c4 += *(const f32x4*)(sc + (size_t)q * 110592 + k); }
      s4 += *(const f32x4*)(bsh + k); c4 += *(const f32x4*)(bsh + 1024 + k);
    }
    float y[4], z[4];
#pragma unroll
    for (int j = 0; j < 4; ++j) { const float gm = g4[j] * (1.f + c4[j]); y[j] = (v[0][i][j] * r0) * gm + s4[j]; z[j] = (v[1][i][j] * r1) * gm + s4[j]; }
    uint2 u; u.x = pack2(y[0], y[1]); u.y = pack2(y[2], y[3]);
    *(uint2*)(dst + k) = u;
    u.x = pack2(z[0], z[1]); u.y = pack2(z[2], z[3]);
    *(uint2*)(dst + 1024 + k) = u;
  }
}

__device__ __forceinline__ void phase_normmod_kv(CP& p) {
  const int lane = get_tid() & 63, wv = get_tid() >> 6;
  const float* g = p.norm_mix_g;
  for (int idx = get_bid() * 256 + get_tid(); idx < 110592; idx += VGRID * 256) {
    const int lr = idx / 6144; const int n = idx - lr * 6144; const int layer = lr / 9;
    p.modv[idx] = p.modp[idx] + p.modp[110592 + idx] + p.modp[2 * 110592 + idx] + p.modp[3 * 110592 + idx] + p.mod_b[layer * 6144 + n];
  }
  for (int r = (get_bid() * 4 + wv) * 2; r < 18432; r += VGRID * 8) {
    const int b = r / 2304, pp = r - b * 2304;
    const float* src; const float* mv;
    if (pp < 256) { src = p.ctx + ((size_t)b * 256 + pp) * 1024; mv = p.modp + (size_t)8 * 6144; }
    else { src = p.x + ((size_t)b * 2048 + pp - 256) * 1024; mv = p.modp + (size_t)b * 6144; }
    normmod_row2<true>(src, g, mv, mv + 1024, p.hxc + (size_t)r * 1024, lane, p.mod_b);
  }
}
__device__ __forceinline__ void phase_normmod_x(CP& p, const float* g, int layer, int chunk) {
  const int lane = get_tid() & 63, wv = get_tid() >> 6;
  for (int r = (get_bid() * 4 + wv) * 2; r < 16384; r += VGRID * 8) {
    const int b = r >> 11;
    const float* mv = p.modv + (size_t)(layer * 9 + b) * 6144 + chunk * 1024;
    normmod_row2<false>(p.X + (size_t)r * 1024, g, mv, mv + 1024, p.hxc + (size_t)r * 1024, lane);
  }
}
__device__ __forceinline__ void phase_final_norm(CP& p) {
  const int lane = get_tid() & 63, wv = get_tid() >> 6;
  for (int r = get_bid() * 4 + wv; r < 16384; r += VGRID * 4) {
    float* row = p.X + (size_t)r * 1024;
    f32x4 v[4]; float ss = 0.f;
#pragma unroll
    for (int i = 0; i < 4; ++i) { v[i] = *(const f32x4*)(row + lane * 4 + 256 * i); ss += v[i][0] * v[i][0] + v[i][1] * v[i][1] + v[i][2] * v[i][2] + v[i][3] * v[i][3]; }
    ss = wave_sum(ss);
    const float rr = rsqrtf(ss * (1.0f / 1024.0f) + 1e-6f);
#pragma unroll
    for (int i = 0; i < 4; ++i) {
      const int k = lane * 4 + 256 * i;
      const f32x4 g4 = *(const f32x4*)(p.final_g + k);
      f32x4 o; o[0] = v[i][0] * rr * g4[0]; o[1] = v[i][1] * rr * g4[1]; o[2] = v[i][2] * rr * g4[2]; o[3] = v[i][3] * rr * g4[3];
      *(f32x4*)(row + k) = o;
    }
  }
}

__device__ __forceinline__ void phase_rowstat(CP& p) {
  const int lane = get_tid() & 63, wv = get_tid() >> 6;
  for (int r = get_bid() * 4 + wv; r < 18432; r += VGRID * 4) {
    const int b = r / 2304, pp = r - b * 2304;
    const bf16_t* kvr = p.kv + (size_t)r * 288;
    {
      const uint2 u = *(const uint2*)(kvr + lane * 4);
      const float a0 = bf2f((bf16_t)(u.x & 0xffff)), a1 = bf2f((bf16_t)(u.x >> 16)), a2 = bf2f((bf16_t)(u.y & 0xffff)), a3 = bf2f((bf16_t)(u.y >> 16));
      float ss = a0 * a0 + a1 * a1 + a2 * a2 + a3 * a3;
      ss = wave_sum(ss);
      if (lane == 0) p.rkv[r] = rsqrtf(ss * (1.0f / 256.0f) + 1e-6f);
    }
    {
      const int i = lane & 31;
      const float xv = bf2f(kvr[256 + i]);
      const float ov = __shfl_xor(xv, 8);
      float res = xv;
      if (pp >= 256) {
        const int t = pp - 256;
        const int quarter = i >> 3, idx = i & 7;
        const float pos = (quarter < 2) ? (float)(t >> 6) : (float)(t & 63);
        const float inv = exp2f(-(float)idx * (13.287712379549449f / 8.0f));
        const float ang = pos * inv;
        const float cs = __cosf(ang), sn = __sinf(ang);
        res = xv * cs + ((quarter & 1) ? ov : -ov) * sn;
      }
      if (lane < 32) p.kpe[(size_t)r * 32 + i] = f2bf(res);
    }
    if (pp >= 256) {
      const int xr = b * 2048 + pp - 256;
      const uint4 u = *(const uint4*)(p.cq + (size_t)xr * 512 + lane * 8);
      const unsigned uu[4] = {u.x, u.y, u.z, u.w};
      float ss = 0.f;
#pragma unroll
      for (int j = 0; j < 4; ++j) { const float a = bf2f((bf16_t)(uu[j] & 0xffff)), bb = bf2f((bf16_t)(uu[j] >> 16)); ss += a * a + bb * bb; }
      ss = wave_sum(ss);
      if (lane == 0) p.rq[xr] = rsqrtf(ss * (1.0f / 512.0f) + 1e-6f);
    }
  }
}

struct EpiStore {
  static constexpr int KIND = 0;
  bf16_t* out; int ld; int ostride; const float* rs;
  __device__ __forceinline__ void c4(int g, int rig, int col, f32x4 v) const {
    const size_t row = (size_t)g * ostride + rig;
    const float s = rs ? rs[row] : 1.f;
    uint2 u; u.x = pack2(v[0] * s, v[1] * s); u.y = pack2(v[2] * s, v[3] * s);
    *(uint2*)(out + row * ld + col) = u;
  }
};
struct EpiVt {
  static constexpr int KIND = 1;
  bf16_t* out; const float* rs;
  __device__ __forceinline__ void r4(int g, int rig, int col, f32x4 v) const {
    const size_t row = (size_t)g * 2304 + rig;
    const f32x4 s = *(const f32x4*)(rs + row);
    uint2 u; u.x = pack2(v[0] * s[0], v[1] * s[1]); u.y = pack2(v[2] * s[2], v[3] * s[3]);
    *(uint2*)(out + ((size_t)g * 1024 + col) * 2304 + rig) = u;
  }
};
struct EpiFilt {
  static constexpr int KIND = 1;
  bf16_t* Rf; const float* decay;
  __device__ __forceinline__ void r4(int g, int rig, int col, f32x4 v) const {
    const int c = col & 1023; const bool bwd = col >= 1024;
    const float dec = fabsf(decay[c]);
    bf16_t* rp = Rf + (size_t)c * 4096;
#pragma unroll
    for (int j = 0; j < 4; ++j) {
      const int t = rig + j;
      const float val = v[j] * __expf(-(float)t * (1.0f / 2047.0f) * dec);
      if (!bwd) rp[2048 - t] = f2bf(val);
      else if (t > 0) rp[2048 + t] = f2bf(val);
      else rp[0] = 0;
    }
  }
};
struct EpiResid {
  static constexpr int KIND = 0;
  float* X; const float* base; const float* gate; const float* bias;
  __device__ __forceinline__ void c4(int g, int rig, int col, f32x4 v) const {
    const size_t o = ((size_t)g * 2048 + rig) * 1024 + col;
    const f32x4 bs = *(const f32x4*)(base + o);
    const f32x4 gt = *(const f32x4*)(gate + (size_t)g * 6144 + col);
    f32x4 bi = {0.f, 0.f, 0.f, 0.f};
    if (bias) bi = *(const f32x4*)(bias + col);
    f32x4 r;
#pragma unroll
    for (int j = 0; j < 4; ++j) r[j] = bs[j] + gt[j] * (v[j] + bi[j]);
    *(f32x4*)(X + o) = r;
  }
};
template <int MODE>
struct EpiConv {
  static constexpr int KIND = 2;
  const float* cw; const float* cb; int NC; const float* pre_bias;
  bf16_t* o0; bf16_t* o1;
  __device__ __forceinline__ int norig(int nt, int cl) const {
    if (MODE == 0) return (cl >> 6) * 2816 + nt * 64 + (cl & 63);
    if (nt < 8) return nt * 128 + cl;
    return 1024 + (cl >> 6) * 1024 + (nt - 8) * 64 + (cl & 63);
  }
  __device__ __forceinline__ void finish(const float* Z, int g, int rig0, int nt) const {
    const int tid = get_tid();
    if (MODE == 0 || nt < 8) {
      const int f = tid & 63, q = tid >> 6;
      const int p0 = 1 + 32 * q, p1 = (p0 + 32 < 127) ? p0 + 32 : 127;
      if (MODE == 0) {
        const int na = norig(nt, f), ng = norig(nt, 64 + f);
        const float a0 = cw[na], a1 = cw[NC + na], a2 = cw[2 * NC + na], ab = cb[na];
        const float g0 = cw[ng], g1 = cw[NC + ng], g2 = cw[2 * NC + ng], gb = cb[ng];
        float am = Z[(p0 - 1) * 132 + f], ac = Z[p0 * 132 + f], gm = Z[(p0 - 1) * 132 + 64 + f], gc = Z[p0 * 132 + 64 + f];
#pragma unroll 2
        for (int pl = p0; pl < p1; ++pl) {
          const float an = Z[(pl + 1) * 132 + f], gn = Z[(pl + 1) * 132 + 64 + f];
          const int pos = rig0 + pl;
          if (pos < 2048) {
            const float av = a0 * am + a1 * ac + a2 * an + ab;
            const float gv = g0 * gm + g1 * gc + g2 * gn + gb;
            o0[((size_t)g * 2048 + pos) * 2816 + nt * 64 + f] = f2bf(av * gv / (1.f + __expf(-gv)));
          }
          am = ac; ac = an; gm = gc; gc = gn;
        }
      } else {
#pragma unroll
        for (int fh = 0; fh < 2; ++fh) {
          const int cl = fh * 64 + f;
          const int na = norig(nt, cl);
          const float a0 = cw[na], a1 = cw[NC + na], a2 = cw[2 * NC + na], ab = cb[na];
          float am = Z[(p0 - 1) * 132 + cl], ac = Z[p0 * 132 + cl];
#pragma unroll 2
          for (int pl = p0; pl < p1; ++pl) {
            const float an = Z[(pl + 1) * 132 + cl];
            const int pos = rig0 + pl;
            if (pos < 2048) o0[((size_t)g * 2048 + pos) * 1024 + nt * 128 + cl] = f2bf(a0 * am + a1 * ac + a2 * an + ab);
            am = ac; ac = an;
          }
        }
      }
    } else {
      const int pl = tid & 127, fh = tid >> 7;
      const int pos = rig0 + pl;
      if (pl >= 1 && pl <= 126 && pos < 2048) {
        const int fb = nt - 8;
#pragma unroll 2
        for (int f = fh * 32; f < fh * 32 + 32; ++f) {
          const int na = norig(nt, f), nb = norig(nt, 64 + f);
          const float va = cw[na] * Z[(pl - 1) * 132 + f] + cw[NC + na] * Z[pl * 132 + f] + cw[2 * NC + na] * Z[(pl + 1) * 132 + f] + cb[na];
          const float vb = cw[nb] * Z[(pl - 1) * 132 + 64 + f] + cw[NC + nb] * Z[pl * 132 + 64 + f] + cw[2 * NC + nb] * Z[(pl + 1) * 132 + 64 + f] + cb[nb];
          o1[(size_t)(fb * 64 + f) * 16384 + g * 2048 + pos] = f2bf(va * vb);
        }
      }
    }
  }
};

#define GLDS16(gp, lp) __builtin_amdgcn_global_load_lds((const unsigned*)(gp), (__attribute__((address_space(3))) unsigned*)(lp), 16, 0, 0)

template <bool SWAP, class Epi>
__device__ __forceinline__ void gemm_job(char* smem, const bf16_t* __restrict__ A, int lda, const bf16_t* __restrict__ Bt, int K, int N,
                                         int tpg, int a_gstride, int a_goff, int step, int halo, int grows, int MTS, int voff, int vid0, int grid, const Epi& epi) {
  const int tid = get_tid512(), lane = tid & 63, wid = tid >> 6, wr = wid >> 1, wc = wid & 1, fr = lane & 15, fq = lane >> 4;
  const int NT = (N + 255) >> 8, MT = MTS >> 1, ntiles = MT * NT, nk = K >> 5;
  const int full = MT >> 3;
  int v = vid0;
  if (v < voff) v += ((voff - v + grid - 1) / grid) * grid;
  const int rdoff = ((fq ^ ((0x78 >> (((fr >> 2) & 3) * 2)) & 3)) << 4);
  for (; v < voff + ntiles; v += grid) {
    const int w = v - voff;
    int mt, nt;
    if (w < full * 8 * NT) { const int sr = w / (8 * NT), rem = w - sr * 8 * NT; nt = rem >> 3; mt = sr * 8 + (rem & 7); }
    else { const int w2 = w - full * 8 * NT, rl = MT - full * 8; nt = w2 / rl; mt = full * 8 + (w2 - nt * rl); }
    unsigned ap[2], bp[2];
#pragma unroll
    for (int i = 0; i < 2; ++i) {
      const int b = tid * 16 + i * 8192;
      const int r = b >> 6;
      const int cs = (b & 63) >> 4;
      const int c = ((cs ^ ((0x78 >> (((r >> 2) & 3) * 2)) & 3)) << 3);
      const int sub = 2 * mt + (r >> 7);
      const int g = sub / tpg, ti = sub - g * tpg;
      int rig = ti * step - halo + (r & 127); rig = rig < 0 ? 0 : (rig > grows - 1 ? grows - 1 : rig);
      ap[i] = (unsigned)((g * a_gstride + a_goff + rig) * lda + c);
      int br = nt * 256 + r; br = br > N - 1 ? N - 1 : br;
      bp[i] = (unsigned)(br * K + c);
    }
    f32x4 acc[4][8];
#pragma unroll
    for (int m = 0; m < 4; ++m)
#pragma unroll
      for (int n = 0; n < 8; ++n) acc[m][n] = (f32x4){0.f, 0.f, 0.f, 0.f};
#pragma unroll
    for (int st = 0; st < 3; ++st) {
      if (st < nk) {
        char* nb = smem + st * 32768;
#pragma unroll
        for (int i = 0; i < 2; ++i) GLDS16(A + (size_t)(ap[i] + st * 32), nb + tid * 16 + i * 8192);
#pragma unroll
        for (int i = 0; i < 2; ++i) GLDS16(Bt + (size_t)(bp[i] + st * 32), nb + 16384 + tid * 16 + i * 8192);
      }
    }
    for (int t = 0; t < nk; ++t) {
      if (t + 2 < nk) asm volatile("s_waitcnt vmcnt(8)" ::: "memory");
      else if (t + 1 < nk) asm volatile("s_waitcnt vmcnt(4)" ::: "memory");
      else asm volatile("s_waitcnt vmcnt(0)" ::: "memory");
      __builtin_amdgcn_s_barrier();
      asm volatile("" ::: "memory");
      if (t + 3 < nk) {
        char* nb = smem + ((t + 3) & 3) * 32768;
        const int ko = (t + 3) * 32;
#pragma unroll
        for (int i = 0; i < 2; ++i) GLDS16(A + (size_t)(ap[i] + ko), nb + tid * 16 + i * 8192);
#pragma unroll
        for (int i = 0; i < 2; ++i) GLDS16(Bt + (size_t)(bp[i] + ko), nb + 16384 + tid * 16 + i * 8192);
      }
      const char* sa = smem + (t & 3) * 32768; const char* sb = sa + 16384;
      bf16x8 af[4];
#pragma unroll
      for (int m = 0; m < 4; ++m) af[m] = *(const bf16x8*)(sa + (wr * 64 + m * 16 + fr) * 64 + rdoff);
#pragma unroll
      for (int nh = 0; nh < 4; ++nh) {
        bf16x8 bf[2];
#pragma unroll
        for (int n = 0; n < 2; ++n) bf[n] = *(const bf16x8*)(sb + (wc * 128 + (nh * 2 + n) * 16 + fr) * 64 + rdoff);
#pragma unroll
        for (int m = 0; m < 4; ++m)
#pragma unroll
          for (int n = 0; n < 2; ++n)
            acc[m][nh * 2 + n] = SWAP ? __builtin_amdgcn_mfma_f32_16x16x32_bf16(bf[n], af[m], acc[m][nh * 2 + n], 0, 0, 0)
                                      : __builtin_amdgcn_mfma_f32_16x16x32_bf16(af[m], bf[n], acc[m][nh * 2 + n], 0, 0, 0);
      }
    }
    __syncthreads();
    const int te = get_tid512();
    const int fr_e = te & 15, fq_e = (te & 63) >> 4, wr_e = te >> 7, wc_e = (te >> 6) & 1;
    const int sub = 2 * mt + (wr_e >> 1);
    const int g = sub / tpg, ti = sub - g * tpg;
    const int rig0 = ti * step - halo;
    const int rw = (wr_e & 1) * 64;
    if constexpr (Epi::KIND == 0) {
#pragma unroll
      for (int m = 0; m < 4; ++m) {
        const int rig = rig0 + rw + m * 16 + fr_e;
#pragma unroll
        for (int n = 0; n < 8; ++n) {
          const int col = nt * 256 + wc_e * 128 + n * 16 + fq_e * 4;
          if (col < N) epi.c4(g, rig, col, acc[m][n]);
        }
      }
    } else if constexpr (Epi::KIND == 1) {
#pragma unroll
      for (int m = 0; m < 4; ++m) {
        const int rig = rig0 + rw + m * 16 + fq_e * 4;
#pragma unroll
        for (int n = 0; n < 8; ++n) {
          const int col = nt * 256 + wc_e * 128 + n * 16 + fr_e;
          if (col < N) epi.r4(g, rig, col, acc[m][n]);
        }
      }
    } else {
      float* Z = (float*)smem + (wr_e >> 1) * (128 * 132);
#pragma unroll
      for (int h = 0; h < 2; ++h) {
        const int nt2 = nt * 2 + h;
        if (wc_e == h) {
#pragma unroll
          for (int n = 0; n < 8; ++n) {
            const int cl = n * 16 + fq_e * 4;
            f32x4 b4 = {0.f, 0.f, 0.f, 0.f};
            if (epi.pre_bias) b4 = *(const f32x4*)(epi.pre_bias + epi.norig(nt2, cl));
#pragma unroll
            for (int m = 0; m < 4; ++m) {
              const int rl = rw + m * 16 + fr_e;
              const int pos = rig0 + rl;
              const bool ok = pos >= 0 && pos < grows;
              f32x4 vv = acc[m][n] + b4;
              if (!ok) vv = (f32x4){0.f, 0.f, 0.f, 0.f};
              *(f32x4*)(Z + rl * 132 + cl) = vv;
            }
          }
        }
        __syncthreads();
        epi.finish(Z, g, rig0, nt2);
        __syncthreads();
      }
    }
    asm volatile("s_waitcnt vmcnt(0)" ::: "memory");
    __syncthreads();
  }
}

__device__ __forceinline__ void phase_attn(CP& p, char* smem, int vid0, int grid) {
  bf16_t* Ks = (bf16_t*)smem;
  bf16_t* Vs = (bf16_t*)(smem + 64 * 104 * 2);
  const int tid = get_tid(), lane = tid & 63, w = tid >> 6, r = lane & 31, hh = lane >> 5;
  const float cs = 1.4426950408889634f * 0.10206207261596577f;
  for (int it = vid0; it < 2048; it += grid) {
    const int qt = it & 15, h = (it >> 4) & 15, b = it >> 8;
    const int t = qt * 128 + w * 32 + r;
    const size_t xrow = (size_t)b * 2048 + t;
    const bf16_t* qp = p.Q + xrow * 1536 + h * 96;
    bf16x8 qf[6];
#pragma unroll
    for (int kk = 0; kk < 4; ++kk) qf[kk] = *(const bf16x8*)(qp + 16 * kk + 8 * hh);
#pragma unroll
    for (int part = 0; part < 2; ++part) {
      const bf16_t* pp = qp + 64 + 16 * part;
      const bf16x8 mine = *(const bf16x8*)(pp + 8 * hh), oth = *(const bf16x8*)(pp + 8 * (1 - hh));
      const float posf = part == 0 ? (float)(t >> 6) : (float)(t & 63);
      union { unsigned u[4]; bf16x8 v; } o;
      float res[8];
#pragma unroll
      for (int j = 0; j < 8; ++j) {
        const float inv = exp2f(-(float)j * (13.287712379549449f / 8.0f));
        const float ang = posf * inv;
        const float c = __cosf(ang), s = __sinf(ang);
        const float m = bf2f((bf16_t)mine[j]), ov = bf2f((bf16_t)oth[j]);
        res[j] = m * c + (hh ? ov : -ov) * s;
      }
#pragma unroll
      for (int j = 0; j < 4; ++j) o.u[j] = pack2(res[2 * j], res[2 * j + 1]);
      qf[4 + part] = o.v;
    }
    f32x16 oacc[2];
#pragma unroll
    for (int i = 0; i < 16; ++i) { oacc[0][i] = 0.f; oacc[1][i] = 0.f; }
    float mrun = -INFINITY, lrun = 0.f;
    const size_t kvrow0 = (size_t)b * 2304;
    const bf16_t* kn_base = p.Kn + kvrow0 * 1024 + h * 64;
    const bf16_t* kpe_base = p.kpe + kvrow0 * 32;
    const bf16_t* vt_base = p.Vt + ((size_t)(b * 16 + h) * 64) * 2304;
    uint4 rk0, rk1, rp, rv0, rv1;
    const int srow = tid >> 3, sch = tid & 7;
#define ATT_GLOAD(kt) do { \
      rk0 = *(const uint4*)(kn_base + (size_t)((kt) * 64 + srow) * 1024 + sch * 8); \
      rk1 = *(const uint4*)(kn_base + (size_t)((kt) * 64 + srow + 32) * 1024 + sch * 8); \
      rv0 = *(const uint4*)(vt_base + (size_t)srow * 2304 + (kt) * 64 + sch * 8); \
      rv1 = *(const uint4*)(vt_base + (size_t)(srow + 32) * 2304 + (kt) * 64 + sch * 8); \
      rp = *(const uint4*)(kpe_base + (size_t)((kt) * 64 + (tid >> 2)) * 32 + (tid & 3) * 8); } while (0)
    ATT_GLOAD(0);
    for (int kt = 0; kt < 36; ++kt) {
      __syncthreads();
      {
        *(uint4*)(Ks + srow * 104 + sch * 8) = rk0;
        *(uint4*)(Ks + (srow + 32) * 104 + sch * 8) = rk1;
        uint2 lo, hi;
        lo.x = rv0.x; lo.y = rv0.y; hi.x = rv0.z; hi.y = rv0.w;
        *(uint2*)(Vs + srow * 68 + sch * 8) = lo; *(uint2*)(Vs + srow * 68 + sch * 8 + 4) = hi;
        lo.x = rv1.x; lo.y = rv1.y; hi.x = rv1.z; hi.y = rv1.w;
        *(uint2*)(Vs + (srow + 32) * 68 + sch * 8) = lo; *(uint2*)(Vs + (srow + 32) * 68 + sch * 8 + 4) = hi;
      }
      *(uint4*)(Ks + (tid >> 2) * 104 + 64 + (tid & 3) * 8) = rp;
      __syncthreads();
      if (kt + 1 < 36) ATT_GLOAD(kt + 1);
      f32x16 s[2];
#pragma unroll
      for (int t2 = 0; t2 < 2; ++t2) {
#pragma unroll
        for (int i = 0; i < 16; ++i) s[t2][i] = 0.f;
#pragma unroll
        for (int kk = 0; kk < 6; ++kk) {
          const bf16x8 a = *(const bf16x8*)(Ks + (32 * t2 + r) * 104 + 16 * kk + 8 * hh);
          s[t2] = __builtin_amdgcn_mfma_f32_32x32x16_bf16(a, qf[kk], s[t2], 0, 0, 0);
        }
      }
      float mx = s[0][0];
#pragma unroll
      for (int i = 1; i < 16; ++i) mx = fmaxf(mx, s[0][i]);
#pragma unroll
      for (int i = 0; i < 16; ++i) mx = fmaxf(mx, s[1][i]);
      mx = fmaxf(mx, __shfl_xor(mx, 32));
      const float mnew = fmaxf(mrun, mx * cs);
      const float alpha = __builtin_amdgcn_exp2f(mrun - mnew);
      mrun = mnew;
      float psum = 0.f;
      bf16x8 pf[4];
#pragma unroll
      for (int t2 = 0; t2 < 2; ++t2)
#pragma unroll
        for (int hf = 0; hf < 2; ++hf) {
          union { unsigned u[4]; bf16x8 v; } cvp;
#pragma unroll
          for (int i = 0; i < 4; ++i) {
            const float p0 = __builtin_amdgcn_exp2f(s[t2][hf * 8 + 2 * i] * cs - mnew);
            const float p1 = __builtin_amdgcn_exp2f(s[t2][hf * 8 + 2 * i + 1] * cs - mnew);
            psum += p0 + p1;
            cvp.u[i] = pack2(p0, p1);
          }
          pf[t2 * 2 + hf] = cvp.v;
        }
      lrun = lrun * alpha + psum;
#pragma unroll
      for (int i = 0; i < 16; ++i) { oacc[0][i] *= alpha; oacc[1][i] *= alpha; }
#pragma unroll
      for (int dt = 0; dt < 2; ++dt)
#pragma unroll
        for (int s4 = 0; s4 < 4; ++s4) {
          const bf16_t* vp = Vs + (32 * dt + r) * 68 + 16 * s4 + 4 * hh;
          const uint2 lo = *(const uint2*)vp, hi = *(const uint2*)(vp + 8);
          union { uint4 u; bf16x8 v; } cv; cv.u.x = lo.x; cv.u.y = lo.y; cv.u.z = hi.x; cv.u.w = hi.y;
          oacc[dt] = __builtin_amdgcn_mfma_f32_32x32x16_bf16(cv.v, pf[s4], oacc[dt], 0, 0, 0);
        }
    }
    const float ltot = lrun + __shfl_xor(lrun, 32);
    const float inv = 1.f / ltot;
    bf16_t* op = p.hxc + xrow * 1024 + h * 64;
#pragma unroll
    for (int dt = 0; dt < 2; ++dt)
#pragma unroll
      for (int i4 = 0; i4 < 4; ++i4) {
        const int d = 32 * dt + 8 * i4 + 4 * hh;
        uint2 u; u.x = pack2(oacc[dt][4 * i4] * inv, oacc[dt][4 * i4 + 1] * inv); u.y = pack2(oacc[dt][4 * i4 + 2] * inv, oacc[dt][4 * i4 + 3] * inv);
        *(uint2*)(op + d) = u;
      }
  }
}

__device__ __forceinline__ void phase_hyconv(CP& p, char* smem) {
  bf16_t* cp = (bf16_t*)smem;
  bf16_t* Vl = (bf16_t*)(smem + 4 * 8256);
  const int tid = get_tid(), lane = tid & 63, w = tid >> 6, i16 = lane & 15, g4 = lane >> 4;
  const int si = (-i16) & 3;
  const int ocb = 64 * w;
  for (int c = get_bid(); c < 1024; c += VGRID) {
    __syncthreads();
#pragma unroll
    for (int i = 0; i < 2; ++i) { const int ch = tid + 256 * i; *(uint4*)(cp + ch * 8) = *(const uint4*)(p.Rf + (size_t)c * 4096 + ch * 8); }
#pragma unroll
    for (int i = 0; i < 8; ++i) {
      const int q = tid + 256 * i; const int b = q >> 8, l8 = q & 255; const int m1 = l8 >> 3, m2 = (l8 & 7) * 8;
      *(uint4*)(Vl + (8 + m1 * 8 + b) * 80 + m2) = *(const uint4*)(p.vvT + (size_t)c * 16384 + b * 2048 + l8 * 8);
    }
    if (tid < 144) {
      const int colp = tid / 9, part = tid - colp * 9;
      const int col = colp < 8 ? colp : 256 + colp;
      uint4 zz; zz.x = 0; zz.y = 0; zz.z = 0; zz.w = 0;
      *(uint4*)(Vl + col * 80 + part * 8) = zz;
    }
    __syncthreads();
#pragma unroll
    for (int s = 1; s < 4; ++s)
#pragma unroll
      for (int i = 0; i < 2; ++i) {
        const int ch = tid + 256 * i;
        unsigned e[8];
#pragma unroll
        for (int j = 0; j < 8; ++j) { const int idx = 8 * ch + s + j; e[j] = idx < 4096 ? (unsigned)cp[idx] : 0u; }
        uint4 u; u.x = e[0] | (e[1] << 16); u.y = e[2] | (e[3] << 16); u.z = e[4] | (e[5] << 16); u.w = e[6] | (e[7] << 16);
        *(uint4*)(cp + s * 4128 + 8 * ch) = u;
      }
    __syncthreads();
    const bf16_t* abase = cp + si * 4128 + (2048 - i16 - si + 8 * g4);
    f32x4 acc[4][4];
#pragma unroll
    for (int m = 0; m < 4; ++m)
#pragma unroll
      for (int n = 0; n < 4; ++n) acc[m][n] = (f32x4){0.f, 0.f, 0.f, 0.f};
    for (int dl = -31; dl <= 31; ++dl) {
      bf16x8 af[4][2];
#pragma unroll
      for (int mt = 0; mt < 4; ++mt)
#pragma unroll
        for (int kk = 0; kk < 2; ++kk) {
          const bf16_t* ap = abase - 64 * dl - 16 * mt + 32 * kk;
          const uint2 lo = *(const uint2*)ap, hi = *(const uint2*)(ap + 4);
          union { uint4 u; bf16x8 v; } cv; cv.u.x = lo.x; cv.u.y = lo.y; cv.u.z = hi.x; cv.u.w = hi.y;
          af[mt][kk] = cv.v;
        }
#pragma unroll
      for (int jt = 0; jt < 4; ++jt) {
        const int in0 = ocb + 16 * jt - 8 * dl;
        if (in0 >= -8 && in0 <= 248) {
          const bf16_t* bp = Vl + (in0 + 8 + i16) * 80 + 8 * g4;
          const bf16x8 b0 = *(const bf16x8*)bp, b1 = *(const bf16x8*)(bp + 32);
#pragma unroll
          for (int mt = 0; mt < 4; ++mt) {
            acc[mt][jt] = __builtin_amdgcn_mfma_f32_16x16x32_bf16(af[mt][0], b0, acc[mt][jt], 0, 0, 0);
            acc[mt][jt] = __builtin_amdgcn_mfma_f32_16x16x32_bf16(af[mt][1], b1, acc[mt][jt], 0, 0, 0);
          }
        }
      }
    }
    const float db = p.hy_d_bias[c];
#pragma unroll
    for (int mt = 0; mt < 4; ++mt)
#pragma unroll
      for (int jt = 0; jt < 4; ++jt) {
        const int col = ocb + 16 * jt + i16;
        const int n1 = col >> 3, b = col & 7;
        const int n2 = 16 * mt + 4 * g4;
        const uint2 vv = *(const uint2*)(Vl + (col + 8) * 80 + n2);
        const float y0 = acc[mt][jt][0] + bf2f((bf16_t)(vv.x & 0xffff)) * db;
        const float y1 = acc[mt][jt][1] + bf2f((bf16_t)(vv.x >> 16)) * db;
        const float y2 = acc[mt][jt][2] + bf2f((bf16_t)(vv.y & 0xffff)) * db;
        const float y3 = acc[mt][jt][3] + bf2f((bf16_t)(vv.y >> 16)) * db;
        uint2 u; u.x = pack2(y0, y1); u.y = pack2(y2, y3);
        *(uint2*)(p.Yp + (size_t)c * 16384 + b * 2048 + n1 * 64 + n2) = u;
      }
  }
}

__device__ __forceinline__ void phase_transmul(CP& p, char* smem) {
  bf16_t* tl = (bf16_t*)smem;
  const int tid = get_tid();
  for (int it = get_bid(); it < 4096; it += VGRID) {
    const int ct = it & 15, rt = it >> 4;
    const int c0 = ct * 64, r0 = rt * 64;
    __syncthreads();
#pragma unroll
    for (int i = 0; i < 2; ++i) {
      const int ci = tid + 256 * i; const int cc = ci >> 3, ch = ci & 7;
      const uint4 u = *(const uint4*)(p.Yp + (size_t)(c0 + cc) * 16384 + r0 + ch * 8);
      unsigned* d = (unsigned*)(tl + cc * 66 + ch * 8);
      d[0] = u.x; d[1] = u.y; d[2] = u.z; d[3] = u.w;
    }
    __syncthreads();
    const int row = tid >> 2, cq = tid & 3;
    const bf16_t* xp = p.x1h + (size_t)(r0 + row) * 1024 + c0 + cq * 16;
    const uint4 xa = *(const uint4*)xp, xb = *(const uint4*)(xp + 8);
    const unsigned xs[8] = {xa.x, xa.y, xa.z, xa.w, xb.x, xb.y, xb.z, xb.w};
    unsigned o[8];
#pragma unroll
    for (int j = 0; j < 8; ++j) {
      const float y0 = bf2f(tl[(cq * 16 + 2 * j) * 66 + row]) * bf2f((bf16_t)(xs[j] & 0xffff));
      const float y1 = bf2f(tl[(cq * 16 + 2 * j + 1) * 66 + row]) * bf2f((bf16_t)(xs[j] >> 16));
      o[j] = pack2(y0, y1);
    }
    bf16_t* op = p.hxc + (size_t)(r0 + row) * 1024 + c0 + cq * 16;
    uint4 oa; oa.x = o[0]; oa.y = o[1]; oa.z = o[2]; oa.w = o[3];
    uint4 ob; ob.x = o[4]; ob.y = o[5]; ob.z = o[6]; ob.w = o[7];
    *(uint4*)op = oa; *(uint4*)(op + 8) = ob;
  }
}

__global__ void __launch_bounds__(512, 2) mega(P p_arg) {
  __shared__ __attribute__((aligned(16))) char smem[LDS_BYTES];
  cg::grid_group grid = cg::this_grid();
  const int G = gridDim.x;
  CP* pp = (CP*)__builtin_amdgcn_kernarg_segment_ptr();
  const int ph0 = pp->ph0, ph1 = pp->ph1;
  volatile LAS unsigned* xst = (volatile LAS unsigned*)(smem + LDS_BYTES - 16);
  if (threadIdx.x == 0) { xst[0] = 0u; xst[1] = 0u; }
  __syncthreads();
  const XcdBarrier xb = xcd_barrier_post(pp->bar, xst);
  if (ph0 <= 0 && 0 < ph1) {
    asm volatile("" : "+s"(pp));
    CP& p = *pp;
    const int bid = get_rbid();
    const int vid0 = (G & 7) ? bid : ((bid & 7) * (G >> 3) + (bid >> 3));
    const int hb = get_hb();
    char* smem_h = smem + hb * HALF_LDS; (void)smem_h;
    const float* mv0 = p.modv; const float* mv1 = p.modv + (size_t)9 * 6144;
    (void)mv0; (void)mv1; (void)vid0;
    phase_prep(p, smem_h);
    if (0 + 1 < ph1) { if (ph1 > 1000) grid.sync(); else xcd_barrier(xb); }
  }
  if (ph0 <= 1 && 1 < ph1) {
    asm volatile("" : "+s"(pp));
    CP& p = *pp;
    const int bid = get_rbid();
    const int vid0 = (G & 7) ? bid : ((bid & 7) * (G >> 3) + (bid >> 3));
    const int hb = get_hb();
    char* smem_h = smem + hb * HALF_LDS; (void)smem_h;
    const float* mv0 = p.modv; const float* mv1 = p.modv + (size_t)9 * 6144;
    (void)mv0; (void)mv1; (void)vid0;
    phase_normmod_kv(p);
    if (1 + 1 < ph1) { if (ph1 > 1000) grid.sync(); else xcd_barrier(xb); }
  }
  if (ph0 <= 2 && 2 < ph1) {
    asm volatile("" : "+s"(pp));
    CP& p = *pp;
    const int bid = get_rbid();
    const int vid0 = (G & 7) ? bid : ((bid & 7) * (G >> 3) + (bid >> 3));
    const int hb = get_hb();
    char* smem_h = smem + hb * HALF_LDS; (void)smem_h;
    const float* mv0 = p.modv; const float* mv1 = p.modv + (size_t)9 * 6144;
    (void)mv0; (void)mv1; (void)vid0;
    {
        EpiStore e1{p.cq, 512, 2048, nullptr};
        gemm_job<true>(smem, p.hxc, 1024, p.wt_dq, 1024, 512, 16, 2304, 256, 128, 0, 2048, 128, 0, vid0, G, e1);
        EpiStore e2{p.kv, 288, 2304, nullptr};
        gemm_job<true>(smem, p.hxc, 1024, p.wt_dkv, 1024, 288, 18, 2304, 0, 128, 0, 2304, 144, 64 * 2, vid0, G, e2);
        EpiFilt e3{p.Rf, p.hy_decay};
        gemm_job<false>(smem, p.h2bf, 64, p.wt_f3, 64, 2048, 16, 0, 0, 128, 0, 2048, 16, 64 * 2 + 72 * 2, vid0, G, e3);
      }
    if (2 + 1 < ph1) { if (ph1 > 1000) grid.sync(); else xcd_barrier(xb); }
  }
  if (ph0 <= 3 && 3 < ph1) {
    asm volatile("" : "+s"(pp));
    CP& p = *pp;
    const int bid = get_rbid();
    const int vid0 = (G & 7) ? bid : ((bid & 7) * (G >> 3) + (bid >> 3));
    const int hb = get_hb();
    char* smem_h = smem + hb * HALF_LDS; (void)smem_h;
    const float* mv0 = p.modv; const float* mv1 = p.modv + (size_t)9 * 6144;
    (void)mv0; (void)mv1; (void)vid0;
    phase_rowstat(p);
    if (3 + 1 < ph1) { if (ph1 > 1000) grid.sync(); else xcd_barrier(xb); }
  }
  if (ph0 <= 4 && 4 < ph1) {
    asm volatile("" : "+s"(pp));
    CP& p = *pp;
    const int bid = get_rbid();
    const int vid0 = (G & 7) ? bid : ((bid & 7) * (G >> 3) + (bid >> 3));
    const int hb = get_hb();
    char* smem_h = smem + hb * HALF_LDS; (void)smem_h;
    const float* mv0 = p.modv; const float* mv1 = p.modv + (size_t)9 * 6144;
    (void)mv0; (void)mv1; (void)vid0;
    {
        EpiStore e1{p.Q, 1536, 2048, p.rq};
        gemm_job<true>(smem, p.cq, 512, p.wt_uq, 512, 1536, 16, 2048, 0, 128, 0, 2048, 128, 0, vid0, G, e1);
        EpiStore e2{p.Kn, 1024, 2304, p.rkv};
        gemm_job<true>(smem, p.kv, 288, p.wt_uk, 256, 1024, 18, 2304, 0, 128, 0, 2304, 144, 64 * 6, vid0, G, e2);
        EpiVt e3{p.Vt, p.rkv};
        gemm_job<false>(smem, p.kv, 288, p.wt_uv, 256, 1024, 18, 2304, 0, 128, 0, 2304, 144, 64 * 6 + 72 * 4, vid0, G, e3);
      }
    if (4 + 1 < ph1) { if (ph1 > 1000) grid.sync(); else xcd_barrier(xb); }
  }
  if (ph0 <= 5 && 5 < ph1) {
    asm volatile("" : "+s"(pp));
    CP& p = *pp;
    const int bid = get_rbid();
    const int vid0 = (G & 7) ? bid : ((bid & 7) * (G >> 3) + (bid >> 3));
    const int hb = get_hb();
    char* smem_h = smem + hb * HALF_LDS; (void)smem_h;
    const float* mv0 = p.modv; const float* mv1 = p.modv + (size_t)9 * 6144;
    (void)mv0; (void)mv1; (void)vid0;
    phase_attn(p, smem_h, 2 * vid0 + hb, 2 * G);
    if (5 + 1 < ph1) { if (ph1 > 1000) grid.sync(); else xcd_barrier(xb); }
  }
  if (ph0 <= 6 && 6 < ph1) {
    asm volatile("" : "+s"(pp));
    CP& p = *pp;
    const int bid = get_rbid();
    const int vid0 = (G & 7) ? bid : ((bid & 7) * (G >> 3) + (bid >> 3));
    const int hb = get_hb();
    char* smem_h = smem + hb * HALF_LDS; (void)smem_h;
    const float* mv0 = p.modv; const float* mv1 = p.modv + (size_t)9 * 6144;
    (void)mv0; (void)mv1; (void)vid0;
    {
        EpiResid e{p.X, p.x, mv0 + 2 * 1024, nullptr};
        gemm_job<true>(smem, p.hxc, 1024, p.wt_o, 1024, 1024, 16, 2048, 0, 128, 0, 2048, 128, 0, vid0, G, e);
      }
    if (6 + 1 < ph1) { if (ph1 > 1000) grid.sync(); else xcd_barrier(xb); }
  }
  if (ph0 <= 7 && 7 < ph1) {
    asm volatile("" : "+s"(pp));
    CP& p = *pp;
    const int bid = get_rbid();
    const int vid0 = (G & 7) ? bid : ((bid & 7) * (G >> 3) + (bid >> 3));
    const int hb = get_hb();
    char* smem_h = smem + hb * HALF_LDS; (void)smem_h;
    const float* mv0 = p.modv; const float* mv1 = p.modv + (size_t)9 * 6144;
    (void)mv0; (void)mv1; (void)vid0;
    phase_normmod_x(p, p.norm_ffn_g, 0, 3);
    if (7 + 1 < ph1) { if (ph1 > 1000) grid.sync(); else xcd_barrier(xb); }
  }
  if (ph0 <= 8 && 8 < ph1) {
    asm volatile("" : "+s"(pp));
    CP& p = *pp;
    const int bid = get_rbid();
    const int vid0 = (G & 7) ? bid : ((bid & 7) * (G >> 3) + (bid >> 3));
    const int hb = get_hb();
    char* smem_h = smem + hb * HALF_LDS; (void)smem_h;
    const float* mv0 = p.modv; const float* mv1 = p.modv + (size_t)9 * 6144;
    (void)mv0; (void)mv1; (void)vid0;
    {
        EpiConv<0> e{p.ffn_conv_w, p.ffn_conv_b, 5632, nullptr, p.act, nullptr};
        gemm_job<true>(smem, p.hxc, 1024, p.wt_up0, 1024, 5632, 17, 2048, 0, 126, 1, 2048, 136, 0, vid0, G, e);
      }
    if (8 + 1 < ph1) { if (ph1 > 1000) grid.sync(); else xcd_barrier(xb); }
  }
  if (ph0 <= 9 && 9 < ph1) {
    asm volatile("" : "+s"(pp));
    CP& p = *pp;
    const int bid = get_rbid();
    const int vid0 = (G & 7) ? bid : ((bid & 7) * (G >> 3) + (bid >> 3));
    const int hb = get_hb();
    char* smem_h = smem + hb * HALF_LDS; (void)smem_h;
    const float* mv0 = p.modv; const float* mv1 = p.modv + (size_t)9 * 6144;
    (void)mv0; (void)mv1; (void)vid0;
    {
        EpiResid e{p.X, p.X, mv0 + 5 * 1024, nullptr};
        gemm_job<true>(smem, p.act, 2816, p.wt_dn0, 2816, 1024, 16, 2048, 0, 128, 0, 2048, 128, 0, vid0, G, e);
      }
    if (9 + 1 < ph1) { if (ph1 > 1000) grid.sync(); else xcd_barrier(xb); }
  }
  if (ph0 <= 10 && 10 < ph1) {
    asm volatile("" : "+s"(pp));
    CP& p = *pp;
    const int bid = get_rbid();
    const int vid0 = (G & 7) ? bid : ((bid & 7) * (G >> 3) + (bid >> 3));
    const int hb = get_hb();
    char* smem_h = smem + hb * HALF_LDS; (void)smem_h;
    const float* mv0 = p.modv; const float* mv1 = p.modv + (size_t)9 * 6144;
    (void)mv0; (void)mv1; (void)vid0;
    phase_normmod_x(p, p.norm_mix_g + 1024, 1, 0);
    if (10 + 1 < ph1) { if (ph1 > 1000) grid.sync(); else xcd_barrier(xb); }
  }
  if (ph0 <= 11 && 11 < ph1) {
    asm volatile("" : "+s"(pp));
    CP& p = *pp;
    const int bid = get_rbid();
    const int vid0 = (G & 7) ? bid : ((bid & 7) * (G >> 3) + (bid >> 3));
    const int hb = get_hb();
    char* smem_h = smem + hb * HALF_LDS; (void)smem_h;
    const float* mv0 = p.modv; const float* mv1 = p.modv + (size_t)9 * 6144;
    (void)mv0; (void)mv1; (void)vid0;
    {
        EpiConv<1> e{p.hy_conv_w, p.hy_conv_b, 3072, p.hy_b_in, p.x1h, p.vvT};
        gemm_job<true>(smem, p.hxc, 1024, p.wt_hin, 1024, 3072, 17, 2048, 0, 126, 1, 2048, 136, 0, vid0, G, e);
      }
    if (11 + 1 < ph1) { if (ph1 > 1000) grid.sync(); else xcd_barrier(xb); }
  }
  if (ph0 <= 12 && 12 < ph1) {
    asm volatile("" : "+s"(pp));
    CP& p = *pp;
    const int bid = get_rbid();
    const int vid0 = (G & 7) ? bid : ((bid & 7) * (G >> 3) + (bid >> 3));
    const int hb = get_hb();
    char* smem_h = smem + hb * HALF_LDS; (void)smem_h;
    const float* mv0 = p.modv; const float* mv1 = p.modv + (size_t)9 * 6144;
    (void)mv0; (void)mv1; (void)vid0;
    phase_hyconv(p, smem_h);
    if (12 + 1 < ph1) { if (ph1 > 1000) grid.sync(); else xcd_barrier(xb); }
  }
  if (ph0 <= 13 && 13 < ph1) {
    asm volatile("" : "+s"(pp));
    CP& p = *pp;
    const int bid = get_rbid();
    const int vid0 = (G & 7) ? bid : ((bid & 7) * (G >> 3) + (bid >> 3));
    const int hb = get_hb();
    char* smem_h = smem + hb * HALF_LDS; (void)smem_h;
    const float* mv0 = p.modv; const float* mv1 = p.modv + (size_t)9 * 6144;
    (void)mv0; (void)mv1; (void)vid0;
    phase_transmul(p, smem_h);
    if (13 + 1 < ph1) { if (ph1 > 1000) grid.sync(); else xcd_barrier(xb); }
  }
  if (ph0 <= 14 && 14 < ph1) {
    asm volatile("" : "+s"(pp));
    CP& p = *pp;
    const int bid = get_rbid();
    const int vid0 = (G & 7) ? bid : ((bid & 7) * (G >> 3) + (bid >> 3));
    const int hb = get_hb();
    char* smem_h = smem + hb * HALF_LDS; (void)smem_h;
    const float* mv0 = p.modv; const float* mv1 = p.modv + (size_t)9 * 6144;
    (void)mv0; (void)mv1; (void)vid0;
    {
        EpiResid e{p.X, p.X, mv1 + 2 * 1024, p.hy_b_out};
        gemm_job<true>(smem, p.hxc, 1024, p.wt_hout, 1024, 1024, 16, 2048, 0, 128, 0, 2048, 128, 0, vid0, G, e);
      }
    if (14 + 1 < ph1) { if (ph1 > 1000) grid.sync(); else xcd_barrier(xb); }
  }
  if (ph0 <= 15 && 15 < ph1) {
    asm volatile("" : "+s"(pp));
    CP& p = *pp;
    const int bid = get_rbid();
    const int vid0 = (G & 7) ? bid : ((bid & 7) * (G >> 3) + (bid >> 3));
    const int hb = get_hb();
    char* smem_h = smem + hb * HALF_LDS; (void)smem_h;
    const float* mv0 = p.modv; const float* mv1 = p.modv + (size_t)9 * 6144;
    (void)mv0; (void)mv1; (void)vid0;
    phase_normmod_x(p, p.norm_ffn_g + 1024, 1, 3);
    if (15 + 1 < ph1) { if (ph1 > 1000) grid.sync(); else xcd_barrier(xb); }
  }
  if (ph0 <= 16 && 16 < ph1) {
    asm volatile("" : "+s"(pp));
    CP& p = *pp;
    const int bid = get_rbid();
    const int vid0 = (G & 7) ? bid : ((bid & 7) * (G >> 3) + (bid >> 3));
    const int hb = get_hb();
    char* smem_h = smem + hb * HALF_LDS; (void)smem_h;
    const float* mv0 = p.modv; const float* mv1 = p.modv + (size_t)9 * 6144;
    (void)mv0; (void)mv1; (void)vid0;
    {
        EpiConv<0> e{p.ffn_conv_w + (size_t)3 * 5632, p.ffn_conv_b + 5632, 5632, nullptr, p.act, nullptr};
        gemm_job<true>(smem, p.hxc, 1024, p.wt_up1, 1024, 5632, 17, 2048, 0, 126, 1, 2048, 136, 0, vid0, G, e);
      }
    if (16 + 1 < ph1) { if (ph1 > 1000) grid.sync(); else xcd_barrier(xb); }
  }
  if (ph0 <= 17 && 17 < ph1) {
    asm volatile("" : "+s"(pp));
    CP& p = *pp;
    const int bid = get_rbid();
    const int vid0 = (G & 7) ? bid : ((bid & 7) * (G >> 3) + (bid >> 3));
    const int hb = get_hb();
    char* smem_h = smem + hb * HALF_LDS; (void)smem_h;
    const float* mv0 = p.modv; const float* mv1 = p.modv + (size_t)9 * 6144;
    (void)mv0; (void)mv1; (void)vid0;
    {
        EpiResid e{p.X, p.X, mv1 + 5 * 1024, nullptr};
        gemm_job<true>(smem, p.act, 2816, p.wt_dn1, 2816, 1024, 16, 2048, 0, 128, 0, 2048, 128, 0, vid0, G, e);
      }
    if (17 + 1 < ph1) { if (ph1 > 1000) grid.sync(); else xcd_barrier(xb); }
  }
  if (ph0 <= 18 && 18 < ph1) {
    asm volatile("" : "+s"(pp));
    CP& p = *pp;
    const int bid = get_rbid();
    const int vid0 = (G & 7) ? bid : ((bid & 7) * (G >> 3) + (bid >> 3));
    const int hb = get_hb();
    char* smem_h = smem + hb * HALF_LDS; (void)smem_h;
    const float* mv0 = p.modv; const float* mv1 = p.modv + (size_t)9 * 6144;
    (void)mv0; (void)mv1; (void)vid0;
    phase_final_norm(p);
    if (18 + 1 < ph1) { if (ph1 > 1000) grid.sync(); else xcd_barrier(xb); }
  }
}

extern "C" void kernel_launch(void* const* d_in, const int* in_sizes, int n_in, void* d_out, int out_size, void* d_ws, size_t ws_size, hipStream_t stream) {
  static int grid_blocks = 0;
  if (!grid_blocks) {
    int dev = 0, cus = 0, per_cu = 0;
    hipGetDevice(&dev);
    hipDeviceGetAttribute(&cus, hipDeviceAttributeMultiprocessorCount, dev);
    hipOccupancyMaxActiveBlocksPerMultiprocessor(&per_cu, (const void*)mega, 512, 0);
    per_cu = 1;
    grid_blocks = cus * per_cu;
  }
  P p{};
  const float** in = (const float**)&p;
  for (int i = 0; i < 36; ++i) in[i] = (const float*)d_in[i];
  p.X = (float*)d_out;
  char* ws = (char*)d_ws; size_t off = 0;
  auto take = [&](size_t bytes) { char* r = ws + off; off += (bytes + 255) & ~(size_t)255; return r; };
  p.wt_dq = (bf16_t*)take((size_t)512 * 1024 * 2);
  p.wt_dkv = (bf16_t*)take((size_t)288 * 1024 * 2);
  p.wt_uq = (bf16_t*)take((size_t)1536 * 512 * 2);
  p.wt_uk = (bf16_t*)take((size_t)1024 * 256 * 2);
  p.wt_uv = (bf16_t*)take((size_t)1024 * 256 * 2);
  p.wt_o = (bf16_t*)take((size_t)1024 * 1024 * 2);
  p.wt_hin = (bf16_t*)take((size_t)3072 * 1024 * 2);
  p.wt_hout = (bf16_t*)take((size_t)1024 * 1024 * 2);
  p.wt_up0 = (bf16_t*)take((size_t)5632 * 1024 * 2);
  p.wt_up1 = (bf16_t*)take((size_t)5632 * 1024 * 2);
  p.wt_dn0 = (bf16_t*)take((size_t)1024 * 2816 * 2);
  p.wt_dn1 = (bf16_t*)take((size_t)1024 * 2816 * 2);
  p.modv = (float*)take((size_t)2 * 9 * 6144 * 4);
  p.rq = (float*)take((size_t)16384 * 4);
  p.rkv = (float*)take((size_t)18432 * 4);
  p.modp = (float*)take((size_t)4 * 110592 * 4);
  p.bar = (unsigned*)take((size_t)XCD_BAR_WORDS * 4);
  p.wt_f3 = (bf16_t*)take((size_t)2048 * 64 * 2);
  p.h2bf = (bf16_t*)take((size_t)2048 * 64 * 2);
  p.Rf = (bf16_t*)take((size_t)1024 * 4096 * 2);
  p.kpe = (bf16_t*)take((size_t)18432 * 32 * 2);
  p.hxc = (bf16_t*)take((size_t)18432 * 1024 * 2);
  const size_t ubase = off;
  p.cq = (bf16_t*)take((size_t)16384 * 512 * 2);
  p.kv = (bf16_t*)take((size_t)18432 * 288 * 2);
  p.Q = (bf16_t*)take((size_t)16384 * 1536 * 2);
  p.Kn = (bf16_t*)take((size_t)18432 * 1024 * 2);
  p.Vt = (bf16_t*)take((size_t)18432 * 1024 * 2);
  const size_t uend1 = off;
  off = ubase;
  p.act = (bf16_t*)take((size_t)16384 * 2816 * 2);
  off = ubase;
  p.x1h = (bf16_t*)take((size_t)16384 * 1024 * 2);
  p.vvT = (bf16_t*)take((size_t)16384 * 1024 * 2);
  p.Yp = (bf16_t*)take((size_t)16384 * 1024 * 2);
  if (uend1 > ws_size) { fprintf(stderr, "workspace too small: need %zu have %zu\n", uend1, ws_size); return; }
  p.ph0 = 0; p.ph1 = NPHASE;
  if (hipMemsetAsync(p.bar, 0, (size_t)XCD_BAR_WORDS * 4, stream) != hipSuccess) { fprintf(stderr, "memset failed\n"); return; }
  void* args[] = {&p};
  hipError_t e = hipLaunchCooperativeKernel((const void*)mega, dim3(grid_blocks), dim3(512), args, 0, stream);
  if (e != hipSuccess) fprintf(stderr, "cooperative launch failed: %s (grid %d)\n", hipGetErrorString(e), grid_blocks);
}
```

```cpp
#include <hip/hip_runtime.h>
#include <hip/hip_cooperative_groups.h>
#include <cstdio>
namespace cg = cooperative_groups;

typedef unsigned short bf16_t;
typedef short bf16x8 __attribute__((ext_vector_type(8)));
typedef float f32x4 __attribute__((ext_vector_type(4)));
typedef float f32x16 __attribute__((ext_vector_type(16)));

#define LDS_BYTES 163840
#define HALF_LDS 81920
#define NPHASE 19

struct P {
  const float *x, *c, *ctx, *c_ctx, *mod_w, *mod_b, *norm_mix_g, *norm_ffn_g;
  const float *w_dq, *g_q, *w_uq, *w_dkv, *g_kv, *w_uk, *w_uv, *w_o;
  const float *hy_w_in, *hy_b_in, *hy_conv_w, *hy_conv_b, *f_w1, *f_b1, *f_freq1, *f_w2, *f_b2, *f_freq2, *f_w3, *hy_decay, *hy_d_bias, *hy_w_out, *hy_b_out;
  const float *ffn_w_up, *ffn_conv_w, *ffn_conv_b, *ffn_w_down, *final_g;
  float* X;
  bf16_t *wt_dq, *wt_dkv, *wt_uq, *wt_uk, *wt_uv, *wt_o, *wt_hin, *wt_hout, *wt_up0, *wt_up1, *wt_dn0, *wt_dn1;
  float *modv, *rq, *rkv, *modp;
  unsigned* bar;
  bf16_t *wt_f3, *h2bf;
  bf16_t *Rf, *kpe, *hxc, *cq, *kv, *Q, *Kn, *Vt, *act, *x1h, *vvT, *Yp;
  int ph0, ph1;
};

typedef const __attribute__((address_space(4))) P CP;
__device__ __forceinline__ int get_tid512() { int t = threadIdx.x; asm volatile("" : "+v"(t)); return t; }
__device__ __forceinline__ int get_tid() { int t = threadIdx.x & 255; asm volatile("" : "+v"(t)); return t; }
__device__ __forceinline__ int get_hb() { int t = __builtin_amdgcn_readfirstlane((int)(threadIdx.x >> 8)); asm volatile("" : "+s"(t)); return t; }
__device__ __forceinline__ int get_rbid() { int t = blockIdx.x; asm volatile("" : "+s"(t)); return t; }
__device__ __forceinline__ int get_bid() { return 2 * get_rbid() + get_hb(); }
#define VGRID (2 * (int)gridDim.x)

__device__ __forceinline__ unsigned pack2(float a, float b) { unsigned r; asm("v_cvt_pk_bf16_f32 %0, %1, %2" : "=v"(r) : "v"(a), "v"(b)); return r; }
__device__ __forceinline__ bf16_t f2bf(float f) { return (bf16_t)(pack2(f, f) & 0xffffu); }
__device__ __forceinline__ float bf2f(bf16_t h) { return __uint_as_float(((unsigned)h) << 16); }
__device__ __forceinline__ float wave_sum(float v) {
#pragma unroll
  for (int o = 32; o; o >>= 1) v += __shfl_xor(v, o);
  return v;
}


#define XB_TMO      128
#define XB_XCNT(j)  (256  + 64 * (j))
#define XB_XSUB(j)  (1280 + 64 * (j))
#define XB_XGEN(j)  (2304 + 64 * (j))
#define XB_TOP      3328
#define XB_TOPGEN   3392
#define XCD_BAR_WORDS 3456
#define XB_SPIN_CAP (1u << 18)
#define LAS __attribute__((address_space(3)))
__device__ __forceinline__ unsigned xb_ld(unsigned* p)              { return __hip_atomic_load(p, __ATOMIC_RELAXED, __HIP_MEMORY_SCOPE_AGENT); }
__device__ __forceinline__ unsigned xb_add(unsigned* p, unsigned v) { return __hip_atomic_fetch_add(p, v, __ATOMIC_RELAXED, __HIP_MEMORY_SCOPE_AGENT); }
__device__ __forceinline__ unsigned xb_xcc_id() { return (unsigned)__builtin_amdgcn_s_getreg((3 << 11) | 20) & 0xFu; }
#define XB_SPIN(cond, bar) do { unsigned _sp = 0; while (cond) { __builtin_amdgcn_s_sleep(1); \
    if ((++_sp & 255u) == 0u) { if (xb_ld(&(bar)[XB_TMO])) break; if (_sp > XB_SPIN_CAP) { atomicAdd(&(bar)[XB_TMO], 1u); break; } } } } while (0)
struct XcdBarrier { unsigned* bar; unsigned x; volatile LAS unsigned* st; };
__device__ __forceinline__ XcdBarrier xcd_barrier_post(unsigned* bar, volatile LAS unsigned* st) {
    XcdBarrier b; b.bar = bar; b.x = xb_xcc_id(); b.st = st;
    if (threadIdx.x == 0) (void)xb_add(&bar[XB_XCNT(b.x)], 1u);
    return b;
}
__device__ __forceinline__ void xcd_barrier_complete(unsigned* bar, unsigned x, unsigned& nloc, unsigned& nx) {
    const unsigned G = gridDim.x * gridDim.y * gridDim.z;
    unsigned sum, cnt, mine, sp = 0u;
    for (;;) {
        sum = 0u; cnt = 0u; mine = 0u;
#pragma unroll
        for (unsigned j = 0; j < 16; ++j) { const unsigned c = xb_ld(&bar[XB_XCNT(j)]); sum += c; cnt += (c > 0u) ? 1u : 0u; mine = (j == x) ? c : mine; }
        if (sum == G) break;
        __builtin_amdgcn_s_sleep(1);
        if ((++sp & 255u) == 0u) { if (xb_ld(&bar[XB_TMO])) break; if (sp > XB_SPIN_CAP) { atomicAdd(&bar[XB_TMO], 1u); break; } }
    }
    nloc = mine > 0u ? mine : 1u; nx = cnt > 0u ? cnt : 1u;
}
__device__ __forceinline__ void xcd_barrier(const XcdBarrier& b) {
    asm volatile("s_waitcnt vmcnt(0)" ::: "memory");
    __syncthreads();
    if (threadIdx.x == 0) {
        unsigned* bar = b.bar;
        __builtin_amdgcn_s_waitcnt(0);
        unsigned nloc = b.st[0], nx = b.st[1];
        if (nloc == 0u) { xcd_barrier_complete(bar, b.x, nloc, nx); b.st[0] = nloc; b.st[1] = nx; }
        const unsigned old = xb_add(&bar[XB_XSUB(b.x)], 1u);
        const unsigned gen = old / nloc;
        if (old + 1u == (gen + 1u) * nloc) {
            __builtin_amdgcn_fence(__ATOMIC_RELEASE, "agent");
            asm volatile("s_waitcnt vmcnt(0)" ::: "memory");
            const unsigned og = xb_add(&bar[XB_TOP], 1u);
            const unsigned tg = og / nx;
            if (og + 1u == (tg + 1u) * nx) xb_add(&bar[XB_TOPGEN], 1u);
            else XB_SPIN(xb_ld(&bar[XB_TOPGEN]) == tg, bar);
            __builtin_amdgcn_fence(__ATOMIC_ACQUIRE, "agent");
            xb_add(&bar[XB_XGEN(b.x)], 1u);
            asm volatile("s_waitcnt vmcnt(0)" ::: "memory");
        } else {
            XB_SPIN(xb_ld(&bar[XB_XGEN(b.x)]) == gen, bar);
            __builtin_amdgcn_fence(__ATOMIC_ACQUIRE, "agent");
            asm volatile("s_waitcnt vmcnt(0)" ::: "memory");
        }
    }
    __syncthreads();
}

__device__ __forceinline__ void prep_weight_tile(CP& p, char* smem, int wt) {
  const int tid = get_tid();
  int id = 0;
  {
    const int cnt[13] = {128, 80, 192, 64, 64, 256, 768, 256, 1408, 1408, 704, 704, 32};
#pragma unroll
    for (int i = 0; i < 12; ++i) { if (id == i && wt >= cnt[i]) { wt -= cnt[i]; id = i + 1; } }
  }
  const float* src; int K, N; bf16_t* dst; const float* scale = nullptr; int perm = 0;
  switch (id) {
    case 0: src = p.w_dq; K = 1024; N = 512; dst = p.wt_dq; break;
    case 1: src = p.w_dkv; K = 1024; N = 288; dst = p.wt_dkv; break;
    case 2: src = p.w_uq; K = 512; N = 1536; dst = p.wt_uq; scale = p.g_q; break;
    case 3: src = p.w_uk; K = 256; N = 1024; dst = p.wt_uk; scale = p.g_kv; break;
    case 4: src = p.w_uv; K = 256; N = 1024; dst = p.wt_uv; scale = p.g_kv; break;
    case 5: src = p.w_o; K = 1024; N = 1024; dst = p.wt_o; break;
    case 6: src = p.hy_w_in; K = 1024; N = 3072; dst = p.wt_hin; perm = 2; break;
    case 7: src = p.hy_w_out; K = 1024; N = 1024; dst = p.wt_hout; break;
    case 8: src = p.ffn_w_up; K = 1024; N = 5632; dst = p.wt_up0; perm = 1; break;
    case 9: src = p.ffn_w_up + (size_t)1024 * 5632; K = 1024; N = 5632; dst = p.wt_up1; perm = 1; break;
    case 10: src = p.ffn_w_down; K = 2816; N = 1024; dst = p.wt_dn0; break;
    case 11: src = p.ffn_w_down + (size_t)2816 * 1024; K = 2816; N = 1024; dst = p.wt_dn1; break;
    default: src = p.f_w3; K = 64; N = 2048; dst = p.wt_f3; break;
  }
  const int ntn = (N + 63) >> 6;
  const int kt = wt / ntn, nt = wt - kt * ntn;
  const int k0 = kt * 64, n0 = nt * 64;
  int np0;
  if (perm == 1) { const int half = n0 / 2816, f = n0 - half * 2816; np0 = (f >> 6) * 128 + half * 64; }
  else if (perm == 2) { if (n0 < 1024) np0 = n0; else { const int m = n0 - 1024, half = m >> 10, f = m & 1023; np0 = 1024 + (f >> 6) * 128 + half * 64; } }
  else np0 = n0;
  bf16_t* t16 = (bf16_t*)smem;
  f32x4 v[4];
#pragma unroll
  for (int i = 0; i < 4; ++i) {
    const int idx = tid + 256 * i; const int kr = idx >> 4, c4 = idx & 15;
    v[i] = (f32x4){0.f, 0.f, 0.f, 0.f};
    if (n0 + 4 * c4 < N) v[i] = *(const f32x4*)(src + (size_t)(k0 + kr) * N + n0 + 4 * c4);
  }
#pragma unroll
  for (int i = 0; i < 4; ++i) {
    const int idx = tid + 256 * i; const int kr = idx >> 4, c4 = idx & 15;
    const float sc = scale ? scale[k0 + kr] : 1.f;
#pragma unroll
    for (int j = 0; j < 4; ++j) t16[(4 * c4 + j) * 72 + kr] = f2bf(v[i][j] * sc);
  }
  __syncthreads();
#pragma unroll
  for (int i = 0; i < 2; ++i) {
    const int idx = tid + 256 * i; const int n = idx >> 3, ch = idx & 7;
    if (n0 + n < N) *(uint4*)(dst + (size_t)(np0 + n) * K + k0 + ch * 8) = *(const uint4*)(t16 + n * 72 + ch * 8);
  }
  __syncthreads();
}

__device__ __forceinline__ void prep_modvec(CP& p, char* smem, int it) {
  const int tid = get_tid();
  const int layer = it / 384, rem = it - layer * 384, cb = rem >> 2, ks = rem & 3;
  float* s_lds = (float*)smem;
  float* red = (float*)(smem + 12288);
  const int kbase = ks * 256;
  for (int idx = tid; idx < 9 * 256; idx += 256) {
    const int r = idx >> 8, k = idx & 255;
    const float v = r < 8 ? p.c[r * 1024 + kbase + k] : p.c_ctx[kbase + k];
    s_lds[k * 12 + r] = v / (1.f + __expf(-v));
  }
  __syncthreads();
  const int col = cb * 64 + (tid & 63), kg = tid >> 6;
  const float* W = p.mod_w + (size_t)layer * 1024 * 6144 + (size_t)kbase * 6144 + col;
  float acc[9];
#pragma unroll
  for (int r = 0; r < 9; ++r) acc[r] = 0.f;
#pragma unroll
  for (int kb = 0; kb < 4; ++kb) {
    float w[16];
#pragma unroll
    for (int u = 0; u < 16; ++u) w[u] = W[(size_t)(kg * 64 + kb * 16 + u) * 6144];
#pragma unroll
    for (int u = 0; u < 16; ++u) {
      const int k = kg * 64 + kb * 16 + u;
      const f32x4 s0 = *(const f32x4*)(s_lds + k * 12), s1 = *(const f32x4*)(s_lds + k * 12 + 4);
      const float s2 = s_lds[k * 12 + 8];
      acc[0] += s0[0] * w[u]; acc[1] += s0[1] * w[u]; acc[2] += s0[2] * w[u]; acc[3] += s0[3] * w[u];
      acc[4] += s1[0] * w[u]; acc[5] += s1[1] * w[u]; acc[6] += s1[2] * w[u]; acc[7] += s1[3] * w[u];
      acc[8] += s2 * w[u];
    }
  }
#pragma unroll
  for (int r = 0; r < 9; ++r) red[(kg * 9 + r) * 64 + (tid & 63)] = acc[r];
  __syncthreads();
  for (int o = tid; o < 9 * 64; o += 256) {
    const int r = o >> 6, cl = o & 63;
    const float sm = red[(0 * 9 + r) * 64 + cl] + red[(1 * 9 + r) * 64 + cl] + red[(2 * 9 + r) * 64 + cl] + red[(3 * 9 + r) * 64 + cl];
    p.modp[(size_t)ks * 110592 + (size_t)(layer * 9 + r) * 6144 + cb * 64 + cl] = sm;
  }
  __syncthreads();
}

__device__ __forceinline__ void prep_filter(CP& p, char* smem, int it) {
  const int tid = get_tid();
  float* z = (float*)smem;
  float* h1 = z + 8 * 33;
  float* h2 = h1 + 8 * 64;
  const int t0 = it * 8;
  for (int idx = tid; idx < 8 * 33; idx += 256) {
    const int pp = idx / 33, i = idx - pp * 33;
    const int t = t0 + pp;
    float v;
    if (i == 0) v = (float)t * (1.0f / 2047.0f);
    else {
      const int k = (i - 1) & 15;
      const float w = (6.283185307179586f * (float)t) / 2048.0f;
      const float f = 1e-4f + (float)k * ((15.0f - 1e-4f) / 15.0f);
      const float a = w * f;
      v = (i <= 16) ? __cosf(a) : -__sinf(a);
    }
    z[idx] = v;
  }
  __syncthreads();
  for (int idx = tid; idx < 8 * 64; idx += 256) {
    const int pp = idx >> 6, j = idx & 63;
    float s = p.f_b1[j];
#pragma unroll
    for (int i = 0; i < 33; ++i) s += z[pp * 33 + i] * p.f_w1[i * 64 + j];
    h1[idx] = __sinf(p.f_freq1[j] * s);
  }
  __syncthreads();
  for (int idx = tid; idx < 8 * 64; idx += 256) {
    const int pp = idx >> 6, j = idx & 63;
    float s = p.f_b2[j];
#pragma unroll 16
    for (int i = 0; i < 64; ++i) s += h1[pp * 64 + i] * p.f_w2[i * 64 + j];
    h2[idx] = __sinf(p.f_freq2[j] * s);
  }
  __syncthreads();
  for (int idx = tid; idx < 8 * 64; idx += 256) p.h2bf[(size_t)t0 * 64 + idx] = f2bf(h2[idx]);
  __syncthreads();
}

__device__ __forceinline__ void phase_prep(CP& p, char* smem) {
  const int total = 768 + 256 + 6064;
  for (int it = get_bid(); it < total; it += VGRID) {
    if (it < 768) prep_modvec(p, smem, it);
    else if (it < 1024) prep_filter(p, smem, it - 768);
    else prep_weight_tile(p, smem, it - 1024);
  }
}

template <bool PART>
__device__ __forceinline__ void normmod_row2(const float* __restrict__ src, const float* __restrict__ g, const float* __restrict__ sh, const float* __restrict__ sc, bf16_t* __restrict__ dst, int lane, const float* __restrict__ bsh = nullptr) {
  f32x4 v[2][4]; float ss0 = 0.f, ss1 = 0.f;
#pragma unroll
  for (int i = 0; i < 4; ++i) { v[0][i] = *(const f32x4*)(src + lane * 4 + 256 * i); v[1][i] = *(const f32x4*)(src + 1024 + lane * 4 + 256 * i); }
#pragma unroll
  for (int i = 0; i < 4; ++i) {
    ss0 += v[0][i][0] * v[0][i][0] + v[0][i][1] * v[0][i][1] + v[0][i][2] * v[0][i][2] + v[0][i][3] * v[0][i][3];
    ss1 += v[1][i][0] * v[1][i][0] + v[1][i][1] * v[1][i][1] + v[1][i][2] * v[1][i][2] + v[1][i][3] * v[1][i][3];
  }
  ss0 = wave_sum(ss0); ss1 = wave_sum(ss1);
  const float r0 = rsqrtf(ss0 * (1.0f / 1024.0f) + 1e-6f), r1 = rsqrtf(ss1 * (1.0f / 1024.0f) + 1e-6f);
#pragma unroll
  for (int i = 0; i < 4; ++i) {
    const int k = lane * 4 + 256 * i;
    const f32x4 g4 = *(const f32x4*)(g + k);
    f32x4 s4 = *(const f32x4*)(sh + k), c4 = *(const f32x4*)(sc + k);
    if (PART) {
#pragma unroll
      for (int q = 1; q < 4; ++q) { s4 += *(const f32x4*)(sh + (size_t)q * 110592 + k); c4 += *(const f32x4*)(sc + (size_t)q * 110592 + k); }
      s4 += *(const f32x4*)(bsh + k); c4 += *(const f32x4*)(bsh + 1024 + k);
    }
    float y[4], z[4];
#pragma unroll
    for (int j = 0; j < 4; ++j) { const float gm = g4[j] * (1.f + c4[j]); y[j] = (v[0][i][j] * r0) * gm + s4[j]; z[j] = (v[1][i][j] * r1) * gm + s4[j]; }
    uint2 u; u.x = pack2(y[0], y[1]); u.y = pack2(y[2], y[3]);
    *(uint2*)(dst + k) = u;
    u.x = pack2(z[0], z[1]); u.y = pack2(z[2], z[3]);
    *(uint2*)(dst + 1024 + k) = u;
  }
}

__device__ __forceinline__ void phase_normmod_kv(CP& p) {
  const int lane = get_tid() & 63, wv = get_tid() >> 6;
  const float* g = p.norm_mix_g;
  for (int idx = get_bid() * 256 + get_tid(); idx < 110592; idx += VGRID * 256) {
    const int lr = idx / 6144; const int n = idx - lr * 6144; const int layer = lr / 9;
    p.modv[idx] = p.modp[idx] + p.modp[110592 + idx] + p.modp[2 * 110592 + idx] + p.modp[3 * 110592 + idx] + p.mod_b[layer * 6144 + n];
  }
  for (int r = (get_bid() * 4 + wv) * 2; r < 18432; r += VGRID * 8) {
    const int b = r / 2304, pp = r - b * 2304;
    const float* src; const float* mv;
    if (pp < 256) { src = p.ctx + ((size_t)b * 256 + pp) * 1024; mv = p.modp + (size_t)8 * 6144; }
    else { src = p.x + ((size_t)b * 2048 + pp - 256) * 1024; mv = p.modp + (size_t)b * 6144; }
    normmod_row2<true>(src, g, mv, mv + 1024, p.hxc + (size_t)r * 1024, lane, p.mod_b);
  }
}
__device__ __forceinline__ void phase_normmod_x(CP& p, const float* g, int layer, int chunk) {
  const int lane = get_tid() & 63, wv = get_tid() >> 6;
  for (int r = (get_bid() * 4 + wv) * 2; r < 16384; r += VGRID * 8) {
    const int b = r >> 11;
    const float* mv = p.modv + (size_t)(layer * 9 + b) * 6144 + chunk * 1024;
    normmod_row2<false>(p.X + (size_t)r * 1024, g, mv, mv + 1024, p.hxc + (size_t)r * 1024, lane);
  }
}
__device__ __forceinline__ void phase_final_norm(CP& p) {
  const int lane = get_tid() & 63, wv = get_tid() >> 6;
  for (int r = get_bid() * 4 + wv; r < 16384; r += VGRID * 4) {
    float* row = p.X + (size_t)r * 1024;
    f32x4 v[4]; float ss = 0.f;
#pragma unroll
    for (int i = 0; i < 4; ++i) { v[i] = *(const f32x4*)(row + lane * 4 + 256 * i); ss += v[i][0] * v[i][0] + v[i][1] * v[i][1] + v[i][2] * v[i][2] + v[i][3] * v[i][3]; }
    ss = wave_sum(ss);
    const float rr = rsqrtf(ss * (1.0f / 1024.0f) + 1e-6f);
#pragma unroll
    for (int i = 0; i < 4; ++i) {
      const int k = lane * 4 + 256 * i;
      const f32x4 g4 = *(const f32x4*)(p.final_g + k);
      f32x4 o; o[0] = v[i][0] * rr * g4[0]; o[1] = v[i][1] * rr * g4[1]; o[2] = v[i][2] * rr * g4[2]; o[3] = v[i][3] * rr * g4[3];
      *(f32x4*)(row + k) = o;
    }
  }
}

__device__ __forceinline__ void phase_rowstat(CP& p) {
  const int lane = get_tid() & 63, wv = get_tid() >> 6;
  for (int r = get_bid() * 4 + wv; r < 18432; r += VGRID * 4) {
    const int b = r / 2304, pp = r - b * 2304;
    const bf16_t* kvr = p.kv + (size_t)r * 288;
    {
      const uint2 u = *(const uint2*)(kvr + lane * 4);
      const float a0 = bf2f((bf16_t)(u.x & 0xffff)), a1 = bf2f((bf16_t)(u.x >> 16)), a2 = bf2f((bf16_t)(u.y & 0xffff)), a3 = bf2f((bf16_t)(u.y >> 16));
      float ss = a0 * a0 + a1 * a1 + a2 * a2 + a3 * a3;
      ss = wave_sum(ss);
      if (lane == 0) p.rkv[r] = rsqrtf(ss * (1.0f / 256.0f) + 1e-6f);
    }
    {
      const int i = lane & 31;
      const float xv = bf2f(kvr[256 + i]);
      const float ov = __shfl_xor(xv, 8);
      float res = xv;
      if (pp >= 256) {
        const int t = pp - 256;
        const int quarter = i >> 3, idx = i & 7;
        const float pos = (quarter < 2) ? (float)(t >> 6) : (float)(t & 63);
        const float inv = exp2f(-(float)idx * (13.287712379549449f / 8.0f));
        const float ang = pos * inv;
        const float cs = __cosf(ang), sn = __sinf(ang);
        res = xv * cs + ((quarter & 1) ? ov : -ov) * sn;
      }
      if (lane < 32) p.kpe[(size_t)r * 32 + i] = f2bf(res);
    }
    if (pp >= 256) {
      const int xr = b * 2048 + pp - 256;
      const uint4 u = *(const uint4*)(p.cq + (size_t)xr * 512 + lane * 8);
      const unsigned uu[4] = {u.x, u.y, u.z, u.w};
      float ss = 0.f;
#pragma unroll
      for (int j = 0; j < 4; ++j) { const float a = bf2f((bf16_t)(uu[j] & 0xffff)), bb = bf2f((bf16_t)(uu[j] >> 16)); ss += a * a + bb * bb; }
      ss = wave_sum(ss);
      if (lane == 0) p.rq[xr] = rsqrtf(ss * (1.0f / 512.0f) + 1e-6f);
    }
  }
}

struct EpiStore {
  static constexpr int KIND = 0;
  bf16_t* out; int ld; int ostride; const float* rs;
  __device__ __forceinline__ void c4(int g, int rig, int col, f32x4 v) const {
    const size_t row = (size_t)g * ostride + rig;
    const float s = rs ? rs[row] : 1.f;
    uint2 u; u.x = pack2(v[0] * s, v[1] * s); u.y = pack2(v[2] * s, v[3] * s);
    *(uint2*)(out + row * ld + col) = u;
  }
};
struct EpiVt {
  static constexpr int KIND = 1;
  bf16_t* out; const float* rs;
  __device__ __forceinline__ void r4(int g, int rig, int col, f32x4 v) const {
    const size_t row = (size_t)g * 2304 + rig;
    const f32x4 s = *(const f32x4*)(rs + row);
    uint2 u; u.x = pack2(v[0] * s[0], v[1] * s[1]); u.y = pack2(v[2] * s[2], v[3] * s[3]);
    *(uint2*)(out + ((size_t)g * 1024 + col) * 2304 + rig) = u;
  }
};
struct EpiFilt {
  static constexpr int KIND = 1;
  bf16_t* Rf; const float* decay;
  __device__ __forceinline__ void r4(int g, int rig, int col, f32x4 v) const {
    const int c = col & 1023; const bool bwd = col >= 1024;
    const float dec = fabsf(decay[c]);
    bf16_t* rp = Rf + (size_t)c * 4096;
#pragma unroll
    for (int j = 0; j < 4; ++j) {
      const int t = rig + j;
      const float val = v[j] * __expf(-(float)t * (1.0f / 2047.0f) * dec);
      if (!bwd) rp[2048 - t] = f2bf(val);
      else if (t > 0) rp[2048 + t] = f2bf(val);
      else rp[0] = 0;
    }
  }
};
struct EpiResid {
  static constexpr int KIND = 0;
  float* X; const float* base; const float* gate; const float* bias;
  __device__ __forceinline__ void c4(int g, int rig, int col, f32x4 v) const {
    const size_t o = ((size_t)g * 2048 + rig) * 1024 + col;
    const f32x4 bs = *(const f32x4*)(base + o);
    const f32x4 gt = *(const f32x4*)(gate + (size_t)g * 6144 + col);
    f32x4 bi = {0.f, 0.f, 0.f, 0.f};
    if (bias) bi = *(const f32x4*)(bias + col);
    f32x4 r;
#pragma unroll
    for (int j = 0; j < 4; ++j) r[j] = bs[j] + gt[j] * (v[j] + bi[j]);
    *(f32x4*)(X + o) = r;
  }
};
template <int MODE>
struct EpiConv {
  static constexpr int KIND = 2;
  const float* cw; const float* cb; int NC; const float* pre_bias;
  bf16_t* o0; bf16_t* o1;
  __device__ __forceinline__ int norig(int nt, int cl) const {
    if (MODE == 0) return (cl >> 6) * 2816 + nt * 64 + (cl & 63);
    if (nt < 8) return nt * 128 + cl;
    return 1024 + (cl >> 6) * 1024 + (nt - 8) * 64 + (cl & 63);
  }
  __device__ __forceinline__ void finish(const float* Z, int g, int rig0, int nt) const {
    const int tid = get_tid();
    if (MODE == 0 || nt < 8) {
      const int f = tid & 63, q = tid >> 6;
      const int p0 = 1 + 32 * q, p1 = (p0 + 32 < 127) ? p0 + 32 : 127;
      if (MODE == 0) {
        const int na = norig(nt, f), ng = norig(nt, 64 + f);
        const float a0 = cw[na], a1 = cw[NC + na], a2 = cw[2 * NC + na], ab = cb[na];
        const float g0 = cw[ng], g1 = cw[NC + ng], g2 = cw[2 * NC + ng], gb = cb[ng];
        float am = Z[(p0 - 1) * 132 + f], ac = Z[p0 * 132 + f], gm = Z[(p0 - 1) * 132 + 64 + f], gc = Z[p0 * 132 + 64 + f];
#pragma unroll 2
        for (int pl = p0; pl < p1; ++pl) {
          const float an = Z[(pl + 1) * 132 + f], gn = Z[(pl + 1) * 132 + 64 + f];
          const int pos = rig0 + pl;
          if (pos < 2048) {
            const float av = a0 * am + a1 * ac + a2 * an + ab;
            const float gv = g0 * gm + g1 * gc + g2 * gn + gb;
            o0[((size_t)g * 2048 + pos) * 2816 + nt * 64 + f] = f2bf(av * gv / (1.f + __expf(-gv)));
          }
          am = ac; ac = an; gm = gc; gc = gn;
        }
      } else {
#pragma unroll
        for (int fh = 0; fh < 2; ++fh) {
          const int cl = fh * 64 + f;
          const int na = norig(nt, cl);
          const float a0 = cw[na], a1 = cw[NC + na], a2 = cw[2 * NC + na], ab = cb[na];
          float am = Z[(p0 - 1) * 132 + cl], ac = Z[p0 * 132 + cl];
#pragma unroll 2
          for (int pl = p0; pl < p1; ++pl) {
            const float an = Z[(pl + 1) * 132 + cl];
            const int pos = rig0 + pl;
            if (pos < 2048) o0[((size_t)g * 2048 + pos) * 1024 + nt * 128 + cl] = f2bf(a0 * am + a1 * ac + a2 * an + ab);
            am = ac; ac = an;
          }
        }
      }
    } else {
      const int pl = tid & 127, fh = tid >> 7;
      const int pos = rig0 + pl;
      if (pl >= 1 && pl <= 126 && pos < 2048) {
        const int fb = nt - 8;
#pragma unroll 2
        for (int f = fh * 32; f < fh * 32 + 32; ++f) {
          const int na = norig(nt, f), nb = norig(nt, 64 + f);
          const float va = cw[na] * Z[(pl - 1) * 132 + f] + cw[NC + na] * Z[pl * 132 + f] + cw[2 * NC + na] * Z[(pl + 1) * 132 + f] + cb[na];
          const float vb = cw[nb] * Z[(pl - 1) * 132 + 64 + f] + cw[NC + nb] * Z[pl * 132 + 64 + f] + cw[2 * NC + nb] * Z[(pl + 1) * 132 + 64 + f] + cb[nb];
          o1[(size_t)(fb * 64 + f) * 16384 + g * 2048 + pos] = f2bf(va * vb);
        }
      }
    }
  }
};

#define GLDS16(gp, lp) __builtin_amdgcn_global_load_lds((const unsigned*)(gp), (__attribute__((address_space(3))) unsigned*)(lp), 16, 0, 0)

template <bool SWAP, class Epi>
__device__ __forceinline__ void gemm_job(char* smem, const bf16_t* __restrict__ A, int lda, const bf16_t* __restrict__ Bt, int K, int N,
                                         int tpg, int a_gstride, int a_goff, int step, int halo, int grows, int MTS, int voff, int vid0, int grid, const Epi& epi) {
  const int tid = get_tid512(), lane = tid & 63, wid = tid >> 6, wr = wid >> 1, wc = wid & 1, fr = lane & 15, fq = lane >> 4;
  const int NT = (N + 255) >> 8, MT = MTS >> 1, ntiles = MT * NT, nk = K >> 5;
  const int full = MT >> 3;
  int v = vid0;
  if (v < voff) v += ((voff - v + grid - 1) / grid) * grid;
  const int rdoff = ((fq ^ ((0x78 >> (((fr >> 2) & 3) * 2)) & 3)) << 4);
  for (; v < voff + ntiles; v += grid) {
    const int w = v - voff;
    int mt, nt;
    if (w < full * 8 * NT) { const int sr = w / (8 * NT), rem = w - sr * 8 * NT; nt = rem >> 3; mt = sr * 8 + (rem & 7); }
    else { const int w2 = w - full * 8 * NT, rl = MT - full * 8; nt = w2 / rl; mt = full * 8 + (w2 - nt * rl); }
    unsigned ap[2], bp[2];
#pragma unroll
    for (int i = 0; i < 2; ++i) {
      const int b = tid * 16 + i * 8192;
      const int r = b >> 6;
      const int cs = (b & 63) >> 4;
      const int c = ((cs ^ ((0x78 >> (((r >> 2) & 3) * 2)) & 3)) << 3);
      const int sub = 2 * mt + (r >> 7);
      const int g = sub / tpg, ti = sub - g * tpg;
      int rig = ti * step - halo + (r & 127); rig = rig < 0 ? 0 : (rig > grows - 1 ? grows - 1 : rig);
      ap[i] = (unsigned)((g * a_gstride + a_goff + rig) * lda + c);
      int br = nt * 256 + r; br = br > N - 1 ? N - 1 : br;
      bp[i] = (unsigned)(br * K + c);
    }
    f32x4 acc[4][8];
#pragma unroll
    for (int m = 0; m < 4; ++m)
#pragma unroll
      for (int n = 0; n < 8; ++n) acc[m][n] = (f32x4){0.f, 0.f, 0.f, 0.f};
#pragma unroll
    for (int st = 0; st < 3; ++st) {
      if (st < nk) {
        char* nb = smem + st * 32768;
#pragma unroll
        for (int i = 0; i < 2; ++i) GLDS16(A + (size_t)(ap[i] + st * 32), nb + tid * 16 + i * 8192);
#pragma unroll
        for (int i = 0; i < 2; ++i) GLDS16(Bt + (size_t)(bp[i] + st * 32), nb + 16384 + tid * 16 + i * 8192);
      }
    }
    for (int t = 0; t < nk; ++t) {
      if (t + 2 < nk) asm volatile("s_waitcnt vmcnt(8)" ::: "memory");
      else if (t + 1 < nk) asm volatile("s_waitcnt vmcnt(4)" ::: "memory");
      else asm volatile("s_waitcnt vmcnt(0)" ::: "memory");
      __builtin_amdgcn_s_barrier();
      asm volatile("" ::: "memory");
      if (t + 3 < nk) {
        char* nb = smem + ((t + 3) & 3) * 32768;
        const int ko = (t + 3) * 32;
#pragma unroll
        for (int i = 0; i < 2; ++i) GLDS16(A + (size_t)(ap[i] + ko), nb + tid * 16 + i * 8192);
#pragma unroll
        for (int i = 0; i < 2; ++i) GLDS16(Bt + (size_t)(bp[i] + ko), nb + 16384 + tid * 16 + i * 8192);
      }
      const char* sa = smem + (t & 3) * 32768; const char* sb = sa + 16384;
      bf16x8 af[4];
#pragma unroll
      for (int m = 0; m < 4; ++m) af[m] = *(const bf16x8*)(sa + (wr * 64 + m * 16 + fr) * 64 + rdoff);
      bf16x8 bfb[2][2];
#pragma unroll
      for (int n = 0; n < 2; ++n) bfb[0][n] = *(const bf16x8*)(sb + (wc * 128 + n * 16 + fr) * 64 + rdoff);
#pragma unroll
      for (int nh = 0; nh < 4; ++nh) {
        if (nh < 3) {
#pragma unroll
          for (int n = 0; n < 2; ++n) bfb[(nh + 1) & 1][n] = *(const bf16x8*)(sb + (wc * 128 + ((nh + 1) * 2 + n) * 16 + fr) * 64 + rdoff);
        }
        __builtin_amdgcn_sched_barrier(0);
#pragma unroll
        for (int m = 0; m < 4; ++m)
#pragma unroll
          for (int n = 0; n < 2; ++n)
            acc[m][nh * 2 + n] = SWAP ? __builtin_amdgcn_mfma_f32_16x16x32_bf16(bfb[nh & 1][n], af[m], acc[m][nh * 2 + n], 0, 0, 0)
                                      : __builtin_amdgcn_mfma_f32_16x16x32_bf16(af[m], bfb[nh & 1][n], acc[m][nh * 2 + n], 0, 0, 0);
      }
    }
    __syncthreads();
    const int te = get_tid512();
    const int fr_e = te & 15, fq_e = (te & 63) >> 4, wr_e = te >> 7, wc_e = (te >> 6) & 1;
    const int sub = 2 * mt + (wr_e >> 1);
    const int g = sub / tpg, ti = sub - g * tpg;
    const int rig0 = ti * step - halo;
    const int rw = (wr_e & 1) * 64;
    if constexpr (Epi::KIND == 0) {
#pragma unroll
      for (int m = 0; m < 4; ++m) {
        const int rig = rig0 + rw + m * 16 + fr_e;
#pragma unroll
        for (int n = 0; n < 8; ++n) {
          const int col = nt * 256 + wc_e * 128 + n * 16 + fq_e * 4;
          if (col < N) epi.c4(g, rig, col, acc[m][n]);
        }
      }
    } else if constexpr (Epi::KIND == 1) {
#pragma unroll
      for (int m = 0; m < 4; ++m) {
        const int rig = rig0 + rw + m * 16 + fq_e * 4;
#pragma unroll
        for (int n = 0; n < 8; ++n) {
          const int col = nt * 256 + wc_e * 128 + n * 16 + fr_e;
          if (col < N) epi.r4(g, rig, col, acc[m][n]);
        }
      }
    } else {
      float* Z = (float*)smem + (wr_e >> 1) * (128 * 132);
#pragma unroll
      for (int h = 0; h < 2; ++h) {
        const int nt2 = nt * 2 + h;
        if (wc_e == h) {
#pragma unroll
          for (int n = 0; n < 8; ++n) {
            const int cl = n * 16 + fq_e * 4;
            f32x4 b4 = {0.f, 0.f, 0.f, 0.f};
            if (epi.pre_bias) b4 = *(const f32x4*)(epi.pre_bias + epi.norig(nt2, cl));
#pragma unroll
            for (int m = 0; m < 4; ++m) {
              const int rl = rw + m * 16 + fr_e;
              const int pos = rig0 + rl;
              const bool ok = pos >= 0 && pos < grows;
              f32x4 vv = acc[m][n] + b4;
              if (!ok) vv = (f32x4){0.f, 0.f, 0.f, 0.f};
              *(f32x4*)(Z + rl * 132 + cl) = vv;
            }
          }
        }
        __syncthreads();
        epi.finish(Z, g, rig0, nt2);
        __syncthreads();
      }
    }
    asm volatile("s_waitcnt vmcnt(0)" ::: "memory");
    __syncthreads();
  }
}

__device__ __forceinline__ void phase_attn(CP& p, char* smem, int vid0, int grid) {
  bf16_t* Ks = (bf16_t*)smem;
  bf16_t* Vs = (bf16_t*)(smem + 64 * 104 * 2);
  const int tid = get_tid(), lane = tid & 63, w = tid >> 6, r = lane & 31, hh = lane >> 5;
  const float cs = 1.4426950408889634f * 0.10206207261596577f;
  for (int it = vid0; it < 2048; it += grid) {
    const int qt = it & 15, h = (it >> 4) & 15, b = it >> 8;
    const int t = qt * 128 + w * 32 + r;
    const size_t xrow = (size_t)b * 2048 + t;
    const bf16_t* qp = p.Q + xrow * 1536 + h * 96;
    bf16x8 qf[6];
#pragma unroll
    for (int kk = 0; kk < 4; ++kk) qf[kk] = *(const bf16x8*)(qp + 16 * kk + 8 * hh);
#pragma unroll
    for (int part = 0; part < 2; ++part) {
      const bf16_t* pp = qp + 64 + 16 * part;
      const bf16x8 mine = *(const bf16x8*)(pp + 8 * hh), oth = *(const bf16x8*)(pp + 8 * (1 - hh));
      const float posf = part == 0 ? (float)(t >> 6) : (float)(t & 63);
      union { unsigned u[4]; bf16x8 v; } o;
      float res[8];
#pragma unroll
      for (int j = 0; j < 8; ++j) {
        const float inv = exp2f(-(float)j * (13.287712379549449f / 8.0f));
        const float ang = posf * inv;
        const float c = __cosf(ang), s = __sinf(ang);
        const float m = bf2f((bf16_t)mine[j]), ov = bf2f((bf16_t)oth[j]);
        res[j] = m * c + (hh ? ov : -ov) * s;
      }
#pragma unroll
      for (int j = 0; j < 4; ++j) o.u[j] = pack2(res[2 * j], res[2 * j + 1]);
      qf[4 + part] = o.v;
    }
    f32x16 oacc[2];
#pragma unroll
    for (int i = 0; i < 16; ++i) { oacc[0][i] = 0.f; oacc[1][i] = 0.f; }
    float mrun = -INFINITY, lrun = 0.f;
    const size_t kvrow0 = (size_t)b * 2304;
    const bf16_t* kn_base = p.Kn + kvrow0 * 1024 + h * 64;
    const bf16_t* kpe_base = p.kpe + kvrow0 * 32;
    const bf16_t* vt_base = p.Vt + ((size_t)(b * 16 + h) * 64) * 2304;
    uint4 rk0, rk1, rp, rv0, rv1;
    const int srow = tid >> 3, sch = tid & 7;
#define ATT_GLOAD(kt) do { \
      rk0 = *(const uint4*)(kn_base + (size_t)((kt) * 64 + srow) * 1024 + sch * 8); \
      rk1 = *(const uint4*)(kn_base + (size_t)((kt) * 64 + srow + 32) * 1024 + sch * 8); \
      rv0 = *(const uint4*)(vt_base + (size_t)srow * 2304 + (kt) * 64 + sch * 8); \
      rv1 = *(const uint4*)(vt_base + (size_t)(srow + 32) * 2304 + (kt) * 64 + sch * 8); \
      rp = *(const uint4*)(kpe_base + (size_t)((kt) * 64 + (tid >> 2)) * 32 + (tid & 3) * 8); } while (0)
    ATT_GLOAD(0);
    for (int kt = 0; kt < 36; ++kt) {
      __syncthreads();
      {
        *(uint4*)(Ks + srow * 104 + sch * 8) = rk0;
        *(uint4*)(Ks + (srow + 32) * 104 + sch * 8) = rk1;
        uint2 lo, hi;
        lo.x = rv0.x; lo.y = rv0.y; hi.x = rv0.z; hi.y = rv0.w;
        *(uint2*)(Vs + srow * 68 + sch * 8) = lo; *(uint2*)(Vs + srow * 68 + sch * 8 + 4) = hi;
        lo.x = rv1.x; lo.y = rv1.y; hi.x = rv1.z; hi.y = rv1.w;
        *(uint2*)(Vs + (srow + 32) * 68 + sch * 8) = lo; *(uint2*)(Vs + (srow + 32) * 68 + sch * 8 + 4) = hi;
      }
      *(uint4*)(Ks + (tid >> 2) * 104 + 64 + (tid & 3) * 8) = rp;
      __syncthreads();
      if (kt + 1 < 36) ATT_GLOAD(kt + 1);
      f32x16 s[2];
#pragma unroll
      for (int t2 = 0; t2 < 2; ++t2) {
#pragma unroll
        for (int i = 0; i < 16; ++i) s[t2][i] = 0.f;
#pragma unroll
        for (int kk = 0; kk < 6; ++kk) {
          const bf16x8 a = *(const bf16x8*)(Ks + (32 * t2 + r) * 104 + 16 * kk + 8 * hh);
          s[t2] = __builtin_amdgcn_mfma_f32_32x32x16_bf16(a, qf[kk], s[t2], 0, 0, 0);
        }
      }
      float mx = s[0][0];
#pragma unroll
      for (int i = 1; i < 16; ++i) mx = fmaxf(mx, s[0][i]);
#pragma unroll
      for (int i = 0; i < 16; ++i) mx = fmaxf(mx, s[1][i]);
      mx = fmaxf(mx, __shfl_xor(mx, 32));
      const float mnew = fmaxf(mrun, mx * cs);
      const float alpha = __builtin_amdgcn_exp2f(mrun - mnew);
      mrun = mnew;
      float psum = 0.f;
      bf16x8 pf[4];
#pragma unroll
      for (int t2 = 0; t2 < 2; ++t2)
#pragma unroll
        for (int hf = 0; hf < 2; ++hf) {
          union { unsigned u[4]; bf16x8 v; } cvp;
#pragma unroll
          for (int i = 0; i < 4; ++i) {
            const float p0 = __builtin_amdgcn_exp2f(s[t2][hf * 8 + 2 * i] * cs - mnew);
            const float p1 = __builtin_amdgcn_exp2f(s[t2][hf * 8 + 2 * i + 1] * cs - mnew);
            psum += p0 + p1;
            cvp.u[i] = pack2(p0, p1);
          }
          pf[t2 * 2 + hf] = cvp.v;
        }
      lrun = lrun * alpha + psum;
#pragma unroll
      for (int i = 0; i < 16; ++i) { oacc[0][i] *= alpha; oacc[1][i] *= alpha; }
#pragma unroll
      for (int dt = 0; dt < 2; ++dt)
#pragma unroll
        for (int s4 = 0; s4 < 4; ++s4) {
          const bf16_t* vp = Vs + (32 * dt + r) * 68 + 16 * s4 + 4 * hh;
          const uint2 lo = *(const uint2*)vp, hi = *(const uint2*)(vp + 8);
          union { uint4 u; bf16x8 v; } cv; cv.u.x = lo.x; cv.u.y = lo.y; cv.u.z = hi.x; cv.u.w = hi.y;
          oacc[dt] = __builtin_amdgcn_mfma_f32_32x32x16_bf16(cv.v, pf[s4], oacc[dt], 0, 0, 0);
        }
    }
    const float ltot = lrun + __shfl_xor(lrun, 32);
    const float inv = 1.f / ltot;
    bf16_t* op = p.hxc + xrow * 1024 + h * 64;
#pragma unroll
    for (int dt = 0; dt < 2; ++dt)
#pragma unroll
      for (int i4 = 0; i4 < 4; ++i4) {
        const int d = 32 * dt + 8 * i4 + 4 * hh;
        uint2 u; u.x = pack2(oacc[dt][4 * i4] * inv, oacc[dt][4 * i4 + 1] * inv); u.y = pack2(oacc[dt][4 * i4 + 2] * inv, oacc[dt][4 * i4 + 3] * inv);
        *(uint2*)(op + d) = u;
      }
  }
}

__device__ __forceinline__ void phase_hyconv(CP& p, char* smem) {
  bf16_t* cp = (bf16_t*)smem;
  bf16_t* Vl = (bf16_t*)(smem + 4 * 8256);
  const int tid = get_tid(), lane = tid & 63, w = tid >> 6, i16 = lane & 15, g4 = lane >> 4;
  const int si = (-i16) & 3;
  const int ocb = 64 * w;
  for (int c = get_bid(); c < 1024; c += VGRID) {
    __syncthreads();
#pragma unroll
    for (int i = 0; i < 2; ++i) { const int ch = tid + 256 * i; *(uint4*)(cp + ch * 8) = *(const uint4*)(p.Rf + (size_t)c * 4096 + ch * 8); }
#pragma unroll
    for (int i = 0; i < 8; ++i) {
      const int q = tid + 256 * i; const int b = q >> 8, l8 = q & 255; const int m1 = l8 >> 3, m2 = (l8 & 7) * 8;
      *(uint4*)(Vl + (8 + m1 * 8 + b) * 80 + m2) = *(const uint4*)(p.vvT + (size_t)c * 16384 + b * 2048 + l8 * 8);
    }
    if (tid < 144) {
      const int colp = tid / 9, part = tid - colp * 9;
      const int col = colp < 8 ? colp : 256 + colp;
      uint4 zz; zz.x = 0; zz.y = 0; zz.z = 0; zz.w = 0;
      *(uint4*)(Vl + col * 80 + part * 8) = zz;
    }
    __syncthreads();
#pragma unroll
    for (int s = 1; s < 4; ++s)
#pragma unroll
      for (int i = 0; i < 2; ++i) {
        const int ch = tid + 256 * i;
        unsigned e[8];
#pragma unroll
        for (int j = 0; j < 8; ++j) { const int idx = 8 * ch + s + j; e[j] = idx < 4096 ? (unsigned)cp[idx] : 0u; }
        uint4 u; u.x = e[0] | (e[1] << 16); u.y = e[2] | (e[3] << 16); u.z = e[4] | (e[5] << 16); u.w = e[6] | (e[7] << 16);
        *(uint4*)(cp + s * 4128 + 8 * ch) = u;
      }
    __syncthreads();
    const bf16_t* abase = cp + si * 4128 + (2048 - i16 - si + 8 * g4);
    f32x4 acc[4][4];
#pragma unroll
    for (int m = 0; m < 4; ++m)
#pragma unroll
      for (int n = 0; n < 4; ++n) acc[m][n] = (f32x4){0.f, 0.f, 0.f, 0.f};
    for (int dl = -31; dl <= 31; ++dl) {
      bf16x8 af[4][2];
#pragma unroll
      for (int mt = 0; mt < 4; ++mt)
#pragma unroll
        for (int kk = 0; kk < 2; ++kk) {
          const bf16_t* ap = abase - 64 * dl - 16 * mt + 32 * kk;
          const uint2 lo = *(const uint2*)ap, hi = *(const uint2*)(ap + 4);
          union { uint4 u; bf16x8 v; } cv; cv.u.x = lo.x; cv.u.y = lo.y; cv.u.z = hi.x; cv.u.w = hi.y;
          af[mt][kk] = cv.v;
        }
#pragma unroll
      for (int jt = 0; jt < 4; ++jt) {
        const int in0 = ocb + 16 * jt - 8 * dl;
        if (in0 >= -8 && in0 <= 248) {
          const bf16_t* bp = Vl + (in0 + 8 + i16) * 80 + 8 * g4;
          const bf16x8 b0 = *(const bf16x8*)bp, b1 = *(const bf16x8*)(bp + 32);
#pragma unroll
          for (int mt = 0; mt < 4; ++mt) {
            acc[mt][jt] = __builtin_amdgcn_mfma_f32_16x16x32_bf16(af[mt][0], b0, acc[mt][jt], 0, 0, 0);
            acc[mt][jt] = __builtin_amdgcn_mfma_f32_16x16x32_bf16(af[mt][1], b1, acc[mt][jt], 0, 0, 0);
          }
        }
      }
    }
    const float db = p.hy_d_bias[c];
#pragma unroll
    for (int mt = 0; mt < 4; ++mt)
#pragma unroll
      for (int jt = 0; jt < 4; ++jt) {
        const int col = ocb + 16 * jt + i16;
        const int n1 = col >> 3, b = col & 7;
        const int n2 = 16 * mt + 4 * g4;
        const uint2 vv = *(const uint2*)(Vl + (col + 8) * 80 + n2);
        const float y0 = acc[mt][jt][0] + bf2f((bf16_t)(vv.x & 0xffff)) * db;
        const float y1 = acc[mt][jt][1] + bf2f((bf16_t)(vv.x >> 16)) * db;
        const float y2 = acc[mt][jt][2] + bf2f((bf16_t)(vv.y & 0xffff)) * db;
        const float y3 = acc[mt][jt][3] + bf2f((bf16_t)(vv.y >> 16)) * db;
        uint2 u; u.x = pack2(y0, y1); u.y = pack2(y2, y3);
        *(uint2*)(p.Yp + (size_t)c * 16384 + b * 2048 + n1 * 64 + n2) = u;
      }
  }
}

__device__ __forceinline__ void phase_transmul(CP& p, char* smem) {
  bf16_t* tl = (bf16_t*)smem;
  const int tid = get_tid();
  for (int it = get_bid(); it < 4096; it += VGRID) {
    const int ct = it & 15, rt = it >> 4;
    const int c0 = ct * 64, r0 = rt * 64;
    __syncthreads();
#pragma unroll
    for (int i = 0; i < 2; ++i) {
      const int ci = tid + 256 * i; const int cc = ci >> 3, ch = ci & 7;
      const uint4 u = *(const uint4*)(p.Yp + (size_t)(c0 + cc) * 16384 + r0 + ch * 8);
      unsigned* d = (unsigned*)(tl + cc * 66 + ch * 8);
      d[0] = u.x; d[1] = u.y; d[2] = u.z; d[3] = u.w;
    }
    __syncthreads();
    const int row = tid >> 2, cq = tid & 3;
    const bf16_t* xp = p.x1h + (size_t)(r0 + row) * 1024 + c0 + cq * 16;
    const uint4 xa = *(const uint4*)xp, xb = *(const uint4*)(xp + 8);
    const unsigned xs[8] = {xa.x, xa.y, xa.z, xa.w, xb.x, xb.y, xb.z, xb.w};
    unsigned o[8];
#pragma unroll
    for (int j = 0; j < 8; ++j) {
      const float y0 = bf2f(tl[(cq * 16 + 2 * j) * 66 + row]) * bf2f((bf16_t)(xs[j] & 0xffff));
      const float y1 = bf2f(tl[(cq * 16 + 2 * j + 1) * 66 + row]) * bf2f((bf16_t)(xs[j] >> 16));
      o[j] = pack2(y0, y1);
    }
    bf16_t* op = p.hxc + (size_t)(r0 + row) * 1024 + c0 + cq * 16;
    uint4 oa; oa.x = o[0]; oa.y = o[1]; oa.z = o[2]; oa.w = o[3];
    uint4 ob; ob.x = o[4]; ob.y = o[5]; ob.z = o[6]; ob.w = o[7];
    *(uint4*)op = oa; *(uint4*)(op + 8) = ob;
  }
}

__global__ void __launch_bounds__(512, 2) mega(P p_arg) {
  __shared__ __attribute__((aligned(16))) char smem[LDS_BYTES];
  cg::grid_group grid = cg::this_grid();
  const int G = gridDim.x;
  CP* pp = (CP*)__builtin_amdgcn_kernarg_segment_ptr();
  const int ph0 = pp->ph0, ph1 = pp->ph1;
  volatile LAS unsigned* xst = (volatile LAS unsigned*)(smem + LDS_BYTES - 16);
  if (threadIdx.x == 0) { xst[0] = 0u; xst[1] = 0u; }
  __syncthreads();
  const XcdBarrier xb = xcd_barrier_post(pp->bar, xst);
  if (ph0 <= 0 && 0 < ph1) {
    asm volatile("" : "+s"(pp));
    CP& p = *pp;
    const int bid = get_rbid();
    const int vid0 = (G & 7) ? bid : ((bid & 7) * (G >> 3) + (bid >> 3));
    const int hb = get_hb();
    char* smem_h = smem + hb * HALF_LDS; (void)smem_h;
    const float* mv0 = p.modv; const float* mv1 = p.modv + (size_t)9 * 6144;
    (void)mv0; (void)mv1; (void)vid0;
    phase_prep(p, smem_h);
    if (0 + 1 < ph1) { if (ph1 > 1000) grid.sync(); else xcd_barrier(xb); }
  }
  if (ph0 <= 1 && 1 < ph1) {
    asm volatile("" : "+s"(pp));
    CP& p = *pp;
    const int bid = get_rbid();
    const int vid0 = (G & 7) ? bid : ((bid & 7) * (G >> 3) + (bid >> 3));
    const int hb = get_hb();
    char* smem_h = smem + hb * HALF_LDS; (void)smem_h;
    const float* mv0 = p.modv; const float* mv1 = p.modv + (size_t)9 * 6144;
    (void)mv0; (void)mv1; (void)vid0;
    phase_normmod_kv(p);
    if (1 + 1 < ph1) { if (ph1 > 1000) grid.sync(); else xcd_barrier(xb); }
  }
  if (ph0 <= 2 && 2 < ph1) {
    asm volatile("" : "+s"(pp));
    CP& p = *pp;
    const int bid = get_rbid();
    const int vid0 = (G & 7) ? bid : ((bid & 7) * (G >> 3) + (bid >> 3));
    const int hb = get_hb();
    char* smem_h = smem + hb * HALF_LDS; (void)smem_h;
    const float* mv0 = p.modv; const float* mv1 = p.modv + (size_t)9 * 6144;
    (void)mv0; (void)mv1; (void)vid0;
    {
        EpiStore e1{p.cq, 512, 2048, nullptr};
        gemm_job<true>(smem, p.hxc, 1024, p.wt_dq, 1024, 512, 16, 2304, 256, 128, 0, 2048, 128, 0, vid0, G, e1);
        EpiStore e2{p.kv, 288, 2304, nullptr};
        gemm_job<true>(smem, p.hxc, 1024, p.wt_dkv, 1024, 288, 18, 2304, 0, 128, 0, 2304, 144, 64 * 2, vid0, G, e2);
        EpiFilt e3{p.Rf, p.hy_decay};
        gemm_job<false>(smem, p.h2bf, 64, p.wt_f3, 64, 2048, 16, 0, 0, 128, 0, 2048, 16, 64 * 2 + 72 * 2, vid0, G, e3);
      }
    if (2 + 1 < ph1) { if (ph1 > 1000) grid.sync(); else xcd_barrier(xb); }
  }
  if (ph0 <= 3 && 3 < ph1) {
    asm volatile("" : "+s"(pp));
    CP& p = *pp;
    const int bid = get_rbid();
    const int vid0 = (G & 7) ? bid : ((bid & 7) * (G >> 3) + (bid >> 3));
    const int hb = get_hb();
    char* smem_h = smem + hb * HALF_LDS; (void)smem_h;
    const float* mv0 = p.modv; const float* mv1 = p.modv + (size_t)9 * 6144;
    (void)mv0; (void)mv1; (void)vid0;
    phase_rowstat(p);
    if (3 + 1 < ph1) { if (ph1 > 1000) grid.sync(); else xcd_barrier(xb); }
  }
  if (ph0 <= 4 && 4 < ph1) {
    asm volatile("" : "+s"(pp));
    CP& p = *pp;
    const int bid = get_rbid();
    const int vid0 = (G & 7) ? bid : ((bid & 7) * (G >> 3) + (bid >> 3));
    const int hb = get_hb();
    char* smem_h = smem + hb * HALF_LDS; (void)smem_h;
    const float* mv0 = p.modv; const float* mv1 = p.modv + (size_t)9 * 6144;
    (void)mv0; (void)mv1; (void)vid0;
    {
        EpiStore e1{p.Q, 1536, 2048, p.rq};
        gemm_job<true>(smem, p.cq, 512, p.wt_uq, 512, 1536, 16, 2048, 0, 128, 0, 2048, 128, 0, vid0, G, e1);
        EpiStore e2{p.Kn, 1024, 2304, p.rkv};
        gemm_job<true>(smem, p.kv, 288, p.wt_uk, 256, 1024, 18, 2304, 0, 128, 0, 2304, 144, 64 * 6, vid0, G, e2);
        EpiVt e3{p.Vt, p.rkv};
        gemm_job<false>(smem, p.kv, 288, p.wt_uv, 256, 1024, 18, 2304, 0, 128, 0, 2304, 144, 64 * 6 + 72 * 4, vid0, G, e3);
      }
    if (4 + 1 < ph1) { if (ph1 > 1000) grid.sync(); else xcd_barrier(xb); }
  }
  if (ph0 <= 5 && 5 < ph1) {
    asm volatile("" : "+s"(pp));
    CP& p = *pp;
    const int bid = get_rbid();
    const int vid0 = (G & 7) ? bid : ((bid & 7) * (G >> 3) + (bid >> 3));
    const int hb = get_hb();
    char* smem_h = smem + hb * HALF_LDS; (void)smem_h;
    const float* mv0 = p.modv; const float* mv1 = p.modv + (size_t)9 * 6144;
    (void)mv0; (void)mv1; (void)vid0;
    phase_attn(p, smem_h, 2 * vid0 + hb, 2 * G);
    if (5 + 1 < ph1) { if (ph1 > 1000) grid.sync(); else xcd_barrier(xb); }
  }
  if (ph0 <= 6 && 6 < ph1) {
    asm volatile("" : "+s"(pp));
    CP& p = *pp;
    const int bid = get_rbid();
    const int vid0 = (G & 7) ? bid : ((bid & 7) * (G >> 3) + (bid >> 3));
    const int hb = get_hb();
    char* smem_h = smem + hb * HALF_LDS; (void)smem_h;
    const float* mv0 = p.modv; const float* mv1 = p.modv + (size_t)9 * 6144;
    (void)mv0; (void)mv1; (void)vid0;
    {
        EpiResid e{p.X, p.x, mv0 + 2 * 1024, nullptr};
        gemm_job<true>(smem, p.hxc, 1024, p.wt_o, 1024, 1024, 16, 2048, 0, 128, 0, 2048, 128, 0, vid0, G, e);
      }
    if (6 + 1 < ph1) { if (ph1 > 1000) grid.sync(); else xcd_barrier(xb); }
  }
  if (ph0 <= 7 && 7 < ph1) {
    asm volatile("" : "+s"(pp));
    CP& p = *pp;
    const int bid = get_rbid();
    const int vid0 = (G & 7) ? bid : ((bid & 7) * (G >> 3) + (bid >> 3));
    const int hb = get_hb();
    char* smem_h = smem + hb * HALF_LDS; (void)smem_h;
    const float* mv0 = p.modv; const float* mv1 = p.modv + (size_t)9 * 6144;
    (void)mv0; (void)mv1; (void)vid0;
    phase_normmod_x(p, p.norm_ffn_g, 0, 3);
    if (7 + 1 < ph1) { if (ph1 > 1000) grid.sync(); else xcd_barrier(xb); }
  }
  if (ph0 <= 8 && 8 < ph1) {
    asm volatile("" : "+s"(pp));
    CP& p = *pp;
    const int bid = get_rbid();
    const int vid0 = (G & 7) ? bid : ((bid & 7) * (G >> 3) + (bid >> 3));
    const int hb = get_hb();
    char* smem_h = smem + hb * HALF_LDS; (void)smem_h;
    const float* mv0 = p.modv; const float* mv1 = p.modv + (size_t)9 * 6144;
    (void)mv0; (void)mv1; (void)vid0;
    {
        EpiConv<0> e{p.ffn_conv_w, p.ffn_conv_b, 5632, nullptr, p.act, nullptr};
        gemm_job<true>(smem, p.hxc, 1024, p.wt_up0, 1024, 5632, 17, 2048, 0, 126, 1, 2048, 136, 0, vid0, G, e);
      }
    if (8 + 1 < ph1) { if (ph1 > 1000) grid.sync(); else xcd_barrier(xb); }
  }
  if (ph0 <= 9 && 9 < ph1) {
    asm volatile("" : "+s"(pp));
    CP& p = *pp;
    const int bid = get_rbid();
    const int vid0 = (G & 7) ? bid : ((bid & 7) * (G >> 3) + (bid >> 3));
    const int hb = get_hb();
    char* smem_h = smem + hb * HALF_LDS; (void)smem_h;
    const float* mv0 = p.modv; const float* mv1 = p.modv + (size_t)9 * 6144;
    (void)mv0; (void)mv1; (void)vid0;
    {
        EpiResid e{p.X, p.X, mv0 + 5 * 1024, nullptr};
        gemm_job<true>(smem, p.act, 2816, p.wt_dn0, 2816, 1024, 16, 2048, 0, 128, 0, 2048, 128, 0, vid0, G, e);
      }
    if (9 + 1 < ph1) { if (ph1 > 1000) grid.sync(); else xcd_barrier(xb); }
  }
  if (ph0 <= 10 && 10 < ph1) {
    asm volatile("" : "+s"(pp));
    CP& p = *pp;
    const int bid = get_rbid();
    const int vid0 = (G & 7) ? bid : ((bid & 7) * (G >> 3) + (bid >> 3));
    const int hb = get_hb();
    char* smem_h = smem + hb * HALF_LDS; (void)smem_h;
    const float* mv0 = p.modv; const float* mv1 = p.modv + (size_t)9 * 6144;
    (void)mv0; (void)mv1; (void)vid0;
    phase_normmod_x(p, p.norm_mix_g + 1024, 1, 0);
    if (10 + 1 < ph1) { if (ph1 > 1000) grid.sync(); else xcd_barrier(xb); }
  }
  if (ph0 <= 11 && 11 < ph1) {
    asm volatile("" : "+s"(pp));
    CP& p = *pp;
    const int bid = get_rbid();
    const int vid0 = (G & 7) ? bid : ((bid & 7) * (G >> 3) + (bid >> 3));
    const int hb = get_hb();
    char* smem_h = smem + hb * HALF_LDS; (void)smem_h;
    const float* mv0 = p.modv; const float* mv1 = p.modv + (size_t)9 * 6144;
    (void)mv0; (void)mv1; (void)vid0;
    {
        EpiConv<1> e{p.hy_conv_w, p.hy_conv_b, 3072, p.hy_b_in, p.x1h, p.vvT};
        gemm_job<true>(smem, p.hxc, 1024, p.wt_hin, 1024, 3072, 17, 2048, 0, 126, 1, 2048, 136, 0, vid0, G, e);
      }
    if (11 + 1 < ph1) { if (ph1 > 1000) grid.sync(); else xcd_barrier(xb); }
  }
  if (ph0 <= 12 && 12 < ph1) {
    asm volatile("" : "+s"(pp));
    CP& p = *pp;
    const int bid = get_rbid();
    const int vid0 = (G & 7) ? bid : ((bid & 7) * (G >> 3) + (bid >> 3));
    const int hb = get_hb();
    char* smem_h = smem + hb * HALF_LDS; (void)smem_h;
    const float* mv0 = p.modv; const float* mv1 = p.modv + (size_t)9 * 6144;
    (void)mv0; (void)mv1; (void)vid0;
    phase_hyconv(p, smem_h);
    if (12 + 1 < ph1) { if (ph1 > 1000) grid.sync(); else xcd_barrier(xb); }
  }
  if (ph0 <= 13 && 13 < ph1) {
    asm volatile("" : "+s"(pp));
    CP& p = *pp;
    const int bid = get_rbid();
    const int vid0 = (G & 7) ? bid : ((bid & 7) * (G >> 3) + (bid >> 3));
    const int hb = get_hb();
    char* smem_h = smem + hb * HALF_LDS; (void)smem_h;
    const float* mv0 = p.modv; const float* mv1 = p.modv + (size_t)9 * 6144;
    (void)mv0; (void)mv1; (void)vid0;
    phase_transmul(p, smem_h);
    if (13 + 1 < ph1) { if (ph1 > 1000) grid.sync(); else xcd_barrier(xb); }
  }
  if (ph0 <= 14 && 14 < ph1) {
    asm volatile("" : "+s"(pp));
    CP& p = *pp;
    const int bid = get_rbid();
    const int vid0 = (G & 7) ? bid : ((bid & 7) * (G >> 3) + (bid >> 3));
    const int hb = get_hb();
    char* smem_h = smem + hb * HALF_LDS; (void)smem_h;
    const float* mv0 = p.modv; const float* mv1 = p.modv + (size_t)9 * 6144;
    (void)mv0; (void)mv1; (void)vid0;
    {
        EpiResid e{p.X, p.X, mv1 + 2 * 1024, p.hy_b_out};
        gemm_job<true>(smem, p.hxc, 1024, p.wt_hout, 1024, 1024, 16, 2048, 0, 128, 0, 2048, 128, 0, vid0, G, e);
      }
    if (14 + 1 < ph1) { if (ph1 > 1000) grid.sync(); else xcd_barrier(xb); }
  }
  if (ph0 <= 15 && 15 < ph1) {
    asm volatile("" : "+s"(pp));
    CP& p = *pp;
    const int bid = get_rbid();
    const int vid0 = (G & 7) ? bid : ((bid & 7) * (G >> 3) + (bid >> 3));
    const int hb = get_hb();
    char* smem_h = smem + hb * HALF_LDS; (void)smem_h;
    const float* mv0 = p.modv; const float* mv1 = p.modv + (size_t)9 * 6144;
    (void)mv0; (void)mv1; (void)vid0;
    phase_normmod_x(p, p.norm_ffn_g + 1024, 1, 3);
    if (15 + 1 < ph1) { if (ph1 > 1000) grid.sync(); else xcd_barrier(xb); }
  }
  if (ph0 <= 16 && 16 < ph1) {
    asm volatile("" : "+s"(pp));
    CP& p = *pp;
    const int bid = get_rbid();
    const int vid0 = (G & 7) ? bid : ((bid & 7) * (G >> 3) + (bid >> 3));
    const int hb = get_hb();
    char* smem_h = smem + hb * HALF_LDS; (void)smem_h;
    const float* mv0 = p.modv; const float* mv1 = p.modv + (size_t)9 * 6144;
    (void)mv0; (void)mv1; (void)vid0;
    {
        EpiConv<0> e{p.ffn_conv_w + (size_t)3 * 5632, p.ffn_conv_b + 5632, 5632, nullptr, p.act, nullptr};
        gemm_job<true>(smem, p.hxc, 1024, p.wt_up1, 1024, 5632, 17, 2048, 0, 126, 1, 2048, 136, 0, vid0, G, e);
      }
    if (16 + 1 < ph1) { if (ph1 > 1000) grid.sync(); else xcd_barrier(xb); }
  }
  if (ph0 <= 17 && 17 < ph1) {
    asm volatile("" : "+s"(pp));
    CP& p = *pp;
    const int bid = get_rbid();
    const int vid0 = (G & 7) ? bid : ((bid & 7) * (G >> 3) + (bid >> 3));
    const int hb = get_hb();
    char* smem_h = smem + hb * HALF_LDS; (void)smem_h;
    const float* mv0 = p.modv; const float* mv1 = p.modv + (size_t)9 * 6144;
    (void)mv0; (void)mv1; (void)vid0;
    {
        EpiResid e{p.X, p.X, mv1 + 5 * 1024, nullptr};
        gemm_job<true>(smem, p.act, 2816, p.wt_dn1, 2816, 1024, 16, 2048, 0, 128, 0, 2048, 128, 0, vid0, G, e);
      }
    if (17 + 1 < ph1) { if (ph1 > 1000) grid.sync(); else xcd_barrier(xb); }
  }
  if (ph0 <= 18 && 18 < ph1) {
    asm volatile("" : "+s"(pp));
    CP& p = *pp;
    const int bid = get_rbid();
    const int vid0 = (G & 7) ? bid : ((bid & 7) * (G >> 3) + (bid >> 3));
    const int hb = get_hb();
    char* smem_h = smem + hb * HALF_LDS; (void)smem_h;
    const float* mv0 = p.modv; const float* mv1 = p.modv + (size_t)9 * 6144;
    (void)mv0; (void)mv1; (void)vid0;
    phase_final_norm(p);
    if (18 + 1 < ph1) { if (ph1 > 1000) grid.sync(); else xcd_barrier(xb); }
  }
}

extern "C" void kernel_launch(void* const* d_in, const int* in_sizes, int n_in, void* d_out, int out_size, void* d_ws, size_t ws_size, hipStream_t stream) {
  static int grid_blocks = 0;
  if (!grid_blocks) {
    int dev = 0, cus = 0, per_cu = 0;
    hipGetDevice(&dev);
    hipDeviceGetAttribute(&cus, hipDeviceAttributeMultiprocessorCount, dev);
    hipOccupancyMaxActiveBlocksPerMultiprocessor(&per_cu, (const void*)mega, 512, 0);
    per_cu = 1;
    grid_blocks = cus * per_cu;
  }
  P p{};
  const float** in = (const float**)&p;
  for (int i = 0; i < 36; ++i) in[i] = (const float*)d_in[i];
  p.X = (float*)d_out;
  char* ws = (char*)d_ws; size_t off = 0;
  auto take = [&](size_t bytes) { char* r = ws + off; off += (bytes + 255) & ~(size_t)255; return r; };
  p.wt_dq = (bf16_t*)take((size_t)512 * 1024 * 2);
  p.wt_dkv = (bf16_t*)take((size_t)288 * 1024 * 2);
  p.wt_uq = (bf16_t*)take((size_t)1536 * 512 * 2);
  p.wt_uk = (bf16_t*)take((size_t)1024 * 256 * 2);
  p.wt_uv = (bf16_t*)take((size_t)1024 * 256 * 2);
  p.wt_o = (bf16_t*)take((size_t)1024 * 1024 * 2);
  p.wt_hin = (bf16_t*)take((size_t)3072 * 1024 * 2);
  p.wt_hout = (bf16_t*)take((size_t)1024 * 1024 * 2);
  p.wt_up0 = (bf16_t*)take((size_t)5632 * 1024 * 2);
  p.wt_up1 = (bf16_t*)take((size_t)5632 * 1024 * 2);
  p.wt_dn0 = (bf16_t*)take((size_t)1024 * 2816 * 2);
  p.wt_dn1 = (bf16_t*)take((size_t)1024 * 2816 * 2);
  p.modv = (float*)take((size_t)2 * 9 * 6144 * 4);
  p.rq = (float*)take((size_t)16384 * 4);
  p.rkv = (float*)take((size_t)18432 * 4);
  p.modp = (float*)take((size_t)4 * 110592 * 4);
  p.bar = (unsigned*)take((size_t)XCD_BAR_WORDS * 4);
  p.wt_f3 = (bf16_t*)take((size_t)2048 * 64 * 2);
  p.h2bf = (bf16_t*)take((size_t)2048 * 64 * 2);
  p.Rf = (bf16_t*)take((size_t)1024 * 4096 * 2);
  p.kpe = (bf16_t*)take((size_t)18432 * 32 * 2);
  p.hxc = (bf16_t*)take((size_t)18432 * 1024 * 2);
  const size_t ubase = off;
  p.cq = (bf16_t*)take((size_t)16384 * 512 * 2);
  p.kv = (bf16_t*)take((size_t)18432 * 288 * 2);
  p.Q = (bf16_t*)take((size_t)16384 * 1536 * 2);
  p.Kn = (bf16_t*)take((size_t)18432 * 1024 * 2);
  p.Vt = (bf16_t*)take((size_t)18432 * 1024 * 2);
  const size_t uend1 = off;
  off = ubase;
  p.act = (bf16_t*)take((size_t)16384 * 2816 * 2);
  off = ubase;
  p.x1h = (bf16_t*)take((size_t)16384 * 1024 * 2);
  p.vvT = (bf16_t*)take((size_t)16384 * 1024 * 2);
  p.Yp = (bf16_t*)take((size_t)16384 * 1024 * 2);
  if (uend1 > ws_size) { fprintf(stderr, "workspace too small: need %zu have %zu\n", uend1, ws_size); return; }
  p.ph0 = 0; p.ph1 = NPHASE;
  if (hipMemsetAsync(p.bar, 0, (size_t)XCD_BAR_WORDS * 4, stream) != hipSuccess) { fprintf(stderr, "memset failed\n"); return; }
  void* args[] = {&p};
  hipError_t e = hipLaunchCooperativeKernel((const void*)mega, dim3(grid_blocks), dim3(512), args, 0, stream);
  if (e != hipSuccess) fprintf(stderr, "cooperative launch failed: %s (grid %d)\n", hipGetErrorString(e), grid_blocks);
}
```

```cpp
#include <hip/hip_runtime.h>
#include <hip/hip_cooperative_groups.h>
#include <cstdio>
namespace cg = cooperative_groups;

typedef unsigned short bf16_t;
typedef short bf16x8 __attribute__((ext_vector_type(8)));
typedef float f32x4 __attribute__((ext_vector_type(4)));
typedef float f32x16 __attribute__((ext_vector_type(16)));

#define LDS_BYTES 163840
#define HALF_LDS 81920
#define NPHASE 19

struct P {
  const float *x, *c, *ctx, *c_ctx, *mod_w, *mod_b, *norm_mix_g, *norm_ffn_g;
  const float *w_dq, *g_q, *w_uq, *w_dkv, *g_kv, *w_uk, *w_uv, *w_o;
  const float *hy_w_in, *hy_b_in, *hy_conv_w, *hy_conv_b, *f_w1, *f_b1, *f_freq1, *f_w2, *f_b2, *f_freq2, *f_w3, *hy_decay, *hy_d_bias, *hy_w_out, *hy_b_out;
  const float *ffn_w_up, *ffn_conv_w, *ffn_conv_b, *ffn_w_down, *final_g;
  float* X;
  bf16_t *wt_dq, *wt_dkv, *wt_uq, *wt_uk, *wt_uv, *wt_o, *wt_hin, *wt_hout, *wt_up0, *wt_up1, *wt_dn0, *wt_dn1;
  float *modv, *rq, *rkv, *modp;
  unsigned* bar;
  bf16_t *wt_f3, *h2bf;
  bf16_t *Rf, *kpe, *hxc, *cq, *kv, *Q, *Kn, *Vt, *act, *x1h, *vvT, *Yp;
  int ph0, ph1;
};

typedef const __attribute__((address_space(4))) P CP;
__device__ __forceinline__ int get_tid512() { int t = threadIdx.x; asm volatile("" : "+v"(t)); return t; }
__device__ __forceinline__ int get_tid() { int t = threadIdx.x & 255; asm volatile("" : "+v"(t)); return t; }
__device__ __forceinline__ int get_hb() { int t = __builtin_amdgcn_readfirstlane((int)(threadIdx.x >> 8)); asm volatile("" : "+s"(t)); return t; }
__device__ __forceinline__ int get_rbid() { int t = blockIdx.x; asm volatile("" : "+s"(t)); return t; }
__device__ __forceinline__ int get_bid() { return 2 * get_rbid() + get_hb(); }
#define VGRID (2 * (int)gridDim.x)

__device__ __forceinline__ unsigned pack2(float a, float b) { unsigned r; asm("v_cvt_pk_bf16_f32 %0, %1, %2" : "=v"(r) : "v"(a), "v"(b)); return r; }
__device__ __forceinline__ bf16_t f2bf(float f) { return (bf16_t)(pack2(f, f) & 0xffffu); }
__device__ __forceinline__ float bf2f(bf16_t h) { return __uint_as_float(((unsigned)h) << 16); }
__device__ __forceinline__ float wave_sum(float v) {
#pragma unroll
  for (int o = 32; o; o >>= 1) v += __shfl_xor(v, o);
  return v;
}


#define XB_TMO      128
#define XB_XCNT(j)  (256  + 64 * (j))
#define XB_XSUB(j)  (1280 + 64 * (j))
#define XB_XGEN(j)  (2304 + 64 * (j))
#define XB_TOP      3328
#define XB_TOPGEN   3392
#define XCD_BAR_WORDS 3456
#define XB_SPIN_CAP (1u << 18)
#define LAS __attribute__((address_space(3)))
__device__ __forceinline__ unsigned xb_ld(unsigned* p)              { return __hip_atomic_load(p, __ATOMIC_RELAXED, __HIP_MEMORY_SCOPE_AGENT); }
__device__ __forceinline__ unsigned xb_add(unsigned* p, unsigned v) { return __hip_atomic_fetch_add(p, v, __ATOMIC_RELAXED, __HIP_MEMORY_SCOPE_AGENT); }
__device__ __forceinline__ unsigned xb_xcc_id() { return (unsigned)__builtin_amdgcn_s_getreg((3 << 11) | 20) & 0xFu; }
#define XB_SPIN(cond, bar) do { unsigned _sp = 0; while (cond) { __builtin_amdgcn_s_sleep(1); \
    if ((++_sp & 255u) == 0u) { if (xb_ld(&(bar)[XB_TMO])) break; if (_sp > XB_SPIN_CAP) { atomicAdd(&(bar)[XB_TMO], 1u); break; } } } } while (0)
struct XcdBarrier { unsigned* bar; unsigned x; volatile LAS unsigned* st; };
__device__ __forceinline__ XcdBarrier xcd_barrier_post(unsigned* bar, volatile LAS unsigned* st) {
    XcdBarrier b; b.bar = bar; b.x = xb_xcc_id(); b.st = st;
    if (threadIdx.x == 0) (void)xb_add(&bar[XB_XCNT(b.x)], 1u);
    return b;
}
__device__ __forceinline__ void xcd_barrier_complete(unsigned* bar, unsigned x, unsigned& nloc, unsigned& nx) {
    const unsigned G = gridDim.x * gridDim.y * gridDim.z;
    unsigned sum, cnt, mine, sp = 0u;
    for (;;) {
        sum = 0u; cnt = 0u; mine = 0u;
#pragma unroll
        for (unsigned j = 0; j < 16; ++j) { const unsigned c = xb_ld(&bar[XB_XCNT(j)]); sum += c; cnt += (c > 0u) ? 1u : 0u; mine = (j == x) ? c : mine; }
        if (sum == G) break;
        __builtin_amdgcn_s_sleep(1);
        if ((++sp & 255u) == 0u) { if (xb_ld(&bar[XB_TMO])) break; if (sp > XB_SPIN_CAP) { atomicAdd(&bar[XB_TMO], 1u); break; } }
    }
    nloc = mine > 0u ? mine : 1u; nx = cnt > 0u ? cnt : 1u;
}
__device__ __forceinline__ void xcd_barrier(const XcdBarrier& b) {
    asm volatile("s_waitcnt vmcnt(0)" ::: "memory");
    __syncthreads();
    if (threadIdx.x == 0) {
        unsigned* bar = b.bar;
        __builtin_amdgcn_s_waitcnt(0);
        unsigned nloc = b.st[0], nx = b.st[1];
        if (nloc == 0u) { xcd_barrier_complete(bar, b.x, nloc, nx); b.st[0] = nloc; b.st[1] = nx; }
        const unsigned old = xb_add(&bar[XB_XSUB(b.x)], 1u);
        const unsigned gen = old / nloc;
        if (old + 1u == (gen + 1u) * nloc) {
            __builtin_amdgcn_fence(__ATOMIC_RELEASE, "agent");
            asm volatile("s_waitcnt vmcnt(0)" ::: "memory");
            const unsigned og = xb_add(&bar[XB_TOP], 1u);
            const unsigned tg = og / nx;
            if (og + 1u == (tg + 1u) * nx) xb_add(&bar[XB_TOPGEN], 1u);
            else XB_SPIN(xb_ld(&bar[XB_TOPGEN]) == tg, bar);
            __builtin_amdgcn_fence(__ATOMIC_ACQUIRE, "agent");
            xb_add(&bar[XB_XGEN(b.x)], 1u);
            asm volatile("s_waitcnt vmcnt(0)" ::: "memory");
        } else {
            XB_SPIN(xb_ld(&bar[XB_XGEN(b.x)]) == gen, bar);
            __builtin_amdgcn_fence(__ATOMIC_ACQUIRE, "agent");
            asm volatile("s_waitcnt vmcnt(0)" ::: "memory");
        }
    }
    __syncthreads();
}

__device__ __forceinline__ void prep_weight_tile(CP& p, char* smem, int wt) {
  const int tid = get_tid();
  int id = 0;
  {
    const int cnt[13] = {128, 80, 192, 64, 64, 256, 768, 256, 1408, 1408, 704, 704, 32};
#pragma unroll
    for (int i = 0; i < 12; ++i) { if (id == i && wt >= cnt[i]) { wt -= cnt[i]; id = i + 1; } }
  }
  const float* src; int K, N; bf16_t* dst; const float* scale = nullptr; int perm = 0;
  switch (id) {
    case 0: src = p.w_dq; K = 1024; N = 512; dst = p.wt_dq; break;
    case 1: src = p.w_dkv; K = 1024; N = 288; dst = p.wt_dkv; break;
    case 2: src = p.w_uq; K = 512; N = 1536; dst = p.wt_uq; scale = p.g_q; break;
    case 3: src = p.w_uk; K = 256; N = 1024; dst = p.wt_uk; scale = p.g_kv; break;
    case 4: src = p.w_uv; K = 256; N = 1024; dst = p.wt_uv; scale = p.g_kv; break;
    case 5: src = p.w_o; K = 1024; N = 1024; dst = p.wt_o; break;
    case 6: src = p.hy_w_in; K = 1024; N = 3072; dst = p.wt_hin; perm = 2; break;
    case 7: src = p.hy_w_out; K = 1024; N = 1024; dst = p.wt_hout; break;
    case 8: src = p.ffn_w_up; K = 1024; N = 5632; dst = p.wt_up0; perm = 1; break;
    case 9: src = p.ffn_w_up + (size_t)1024 * 5632; K = 1024; N = 5632; dst = p.wt_up1; perm = 1; break;
    case 10: src = p.ffn_w_down; K = 2816; N = 1024; dst = p.wt_dn0; break;
    case 11: src = p.ffn_w_down + (size_t)2816 * 1024; K = 2816; N = 1024; dst = p.wt_dn1; break;
    default: src = p.f_w3; K = 64; N = 2048; dst = p.wt_f3; break;
  }
  const int ntn = (N + 63) >> 6;
  const int kt = wt / ntn, nt = wt - kt * ntn;
  const int k0 = kt * 64, n0 = nt * 64;
  int np0;
  if (perm == 1) { const int half = n0 / 2816, f = n0 - half * 2816; np0 = (f >> 6) * 128 + half * 64; }
  else if (perm == 2) { if (n0 < 1024) np0 = n0; else { const int m = n0 - 1024, half = m >> 10, f = m & 1023; np0 = 1024 + (f >> 6) * 128 + half * 64; } }
  else np0 = n0;
  bf16_t* t16 = (bf16_t*)smem;
  f32x4 v[4];
#pragma unroll
  for (int i = 0; i < 4; ++i) {
    const int idx = tid + 256 * i; const int kr = idx >> 4, c4 = idx & 15;
    v[i] = (f32x4){0.f, 0.f, 0.f, 0.f};
    if (n0 + 4 * c4 < N) v[i] = *(const f32x4*)(src + (size_t)(k0 + kr) * N + n0 + 4 * c4);
  }
#pragma unroll
  for (int i = 0; i < 4; ++i) {
    const int idx = tid + 256 * i; const int kr = idx >> 4, c4 = idx & 15;
    const float sc = scale ? scale[k0 + kr] : 1.f;
#pragma unroll
    for (int j = 0; j < 4; ++j) t16[(4 * c4 + j) * 72 + kr] = f2bf(v[i][j] * sc);
  }
  __syncthreads();
#pragma unroll
  for (int i = 0; i < 2; ++i) {
    const int idx = tid + 256 * i; const int n = idx >> 3, ch = idx & 7;
    if (n0 + n < N) *(uint4*)(dst + (size_t)(np0 + n) * K + k0 + ch * 8) = *(const uint4*)(t16 + n * 72 + ch * 8);
  }
  __syncthreads();
}

__device__ __forceinline__ void prep_modvec(CP& p, char* smem, int it) {
  const int tid = get_tid();
  const int layer = it / 384, rem = it - layer * 384, cb = rem >> 2, ks = rem & 3;
  float* s_lds = (float*)smem;
  float* red = (float*)(smem + 12288);
  const int kbase = ks * 256;
  for (int idx = tid; idx < 9 * 256; idx += 256) {
    const int r = idx >> 8, k = idx & 255;
    const float v = r < 8 ? p.c[r * 1024 + kbase + k] : p.c_ctx[kbase + k];
    s_lds[k * 12 + r] = v / (1.f + __expf(-v));
  }
  __syncthreads();
  const int col = cb * 64 + (tid & 63), kg = tid >> 6;
  const float* W = p.mod_w + (size_t)layer * 1024 * 6144 + (size_t)kbase * 6144 + col;
  float acc[9];
#pragma unroll
  for (int r = 0; r < 9; ++r) acc[r] = 0.f;
#pragma unroll
  for (int kb = 0; kb < 4; ++kb) {
    float w[16];
#pragma unroll
    for (int u = 0; u < 16; ++u) w[u] = W[(size_t)(kg * 64 + kb * 16 + u) * 6144];
#pragma unroll
    for (int u = 0; u < 16; ++u) {
      const int k = kg * 64 + kb * 16 + u;
      const f32x4 s0 = *(const f32x4*)(s_lds + k * 12), s1 = *(const f32x4*)(s_lds + k * 12 + 4);
      const float s2 = s_lds[k * 12 + 8];
      acc[0] += s0[0] * w[u]; acc[1] += s0[1] * w[u]; acc[2] += s0[2] * w[u]; acc[3] += s0[3] * w[u];
      acc[4] += s1[0] * w[u]; acc[5] += s1[1] * w[u]; acc[6] += s1[2] * w[u]; acc[7] += s1[3] * w[u];
      acc[8] += s2 * w[u];
    }
  }
#pragma unroll
  for (int r = 0; r < 9; ++r) red[(kg * 9 + r) * 64 + (tid & 63)] = acc[r];
  __syncthreads();
  for (int o = tid; o < 9 * 64; o += 256) {
    const int r = o >> 6, cl = o & 63;
    const float sm = red[(0 * 9 + r) * 64 + cl] + red[(1 * 9 + r) * 64 + cl] + red[(2 * 9 + r) * 64 + cl] + red[(3 * 9 + r) * 64 + cl];
    p.modp[(size_t)ks * 110592 + (size_t)(layer * 9 + r) * 6144 + cb * 64 + cl] = sm;
  }
  __syncthreads();
}

__device__ __forceinline__ void prep_filter(CP& p, char* smem, int it) {
  const int tid = get_tid();
  float* z = (float*)smem;
  float* h1 = z + 8 * 33;
  float* h2 = h1 + 8 * 64;
  const int t0 = it * 8;
  for (int idx = tid; idx < 8 * 33; idx += 256) {
    const int pp = idx / 33, i = idx - pp * 33;
    const int t = t0 + pp;
    float v;
    if (i == 0) v = (float)t * (1.0f / 2047.0f);
    else {
      const int k = (i - 1) & 15;
      const float w = (6.283185307179586f * (float)t) / 2048.0f;
      const float f = 1e-4f + (float)k * ((15.0f - 1e-4f) / 15.0f);
      const float a = w * f;
      v = (i <= 16) ? __cosf(a) : -__sinf(a);
    }
    z[idx] = v;
  }
  __syncthreads();
  for (int idx = tid; idx < 8 * 64; idx += 256) {
    const int pp = idx >> 6, j = idx & 63;
    float s = p.f_b1[j];
#pragma unroll
    for (int i = 0; i < 33; ++i) s += z[pp * 33 + i] * p.f_w1[i * 64 + j];
    h1[idx] = __sinf(p.f_freq1[j] * s);
  }
  __syncthreads();
  for (int idx = tid; idx < 8 * 64; idx += 256) {
    const int pp = idx >> 6, j = idx & 63;
    float s = p.f_b2[j];
#pragma unroll 16
    for (int i = 0; i < 64; ++i) s += h1[pp * 64 + i] * p.f_w2[i * 64 + j];
    h2[idx] = __sinf(p.f_freq2[j] * s);
  }
  __syncthreads();
  for (int idx = tid; idx < 8 * 64; idx += 256) p.h2bf[(size_t)t0 * 64 + idx] = f2bf(h2[idx]);
  __syncthreads();
}

__device__ __forceinline__ void phase_prep(CP& p, char* smem) {
  const int total = 768 + 256 + 6064;
  for (int it = get_bid(); it < total; it += VGRID) {
    if (it < 768) prep_modvec(p, smem, it);
    else if (it < 1024) prep_filter(p, smem, it - 768);
    else prep_weight_tile(p, smem, it - 1024);
  }
}

template <bool PART>
__device__ __forceinline__ void normmod_row2(const float* __restrict__ src, const float* __restrict__ g, const float* __restrict__ sh, const float* __restrict__ sc, bf16_t* __restrict__ dst, int lane, const float* __restrict__ bsh = nullptr) {
  f32x4 v[2][4]; float ss0 = 0.f, ss1 = 0.f;
#pragma unroll
  for (int i = 0; i < 4; ++i) { v[0][i] = *(const f32x4*)(src + lane * 4 + 256 * i); v[1][i] = *(const f32x4*)(src + 1024 + lane * 4 + 256 * i); }
#pragma unroll
  for (int i = 0; i < 4; ++i) {
    ss0 += v[0][i][0] * v[0][i][0] + v[0][i][1] * v[0][i][1] + v[0][i][2] * v[0][i][2] + v[0][i][3] * v[0][i][3];
    ss1 += v[1][i][0] * v[1][i][0] + v[1][i][1] * v[1][i][1] + v[1][i][2] * v[1][i][2] + v[1][i][3] * v[1][i][3];
  }
  ss0 = wave_sum(ss0); ss1 = wave_sum(ss1);
  const float r0 = rsqrtf(ss0 * (1.0f / 1024.0f) + 1e-6f), r1 = rsqrtf(ss1 * (1.0f / 1024.0f) + 1e-6f);
#pragma unroll
  for (int i = 0; i < 4; ++i) {
    const int k = lane * 4 + 256 * i;
    const f32x4 g4 = *(const f32x4*)(g + k);
    f32x4 s4 = *(const f32x4*)(sh + k), c4 = *(const f32x4*)(sc + k);
    if (PART) {
#pragma unroll
      for (int q = 1; q < 4; ++q) { s4 += *(const f32x4*)(sh + (size_t)q * 110592 + k); c4 += *(const f32x4*)(sc + (size_t)q * 110592 + k); }
      s4 += *(const f32x4*)(bsh + k); c4 += *(const f32x4*)(bsh + 1024 + k);
    }
    float y[4], z[4];
#pragma unroll
    for (int j = 0; j < 4; ++j) { const float gm = g4[j] * (1.f + c4[j]); y[j] = (v[0][i][j] * r0) * gm + s4[j]; z[j] = (v[1][i][j] * r1) * gm + s4[j]; }
    uint2 u; u.x = pack2(y[0], y[1]); u.y = pack2(y[2], y[3]);
    *(uint2*)(dst + k) = u;
    u.x = pack2(z[0], z[1]); u.y = pack2(z[2], z[3]);
    *(uint2*)(dst + 1024 + k) = u;
  }
}

__device__ __forceinline__ void phase_normmod_kv(CP& p) {
  const int lane = get_tid() & 63, wv = get_tid() >> 6;
  const float* g = p.norm_mix_g;
  for (int idx = get_bid() * 256 + get_tid(); idx < 110592; idx += VGRID * 256) {
    const int lr = idx / 6144; const int n = idx - lr * 6144; const int layer = lr / 9;
    p.modv[idx] = p.modp[idx] + p.modp[110592 + idx] + p.modp[2 * 110592 + idx] + p.modp[3 * 110592 + idx] + p.mod_b[layer * 6144 + n];
  }
  for (int r = (get_bid() * 4 + wv) * 2; r < 18432; r += VGRID * 8) {
    const int b = r / 2304, pp = r - b * 2304;
    const float* src; const float* mv;
    if (pp < 256) { src = p.ctx + ((size_t)b * 256 + pp) * 1024; mv = p.modp + (size_t)8 * 6144; }
    else { src = p.x + ((size_t)b * 2048 + pp - 256) * 1024; mv = p.modp + (size_t)b * 6144; }
    normmod_row2<true>(src, g, mv, mv + 1024, p.hxc + (size_t)r * 1024, lane, p.mod_b);
  }
}
__device__ __forceinline__ void phase_normmod_x(CP& p, const float* g, int layer, int chunk) {
  const int lane = get_tid() & 63, wv = get_tid() >> 6;
  for (int r = (get_bid() * 4 + wv) * 2; r < 16384; r += VGRID * 8) {
    const int b = r >> 11;
    const float* mv = p.modv + (size_t)(layer * 9 + b) * 6144 + chunk * 1024;
    normmod_row2<false>(p.X + (size_t)r * 1024, g, mv, mv + 1024, p.hxc + (size_t)r * 1024, lane);
  }
}
__device__ __forceinline__ void phase_final_norm(CP& p) {
  const int lane = get_tid() & 63, wv = get_tid() >> 6;
  for (int r = get_bid() * 4 + wv; r < 16384; r += VGRID * 4) {
    float* row = p.X + (size_t)r * 1024;
    f32x4 v[4]; float ss = 0.f;
#pragma unroll
    for (int i = 0; i < 4; ++i) { v[i] = *(const f32x4*)(row + lane * 4 + 256 * i); ss += v[i][0] * v[i][0] + v[i][1] * v[i][1] + v[i][2] * v[i][2] + v[i][3] * v[i][3]; }
    ss = wave_sum(ss);
    const float rr = rsqrtf(ss * (1.0f / 1024.0f) + 1e-6f);
#pragma unroll
    for (int i = 0; i < 4; ++i) {
      const int k = lane * 4 + 256 * i;
      const f32x4 g4 = *(const f32x4*)(p.final_g + k);
      f32x4 o; o[0] = v[i][0] * rr * g4[0]; o[1] = v[i][1] * rr * g4[1]; o[2] = v[i][2] * rr * g4[2]; o[3] = v[i][3] * rr * g4[3];
      *(f32x4*)(row + k) = o;
    }
  }
}

__device__ __forceinline__ void phase_rowstat(CP& p) {
  const int lane = get_tid() & 63, wv = get_tid() >> 6;
  for (int r = get_bid() * 4 + wv; r < 18432; r += VGRID * 4) {
    const int b = r / 2304, pp = r - b * 2304;
    const bf16_t* kvr = p.kv + (size_t)r * 288;
    {
      const uint2 u = *(const uint2*)(kvr + lane * 4);
      const float a0 = bf2f((bf16_t)(u.x & 0xffff)), a1 = bf2f((bf16_t)(u.x >> 16)), a2 = bf2f((bf16_t)(u.y & 0xffff)), a3 = bf2f((bf16_t)(u.y >> 16));
      float ss = a0 * a0 + a1 * a1 + a2 * a2 + a3 * a3;
      ss = wave_sum(ss);
      if (lane == 0) p.rkv[r] = rsqrtf(ss * (1.0f / 256.0f) + 1e-6f);
    }
    {
      const int i = lane & 31;
      const float xv = bf2f(kvr[256 + i]);
      const float ov = __shfl_xor(xv, 8);
      float res = xv;
      if (pp >= 256) {
        const int t = pp - 256;
        const int quarter = i >> 3, idx = i & 7;
        const float pos = (quarter < 2) ? (float)(t >> 6) : (float)(t & 63);
        const float inv = exp2f(-(float)idx * (13.287712379549449f / 8.0f));
        const float ang = pos * inv;
        const float cs = __cosf(ang), sn = __sinf(ang);
        res = xv * cs + ((quarter & 1) ? ov : -ov) * sn;
      }
      if (lane < 32) p.kpe[(size_t)r * 32 + i] = f2bf(res);
    }
    if (pp >= 256) {
      const int xr = b * 2048 + pp - 256;
      const uint4 u = *(const uint4*)(p.cq + (size_t)xr * 512 + lane * 8);
      const unsigned uu[4] = {u.x, u.y, u.z, u.w};
      float ss = 0.f;
#pragma unroll
      for (int j = 0; j < 4; ++j) { const float a = bf2f((bf16_t)(uu[j] & 0xffff)), bb = bf2f((bf16_t)(uu[j] >> 16)); ss += a * a + bb * bb; }
      ss = wave_sum(ss);
      if (lane == 0) p.rq[xr] = rsqrtf(ss * (1.0f / 512.0f) + 1e-6f);
    }
  }
}

struct EpiStore {
  static constexpr int KIND = 0;
  bf16_t* out; int ld; int ostride; const float* rs;
  __device__ __forceinline__ void c4(int g, int rig, int col, f32x4 v) const {
    const size_t row = (size_t)g * ostride + rig;
    const float s = rs ? rs[row] : 1.f;
    uint2 u; u.x = pack2(v[0] * s, v[1] * s); u.y = pack2(v[2] * s, v[3] * s);
    *(uint2*)(out + row * ld + col) = u;
  }
};
struct EpiVt {
  static constexpr int KIND = 1;
  bf16_t* out; const float* rs;
  __device__ __forceinline__ void r4(int g, int rig, int col, f32x4 v) const {
    const size_t row = (size_t)g * 2304 + rig;
    const f32x4 s = *(const f32x4*)(rs + row);
    uint2 u; u.x = pack2(v[0] * s[0], v[1] * s[1]); u.y = pack2(v[2] * s[2], v[3] * s[3]);
    *(uint2*)(out + ((size_t)g * 1024 + col) * 2304 + rig) = u;
  }
};
struct EpiFilt {
  static constexpr int KIND = 1;
  bf16_t* Rf; const float* decay;
  __device__ __forceinline__ void r4(int g, int rig, int col, f32x4 v) const {
    const int c = col & 1023; const bool bwd = col >= 1024;
    const float dec = fabsf(decay[c]);
    bf16_t* rp = Rf + (size_t)c * 4096;
#pragma unroll
    for (int j = 0; j < 4; ++j) {
      const int t = rig + j;
      const float val = v[j] * __expf(-(float)t * (1.0f / 2047.0f) * dec);
      if (!bwd) rp[2048 - t] = f2bf(val);
      else if (t > 0) rp[2048 + t] = f2bf(val);
      else rp[0] = 0;
    }
  }
};
struct EpiResid {
  static constexpr int KIND = 0;
  float* X; const float* base; const float* gate; const float* bias;
  __device__ __forceinline__ void c4(int g, int rig, int col, f32x4 v) const {
    const size_t o = ((size_t)g * 2048 + rig) * 1024 + col;
    const f32x4 bs = *(const f32x4*)(base + o);
    const f32x4 gt = *(const f32x4*)(gate + (size_t)g * 6144 + col);
    f32x4 bi = {0.f, 0.f, 0.f, 0.f};
    if (bias) bi = *(const f32x4*)(bias + col);
    f32x4 r;
#pragma unroll
    for (int j = 0; j < 4; ++j) r[j] = bs[j] + gt[j] * (v[j] + bi[j]);
    *(f32x4*)(X + o) = r;
  }
};
template <int MODE>
struct EpiConv {
  static constexpr int KIND = 2;
  const float* cw; const float* cb; int NC; const float* pre_bias;
  bf16_t* o0; bf16_t* o1;
  __device__ __forceinline__ int norig(int nt, int cl) const {
    if (MODE == 0) return (cl >> 6) * 2816 + nt * 64 + (cl & 63);
    if (nt < 8) return nt * 128 + cl;
    return 1024 + (cl >> 6) * 1024 + (nt - 8) * 64 + (cl & 63);
  }
  __device__ __forceinline__ void finish(const float* Z, int g, int rig0, int nt) const {
    const int tid = get_tid();
    if (MODE == 0 || nt < 8) {
      const int f = tid & 63, q = tid >> 6;
      const int p0 = 1 + 32 * q, p1 = (p0 + 32 < 127) ? p0 + 32 : 127;
      if (MODE == 0) {
        const int na = norig(nt, f), ng = norig(nt, 64 + f);
        const float a0 = cw[na], a1 = cw[NC + na], a2 = cw[2 * NC + na], ab = cb[na];
        const float g0 = cw[ng], g1 = cw[NC + ng], g2 = cw[2 * NC + ng], gb = cb[ng];
        float am = Z[(p0 - 1) * 132 + f], ac = Z[p0 * 132 + f], gm = Z[(p0 - 1) * 132 + 64 + f], gc = Z[p0 * 132 + 64 + f];
#pragma unroll 2
        for (int pl = p0; pl < p1; ++pl) {
          const float an = Z[(pl + 1) * 132 + f], gn = Z[(pl + 1) * 132 + 64 + f];
          const int pos = rig0 + pl;
          if (pos < 2048) {
            const float av = a0 * am + a1 * ac + a2 * an + ab;
            const float gv = g0 * gm + g1 * gc + g2 * gn + gb;
            o0[((size_t)g * 2048 + pos) * 2816 + nt * 64 + f] = f2bf(av * gv / (1.f + __expf(-gv)));
          }
          am = ac; ac = an; gm = gc; gc = gn;
        }
      } else {
#pragma unroll
        for (int fh = 0; fh < 2; ++fh) {
          const int cl = fh * 64 + f;
          const int na = norig(nt, cl);
          const float a0 = cw[na], a1 = cw[NC + na], a2 = cw[2 * NC + na], ab = cb[na];
          float am = Z[(p0 - 1) * 132 + cl], ac = Z[p0 * 132 + cl];
#pragma unroll 2
          for (int pl = p0; pl < p1; ++pl) {
            const float an = Z[(pl + 1) * 132 + cl];
            const int pos = rig0 + pl;
            if (pos < 2048) o0[((size_t)g * 2048 + pos) * 1024 + nt * 128 + cl] = f2bf(a0 * am + a1 * ac + a2 * an + ab);
            am = ac; ac = an;
          }
        }
      }
    } else {
      const int pl = tid & 127, fh = tid >> 7;
      const int pos = rig0 + pl;
      if (pl >= 1 && pl <= 126 && pos < 2048) {
        const int fb = nt - 8;
#pragma unroll 2
        for (int f = fh * 32; f < fh * 32 + 32; ++f) {
          const int na = norig(nt, f), nb = norig(nt, 64 + f);
          const float va = cw[na] * Z[(pl - 1) * 132 + f] + cw[NC + na] * Z[pl * 132 + f] + cw[2 * NC + na] * Z[(pl + 1) * 132 + f] + cb[na];
          const float vb = cw[nb] * Z[(pl - 1) * 132 + 64 + f] + cw[NC + nb] * Z[pl * 132 + 64 + f] + cw[2 * NC + nb] * Z[(pl + 1) * 132 + 64 + f] + cb[nb];
          o1[(size_t)(fb * 64 + f) * 16384 + g * 2048 + pos] = f2bf(va * vb);
        }
      }
    }
  }
};

#define GLDS16(gp, lp) __builtin_amdgcn_global_load_lds((const unsigned*)(gp), (__attribute__((address_space(3))) unsigned*)(lp), 16, 0, 0)

template <bool SWAP, class Epi>
__device__ __forceinline__ void gemm_job(char* smem, const bf16_t* __restrict__ A, int lda, const bf16_t* __restrict__ Bt, int K, int N,
                                         int tpg, int a_gstride, int a_goff, int step, int halo, int grows, int MTS, int voff, int vid0, int grid, const Epi& epi) {
  const int tid = get_tid512(), lane = tid & 63, wid = tid >> 6, wr = wid >> 1, wc = wid & 1, fr = lane & 15, fq = lane >> 4;
  const int NT = (N + 255) >> 8, MT = MTS >> 1, ntiles = MT * NT, ns = K >> 6;
  const int full = MT >> 3;
  int v = vid0;
  if (v < voff) v += ((voff - v + grid - 1) / grid) * grid;
  const int swz = (fr >> 1) & 7;
  for (; v < voff + ntiles; v += grid) {
    const int w = v - voff;
    int mt, nt;
    if (w < full * 8 * NT) { const int sr = w / (8 * NT), rem = w - sr * 8 * NT; nt = rem >> 3; mt = sr * 8 + (rem & 7); }
    else { const int w2 = w - full * 8 * NT, rl = MT - full * 8; nt = w2 / rl; mt = full * 8 + (w2 - nt * rl); }
    unsigned ap[4], bp[4];
#pragma unroll
    for (int i = 0; i < 4; ++i) {
      const int r = (tid >> 3) + 64 * i;
      const int cs = tid & 7;
      const int c = ((cs ^ ((r >> 1) & 7)) << 3);
      const int sub = 2 * mt + (r >> 7);
      const int g = sub / tpg, ti = sub - g * tpg;
      int rig = ti * step - halo + (r & 127); rig = rig < 0 ? 0 : (rig > grows - 1 ? grows - 1 : rig);
      ap[i] = (unsigned)((g * a_gstride + a_goff + rig) * lda + c);
      int br = nt * 256 + r; br = br > N - 1 ? N - 1 : br;
      bp[i] = (unsigned)(br * K + c);
    }
    f32x4 acc[4][8];
#pragma unroll
    for (int m = 0; m < 4; ++m)
#pragma unroll
      for (int n = 0; n < 8; ++n) acc[m][n] = (f32x4){0.f, 0.f, 0.f, 0.f};
#pragma unroll
    for (int i = 0; i < 4; ++i) { GLDS16(A + (size_t)ap[i], smem + tid * 16 + i * 8192); GLDS16(Bt + (size_t)bp[i], smem + 32768 + tid * 16 + i * 8192); }
    for (int st = 0; st < ns; ++st) {
      asm volatile("s_waitcnt vmcnt(0)" ::: "memory");
      __builtin_amdgcn_s_barrier();
      asm volatile("" ::: "memory");
      if (st + 1 < ns) {
        char* nb = smem + ((st + 1) & 1) * 65536;
        const int ko = (st + 1) * 64;
#pragma unroll
        for (int i = 0; i < 4; ++i) { GLDS16(A + (size_t)(ap[i] + ko), nb + tid * 16 + i * 8192); GLDS16(Bt + (size_t)(bp[i] + ko), nb + 32768 + tid * 16 + i * 8192); }
      }
      const char* sa = smem + (st & 1) * 65536 + (wr * 64 + fr) * 128;
      const char* sb = smem + (st & 1) * 65536 + 32768 + (wc * 128 + fr) * 128;
      bf16x8 afA[4], afB[4], bfb[2][2];
#pragma unroll
      for (int m = 0; m < 4; ++m) afA[m] = *(const bf16x8*)(sa + m * 2048 + ((fq ^ swz) << 4));
#pragma unroll
      for (int n = 0; n < 2; ++n) bfb[0][n] = *(const bf16x8*)(sb + n * 2048 + ((fq ^ swz) << 4));
#pragma unroll
      for (int gq = 0; gq < 8; ++gq) {
        const int ks = gq >> 2, nh = gq & 3;
        if (gq < 7) {
          const int ks2 = (gq + 1) >> 2, nh2 = (gq + 1) & 3;
#pragma unroll
          for (int n = 0; n < 2; ++n) bfb[(gq + 1) & 1][n] = *(const bf16x8*)(sb + (nh2 * 2 + n) * 2048 + (((ks2 * 4 + fq) ^ swz) << 4));
        }
        if (gq == 3) {
#pragma unroll
          for (int m = 0; m < 4; ++m) afB[m] = *(const bf16x8*)(sa + m * 2048 + (((4 + fq) ^ swz) << 4));
        }
        __builtin_amdgcn_sched_barrier(0);
#pragma unroll
        for (int m = 0; m < 4; ++m)
#pragma unroll
          for (int n = 0; n < 2; ++n) {
            const bf16x8 av = ks ? afB[m] : afA[m];
            acc[m][nh * 2 + n] = SWAP ? __builtin_amdgcn_mfma_f32_16x16x32_bf16(bfb[gq & 1][n], av, acc[m][nh * 2 + n], 0, 0, 0)
                                      : __builtin_amdgcn_mfma_f32_16x16x32_bf16(av, bfb[gq & 1][n], acc[m][nh * 2 + n], 0, 0, 0);
          }
      }
    }
    __syncthreads();
    const int te = get_tid512();
    const int fr_e = te & 15, fq_e = (te & 63) >> 4, wr_e = te >> 7, wc_e = (te >> 6) & 1;
    const int sub = 2 * mt + (wr_e >> 1);
    const int g = sub / tpg, ti = sub - g * tpg;
    const int rig0 = ti * step - halo;
    const int rw = (wr_e & 1) * 64;
    if constexpr (Epi::KIND == 0) {
#pragma unroll
      for (int m = 0; m < 4; ++m) {
        const int rig = rig0 + rw + m * 16 + fr_e;
#pragma unroll
        for (int n = 0; n < 8; ++n) {
          const int col = nt * 256 + wc_e * 128 + n * 16 + fq_e * 4;
          if (col < N) epi.c4(g, rig, col, acc[m][n]);
        }
      }
    } else if constexpr (Epi::KIND == 1) {
#pragma unroll
      for (int m = 0; m < 4; ++m) {
        const int rig = rig0 + rw + m * 16 + fq_e * 4;
#pragma unroll
        for (int n = 0; n < 8; ++n) {
          const int col = nt * 256 + wc_e * 128 + n * 16 + fr_e;
          if (col < N) epi.r4(g, rig, col, acc[m][n]);
        }
      }
    } else {
      float* Z = (float*)smem + (wr_e >> 1) * (128 * 132);
#pragma unroll
      for (int h = 0; h < 2; ++h) {
        const int nt2 = nt * 2 + h;
        if (wc_e == h) {
#pragma unroll
          for (int n = 0; n < 8; ++n) {
            const int cl = n * 16 + fq_e * 4;
            f32x4 b4 = {0.f, 0.f, 0.f, 0.f};
            if (epi.pre_bias) b4 = *(const f32x4*)(epi.pre_bias + epi.norig(nt2, cl));
#pragma unroll
            for (int m = 0; m < 4; ++m) {
              const int rl = rw + m * 16 + fr_e;
              const int pos = rig0 + rl;
              const bool ok = pos >= 0 && pos < grows;
              f32x4 vv = acc[m][n] + b4;
              if (!ok) vv = (f32x4){0.f, 0.f, 0.f, 0.f};
              *(f32x4*)(Z + rl * 132 + cl) = vv;
            }
          }
        }
        __syncthreads();
        epi.finish(Z, g, rig0, nt2);
        __syncthreads();
      }
    }
    asm volatile("s_waitcnt vmcnt(0)" ::: "memory");
    __syncthreads();
  }
}

__device__ __forceinline__ void phase_attn(CP& p, char* smem, int vid0, int grid) {
  bf16_t* Ks = (bf16_t*)smem;
  bf16_t* Vs = (bf16_t*)(smem + 64 * 104 * 2);
  const int tid = get_tid(), lane = tid & 63, w = tid >> 6, r = lane & 31, hh = lane >> 5;
  const float cs = 1.4426950408889634f * 0.10206207261596577f;
  for (int it = vid0; it < 2048; it += grid) {
    const int qt = it & 15, h = (it >> 4) & 15, b = it >> 8;
    const int t = qt * 128 + w * 32 + r;
    const size_t xrow = (size_t)b * 2048 + t;
    const bf16_t* qp = p.Q + xrow * 1536 + h * 96;
    bf16x8 qf[6];
#pragma unroll
    for (int kk = 0; kk < 4; ++kk) qf[kk] = *(const bf16x8*)(qp + 16 * kk + 8 * hh);
#pragma unroll
    for (int part = 0; part < 2; ++part) {
      const bf16_t* pp = qp + 64 + 16 * part;
      const bf16x8 mine = *(const bf16x8*)(pp + 8 * hh), oth = *(const bf16x8*)(pp + 8 * (1 - hh));
      const float posf = part == 0 ? (float)(t >> 6) : (float)(t & 63);
      union { unsigned u[4]; bf16x8 v; } o;
      float res[8];
#pragma unroll
      for (int j = 0; j < 8; ++j) {
        const float inv = exp2f(-(float)j * (13.287712379549449f / 8.0f));
        const float ang = posf * inv;
        const float c = __cosf(ang), s = __sinf(ang);
        const float m = bf2f((bf16_t)mine[j]), ov = bf2f((bf16_t)oth[j]);
        res[j] = m * c + (hh ? ov : -ov) * s;
      }
#pragma unroll
      for (int j = 0; j < 4; ++j) o.u[j] = pack2(res[2 * j], res[2 * j + 1]);
      qf[4 + part] = o.v;
    }
    f32x16 oacc[2];
#pragma unroll
    for (int i = 0; i < 16; ++i) { oacc[0][i] = 0.f; oacc[1][i] = 0.f; }
    float mrun = -INFINITY, lrun = 0.f;
    const size_t kvrow0 = (size_t)b * 2304;
    const bf16_t* kn_base = p.Kn + kvrow0 * 1024 + h * 64;
    const bf16_t* kpe_base = p.kpe + kvrow0 * 32;
    const bf16_t* vt_base = p.Vt + ((size_t)(b * 16 + h) * 64) * 2304;
    uint4 rk0, rk1, rp, rv0, rv1;
    const int srow = tid >> 3, sch = tid & 7;
#define ATT_GLOAD(kt) do { \
      rk0 = *(const uint4*)(kn_base + (size_t)((kt) * 64 + srow) * 1024 + sch * 8); \
      rk1 = *(const uint4*)(kn_base + (size_t)((kt) * 64 + srow + 32) * 1024 + sch * 8); \
      rv0 = *(const uint4*)(vt_base + (size_t)srow * 2304 + (kt) * 64 + sch * 8); \
      rv1 = *(const uint4*)(vt_base + (size_t)(srow + 32) * 2304 + (kt) * 64 + sch * 8); \
      rp = *(const uint4*)(kpe_base + (size_t)((kt) * 64 + (tid >> 2)) * 32 + (tid & 3) * 8); } while (0)
    ATT_GLOAD(0);
    for (int kt = 0; kt < 36; ++kt) {
      __syncthreads();
      {
        *(uint4*)(Ks + srow * 104 + sch * 8) = rk0;
        *(uint4*)(Ks + (srow + 32) * 104 + sch * 8) = rk1;
        uint2 lo, hi;
        lo.x = rv0.x; lo.y = rv0.y; hi.x = rv0.z; hi.y = rv0.w;
        *(uint2*)(Vs + srow * 68 + sch * 8) = lo; *(uint2*)(Vs + srow * 68 + sch * 8 + 4) = hi;
        lo.x = rv1.x; lo.y = rv1.y; hi.x = rv1.z; hi.y = rv1.w;
        *(uint2*)(Vs + (srow + 32) * 68 + sch * 8) = lo; *(uint2*)(Vs + (srow + 32) * 68 + sch * 8 + 4) = hi;
      }
      *(uint4*)(Ks + (tid >> 2) * 104 + 64 + (tid & 3) * 8) = rp;
      __syncthreads();
      if (kt + 1 < 36) ATT_GLOAD(kt + 1);
      f32x16 s[2];
#pragma unroll
      for (int t2 = 0; t2 < 2; ++t2) {
#pragma unroll
        for (int i = 0; i < 16; ++i) s[t2][i] = 0.f;
#pragma unroll
        for (int kk = 0; kk < 6; ++kk) {
          const bf16x8 a = *(const bf16x8*)(Ks + (32 * t2 + r) * 104 + 16 * kk + 8 * hh);
          s[t2] = __builtin_amdgcn_mfma_f32_32x32x16_bf16(a, qf[kk], s[t2], 0, 0, 0);
        }
      }
      float mx = s[0][0];
#pragma unroll
      for (int i = 1; i < 16; ++i) mx = fmaxf(mx, s[0][i]);
#pragma unroll
      for (int i = 0; i < 16; ++i) mx = fmaxf(mx, s[1][i]);
      mx = fmaxf(mx, __shfl_xor(mx, 32));
      const float mnew = fmaxf(mrun, mx * cs);
      const float alpha = __builtin_amdgcn_exp2f(mrun - mnew);
      mrun = mnew;
      float psum = 0.f;
      bf16x8 pf[4];
#pragma unroll
      for (int t2 = 0; t2 < 2; ++t2)
#pragma unroll
        for (int hf = 0; hf < 2; ++hf) {
          union { unsigned u[4]; bf16x8 v; } cvp;
#pragma unroll
          for (int i = 0; i < 4; ++i) {
            const float p0 = __builtin_amdgcn_exp2f(s[t2][hf * 8 + 2 * i] * cs - mnew);
            const float p1 = __builtin_amdgcn_exp2f(s[t2][hf * 8 + 2 * i + 1] * cs - mnew);
            psum += p0 + p1;
            cvp.u[i] = pack2(p0, p1);
          }
          pf[t2 * 2 + hf] = cvp.v;
        }
      lrun = lrun * alpha + psum;
#pragma unroll
      for (int i = 0; i < 16; ++i) { oacc[0][i] *= alpha; oacc[1][i] *= alpha; }
#pragma unroll
      for (int dt = 0; dt < 2; ++dt)
#pragma unroll
        for (int s4 = 0; s4 < 4; ++s4) {
          const bf16_t* vp = Vs + (32 * dt + r) * 68 + 16 * s4 + 4 * hh;
          const uint2 lo = *(const uint2*)vp, hi = *(const uint2*)(vp + 8);
          union { uint4 u; bf16x8 v; } cv; cv.u.x = lo.x; cv.u.y = lo.y; cv.u.z = hi.x; cv.u.w = hi.y;
          oacc[dt] = __builtin_amdgcn_mfma_f32_32x32x16_bf16(cv.v, pf[s4], oacc[dt], 0, 0, 0);
        }
    }
    const float ltot = lrun + __shfl_xor(lrun, 32);
    const float inv = 1.f / ltot;
    bf16_t* op = p.hxc + xrow * 1024 + h * 64;
#pragma unroll
    for (int dt = 0; dt < 2; ++dt)
#pragma unroll
      for (int i4 = 0; i4 < 4; ++i4) {
        const int d = 32 * dt + 8 * i4 + 4 * hh;
        uint2 u; u.x = pack2(oacc[dt][4 * i4] * inv, oacc[dt][4 * i4 + 1] * inv); u.y = pack2(oacc[dt][4 * i4 + 2] * inv, oacc[dt][4 * i4 + 3] * inv);
        *(uint2*)(op + d) = u;
      }
  }
}

__device__ __forceinline__ void phase_hyconv(CP& p, char* smem) {
  bf16_t* cp = (bf16_t*)smem;
  bf16_t* Vl = (bf16_t*)(smem + 4 * 8256);
  const int tid = get_tid(), lane = tid & 63, w = tid >> 6, i16 = lane & 15, g4 = lane >> 4;
  const int si = (-i16) & 3;
  const int ocb = 64 * w;
  for (int c = get_bid(); c < 1024; c += VGRID) {
    __syncthreads();
#pragma unroll
    for (int i = 0; i < 2; ++i) { const int ch = tid + 256 * i; *(uint4*)(cp + ch * 8) = *(const uint4*)(p.Rf + (size_t)c * 4096 + ch * 8); }
#pragma unroll
    for (int i = 0; i < 8; ++i) {
      const int q = tid + 256 * i; const int b = q >> 8, l8 = q & 255; const int m1 = l8 >> 3, m2 = (l8 & 7) * 8;
      *(uint4*)(Vl + (8 + m1 * 8 + b) * 80 + m2) = *(const uint4*)(p.vvT + (size_t)c * 16384 + b * 2048 + l8 * 8);
    }
    if (tid < 144) {
      const int colp = tid / 9, part = tid - colp * 9;
      const int col = colp < 8 ? colp : 256 + colp;
      uint4 zz; zz.x = 0; zz.y = 0; zz.z = 0; zz.w = 0;
      *(uint4*)(Vl + col * 80 + part * 8) = zz;
    }
    __syncthreads();
#pragma unroll
    for (int s = 1; s < 4; ++s)
#pragma unroll
      for (int i = 0; i < 2; ++i) {
        const int ch = tid + 256 * i;
        unsigned e[8];
#pragma unroll
        for (int j = 0; j < 8; ++j) { const int idx = 8 * ch + s + j; e[j] = idx < 4096 ? (unsigned)cp[idx] : 0u; }
        uint4 u; u.x = e[0] | (e[1] << 16); u.y = e[2] | (e[3] << 16); u.z = e[4] | (e[5] << 16); u.w = e[6] | (e[7] << 16);
        *(uint4*)(cp + s * 4128 + 8 * ch) = u;
      }
    __syncthreads();
    const bf16_t* abase = cp + si * 4128 + (2048 - i16 - si + 8 * g4);
    f32x4 acc[4][4];
#pragma unroll
    for (int m = 0; m < 4; ++m)
#pragma unroll
      for (int n = 0; n < 4; ++n) acc[m][n] = (f32x4){0.f, 0.f, 0.f, 0.f};
    for (int dl = -31; dl <= 31; ++dl) {
      bf16x8 af[4][2];
#pragma unroll
      for (int mt = 0; mt < 4; ++mt)
#pragma unroll
        for (int kk = 0; kk < 2; ++kk) {
          const bf16_t* ap = abase - 64 * dl - 16 * mt + 32 * kk;
          const uint2 lo = *(const uint2*)ap, hi = *(const uint2*)(ap + 4);
          union { uint4 u; bf16x8 v; } cv; cv.u.x = lo.x; cv.u.y = lo.y; cv.u.z = hi.x; cv.u.w = hi.y;
          af[mt][kk] = cv.v;
        }
#pragma unroll
      for (int jt = 0; jt < 4; ++jt) {
        const int in0 = ocb + 16 * jt - 8 * dl;
        if (in0 >= -8 && in0 <= 248) {
          const bf16_t* bp = Vl + (in0 + 8 + i16) * 80 + 8 * g4;
          const bf16x8 b0 = *(const bf16x8*)bp, b1 = *(const bf16x8*)(bp + 32);
#pragma unroll
          for (int mt = 0; mt < 4; ++mt) {
            acc[mt][jt] = __builtin_amdgcn_mfma_f32_16x16x32_bf16(af[mt][0], b0, acc[mt][jt], 0, 0, 0);
            acc[mt][jt] = __builtin_amdgcn_mfma_f32_16x16x32_bf16(af[mt][1], b1, acc[mt][jt], 0, 0, 0);
          }
        }
      }
    }
    const float db = p.hy_d_bias[c];
#pragma unroll
    for (int mt = 0; mt < 4; ++mt)
#pragma unroll
      for (int jt = 0; jt < 4; ++jt) {
        const int col = ocb + 16 * jt + i16;
        const int n1 = col >> 3, b = col & 7;
        const int n2 = 16 * mt + 4 * g4;
        const uint2 vv = *(const uint2*)(Vl + (col + 8) * 80 + n2);
        const float y0 = acc[mt][jt][0] + bf2f((bf16_t)(vv.x & 0xffff)) * db;
        const float y1 = acc[mt][jt][1] + bf2f((bf16_t)(vv.x >> 16)) * db;
        const float y2 = acc[mt][jt][2] + bf2f((bf16_t)(vv.y & 0xffff)) * db;
        const float y3 = acc[mt][jt][3] + bf2f((bf16_t)(vv.y >> 16)) * db;
        uint2 u; u.x = pack2(y0, y1); u.y = pack2(y2, y3);
        *(uint2*)(p.Yp + (size_t)c * 16384 + b * 2048 + n1 * 64 + n2) = u;
      }
  }
}

__device__ __forceinline__ void phase_transmul(CP& p, char* smem) {
  bf16_t* tl = (bf16_t*)smem;
  const int tid = get_tid();
  for (int it = get_bid(); it < 4096; it += VGRID) {
    const int ct = it & 15, rt = it >> 4;
    const int c0 = ct * 64, r0 = rt * 64;
    __syncthreads();
#pragma unroll
    for (int i = 0; i < 2; ++i) {
      const int ci = tid + 256 * i; const int cc = ci >> 3, ch = ci & 7;
      const uint4 u = *(const uint4*)(p.Yp + (size_t)(c0 + cc) * 16384 + r0 + ch * 8);
      unsigned* d = (unsigned*)(tl + cc * 66 + ch * 8);
      d[0] = u.x; d[1] = u.y; d[2] = u.z; d[3] = u.w;
    }
    __syncthreads();
    const int row = tid >> 2, cq = tid & 3;
    const bf16_t* xp = p.x1h + (size_t)(r0 + row) * 1024 + c0 + cq * 16;
    const uint4 xa = *(const uint4*)xp, xb = *(const uint4*)(xp + 8);
    const unsigned xs[8] = {xa.x, xa.y, xa.z, xa.w, xb.x, xb.y, xb.z, xb.w};
    unsigned o[8];
#pragma unroll
    for (int j = 0; j < 8; ++j) {
      const float y0 = bf2f(tl[(cq * 16 + 2 * j) * 66 + row]) * bf2f((bf16_t)(xs[j] & 0xffff));
      const float y1 = bf2f(tl[(cq * 16 + 2 * j + 1) * 66 + row]) * bf2f((bf16_t)(xs[j] >> 16));
      o[j] = pack2(y0, y1);
    }
    bf16_t* op = p.hxc + (size_t)(r0 + row) * 1024 + c0 + cq * 16;
    uint4 oa; oa.x = o[0]; oa.y = o[1]; oa.z = o[2]; oa.w = o[3];
    uint4 ob; ob.x = o[4]; ob.y = o[5]; ob.z = o[6]; ob.w = o[7];
    *(uint4*)op = oa; *(uint4*)(op + 8) = ob;
  }
}

__global__ void __launch_bounds__(512, 2) mega(P p_arg) {
  __shared__ __attribute__((aligned(16))) char smem[LDS_BYTES];
  cg::grid_group grid = cg::this_grid();
  const int G = gridDim.x;
  CP* pp = (CP*)__builtin_amdgcn_kernarg_segment_ptr();
  const int ph0 = pp->ph0, ph1 = pp->ph1;
  volatile LAS unsigned* xst = (volatile LAS unsigned*)(smem + LDS_BYTES - 16);
  if (threadIdx.x == 0) { xst[0] = 0u; xst[1] = 0u; }
  __syncthreads();
  const XcdBarrier xb = xcd_barrier_post(pp->bar, xst);
  if (ph0 <= 0 && 0 < ph1) {
    asm volatile("" : "+s"(pp));
    CP& p = *pp;
    const int bid = get_rbid();
    const int vid0 = (G & 7) ? bid : ((bid & 7) * (G >> 3) + (bid >> 3));
    const int hb = get_hb();
    char* smem_h = smem + hb * HALF_LDS; (void)smem_h;
    const float* mv0 = p.modv; const float* mv1 = p.modv + (size_t)9 * 6144;
    (void)mv0; (void)mv1; (void)vid0;
    phase_prep(p, smem_h);
    if (0 + 1 < ph1) { if (ph1 > 1000) grid.sync(); else xcd_barrier(xb); }
  }
  if (ph0 <= 1 && 1 < ph1) {
    asm volatile("" : "+s"(pp));
    CP& p = *pp;
    const int bid = get_rbid();
    const int vid0 = (G & 7) ? bid : ((bid & 7) * (G >> 3) + (bid >> 3));
    const int hb = get_hb();
    char* smem_h = smem + hb * HALF_LDS; (void)smem_h;
    const float* mv0 = p.modv; const float* mv1 = p.modv + (size_t)9 * 6144;
    (void)mv0; (void)mv1; (void)vid0;
    phase_normmod_kv(p);
    if (1 + 1 < ph1) { if (ph1 > 1000) grid.sync(); else xcd_barrier(xb); }
  }
  if (ph0 <= 2 && 2 < ph1) {
    asm volatile("" : "+s"(pp));
    CP& p = *pp;
    const int bid = get_rbid();
    const int vid0 = (G & 7) ? bid : ((bid & 7) * (G >> 3) + (bid >> 3));
    const int hb = get_hb();
    char* smem_h = smem + hb * HALF_LDS; (void)smem_h;
    const float* mv0 = p.modv; const float* mv1 = p.modv + (size_t)9 * 6144;
    (void)mv0; (void)mv1; (void)vid0;
    {
        EpiStore e1{p.cq, 512, 2048, nullptr};
        gemm_job<true>(smem, p.hxc, 1024, p.wt_dq, 1024, 512, 16, 2304, 256, 128, 0, 2048, 128, 0, vid0, G, e1);
        EpiStore e2{p.kv, 288, 2304, nullptr};
        gemm_job<true>(smem, p.hxc, 1024, p.wt_dkv, 1024, 288, 18, 2304, 0, 128, 0, 2304, 144, 64 * 2, vid0, G, e2);
        EpiFilt e3{p.Rf, p.hy_decay};
        gemm_job<false>(smem, p.h2bf, 64, p.wt_f3, 64, 2048, 16, 0, 0, 128, 0, 2048, 16, 64 * 2 + 72 * 2, vid0, G, e3);
      }
    if (2 + 1 < ph1) { if (ph1 > 1000) grid.sync(); else xcd_barrier(xb); }
  }
  if (ph0 <= 3 && 3 < ph1) {
    asm volatile("" : "+s"(pp));
    CP& p = *pp;
    const int bid = get_rbid();
    const int vid0 = (G & 7) ? bid : ((bid & 7) * (G >> 3) + (bid >> 3));
    const int hb = get_hb();
    char* smem_h = smem + hb * HALF_LDS; (void)smem_h;
    const float* mv0 = p.modv; const float* mv1 = p.modv + (size_t)9 * 6144;
    (void)mv0; (void)mv1; (void)vid0;
    phase_rowstat(p);
    if (3 + 1 < ph1) { if (ph1 > 1000) grid.sync(); else xcd_barrier(xb); }
  }
  if (ph0 <= 4 && 4 < ph1) {
    asm volatile("" : "+s"(pp));
    CP& p = *pp;
    const int bid = get_rbid();
    const int vid0 = (G & 7) ? bid : ((bid & 7) * (G >> 3) + (bid >> 3));
    const int hb = get_hb();
    char* smem_h = smem + hb * HALF_LDS; (void)smem_h;
    const float* mv0 = p.modv; const float* mv1 = p.modv + (size_t)9 * 6144;
    (void)mv0; (void)mv1; (void)vid0;
    {
        EpiStore e1{p.Q, 1536, 2048, p.rq};
        gemm_job<true>(smem, p.cq, 512, p.wt_uq, 512, 1536, 16, 2048, 0, 128, 0, 2048, 128, 0, vid0, G, e1);
        EpiStore e2{p.Kn, 1024, 2304, p.rkv};
        gemm_job<true>(smem, p.kv, 288, p.wt_uk, 256, 1024, 18, 2304, 0, 128, 0, 2304, 144, 64 * 6, vid0, G, e2);
        EpiVt e3{p.Vt, p.rkv};
        gemm_job<false>(smem, p.kv, 288, p.wt_uv, 256, 1024, 18, 2304, 0, 128, 0, 2304, 144, 64 * 6 + 72 * 4, vid0, G, e3);
      }
    if (4 + 1 < ph1) { if (ph1 > 1000) grid.sync(); else xcd_barrier(xb); }
  }
  if (ph0 <= 5 && 5 < ph1) {
    asm volatile("" : "+s"(pp));
    CP& p = *pp;
    const int bid = get_rbid();
    const int vid0 = (G & 7) ? bid : ((bid & 7) * (G >> 3) + (bid >> 3));
    const int hb = get_hb();
    char* smem_h = smem + hb * HALF_LDS; (void)smem_h;
    const float* mv0 = p.modv; const float* mv1 = p.modv + (size_t)9 * 6144;
    (void)mv0; (void)mv1; (void)vid0;
    phase_attn(p, smem_h, 2 * vid0 + hb, 2 * G);
    if (5 + 1 < ph1) { if (ph1 > 1000) grid.sync(); else xcd_barrier(xb); }
  }
  if (ph0 <= 6 && 6 < ph1) {
    asm volatile("" : "+s"(pp));
    CP& p = *pp;
    const int bid = get_rbid();
    const int vid0 = (G & 7) ? bid : ((bid & 7) * (G >> 3) + (bid >> 3));
    const int hb = get_hb();
    char* smem_h = smem + hb * HALF_LDS; (void)smem_h;
    const float* mv0 = p.modv; const float* mv1 = p.modv + (size_t)9 * 6144;
    (void)mv0; (void)mv1; (void)vid0;
    {
        EpiResid e{p.X, p.x, mv0 + 2 * 1024, nullptr};
        gemm_job<true>(smem, p.hxc, 1024, p.wt_o, 1024, 1024, 16, 2048, 0, 128, 0, 2048, 128, 0, vid0, G, e);
      }
    if (6 + 1 < ph1) { if (ph1 > 1000) grid.sync(); else xcd_barrier(xb); }
  }
  if (ph0 <= 7 && 7 < ph1) {
    asm volatile("" : "+s"(pp));
    CP& p = *pp;
    const int bid = get_rbid();
    const int vid0 = (G & 7) ? bid : ((bid & 7) * (G >> 3) + (bid >> 3));
    const int hb = get_hb();
    char* smem_h = smem + hb * HALF_LDS; (void)smem_h;
    const float* mv0 = p.modv; const float* mv1 = p.modv + (size_t)9 * 6144;
    (void)mv0; (void)mv1; (void)vid0;
    phase_normmod_x(p, p.norm_ffn_g, 0, 3);
    if (7 + 1 < ph1) { if (ph1 > 1000) grid.sync(); else xcd_barrier(xb); }
  }
  if (ph0 <= 8 && 8 < ph1) {
    asm volatile("" : "+s"(pp));
    CP& p = *pp;
    const int bid = get_rbid();
    const int vid0 = (G & 7) ? bid : ((bid & 7) * (G >> 3) + (bid >> 3));
    const int hb = get_hb();
    char* smem_h = smem + hb * HALF_LDS; (void)smem_h;
    const float* mv0 = p.modv; const float* mv1 = p.modv + (size_t)9 * 6144;
    (void)mv0; (void)mv1; (void)vid0;
    {
        EpiConv<0> e{p.ffn_conv_w, p.ffn_conv_b, 5632, nullptr, p.act, nullptr};
        gemm_job<true>(smem, p.hxc, 1024, p.wt_up0, 1024, 5632, 17, 2048, 0, 126, 1, 2048, 136, 0, vid0, G, e);
      }
    if (8 + 1 < ph1) { if (ph1 > 1000) grid.sync(); else xcd_barrier(xb); }
  }
  if (ph0 <= 9 && 9 < ph1) {
    asm volatile("" : "+s"(pp));
    CP& p = *pp;
    const int bid = get_rbid();
    const int vid0 = (G & 7) ? bid : ((bid & 7) * (G >> 3) + (bid >> 3));
    const int hb = get_hb();
    char* smem_h = smem + hb * HALF_LDS; (void)smem_h;
    const float* mv0 = p.modv; const float* mv1 = p.modv + (size_t)9 * 6144;
    (void)mv0; (void)mv1; (void)vid0;
    {
        EpiResid e{p.X, p.X, mv0 + 5 * 1024, nullptr};
        gemm_job<true>(smem, p.act, 2816, p.wt_dn0, 2816, 1024, 16, 2048, 0, 128, 0, 2048, 128, 0, vid0, G, e);
      }
    if (9 + 1 < ph1) { if (ph1 > 1000) grid.sync(); else xcd_barrier(xb); }
  }
  if (ph0 <= 10 && 10 < ph1) {
    asm volatile("" : "+s"(pp));
    CP& p = *pp;
    const int bid = get_rbid();
    const int vid0 = (G & 7) ? bid : ((bid & 7) * (G >> 3) + (bid >> 3));
    const int hb = get_hb();
    char* smem_h = smem + hb * HALF_LDS; (void)smem_h;
    const float* mv0 = p.modv; const float* mv1 = p.modv + (size_t)9 * 6144;
    (void)mv0; (void)mv1; (void)vid0;
    phase_normmod_x(p, p.norm_mix_g + 1024, 1, 0);
    if (10 + 1 < ph1) { if (ph1 > 1000) grid.sync(); else xcd_barrier(xb); }
  }
  if (ph0 <= 11 && 11 < ph1) {
    asm volatile("" : "+s"(pp));
    CP& p = *pp;
    const int bid = get_rbid();
    const int vid0 = (G & 7) ? bid : ((bid & 7) * (G >> 3) + (bid >> 3));
    const int hb = get_hb();
    char* smem_h = smem + hb * HALF_LDS; (void)smem_h;
    const float* mv0 = p.modv; const float* mv1 = p.modv + (size_t)9 * 6144;
    (void)mv0; (void)mv1; (void)vid0;
    {
        EpiConv<1> e{p.hy_conv_w, p.hy_conv_b, 3072, p.hy_b_in, p.x1h, p.vvT};
        gemm_job<true>(smem, p.hxc, 1024, p.wt_hin, 1024, 3072, 17, 2048, 0, 126, 1, 2048, 136, 0, vid0, G, e);
      }
    if (11 + 1 < ph1) { if (ph1 > 1000) grid.sync(); else xcd_barrier(xb); }
  }
  if (ph0 <= 12 && 12 < ph1) {
    asm volatile("" : "+s"(pp));
    CP& p = *pp;
    const int bid = get_rbid();
    const int vid0 = (G & 7) ? bid : ((bid & 7) * (G >> 3) + (bid >> 3));
    const int hb = get_hb();
    char* smem_h = smem + hb * HALF_LDS; (void)smem_h;
    const float* mv0 = p.modv; const float* mv1 = p.modv + (size_t)9 * 6144;
    (void)mv0; (void)mv1; (void)vid0;
    phase_hyconv(p, smem_h);
    if (12 + 1 < ph1) { if (ph1 > 1000) grid.sync(); else xcd_barrier(xb); }
  }
  if (ph0 <= 13 && 13 < ph1) {
    asm volatile("" : "+s"(pp));
    CP& p = *pp;
    const int bid = get_rbid();
    const int vid0 = (G & 7) ? bid : ((bid & 7) * (G >> 3) + (bid >> 3));
    const int hb = get_hb();
    char* smem_h = smem + hb * HALF_LDS; (void)smem_h;
    const float* mv0 = p.modv; const float* mv1 = p.modv + (size_t)9 * 6144;
    (void)mv0; (void)mv1; (void)vid0;
    phase_transmul(p, smem_h);
    if (13 + 1 < ph1) { if (ph1 > 1000) grid.sync(); else xcd_barrier(xb); }
  }
  if (ph0 <= 14 && 14 < ph1) {
    asm volatile("" : "+s"(pp));
    CP& p = *pp;
    const int bid = get_rbid();
    const int vid0 = (G & 7) ? bid : ((bid & 7) * (G >> 3) + (bid >> 3));
    const int hb = get_hb();
    char* smem_h = smem + hb * HALF_LDS; (void)smem_h;
    const float* mv0 = p.modv; const float* mv1 = p.modv + (size_t)9 * 6144;
    (void)mv0; (void)mv1; (void)vid0;
    {
        EpiResid e{p.X, p.X, mv1 + 2 * 1024, p.hy_b_out};
        gemm_job<true>(smem, p.hxc, 1024, p.wt_hout, 1024, 1024, 16, 2048, 0, 128, 0, 2048, 128, 0, vid0, G, e);
      }
    if (14 + 1 < ph1) { if (ph1 > 1000) grid.sync(); else xcd_barrier(xb); }
  }
  if (ph0 <= 15 && 15 < ph1) {
    asm volatile("" : "+s"(pp));
    CP& p = *pp;
    const int bid = get_rbid();
    const int vid0 = (G & 7) ? bid : ((bid & 7) * (G >> 3) + (bid >> 3));
    const int hb = get_hb();
    char* smem_h = smem + hb * HALF_LDS; (void)smem_h;
    const float* mv0 = p.modv; const float* mv1 = p.modv + (size_t)9 * 6144;
    (void)mv0; (void)mv1; (void)vid0;
    phase_normmod_x(p, p.norm_ffn_g + 1024, 1, 3);
    if (15 + 1 < ph1) { if (ph1 > 1000) grid.sync(); else xcd_barrier(xb); }
  }
  if (ph0 <= 16 && 16 < ph1) {
    asm volatile("" : "+s"(pp));
    CP& p = *pp;
    const int bid = get_rbid();
    const int vid0 = (G & 7) ? bid : ((bid & 7) * (G >> 3) + (bid >> 3));
    const int hb = get_hb();
    char* smem_h = smem + hb * HALF_LDS; (void)smem_h;
    const float* mv0 = p.modv; const float* mv1 = p.modv + (size_t)9 * 6144;
    (void)mv0; (void)mv1; (void)vid0;
    {
        EpiConv<0> e{p.ffn_conv_w + (size_t)3 * 5632, p.ffn_conv_b + 5632, 5632, nullptr, p.act, nullptr};
        gemm_job<true>(smem, p.hxc, 1024, p.wt_up1, 1024, 5632, 17, 2048, 0, 126, 1, 2048, 136, 0, vid0, G, e);
      }
    if (16 + 1 < ph1) { if (ph1 > 1000) grid.sync(); else xcd_barrier(xb); }
  }
  if (ph0 <= 17 && 17 < ph1) {
    asm volatile("" : "+s"(pp));
    CP& p = *pp;
    const int bid = get_rbid();
    const int vid0 = (G & 7) ? bid : ((bid & 7) * (G >> 3) + (bid >> 3));
    const int hb = get_hb();
    char* smem_h = smem + hb * HALF_LDS; (void)smem_h;
    const float* mv0 = p.modv; const float* mv1 = p.modv + (size_t)9 * 6144;
    (void)mv0; (void)mv1; (void)vid0;
    {
        EpiResid e{p.X, p.X, mv1 + 5 * 1024, nullptr};
        gemm_job<true>(smem, p.act, 2816, p.wt_dn1, 2816, 1024, 16, 2048, 0, 128, 0, 2048, 128, 0, vid0, G, e);
      }
    if (17 + 1 < ph1) { if (ph1 > 1000) grid.sync(); else xcd_barrier(xb); }
  }
  if (ph0 <= 18 && 18 < ph1) {
    asm volatile("" : "+s"(pp));
    CP& p = *pp;
    const int bid = get_rbid();
    const int vid0 = (G & 7) ? bid : ((bid & 7) * (G >> 3) + (bid >> 3));
    const int hb = get_hb();
    char* smem_h = smem + hb * HALF_LDS; (void)smem_h;
    const float* mv0 = p.modv; const float* mv1 = p.modv + (size_t)9 * 6144;
    (void)mv0; (void)mv1; (void)vid0;
    phase_final_norm(p);
    if (18 + 1 < ph1) { if (ph1 > 1000) grid.sync(); else xcd_barrier(xb); }
  }
}

extern "C" void kernel_launch(void* const* d_in, const int* in_sizes, int n_in, void* d_out, int out_size, void* d_ws, size_t ws_size, hipStream_t stream) {
  static int grid_blocks = 0;
  if (!grid_blocks) {
    int dev = 0, cus = 0, per_cu = 0;
    hipGetDevice(&dev);
    hipDeviceGetAttribute(&cus, hipDeviceAttributeMultiprocessorCount, dev);
    hipOccupancyMaxActiveBlocksPerMultiprocessor(&per_cu, (const void*)mega, 512, 0);
    per_cu = 1;
    grid_blocks = cus * per_cu;
  }
  P p{};
  const float** in = (const float**)&p;
  for (int i = 0; i < 36; ++i) in[i] = (const float*)d_in[i];
  p.X = (float*)d_out;
  char* ws = (char*)d_ws; size_t off = 0;
  auto take = [&](size_t bytes) { char* r = ws + off; off += (bytes + 255) & ~(size_t)255; return r; };
  p.wt_dq = (bf16_t*)take((size_t)512 * 1024 * 2);
  p.wt_dkv = (bf16_t*)take((size_t)288 * 1024 * 2);
  p.wt_uq = (bf16_t*)take((size_t)1536 * 512 * 2);
  p.wt_uk = (bf16_t*)take((size_t)1024 * 256 * 2);
  p.wt_uv = (bf16_t*)take((size_t)1024 * 256 * 2);
  p.wt_o = (bf16_t*)take((size_t)1024 * 1024 * 2);
  p.wt_hin = (bf16_t*)take((size_t)3072 * 1024 * 2);
  p.wt_hout = (bf16_t*)take((size_t)1024 * 1024 * 2);
  p.wt_up0 = (bf16_t*)take((size_t)5632 * 1024 * 2);
  p.wt_up1 = (bf16_t*)take((size_t)5632 * 1024 * 2);
  p.wt_dn0 = (bf16_t*)take((size_t)1024 * 2816 * 2);
  p.wt_dn1 = (bf16_t*)take((size_t)1024 * 2816 * 2);
  p.modv = (float*)take((size_t)2 * 9 * 6144 * 4);
  p.rq = (float*)take((size_t)16384 * 4);
  p.rkv = (float*)take((size_t)18432 * 4);
  p.modp = (float*)take((size_t)4 * 110592 * 4);
  p.bar = (unsigned*)take((size_t)XCD_BAR_WORDS * 4);
  p.wt_f3 = (bf16_t*)take((size_t)2048 * 64 * 2);
  p.h2bf = (bf16_t*)take((size_t)2048 * 64 * 2);
  p.Rf = (bf16_t*)take((size_t)1024 * 4096 * 2);
  p.kpe = (bf16_t*)take((size_t)18432 * 32 * 2);
  p.hxc = (bf16_t*)take((size_t)18432 * 1024 * 2);
  const size_t ubase = off;
  p.cq = (bf16_t*)take((size_t)16384 * 512 * 2);
  p.kv = (bf16_t*)take((size_t)18432 * 288 * 2);
  p.Q = (bf16_t*)take((size_t)16384 * 1536 * 2);
  p.Kn = (bf16_t*)take((size_t)18432 * 1024 * 2);
  p.Vt = (bf16_t*)take((size_t)18432 * 1024 * 2);
  const size_t uend1 = off;
  off = ubase;
  p.act = (bf16_t*)take((size_t)16384 * 2816 * 2);
  off = ubase;
  p.x1h = (bf16_t*)take((size_t)16384 * 1024 * 2);
  p.vvT = (bf16_t*)take((size_t)16384 * 1024 * 2);
  p.Yp = (bf16_t*)take((size_t)16384 * 1024 * 2);
  if (uend1 > ws_size) { fprintf(stderr, "workspace too small: need %zu have %zu\n", uend1, ws_size); return; }
  p.ph0 = 0; p.ph1 = NPHASE;
  if (hipMemsetAsync(p.bar, 0, (size_t)XCD_BAR_WORDS * 4, stream) != hipSuccess) { fprintf(stderr, "memset failed\n"); return; }
  void* args[] = {&p};
  hipError_t e = hipLaunchCooperativeKernel((const void*)mega, dim3(grid_blocks), dim3(512), args, 0, stream);
  if (e != hipSuccess) fprintf(stderr, "cooperative launch failed: %s (grid %d)\n", hipGetErrorString(e), grid_blocks);
}
```

```cpp
#include <hip/hip_runtime.h>
#include <hip/hip_cooperative_groups.h>
#include <cstdio>
namespace cg = cooperative_groups;

typedef unsigned short bf16_t;
typedef short bf16x8 __attribute__((ext_vector_type(8)));
typedef float f32x4 __attribute__((ext_vector_type(4)));
typedef float f32x16 __attribute__((ext_vector_type(16)));

#define LDS_BYTES 163840
#define HALF_LDS 81920
#define NPHASE 19

struct P {
  const float *x, *c, *ctx, *c_ctx, *mod_w, *mod_b, *norm_mix_g, *norm_ffn_g;
  const float *w_dq, *g_q, *w_uq, *w_dkv, *g_kv, *w_uk, *w_uv, *w_o;
  const float *hy_w_in, *hy_b_in, *hy_conv_w, *hy_conv_b, *f_w1, *f_b1, *f_freq1, *f_w2, *f_b2, *f_freq2, *f_w3, *hy_decay, *hy_d_bias, *hy_w_out, *hy_b_out;
  const float *ffn_w_up, *ffn_conv_w, *ffn_conv_b, *ffn_w_down, *final_g;
  float* X;
  bf16_t *wt_dq, *wt_dkv, *wt_uq, *wt_uk, *wt_uv, *wt_o, *wt_hin, *wt_hout, *wt_up0, *wt_up1, *wt_dn0, *wt_dn1;
  float *modv, *rq, *rkv, *modp;
  unsigned* bar;
  bf16_t *wt_f3, *h2bf;
  bf16_t *Rf, *kpe, *hxc, *cq, *kv, *Q, *Kn, *Vt, *act, *x1h, *vvT, *Yp;
  int ph0, ph1;
};

typedef const __attribute__((address_space(4))) P CP;
__device__ __forceinline__ int get_tid512() { int t = threadIdx.x; asm volatile("" : "+v"(t)); return t; }
__device__ __forceinline__ int get_tid() { int t = threadIdx.x & 255; asm volatile("" : "+v"(t)); return t; }
__device__ __forceinline__ int get_hb() { int t = __builtin_amdgcn_readfirstlane((int)(threadIdx.x >> 8)); asm volatile("" : "+s"(t)); return t; }
__device__ __forceinline__ int get_rbid() { int t = blockIdx.x; asm volatile("" : "+s"(t)); return t; }
__device__ __forceinline__ int get_bid() { return 2 * get_rbid() + get_hb(); }
#define VGRID (2 * (int)gridDim.x)

__device__ __forceinline__ unsigned pack2(float a, float b) { unsigned r; asm("v_cvt_pk_bf16_f32 %0, %1, %2" : "=v"(r) : "v"(a), "v"(b)); return r; }
__device__ __forceinline__ bf16_t f2bf(float f) { return (bf16_t)(pack2(f, f) & 0xffffu); }
__device__ __forceinline__ float bf2f(bf16_t h) { return __uint_as_float(((unsigned)h) << 16); }
__device__ __forceinline__ float wave_sum(float v) {
#pragma unroll
  for (int o = 32; o; o >>= 1) v += __shfl_xor(v, o);
  return v;
}


#define XB_TMO      128
#define XB_XCNT(j)  (256  + 64 * (j))
#define XB_XSUB(j)  (1280 + 64 * (j))
#define XB_XGEN(j)  (2304 + 64 * (j))
#define XB_TOP      3328
#define XB_TOPGEN   3392
#define XCD_BAR_WORDS 3456
#define XB_SPIN_CAP (1u << 18)
#define LAS __attribute__((address_space(3)))
__device__ __forceinline__ unsigned xb_ld(unsigned* p)              { return __hip_atomic_load(p, __ATOMIC_RELAXED, __HIP_MEMORY_SCOPE_AGENT); }
__device__ __forceinline__ unsigned xb_add(unsigned* p, unsigned v) { return __hip_atomic_fetch_add(p, v, __ATOMIC_RELAXED, __HIP_MEMORY_SCOPE_AGENT); }
__device__ __forceinline__ unsigned xb_xcc_id() { return (unsigned)__builtin_amdgcn_s_getreg((3 << 11) | 20) & 0xFu; }
#define XB_SPIN(cond, bar) do { unsigned _sp = 0; while (cond) { __builtin_amdgcn_s_sleep(1); \
    if ((++_sp & 255u) == 0u) { if (xb_ld(&(bar)[XB_TMO])) break; if (_sp > XB_SPIN_CAP) { atomicAdd(&(bar)[XB_TMO], 1u); break; } } } } while (0)
struct XcdBarrier { unsigned* bar; unsigned x; volatile LAS unsigned* st; };
__device__ __forceinline__ XcdBarrier xcd_barrier_post(unsigned* bar, volatile LAS unsigned* st) {
    XcdBarrier b; b.bar = bar; b.x = xb_xcc_id(); b.st = st;
    if (threadIdx.x == 0) (void)xb_add(&bar[XB_XCNT(b.x)], 1u);
    return b;
}
__device__ __forceinline__ void xcd_barrier_complete(unsigned* bar, unsigned x, unsigned& nloc, unsigned& nx) {
    const unsigned G = gridDim.x * gridDim.y * gridDim.z;
    unsigned sum, cnt, mine, sp = 0u;
    for (;;) {
        sum = 0u; cnt = 0u; mine = 0u;
#pragma unroll
        for (unsigned j = 0; j < 16; ++j) { const unsigned c = xb_ld(&bar[XB_XCNT(j)]); sum += c; cnt += (c > 0u) ? 1u : 0u; mine = (j == x) ? c : mine; }
        if (sum == G) break;
        __builtin_amdgcn_s_sleep(1);
        if ((++sp & 255u) == 0u) { if (xb_ld(&bar[XB_TMO])) break; if (sp > XB_SPIN_CAP) { atomicAdd(&bar[XB_TMO], 1u); break; } }
    }
    nloc = mine > 0u ? mine : 1u; nx = cnt > 0u ? cnt : 1u;
}
__device__ __forceinline__ void xcd_barrier(const XcdBarrier& b) {
    asm volatile("s_waitcnt vmcnt(0)" ::: "memory");
    __syncthreads();
    if (threadIdx.x == 0) {
        unsigned* bar = b.bar;
        __builtin_amdgcn_s_waitcnt(0);
        unsigned nloc = b.st[0], nx = b.st[1];
        if (nloc == 0u) { xcd_barrier_complete(bar, b.x, nloc, nx); b.st[0] = nloc; b.st[1] = nx; }
        const unsigned old = xb_add(&bar[XB_XSUB(b.x)], 1u);
        const unsigned gen = old / nloc;
        if (old + 1u == (gen + 1u) * nloc) {
            __builtin_amdgcn_fence(__ATOMIC_RELEASE, "agent");
            asm volatile("s_waitcnt vmcnt(0)" ::: "memory");
            const unsigned og = xb_add(&bar[XB_TOP], 1u);
            const unsigned tg = og / nx;
            if (og + 1u == (tg + 1u) * nx) xb_add(&bar[XB_TOPGEN], 1u);
            else XB_SPIN(xb_ld(&bar[XB_TOPGEN]) == tg, bar);
            __builtin_amdgcn_fence(__ATOMIC_ACQUIRE, "agent");
            xb_add(&bar[XB_XGEN(b.x)], 1u);
            asm volatile("s_waitcnt vmcnt(0)" ::: "memory");
        } else {
            XB_SPIN(xb_ld(&bar[XB_XGEN(b.x)]) == gen, bar);
            __builtin_amdgcn_fence(__ATOMIC_ACQUIRE, "agent");
            asm volatile("s_waitcnt vmcnt(0)" ::: "memory");
        }
    }
    __syncthreads();
}

__device__ __forceinline__ void prep_weight_tile(CP& p, char* smem, int wt) {
  const int tid = get_tid();
  int id = 0;
  {
    const int cnt[13] = {64, 40, 96, 32, 32, 128, 384, 128, 704, 704, 352, 352, 32};
#pragma unroll
    for (int i = 0; i < 12; ++i) { if (id == i && wt >= cnt[i]) { wt -= cnt[i]; id = i + 1; } }
  }
  const float* src; int K, N; bf16_t* dst; const float* scale = nullptr; int perm = 0;
  switch (id) {
    case 0: src = p.w_dq; K = 1024; N = 512; dst = p.wt_dq; break;
    case 1: src = p.w_dkv; K = 1024; N = 288; dst = p.wt_dkv; break;
    case 2: src = p.w_uq; K = 512; N = 1536; dst = p.wt_uq; scale = p.g_q; break;
    case 3: src = p.w_uk; K = 256; N = 1024; dst = p.wt_uk; scale = p.g_kv; break;
    case 4: src = p.w_uv; K = 256; N = 1024; dst = p.wt_uv; scale = p.g_kv; break;
    case 5: src = p.w_o; K = 1024; N = 1024; dst = p.wt_o; break;
    case 6: src = p.hy_w_in; K = 1024; N = 3072; dst = p.wt_hin; perm = 2; break;
    case 7: src = p.hy_w_out; K = 1024; N = 1024; dst = p.wt_hout; break;
    case 8: src = p.ffn_w_up; K = 1024; N = 5632; dst = p.wt_up0; perm = 1; break;
    case 9: src = p.ffn_w_up + (size_t)1024 * 5632; K = 1024; N = 5632; dst = p.wt_up1; perm = 1; break;
    case 10: src = p.ffn_w_down; K = 2816; N = 1024; dst = p.wt_dn0; break;
    case 11: src = p.ffn_w_down + (size_t)2816 * 1024; K = 2816; N = 1024; dst = p.wt_dn1; break;
    default: src = p.f_w3; K = 64; N = 2048; dst = p.wt_f3; break;
  }
  const int ntn = (N + 63) >> 6;
  const int kt = wt / ntn, nt = wt - kt * ntn;
  const int k0 = kt * 128, n0 = nt * 64;
  int np0;
  if (perm == 1) { const int half = n0 / 2816, f = n0 - half * 2816; np0 = (f >> 6) * 128 + half * 64; }
  else if (perm == 2) { if (n0 < 1024) np0 = n0; else { const int m = n0 - 1024, half = m >> 10, f = m & 1023; np0 = 1024 + (f >> 6) * 128 + half * 64; } }
  else np0 = n0;
  bf16_t* t16 = (bf16_t*)smem;
  f32x4 v[8];
#pragma unroll
  for (int i = 0; i < 8; ++i) {
    const int idx = tid + 256 * i; const int kr = idx >> 4, c4 = idx & 15;
    v[i] = (f32x4){0.f, 0.f, 0.f, 0.f};
    if (n0 + 4 * c4 < N && k0 + kr < K) v[i] = *(const f32x4*)(src + (size_t)(k0 + kr) * N + n0 + 4 * c4);
  }
#pragma unroll
  for (int i = 0; i < 8; ++i) {
    const int idx = tid + 256 * i; const int kr = idx >> 4, c4 = idx & 15;
    const float sc = (scale && k0 + kr < K) ? scale[k0 + kr] : 1.f;
#pragma unroll
    for (int j = 0; j < 4; ++j) t16[(4 * c4 + j) * 136 + kr] = f2bf(v[i][j] * sc);
  }
  __syncthreads();
#pragma unroll
  for (int i = 0; i < 4; ++i) {
    const int idx = tid + 256 * i; const int n = idx >> 4, ch = idx & 15;
    if (n0 + n < N && k0 + ch * 8 < K) *(uint4*)(dst + (size_t)(np0 + n) * K + k0 + ch * 8) = *(const uint4*)(t16 + n * 136 + ch * 8);
  }
  __syncthreads();
}

__device__ __forceinline__ void prep_modvec(CP& p, char* smem, int it) {
  const int tid = get_tid();
  const int layer = it / 384, rem = it - layer * 384, cb = rem >> 2, ks = rem & 3;
  float* s_lds = (float*)smem;
  float* red = (float*)(smem + 12288);
  const int kbase = ks * 256;
  for (int idx = tid; idx < 9 * 256; idx += 256) {
    const int r = idx >> 8, k = idx & 255;
    const float v = r < 8 ? p.c[r * 1024 + kbase + k] : p.c_ctx[kbase + k];
    s_lds[k * 12 + r] = v / (1.f + __expf(-v));
  }
  __syncthreads();
  const int col = cb * 64 + (tid & 63), kg = tid >> 6;
  const float* W = p.mod_w + (size_t)layer * 1024 * 6144 + (size_t)kbase * 6144 + col;
  float acc[9];
#pragma unroll
  for (int r = 0; r < 9; ++r) acc[r] = 0.f;
#pragma unroll
  for (int kb = 0; kb < 4; ++kb) {
    float w[16];
#pragma unroll
    for (int u = 0; u < 16; ++u) w[u] = W[(size_t)(kg * 64 + kb * 16 + u) * 6144];
#pragma unroll
    for (int u = 0; u < 16; ++u) {
      const int k = kg * 64 + kb * 16 + u;
      const f32x4 s0 = *(const f32x4*)(s_lds + k * 12), s1 = *(const f32x4*)(s_lds + k * 12 + 4);
      const float s2 = s_lds[k * 12 + 8];
      acc[0] += s0[0] * w[u]; acc[1] += s0[1] * w[u]; acc[2] += s0[2] * w[u]; acc[3] += s0[3] * w[u];
      acc[4] += s1[0] * w[u]; acc[5] += s1[1] * w[u]; acc[6] += s1[2] * w[u]; acc[7] += s1[3] * w[u];
      acc[8] += s2 * w[u];
    }
  }
#pragma unroll
  for (int r = 0; r < 9; ++r) red[(kg * 9 + r) * 64 + (tid & 63)] = acc[r];
  __syncthreads();
  for (int o = tid; o < 9 * 64; o += 256) {
    const int r = o >> 6, cl = o & 63;
    const float sm = red[(0 * 9 + r) * 64 + cl] + red[(1 * 9 + r) * 64 + cl] + red[(2 * 9 + r) * 64 + cl] + red[(3 * 9 + r) * 64 + cl];
    p.modp[(size_t)ks * 110592 + (size_t)(layer * 9 + r) * 6144 + cb * 64 + cl] = sm;
  }
  __syncthreads();
}

__device__ __forceinline__ void prep_filter(CP& p, char* smem, int it) {
  const int tid = get_tid();
  float* z = (float*)smem;
  float* h1 = z + 8 * 33;
  float* h2 = h1 + 8 * 64;
  const int t0 = it * 8;
  for (int idx = tid; idx < 8 * 33; idx += 256) {
    const int pp = idx / 33, i = idx - pp * 33;
    const int t = t0 + pp;
    float v;
    if (i == 0) v = (float)t * (1.0f / 2047.0f);
    else {
      const int k = (i - 1) & 15;
      const float w = (6.283185307179586f * (float)t) / 2048.0f;
      const float f = 1e-4f + (float)k * ((15.0f - 1e-4f) / 15.0f);
      const float a = w * f;
      v = (i <= 16) ? __cosf(a) : -__sinf(a);
    }
    z[idx] = v;
  }
  __syncthreads();
  for (int idx = tid; idx < 8 * 64; idx += 256) {
    const int pp = idx >> 6, j = idx & 63;
    float s = p.f_b1[j];
#pragma unroll
    for (int i = 0; i < 33; ++i) s += z[pp * 33 + i] * p.f_w1[i * 64 + j];
    h1[idx] = __sinf(p.f_freq1[j] * s);
  }
  __syncthreads();
  for (int idx = tid; idx < 8 * 64; idx += 256) {
    const int pp = idx >> 6, j = idx & 63;
    float s = p.f_b2[j];
#pragma unroll 16
    for (int i = 0; i < 64; ++i) s += h1[pp * 64 + i] * p.f_w2[i * 64 + j];
    h2[idx] = __sinf(p.f_freq2[j] * s);
  }
  __syncthreads();
  for (int idx = tid; idx < 8 * 64; idx += 256) p.h2bf[(size_t)t0 * 64 + idx] = f2bf(h2[idx]);
  __syncthreads();
}

__device__ __forceinline__ void phase_prep(CP& p, char* smem) {
  const int total = 768 + 256 + 3048;
  for (int it = get_bid(); it < total; it += VGRID) {
    if (it < 768) prep_modvec(p, smem, it);
    else if (it < 1024) prep_filter(p, smem, it - 768);
    else prep_weight_tile(p, smem, it - 1024);
  }
}

template <bool PART>
__device__ __forceinline__ void normmod_row2(const float* __restrict__ src, const float* __restrict__ g, const float* __restrict__ sh, const float* __restrict__ sc, bf16_t* __restrict__ dst, int lane, const float* __restrict__ bsh = nullptr) {
  f32x4 v[2][4]; float ss0 = 0.f, ss1 = 0.f;
#pragma unroll
  for (int i = 0; i < 4; ++i) { v[0][i] = *(const f32x4*)(src + lane * 4 + 256 * i); v[1][i] = *(const f32x4*)(src + 1024 + lane * 4 + 256 * i); }
#pragma unroll
  for (int i = 0; i < 4; ++i) {
    ss0 += v[0][i][0] * v[0][i][0] + v[0][i][1] * v[0][i][1] + v[0][i][2] * v[0][i][2] + v[0][i][3] * v[0][i][3];
    ss1 += v[1][i][0] * v[1][i][0] + v[1][i][1] * v[1][i][1] + v[1][i][2] * v[1][i][2] + v[1][i][3] * v[1][i][3];
  }
  ss0 = wave_sum(ss0); ss1 = wave_sum(ss1);
  const float r0 = rsqrtf(ss0 * (1.0f / 1024.0f) + 1e-6f), r1 = rsqrtf(ss1 * (1.0f / 1024.0f) + 1e-6f);
#pragma unroll
  for (int i = 0; i < 4; ++i) {
    const int k = lane * 4 + 256 * i;
    const f32x4 g4 = *(const f32x4*)(g + k);
    f32x4 s4 = *(const f32x4*)(sh + k), c4 = *(const f32x4*)(sc + k);
    if (PART) {
#pragma unroll
      for (int q = 1; q < 4; ++q) { s4 += *(const f32x4*)(sh + (size_t)q * 110592 + k); c4 += *(const f32x4*)(sc + (size_t)q * 110592 + k); }
      s4 += *(const f32x4*)(bsh + k); c4 += *(const f32x4*)(bsh + 1024 + k);
    }
    float y[4], z[4];
#pragma unroll
    for (int j = 0; j < 4; ++j) { const float gm = g4[j] * (1.f + c4[j]); y[j] = (v[0][i][j] * r0) * gm + s4[j]; z[j] = (v[1][i][j] * r1) * gm + s4[j]; }
    uint2 u; u.x = pack2(y[0], y[1]); u.y = pack2(y[2], y[3]);
    *(uint2*)(dst + k) = u;
    u.x = pack2(z[0], z[1]); u.y = pack2(z[2], z[3]);
    *(uint2*)(dst + 1024 + k) = u;
  }
}

__device__ __forceinline__ void phase_normmod_kv(CP& p) {
  const int lane = get_tid() & 63, wv = get_tid() >> 6;
  const float* g = p.norm_mix_g;
  for (int idx = get_bid() * 256 + get_tid(); idx < 110592; idx += VGRID * 256) {
    const int lr = idx / 6144; const int n = idx - lr * 6144; const int layer = lr / 9;
    p.modv[idx] = p.modp[idx] + p.modp[110592 + idx] + p.modp[2 * 110592 + idx] + p.modp[3 * 110592 + idx] + p.mod_b[layer * 6144 + n];
  }
  for (int r = (get_bid() * 4 + wv) * 2; r < 18432; r += VGRID * 8) {
    const int b = r / 2304, pp = r - b * 2304;
    const float* src; const float* mv;
    if (pp < 256) { src = p.ctx + ((size_t)b * 256 + pp) * 1024; mv = p.modp + (size_t)8 * 6144; }
    else { src = p.x + ((size_t)b * 2048 + pp - 256) * 1024; mv = p.modp + (size_t)b * 6144; }
    normmod_row2<true>(src, g, mv, mv + 1024, p.hxc + (size_t)r * 1024, lane, p.mod_b);
  }
}
__device__ __forceinline__ void phase_normmod_x(CP& p, const float* g, int layer, int chunk) {
  const int lane = get_tid() & 63, wv = get_tid() >> 6;
  for (int r = (get_bid() * 4 + wv) * 2; r < 16384; r += VGRID * 8) {
    const int b = r >> 11;
    const float* mv = p.modv + (size_t)(layer * 9 + b) * 6144 + chunk * 1024;
    normmod_row2<false>(p.X + (size_t)r * 1024, g, mv, mv + 1024, p.hxc + (size_t)r * 1024, lane);
  }
}
__device__ __forceinline__ void phase_final_norm(CP& p) {
  const int lane = get_tid() & 63, wv = get_tid() >> 6;
  for (int r = get_bid() * 4 + wv; r < 16384; r += VGRID * 4) {
    float* row = p.X + (size_t)r * 1024;
    f32x4 v[4]; float ss = 0.f;
#pragma unroll
    for (int i = 0; i < 4; ++i) { v[i] = *(const f32x4*)(row + lane * 4 + 256 * i); ss += v[i][0] * v[i][0] + v[i][1] * v[i][1] + v[i][2] * v[i][2] + v[i][3] * v[i][3]; }
    ss = wave_sum(ss);
    const float rr = rsqrtf(ss * (1.0f / 1024.0f) + 1e-6f);
#pragma unroll
    for (int i = 0; i < 4; ++i) {
      const int k = lane * 4 + 256 * i;
      const f32x4 g4 = *(const f32x4*)(p.final_g + k);
      f32x4 o; o[0] = v[i][0] * rr * g4[0]; o[1] = v[i][1] * rr * g4[1]; o[2] = v[i][2] * rr * g4[2]; o[3] = v[i][3] * rr * g4[3];
      *(f32x4*)(row + k) = o;
    }
  }
}

__device__ __forceinline__ void phase_rowstat(CP& p) {
  const int lane = get_tid() & 63, wv = get_tid() >> 6;
  for (int r = get_bid() * 4 + wv; r < 18432; r += VGRID * 4) {
    const int b = r / 2304, pp = r - b * 2304;
    const bf16_t* kvr = p.kv + (size_t)r * 288;
    {
      const uint2 u = *(const uint2*)(kvr + lane * 4);
      const float a0 = bf2f((bf16_t)(u.x & 0xffff)), a1 = bf2f((bf16_t)(u.x >> 16)), a2 = bf2f((bf16_t)(u.y & 0xffff)), a3 = bf2f((bf16_t)(u.y >> 16));
      float ss = a0 * a0 + a1 * a1 + a2 * a2 + a3 * a3;
      ss = wave_sum(ss);
      if (lane == 0) p.rkv[r] = rsqrtf(ss * (1.0f / 256.0f) + 1e-6f);
    }
    {
      const int i = lane & 31;
      const float xv = bf2f(kvr[256 + i]);
      const float ov = __shfl_xor(xv, 8);
      float res = xv;
      if (pp >= 256) {
        const int t = pp - 256;
        const int quarter = i >> 3, idx = i & 7;
        const float pos = (quarter < 2) ? (float)(t >> 6) : (float)(t & 63);
        const float inv = exp2f(-(float)idx * (13.287712379549449f / 8.0f));
        const float ang = pos * inv;
        const float cs = __cosf(ang), sn = __sinf(ang);
        res = xv * cs + ((quarter & 1) ? ov : -ov) * sn;
      }
      if (lane < 32) p.kpe[(size_t)r * 32 + i] = f2bf(res);
    }
    if (pp >= 256) {
      const int xr = b * 2048 + pp - 256;
      const uint4 u = *(const uint4*)(p.cq + (size_t)xr * 512 + lane * 8);
      const unsigned uu[4] = {u.x, u.y, u.z, u.w};
      float ss = 0.f;
#pragma unroll
      for (int j = 0; j < 4; ++j) { const float a = bf2f((bf16_t)(uu[j] & 0xffff)), bb = bf2f((bf16_t)(uu[j] >> 16)); ss += a * a + bb * bb; }
      ss = wave_sum(ss);
      if (lane == 0) p.rq[xr] = rsqrtf(ss * (1.0f / 512.0f) + 1e-6f);
    }
  }
}

struct EpiStore {
  static constexpr int KIND = 0;
  bf16_t* out; int ld; int ostride; const float* rs;
  __device__ __forceinline__ void c4(int g, int rig, int col, f32x4 v) const {
    const size_t row = (size_t)g * ostride + rig;
    const float s = rs ? rs[row] : 1.f;
    uint2 u; u.x = pack2(v[0] * s, v[1] * s); u.y = pack2(v[2] * s, v[3] * s);
    *(uint2*)(out + row * ld + col) = u;
  }
};
struct EpiVt {
  static constexpr int KIND = 1;
  bf16_t* out; const float* rs;
  __device__ __forceinline__ void r4(int g, int rig, int col, f32x4 v) const {
    const size_t row = (size_t)g * 2304 + rig;
    const f32x4 s = *(const f32x4*)(rs + row);
    uint2 u; u.x = pack2(v[0] * s[0], v[1] * s[1]); u.y = pack2(v[2] * s[2], v[3] * s[3]);
    *(uint2*)(out + ((size_t)g * 1024 + col) * 2304 + rig) = u;
  }
};
struct EpiFilt {
  static constexpr int KIND = 1;
  bf16_t* Rf; const float* decay;
  __device__ __forceinline__ void r4(int g, int rig, int col, f32x4 v) const {
    const int c = col & 1023; const bool bwd = col >= 1024;
    const float dec = fabsf(decay[c]);
    bf16_t* rp = Rf + (size_t)c * 4096;
#pragma unroll
    for (int j = 0; j < 4; ++j) {
      const int t = rig + j;
      const float val = v[j] * __expf(-(float)t * (1.0f / 2047.0f) * dec);
      if (!bwd) rp[2048 - t] = f2bf(val);
      else if (t > 0) rp[2048 + t] = f2bf(val);
      else rp[0] = 0;
    }
  }
};
struct EpiResid {
  static constexpr int KIND = 0;
  float* X; const float* base; const float* gate; const float* bias;
  __device__ __forceinline__ void c4(int g, int rig, int col, f32x4 v) const {
    const size_t o = ((size_t)g * 2048 + rig) * 1024 + col;
    const f32x4 bs = *(const f32x4*)(base + o);
    const f32x4 gt = *(const f32x4*)(gate + (size_t)g * 6144 + col);
    f32x4 bi = {0.f, 0.f, 0.f, 0.f};
    if (bias) bi = *(const f32x4*)(bias + col);
    f32x4 r;
#pragma unroll
    for (int j = 0; j < 4; ++j) r[j] = bs[j] + gt[j] * (v[j] + bi[j]);
    *(f32x4*)(X + o) = r;
  }
};
template <int MODE>
struct EpiConv {
  static constexpr int KIND = 2;
  const float* cw; const float* cb; int NC; const float* pre_bias;
  bf16_t* o0; bf16_t* o1;
  __device__ __forceinline__ int norig(int nt, int cl) const {
    if (MODE == 0) return (cl >> 6) * 2816 + nt * 64 + (cl & 63);
    if (nt < 8) return nt * 128 + cl;
    return 1024 + (cl >> 6) * 1024 + (nt - 8) * 64 + (cl & 63);
  }
  __device__ __forceinline__ void finish(const float* Z, int g, int rig0, int nt) const {
    const int tid = get_tid();
    if (MODE == 0 || nt < 8) {
      const int f = tid & 63, q = tid >> 6;
      const int p0 = 1 + 32 * q, p1 = (p0 + 32 < 127) ? p0 + 32 : 127;
      if (MODE == 0) {
        const int na = norig(nt, f), ng = norig(nt, 64 + f);
        const float a0 = cw[na], a1 = cw[NC + na], a2 = cw[2 * NC + na], ab = cb[na];
        const float g0 = cw[ng], g1 = cw[NC + ng], g2 = cw[2 * NC + ng], gb = cb[ng];
        float am = Z[(p0 - 1) * 132 + f], ac = Z[p0 * 132 + f], gm = Z[(p0 - 1) * 132 + 64 + f], gc = Z[p0 * 132 + 64 + f];
#pragma unroll 2
        for (int pl = p0; pl < p1; ++pl) {
          const float an = Z[(pl + 1) * 132 + f], gn = Z[(pl + 1) * 132 + 64 + f];
          const int pos = rig0 + pl;
          if (pos < 2048) {
            const float av = a0 * am + a1 * ac + a2 * an + ab;
            const float gv = g0 * gm + g1 * gc + g2 * gn + gb;
            o0[((size_t)g * 2048 + pos) * 2816 + nt * 64 + f] = f2bf(av * gv / (1.f + __expf(-gv)));
          }
          am = ac; ac = an; gm = gc; gc = gn;
        }
      } else {
#pragma unroll
        for (int fh = 0; fh < 2; ++fh) {
          const int cl = fh * 64 + f;
          const int na = norig(nt, cl);
          const float a0 = cw[na], a1 = cw[NC + na], a2 = cw[2 * NC + na], ab = cb[na];
          float am = Z[(p0 - 1) * 132 + cl], ac = Z[p0 * 132 + cl];
#pragma unroll 2
          for (int pl = p0; pl < p1; ++pl) {
            const float an = Z[(pl + 1) * 132 + cl];
            const int pos = rig0 + pl;
            if (pos < 2048) o0[((size_t)g * 2048 + pos) * 1024 + nt * 128 + cl] = f2bf(a0 * am + a1 * ac + a2 * an + ab);
            am = ac; ac = an;
          }
        }
      }
    } else {
      const int pl = tid & 127, fh = tid >> 7;
      const int pos = rig0 + pl;
      if (pl >= 1 && pl <= 126 && pos < 2048) {
        const int fb = nt - 8;
#pragma unroll 2
        for (int f = fh * 32; f < fh * 32 + 32; ++f) {
          const int na = norig(nt, f), nb = norig(nt, 64 + f);
          const float va = cw[na] * Z[(pl - 1) * 132 + f] + cw[NC + na] * Z[pl * 132 + f] + cw[2 * NC + na] * Z[(pl + 1) * 132 + f] + cb[na];
          const float vb = cw[nb] * Z[(pl - 1) * 132 + 64 + f] + cw[NC + nb] * Z[pl * 132 + 64 + f] + cw[2 * NC + nb] * Z[(pl + 1) * 132 + 64 + f] + cb[nb];
          o1[(size_t)(fb * 64 + f) * 16384 + g * 2048 + pos] = f2bf(va * vb);
        }
      }
    }
  }
};

#define GLDS16(gp, lp) __builtin_amdgcn_global_load_lds((const unsigned*)(gp), (__attribute__((address_space(3))) unsigned*)(lp), 16, 0, 0)

template <bool SWAP, class Epi>
__device__ __forceinline__ void gemm_job(char* smem, const bf16_t* __restrict__ A, int lda, const bf16_t* __restrict__ Bt, int K, int N,
                                         int tpg, int a_gstride, int a_goff, int step, int halo, int grows, int MTS, int voff, int vid0, int grid, const Epi& epi) {
  const int tid = get_tid512(), lane = tid & 63, wid = tid >> 6, wr = wid >> 1, wc = wid & 1, fr = lane & 15, fq = lane >> 4;
  const int NT = (N + 255) >> 8, MT = MTS >> 1, ntiles = MT * NT, ns = K >> 6;
  const int full = MT >> 3;
  int v = vid0;
  if (v < voff) v += ((voff - v + grid - 1) / grid) * grid;
  const int swz = (fr >> 1) & 7;
  for (; v < voff + ntiles; v += grid) {
    const int w = v - voff;
    int mt, nt;
    if (w < full * 8 * NT) { const int sr = w / (8 * NT), rem = w - sr * 8 * NT; nt = rem >> 3; mt = sr * 8 + (rem & 7); }
    else { const int w2 = w - full * 8 * NT, rl = MT - full * 8; nt = w2 / rl; mt = full * 8 + (w2 - nt * rl); }
    unsigned ap[4], bp[4];
#pragma unroll
    for (int i = 0; i < 4; ++i) {
      const int r = (tid >> 3) + 64 * i;
      const int cs = tid & 7;
      const int c = ((cs ^ ((r >> 1) & 7)) << 3);
      const int sub = 2 * mt + (r >> 7);
      const int g = sub / tpg, ti = sub - g * tpg;
      int rig = ti * step - halo + (r & 127); rig = rig < 0 ? 0 : (rig > grows - 1 ? grows - 1 : rig);
      ap[i] = (unsigned)((g * a_gstride + a_goff + rig) * lda + c);
      int br = nt * 256 + r; br = br > N - 1 ? N - 1 : br;
      bp[i] = (unsigned)(br * K + c);
    }
    f32x4 acc[4][8];
#pragma unroll
    for (int m = 0; m < 4; ++m)
#pragma unroll
      for (int n = 0; n < 8; ++n) acc[m][n] = (f32x4){0.f, 0.f, 0.f, 0.f};
#pragma unroll
    for (int i = 0; i < 4; ++i) { GLDS16(A + (size_t)ap[i], smem + tid * 16 + i * 8192); GLDS16(Bt + (size_t)bp[i], smem + 32768 + tid * 16 + i * 8192); }
    for (int st = 0; st < ns; ++st) {
      asm volatile("s_waitcnt vmcnt(0)" ::: "memory");
      __builtin_amdgcn_s_barrier();
      asm volatile("" ::: "memory");
      if (st + 1 < ns) {
        char* nb = smem + ((st + 1) & 1) * 65536;
        const int ko = (st + 1) * 64;
#pragma unroll
        for (int i = 0; i < 4; ++i) { GLDS16(A + (size_t)(ap[i] + ko), nb + tid * 16 + i * 8192); GLDS16(Bt + (size_t)(bp[i] + ko), nb + 32768 + tid * 16 + i * 8192); }
      }
      const char* sa = smem + (st & 1) * 65536 + (wr * 64 + fr) * 128;
      const char* sb = smem + (st & 1) * 65536 + 32768 + (wc * 128 + fr) * 128;
      bf16x8 afA[4], afB[4], bfb[2][2];
#pragma unroll
      for (int m = 0; m < 4; ++m) afA[m] = *(const bf16x8*)(sa + m * 2048 + ((fq ^ swz) << 4));
#pragma unroll
      for (int n = 0; n < 2; ++n) bfb[0][n] = *(const bf16x8*)(sb + n * 2048 + ((fq ^ swz) << 4));
#pragma unroll
      for (int gq = 0; gq < 8; ++gq) {
        const int ks = gq >> 2, nh = gq & 3;
        if (gq < 7) {
          const int ks2 = (gq + 1) >> 2, nh2 = (gq + 1) & 3;
#pragma unroll
          for (int n = 0; n < 2; ++n) bfb[(gq + 1) & 1][n] = *(const bf16x8*)(sb + (nh2 * 2 + n) * 2048 + (((ks2 * 4 + fq) ^ swz) << 4));
        }
        if (gq == 3) {
#pragma unroll
          for (int m = 0; m < 4; ++m) afB[m] = *(const bf16x8*)(sa + m * 2048 + (((4 + fq) ^ swz) << 4));
        }
        __builtin_amdgcn_sched_barrier(0);
#pragma unroll
        for (int m = 0; m < 4; ++m)
#pragma unroll
          for (int n = 0; n < 2; ++n) {
            const bf16x8 av = ks ? afB[m] : afA[m];
            acc[m][nh * 2 + n] = SWAP ? __builtin_amdgcn_mfma_f32_16x16x32_bf16(bfb[gq & 1][n], av, acc[m][nh * 2 + n], 0, 0, 0)
                                      : __builtin_amdgcn_mfma_f32_16x16x32_bf16(av, bfb[gq & 1][n], acc[m][nh * 2 + n], 0, 0, 0);
          }
      }
    }
    __syncthreads();
    const int te = get_tid512();
    const int fr_e = te & 15, fq_e = (te & 63) >> 4, wr_e = te >> 7, wc_e = (te >> 6) & 1;
    const int sub = 2 * mt + (wr_e >> 1);
    const int g = sub / tpg, ti = sub - g * tpg;
    const int rig0 = ti * step - halo;
    const int rw = (wr_e & 1) * 64;
    if constexpr (Epi::KIND == 0) {
#pragma unroll
      for (int m = 0; m < 4; ++m) {
        const int rig = rig0 + rw + m * 16 + fr_e;
#pragma unroll
        for (int n = 0; n < 8; ++n) {
          const int col = nt * 256 + wc_e * 128 + n * 16 + fq_e * 4;
          if (col < N) epi.c4(g, rig, col, acc[m][n]);
        }
      }
    } else if constexpr (Epi::KIND == 1) {
#pragma unroll
      for (int m = 0; m < 4; ++m) {
        const int rig = rig0 + rw + m * 16 + fq_e * 4;
#pragma unroll
        for (int n = 0; n < 8; ++n) {
          const int col = nt * 256 + wc_e * 128 + n * 16 + fr_e;
          if (col < N) epi.r4(g, rig, col, acc[m][n]);
        }
      }
    } else {
      float* Z = (float*)smem + (wr_e >> 1) * (128 * 132);
#pragma unroll
      for (int h = 0; h < 2; ++h) {
        const int nt2 = nt * 2 + h;
        if (wc_e == h) {
#pragma unroll
          for (int n = 0; n < 8; ++n) {
            const int cl = n * 16 + fq_e * 4;
            f32x4 b4 = {0.f, 0.f, 0.f, 0.f};
            if (epi.pre_bias) b4 = *(const f32x4*)(epi.pre_bias + epi.norig(nt2, cl));
#pragma unroll
            for (int m = 0; m < 4; ++m) {
              const int rl = rw + m * 16 + fr_e;
              const int pos = rig0 + rl;
              const bool ok = pos >= 0 && pos < grows;
              f32x4 vv = acc[m][n] + b4;
              if (!ok) vv = (f32x4){0.f, 0.f, 0.f, 0.f};
              *(f32x4*)(Z + rl * 132 + cl) = vv;
            }
          }
        }
        __syncthreads();
        epi.finish(Z, g, rig0, nt2);
        __syncthreads();
      }
    }
    asm volatile("s_waitcnt vmcnt(0)" ::: "memory");
    __syncthreads();
  }
}

__device__ __forceinline__ void phase_attn(CP& p, char* smem, int vid0, int grid) {
  bf16_t* Ks = (bf16_t*)smem;
  bf16_t* Vs = (bf16_t*)(smem + 64 * 104 * 2);
  const int tid = get_tid(), lane = tid & 63, w = tid >> 6, r = lane & 31, hh = lane >> 5;
  const float cs = 1.4426950408889634f * 0.10206207261596577f;
  for (int it = vid0; it < 2048; it += grid) {
    const int qt = it & 15, h = (it >> 4) & 15, b = it >> 8;
    const int t = qt * 128 + w * 32 + r;
    const size_t xrow = (size_t)b * 2048 + t;
    const bf16_t* qp = p.Q + xrow * 1536 + h * 96;
    bf16x8 qf[6];
#pragma unroll
    for (int kk = 0; kk < 4; ++kk) qf[kk] = *(const bf16x8*)(qp + 16 * kk + 8 * hh);
#pragma unroll
    for (int part = 0; part < 2; ++part) {
      const bf16_t* pp = qp + 64 + 16 * part;
      const bf16x8 mine = *(const bf16x8*)(pp + 8 * hh), oth = *(const bf16x8*)(pp + 8 * (1 - hh));
      const float posf = part == 0 ? (float)(t >> 6) : (float)(t & 63);
      union { unsigned u[4]; bf16x8 v; } o;
      float res[8];
#pragma unroll
      for (int j = 0; j < 8; ++j) {
        const float inv = exp2f(-(float)j * (13.287712379549449f / 8.0f));
        const float ang = posf * inv;
        const float c = __cosf(ang), s = __sinf(ang);
        const float m = bf2f((bf16_t)mine[j]), ov = bf2f((bf16_t)oth[j]);
        res[j] = m * c + (hh ? ov : -ov) * s;
      }
#pragma unroll
      for (int j = 0; j < 4; ++j) o.u[j] = pack2(res[2 * j], res[2 * j + 1]);
      qf[4 + part] = o.v;
    }
    f32x16 oacc[2];
#pragma unroll
    for (int i = 0; i < 16; ++i) { oacc[0][i] = 0.f; oacc[1][i] = 0.f; }
    float mrun = -INFINITY, lrun = 0.f;
    const size_t kvrow0 = (size_t)b * 2304;
    const bf16_t* kn_base = p.Kn + kvrow0 * 1024 + h * 64;
    const bf16_t* kpe_base = p.kpe + kvrow0 * 32;
    const bf16_t* vt_base = p.Vt + ((size_t)(b * 16 + h) * 64) * 2304;
    uint4 rk0, rk1, rp, rv0, rv1;
    const int srow = tid >> 3, sch = tid & 7;
#define ATT_GLOAD(kt) do { \
      rk0 = *(const uint4*)(kn_base + (size_t)((kt) * 64 + srow) * 1024 + sch * 8); \
      rk1 = *(const uint4*)(kn_base + (size_t)((kt) * 64 + srow + 32) * 1024 + sch * 8); \
      rv0 = *(const uint4*)(vt_base + (size_t)srow * 2304 + (kt) * 64 + sch * 8); \
      rv1 = *(const uint4*)(vt_base + (size_t)(srow + 32) * 2304 + (kt) * 64 + sch * 8); \
      rp = *(const uint4*)(kpe_base + (size_t)((kt) * 64 + (tid >> 2)) * 32 + (tid & 3) * 8); } while (0)
    ATT_GLOAD(0);
    for (int kt = 0; kt < 36; ++kt) {
      __syncthreads();
      {
        *(uint4*)(Ks + srow * 104 + sch * 8) = rk0;
        *(uint4*)(Ks + (srow + 32) * 104 + sch * 8) = rk1;
        uint2 lo, hi;
        lo.x = rv0.x; lo.y = rv0.y; hi.x = rv0.z; hi.y = rv0.w;
        *(uint2*)(Vs + srow * 68 + sch * 8) = lo; *(uint2*)(Vs + srow * 68 + sch * 8 + 4) = hi;
        lo.x = rv1.x; lo.y = rv1.y; hi.x = rv1.z; hi.y = rv1.w;
        *(uint2*)(Vs + (srow + 32) * 68 + sch * 8) = lo; *(uint2*)(Vs + (srow + 32) * 68 + sch * 8 + 4) = hi;
      }
      *(uint4*)(Ks + (tid >> 2) * 104 + 64 + (tid & 3) * 8) = rp;
      __syncthreads();
      if (kt + 1 < 36) ATT_GLOAD(kt + 1);
      f32x16 s[2];
#pragma unroll
      for (int t2 = 0; t2 < 2; ++t2) {
#pragma unroll
        for (int i = 0; i < 16; ++i) s[t2][i] = 0.f;
#pragma unroll
        for (int kk = 0; kk < 6; ++kk) {
          const bf16x8 a = *(const bf16x8*)(Ks + (32 * t2 + r) * 104 + 16 * kk + 8 * hh);
          s[t2] = __builtin_amdgcn_mfma_f32_32x32x16_bf16(a, qf[kk], s[t2], 0, 0, 0);
        }
      }
      float mx = s[0][0];
#pragma unroll
      for (int i = 1; i < 16; ++i) mx = fmaxf(mx, s[0][i]);
#pragma unroll
      for (int i = 0; i < 16; ++i) mx = fmaxf(mx, s[1][i]);
      mx = fmaxf(mx, __shfl_xor(mx, 32));
      const float mnew = fmaxf(mrun, mx * cs);
      const float alpha = __builtin_amdgcn_exp2f(mrun - mnew);
      mrun = mnew;
      float psum = 0.f;
      bf16x8 pf[4];
#pragma unroll
      for (int t2 = 0; t2 < 2; ++t2)
#pragma unroll
        for (int hf = 0; hf < 2; ++hf) {
          union { unsigned u[4]; bf16x8 v; } cvp;
#pragma unroll
          for (int i = 0; i < 4; ++i) {
            const float p0 = __builtin_amdgcn_exp2f(s[t2][hf * 8 + 2 * i] * cs - mnew);
            const float p1 = __builtin_amdgcn_exp2f(s[t2][hf * 8 + 2 * i + 1] * cs - mnew);
            psum += p0 + p1;
            cvp.u[i] = pack2(p0, p1);
          }
          pf[t2 * 2 + hf] = cvp.v;
        }
      lrun = lrun * alpha + psum;
#pragma unroll
      for (int i = 0; i < 16; ++i) { oacc[0][i] *= alpha; oacc[1][i] *= alpha; }
#pragma unroll
      for (int dt = 0; dt < 2; ++dt)
#pragma unroll
        for (int s4 = 0; s4 < 4; ++s4) {
          const bf16_t* vp = Vs + (32 * dt + r) * 68 + 16 * s4 + 4 * hh;
          const uint2 lo = *(const uint2*)vp, hi = *(const uint2*)(vp + 8);
          union { uint4 u; bf16x8 v; } cv; cv.u.x = lo.x; cv.u.y = lo.y; cv.u.z = hi.x; cv.u.w = hi.y;
          oacc[dt] = __builtin_amdgcn_mfma_f32_32x32x16_bf16(cv.v, pf[s4], oacc[dt], 0, 0, 0);
        }
    }
    const float ltot = lrun + __shfl_xor(lrun, 32);
    const float inv = 1.f / ltot;
    bf16_t* op = p.hxc + xrow * 1024 + h * 64;
#pragma unroll
    for (int dt = 0; dt < 2; ++dt)
#pragma unroll
      for (int i4 = 0; i4 < 4; ++i4) {
        const int d = 32 * dt + 8 * i4 + 4 * hh;
        uint2 u; u.x = pack2(oacc[dt][4 * i4] * inv, oacc[dt][4 * i4 + 1] * inv); u.y = pack2(oacc[dt][4 * i4 + 2] * inv, oacc[dt][4 * i4 + 3] * inv);
        *(uint2*)(op + d) = u;
      }
  }
}

__device__ __forceinline__ void phase_hyconv(CP& p, char* smem) {
  bf16_t* cp = (bf16_t*)smem;
  bf16_t* Vl = (bf16_t*)(smem + 4 * 8256);
  const int tid = get_tid(), lane = tid & 63, w = tid >> 6, i16 = lane & 15, g4 = lane >> 4;
  const int si = (-i16) & 3;
  const int ocb = 64 * w;
  for (int c = get_bid(); c < 1024; c += VGRID) {
    __syncthreads();
#pragma unroll
    for (int i = 0; i < 2; ++i) { const int ch = tid + 256 * i; *(uint4*)(cp + ch * 8) = *(const uint4*)(p.Rf + (size_t)c * 4096 + ch * 8); }
#pragma unroll
    for (int i = 0; i < 8; ++i) {
      const int q = tid + 256 * i; const int b = q >> 8, l8 = q & 255; const int m1 = l8 >> 3, m2 = (l8 & 7) * 8;
      *(uint4*)(Vl + (8 + m1 * 8 + b) * 80 + m2) = *(const uint4*)(p.vvT + (size_t)c * 16384 + b * 2048 + l8 * 8);
    }
    if (tid < 144) {
      const int colp = tid / 9, part = tid - colp * 9;
      const int col = colp < 8 ? colp : 256 + colp;
      uint4 zz; zz.x = 0; zz.y = 0; zz.z = 0; zz.w = 0;
      *(uint4*)(Vl + col * 80 + part * 8) = zz;
    }
    __syncthreads();
#pragma unroll
    for (int s = 1; s < 4; ++s)
#pragma unroll
      for (int i = 0; i < 2; ++i) {
        const int ch = tid + 256 * i;
        unsigned e[8];
#pragma unroll
        for (int j = 0; j < 8; ++j) { const int idx = 8 * ch + s + j; e[j] = idx < 4096 ? (unsigned)cp[idx] : 0u; }
        uint4 u; u.x = e[0] | (e[1] << 16); u.y = e[2] | (e[3] << 16); u.z = e[4] | (e[5] << 16); u.w = e[6] | (e[7] << 16);
        *(uint4*)(cp + s * 4128 + 8 * ch) = u;
      }
    __syncthreads();
    const bf16_t* abase = cp + si * 4128 + (2048 - i16 - si + 8 * g4);
    f32x4 acc[4][4];
#pragma unroll
    for (int m = 0; m < 4; ++m)
#pragma unroll
      for (int n = 0; n < 4; ++n) acc[m][n] = (f32x4){0.f, 0.f, 0.f, 0.f};
    for (int dl = -31; dl <= 31; ++dl) {
      bf16x8 af[4][2];
#pragma unroll
      for (int mt = 0; mt < 4; ++mt)
#pragma unroll
        for (int kk = 0; kk < 2; ++kk) {
          const bf16_t* ap = abase - 64 * dl - 16 * mt + 32 * kk;
          const uint2 lo = *(const uint2*)ap, hi = *(const uint2*)(ap + 4);
          union { uint4 u; bf16x8 v; } cv; cv.u.x = lo.x; cv.u.y = lo.y; cv.u.z = hi.x; cv.u.w = hi.y;
          af[mt][kk] = cv.v;
        }
#pragma unroll
      for (int jt = 0; jt < 4; ++jt) {
        const int in0 = ocb + 16 * jt - 8 * dl;
        if (in0 >= -8 && in0 <= 248) {
          const bf16_t* bp = Vl + (in0 + 8 + i16) * 80 + 8 * g4;
          const bf16x8 b0 = *(const bf16x8*)bp, b1 = *(const bf16x8*)(bp + 32);
#pragma unroll
          for (int mt = 0; mt < 4; ++mt) {
            acc[mt][jt] = __builtin_amdgcn_mfma_f32_16x16x32_bf16(af[mt][0], b0, acc[mt][jt], 0, 0, 0);
            acc[mt][jt] = __builtin_amdgcn_mfma_f32_16x16x32_bf16(af[mt][1], b1, acc[mt][jt], 0, 0, 0);
          }
        }
      }
    }
    const float db = p.hy_d_bias[c];
#pragma unroll
    for (int mt = 0; mt < 4; ++mt)
#pragma unroll
      for (int jt = 0; jt < 4; ++jt) {
        const int col = ocb + 16 * jt + i16;
        const int n1 = col >> 3, b = col & 7;
        const int n2 = 16 * mt + 4 * g4;
        const uint2 vv = *(const uint2*)(Vl + (col + 8) * 80 + n2);
        const float y0 = acc[mt][jt][0] + bf2f((bf16_t)(vv.x & 0xffff)) * db;
        const float y1 = acc[mt][jt][1] + bf2f((bf16_t)(vv.x >> 16)) * db;
        const float y2 = acc[mt][jt][2] + bf2f((bf16_t)(vv.y & 0xffff)) * db;
        const float y3 = acc[mt][jt][3] + bf2f((bf16_t)(vv.y >> 16)) * db;
        uint2 u; u.x = pack2(y0, y1); u.y = pack2(y2, y3);
        *(uint2*)(p.Yp + (size_t)c * 16384 + b * 2048 + n1 * 64 + n2) = u;
      }
  }
}

__device__ __forceinline__ void phase_transmul(CP& p, char* smem) {
  bf16_t* tl = (bf16_t*)smem;
  const int tid = get_tid();
  for (int it = get_bid(); it < 4096; it += VGRID) {
    const int ct = it & 15, rt = it >> 4;
    const int c0 = ct * 64, r0 = rt * 64;
    __syncthreads();
#pragma unroll
    for (int i = 0; i < 2; ++i) {
      const int ci = tid + 256 * i; const int cc = ci >> 3, ch = ci & 7;
      const uint4 u = *(const uint4*)(p.Yp + (size_t)(c0 + cc) * 16384 + r0 + ch * 8);
      unsigned* d = (unsigned*)(tl + cc * 66 + ch * 8);
      d[0] = u.x; d[1] = u.y; d[2] = u.z; d[3] = u.w;
    }
    __syncthreads();
    const int row = tid >> 2, cq = tid & 3;
    const bf16_t* xp = p.x1h + (size_t)(r0 + row) * 1024 + c0 + cq * 16;
    const uint4 xa = *(const uint4*)xp, xb = *(const uint4*)(xp + 8);
    const unsigned xs[8] = {xa.x, xa.y, xa.z, xa.w, xb.x, xb.y, xb.z, xb.w};
    unsigned o[8];
#pragma unroll
    for (int j = 0; j < 8; ++j) {
      const float y0 = bf2f(tl[(cq * 16 + 2 * j) * 66 + row]) * bf2f((bf16_t)(xs[j] & 0xffff));
      const float y1 = bf2f(tl[(cq * 16 + 2 * j + 1) * 66 + row]) * bf2f((bf16_t)(xs[j] >> 16));
      o[j] = pack2(y0, y1);
    }
    bf16_t* op = p.hxc + (size_t)(r0 + row) * 1024 + c0 + cq * 16;
    uint4 oa; oa.x = o[0]; oa.y = o[1]; oa.z = o[2]; oa.w = o[3];
    uint4 ob; ob.x = o[4]; ob.y = o[5]; ob.z = o[6]; ob.w = o[7];
    *(uint4*)op = oa; *(uint4*)(op + 8) = ob;
  }
}

__global__ void __launch_bounds__(512, 2) mega(P p_arg) {
  __shared__ __attribute__((aligned(16))) char smem[LDS_BYTES];
  cg::grid_group grid = cg::this_grid();
  const int G = gridDim.x;
  CP* pp = (CP*)__builtin_amdgcn_kernarg_segment_ptr();
  const int ph0 = pp->ph0, ph1 = pp->ph1;
  volatile LAS unsigned* xst = (volatile LAS unsigned*)(smem + LDS_BYTES - 16);
  if (threadIdx.x == 0) { xst[0] = 0u; xst[1] = 0u; }
  __syncthreads();
  const XcdBarrier xb = xcd_barrier_post(pp->bar, xst);
  if (ph0 <= 0 && 0 < ph1) {
    asm volatile("" : "+s"(pp));
    CP& p = *pp;
    const int bid = get_rbid();
    const int vid0 = (G & 7) ? bid : ((bid & 7) * (G >> 3) + (bid >> 3));
    const int hb = get_hb();
    char* smem_h = smem + hb * HALF_LDS; (void)smem_h;
    const float* mv0 = p.modv; const float* mv1 = p.modv + (size_t)9 * 6144;
    (void)mv0; (void)mv1; (void)vid0;
    phase_prep(p, smem_h);
    if (0 + 1 < ph1) { if (ph1 > 1000) grid.sync(); else xcd_barrier(xb); }
  }
  if (ph0 <= 1 && 1 < ph1) {
    asm volatile("" : "+s"(pp));
    CP& p = *pp;
    const int bid = get_rbid();
    const int vid0 = (G & 7) ? bid : ((bid & 7) * (G >> 3) + (bid >> 3));
    const int hb = get_hb();
    char* smem_h = smem + hb * HALF_LDS; (void)smem_h;
    const float* mv0 = p.modv; const float* mv1 = p.modv + (size_t)9 * 6144;
    (void)mv0; (void)mv1; (void)vid0;
    phase_normmod_kv(p);
    if (1 + 1 < ph1) { if (ph1 > 1000) grid.sync(); else xcd_barrier(xb); }
  }
  if (ph0 <= 2 && 2 < ph1) {
    asm volatile("" : "+s"(pp));
    CP& p = *pp;
    const int bid = get_rbid();
    const int vid0 = (G & 7) ? bid : ((bid & 7) * (G >> 3) + (bid >> 3));
    const int hb = get_hb();
    char* smem_h = smem + hb * HALF_LDS; (void)smem_h;
    const float* mv0 = p.modv; const float* mv1 = p.modv + (size_t)9 * 6144;
    (void)mv0; (void)mv1; (void)vid0;
    {
        EpiStore e1{p.cq, 512, 2048, nullptr};
        gemm_job<true>(smem, p.hxc, 1024, p.wt_dq, 1024, 512, 16, 2304, 256, 128, 0, 2048, 128, 0, vid0, G, e1);
        EpiStore e2{p.kv, 288, 2304, nullptr};
        gemm_job<true>(smem, p.hxc, 1024, p.wt_dkv, 1024, 288, 18, 2304, 0, 128, 0, 2304, 144, 64 * 2, vid0, G, e2);
        EpiFilt e3{p.Rf, p.hy_decay};
        gemm_job<false>(smem, p.h2bf, 64, p.wt_f3, 64, 2048, 16, 0, 0, 128, 0, 2048, 16, 64 * 2 + 72 * 2, vid0, G, e3);
      }
    if (2 + 1 < ph1) { if (ph1 > 1000) grid.sync(); else xcd_barrier(xb); }
  }
  if (ph0 <= 3 && 3 < ph1) {
    asm volatile("" : "+s"(pp));
    CP& p = *pp;
    const int bid = get_rbid();
    const int vid0 = (G & 7) ? bid : ((bid & 7) * (G >> 3) + (bid >> 3));
    const int hb = get_hb();
    char* smem_h = smem + hb * HALF_LDS; (void)smem_h;
    const float* mv0 = p.modv; const float* mv1 = p.modv + (size_t)9 * 6144;
    (void)mv0; (void)mv1; (void)vid0;
    phase_rowstat(p);
    if (3 + 1 < ph1) { if (ph1 > 1000) grid.sync(); else xcd_barrier(xb); }
  }
  if (ph0 <= 4 && 4 < ph1) {
    asm volatile("" : "+s"(pp));
    CP& p = *pp;
    const int bid = get_rbid();
    const int vid0 = (G & 7) ? bid : ((bid & 7) * (G >> 3) + (bid >> 3));
    const int hb = get_hb();
    char* smem_h = smem + hb * HALF_LDS; (void)smem_h;
    const float* mv0 = p.modv; const float* mv1 = p.modv + (size_t)9 * 6144;
    (void)mv0; (void)mv1; (void)vid0;
    {
        EpiStore e1{p.Q, 1536, 2048, p.rq};
        gemm_job<true>(smem, p.cq, 512, p.wt_uq, 512, 1536, 16, 2048, 0, 128, 0, 2048, 128, 0, vid0, G, e1);
        EpiStore e2{p.Kn, 1024, 2304, p.rkv};
        gemm_job<true>(smem, p.kv, 288, p.wt_uk, 256, 1024, 18, 2304, 0, 128, 0, 2304, 144, 64 * 6, vid0, G, e2);
        EpiVt e3{p.Vt, p.rkv};
        gemm_job<false>(smem, p.kv, 288, p.wt_uv, 256, 1024, 18, 2304, 0, 128, 0, 2304, 144, 64 * 6 + 72 * 4, vid0, G, e3);
      }
    if (4 + 1 < ph1) { if (ph1 > 1000) grid.sync(); else xcd_barrier(xb); }
  }
  if (ph0 <= 5 && 5 < ph1) {
    asm volatile("" : "+s"(pp));
    CP& p = *pp;
    const int bid = get_rbid();
    const int vid0 = (G & 7) ? bid : ((bid & 7) * (G >> 3) + (bid >> 3));
    const int hb = get_hb();
    char* smem_h = smem + hb * HALF_LDS; (void)smem_h;
    const float* mv0 = p.modv; const float* mv1 = p.modv + (size_t)9 * 6144;
    (void)mv0; (void)mv1; (void)vid0;
    phase_attn(p, smem_h, 2 * vid0 + hb, 2 * G);
    if (5 + 1 < ph1) { if (ph1 > 1000) grid.sync(); else xcd_barrier(xb); }
  }
  if (ph0 <= 6 && 6 < ph1) {
    asm volatile("" : "+s"(pp));
    CP& p = *pp;
    const int bid = get_rbid();
    const int vid0 = (G & 7) ? bid : ((bid & 7) * (G >> 3) + (bid >> 3));
    const int hb = get_hb();
    char* smem_h = smem + hb * HALF_LDS; (void)smem_h;
    const float* mv0 = p.modv; const float* mv1 = p.modv + (size_t)9 * 6144;
    (void)mv0; (void)mv1; (void)vid0;
    {
        EpiResid e{p.X, p.x, mv0 + 2 * 1024, nullptr};
        gemm_job<true>(smem, p.hxc, 1024, p.wt_o, 1024, 1024, 16, 2048, 0, 128, 0, 2048, 128, 0, vid0, G, e);
      }
    if (6 + 1 < ph1) { if (ph1 > 1000) grid.sync(); else xcd_barrier(xb); }
  }
  if (ph0 <= 7 && 7 < ph1) {
    asm volatile("" : "+s"(pp));
    CP& p = *pp;
    const int bid = get_rbid();
    const int vid0 = (G & 7) ? bid : ((bid & 7) * (G >> 3) + (bid >> 3));
    const int hb = get_hb();
    char* smem_h = smem + hb * HALF_LDS; (void)smem_h;
    const float* mv0 = p.modv; const float* mv1 = p.modv + (size_t)9 * 6144;
    (void)mv0; (void)mv1; (void)vid0;
    phase_normmod_x(p, p.norm_ffn_g, 0, 3);
    if (7 + 1 < ph1) { if (ph1 > 1000) grid.sync(); else xcd_barrier(xb); }
  }
  if (ph0 <= 8 && 8 < ph1) {
    asm volatile("" : "+s"(pp));
    CP& p = *pp;
    const int bid = get_rbid();
    const int vid0 = (G & 7) ? bid : ((bid & 7) * (G >> 3) + (bid >> 3));
    const int hb = get_hb();
    char* smem_h = smem + hb * HALF_LDS; (void)smem_h;
    const float* mv0 = p.modv; const float* mv1 = p.modv + (size_t)9 * 6144;
    (void)mv0; (void)mv1; (void)vid0;
    {
        EpiConv<0> e{p.ffn_conv_w, p.ffn_conv_b, 5632, nullptr, p.act, nullptr};
        gemm_job<true>(smem, p.hxc, 1024, p.wt_up0, 1024, 5632, 17, 2048, 0, 126, 1, 2048, 136, 0, vid0, G, e);
      }
    if (8 + 1 < ph1) { if (ph1 > 1000) grid.sync(); else xcd_barrier(xb); }
  }
  if (ph0 <= 9 && 9 < ph1) {
    asm volatile("" : "+s"(pp));
    CP& p = *pp;
    const int bid = get_rbid();
    const int vid0 = (G & 7) ? bid : ((bid & 7) * (G >> 3) + (bid >> 3));
    const int hb = get_hb();
    char* smem_h = smem + hb * HALF_LDS; (void)smem_h;
    const float* mv0 = p.modv; const float* mv1 = p.modv + (size_t)9 * 6144;
    (void)mv0; (void)mv1; (void)vid0;
    {
        EpiResid e{p.X, p.X, mv0 + 5 * 1024, nullptr};
        gemm_job<true>(smem, p.act, 2816, p.wt_dn0, 2816, 1024, 16, 2048, 0, 128, 0, 2048, 128, 0, vid0, G, e);
      }
    if (9 + 1 < ph1) { if (ph1 > 1000) grid.sync(); else xcd_barrier(xb); }
  }
  if (ph0 <= 10 && 10 < ph1) {
    asm volatile("" : "+s"(pp));
    CP& p = *pp;
    const int bid = get_rbid();
    const int vid0 = (G & 7) ? bid : ((bid & 7) * (G >> 3) + (bid >> 3));
    const int hb = get_hb();
    char* smem_h = smem + hb * HALF_LDS; (void)smem_h;
    const float* mv0 = p.modv; const float* mv1 = p.modv + (size_t)9 * 6144;
    (void)mv0; (void)mv1; (void)vid0;
    phase_normmod_x(p, p.norm_mix_g + 1024, 1, 0);
    if (10 + 1 < ph1) { if (ph1 > 1000) grid.sync(); else xcd_barrier(xb); }
  }
  if (ph0 <= 11 && 11 < ph1) {
    asm volatile("" : "+s"(pp));
    CP& p = *pp;
    const int bid = get_rbid();
    const int vid0 = (G & 7) ? bid : ((bid & 7) * (G >> 3) + (bid >> 3));
    const int hb = get_hb();
    char* smem_h = smem + hb * HALF_LDS; (void)smem_h;
    const float* mv0 = p.modv; const float* mv1 = p.modv + (size_t)9 * 6144;
    (void)mv0; (void)mv1; (void)vid0;
    {
        EpiConv<1> e{p.hy_conv_w, p.hy_conv_b, 3072, p.hy_b_in, p.x1h, p.vvT};
        gemm_job<true>(smem, p.hxc, 1024, p.wt_hin, 1024, 3072, 17, 2048, 0, 126, 1, 2048, 136, 0, vid0, G, e);
      }
    if (11 + 1 < ph1) { if (ph1 > 1000) grid.sync(); else xcd_barrier(xb); }
  }
  if (ph0 <= 12 && 12 < ph1) {
    asm volatile("" : "+s"(pp));
    CP& p = *pp;
    const int bid = get_rbid();
    const int vid0 = (G & 7) ? bid : ((bid & 7) * (G >> 3) + (bid >> 3));
    const int hb = get_hb();
    char* smem_h = smem + hb * HALF_LDS; (void)smem_h;
    const float* mv0 = p.modv; const float* mv1 = p.modv + (size_t)9 * 6144;
    (void)mv0; (void)mv1; (void)vid0;
    phase_hyconv(p, smem_h);
    if (12 + 1 < ph1) { if (ph1 > 1000) grid.sync(); else xcd_barrier(xb); }
  }
  if (ph0 <= 13 && 13 < ph1) {
    asm volatile("" : "+s"(pp));
    CP& p = *pp;
    const int bid = get_rbid();
    const int vid0 = (G & 7) ? bid : ((bid & 7) * (G >> 3) + (bid >> 3));
    const int hb = get_hb();
    char* smem_h = smem + hb * HALF_LDS; (void)smem_h;
    const float* mv0 = p.modv; const float* mv1 = p.modv + (size_t)9 * 6144;
    (void)mv0; (void)mv1; (void)vid0;
    phase_transmul(p, smem_h);
    if (13 + 1 < ph1) { if (ph1 > 1000) grid.sync(); else xcd_barrier(xb); }
  }
  if (ph0 <= 14 && 14 < ph1) {
    asm volatile("" : "+s"(pp));
    CP& p = *pp;
    const int bid = get_rbid();
    const int vid0 = (G & 7) ? bid : ((bid & 7) * (G >> 3) + (bid >> 3));
    const int hb = get_hb();
    char* smem_h = smem + hb * HALF_LDS; (void)smem_h;
    const float* mv0 = p.modv; const float* mv1 = p.modv + (size_t)9 * 6144;
    (void)mv0; (void)mv1; (void)vid0;
    {
        EpiResid e{p.X, p.X, mv1 + 2 * 1024, p.hy_b_out};
        gemm_job<true>(smem, p.hxc, 1024, p.wt_hout, 1024, 1024, 16, 2048, 0, 128, 0, 2048, 128, 0, vid0, G, e);
      }
    if (14 + 1 < ph1) { if (ph1 > 1000) grid.sync(); else xcd_barrier(xb); }
  }
  if (ph0 <= 15 && 15 < ph1) {
    asm volatile("" : "+s"(pp));
    CP& p = *pp;
    const int bid = get_rbid();
    const int vid0 = (G & 7) ? bid : ((bid & 7) * (G >> 3) + (bid >> 3));
    const int hb = get_hb();
    char* smem_h = smem + hb * HALF_LDS; (void)smem_h;
    const float* mv0 = p.modv; const float* mv1 = p.modv + (size_t)9 * 6144;
    (void)mv0; (void)mv1; (void)vid0;
    phase_normmod_x(p, p.norm_ffn_g + 1024, 1, 3);
    if (15 + 1 < ph1) { if (ph1 > 1000) grid.sync(); else xcd_barrier(xb); }
  }
  if (ph0 <= 16 && 16 < ph1) {
    asm volatile("" : "+s"(pp));
    CP& p = *pp;
    const int bid = get_rbid();
    const int vid0 = (G & 7) ? bid : ((bid & 7) * (G >> 3) + (bid >> 3));
    const int hb = get_hb();
    char* smem_h = smem + hb * HALF_LDS; (void)smem_h;
    const float* mv0 = p.modv; const float* mv1 = p.modv + (size_t)9 * 6144;
    (void)mv0; (void)mv1; (void)vid0;
    {
        EpiConv<0> e{p.ffn_conv_w + (size_t)3 * 5632, p.ffn_conv_b + 5632, 5632, nullptr, p.act, nullptr};
        gemm_job<true>(smem, p.hxc, 1024, p.wt_up1, 1024, 5632, 17, 2048, 0, 126, 1, 2048, 136, 0, vid0, G, e);
      }
    if (16 + 1 < ph1) { if (ph1 > 1000) grid.sync(); else xcd_barrier(xb); }
  }
  if (ph0 <= 17 && 17 < ph1) {
    asm volatile("" : "+s"(pp));
    CP& p = *pp;
    const int bid = get_rbid();
    const int vid0 = (G & 7) ? bid : ((bid & 7) * (G >> 3) + (bid >> 3));
    const int hb = get_hb();
    char* smem_h = smem + hb * HALF_LDS; (void)smem_h;
    const float* mv0 = p.modv; const float* mv1 = p.modv + (size_t)9 * 6144;
    (void)mv0; (void)mv1; (void)vid0;
    {
        EpiResid e{p.X, p.X, mv1 + 5 * 1024, nullptr};
        gemm_job<true>(smem, p.act, 2816, p.wt_dn1, 2816, 1024, 16, 2048, 0, 128, 0, 2048, 128, 0, vid0, G, e);
      }
    if (17 + 1 < ph1) { if (ph1 > 1000) grid.sync(); else xcd_barrier(xb); }
  }
  if (ph0 <= 18 && 18 < ph1) {
    asm volatile("" : "+s"(pp));
    CP& p = *pp;
    const int bid = get_rbid();
    const int vid0 = (G & 7) ? bid : ((bid & 7) * (G >> 3) + (bid >> 3));
    const int hb = get_hb();
    char* smem_h = smem + hb * HALF_LDS; (void)smem_h;
    const float* mv0 = p.modv; const float* mv1 = p.modv + (size_t)9 * 6144;
    (void)mv0; (void)mv1; (void)vid0;
    phase_final_norm(p);
    if (18 + 1 < ph1) { if (ph1 > 1000) grid.sync(); else xcd_barrier(xb); }
  }
}

extern "C" void kernel_launch(void* const* d_in, const int* in_sizes, int n_in, void* d_out, int out_size, void* d_ws, size_t ws_size, hipStream_t stream) {
  static int grid_blocks = 0;
  if (!grid_blocks) {
    int dev = 0, cus = 0, per_cu = 0;
    hipGetDevice(&dev);
    hipDeviceGetAttribute(&cus, hipDeviceAttributeMultiprocessorCount, dev);
    hipOccupancyMaxActiveBlocksPerMultiprocessor(&per_cu, (const void*)mega, 512, 0);
    per_cu = 1;
    grid_blocks = cus * per_cu;
  }
  P p{};
  const float** in = (const float**)&p;
  for (int i = 0; i < 36; ++i) in[i] = (const float*)d_in[i];
  p.X = (float*)d_out;
  char* ws = (char*)d_ws; size_t off = 0;
  auto take = [&](size_t bytes) { char* r = ws + off; off += (bytes + 255) & ~(size_t)255; return r; };
  p.wt_dq = (bf16_t*)take((size_t)512 * 1024 * 2);
  p.wt_dkv = (bf16_t*)take((size_t)288 * 1024 * 2);
  p.wt_uq = (bf16_t*)take((size_t)1536 * 512 * 2);
  p.wt_uk = (bf16_t*)take((size_t)1024 * 256 * 2);
  p.wt_uv = (bf16_t*)take((size_t)1024 * 256 * 2);
  p.wt_o = (bf16_t*)take((size_t)1024 * 1024 * 2);
  p.wt_hin = (bf16_t*)take((size_t)3072 * 1024 * 2);
  p.wt_hout = (bf16_t*)take((size_t)1024 * 1024 * 2);
  p.wt_up0 = (bf16_t*)take((size_t)5632 * 1024 * 2);
  p.wt_up1 = (bf16_t*)take((size_t)5632 * 1024 * 2);
  p.wt_dn0 = (bf16_t*)take((size_t)1024 * 2816 * 2);
  p.wt_dn1 = (bf16_t*)take((size_t)1024 * 2816 * 2);
  p.modv = (float*)take((size_t)2 * 9 * 6144 * 4);
  p.rq = (float*)take((size_t)16384 * 4);
  p.rkv = (float*)take((size_t)18432 * 4);
  p.modp = (float*)take((size_t)4 * 110592 * 4);
  p.bar = (unsigned*)take((size_t)XCD_BAR_WORDS * 4);
  p.wt_f3 = (bf16_t*)take((size_t)2048 * 64 * 2);
  p.h2bf = (bf16_t*)take((size_t)2048 * 64 * 2);
  p.Rf = (bf16_t*)take((size_t)1024 * 4096 * 2);
  p.kpe = (bf16_t*)take((size_t)18432 * 32 * 2);
  p.hxc = (bf16_t*)take((size_t)18432 * 1024 * 2);
  const size_t ubase = off;
  p.cq = (bf16_t*)take((size_t)16384 * 512 * 2);
  p.kv = (bf16_t*)take((size_t)18432 * 288 * 2);
  p.Q = (bf16_t*)take((size_t)16384 * 1536 * 2);
  p.Kn = (bf16_t*)take((size_t)18432 * 1024 * 2);
  p.Vt = (bf16_t*)take((size_t)18432 * 1024 * 2);
  const size_t uend1 = off;
  off = ubase;
  p.act = (bf16_t*)take((size_t)16384 * 2816 * 2);
  off = ubase;
  p.x1h = (bf16_t*)take((size_t)16384 * 1024 * 2);
  p.vvT = (bf16_t*)take((size_t)16384 * 1024 * 2);
  p.Yp = (bf16_t*)take((size_t)16384 * 1024 * 2);
  if (uend1 > ws_size) { fprintf(stderr, "workspace too small: need %zu have %zu\n", uend1, ws_size); return; }
  p.ph0 = 0; p.ph1 = NPHASE;
  if (hipMemsetAsync(p.bar, 0, (size_t)XCD_BAR_WORDS * 4, stream) != hipSuccess) { fprintf(stderr, "memset failed\n"); return; }
  void* args[] = {&p};
  hipError_t e = hipLaunchCooperativeKernel((const void*)mega, dim3(grid_blocks), dim3(512), args, 0, stream);
  if (e != hipSuccess) fprintf(stderr, "cooperative launch failed: %s (grid %d)\n", hipGetErrorString(e), grid_blocks);
}
```

```cpp
#include <hip/hip_runtime.h>
#include <hip/hip_cooperative_groups.h>
#include <cstdio>
namespace cg = cooperative_groups;

typedef unsigned short bf16_t;
typedef short bf16x8 __attribute__((ext_vector_type(8)));
typedef float f32x4 __attribute__((ext_vector_type(4)));
typedef float f32x16 __attribute__((ext_vector_type(16)));

#define LDS_BYTES 163840
#define HALF_LDS 81920
#define NPHASE 19

struct P {
  const float *x, *c, *ctx, *c_ctx, *mod_w, *mod_b, *norm_mix_g, *norm_ffn_g;
  const float *w_dq, *g_q, *w_uq, *w_dkv, *g_kv, *w_uk, *w_uv, *w_o;
  const float *hy_w_in, *hy_b_in, *hy_conv_w, *hy_conv_b, *f_w1, *f_b1, *f_freq1, *f_w2, *f_b2, *f_freq2, *f_w3, *hy_decay, *hy_d_bias, *hy_w_out, *hy_b_out;
  const float *ffn_w_up, *ffn_conv_w, *ffn_conv_b, *ffn_w_down, *final_g;
  float* X;
  bf16_t *wt_dq, *wt_dkv, *wt_uq, *wt_uk, *wt_uv, *wt_o, *wt_hin, *wt_hout, *wt_up0, *wt_up1, *wt_dn0, *wt_dn1;
  float *modv, *rq, *rkv, *modp;
  unsigned* bar;
  bf16_t *wt_f3, *h2bf;
  bf16_t *Rf, *kpe, *hxc, *cq, *kv, *Q, *Kn, *Vt, *act, *x1h, *vvT, *Yp;
  int ph0, ph1;
};

typedef const __attribute__((address_space(4))) P CP;
__device__ __forceinline__ int get_tid512() { int t = threadIdx.x; asm volatile("" : "+v"(t)); return t; }
__device__ __forceinline__ int get_tid() { int t = threadIdx.x & 255; asm volatile("" : "+v"(t)); return t; }
__device__ __forceinline__ int get_hb() { int t = __builtin_amdgcn_readfirstlane((int)(threadIdx.x >> 8)); asm volatile("" : "+s"(t)); return t; }
__device__ __forceinline__ int get_rbid() { int t = blockIdx.x; asm volatile("" : "+s"(t)); return t; }
__device__ __forceinline__ int get_bid() { return 2 * get_rbid() + get_hb(); }
#define VGRID (2 * (int)gridDim.x)

__device__ __forceinline__ unsigned pack2(float a, float b) { unsigned r; asm("v_cvt_pk_bf16_f32 %0, %1, %2" : "=v"(r) : "v"(a), "v"(b)); return r; }
__device__ __forceinline__ bf16_t f2bf(float f) { return (bf16_t)(pack2(f, f) & 0xffffu); }
__device__ __forceinline__ float bf2f(bf16_t h) { return __uint_as_float(((unsigned)h) << 16); }
__device__ __forceinline__ float wave_sum(float v) {
#pragma unroll
  for (int o = 32; o; o >>= 1) v += __shfl_xor(v, o);
  return v;
}


#define XB_TMO      128
#define XB_XCNT(j)  (256  + 64 * (j))
#define XB_XSUB(j)  (1280 + 64 * (j))
#define XB_XGEN(j)  (2304 + 64 * (j))
#define XB_TOP      3328
#define XB_TOPGEN   3392
#define XCD_BAR_WORDS 3456
#define XB_SPIN_CAP (1u << 18)
#define LAS __attribute__((address_space(3)))
__device__ __forceinline__ unsigned xb_ld(unsigned* p)              { return __hip_atomic_load(p, __ATOMIC_RELAXED, __HIP_MEMORY_SCOPE_AGENT); }
__device__ __forceinline__ unsigned xb_add(unsigned* p, unsigned v) { return __hip_atomic_fetch_add(p, v, __ATOMIC_RELAXED, __HIP_MEMORY_SCOPE_AGENT); }
__device__ __forceinline__ unsigned xb_xcc_id() { return (unsigned)__builtin_amdgcn_s_getreg((3 << 11) | 20) & 0xFu; }
#define XB_SPIN(cond, bar) do { unsigned _sp = 0; while (cond) { __builtin_amdgcn_s_sleep(1); \
    if ((++_sp & 255u) == 0u) { if (xb_ld(&(bar)[XB_TMO])) break; if (_sp > XB_SPIN_CAP) { atomicAdd(&(bar)[XB_TMO], 1u); break; } } } } while (0)
struct XcdBarrier { unsigned* bar; unsigned x; volatile LAS unsigned* st; };
__device__ __forceinline__ XcdBarrier xcd_barrier_post(unsigned* bar, volatile LAS unsigned* st) {
    XcdBarrier b; b.bar = bar; b.x = xb_xcc_id(); b.st = st;
    if (threadIdx.x == 0) (void)xb_add(&bar[XB_XCNT(b.x)], 1u);
    return b;
}
__device__ __forceinline__ void xcd_barrier_complete(unsigned* bar, unsigned x, unsigned& nloc, unsigned& nx) {
    const unsigned G = gridDim.x * gridDim.y * gridDim.z;
    unsigned sum, cnt, mine, sp = 0u;
    for (;;) {
        sum = 0u; cnt = 0u; mine = 0u;
#pragma unroll
        for (unsigned j = 0; j < 16; ++j) { const unsigned c = xb_ld(&bar[XB_XCNT(j)]); sum += c; cnt += (c > 0u) ? 1u : 0u; mine = (j == x) ? c : mine; }
        if (sum == G) break;
        __builtin_amdgcn_s_sleep(1);
        if ((++sp & 255u) == 0u) { if (xb_ld(&bar[XB_TMO])) break; if (sp > XB_SPIN_CAP) { atomicAdd(&bar[XB_TMO], 1u); break; } }
    }
    nloc = mine > 0u ? mine : 1u; nx = cnt > 0u ? cnt : 1u;
}
__device__ __forceinline__ void xcd_barrier(const XcdBarrier& b) {
    asm volatile("s_waitcnt vmcnt(0)" ::: "memory");
    __syncthreads();
    if (threadIdx.x == 0) {
        unsigned* bar = b.bar;
        __builtin_amdgcn_s_waitcnt(0);
        unsigned nloc = b.st[0], nx = b.st[1];
        if (nloc == 0u) { xcd_barrier_complete(bar, b.x, nloc, nx); b.st[0] = nloc; b.st[1] = nx; }
        const unsigned old = xb_add(&bar[XB_XSUB(b.x)], 1u);
        const unsigned gen = old / nloc;
        if (old + 1u == (gen + 1u) * nloc) {
            __builtin_amdgcn_fence(__ATOMIC_RELEASE, "agent");
            asm volatile("s_waitcnt vmcnt(0)" ::: "memory");
            const unsigned og = xb_add(&bar[XB_TOP], 1u);
            const unsigned tg = og / nx;
            if (og + 1u == (tg + 1u) * nx) xb_add(&bar[XB_TOPGEN], 1u);
            else XB_SPIN(xb_ld(&bar[XB_TOPGEN]) == tg, bar);
            __builtin_amdgcn_fence(__ATOMIC_ACQUIRE, "agent");
            xb_add(&bar[XB_XGEN(b.x)], 1u);
            asm volatile("s_waitcnt vmcnt(0)" ::: "memory");
        } else {
            XB_SPIN(xb_ld(&bar[XB_XGEN(b.x)]) == gen, bar);
            __builtin_amdgcn_fence(__ATOMIC_ACQUIRE, "agent");
            asm volatile("s_waitcnt vmcnt(0)" ::: "memory");
        }
    }
    __syncthreads();
}

__device__ __forceinline__ void prep_weight_tile(CP& p, char* smem, int wt) {
  const int tid = get_tid();
  int id = 0;
  {
    const int cnt[13] = {64, 40, 96, 32, 32, 128, 384, 128, 704, 704, 352, 352, 32};
#pragma unroll
    for (int i = 0; i < 12; ++i) { if (id == i && wt >= cnt[i]) { wt -= cnt[i]; id = i + 1; } }
  }
  const float* src; int K, N; bf16_t* dst; const float* scale = nullptr; int perm = 0;
  switch (id) {
    case 0: src = p.w_dq; K = 1024; N = 512; dst = p.wt_dq; break;
    case 1: src = p.w_dkv; K = 1024; N = 288; dst = p.wt_dkv; break;
    case 2: src = p.w_uq; K = 512; N = 1536; dst = p.wt_uq; scale = p.g_q; break;
    case 3: src = p.w_uk; K = 256; N = 1024; dst = p.wt_uk; scale = p.g_kv; break;
    case 4: src = p.w_uv; K = 256; N = 1024; dst = p.wt_uv; scale = p.g_kv; break;
    case 5: src = p.w_o; K = 1024; N = 1024; dst = p.wt_o; break;
    case 6: src = p.hy_w_in; K = 1024; N = 3072; dst = p.wt_hin; perm = 2; break;
    case 7: src = p.hy_w_out; K = 1024; N = 1024; dst = p.wt_hout; break;
    case 8: src = p.ffn_w_up; K = 1024; N = 5632; dst = p.wt_up0; perm = 1; break;
    case 9: src = p.ffn_w_up + (size_t)1024 * 5632; K = 1024; N = 5632; dst = p.wt_up1; perm = 1; break;
    case 10: src = p.ffn_w_down; K = 2816; N = 1024; dst = p.wt_dn0; break;
    case 11: src = p.ffn_w_down + (size_t)2816 * 1024; K = 2816; N = 1024; dst = p.wt_dn1; break;
    default: src = p.f_w3; K = 64; N = 2048; dst = p.wt_f3; break;
  }
  const int ntn = (N + 63) >> 6;
  const int kt = wt / ntn, nt = wt - kt * ntn;
  const int k0 = kt * 128, n0 = nt * 64;
  int np0;
  if (perm == 1) { const int half = n0 / 2816, f = n0 - half * 2816; np0 = (f >> 6) * 128 + half * 64; }
  else if (perm == 2) { if (n0 < 1024) np0 = n0; else { const int m = n0 - 1024, half = m >> 10, f = m & 1023; np0 = 1024 + (f >> 6) * 128 + half * 64; } }
  else np0 = n0;
  bf16_t* t16 = (bf16_t*)smem;
  f32x4 v[8];
#pragma unroll
  for (int i = 0; i < 8; ++i) {
    const int idx = tid + 256 * i; const int kr = idx >> 4, c4 = idx & 15;
    v[i] = (f32x4){0.f, 0.f, 0.f, 0.f};
    if (n0 + 4 * c4 < N && k0 + kr < K) v[i] = *(const f32x4*)(src + (size_t)(k0 + kr) * N + n0 + 4 * c4);
  }
#pragma unroll
  for (int i = 0; i < 8; ++i) {
    const int idx = tid + 256 * i; const int kr = idx >> 4, c4 = idx & 15;
    const float sc = (scale && k0 + kr < K) ? scale[k0 + kr] : 1.f;
#pragma unroll
    for (int j = 0; j < 4; ++j) t16[(4 * c4 + j) * 136 + kr] = f2bf(v[i][j] * sc);
  }
  __syncthreads();
#pragma unroll
  for (int i = 0; i < 4; ++i) {
    const int idx = tid + 256 * i; const int n = idx >> 4, ch = idx & 15;
    if (n0 + n < N && k0 + ch * 8 < K) *(uint4*)(dst + (size_t)(np0 + n) * K + k0 + ch * 8) = *(const uint4*)(t16 + n * 136 + ch * 8);
  }
  __syncthreads();
}

__device__ __forceinline__ void prep_modvec(CP& p, char* smem, int it) {
  const int tid = get_tid();
  const int layer = it / 384, rem = it - layer * 384, cb = rem >> 2, ks = rem & 3;
  float* s_lds = (float*)smem;
  float* red = (float*)(smem + 12288);
  const int kbase = ks * 256;
  for (int idx = tid; idx < 9 * 256; idx += 256) {
    const int r = idx >> 8, k = idx & 255;
    const float v = r < 8 ? p.c[r * 1024 + kbase + k] : p.c_ctx[kbase + k];
    s_lds[k * 12 + r] = v / (1.f + __expf(-v));
  }
  __syncthreads();
  const int col = cb * 64 + (tid & 63), kg = tid >> 6;
  const float* W = p.mod_w + (size_t)layer * 1024 * 6144 + (size_t)kbase * 6144 + col;
  float acc[9];
#pragma unroll
  for (int r = 0; r < 9; ++r) acc[r] = 0.f;
#pragma unroll
  for (int kb = 0; kb < 4; ++kb) {
    float w[16];
#pragma unroll
    for (int u = 0; u < 16; ++u) w[u] = W[(size_t)(kg * 64 + kb * 16 + u) * 6144];
#pragma unroll
    for (int u = 0; u < 16; ++u) {
      const int k = kg * 64 + kb * 16 + u;
      const f32x4 s0 = *(const f32x4*)(s_lds + k * 12), s1 = *(const f32x4*)(s_lds + k * 12 + 4);
      const float s2 = s_lds[k * 12 + 8];
      acc[0] += s0[0] * w[u]; acc[1] += s0[1] * w[u]; acc[2] += s0[2] * w[u]; acc[3] += s0[3] * w[u];
      acc[4] += s1[0] * w[u]; acc[5] += s1[1] * w[u]; acc[6] += s1[2] * w[u]; acc[7] += s1[3] * w[u];
      acc[8] += s2 * w[u];
    }
  }
#pragma unroll
  for (int r = 0; r < 9; ++r) red[(kg * 9 + r) * 64 + (tid & 63)] = acc[r];
  __syncthreads();
  for (int o = tid; o < 9 * 64; o += 256) {
    const int r = o >> 6, cl = o & 63;
    const float sm = red[(0 * 9 + r) * 64 + cl] + red[(1 * 9 + r) * 64 + cl] + red[(2 * 9 + r) * 64 + cl] + red[(3 * 9 + r) * 64 + cl];
    p.modp[(size_t)ks * 110592 + (size_t)(layer * 9 + r) * 6144 + cb * 64 + cl] = sm;
  }
  __syncthreads();
}

__device__ __forceinline__ void prep_filter(CP& p, char* smem, int it) {
  const int tid = get_tid();
  float* z = (float*)smem;
  float* h1 = z + 8 * 33;
  float* h2 = h1 + 8 * 64;
  const int t0 = it * 8;
  for (int idx = tid; idx < 8 * 33; idx += 256) {
    const int pp = idx / 33, i = idx - pp * 33;
    const int t = t0 + pp;
    float v;
    if (i == 0) v = (float)t * (1.0f / 2047.0f);
    else {
      const int k = (i - 1) & 15;
      const float w = (6.283185307179586f * (float)t) / 2048.0f;
      const float f = 1e-4f + (float)k * ((15.0f - 1e-4f) / 15.0f);
      const float a = w * f;
      v = (i <= 16) ? __cosf(a) : -__sinf(a);
    }
    z[idx] = v;
  }
  __syncthreads();
  for (int idx = tid; idx < 8 * 64; idx += 256) {
    const int pp = idx >> 6, j = idx & 63;
    float s = p.f_b1[j];
#pragma unroll
    for (int i = 0; i < 33; ++i) s += z[pp * 33 + i] * p.f_w1[i * 64 + j];
    h1[idx] = __sinf(p.f_freq1[j] * s);
  }
  __syncthreads();
  for (int idx = tid; idx < 8 * 64; idx += 256) {
    const int pp = idx >> 6, j = idx & 63;
    float s = p.f_b2[j];
#pragma unroll 16
    for (int i = 0; i < 64; ++i) s += h1[pp * 64 + i] * p.f_w2[i * 64 + j];
    h2[idx] = __sinf(p.f_freq2[j] * s);
  }
  __syncthreads();
  for (int idx = tid; idx < 8 * 64; idx += 256) p.h2bf[(size_t)t0 * 64 + idx] = f2bf(h2[idx]);
  __syncthreads();
}

__device__ __forceinline__ void phase_prep(CP& p, char* smem) {
  const int total = 768 + 256 + 3048;
  for (int it = get_bid(); it < total; it += VGRID) {
    if (it < 768) prep_modvec(p, smem, it);
    else if (it < 1024) prep_filter(p, smem, it - 768);
    else prep_weight_tile(p, smem, it - 1024);
  }
}

template <bool PART>
__device__ __forceinline__ void normmod_row2(const float* __restrict__ src, const float* __restrict__ g, const float* __restrict__ sh, const float* __restrict__ sc, bf16_t* __restrict__ dst, int lane, const float* __restrict__ bsh = nullptr) {
  f32x4 v[2][4]; float ss0 = 0.f, ss1 = 0.f;
#pragma unroll
  for (int i = 0; i < 4; ++i) { v[0][i] = *(const f32x4*)(src + lane * 4 + 256 * i); v[1][i] = *(const f32x4*)(src + 1024 + lane * 4 + 256 * i); }
#pragma unroll
  for (int i = 0; i < 4; ++i) {
    ss0 += v[0][i][0] * v[0][i][0] + v[0][i][1] * v[0][i][1] + v[0][i][2] * v[0][i][2] + v[0][i][3] * v[0][i][3];
    ss1 += v[1][i][0] * v[1][i][0] + v[1][i][1] * v[1][i][1] + v[1][i][2] * v[1][i][2] + v[1][i][3] * v[1][i][3];
  }
  ss0 = wave_sum(ss0); ss1 = wave_sum(ss1);
  const float r0 = rsqrtf(ss0 * (1.0f / 1024.0f) + 1e-6f), r1 = rsqrtf(ss1 * (1.0f / 1024.0f) + 1e-6f);
#pragma unroll
  for (int i = 0; i < 4; ++i) {
    const int k = lane * 4 + 256 * i;
    const f32x4 g4 = *(const f32x4*)(g + k);
    f32x4 s4 = *(const f32x4*)(sh + k), c4 = *(const f32x4*)(sc + k);
    if (PART) {
#pragma unroll
      for (int q = 1; q < 4; ++q) { s4 += *(const f32x4*)(sh + (size_t)q * 110592 + k); c4 += *(const f32x4*)(sc + (size_t)q * 110592 + k); }
      s4 += *(const f32x4*)(bsh + k); c4 += *(const f32x4*)(bsh + 1024 + k);
    }
    float y[4], z[4];
#pragma unroll
    for (int j = 0; j < 4; ++j) { const float gm = g4[j] * (1.f + c4[j]); y[j] = (v[0][i][j] * r0) * gm + s4[j]; z[j] = (v[1][i][j] * r1) * gm + s4[j]; }
    uint2 u; u.x = pack2(y[0], y[1]); u.y = pack2(y[2], y[3]);
    *(uint2*)(dst + k) = u;
    u.x = pack2(z[0], z[1]); u.y = pack2(z[2], z[3]);
    *(uint2*)(dst + 1024 + k) = u;
  }
}

__device__ __forceinline__ void phase_normmod_kv(CP& p) {
  const int lane = get_tid() & 63, wv = get_tid() >> 6;
  const float* g = p.norm_mix_g;
  for (int idx = get_bid() * 256 + get_tid(); idx < 110592; idx += VGRID * 256) {
    const int lr = idx / 6144; const int n = idx - lr * 6144; const int layer = lr / 9;
    p.modv[idx] = p.modp[idx] + p.modp[110592 + idx] + p.modp[2 * 110592 + idx] + p.modp[3 * 110592 + idx] + p.mod_b[layer * 6144 + n];
  }
  for (int r = (get_bid() * 4 + wv) * 2; r < 18432; r += VGRID * 8) {
    const int b = r / 2304, pp = r - b * 2304;
    const float* src; const float* mv;
    if (pp < 256) { src = p.ctx + ((size_t)b * 256 + pp) * 1024; mv = p.modp + (size_t)8 * 6144; }
    else { src = p.x + ((size_t)b * 2048 + pp - 256) * 1024; mv = p.modp + (size_t)b * 6144; }
    normmod_row2<true>(src, g, mv, mv + 1024, p.hxc + (size_t)r * 1024, lane, p.mod_b);
  }
}
__device__ __forceinline__ void phase_normmod_x(CP& p, const float* g, int layer, int chunk) {
  const int lane = get_tid() & 63, wv = get_tid() >> 6;
  for (int r = (get_bid() * 4 + wv) * 2; r < 16384; r += VGRID * 8) {
    const int b = r >> 11;
    const float* mv = p.modv + (size_t)(layer * 9 + b) * 6144 + chunk * 1024;
    normmod_row2<false>(p.X + (size_t)r * 1024, g, mv, mv + 1024, p.hxc + (size_t)r * 1024, lane);
  }
}
__device__ __forceinline__ void phase_final_norm(CP& p) {
  const int lane = get_tid() & 63, wv = get_tid() >> 6;
  for (int r = get_bid() * 4 + wv; r < 16384; r += VGRID * 4) {
    float* row = p.X + (size_t)r * 1024;
    f32x4 v[4]; float ss = 0.f;
#pragma unroll
    for (int i = 0; i < 4; ++i) { v[i] = *(const f32x4*)(row + lane * 4 + 256 * i); ss += v[i][0] * v[i][0] + v[i][1] * v[i][1] + v[i][2] * v[i][2] + v[i][3] * v[i][3]; }
    ss = wave_sum(ss);
    const float rr = rsqrtf(ss * (1.0f / 1024.0f) + 1e-6f);
#pragma unroll
    for (int i = 0; i < 4; ++i) {
      const int k = lane * 4 + 256 * i;
      const f32x4 g4 = *(const f32x4*)(p.final_g + k);
      f32x4 o; o[0] = v[i][0] * rr * g4[0]; o[1] = v[i][1] * rr * g4[1]; o[2] = v[i][2] * rr * g4[2]; o[3] = v[i][3] * rr * g4[3];
      *(f32x4*)(row + k) = o;
    }
  }
}

__device__ __forceinline__ void phase_rowstat(CP& p) {
  const int lane = get_tid() & 63, wv = get_tid() >> 6;
  for (int r = get_bid() * 4 + wv; r < 18432; r += VGRID * 4) {
    const int b = r / 2304, pp = r - b * 2304;
    const bf16_t* kvr = p.kv + (size_t)r * 288;
    {
      const uint2 u = *(const uint2*)(kvr + lane * 4);
      const float a0 = bf2f((bf16_t)(u.x & 0xffff)), a1 = bf2f((bf16_t)(u.x >> 16)), a2 = bf2f((bf16_t)(u.y & 0xffff)), a3 = bf2f((bf16_t)(u.y >> 16));
      float ss = a0 * a0 + a1 * a1 + a2 * a2 + a3 * a3;
      ss = wave_sum(ss);
      if (lane == 0) p.rkv[r] = rsqrtf(ss * (1.0f / 256.0f) + 1e-6f);
    }
    {
      const int i = lane & 31;
      const float xv = bf2f(kvr[256 + i]);
      const float ov = __shfl_xor(xv, 8);
      float res = xv;
      if (pp >= 256) {
        const int t = pp - 256;
        const int quarter = i >> 3, idx = i & 7;
        const float pos = (quarter < 2) ? (float)(t >> 6) : (float)(t & 63);
        const float inv = exp2f(-(float)idx * (13.287712379549449f / 8.0f));
        const float ang = pos * inv;
        const float cs = __cosf(ang), sn = __sinf(ang);
        res = xv * cs + ((quarter & 1) ? ov : -ov) * sn;
      }
      if (lane < 32) p.kpe[(size_t)r * 32 + i] = f2bf(res);
    }
    if (pp >= 256) {
      const int xr = b * 2048 + pp - 256;
      const uint4 u = *(const uint4*)(p.cq + (size_t)xr * 512 + lane * 8);
      const unsigned uu[4] = {u.x, u.y, u.z, u.w};
      float ss = 0.f;
#pragma unroll
      for (int j = 0; j < 4; ++j) { const float a = bf2f((bf16_t)(uu[j] & 0xffff)), bb = bf2f((bf16_t)(uu[j] >> 16)); ss += a * a + bb * bb; }
      ss = wave_sum(ss);
      if (lane == 0) p.rq[xr] = rsqrtf(ss * (1.0f / 512.0f) + 1e-6f);
    }
  }
}

struct EpiStore {
  static constexpr int KIND = 0;
  bf16_t* out; int ld; int ostride; const float* rs;
  __device__ __forceinline__ void c4(int g, int rig, int col, f32x4 v) const {
    const size_t row = (size_t)g * ostride + rig;
    const float s = rs ? rs[row] : 1.f;
    uint2 u; u.x = pack2(v[0] * s, v[1] * s); u.y = pack2(v[2] * s, v[3] * s);
    *(uint2*)(out + row * ld + col) = u;
  }
};
struct EpiVt {
  static constexpr int KIND = 1;
  bf16_t* out; const float* rs;
  __device__ __forceinline__ void r4(int g, int rig, int col, f32x4 v) const {
    const size_t row = (size_t)g * 2304 + rig;
    const f32x4 s = *(const f32x4*)(rs + row);
    uint2 u; u.x = pack2(v[0] * s[0], v[1] * s[1]); u.y = pack2(v[2] * s[2], v[3] * s[3]);
    *(uint2*)(out + ((size_t)g * 1024 + col) * 2304 + rig) = u;
  }
};
struct EpiFilt {
  static constexpr int KIND = 1;
  bf16_t* Rf; const float* decay;
  __device__ __forceinline__ void r4(int g, int rig, int col, f32x4 v) const {
    const int c = col & 1023; const bool bwd = col >= 1024;
    const float dec = fabsf(decay[c]);
    bf16_t* rp = Rf + (size_t)c * 4096;
#pragma unroll
    for (int j = 0; j < 4; ++j) {
      const int t = rig + j;
      const float val = v[j] * __expf(-(float)t * (1.0f / 2047.0f) * dec);
      if (!bwd) rp[2048 - t] = f2bf(val);
      else if (t > 0) rp[2048 + t] = f2bf(val);
      else rp[0] = 0;
    }
  }
};
struct EpiResid {
  static constexpr int KIND = 0;
  float* X; const float* base; const float* gate; const float* bias;
  __device__ __forceinline__ void c4(int g, int rig, int col, f32x4 v) const {
    const size_t o = ((size_t)g * 2048 + rig) * 1024 + col;
    const f32x4 bs = *(const f32x4*)(base + o);
    const f32x4 gt = *(const f32x4*)(gate + (size_t)g * 6144 + col);
    f32x4 bi = {0.f, 0.f, 0.f, 0.f};
    if (bias) bi = *(const f32x4*)(bias + col);
    f32x4 r;
#pragma unroll
    for (int j = 0; j < 4; ++j) r[j] = bs[j] + gt[j] * (v[j] + bi[j]);
    *(f32x4*)(X + o) = r;
  }
};
template <int MODE>
struct EpiConv {
  static constexpr int KIND = 2;
  const float* cw; const float* cb; int NC; const float* pre_bias;
  bf16_t* o0; bf16_t* o1;
  __device__ __forceinline__ int norig(int nt, int cl) const {
    if (MODE == 0) return (cl >> 6) * 2816 + nt * 64 + (cl & 63);
    if (nt < 8) return nt * 128 + cl;
    return 1024 + (cl >> 6) * 1024 + (nt - 8) * 64 + (cl & 63);
  }
  __device__ __forceinline__ void finish(const float* Z, int g, int rig0, int nt) const {
    const int tid = get_tid();
    if (MODE == 0 || nt < 8) {
      const int f = tid & 63, q = tid >> 6;
      const int p0 = 1 + 32 * q, p1 = (p0 + 32 < 127) ? p0 + 32 : 127;
      if (MODE == 0) {
        typedef float f32x2 __attribute__((ext_vector_type(2)));
        const int f2 = (tid & 31) * 2, q8 = tid >> 5;
        const int q0 = 1 + 16 * q8, q1 = (q0 + 16 < 127) ? q0 + 16 : 127;
        const int na = norig(nt, f2), ng = norig(nt, 64 + f2);
        const f32x2 a0 = *(const f32x2*)(cw + na), a1 = *(const f32x2*)(cw + NC + na), a2 = *(const f32x2*)(cw + 2 * NC + na), ab = *(const f32x2*)(cb + na);
        const f32x2 g0 = *(const f32x2*)(cw + ng), g1 = *(const f32x2*)(cw + NC + ng), g2 = *(const f32x2*)(cw + 2 * NC + ng), gb = *(const f32x2*)(cb + ng);
        f32x2 am = *(const f32x2*)(Z + (q0 - 1) * 132 + f2), ac = *(const f32x2*)(Z + q0 * 132 + f2);
        f32x2 gm = *(const f32x2*)(Z + (q0 - 1) * 132 + 64 + f2), gc = *(const f32x2*)(Z + q0 * 132 + 64 + f2);
#pragma unroll 2
        for (int pl = q0; pl < q1; ++pl) {
          const f32x2 an = *(const f32x2*)(Z + (pl + 1) * 132 + f2), gn = *(const f32x2*)(Z + (pl + 1) * 132 + 64 + f2);
          const int pos = rig0 + pl;
          if (pos < 2048) {
            const f32x2 av = a0 * am + a1 * ac + a2 * an + ab;
            const f32x2 gv = g0 * gm + g1 * gc + g2 * gn + gb;
            const float s0 = av[0] * gv[0] * __builtin_amdgcn_rcpf(1.f + __expf(-gv[0]));
            const float s1 = av[1] * gv[1] * __builtin_amdgcn_rcpf(1.f + __expf(-gv[1]));
            *(unsigned*)(o0 + ((size_t)g * 2048 + pos) * 2816 + nt * 64 + f2) = pack2(s0, s1);
          }
          am = ac; ac = an; gm = gc; gc = gn;
        }
      } else {
#pragma unroll
        for (int fh = 0; fh < 2; ++fh) {
          const int cl = fh * 64 + f;
          const int na = norig(nt, cl);
          const float a0 = cw[na], a1 = cw[NC + na], a2 = cw[2 * NC + na], ab = cb[na];
          float am = Z[(p0 - 1) * 132 + cl], ac = Z[p0 * 132 + cl];
#pragma unroll 2
          for (int pl = p0; pl < p1; ++pl) {
            const float an = Z[(pl + 1) * 132 + cl];
            const int pos = rig0 + pl;
            if (pos < 2048) o0[((size_t)g * 2048 + pos) * 1024 + nt * 128 + cl] = f2bf(a0 * am + a1 * ac + a2 * an + ab);
            am = ac; ac = an;
          }
        }
      }
    } else {
      const int pl = tid & 127, fh = tid >> 7;
      const int pos = rig0 + pl;
      if (pl >= 1 && pl <= 126 && pos < 2048) {
        const int fb = nt - 8;
#pragma unroll 2
        for (int f = fh * 32; f < fh * 32 + 32; ++f) {
          const int na = norig(nt, f), nb = norig(nt, 64 + f);
          const float va = cw[na] * Z[(pl - 1) * 132 + f] + cw[NC + na] * Z[pl * 132 + f] + cw[2 * NC + na] * Z[(pl + 1) * 132 + f] + cb[na];
          const float vb = cw[nb] * Z[(pl - 1) * 132 + 64 + f] + cw[NC + nb] * Z[pl * 132 + 64 + f] + cw[2 * NC + nb] * Z[(pl + 1) * 132 + 64 + f] + cb[nb];
          o1[(size_t)(fb * 64 + f) * 16384 + g * 2048 + pos] = f2bf(va * vb);
        }
      }
    }
  }
};

#define GLDS16(gp, lp) __builtin_amdgcn_global_load_lds((const unsigned*)(gp), (__attribute__((address_space(3))) unsigned*)(lp), 16, 0, 0)

template <bool SWAP, class Epi>
__device__ __forceinline__ void gemm_job(char* smem, const bf16_t* __restrict__ A, int lda, const bf16_t* __restrict__ Bt, int K, int N,
                                         int tpg, int a_gstride, int a_goff, int step, int halo, int grows, int MTS, int voff, int vid0, int grid, const Epi& epi) {
  const int tid = get_tid512(), lane = tid & 63, wid = tid >> 6, wr = wid >> 1, wc = wid & 1, fr = lane & 15, fq = lane >> 4;
  const int NT = (N + 255) >> 8, MT = MTS >> 1, ntiles = MT * NT, ns = K >> 6;
  const int full = MT >> 3;
  int v = vid0;
  if (v < voff) v += ((voff - v + grid - 1) / grid) * grid;
  const int swz = (fr >> 1) & 7;
  for (; v < voff + ntiles; v += grid) {
    const int w = v - voff;
    int mt, nt;
    if (w < full * 8 * NT) { const int sr = w / (8 * NT), rem = w - sr * 8 * NT; nt = rem >> 3; mt = sr * 8 + (rem & 7); }
    else { const int w2 = w - full * 8 * NT, rl = MT - full * 8; nt = w2 / rl; mt = full * 8 + (w2 - nt * rl); }
    unsigned ap[4], bp[4];
#pragma unroll
    for (int i = 0; i < 4; ++i) {
      const int r = (tid >> 3) + 64 * i;
      const int cs = tid & 7;
      const int c = ((cs ^ ((r >> 1) & 7)) << 3);
      const int sub = 2 * mt + (r >> 7);
      const int g = sub / tpg, ti = sub - g * tpg;
      int rig = ti * step - halo + (r & 127); rig = rig < 0 ? 0 : (rig > grows - 1 ? grows - 1 : rig);
      ap[i] = (unsigned)((g * a_gstride + a_goff + rig) * lda + c);
      int br = nt * 256 + r; br = br > N - 1 ? N - 1 : br;
      bp[i] = (unsigned)(br * K + c);
    }
    f32x4 acc[4][8];
#pragma unroll
    for (int m = 0; m < 4; ++m)
#pragma unroll
      for (int n = 0; n < 8; ++n) acc[m][n] = (f32x4){0.f, 0.f, 0.f, 0.f};
#pragma unroll
    for (int i = 0; i < 4; ++i) { GLDS16(A + (size_t)ap[i], smem + tid * 16 + i * 8192); GLDS16(Bt + (size_t)bp[i], smem + 32768 + tid * 16 + i * 8192); }
    for (int st = 0; st < ns; ++st) {
      asm volatile("s_waitcnt vmcnt(0)" ::: "memory");
      __builtin_amdgcn_s_barrier();
      asm volatile("" ::: "memory");
      if (st + 1 < ns) {
        char* nb = smem + ((st + 1) & 1) * 65536;
        const int ko = (st + 1) * 64;
#pragma unroll
        for (int i = 0; i < 4; ++i) { GLDS16(A + (size_t)(ap[i] + ko), nb + tid * 16 + i * 8192); GLDS16(Bt + (size_t)(bp[i] + ko), nb + 32768 + tid * 16 + i * 8192); }
      }
      const char* sa = smem + (st & 1) * 65536 + (wr * 64 + fr) * 128;
      const char* sb = smem + (st & 1) * 65536 + 32768 + (wc * 128 + fr) * 128;
      bf16x8 afA[4], afB[4], bfb[2][2];
#pragma unroll
      for (int m = 0; m < 4; ++m) afA[m] = *(const bf16x8*)(sa + m * 2048 + ((fq ^ swz) << 4));
#pragma unroll
      for (int n = 0; n < 2; ++n) bfb[0][n] = *(const bf16x8*)(sb + n * 2048 + ((fq ^ swz) << 4));
#pragma unroll
      for (int gq = 0; gq < 8; ++gq) {
        const int ks = gq >> 2, nh = gq & 3;
        if (gq < 7) {
          const int ks2 = (gq + 1) >> 2, nh2 = (gq + 1) & 3;
#pragma unroll
          for (int n = 0; n < 2; ++n) bfb[(gq + 1) & 1][n] = *(const bf16x8*)(sb + (nh2 * 2 + n) * 2048 + (((ks2 * 4 + fq) ^ swz) << 4));
        }
        if (gq == 3) {
#pragma unroll
          for (int m = 0; m < 4; ++m) afB[m] = *(const bf16x8*)(sa + m * 2048 + (((4 + fq) ^ swz) << 4));
        }
        __builtin_amdgcn_sched_barrier(0);
#pragma unroll
        for (int m = 0; m < 4; ++m)
#pragma unroll
          for (int n = 0; n < 2; ++n) {
            const bf16x8 av = ks ? afB[m] : afA[m];
            acc[m][nh * 2 + n] = SWAP ? __builtin_amdgcn_mfma_f32_16x16x32_bf16(bfb[gq & 1][n], av, acc[m][nh * 2 + n], 0, 0, 0)
                                      : __builtin_amdgcn_mfma_f32_16x16x32_bf16(av, bfb[gq & 1][n], acc[m][nh * 2 + n], 0, 0, 0);
          }
      }
    }
    __syncthreads();
    const int te = get_tid512();
    const int fr_e = te & 15, fq_e = (te & 63) >> 4, wr_e = te >> 7, wc_e = (te >> 6) & 1;
    const int sub = 2 * mt + (wr_e >> 1);
    const int g = sub / tpg, ti = sub - g * tpg;
    const int rig0 = ti * step - halo;
    const int rw = (wr_e & 1) * 64;
    if constexpr (Epi::KIND == 0) {
#pragma unroll
      for (int m = 0; m < 4; ++m) {
        const int rig = rig0 + rw + m * 16 + fr_e;
#pragma unroll
        for (int n = 0; n < 8; ++n) {
          const int col = nt * 256 + wc_e * 128 + n * 16 + fq_e * 4;
          if (col < N) epi.c4(g, rig, col, acc[m][n]);
        }
      }
    } else if constexpr (Epi::KIND == 1) {
#pragma unroll
      for (int m = 0; m < 4; ++m) {
        const int rig = rig0 + rw + m * 16 + fq_e * 4;
#pragma unroll
        for (int n = 0; n < 8; ++n) {
          const int col = nt * 256 + wc_e * 128 + n * 16 + fr_e;
          if (col < N) epi.r4(g, rig, col, acc[m][n]);
        }
      }
    } else {
      float* Z = (float*)smem + (wr_e >> 1) * (128 * 132);
#pragma unroll
      for (int h = 0; h < 2; ++h) {
        const int nt2 = nt * 2 + h;
        if (wc_e == h) {
#pragma unroll
          for (int n = 0; n < 8; ++n) {
            const int cl = n * 16 + fq_e * 4;
            f32x4 b4 = {0.f, 0.f, 0.f, 0.f};
            if (epi.pre_bias) b4 = *(const f32x4*)(epi.pre_bias + epi.norig(nt2, cl));
#pragma unroll
            for (int m = 0; m < 4; ++m) {
              const int rl = rw + m * 16 + fr_e;
              const int pos = rig0 + rl;
              const bool ok = pos >= 0 && pos < grows;
              f32x4 vv = acc[m][n] + b4;
              if (!ok) vv = (f32x4){0.f, 0.f, 0.f, 0.f};
              *(f32x4*)(Z + rl * 132 + cl) = vv;
            }
          }
        }
        __syncthreads();
        epi.finish(Z, g, rig0, nt2);
        __syncthreads();
      }
    }
    asm volatile("s_waitcnt vmcnt(0)" ::: "memory");
    __syncthreads();
  }
}

__device__ __forceinline__ void phase_attn(CP& p, char* smem, int vid0, int grid) {
  bf16_t* Ks = (bf16_t*)smem;
  bf16_t* Vs = (bf16_t*)(smem + 64 * 104 * 2);
  const int tid = get_tid(), lane = tid & 63, w = tid >> 6, r = lane & 31, hh = lane >> 5;
  const float cs = 1.4426950408889634f * 0.10206207261596577f;
  for (int it = vid0; it < 2048; it += grid) {
    const int qt = it & 15, h = (it >> 4) & 15, b = it >> 8;
    const int t = qt * 128 + w * 32 + r;
    const size_t xrow = (size_t)b * 2048 + t;
    const bf16_t* qp = p.Q + xrow * 1536 + h * 96;
    bf16x8 qf[6];
#pragma unroll
    for (int kk = 0; kk < 4; ++kk) qf[kk] = *(const bf16x8*)(qp + 16 * kk + 8 * hh);
#pragma unroll
    for (int part = 0; part < 2; ++part) {
      const bf16_t* pp = qp + 64 + 16 * part;
      const bf16x8 mine = *(const bf16x8*)(pp + 8 * hh), oth = *(const bf16x8*)(pp + 8 * (1 - hh));
      const float posf = part == 0 ? (float)(t >> 6) : (float)(t & 63);
      union { unsigned u[4]; bf16x8 v; } o;
      float res[8];
#pragma unroll
      for (int j = 0; j < 8; ++j) {
        const float inv = exp2f(-(float)j * (13.287712379549449f / 8.0f));
        const float ang = posf * inv;
        const float c = __cosf(ang), s = __sinf(ang);
        const float m = bf2f((bf16_t)mine[j]), ov = bf2f((bf16_t)oth[j]);
        res[j] = m * c + (hh ? ov : -ov) * s;
      }
#pragma unroll
      for (int j = 0; j < 4; ++j) o.u[j] = pack2(res[2 * j], res[2 * j + 1]);
      qf[4 + part] = o.v;
    }
    f32x16 oacc[2];
#pragma unroll
    for (int i = 0; i < 16; ++i) { oacc[0][i] = 0.f; oacc[1][i] = 0.f; }
    float mrun = -INFINITY, lrun = 0.f;
    const size_t kvrow0 = (size_t)b * 2304;
    const bf16_t* kn_base = p.Kn + kvrow0 * 1024 + h * 64;
    const bf16_t* kpe_base = p.kpe + kvrow0 * 32;
    const bf16_t* vt_base = p.Vt + ((size_t)(b * 16 + h) * 64) * 2304;
    uint4 rk0, rk1, rp, rv0, rv1;
    const int srow = tid >> 3, sch = tid & 7;
#define ATT_GLOAD(kt) do { \
      rk0 = *(const uint4*)(kn_base + (size_t)((kt) * 64 + srow) * 1024 + sch * 8); \
      rk1 = *(const uint4*)(kn_base + (size_t)((kt) * 64 + srow + 32) * 1024 + sch * 8); \
      rv0 = *(const uint4*)(vt_base + (size_t)srow * 2304 + (kt) * 64 + sch * 8); \
      rv1 = *(const uint4*)(vt_base + (size_t)(srow + 32) * 2304 + (kt) * 64 + sch * 8); \
      rp = *(const uint4*)(kpe_base + (size_t)((kt) * 64 + (tid >> 2)) * 32 + (tid & 3) * 8); } while (0)
    ATT_GLOAD(0);
    for (int kt = 0; kt < 36; ++kt) {
      __syncthreads();
      {
        *(uint4*)(Ks + srow * 104 + sch * 8) = rk0;
        *(uint4*)(Ks + (srow + 32) * 104 + sch * 8) = rk1;
        uint2 lo, hi;
        lo.x = rv0.x; lo.y = rv0.y; hi.x = rv0.z; hi.y = rv0.w;
        *(uint2*)(Vs + srow * 68 + sch * 8) = lo; *(uint2*)(Vs + srow * 68 + sch * 8 + 4) = hi;
        lo.x = rv1.x; lo.y = rv1.y; hi.x = rv1.z; hi.y = rv1.w;
        *(uint2*)(Vs + (srow + 32) * 68 + sch * 8) = lo; *(uint2*)(Vs + (srow + 32) * 68 + sch * 8 + 4) = hi;
      }
      *(uint4*)(Ks + (tid >> 2) * 104 + 64 + (tid & 3) * 8) = rp;
      __syncthreads();
      if (kt + 1 < 36) ATT_GLOAD(kt + 1);
      f32x16 s[2];
#pragma unroll
      for (int t2 = 0; t2 < 2; ++t2) {
#pragma unroll
        for (int i = 0; i < 16; ++i) s[t2][i] = 0.f;
#pragma unroll
        for (int kk = 0; kk < 6; ++kk) {
          const bf16x8 a = *(const bf16x8*)(Ks + (32 * t2 + r) * 104 + 16 * kk + 8 * hh);
          s[t2] = __builtin_amdgcn_mfma_f32_32x32x16_bf16(a, qf[kk], s[t2], 0, 0, 0);
        }
      }
      float mx = s[0][0];
#pragma unroll
      for (int i = 1; i < 16; ++i) mx = fmaxf(mx, s[0][i]);
#pragma unroll
      for (int i = 0; i < 16; ++i) mx = fmaxf(mx, s[1][i]);
      mx = fmaxf(mx, __shfl_xor(mx, 32));
      const float mnew = fmaxf(mrun, mx * cs);
      const float alpha = __builtin_amdgcn_exp2f(mrun - mnew);
      mrun = mnew;
      float psum = 0.f;
      bf16x8 pf[4];
#pragma unroll
      for (int t2 = 0; t2 < 2; ++t2)
#pragma unroll
        for (int hf = 0; hf < 2; ++hf) {
          union { unsigned u[4]; bf16x8 v; } cvp;
#pragma unroll
          for (int i = 0; i < 4; ++i) {
            const float p0 = __builtin_amdgcn_exp2f(s[t2][hf * 8 + 2 * i] * cs - mnew);
            const float p1 = __builtin_amdgcn_exp2f(s[t2][hf * 8 + 2 * i + 1] * cs - mnew);
            psum += p0 + p1;
            cvp.u[i] = pack2(p0, p1);
          }
          pf[t2 * 2 + hf] = cvp.v;
        }
      lrun = lrun * alpha + psum;
#pragma unroll
      for (int i = 0; i < 16; ++i) { oacc[0][i] *= alpha; oacc[1][i] *= alpha; }
#pragma unroll
      for (int dt = 0; dt < 2; ++dt)
#pragma unroll
        for (int s4 = 0; s4 < 4; ++s4) {
          const bf16_t* vp = Vs + (32 * dt + r) * 68 + 16 * s4 + 4 * hh;
          const uint2 lo = *(const uint2*)vp, hi = *(const uint2*)(vp + 8);
          union { uint4 u; bf16x8 v; } cv; cv.u.x = lo.x; cv.u.y = lo.y; cv.u.z = hi.x; cv.u.w = hi.y;
          oacc[dt] = __builtin_amdgcn_mfma_f32_32x32x16_bf16(cv.v, pf[s4], oacc[dt], 0, 0, 0);
        }
    }
    const float ltot = lrun + __shfl_xor(lrun, 32);
    const float inv = 1.f / ltot;
    bf16_t* op = p.hxc + xrow * 1024 + h * 64;
#pragma unroll
    for (int dt = 0; dt < 2; ++dt)
#pragma unroll
      for (int i4 = 0; i4 < 4; ++i4) {
        const int d = 32 * dt + 8 * i4 + 4 * hh;
        uint2 u; u.x = pack2(oacc[dt][4 * i4] * inv, oacc[dt][4 * i4 + 1] * inv); u.y = pack2(oacc[dt][4 * i4 + 2] * inv, oacc[dt][4 * i4 + 3] * inv);
        *(uint2*)(op + d) = u;
      }
  }
}

__device__ __forceinline__ void phase_hyconv(CP& p, char* smem) {
  bf16_t* cp = (bf16_t*)smem;
  bf16_t* Vl = (bf16_t*)(smem + 4 * 8256);
  const int tid = get_tid(), lane = tid & 63, w = tid >> 6, i16 = lane & 15, g4 = lane >> 4;
  const int si = (-i16) & 3;
  const int ocb = 64 * w;
  for (int c = get_bid(); c < 1024; c += VGRID) {
    __syncthreads();
#pragma unroll
    for (int i = 0; i < 2; ++i) { const int ch = tid + 256 * i; *(uint4*)(cp + ch * 8) = *(const uint4*)(p.Rf + (size_t)c * 4096 + ch * 8); }
#pragma unroll
    for (int i = 0; i < 8; ++i) {
      const int q = tid + 256 * i; const int b = q >> 8, l8 = q & 255; const int m1 = l8 >> 3, m2 = (l8 & 7) * 8;
      *(uint4*)(Vl + (8 + m1 * 8 + b) * 80 + m2) = *(const uint4*)(p.vvT + (size_t)c * 16384 + b * 2048 + l8 * 8);
    }
    if (tid < 144) {
      const int colp = tid / 9, part = tid - colp * 9;
      const int col = colp < 8 ? colp : 256 + colp;
      uint4 zz; zz.x = 0; zz.y = 0; zz.z = 0; zz.w = 0;
      *(uint4*)(Vl + col * 80 + part * 8) = zz;
    }
    __syncthreads();
#pragma unroll
    for (int s = 1; s < 4; ++s)
#pragma unroll
      for (int i = 0; i < 2; ++i) {
        const int ch = tid + 256 * i;
        unsigned e[8];
#pragma unroll
        for (int j = 0; j < 8; ++j) { const int idx = 8 * ch + s + j; e[j] = idx < 4096 ? (unsigned)cp[idx] : 0u; }
        uint4 u; u.x = e[0] | (e[1] << 16); u.y = e[2] | (e[3] << 16); u.z = e[4] | (e[5] << 16); u.w = e[6] | (e[7] << 16);
        *(uint4*)(cp + s * 4128 + 8 * ch) = u;
      }
    __syncthreads();
    const bf16_t* abase = cp + si * 4128 + (2048 - i16 - si + 8 * g4);
    f32x4 acc[4][4];
#pragma unroll
    for (int m = 0; m < 4; ++m)
#pragma unroll
      for (int n = 0; n < 4; ++n) acc[m][n] = (f32x4){0.f, 0.f, 0.f, 0.f};
    for (int dl = -31; dl <= 31; ++dl) {
      bf16x8 af[4][2];
#pragma unroll
      for (int mt = 0; mt < 4; ++mt)
#pragma unroll
        for (int kk = 0; kk < 2; ++kk) {
          const bf16_t* ap = abase - 64 * dl - 16 * mt + 32 * kk;
          const uint2 lo = *(const uint2*)ap, hi = *(const uint2*)(ap + 4);
          union { uint4 u; bf16x8 v; } cv; cv.u.x = lo.x; cv.u.y = lo.y; cv.u.z = hi.x; cv.u.w = hi.y;
          af[mt][kk] = cv.v;
        }
#pragma unroll
      for (int jt = 0; jt < 4; ++jt) {
        const int in0 = ocb + 16 * jt - 8 * dl;
        if (in0 >= -8 && in0 <= 248) {
          const bf16_t* bp = Vl + (in0 + 8 + i16) * 80 + 8 * g4;
          const bf16x8 b0 = *(const bf16x8*)bp, b1 = *(const bf16x8*)(bp + 32);
#pragma unroll
          for (int mt = 0; mt < 4; ++mt) {
            acc[mt][jt] = __builtin_amdgcn_mfma_f32_16x16x32_bf16(af[mt][0], b0, acc[mt][jt], 0, 0, 0);
            acc[mt][jt] = __builtin_amdgcn_mfma_f32_16x16x32_bf16(af[mt][1], b1, acc[mt][jt], 0, 0, 0);
          }
        }
      }
    }
    const float db = p.hy_d_bias[c];
#pragma unroll
    for (int mt = 0; mt < 4; ++mt)
#pragma unroll
      for (int jt = 0; jt < 4; ++jt) {
        const int col = ocb + 16 * jt + i16;
        const int n1 = col >> 3, b = col & 7;
        const int n2 = 16 * mt + 4 * g4;
        const uint2 vv = *(const uint2*)(Vl + (col + 8) * 80 + n2);
        const float y0 = acc[mt][jt][0] + bf2f((bf16_t)(vv.x & 0xffff)) * db;
        const float y1 = acc[mt][jt][1] + bf2f((bf16_t)(vv.x >> 16)) * db;
        const float y2 = acc[mt][jt][2] + bf2f((bf16_t)(vv.y & 0xffff)) * db;
        const float y3 = acc[mt][jt][3] + bf2f((bf16_t)(vv.y >> 16)) * db;
        uint2 u; u.x = pack2(y0, y1); u.y = pack2(y2, y3);
        *(uint2*)(p.Yp + (size_t)c * 16384 + b * 2048 + n1 * 64 + n2) = u;
      }
  }
}

__device__ __forceinline__ void phase_transmul(CP& p, char* smem) {
  bf16_t* tl = (bf16_t*)smem;
  const int tid = get_tid();
  for (int it = get_bid(); it < 4096; it += VGRID) {
    const int ct = it & 15, rt = it >> 4;
    const int c0 = ct * 64, r0 = rt * 64;
    __syncthreads();
#pragma unroll
    for (int i = 0; i < 2; ++i) {
      const int ci = tid + 256 * i; const int cc = ci >> 3, ch = ci & 7;
      const uint4 u = *(const uint4*)(p.Yp + (size_t)(c0 + cc) * 16384 + r0 + ch * 8);
      unsigned* d = (unsigned*)(tl + cc * 66 + ch * 8);
      d[0] = u.x; d[1] = u.y; d[2] = u.z; d[3] = u.w;
    }
    __syncthreads();
    const int row = tid >> 2, cq = tid & 3;
    const bf16_t* xp = p.x1h + (size_t)(r0 + row) * 1024 + c0 + cq * 16;
    const uint4 xa = *(const uint4*)xp, xb = *(const uint4*)(xp + 8);
    const unsigned xs[8] = {xa.x, xa.y, xa.z, xa.w, xb.x, xb.y, xb.z, xb.w};
    unsigned o[8];
#pragma unroll
    for (int j = 0; j < 8; ++j) {
      const float y0 = bf2f(tl[(cq * 16 + 2 * j) * 66 + row]) * bf2f((bf16_t)(xs[j] & 0xffff));
      const float y1 = bf2f(tl[(cq * 16 + 2 * j + 1) * 66 + row]) * bf2f((bf16_t)(xs[j] >> 16));
      o[j] = pack2(y0, y1);
    }
    bf16_t* op = p.hxc + (size_t)(r0 + row) * 1024 + c0 + cq * 16;
    uint4 oa; oa.x = o[0]; oa.y = o[1]; oa.z = o[2]; oa.w = o[3];
    uint4 ob; ob.x = o[4]; ob.y = o[5]; ob.z = o[6]; ob.w = o[7];
    *(uint4*)op = oa; *(uint4*)(op + 8) = ob;
  }
}

__global__ void __launch_bounds__(512, 2) mega(P p_arg) {
  __shared__ __attribute__((aligned(16))) char smem[LDS_BYTES];
  cg::grid_group grid = cg::this_grid();
  const int G = gridDim.x;
  CP* pp = (CP*)__builtin_amdgcn_kernarg_segment_ptr();
  const int ph0 = pp->ph0, ph1 = pp->ph1;
  volatile LAS unsigned* xst = (volatile LAS unsigned*)(smem + LDS_BYTES - 16);
  if (threadIdx.x == 0) { xst[0] = 0u; xst[1] = 0u; }
  __syncthreads();
  const XcdBarrier xb = xcd_barrier_post(pp->bar, xst);
  if (ph0 <= 0 && 0 < ph1) {
    asm volatile("" : "+s"(pp));
    CP& p = *pp;
    const int bid = get_rbid();
    const int vid0 = (G & 7) ? bid : ((bid & 7) * (G >> 3) + (bid >> 3));
    const int hb = get_hb();
    char* smem_h = smem + hb * HALF_LDS; (void)smem_h;
    const float* mv0 = p.modv; const float* mv1 = p.modv + (size_t)9 * 6144;
    (void)mv0; (void)mv1; (void)vid0;
    phase_prep(p, smem_h);
    if (0 + 1 < ph1) { if (ph1 > 1000) grid.sync(); else xcd_barrier(xb); }
  }
  if (ph0 <= 1 && 1 < ph1) {
    asm volatile("" : "+s"(pp));
    CP& p = *pp;
    const int bid = get_rbid();
    const int vid0 = (G & 7) ? bid : ((bid & 7) * (G >> 3) + (bid >> 3));
    const int hb = get_hb();
    char* smem_h = smem + hb * HALF_LDS; (void)smem_h;
    const float* mv0 = p.modv; const float* mv1 = p.modv + (size_t)9 * 6144;
    (void)mv0; (void)mv1; (void)vid0;
    phase_normmod_kv(p);
    if (1 + 1 < ph1) { if (ph1 > 1000) grid.sync(); else xcd_barrier(xb); }
  }
  if (ph0 <= 2 && 2 < ph1) {
    asm volatile("" : "+s"(pp));
    CP& p = *pp;
    const int bid = get_rbid();
    const int vid0 = (G & 7) ? bid : ((bid & 7) * (G >> 3) + (bid >> 3));
    const int hb = get_hb();
    char* smem_h = smem + hb * HALF_LDS; (void)smem_h;
    const float* mv0 = p.modv; const float* mv1 = p.modv + (size_t)9 * 6144;
    (void)mv0; (void)mv1; (void)vid0;
    {
        EpiStore e1{p.cq, 512, 2048, nullptr};
        gemm_job<true>(smem, p.hxc, 1024, p.wt_dq, 1024, 512, 16, 2304, 256, 128, 0, 2048, 128, 0, vid0, G, e1);
        EpiStore e2{p.kv, 288, 2304, nullptr};
        gemm_job<true>(smem, p.hxc, 1024, p.wt_dkv, 1024, 288, 18, 2304, 0, 128, 0, 2304, 144, 64 * 2, vid0, G, e2);
        EpiFilt e3{p.Rf, p.hy_decay};
        gemm_job<false>(smem, p.h2bf, 64, p.wt_f3, 64, 2048, 16, 0, 0, 128, 0, 2048, 16, 64 * 2 + 72 * 2, vid0, G, e3);
      }
    if (2 + 1 < ph1) { if (ph1 > 1000) grid.sync(); else xcd_barrier(xb); }
  }
  if (ph0 <= 3 && 3 < ph1) {
    asm volatile("" : "+s"(pp));
    CP& p = *pp;
    const int bid = get_rbid();
    const int vid0 = (G & 7) ? bid : ((bid & 7) * (G >> 3) + (bid >> 3));
    const int hb = get_hb();
    char* smem_h = smem + hb * HALF_LDS; (void)smem_h;
    const float* mv0 = p.modv; const float* mv1 = p.modv + (size_t)9 * 6144;
    (void)mv0; (void)mv1; (void)vid0;
    phase_rowstat(p);
    if (3 + 1 < ph1) { if (ph1 > 1000) grid.sync(); else xcd_barrier(xb); }
  }
  if (ph0 <= 4 && 4 < ph1) {
    asm volatile("" : "+s"(pp));
    CP& p = *pp;
    const int bid = get_rbid();
    const int vid0 = (G & 7) ? bid : ((bid & 7) * (G >> 3) + (bid >> 3));
    const int hb = get_hb();
    char* smem_h = smem + hb * HALF_LDS; (void)smem_h;
    const float* mv0 = p.modv; const float* mv1 = p.modv + (size_t)9 * 6144;
    (void)mv0; (void)mv1; (void)vid0;
    {
        EpiStore e1{p.Q, 1536, 2048, p.rq};
        gemm_job<true>(smem, p.cq, 512, p.wt_uq, 512, 1536, 16, 2048, 0, 128, 0, 2048, 128, 0, vid0, G, e1);
        EpiStore e2{p.Kn, 1024, 2304, p.rkv};
        gemm_job<true>(smem, p.kv, 288, p.wt_uk, 256, 1024, 18, 2304, 0, 128, 0, 2304, 144, 64 * 6, vid0, G, e2);
        EpiVt e3{p.Vt, p.rkv};
        gemm_job<false>(smem, p.kv, 288, p.wt_uv, 256, 1024, 18, 2304, 0, 128, 0, 2304, 144, 64 * 6 + 72 * 4, vid0, G, e3);
      }
    if (4 + 1 < ph1) { if (ph1 > 1000) grid.sync(); else xcd_barrier(xb); }
  }
  if (ph0 <= 5 && 5 < ph1) {
    asm volatile("" : "+s"(pp));
    CP& p = *pp;
    const int bid = get_rbid();
    const int vid0 = (G & 7) ? bid : ((bid & 7) * (G >> 3) + (bid >> 3));
    const int hb = get_hb();
    char* smem_h = smem + hb * HALF_LDS; (void)smem_h;
    const float* mv0 = p.modv; const float* mv1 = p.modv + (size_t)9 * 6144;
    (void)mv0; (void)mv1; (void)vid0;
    phase_attn(p, smem_h, 2 * vid0 + hb, 2 * G);
    if (5 + 1 < ph1) { if (ph1 > 1000) grid.sync(); else xcd_barrier(xb); }
  }
  if (ph0 <= 6 && 6 < ph1) {
    asm volatile("" : "+s"(pp));
    CP& p = *pp;
    const int bid = get_rbid();
    const int vid0 = (G & 7) ? bid : ((bid & 7) * (G >> 3) + (bid >> 3));
    const int hb = get_hb();
    char* smem_h = smem + hb * HALF_LDS; (void)smem_h;
    const float* mv0 = p.modv; const float* mv1 = p.modv + (size_t)9 * 6144;
    (void)mv0; (void)mv1; (void)vid0;
    {
        EpiResid e{p.X, p.x, mv0 + 2 * 1024, nullptr};
        gemm_job<true>(smem, p.hxc, 1024, p.wt_o, 1024, 1024, 16, 2048, 0, 128, 0, 2048, 128, 0, vid0, G, e);
      }
    if (6 + 1 < ph1) { if (ph1 > 1000) grid.sync(); else xcd_barrier(xb); }
  }
  if (ph0 <= 7 && 7 < ph1) {
    asm volatile("" : "+s"(pp));
    CP& p = *pp;
    const int bid = get_rbid();
    const int vid0 = (G & 7) ? bid : ((bid & 7) * (G >> 3) + (bid >> 3));
    const int hb = get_hb();
    char* smem_h = smem + hb * HALF_LDS; (void)smem_h;
    const float* mv0 = p.modv; const float* mv1 = p.modv + (size_t)9 * 6144;
    (void)mv0; (void)mv1; (void)vid0;
    phase_normmod_x(p, p.norm_ffn_g, 0, 3);
    if (7 + 1 < ph1) { if (ph1 > 1000) grid.sync(); else xcd_barrier(xb); }
  }
  if (ph0 <= 8 && 8 < ph1) {
    asm volatile("" : "+s"(pp));
    CP& p = *pp;
    const int bid = get_rbid();
    const int vid0 = (G & 7) ? bid : ((bid & 7) * (G >> 3) + (bid >> 3));
    const int hb = get_hb();
    char* smem_h = smem + hb * HALF_LDS; (void)smem_h;
    const float* mv0 = p.modv; const float* mv1 = p.modv + (size_t)9 * 6144;
    (void)mv0; (void)mv1; (void)vid0;
    {
        EpiConv<0> e{p.ffn_conv_w, p.ffn_conv_b, 5632, nullptr, p.act, nullptr};
        gemm_job<true>(smem, p.hxc, 1024, p.wt_up0, 1024, 5632, 17, 2048, 0, 126, 1, 2048, 136, 0, vid0, G, e);
      }
    if (8 + 1 < ph1) { if (ph1 > 1000) grid.sync(); else xcd_barrier(xb); }
  }
  if (ph0 <= 9 && 9 < ph1) {
    asm volatile("" : "+s"(pp));
    CP& p = *pp;
    const int bid = get_rbid();
    const int vid0 = (G & 7) ? bid : ((bid & 7) * (G >> 3) + (bid >> 3));
    const int hb = get_hb();
    char* smem_h = smem + hb * HALF_LDS; (void)smem_h;
    const float* mv0 = p.modv; const float* mv1 = p.modv + (size_t)9 * 6144;
    (void)mv0; (void)mv1; (void)vid0;
    {
        EpiResid e{p.X, p.X, mv0 + 5 * 1024, nullptr};
        gemm_job<true>(smem, p.act, 2816, p.wt_dn0, 2816, 1024, 16, 2048, 0, 128, 0, 2048, 128, 0, vid0, G, e);
      }
    if (9 + 1 < ph1) { if (ph1 > 1000) grid.sync(); else xcd_barrier(xb); }
  }
  if (ph0 <= 10 && 10 < ph1) {
    asm volatile("" : "+s"(pp));
    CP& p = *pp;
    const int bid = get_rbid();
    const int vid0 = (G & 7) ? bid : ((bid & 7) * (G >> 3) + (bid >> 3));
    const int hb = get_hb();
    char* smem_h = smem + hb * HALF_LDS; (void)smem_h;
    const float* mv0 = p.modv; const float* mv1 = p.modv + (size_t)9 * 6144;
    (void)mv0; (void)mv1; (void)vid0;
    phase_normmod_x(p, p.norm_mix_g + 1024, 1, 0);
    if (10 + 1 < ph1) { if (ph1 > 1000) grid.sync(); else xcd_barrier(xb); }
  }
  if (ph0 <= 11 && 11 < ph1) {
    asm volatile("" : "+s"(pp));
    CP& p = *pp;
    const int bid = get_rbid();
    const int vid0 = (G & 7) ? bid : ((bid & 7) * (G >> 3) + (bid >> 3));
    const int hb = get_hb();
    char* smem_h = smem + hb * HALF_LDS; (void)smem_h;
    const float* mv0 = p.modv; const float* mv1 = p.modv + (size_t)9 * 6144;
    (void)mv0; (void)mv1; (void)vid0;
    {
        EpiConv<1> e{p.hy_conv_w, p.hy_conv_b, 3072, p.hy_b_in, p.x1h, p.vvT};
        gemm_job<true>(smem, p.hxc, 1024, p.wt_hin, 1024, 3072, 17, 2048, 0, 126, 1, 2048, 136, 0, vid0, G, e);
      }
    if (11 + 1 < ph1) { if (ph1 > 1000) grid.sync(); else xcd_barrier(xb); }
  }
  if (ph0 <= 12 && 12 < ph1) {
    asm volatile("" : "+s"(pp));
    CP& p = *pp;
    const int bid = get_rbid();
    const int vid0 = (G & 7) ? bid : ((bid & 7) * (G >> 3) + (bid >> 3));
    const int hb = get_hb();
    char* smem_h = smem + hb * HALF_LDS; (void)smem_h;
    const float* mv0 = p.modv; const float* mv1 = p.modv + (size_t)9 * 6144;
    (void)mv0; (void)mv1; (void)vid0;
    phase_hyconv(p, smem_h);
    if (12 + 1 < ph1) { if (ph1 > 1000) grid.sync(); else xcd_barrier(xb); }
  }
  if (ph0 <= 13 && 13 < ph1) {
    asm volatile("" : "+s"(pp));
    CP& p = *pp;
    const int bid = get_rbid();
    const int vid0 = (G & 7) ? bid : ((bid & 7) * (G >> 3) + (bid >> 3));
    const int hb = get_hb();
    char* smem_h = smem + hb * HALF_LDS; (void)smem_h;
    const float* mv0 = p.modv; const float* mv1 = p.modv + (size_t)9 * 6144;
    (void)mv0; (void)mv1; (void)vid0;
    phase_transmul(p, smem_h);
    if (13 + 1 < ph1) { if (ph1 > 1000) grid.sync(); else xcd_barrier(xb); }
  }
  if (ph0 <= 14 && 14 < ph1) {
    asm volatile("" : "+s"(pp));
    CP& p = *pp;
    const int bid = get_rbid();
    const int vid0 = (G & 7) ? bid : ((bid & 7) * (G >> 3) + (bid >> 3));
    const int hb = get_hb();
    char* smem_h = smem + hb * HALF_LDS; (void)smem_h;
    const float* mv0 = p.modv; const float* mv1 = p.modv + (size_t)9 * 6144;
    (void)mv0; (void)mv1; (void)vid0;
    {
        EpiResid e{p.X, p.X, mv1 + 2 * 1024, p.hy_b_out};
        gemm_job<true>(smem, p.hxc, 1024, p.wt_hout, 1024, 1024, 16, 2048, 0, 128, 0, 2048, 128, 0, vid0, G, e);
      }
    if (14 + 1 < ph1) { if (ph1 > 1000) grid.sync(); else xcd_barrier(xb); }
  }
  if (ph0 <= 15 && 15 < ph1) {
    asm volatile("" : "+s"(pp));
    CP& p = *pp;
    const int bid = get_rbid();
    const int vid0 = (G & 7) ? bid : ((bid & 7) * (G >> 3) + (bid >> 3));
    const int hb = get_hb();
    char* smem_h = smem + hb * HALF_LDS; (void)smem_h;
    const float* mv0 = p.modv; const float* mv1 = p.modv + (size_t)9 * 6144;
    (void)mv0; (void)mv1; (void)vid0;
    phase_normmod_x(p, p.norm_ffn_g + 1024, 1, 3);
    if (15 + 1 < ph1) { if (ph1 > 1000) grid.sync(); else xcd_barrier(xb); }
  }
  if (ph0 <= 16 && 16 < ph1) {
    asm volatile("" : "+s"(pp));
    CP& p = *pp;
    const int bid = get_rbid();
    const int vid0 = (G & 7) ? bid : ((bid & 7) * (G >> 3) + (bid >> 3));
    const int hb = get_hb();
    char* smem_h = smem + hb * HALF_LDS; (void)smem_h;
    const float* mv0 = p.modv; const float* mv1 = p.modv + (size_t)9 * 6144;
    (void)mv0; (void)mv1; (void)vid0;
    {
        EpiConv<0> e{p.ffn_conv_w + (size_t)3 * 5632, p.ffn_conv_b + 5632, 5632, nullptr, p.act, nullptr};
        gemm_job<true>(smem, p.hxc, 1024, p.wt_up1, 1024, 5632, 17, 2048, 0, 126, 1, 2048, 136, 0, vid0, G, e);
      }
    if (16 + 1 < ph1) { if (ph1 > 1000) grid.sync(); else xcd_barrier(xb); }
  }
  if (ph0 <= 17 && 17 < ph1) {
    asm volatile("" : "+s"(pp));
    CP& p = *pp;
    const int bid = get_rbid();
    const int vid0 = (G & 7) ? bid : ((bid & 7) * (G >> 3) + (bid >> 3));
    const int hb = get_hb();
    char* smem_h = smem + hb * HALF_LDS; (void)smem_h;
    const float* mv0 = p.modv; const float* mv1 = p.modv + (size_t)9 * 6144;
    (void)mv0; (void)mv1; (void)vid0;
    {
        EpiResid e{p.X, p.X, mv1 + 5 * 1024, nullptr};
        gemm_job<true>(smem, p.act, 2816, p.wt_dn1, 2816, 1024, 16, 2048, 0, 128, 0, 2048, 128, 0, vid0, G, e);
      }
    if (17 + 1 < ph1) { if (ph1 > 1000) grid.sync(); else xcd_barrier(xb); }
  }
  if (ph0 <= 18 && 18 < ph1) {
    asm volatile("" : "+s"(pp));
    CP& p = *pp;
    const int bid = get_rbid();
    const int vid0 = (G & 7) ? bid : ((bid & 7) * (G >> 3) + (bid >> 3));
    const int hb = get_hb();
    char* smem_h = smem + hb * HALF_LDS; (void)smem_h;
    const float* mv0 = p.modv; const float* mv1 = p.modv + (size_t)9 * 6144;
    (void)mv0; (void)mv1; (void)vid0;
    phase_final_norm(p);
    if (18 + 1 < ph1) { if (ph1 > 1000) grid.sync(); else xcd_barrier(xb); }
  }
}

extern "C" void kernel_launch(void* const* d_in, const int* in_sizes, int n_in, void* d_out, int out_size, void* d_ws, size_t ws_size, hipStream_t stream) {
  static int grid_blocks = 0;
  if (!grid_blocks) {
    int dev = 0, cus = 0, per_cu = 0;
    hipGetDevice(&dev);
    hipDeviceGetAttribute(&cus, hipDeviceAttributeMultiprocessorCount, dev);
    hipOccupancyMaxActiveBlocksPerMultiprocessor(&per_cu, (const void*)mega, 512, 0);
    per_cu = 1;
    grid_blocks = cus * per_cu;
  }
  P p{};
  const float** in = (const float**)&p;
  for (int i = 0; i < 36; ++i) in[i] = (const float*)d_in[i];
  p.X = (float*)d_out;
  char* ws = (char*)d_ws; size_t off = 0;
  auto take = [&](size_t bytes) { char* r = ws + off; off += (bytes + 255) & ~(size_t)255; return r; };
  p.wt_dq = (bf16_t*)take((size_t)512 * 1024 * 2);
  p.wt_dkv = (bf16_t*)take((size_t)288 * 1024 * 2);
  p.wt_uq = (bf16_t*)take((size_t)1536 * 512 * 2);
  p.wt_uk = (bf16_t*)take((size_t)1024 * 256 * 2);
  p.wt_uv = (bf16_t*)take((size_t)1024 * 256 * 2);
  p.wt_o = (bf16_t*)take((size_t)1024 * 1024 * 2);
  p.wt_hin = (bf16_t*)take((size_t)3072 * 1024 * 2);
  p.wt_hout = (bf16_t*)take((size_t)1024 * 1024 * 2);
  p.wt_up0 = (bf16_t*)take((size_t)5632 * 1024 * 2);
  p.wt_up1 = (bf16_t*)take((size_t)5632 * 1024 * 2);
  p.wt_dn0 = (bf16_t*)take((size_t)1024 * 2816 * 2);
  p.wt_dn1 = (bf16_t*)take((size_t)1024 * 2816 * 2);
  p.modv = (float*)take((size_t)2 * 9 * 6144 * 4);
  p.rq = (float*)take((size_t)16384 * 4);
  p.rkv = (float*)take((size_t)18432 * 4);
  p.modp = (float*)take((size_t)4 * 110592 * 4);
  p.bar = (unsigned*)take((size_t)XCD_BAR_WORDS * 4);
  p.wt_f3 = (bf16_t*)take((size_t)2048 * 64 * 2);
  p.h2bf = (bf16_t*)take((size_t)2048 * 64 * 2);
  p.Rf = (bf16_t*)take((size_t)1024 * 4096 * 2);
  p.kpe = (bf16_t*)take((size_t)18432 * 32 * 2);
  p.hxc = (bf16_t*)take((size_t)18432 * 1024 * 2);
  const size_t ubase = off;
  p.cq = (bf16_t*)take((size_t)16384 * 512 * 2);
  p.kv = (bf16_t*)take((size_t)18432 * 288 * 2);
  p.Q = (bf16_t*)take((size_t)16384 * 1536 * 2);
  p.Kn = (bf16_t*)take((size_t)18432 * 1024 * 2);
  p.Vt = (bf16_t*)take((size_t)18432 * 1024 * 2);
  const size_t uend1 = off;
  off = ubase;
  p.act = (bf16_t*)take((size_t)16384 * 2816 * 2);
  off = ubase;
  p.x1h = (bf16_t*)take((size_t)16384 * 1024 * 2);
  p.vvT = (bf16_t*)take((size_t)16384 * 1024 * 2);
  p.Yp = (bf16_t*)take((size_t)16384 * 1024 * 2);
  if (uend1 > ws_size) { fprintf(stderr, "workspace too small: need %zu have %zu\n", uend1, ws_size); return; }
  p.ph0 = 0; p.ph1 = NPHASE;
  if (hipMemsetAsync(p.bar, 0, (size_t)XCD_BAR_WORDS * 4, stream) != hipSuccess) { fprintf(stderr, "memset failed\n"); return; }
  void* args[] = {&p};
  hipError_t e = hipLaunchCooperativeKernel((const void*)mega, dim3(grid_blocks), dim3(512), args, 0, stream);
  if (e != hipSuccess) fprintf(stderr, "cooperative launch failed: %s (grid %d)\n", hipGetErrorString(e), grid_blocks);
}
```

```cpp
#include <hip/hip_runtime.h>
#include <hip/hip_cooperative_groups.h>
#include <cstdio>
namespace cg = cooperative_groups;

typedef unsigned short bf16_t;
typedef short bf16x8 __attribute__((ext_vector_type(8)));
typedef float f32x4 __attribute__((ext_vector_type(4)));
typedef float f32x16 __attribute__((ext_vector_type(16)));

#define LDS_BYTES 163840
#define HALF_LDS 81920
#define NPHASE 19

struct P {
  const float *x, *c, *ctx, *c_ctx, *mod_w, *mod_b, *norm_mix_g, *norm_ffn_g;
  const float *w_dq, *g_q, *w_uq, *w_dkv, *g_kv, *w_uk, *w_uv, *w_o;
  const float *hy_w_in, *hy_b_in, *hy_conv_w, *hy_conv_b, *f_w1, *f_b1, *f_freq1, *f_w2, *f_b2, *f_freq2, *f_w3, *hy_decay, *hy_d_bias, *hy_w_out, *hy_b_out;
  const float *ffn_w_up, *ffn_conv_w, *ffn_conv_b, *ffn_w_down, *final_g;
  float* X;
  bf16_t *wt_dq, *wt_dkv, *wt_uq, *wt_uk, *wt_uv, *wt_o, *wt_hin, *wt_hout, *wt_up0, *wt_up1, *wt_dn0, *wt_dn1;
  float *modv, *rq, *rkv, *modp;
  unsigned* bar;
  bf16_t *wt_f3, *h2bf, *X16;
  bf16_t *Rf, *kpe, *hxc, *cq, *kv, *Q, *Kn, *Vt, *act, *x1h, *vvT, *Yp;
  int ph0, ph1;
};

typedef const __attribute__((address_space(4))) P CP;
__device__ __forceinline__ int get_tid512() { int t = threadIdx.x; asm volatile("" : "+v"(t)); return t; }
__device__ __forceinline__ int get_tid() { int t = threadIdx.x & 255; asm volatile("" : "+v"(t)); return t; }
__device__ __forceinline__ int get_hb() { int t = __builtin_amdgcn_readfirstlane((int)(threadIdx.x >> 8)); asm volatile("" : "+s"(t)); return t; }
__device__ __forceinline__ int get_rbid() { int t = blockIdx.x; asm volatile("" : "+s"(t)); return t; }
__device__ __forceinline__ int get_bid() { return 2 * get_rbid() + get_hb(); }
#define VGRID (2 * (int)gridDim.x)

__device__ __forceinline__ unsigned pack2(float a, float b) { unsigned r; asm("v_cvt_pk_bf16_f32 %0, %1, %2" : "=v"(r) : "v"(a), "v"(b)); return r; }
__device__ __forceinline__ bf16_t f2bf(float f) { return (bf16_t)(pack2(f, f) & 0xffffu); }
__device__ __forceinline__ float bf2f(bf16_t h) { return __uint_as_float(((unsigned)h) << 16); }
__device__ __forceinline__ float wave_sum(float v) {
#pragma unroll
  for (int o = 32; o; o >>= 1) v += __shfl_xor(v, o);
  return v;
}


#define XB_TMO      128
#define XB_XCNT(j)  (256  + 64 * (j))
#define XB_XSUB(j)  (1280 + 64 * (j))
#define XB_XGEN(j)  (2304 + 64 * (j))
#define XB_TOP      3328
#define XB_TOPGEN   3392
#define XCD_BAR_WORDS 3456
#define XB_SPIN_CAP (1u << 18)
#define LAS __attribute__((address_space(3)))
__device__ __forceinline__ unsigned xb_ld(unsigned* p)              { return __hip_atomic_load(p, __ATOMIC_RELAXED, __HIP_MEMORY_SCOPE_AGENT); }
__device__ __forceinline__ unsigned xb_add(unsigned* p, unsigned v) { return __hip_atomic_fetch_add(p, v, __ATOMIC_RELAXED, __HIP_MEMORY_SCOPE_AGENT); }
__device__ __forceinline__ unsigned xb_xcc_id() { return (unsigned)__builtin_amdgcn_s_getreg((3 << 11) | 20) & 0xFu; }
#define XB_SPIN(cond, bar) do { unsigned _sp = 0; while (cond) { __builtin_amdgcn_s_sleep(1); \
    if ((++_sp & 255u) == 0u) { if (xb_ld(&(bar)[XB_TMO])) break; if (_sp > XB_SPIN_CAP) { atomicAdd(&(bar)[XB_TMO], 1u); break; } } } } while (0)
struct XcdBarrier { unsigned* bar; unsigned x; volatile LAS unsigned* st; };
__device__ __forceinline__ XcdBarrier xcd_barrier_post(unsigned* bar, volatile LAS unsigned* st) {
    XcdBarrier b; b.bar = bar; b.x = xb_xcc_id(); b.st = st;
    if (threadIdx.x == 0) (void)xb_add(&bar[XB_XCNT(b.x)], 1u);
    return b;
}
__device__ __forceinline__ void xcd_barrier_complete(unsigned* bar, unsigned x, unsigned& nloc, unsigned& nx) {
    const unsigned G = gridDim.x * gridDim.y * gridDim.z;
    unsigned sum, cnt, mine, sp = 0u;
    for (;;) {
        sum = 0u; cnt = 0u; mine = 0u;
#pragma unroll
        for (unsigned j = 0; j < 16; ++j) { const unsigned c = xb_ld(&bar[XB_XCNT(j)]); sum += c; cnt += (c > 0u) ? 1u : 0u; mine = (j == x) ? c : mine; }
        if (sum == G) break;
        __builtin_amdgcn_s_sleep(1);
        if ((++sp & 255u) == 0u) { if (xb_ld(&bar[XB_TMO])) break; if (sp > XB_SPIN_CAP) { atomicAdd(&bar[XB_TMO], 1u); break; } }
    }
    nloc = mine > 0u ? mine : 1u; nx = cnt > 0u ? cnt : 1u;
}
__device__ __forceinline__ void xcd_barrier(const XcdBarrier& b) {
    asm volatile("s_waitcnt vmcnt(0)" ::: "memory");
    __syncthreads();
    if (threadIdx.x == 0) {
        unsigned* bar = b.bar;
        __builtin_amdgcn_s_waitcnt(0);
        unsigned nloc = b.st[0], nx = b.st[1];
        if (nloc == 0u) { xcd_barrier_complete(bar, b.x, nloc, nx); b.st[0] = nloc; b.st[1] = nx; }
        const unsigned old = xb_add(&bar[XB_XSUB(b.x)], 1u);
        const unsigned gen = old / nloc;
        if (old + 1u == (gen + 1u) * nloc) {
            __builtin_amdgcn_fence(__ATOMIC_RELEASE, "agent");
            asm volatile("s_waitcnt vmcnt(0)" ::: "memory");
            const unsigned og = xb_add(&bar[XB_TOP], 1u);
            const unsigned tg = og / nx;
            if (og + 1u == (tg + 1u) * nx) xb_add(&bar[XB_TOPGEN], 1u);
            else XB_SPIN(xb_ld(&bar[XB_TOPGEN]) == tg, bar);
            __builtin_amdgcn_fence(__ATOMIC_ACQUIRE, "agent");
            xb_add(&bar[XB_XGEN(b.x)], 1u);
            asm volatile("s_waitcnt vmcnt(0)" ::: "memory");
        } else {
            XB_SPIN(xb_ld(&bar[XB_XGEN(b.x)]) == gen, bar);
            __builtin_amdgcn_fence(__ATOMIC_ACQUIRE, "agent");
            asm volatile("s_waitcnt vmcnt(0)" ::: "memory");
        }
    }
    __syncthreads();
}

__device__ __forceinline__ void prep_weight_tile(CP& p, char* smem, int wt) {
  const int tid = get_tid();
  int id = 0;
  {
    const int cnt[13] = {64, 40, 96, 32, 32, 128, 384, 128, 704, 704, 352, 352, 32};
#pragma unroll
    for (int i = 0; i < 12; ++i) { if (id == i && wt >= cnt[i]) { wt -= cnt[i]; id = i + 1; } }
  }
  const float* src; int K, N; bf16_t* dst; const float* scale = nullptr; int perm = 0;
  switch (id) {
    case 0: src = p.w_dq; K = 1024; N = 512; dst = p.wt_dq; break;
    case 1: src = p.w_dkv; K = 1024; N = 288; dst = p.wt_dkv; break;
    case 2: src = p.w_uq; K = 512; N = 1536; dst = p.wt_uq; scale = p.g_q; break;
    case 3: src = p.w_uk; K = 256; N = 1024; dst = p.wt_uk; scale = p.g_kv; break;
    case 4: src = p.w_uv; K = 256; N = 1024; dst = p.wt_uv; scale = p.g_kv; break;
    case 5: src = p.w_o; K = 1024; N = 1024; dst = p.wt_o; break;
    case 6: src = p.hy_w_in; K = 1024; N = 3072; dst = p.wt_hin; perm = 2; break;
    case 7: src = p.hy_w_out; K = 1024; N = 1024; dst = p.wt_hout; break;
    case 8: src = p.ffn_w_up; K = 1024; N = 5632; dst = p.wt_up0; perm = 1; break;
    case 9: src = p.ffn_w_up + (size_t)1024 * 5632; K = 1024; N = 5632; dst = p.wt_up1; perm = 1; break;
    case 10: src = p.ffn_w_down; K = 2816; N = 1024; dst = p.wt_dn0; break;
    case 11: src = p.ffn_w_down + (size_t)2816 * 1024; K = 2816; N = 1024; dst = p.wt_dn1; break;
    default: src = p.f_w3; K = 64; N = 2048; dst = p.wt_f3; break;
  }
  const int ntn = (N + 63) >> 6;
  const int kt = wt / ntn, nt = wt - kt * ntn;
  const int k0 = kt * 128, n0 = nt * 64;
  int np0;
  if (perm == 1) { const int half = n0 / 2816, f = n0 - half * 2816; np0 = (f >> 6) * 128 + half * 64; }
  else if (perm == 2) { if (n0 < 1024) np0 = n0; else { const int m = n0 - 1024, half = m >> 10, f = m & 1023; np0 = 1024 + (f >> 6) * 128 + half * 64; } }
  else np0 = n0;
  bf16_t* t16 = (bf16_t*)smem;
  f32x4 v[8];
#pragma unroll
  for (int i = 0; i < 8; ++i) {
    const int idx = tid + 256 * i; const int kr = idx >> 4, c4 = idx & 15;
    v[i] = (f32x4){0.f, 0.f, 0.f, 0.f};
    if (n0 + 4 * c4 < N && k0 + kr < K) v[i] = *(const f32x4*)(src + (size_t)(k0 + kr) * N + n0 + 4 * c4);
  }
#pragma unroll
  for (int i = 0; i < 8; ++i) {
    const int idx = tid + 256 * i; const int kr = idx >> 4, c4 = idx & 15;
    const float sc = (scale && k0 + kr < K) ? scale[k0 + kr] : 1.f;
#pragma unroll
    for (int j = 0; j < 4; ++j) t16[(4 * c4 + j) * 136 + kr] = f2bf(v[i][j] * sc);
  }
  __syncthreads();
#pragma unroll
  for (int i = 0; i < 4; ++i) {
    const int idx = tid + 256 * i; const int n = idx >> 4, ch = idx & 15;
    if (n0 + n < N && k0 + ch * 8 < K) *(uint4*)(dst + (size_t)(np0 + n) * K + k0 + ch * 8) = *(const uint4*)(t16 + n * 136 + ch * 8);
  }
  __syncthreads();
}

__device__ __forceinline__ void prep_modvec(CP& p, char* smem, int it) {
  const int tid = get_tid();
  const int layer = it / 384, rem = it - layer * 384, cb = rem >> 2, ks = rem & 3;
  float* s_lds = (float*)smem;
  float* red = (float*)(smem + 12288);
  const int kbase = ks * 256;
  for (int idx = tid; idx < 9 * 256; idx += 256) {
    const int r = idx >> 8, k = idx & 255;
    const float v = r < 8 ? p.c[r * 1024 + kbase + k] : p.c_ctx[kbase + k];
    s_lds[k * 12 + r] = v / (1.f + __expf(-v));
  }
  __syncthreads();
  const int col = cb * 64 + (tid & 63), kg = tid >> 6;
  const float* W = p.mod_w + (size_t)layer * 1024 * 6144 + (size_t)kbase * 6144 + col;
  float acc[9];
#pragma unroll
  for (int r = 0; r < 9; ++r) acc[r] = 0.f;
#pragma unroll
  for (int kb = 0; kb < 4; ++kb) {
    float w[16];
#pragma unroll
    for (int u = 0; u < 16; ++u) w[u] = W[(size_t)(kg * 64 + kb * 16 + u) * 6144];
#pragma unroll
    for (int u = 0; u < 16; ++u) {
      const int k = kg * 64 + kb * 16 + u;
      const f32x4 s0 = *(const f32x4*)(s_lds + k * 12), s1 = *(const f32x4*)(s_lds + k * 12 + 4);
      const float s2 = s_lds[k * 12 + 8];
      acc[0] += s0[0] * w[u]; acc[1] += s0[1] * w[u]; acc[2] += s0[2] * w[u]; acc[3] += s0[3] * w[u];
      acc[4] += s1[0] * w[u]; acc[5] += s1[1] * w[u]; acc[6] += s1[2] * w[u]; acc[7] += s1[3] * w[u];
      acc[8] += s2 * w[u];
    }
  }
#pragma unroll
  for (int r = 0; r < 9; ++r) red[(kg * 9 + r) * 64 + (tid & 63)] = acc[r];
  __syncthreads();
  for (int o = tid; o < 9 * 64; o += 256) {
    const int r = o >> 6, cl = o & 63;
    const float sm = red[(0 * 9 + r) * 64 + cl] + red[(1 * 9 + r) * 64 + cl] + red[(2 * 9 + r) * 64 + cl] + red[(3 * 9 + r) * 64 + cl];
    p.modp[(size_t)ks * 110592 + (size_t)(layer * 9 + r) * 6144 + cb * 64 + cl] = sm;
  }
  __syncthreads();
}

__device__ __forceinline__ void prep_filter(CP& p, char* smem, int it) {
  const int tid = get_tid();
  float* z = (float*)smem;
  float* h1 = z + 8 * 33;
  float* h2 = h1 + 8 * 64;
  const int t0 = it * 8;
  for (int idx = tid; idx < 8 * 33; idx += 256) {
    const int pp = idx / 33, i = idx - pp * 33;
    const int t = t0 + pp;
    float v;
    if (i == 0) v = (float)t * (1.0f / 2047.0f);
    else {
      const int k = (i - 1) & 15;
      const float w = (6.283185307179586f * (float)t) / 2048.0f;
      const float f = 1e-4f + (float)k * ((15.0f - 1e-4f) / 15.0f);
      const float a = w * f;
      v = (i <= 16) ? __cosf(a) : -__sinf(a);
    }
    z[idx] = v;
  }
  __syncthreads();
  for (int idx = tid; idx < 8 * 64; idx += 256) {
    const int pp = idx >> 6, j = idx & 63;
    float s = p.f_b1[j];
#pragma unroll
    for (int i = 0; i < 33; ++i) s += z[pp * 33 + i] * p.f_w1[i * 64 + j];
    h1[idx] = __sinf(p.f_freq1[j] * s);
  }
  __syncthreads();
  for (int idx = tid; idx < 8 * 64; idx += 256) {
    const int pp = idx >> 6, j = idx & 63;
    float s = p.f_b2[j];
#pragma unroll 16
    for (int i = 0; i < 64; ++i) s += h1[pp * 64 + i] * p.f_w2[i * 64 + j];
    h2[idx] = __sinf(p.f_freq2[j] * s);
  }
  __syncthreads();
  for (int idx = tid; idx < 8 * 64; idx += 256) p.h2bf[(size_t)t0 * 64 + idx] = f2bf(h2[idx]);
  __syncthreads();
}

__device__ __forceinline__ void phase_prep(CP& p, char* smem) {
  const int total = 768 + 256 + 3048;
  for (int it = get_bid(); it < total; it += VGRID) {
    if (it < 768) prep_modvec(p, smem, it);
    else if (it < 1024) prep_filter(p, smem, it - 768);
    else prep_weight_tile(p, smem, it - 1024);
  }
}

__device__ __forceinline__ f32x4 ld4_bf16(const bf16_t* p) {
  const uint2 u = *(const uint2*)p;
  f32x4 r; r[0] = bf2f((bf16_t)(u.x & 0xffff)); r[1] = bf2f((bf16_t)(u.x >> 16)); r[2] = bf2f((bf16_t)(u.y & 0xffff)); r[3] = bf2f((bf16_t)(u.y >> 16));
  return r;
}
template <bool PART, bool SRC16 = false>
__device__ __forceinline__ void normmod_row2(const void* __restrict__ srcv, const float* __restrict__ g, const float* __restrict__ sh, const float* __restrict__ sc, bf16_t* __restrict__ dst, int lane, const float* __restrict__ bsh = nullptr) {
  f32x4 v[2][4]; float ss0 = 0.f, ss1 = 0.f;
#pragma unroll
  for (int i = 0; i < 4; ++i) {
    if (SRC16) { v[0][i] = ld4_bf16((const bf16_t*)srcv + lane * 4 + 256 * i); v[1][i] = ld4_bf16((const bf16_t*)srcv + 1024 + lane * 4 + 256 * i); }
    else { v[0][i] = *(const f32x4*)((const float*)srcv + lane * 4 + 256 * i); v[1][i] = *(const f32x4*)((const float*)srcv + 1024 + lane * 4 + 256 * i); }
  }
#pragma unroll
  for (int i = 0; i < 4; ++i) {
    ss0 += v[0][i][0] * v[0][i][0] + v[0][i][1] * v[0][i][1] + v[0][i][2] * v[0][i][2] + v[0][i][3] * v[0][i][3];
    ss1 += v[1][i][0] * v[1][i][0] + v[1][i][1] * v[1][i][1] + v[1][i][2] * v[1][i][2] + v[1][i][3] * v[1][i][3];
  }
  ss0 = wave_sum(ss0); ss1 = wave_sum(ss1);
  const float r0 = rsqrtf(ss0 * (1.0f / 1024.0f) + 1e-6f), r1 = rsqrtf(ss1 * (1.0f / 1024.0f) + 1e-6f);
#pragma unroll
  for (int i = 0; i < 4; ++i) {
    const int k = lane * 4 + 256 * i;
    const f32x4 g4 = *(const f32x4*)(g + k);
    f32x4 s4 = *(const f32x4*)(sh + k), c4 = *(const f32x4*)(sc + k);
    if (PART) {
#pragma unroll
      for (int q = 1; q < 4; ++q) { s4 += *(const f32x4*)(sh + (size_t)q * 110592 + k); c4 += *(const f32x4*)(sc + (size_t)q * 110592 + k); }
      s4 += *(const f32x4*)(bsh + k); c4 += *(const f32x4*)(bsh + 1024 + k);
    }
    float y[4], z[4];
#pragma unroll
    for (int j = 0; j < 4; ++j) { const float gm = g4[j] * (1.f + c4[j]); y[j] = (v[0][i][j] * r0) * gm + s4[j]; z[j] = (v[1][i][j] * r1) * gm + s4[j]; }
    uint2 u; u.x = pack2(y[0], y[1]); u.y = pack2(y[2], y[3]);
    *(uint2*)(dst + k) = u;
    u.x = pack2(z[0], z[1]); u.y = pack2(z[2], z[3]);
    *(uint2*)(dst + 1024 + k) = u;
  }
}

__device__ __forceinline__ void phase_normmod_kv(CP& p) {
  const int lane = get_tid() & 63, wv = get_tid() >> 6;
  const float* g = p.norm_mix_g;
  for (int idx = get_bid() * 256 + get_tid(); idx < 110592; idx += VGRID * 256) {
    const int lr = idx / 6144; const int n = idx - lr * 6144; const int layer = lr / 9;
    p.modv[idx] = p.modp[idx] + p.modp[110592 + idx] + p.modp[2 * 110592 + idx] + p.modp[3 * 110592 + idx] + p.mod_b[layer * 6144 + n];
  }
  for (int r = (get_bid() * 4 + wv) * 2; r < 18432; r += VGRID * 8) {
    const int b = r / 2304, pp = r - b * 2304;
    const float* src; const float* mv;
    if (pp < 256) { src = p.ctx + ((size_t)b * 256 + pp) * 1024; mv = p.modp + (size_t)8 * 6144; }
    else { src = p.x + ((size_t)b * 2048 + pp - 256) * 1024; mv = p.modp + (size_t)b * 6144; }
    normmod_row2<true>(src, g, mv, mv + 1024, p.hxc + (size_t)r * 1024, lane, p.mod_b);
  }
}
__device__ __forceinline__ void phase_normmod_x(CP& p, const float* g, int layer, int chunk) {
  const int lane = get_tid() & 63, wv = get_tid() >> 6;
  for (int r = (get_bid() * 4 + wv) * 2; r < 16384; r += VGRID * 8) {
    const int b = r >> 11;
    const float* mv = p.modv + (size_t)(layer * 9 + b) * 6144 + chunk * 1024;
    normmod_row2<false, true>(p.X16 + (size_t)r * 1024, g, mv, mv + 1024, p.hxc + (size_t)r * 1024, lane);
  }
}
__device__ __forceinline__ void phase_final_norm(CP& p) {
  const int lane = get_tid() & 63, wv = get_tid() >> 6;
  for (int r = get_bid() * 4 + wv; r < 16384; r += VGRID * 4) {
    const bf16_t* srow = p.X16 + (size_t)r * 1024;
    float* row = p.X + (size_t)r * 1024;
    f32x4 v[4]; float ss = 0.f;
#pragma unroll
    for (int i = 0; i < 4; ++i) { v[i] = ld4_bf16(srow + lane * 4 + 256 * i); ss += v[i][0] * v[i][0] + v[i][1] * v[i][1] + v[i][2] * v[i][2] + v[i][3] * v[i][3]; }
    ss = wave_sum(ss);
    const float rr = rsqrtf(ss * (1.0f / 1024.0f) + 1e-6f);
#pragma unroll
    for (int i = 0; i < 4; ++i) {
      const int k = lane * 4 + 256 * i;
      const f32x4 g4 = *(const f32x4*)(p.final_g + k);
      f32x4 o; o[0] = v[i][0] * rr * g4[0]; o[1] = v[i][1] * rr * g4[1]; o[2] = v[i][2] * rr * g4[2]; o[3] = v[i][3] * rr * g4[3];
      *(f32x4*)(row + k) = o;
    }
  }
}

__device__ __forceinline__ void phase_rowstat(CP& p) {
  const int lane = get_tid() & 63, wv = get_tid() >> 6;
  for (int r = get_bid() * 4 + wv; r < 18432; r += VGRID * 4) {
    const int b = r / 2304, pp = r - b * 2304;
    const bf16_t* kvr = p.kv + (size_t)r * 288;
    {
      const uint2 u = *(const uint2*)(kvr + lane * 4);
      const float a0 = bf2f((bf16_t)(u.x & 0xffff)), a1 = bf2f((bf16_t)(u.x >> 16)), a2 = bf2f((bf16_t)(u.y & 0xffff)), a3 = bf2f((bf16_t)(u.y >> 16));
      float ss = a0 * a0 + a1 * a1 + a2 * a2 + a3 * a3;
      ss = wave_sum(ss);
      if (lane == 0) p.rkv[r] = rsqrtf(ss * (1.0f / 256.0f) + 1e-6f);
    }
    {
      const int i = lane & 31;
      const float xv = bf2f(kvr[256 + i]);
      const float ov = __shfl_xor(xv, 8);
      float res = xv;
      if (pp >= 256) {
        const int t = pp - 256;
        const int quarter = i >> 3, idx = i & 7;
        const float pos = (quarter < 2) ? (float)(t >> 6) : (float)(t & 63);
        const float inv = exp2f(-(float)idx * (13.287712379549449f / 8.0f));
        const float ang = pos * inv;
        const float cs = __cosf(ang), sn = __sinf(ang);
        res = xv * cs + ((quarter & 1) ? ov : -ov) * sn;
      }
      if (lane < 32) p.kpe[(size_t)r * 32 + i] = f2bf(res);
    }
    if (pp >= 256) {
      const int xr = b * 2048 + pp - 256;
      const uint4 u = *(const uint4*)(p.cq + (size_t)xr * 512 + lane * 8);
      const unsigned uu[4] = {u.x, u.y, u.z, u.w};
      float ss = 0.f;
#pragma unroll
      for (int j = 0; j < 4; ++j) { const float a = bf2f((bf16_t)(uu[j] & 0xffff)), bb = bf2f((bf16_t)(uu[j] >> 16)); ss += a * a + bb * bb; }
      ss = wave_sum(ss);
      if (lane == 0) p.rq[xr] = rsqrtf(ss * (1.0f / 512.0f) + 1e-6f);
    }
  }
}

struct EpiStore {
  static constexpr int KIND = 0;
  bf16_t* out; int ld; int ostride; const float* rs;
  __device__ __forceinline__ void c4(int g, int rig, int col, f32x4 v) const {
    const size_t row = (size_t)g * ostride + rig;
    const float s = rs ? rs[row] : 1.f;
    uint2 u; u.x = pack2(v[0] * s, v[1] * s); u.y = pack2(v[2] * s, v[3] * s);
    *(uint2*)(out + row * ld + col) = u;
  }
};
struct EpiVt {
  static constexpr int KIND = 1;
  bf16_t* out; const float* rs;
  __device__ __forceinline__ void r4(int g, int rig, int col, f32x4 v) const {
    const size_t row = (size_t)g * 2304 + rig;
    const f32x4 s = *(const f32x4*)(rs + row);
    uint2 u; u.x = pack2(v[0] * s[0], v[1] * s[1]); u.y = pack2(v[2] * s[2], v[3] * s[3]);
    *(uint2*)(out + ((size_t)g * 1024 + col) * 2304 + rig) = u;
  }
};
struct EpiFilt {
  static constexpr int KIND = 1;
  bf16_t* Rf; const float* decay;
  __device__ __forceinline__ void r4(int g, int rig, int col, f32x4 v) const {
    const int c = col & 1023; const bool bwd = col >= 1024;
    const float dec = fabsf(decay[c]);
    bf16_t* rp = Rf + (size_t)c * 4096;
#pragma unroll
    for (int j = 0; j < 4; ++j) {
      const int t = rig + j;
      const float val = v[j] * __expf(-(float)t * (1.0f / 2047.0f) * dec);
      if (!bwd) rp[2048 - t] = f2bf(val);
      else if (t > 0) rp[2048 + t] = f2bf(val);
      else rp[0] = 0;
    }
  }
};
template <bool BASE_F32>
struct EpiResid {
  static constexpr int KIND = 0;
  bf16_t* X16; const void* base; const float* gate; const float* bias;
  __device__ __forceinline__ void c4(int g, int rig, int col, f32x4 v) const {
    const size_t o = ((size_t)g * 2048 + rig) * 1024 + col;
    f32x4 bs;
    if (BASE_F32) bs = *(const f32x4*)((const float*)base + o);
    else {
      const uint2 u = *(const uint2*)((const bf16_t*)base + o);
      bs[0] = bf2f((bf16_t)(u.x & 0xffff)); bs[1] = bf2f((bf16_t)(u.x >> 16)); bs[2] = bf2f((bf16_t)(u.y & 0xffff)); bs[3] = bf2f((bf16_t)(u.y >> 16));
    }
    const f32x4 gt = *(const f32x4*)(gate + (size_t)g * 6144 + col);
    f32x4 bi = {0.f, 0.f, 0.f, 0.f};
    if (bias) bi = *(const f32x4*)(bias + col);
    f32x4 r;
#pragma unroll
    for (int j = 0; j < 4; ++j) r[j] = bs[j] + gt[j] * (v[j] + bi[j]);
    uint2 w; w.x = pack2(r[0], r[1]); w.y = pack2(r[2], r[3]);
    *(uint2*)(X16 + o) = w;
  }
};
template <int MODE>
struct EpiConv {
  static constexpr int KIND = 2;
  const float* cw; const float* cb; int NC; const float* pre_bias;
  bf16_t* o0; bf16_t* o1;
  __device__ __forceinline__ int norig(int nt, int cl) const {
    if (MODE == 0) return (cl >> 6) * 2816 + nt * 64 + (cl & 63);
    if (nt < 8) return nt * 128 + cl;
    return 1024 + (cl >> 6) * 1024 + (nt - 8) * 64 + (cl & 63);
  }
  __device__ __forceinline__ void finish(const float* Z, int g, int rig0, int nt) const {
    const int tid = get_tid();
    if (MODE == 0 || nt < 8) {
      const int f = tid & 63, q = tid >> 6;
      const int p0 = 1 + 32 * q, p1 = (p0 + 32 < 127) ? p0 + 32 : 127;
      if (MODE == 0) {
        typedef float f32x2 __attribute__((ext_vector_type(2)));
        const int f2 = (tid & 31) * 2, q8 = tid >> 5;
        const int q0 = 1 + 16 * q8, q1 = (q0 + 16 < 127) ? q0 + 16 : 127;
        const int na = norig(nt, f2), ng = norig(nt, 64 + f2);
        const f32x2 a0 = *(const f32x2*)(cw + na), a1 = *(const f32x2*)(cw + NC + na), a2 = *(const f32x2*)(cw + 2 * NC + na), ab = *(const f32x2*)(cb + na);
        const f32x2 g0 = *(const f32x2*)(cw + ng), g1 = *(const f32x2*)(cw + NC + ng), g2 = *(const f32x2*)(cw + 2 * NC + ng), gb = *(const f32x2*)(cb + ng);
        f32x2 am = *(const f32x2*)(Z + (q0 - 1) * 132 + f2), ac = *(const f32x2*)(Z + q0 * 132 + f2);
        f32x2 gm = *(const f32x2*)(Z + (q0 - 1) * 132 + 64 + f2), gc = *(const f32x2*)(Z + q0 * 132 + 64 + f2);
#pragma unroll 2
        for (int pl = q0; pl < q1; ++pl) {
          const f32x2 an = *(const f32x2*)(Z + (pl + 1) * 132 + f2), gn = *(const f32x2*)(Z + (pl + 1) * 132 + 64 + f2);
          const int pos = rig0 + pl;
          if (pos < 2048) {
            const f32x2 av = a0 * am + a1 * ac + a2 * an + ab;
            const f32x2 gv = g0 * gm + g1 * gc + g2 * gn + gb;
            const float s0 = av[0] * gv[0] * __builtin_amdgcn_rcpf(1.f + __expf(-gv[0]));
            const float s1 = av[1] * gv[1] * __builtin_amdgcn_rcpf(1.f + __expf(-gv[1]));
            *(unsigned*)(o0 + ((size_t)g * 2048 + pos) * 2816 + nt * 64 + f2) = pack2(s0, s1);
          }
          am = ac; ac = an; gm = gc; gc = gn;
        }
      } else {
#pragma unroll
        for (int fh = 0; fh < 2; ++fh) {
          const int cl = fh * 64 + f;
          const int na = norig(nt, cl);
          const float a0 = cw[na], a1 = cw[NC + na], a2 = cw[2 * NC + na], ab = cb[na];
          float am = Z[(p0 - 1) * 132 + cl], ac = Z[p0 * 132 + cl];
#pragma unroll 2
          for (int pl = p0; pl < p1; ++pl) {
            const float an = Z[(pl + 1) * 132 + cl];
            const int pos = rig0 + pl;
            if (pos < 2048) o0[((size_t)g * 2048 + pos) * 1024 + nt * 128 + cl] = f2bf(a0 * am + a1 * ac + a2 * an + ab);
            am = ac; ac = an;
          }
        }
      }
    } else {
      const int pl = tid & 127, fh = tid >> 7;
      const int pos = rig0 + pl;
      if (pl >= 1 && pl <= 126 && pos < 2048) {
        const int fb = nt - 8;
#pragma unroll 2
        for (int f = fh * 32; f < fh * 32 + 32; ++f) {
          const int na = norig(nt, f), nb = norig(nt, 64 + f);
          const float va = cw[na] * Z[(pl - 1) * 132 + f] + cw[NC + na] * Z[pl * 132 + f] + cw[2 * NC + na] * Z[(pl + 1) * 132 + f] + cb[na];
          const float vb = cw[nb] * Z[(pl - 1) * 132 + 64 + f] + cw[NC + nb] * Z[pl * 132 + 64 + f] + cw[2 * NC + nb] * Z[(pl + 1) * 132 + 64 + f] + cb[nb];
          o1[(size_t)(fb * 64 + f) * 16384 + g * 2048 + pos] = f2bf(va * vb);
        }
      }
    }
  }
};

#define GLDS16(gp, lp) __builtin_amdgcn_global_load_lds((const unsigned*)(gp), (__attribute__((address_space(3))) unsigned*)(lp), 16, 0, 0)

template <bool SWAP, class Epi>
__device__ __forceinline__ void gemm_job(char* smem, const bf16_t* __restrict__ A, int lda, const bf16_t* __restrict__ Bt, int K, int N,
                                         int tpg, int a_gstride, int a_goff, int step, int halo, int grows, int MTS, int voff, int vid0, int grid, const Epi& epi) {
  const int tid = get_tid512(), lane = tid & 63, wid = tid >> 6, wr = wid >> 1, wc = wid & 1, fr = lane & 15, fq = lane >> 4;
  const int NT = (N + 255) >> 8, MT = MTS >> 1, ntiles = MT * NT, ns = K >> 6;
  const int full = MT >> 3;
  int v = vid0;
  if (v < voff) v += ((voff - v + grid - 1) / grid) * grid;
  const int swz = (fr >> 1) & 7;
  for (; v < voff + ntiles; v += grid) {
    const int w = v - voff;
    int mt, nt;
    if (w < full * 8 * NT) { const int sr = w / (8 * NT), rem = w - sr * 8 * NT; nt = rem >> 3; mt = sr * 8 + (rem & 7); }
    else { const int w2 = w - full * 8 * NT, rl = MT - full * 8; nt = w2 / rl; mt = full * 8 + (w2 - nt * rl); }
    unsigned ap[4], bp[4];
#pragma unroll
    for (int i = 0; i < 4; ++i) {
      const int r = (tid >> 3) + 64 * i;
      const int cs = tid & 7;
      const int c = ((cs ^ ((r >> 1) & 7)) << 3);
      const int sub = 2 * mt + (r >> 7);
      const int g = sub / tpg, ti = sub - g * tpg;
      int rig = ti * step - halo + (r & 127); rig = rig < 0 ? 0 : (rig > grows - 1 ? grows - 1 : rig);
      ap[i] = (unsigned)((g * a_gstride + a_goff + rig) * lda + c);
      int br = nt * 256 + r; br = br > N - 1 ? N - 1 : br;
      bp[i] = (unsigned)(br * K + c);
    }
    f32x4 acc[4][8];
#pragma unroll
    for (int m = 0; m < 4; ++m)
#pragma unroll
      for (int n = 0; n < 8; ++n) acc[m][n] = (f32x4){0.f, 0.f, 0.f, 0.f};
#pragma unroll
    for (int i = 0; i < 4; ++i) { GLDS16(A + (size_t)ap[i], smem + tid * 16 + i * 8192); GLDS16(Bt + (size_t)bp[i], smem + 32768 + tid * 16 + i * 8192); }
    for (int st = 0; st < ns; ++st) {
      asm volatile("s_waitcnt vmcnt(0)" ::: "memory");
      __builtin_amdgcn_s_barrier();
      asm volatile("" ::: "memory");
      if (st + 1 < ns) {
        char* nb = smem + ((st + 1) & 1) * 65536;
        const int ko = (st + 1) * 64;
#pragma unroll
        for (int i = 0; i < 4; ++i) { GLDS16(A + (size_t)(ap[i] + ko), nb + tid * 16 + i * 8192); GLDS16(Bt + (size_t)(bp[i] + ko), nb + 32768 + tid * 16 + i * 8192); }
      }
      const char* sa = smem + (st & 1) * 65536 + (wr * 64 + fr) * 128;
      const char* sb = smem + (st & 1) * 65536 + 32768 + (wc * 128 + fr) * 128;
      bf16x8 afA[4], afB[4], bfb[2][2];
#pragma unroll
      for (int m = 0; m < 4; ++m) afA[m] = *(const bf16x8*)(sa + m * 2048 + ((fq ^ swz) << 4));
#pragma unroll
      for (int n = 0; n < 2; ++n) bfb[0][n] = *(const bf16x8*)(sb + n * 2048 + ((fq ^ swz) << 4));
#pragma unroll
      for (int gq = 0; gq < 8; ++gq) {
        const int ks = gq >> 2, nh = gq & 3;
        if (gq < 7) {
          const int ks2 = (gq + 1) >> 2, nh2 = (gq + 1) & 3;
#pragma unroll
          for (int n = 0; n < 2; ++n) bfb[(gq + 1) & 1][n] = *(const bf16x8*)(sb + (nh2 * 2 + n) * 2048 + (((ks2 * 4 + fq) ^ swz) << 4));
        }
        if (gq == 3) {
#pragma unroll
          for (int m = 0; m < 4; ++m) afB[m] = *(const bf16x8*)(sa + m * 2048 + (((4 + fq) ^ swz) << 4));
        }
        __builtin_amdgcn_sched_barrier(0);
#pragma unroll
        for (int m = 0; m < 4; ++m)
#pragma unroll
          for (int n = 0; n < 2; ++n) {
            const bf16x8 av = ks ? afB[m] : afA[m];
            acc[m][nh * 2 + n] = SWAP ? __builtin_amdgcn_mfma_f32_16x16x32_bf16(bfb[gq & 1][n], av, acc[m][nh * 2 + n], 0, 0, 0)
                                      : __builtin_amdgcn_mfma_f32_16x16x32_bf16(av, bfb[gq & 1][n], acc[m][nh * 2 + n], 0, 0, 0);
          }
      }
    }
    __syncthreads();
    const int te = get_tid512();
    const int fr_e = te & 15, fq_e = (te & 63) >> 4, wr_e = te >> 7, wc_e = (te >> 6) & 1;
    const int sub = 2 * mt + (wr_e >> 1);
    const int g = sub / tpg, ti = sub - g * tpg;
    const int rig0 = ti * step - halo;
    const int rw = (wr_e & 1) * 64;
    if constexpr (Epi::KIND == 0) {
#pragma unroll
      for (int m = 0; m < 4; ++m) {
        const int rig = rig0 + rw + m * 16 + fr_e;
#pragma unroll
        for (int n = 0; n < 8; ++n) {
          const int col = nt * 256 + wc_e * 128 + n * 16 + fq_e * 4;
          if (col < N) epi.c4(g, rig, col, acc[m][n]);
        }
      }
    } else if constexpr (Epi::KIND == 1) {
#pragma unroll
      for (int m = 0; m < 4; ++m) {
        const int rig = rig0 + rw + m * 16 + fq_e * 4;
#pragma unroll
        for (int n = 0; n < 8; ++n) {
          const int col = nt * 256 + wc_e * 128 + n * 16 + fr_e;
          if (col < N) epi.r4(g, rig, col, acc[m][n]);
        }
      }
    } else {
      float* Z = (float*)smem + (wr_e >> 1) * (128 * 132);
#pragma unroll
      for (int h = 0; h < 2; ++h) {
        const int nt2 = nt * 2 + h;
        if (wc_e == h) {
#pragma unroll
          for (int n = 0; n < 8; ++n) {
            const int cl = n * 16 + fq_e * 4;
            f32x4 b4 = {0.f, 0.f, 0.f, 0.f};
            if (epi.pre_bias) b4 = *(const f32x4*)(epi.pre_bias + epi.norig(nt2, cl));
#pragma unroll
            for (int m = 0; m < 4; ++m) {
              const int rl = rw + m * 16 + fr_e;
              const int pos = rig0 + rl;
              const bool ok = pos >= 0 && pos < grows;
              f32x4 vv = acc[m][n] + b4;
              if (!ok) vv = (f32x4){0.f, 0.f, 0.f, 0.f};
              *(f32x4*)(Z + rl * 132 + cl) = vv;
            }
          }
        }
        __syncthreads();
        epi.finish(Z, g, rig0, nt2);
        __syncthreads();
      }
    }
    asm volatile("s_waitcnt vmcnt(0)" ::: "memory");
    __syncthreads();
  }
}

__device__ __forceinline__ void phase_attn(CP& p, char* smem, int vid0, int grid) {
  bf16_t* Ks = (bf16_t*)smem;
  bf16_t* Vs = (bf16_t*)(smem + 64 * 104 * 2);
  const int tid = get_tid(), lane = tid & 63, w = tid >> 6, r = lane & 31, hh = lane >> 5;
  const float cs = 1.4426950408889634f * 0.10206207261596577f;
  for (int it = vid0; it < 2048; it += grid) {
    const int qt = it & 15, h = (it >> 4) & 15, b = it >> 8;
    const int t = qt * 128 + w * 32 + r;
    const size_t xrow = (size_t)b * 2048 + t;
    const bf16_t* qp = p.Q + xrow * 1536 + h * 96;
    bf16x8 qf[6];
#pragma unroll
    for (int kk = 0; kk < 4; ++kk) qf[kk] = *(const bf16x8*)(qp + 16 * kk + 8 * hh);
#pragma unroll
    for (int part = 0; part < 2; ++part) {
      const bf16_t* pp = qp + 64 + 16 * part;
      const bf16x8 mine = *(const bf16x8*)(pp + 8 * hh), oth = *(const bf16x8*)(pp + 8 * (1 - hh));
      const float posf = part == 0 ? (float)(t >> 6) : (float)(t & 63);
      union { unsigned u[4]; bf16x8 v; } o;
      float res[8];
#pragma unroll
      for (int j = 0; j < 8; ++j) {
        const float inv = exp2f(-(float)j * (13.287712379549449f / 8.0f));
        const float ang = posf * inv;
        const float c = __cosf(ang), s = __sinf(ang);
        const float m = bf2f((bf16_t)mine[j]), ov = bf2f((bf16_t)oth[j]);
        res[j] = m * c + (hh ? ov : -ov) * s;
      }
#pragma unroll
      for (int j = 0; j < 4; ++j) o.u[j] = pack2(res[2 * j], res[2 * j + 1]);
      qf[4 + part] = o.v;
    }
    f32x16 oacc[2];
#pragma unroll
    for (int i = 0; i < 16; ++i) { oacc[0][i] = 0.f; oacc[1][i] = 0.f; }
    float mrun = -INFINITY, lrun = 0.f;
    const size_t kvrow0 = (size_t)b * 2304;
    const bf16_t* kn_base = p.Kn + kvrow0 * 1024 + h * 64;
    const bf16_t* kpe_base = p.kpe + kvrow0 * 32;
    const bf16_t* vt_base = p.Vt + ((size_t)(b * 16 + h) * 64) * 2304;
    uint4 rk0, rk1, rp, rv0, rv1;
    const int srow = tid >> 3, sch = tid & 7;
#define ATT_GLOAD(kt) do { \
      rk0 = *(const uint4*)(kn_base + (size_t)((kt) * 64 + srow) * 1024 + sch * 8); \
      rk1 = *(const uint4*)(kn_base + (size_t)((kt) * 64 + srow + 32) * 1024 + sch * 8); \
      rv0 = *(const uint4*)(vt_base + (size_t)srow * 2304 + (kt) * 64 + sch * 8); \
      rv1 = *(const uint4*)(vt_base + (size_t)(srow + 32) * 2304 + (kt) * 64 + sch * 8); \
      rp = *(const uint4*)(kpe_base + (size_t)((kt) * 64 + (tid >> 2)) * 32 + (tid & 3) * 8); } while (0)
    ATT_GLOAD(0);
    for (int kt = 0; kt < 36; ++kt) {
      __syncthreads();
      {
        *(uint4*)(Ks + srow * 104 + sch * 8) = rk0;
        *(uint4*)(Ks + (srow + 32) * 104 + sch * 8) = rk1;
        uint2 lo, hi;
        lo.x = rv0.x; lo.y = rv0.y; hi.x = rv0.z; hi.y = rv0.w;
        *(uint2*)(Vs + srow * 68 + sch * 8) = lo; *(uint2*)(Vs + srow * 68 + sch * 8 + 4) = hi;
        lo.x = rv1.x; lo.y = rv1.y; hi.x = rv1.z; hi.y = rv1.w;
        *(uint2*)(Vs + (srow + 32) * 68 + sch * 8) = lo; *(uint2*)(Vs + (srow + 32) * 68 + sch * 8 + 4) = hi;
      }
      *(uint4*)(Ks + (tid >> 2) * 104 + 64 + (tid & 3) * 8) = rp;
      __syncthreads();
      if (kt + 1 < 36) ATT_GLOAD(kt + 1);
      f32x16 s[2];
#pragma unroll
      for (int t2 = 0; t2 < 2; ++t2) {
#pragma unroll
        for (int i = 0; i < 16; ++i) s[t2][i] = 0.f;
#pragma unroll
        for (int kk = 0; kk < 6; ++kk) {
          const bf16x8 a = *(const bf16x8*)(Ks + (32 * t2 + r) * 104 + 16 * kk + 8 * hh);
          s[t2] = __builtin_amdgcn_mfma_f32_32x32x16_bf16(a, qf[kk], s[t2], 0, 0, 0);
        }
      }
      float mx = s[0][0];
#pragma unroll
      for (int i = 1; i < 16; ++i) mx = fmaxf(mx, s[0][i]);
#pragma unroll
      for (int i = 0; i < 16; ++i) mx = fmaxf(mx, s[1][i]);
      mx = fmaxf(mx, __shfl_xor(mx, 32));
      const float mnew = fmaxf(mrun, mx * cs);
      const float alpha = __builtin_amdgcn_exp2f(mrun - mnew);
      mrun = mnew;
      float psum = 0.f;
      bf16x8 pf[4];
#pragma unroll
      for (int t2 = 0; t2 < 2; ++t2)
#pragma unroll
        for (int hf = 0; hf < 2; ++hf) {
          union { unsigned u[4]; bf16x8 v; } cvp;
#pragma unroll
          for (int i = 0; i < 4; ++i) {
            const float p0 = __builtin_amdgcn_exp2f(s[t2][hf * 8 + 2 * i] * cs - mnew);
            const float p1 = __builtin_amdgcn_exp2f(s[t2][hf * 8 + 2 * i + 1] * cs - mnew);
            psum += p0 + p1;
            cvp.u[i] = pack2(p0, p1);
          }
          pf[t2 * 2 + hf] = cvp.v;
        }
      lrun = lrun * alpha + psum;
#pragma unroll
      for (int i = 0; i < 16; ++i) { oacc[0][i] *= alpha; oacc[1][i] *= alpha; }
#pragma unroll
      for (int dt = 0; dt < 2; ++dt)
#pragma unroll
        for (int s4 = 0; s4 < 4; ++s4) {
          const bf16_t* vp = Vs + (32 * dt + r) * 68 + 16 * s4 + 4 * hh;
          const uint2 lo = *(const uint2*)vp, hi = *(const uint2*)(vp + 8);
          union { uint4 u; bf16x8 v; } cv; cv.u.x = lo.x; cv.u.y = lo.y; cv.u.z = hi.x; cv.u.w = hi.y;
          oacc[dt] = __builtin_amdgcn_mfma_f32_32x32x16_bf16(cv.v, pf[s4], oacc[dt], 0, 0, 0);
        }
    }
    const float ltot = lrun + __shfl_xor(lrun, 32);
    const float inv = 1.f / ltot;
    bf16_t* op = p.hxc + xrow * 1024 + h * 64;
#pragma unroll
    for (int dt = 0; dt < 2; ++dt)
#pragma unroll
      for (int i4 = 0; i4 < 4; ++i4) {
        const int d = 32 * dt + 8 * i4 + 4 * hh;
        uint2 u; u.x = pack2(oacc[dt][4 * i4] * inv, oacc[dt][4 * i4 + 1] * inv); u.y = pack2(oacc[dt][4 * i4 + 2] * inv, oacc[dt][4 * i4 + 3] * inv);
        *(uint2*)(op + d) = u;
      }
  }
}

__device__ __forceinline__ void phase_hyconv(CP& p, char* smem) {
  bf16_t* cp = (bf16_t*)smem;
  bf16_t* Vl = (bf16_t*)(smem + 4 * 8256);
  const int tid = get_tid(), lane = tid & 63, w = tid >> 6, i16 = lane & 15, g4 = lane >> 4;
  const int si = (-i16) & 3;
  const int ocb = 64 * w;
  for (int c = get_bid(); c < 1024; c += VGRID) {
    __syncthreads();
#pragma unroll
    for (int i = 0; i < 2; ++i) { const int ch = tid + 256 * i; *(uint4*)(cp + ch * 8) = *(const uint4*)(p.Rf + (size_t)c * 4096 + ch * 8); }
#pragma unroll
    for (int i = 0; i < 8; ++i) {
      const int q = tid + 256 * i; const int b = q >> 8, l8 = q & 255; const int m1 = l8 >> 3, m2 = (l8 & 7) * 8;
      *(uint4*)(Vl + (8 + m1 * 8 + b) * 80 + m2) = *(const uint4*)(p.vvT + (size_t)c * 16384 + b * 2048 + l8 * 8);
    }
    if (tid < 144) {
      const int colp = tid / 9, part = tid - colp * 9;
      const int col = colp < 8 ? colp : 256 + colp;
      uint4 zz; zz.x = 0; zz.y = 0; zz.z = 0; zz.w = 0;
      *(uint4*)(Vl + col * 80 + part * 8) = zz;
    }
    __syncthreads();
#pragma unroll
    for (int s = 1; s < 4; ++s)
#pragma unroll
      for (int i = 0; i < 2; ++i) {
        const int ch = tid + 256 * i;
        unsigned e[8];
#pragma unroll
        for (int j = 0; j < 8; ++j) { const int idx = 8 * ch + s + j; e[j] = idx < 4096 ? (unsigned)cp[idx] : 0u; }
        uint4 u; u.x = e[0] | (e[1] << 16); u.y = e[2] | (e[3] << 16); u.z = e[4] | (e[5] << 16); u.w = e[6] | (e[7] << 16);
        *(uint4*)(cp + s * 4128 + 8 * ch) = u;
      }
    __syncthreads();
    const bf16_t* abase = cp + si * 4128 + (2048 - i16 - si + 8 * g4);
    f32x4 acc[4][4];
#pragma unroll
    for (int m = 0; m < 4; ++m)
#pragma unroll
      for (int n = 0; n < 4; ++n) acc[m][n] = (f32x4){0.f, 0.f, 0.f, 0.f};
    for (int dl = -31; dl <= 31; ++dl) {
      bf16x8 af[4][2];
#pragma unroll
      for (int mt = 0; mt < 4; ++mt)
#pragma unroll
        for (int kk = 0; kk < 2; ++kk) {
          const bf16_t* ap = abase - 64 * dl - 16 * mt + 32 * kk;
          const uint2 lo = *(const uint2*)ap, hi = *(const uint2*)(ap + 4);
          union { uint4 u; bf16x8 v; } cv; cv.u.x = lo.x; cv.u.y = lo.y; cv.u.z = hi.x; cv.u.w = hi.y;
          af[mt][kk] = cv.v;
        }
#pragma unroll
      for (int jt = 0; jt < 4; ++jt) {
        const int in0 = ocb + 16 * jt - 8 * dl;
        if (in0 >= -8 && in0 <= 248) {
          const bf16_t* bp = Vl + (in0 + 8 + i16) * 80 + 8 * g4;
          const bf16x8 b0 = *(const bf16x8*)bp, b1 = *(const bf16x8*)(bp + 32);
#pragma unroll
          for (int mt = 0; mt < 4; ++mt) {
            acc[mt][jt] = __builtin_amdgcn_mfma_f32_16x16x32_bf16(af[mt][0], b0, acc[mt][jt], 0, 0, 0);
            acc[mt][jt] = __builtin_amdgcn_mfma_f32_16x16x32_bf16(af[mt][1], b1, acc[mt][jt], 0, 0, 0);
          }
        }
      }
    }
    const float db = p.hy_d_bias[c];
#pragma unroll
    for (int mt = 0; mt < 4; ++mt)
#pragma unroll
      for (int jt = 0; jt < 4; ++jt) {
        const int col = ocb + 16 * jt + i16;
        const int n1 = col >> 3, b = col & 7;
        const int n2 = 16 * mt + 4 * g4;
        const uint2 vv = *(const uint2*)(Vl + (col + 8) * 80 + n2);
        const float y0 = acc[mt][jt][0] + bf2f((bf16_t)(vv.x & 0xffff)) * db;
        const float y1 = acc[mt][jt][1] + bf2f((bf16_t)(vv.x >> 16)) * db;
        const float y2 = acc[mt][jt][2] + bf2f((bf16_t)(vv.y & 0xffff)) * db;
        const float y3 = acc[mt][jt][3] + bf2f((bf16_t)(vv.y >> 16)) * db;
        uint2 u; u.x = pack2(y0, y1); u.y = pack2(y2, y3);
        *(uint2*)(p.Yp + (size_t)c * 16384 + b * 2048 + n1 * 64 + n2) = u;
      }
  }
}

__device__ __forceinline__ void phase_transmul(CP& p, char* smem) {
  bf16_t* tl = (bf16_t*)smem;
  const int tid = get_tid();
  for (int it = get_bid(); it < 4096; it += VGRID) {
    const int ct = it & 15, rt = it >> 4;
    const int c0 = ct * 64, r0 = rt * 64;
    __syncthreads();
#pragma unroll
    for (int i = 0; i < 2; ++i) {
      const int ci = tid + 256 * i; const int cc = ci >> 3, ch = ci & 7;
      const uint4 u = *(const uint4*)(p.Yp + (size_t)(c0 + cc) * 16384 + r0 + ch * 8);
      unsigned* d = (unsigned*)(tl + cc * 66 + ch * 8);
      d[0] = u.x; d[1] = u.y; d[2] = u.z; d[3] = u.w;
    }
    __syncthreads();
    const int row = tid >> 2, cq = tid & 3;
    const bf16_t* xp = p.x1h + (size_t)(r0 + row) * 1024 + c0 + cq * 16;
    const uint4 xa = *(const uint4*)xp, xb = *(const uint4*)(xp + 8);
    const unsigned xs[8] = {xa.x, xa.y, xa.z, xa.w, xb.x, xb.y, xb.z, xb.w};
    unsigned o[8];
#pragma unroll
    for (int j = 0; j < 8; ++j) {
      const float y0 = bf2f(tl[(cq * 16 + 2 * j) * 66 + row]) * bf2f((bf16_t)(xs[j] & 0xffff));
      const float y1 = bf2f(tl[(cq * 16 + 2 * j + 1) * 66 + row]) * bf2f((bf16_t)(xs[j] >> 16));
      o[j] = pack2(y0, y1);
    }
    bf16_t* op = p.hxc + (size_t)(r0 + row) * 1024 + c0 + cq * 16;
    uint4 oa; oa.x = o[0]; oa.y = o[1]; oa.z = o[2]; oa.w = o[3];
    uint4 ob; ob.x = o[4]; ob.y = o[5]; ob.z = o[6]; ob.w = o[7];
    *(uint4*)op = oa; *(uint4*)(op + 8) = ob;
  }
}

__global__ void __launch_bounds__(512, 2) mega(P p_arg) {
  __shared__ __attribute__((aligned(16))) char smem[LDS_BYTES];
  cg::grid_group grid = cg::this_grid();
  const int G = gridDim.x;
  CP* pp = (CP*)__builtin_amdgcn_kernarg_segment_ptr();
  const int ph0 = pp->ph0, ph1 = pp->ph1;
  volatile LAS unsigned* xst = (volatile LAS unsigned*)(smem + LDS_BYTES - 16);
  if (threadIdx.x == 0) { xst[0] = 0u; xst[1] = 0u; }
  __syncthreads();
  const XcdBarrier xb = xcd_barrier_post(pp->bar, xst);
  if (ph0 <= 0 && 0 < ph1) {
    asm volatile("" : "+s"(pp));
    CP& p = *pp;
    const int bid = get_rbid();
    const int vid0 = (G & 7) ? bid : ((bid & 7) * (G >> 3) + (bid >> 3));
    const int hb = get_hb();
    char* smem_h = smem + hb * HALF_LDS; (void)smem_h;
    const float* mv0 = p.modv; const float* mv1 = p.modv + (size_t)9 * 6144;
    (void)mv0; (void)mv1; (void)vid0;
    phase_prep(p, smem_h);
    if (0 + 1 < ph1) { if (ph1 > 1000) grid.sync(); else xcd_barrier(xb); }
  }
  if (ph0 <= 1 && 1 < ph1) {
    asm volatile("" : "+s"(pp));
    CP& p = *pp;
    const int bid = get_rbid();
    const int vid0 = (G & 7) ? bid : ((bid & 7) * (G >> 3) + (bid >> 3));
    const int hb = get_hb();
    char* smem_h = smem + hb * HALF_LDS; (void)smem_h;
    const float* mv0 = p.modv; const float* mv1 = p.modv + (size_t)9 * 6144;
    (void)mv0; (void)mv1; (void)vid0;
    phase_normmod_kv(p);
    if (1 + 1 < ph1) { if (ph1 > 1000) grid.sync(); else xcd_barrier(xb); }
  }
  if (ph0 <= 2 && 2 < ph1) {
    asm volatile("" : "+s"(pp));
    CP& p = *pp;
    const int bid = get_rbid();
    const int vid0 = (G & 7) ? bid : ((bid & 7) * (G >> 3) + (bid >> 3));
    const int hb = get_hb();
    char* smem_h = smem + hb * HALF_LDS; (void)smem_h;
    const float* mv0 = p.modv; const float* mv1 = p.modv + (size_t)9 * 6144;
    (void)mv0; (void)mv1; (void)vid0;
    {
        EpiStore e1{p.cq, 512, 2048, nullptr};
        gemm_job<true>(smem, p.hxc, 1024, p.wt_dq, 1024, 512, 16, 2304, 256, 128, 0, 2048, 128, 0, vid0, G, e1);
        EpiStore e2{p.kv, 288, 2304, nullptr};
        gemm_job<true>(smem, p.hxc, 1024, p.wt_dkv, 1024, 288, 18, 2304, 0, 128, 0, 2304, 144, 64 * 2, vid0, G, e2);
        EpiFilt e3{p.Rf, p.hy_decay};
        gemm_job<false>(smem, p.h2bf, 64, p.wt_f3, 64, 2048, 16, 0, 0, 128, 0, 2048, 16, 64 * 2 + 72 * 2, vid0, G, e3);
      }
    if (2 + 1 < ph1) { if (ph1 > 1000) grid.sync(); else xcd_barrier(xb); }
  }
  if (ph0 <= 3 && 3 < ph1) {
    asm volatile("" : "+s"(pp));
    CP& p = *pp;
    const int bid = get_rbid();
    const int vid0 = (G & 7) ? bid : ((bid & 7) * (G >> 3) + (bid >> 3));
    const int hb = get_hb();
    char* smem_h = smem + hb * HALF_LDS; (void)smem_h;
    const float* mv0 = p.modv; const float* mv1 = p.modv + (size_t)9 * 6144;
    (void)mv0; (void)mv1; (void)vid0;
    phase_rowstat(p);
    if (3 + 1 < ph1) { if (ph1 > 1000) grid.sync(); else xcd_barrier(xb); }
  }
  if (ph0 <= 4 && 4 < ph1) {
    asm volatile("" : "+s"(pp));
    CP& p = *pp;
    const int bid = get_rbid();
    const int vid0 = (G & 7) ? bid : ((bid & 7) * (G >> 3) + (bid >> 3));
    const int hb = get_hb();
    char* smem_h = smem + hb * HALF_LDS; (void)smem_h;
    const float* mv0 = p.modv; const float* mv1 = p.modv + (size_t)9 * 6144;
    (void)mv0; (void)mv1; (void)vid0;
    {
        EpiStore e1{p.Q, 1536, 2048, p.rq};
        gemm_job<true>(smem, p.cq, 512, p.wt_uq, 512, 1536, 16, 2048, 0, 128, 0, 2048, 128, 0, vid0, G, e1);
        EpiStore e2{p.Kn, 1024, 2304, p.rkv};
        gemm_job<true>(smem, p.kv, 288, p.wt_uk, 256, 1024, 18, 2304, 0, 128, 0, 2304, 144, 64 * 6, vid0, G, e2);
        EpiVt e3{p.Vt, p.rkv};
        gemm_job<false>(smem, p.kv, 288, p.wt_uv, 256, 1024, 18, 2304, 0, 128, 0, 2304, 144, 64 * 6 + 72 * 4, vid0, G, e3);
      }
    if (4 + 1 < ph1) { if (ph1 > 1000) grid.sync(); else xcd_barrier(xb); }
  }
  if (ph0 <= 5 && 5 < ph1) {
    asm volatile("" : "+s"(pp));
    CP& p = *pp;
    const int bid = get_rbid();
    const int vid0 = (G & 7) ? bid : ((bid & 7) * (G >> 3) + (bid >> 3));
    const int hb = get_hb();
    char* smem_h = smem + hb * HALF_LDS; (void)smem_h;
    const float* mv0 = p.modv; const float* mv1 = p.modv + (size_t)9 * 6144;
    (void)mv0; (void)mv1; (void)vid0;
    phase_attn(p, smem_h, 2 * vid0 + hb, 2 * G);
    if (5 + 1 < ph1) { if (ph1 > 1000) grid.sync(); else xcd_barrier(xb); }
  }
  if (ph0 <= 6 && 6 < ph1) {
    asm volatile("" : "+s"(pp));
    CP& p = *pp;
    const int bid = get_rbid();
    const int vid0 = (G & 7) ? bid : ((bid & 7) * (G >> 3) + (bid >> 3));
    const int hb = get_hb();
    char* smem_h = smem + hb * HALF_LDS; (void)smem_h;
    const float* mv0 = p.modv; const float* mv1 = p.modv + (size_t)9 * 6144;
    (void)mv0; (void)mv1; (void)vid0;
    {
        EpiResid<true> e{p.X16, p.x, mv0 + 2 * 1024, nullptr};
        gemm_job<true>(smem, p.hxc, 1024, p.wt_o, 1024, 1024, 16, 2048, 0, 128, 0, 2048, 128, 0, vid0, G, e);
      }
    if (6 + 1 < ph1) { if (ph1 > 1000) grid.sync(); else xcd_barrier(xb); }
  }
  if (ph0 <= 7 && 7 < ph1) {
    asm volatile("" : "+s"(pp));
    CP& p = *pp;
    const int bid = get_rbid();
    const int vid0 = (G & 7) ? bid : ((bid & 7) * (G >> 3) + (bid >> 3));
    const int hb = get_hb();
    char* smem_h = smem + hb * HALF_LDS; (void)smem_h;
    const float* mv0 = p.modv; const float* mv1 = p.modv + (size_t)9 * 6144;
    (void)mv0; (void)mv1; (void)vid0;
    phase_normmod_x(p, p.norm_ffn_g, 0, 3);
    if (7 + 1 < ph1) { if (ph1 > 1000) grid.sync(); else xcd_barrier(xb); }
  }
  if (ph0 <= 8 && 8 < ph1) {
    asm volatile("" : "+s"(pp));
    CP& p = *pp;
    const int bid = get_rbid();
    const int vid0 = (G & 7) ? bid : ((bid & 7) * (G >> 3) + (bid >> 3));
    const int hb = get_hb();
    char* smem_h = smem + hb * HALF_LDS; (void)smem_h;
    const float* mv0 = p.modv; const float* mv1 = p.modv + (size_t)9 * 6144;
    (void)mv0; (void)mv1; (void)vid0;
    {
        EpiConv<0> e{p.ffn_conv_w, p.ffn_conv_b, 5632, nullptr, p.act, nullptr};
        gemm_job<true>(smem, p.hxc, 1024, p.wt_up0, 1024, 5632, 17, 2048, 0, 126, 1, 2048, 136, 0, vid0, G, e);
      }
    if (8 + 1 < ph1) { if (ph1 > 1000) grid.sync(); else xcd_barrier(xb); }
  }
  if (ph0 <= 9 && 9 < ph1) {
    asm volatile("" : "+s"(pp));
    CP& p = *pp;
    const int bid = get_rbid();
    const int vid0 = (G & 7) ? bid : ((bid & 7) * (G >> 3) + (bid >> 3));
    const int hb = get_hb();
    char* smem_h = smem + hb * HALF_LDS; (void)smem_h;
    const float* mv0 = p.modv; const float* mv1 = p.modv + (size_t)9 * 6144;
    (void)mv0; (void)mv1; (void)vid0;
    {
        EpiResid<false> e{p.X16, p.X16, mv0 + 5 * 1024, nullptr};
        gemm_job<true>(smem, p.act, 2816, p.wt_dn0, 2816, 1024, 16, 2048, 0, 128, 0, 2048, 128, 0, vid0, G, e);
      }
    if (9 + 1 < ph1) { if (ph1 > 1000) grid.sync(); else xcd_barrier(xb); }
  }
  if (ph0 <= 10 && 10 < ph1) {
    asm volatile("" : "+s"(pp));
    CP& p = *pp;
    const int bid = get_rbid();
    const int vid0 = (G & 7) ? bid : ((bid & 7) * (G >> 3) + (bid >> 3));
    const int hb = get_hb();
    char* smem_h = smem + hb * HALF_LDS; (void)smem_h;
    const float* mv0 = p.modv; const float* mv1 = p.modv + (size_t)9 * 6144;
    (void)mv0; (void)mv1; (void)vid0;
    phase_normmod_x(p, p.norm_mix_g + 1024, 1, 0);
    if (10 + 1 < ph1) { if (ph1 > 1000) grid.sync(); else xcd_barrier(xb); }
  }
  if (ph0 <= 11 && 11 < ph1) {
    asm volatile("" : "+s"(pp));
    CP& p = *pp;
    const int bid = get_rbid();
    const int vid0 = (G & 7) ? bid : ((bid & 7) * (G >> 3) + (bid >> 3));
    const int hb = get_hb();
    char* smem_h = smem + hb * HALF_LDS; (void)smem_h;
    const float* mv0 = p.modv; const float* mv1 = p.modv + (size_t)9 * 6144;
    (void)mv0; (void)mv1; (void)vid0;
    {
        EpiConv<1> e{p.hy_conv_w, p.hy_conv_b, 3072, p.hy_b_in, p.x1h, p.vvT};
        gemm_job<true>(smem, p.hxc, 1024, p.wt_hin, 1024, 3072, 17, 2048, 0, 126, 1, 2048, 136, 0, vid0, G, e);
      }
    if (11 + 1 < ph1) { if (ph1 > 1000) grid.sync(); else xcd_barrier(xb); }
  }
  if (ph0 <= 12 && 12 < ph1) {
    asm volatile("" : "+s"(pp));
    CP& p = *pp;
    const int bid = get_rbid();
    const int vid0 = (G & 7) ? bid : ((bid & 7) * (G >> 3) + (bid >> 3));
    const int hb = get_hb();
    char* smem_h = smem + hb * HALF_LDS; (void)smem_h;
    const float* mv0 = p.modv; const float* mv1 = p.modv + (size_t)9 * 6144;
    (void)mv0; (void)mv1; (void)vid0;
    phase_hyconv(p, smem_h);
    if (12 + 1 < ph1) { if (ph1 > 1000) grid.sync(); else xcd_barrier(xb); }
  }
  if (ph0 <= 13 && 13 < ph1) {
    asm volatile("" : "+s"(pp));
    CP& p = *pp;
    const int bid = get_rbid();
    const int vid0 = (G & 7) ? bid : ((bid & 7) * (G >> 3) + (bid >> 3));
    const int hb = get_hb();
    char* smem_h = smem + hb * HALF_LDS; (void)smem_h;
    const float* mv0 = p.modv; const float* mv1 = p.modv + (size_t)9 * 6144;
    (void)mv0; (void)mv1; (void)vid0;
    phase_transmul(p, smem_h);
    if (13 + 1 < ph1) { if (ph1 > 1000) grid.sync(); else xcd_barrier(xb); }
  }
  if (ph0 <= 14 && 14 < ph1) {
    asm volatile("" : "+s"(pp));
    CP& p = *pp;
    const int bid = get_rbid();
    const int vid0 = (G & 7) ? bid : ((bid & 7) * (G >> 3) + (bid >> 3));
    const int hb = get_hb();
    char* smem_h = smem + hb * HALF_LDS; (void)smem_h;
    const float* mv0 = p.modv; const float* mv1 = p.modv + (size_t)9 * 6144;
    (void)mv0; (void)mv1; (void)vid0;
    {
        EpiResid<false> e{p.X16, p.X16, mv1 + 2 * 1024, p.hy_b_out};
        gemm_job<true>(smem, p.hxc, 1024, p.wt_hout, 1024, 1024, 16, 2048, 0, 128, 0, 2048, 128, 0, vid0, G, e);
      }
    if (14 + 1 < ph1) { if (ph1 > 1000) grid.sync(); else xcd_barrier(xb); }
  }
  if (ph0 <= 15 && 15 < ph1) {
    asm volatile("" : "+s"(pp));
    CP& p = *pp;
    const int bid = get_rbid();
    const int vid0 = (G & 7) ? bid : ((bid & 7) * (G >> 3) + (bid >> 3));
    const int hb = get_hb();
    char* smem_h = smem + hb * HALF_LDS; (void)smem_h;
    const float* mv0 = p.modv; const float* mv1 = p.modv + (size_t)9 * 6144;
    (void)mv0; (void)mv1; (void)vid0;
    phase_normmod_x(p, p.norm_ffn_g + 1024, 1, 3);
    if (15 + 1 < ph1) { if (ph1 > 1000) grid.sync(); else xcd_barrier(xb); }
  }
  if (ph0 <= 16 && 16 < ph1) {
    asm volatile("" : "+s"(pp));
    CP& p = *pp;
    const int bid = get_rbid();
    const int vid0 = (G & 7) ? bid : ((bid & 7) * (G >> 3) + (bid >> 3));
    const int hb = get_hb();
    char* smem_h = smem + hb * HALF_LDS; (void)smem_h;
    const float* mv0 = p.modv; const float* mv1 = p.modv + (size_t)9 * 6144;
    (void)mv0; (void)mv1; (void)vid0;
    {
        EpiConv<0> e{p.ffn_conv_w + (size_t)3 * 5632, p.ffn_conv_b + 5632, 5632, nullptr, p.act, nullptr};
        gemm_job<true>(smem, p.hxc, 1024, p.wt_up1, 1024, 5632, 17, 2048, 0, 126, 1, 2048, 136, 0, vid0, G, e);
      }
    if (16 + 1 < ph1) { if (ph1 > 1000) grid.sync(); else xcd_barrier(xb); }
  }
  if (ph0 <= 17 && 17 < ph1) {
    asm volatile("" : "+s"(pp));
    CP& p = *pp;
    const int bid = get_rbid();
    const int vid0 = (G & 7) ? bid : ((bid & 7) * (G >> 3) + (bid >> 3));
    const int hb = get_hb();
    char* smem_h = smem + hb * HALF_LDS; (void)smem_h;
    const float* mv0 = p.modv; const float* mv1 = p.modv + (size_t)9 * 6144;
    (void)mv0; (void)mv1; (void)vid0;
    {
        EpiResid<false> e{p.X16, p.X16, mv1 + 5 * 1024, nullptr};
        gemm_job<true>(smem, p.act, 2816, p.wt_dn1, 2816, 1024, 16, 2048, 0, 128, 0, 2048, 128, 0, vid0, G, e);
      }
    if (17 + 1 < ph1) { if (ph1 > 1000) grid.sync(); else xcd_barrier(xb); }
  }
  if (ph0 <= 18 && 18 < ph1) {
    asm volatile("" : "+s"(pp));
    CP& p = *pp;
    const int bid = get_rbid();
    const int vid0 = (G & 7) ? bid : ((bid & 7) * (G >> 3) + (bid >> 3));
    const int hb = get_hb();
    char* smem_h = smem + hb * HALF_LDS; (void)smem_h;
    const float* mv0 = p.modv; const float* mv1 = p.modv + (size_t)9 * 6144;
    (void)mv0; (void)mv1; (void)vid0;
    phase_final_norm(p);
    if (18 + 1 < ph1) { if (ph1 > 1000) grid.sync(); else xcd_barrier(xb); }
  }
}

extern "C" void kernel_launch(void* const* d_in, const int* in_sizes, int n_in, void* d_out, int out_size, void* d_ws, size_t ws_size, hipStream_t stream) {
  static int grid_blocks = 0;
  if (!grid_blocks) {
    int dev = 0, cus = 0, per_cu = 0;
    hipGetDevice(&dev);
    hipDeviceGetAttribute(&cus, hipDeviceAttributeMultiprocessorCount, dev);
    hipOccupancyMaxActiveBlocksPerMultiprocessor(&per_cu, (const void*)mega, 512, 0);
    per_cu = 1;
    grid_blocks = cus * per_cu;
  }
  P p{};
  const float** in = (const float**)&p;
  for (int i = 0; i < 36; ++i) in[i] = (const float*)d_in[i];
  p.X = (float*)d_out;
  char* ws = (char*)d_ws; size_t off = 0;
  auto take = [&](size_t bytes) { char* r = ws + off; off += (bytes + 255) & ~(size_t)255; return r; };
  p.wt_dq = (bf16_t*)take((size_t)512 * 1024 * 2);
  p.wt_dkv = (bf16_t*)take((size_t)288 * 1024 * 2);
  p.wt_uq = (bf16_t*)take((size_t)1536 * 512 * 2);
  p.wt_uk = (bf16_t*)take((size_t)1024 * 256 * 2);
  p.wt_uv = (bf16_t*)take((size_t)1024 * 256 * 2);
  p.wt_o = (bf16_t*)take((size_t)1024 * 1024 * 2);
  p.wt_hin = (bf16_t*)take((size_t)3072 * 1024 * 2);
  p.wt_hout = (bf16_t*)take((size_t)1024 * 1024 * 2);
  p.wt_up0 = (bf16_t*)take((size_t)5632 * 1024 * 2);
  p.wt_up1 = (bf16_t*)take((size_t)5632 * 1024 * 2);
  p.wt_dn0 = (bf16_t*)take((size_t)1024 * 2816 * 2);
  p.wt_dn1 = (bf16_t*)take((size_t)1024 * 2816 * 2);
  p.modv = (float*)take((size_t)2 * 9 * 6144 * 4);
  p.rq = (float*)take((size_t)16384 * 4);
  p.rkv = (float*)take((size_t)18432 * 4);
  p.modp = (float*)take((size_t)4 * 110592 * 4);
  p.bar = (unsigned*)take((size_t)XCD_BAR_WORDS * 4);
  p.wt_f3 = (bf16_t*)take((size_t)2048 * 64 * 2);
  p.h2bf = (bf16_t*)take((size_t)2048 * 64 * 2);
  p.Rf = (bf16_t*)take((size_t)1024 * 4096 * 2);
  p.kpe = (bf16_t*)take((size_t)18432 * 32 * 2);
  p.hxc = (bf16_t*)take((size_t)18432 * 1024 * 2);
  const size_t ubase = off;
  p.cq = (bf16_t*)take((size_t)16384 * 512 * 2);
  p.kv = (bf16_t*)take((size_t)18432 * 288 * 2);
  p.Q = (bf16_t*)take((size_t)16384 * 1536 * 2);
  p.Kn = (bf16_t*)take((size_t)18432 * 1024 * 2);
  p.Vt = (bf16_t*)take((size_t)18432 * 1024 * 2);
  const size_t uend1 = off;
  p.X16 = (bf16_t*)(ws + ubase + (size_t)104857600);
  off = ubase;
  p.act = (bf16_t*)take((size_t)16384 * 2816 * 2);
  off = ubase;
  p.x1h = (bf16_t*)take((size_t)16384 * 1024 * 2);
  p.vvT = (bf16_t*)take((size_t)16384 * 1024 * 2);
  p.Yp = (bf16_t*)take((size_t)16384 * 1024 * 2);
  if (uend1 > ws_size) { fprintf(stderr, "workspace too small: need %zu have %zu\n", uend1, ws_size); return; }
  p.ph0 = 0; p.ph1 = NPHASE;
  if (hipMemsetAsync(p.bar, 0, (size_t)XCD_BAR_WORDS * 4, stream) != hipSuccess) { fprintf(stderr, "memset failed\n"); return; }
  void* args[] = {&p};
  hipError_t e = hipLaunchCooperativeKernel((const void*)mega, dim3(grid_blocks), dim3(512), args, 0, stream);
  if (e != hipSuccess) fprintf(stderr, "cooperative launch failed: %s (grid %d)\n", hipGetErrorString(e), grid_blocks);
}
```

```cpp
#include <hip/hip_runtime.h>
#include <hip/hip_cooperative_groups.h>
#include <cstdio>
namespace cg = cooperative_groups;

typedef unsigned short bf16_t;
typedef short bf16x8 __attribute__((ext_vector_type(8)));
typedef float f32x4 __attribute__((ext_vector_type(4)));
typedef float f32x16 __attribute__((ext_vector_type(16)));

#define LDS_BYTES 163840
#define HALF_LDS 81920
#define NPHASE 19

struct P {
  const float *x, *c, *ctx, *c_ctx, *mod_w, *mod_b, *norm_mix_g, *norm_ffn_g;
  const float *w_dq, *g_q, *w_uq, *w_dkv, *g_kv, *w_uk, *w_uv, *w_o;
  const float *hy_w_in, *hy_b_in, *hy_conv_w, *hy_conv_b, *f_w1, *f_b1, *f_freq1, *f_w2, *f_b2, *f_freq2, *f_w3, *hy_decay, *hy_d_bias, *hy_w_out, *hy_b_out;
  const float *ffn_w_up, *ffn_conv_w, *ffn_conv_b, *ffn_w_down, *final_g;
  float* X;
  bf16_t *wt_dq, *wt_dkv, *wt_uq, *wt_uk, *wt_uv, *wt_o, *wt_hin, *wt_hout, *wt_up0, *wt_up1, *wt_dn0, *wt_dn1;
  float *modv, *rq, *rkv, *modp;
  unsigned* bar;
  bf16_t *wt_f3, *h2bf, *X16;
  bf16_t *Rf, *kpe, *hxc, *cq, *kv, *Q, *Kn, *Vt, *act, *x1h, *vvT, *Yp;
  int ph0, ph1;
};

typedef const __attribute__((address_space(4))) P CP;
__device__ __forceinline__ int get_tid512() { int t = threadIdx.x; asm volatile("" : "+v"(t)); return t; }
__device__ __forceinline__ int get_tid() { int t = threadIdx.x & 255; asm volatile("" : "+v"(t)); return t; }
__device__ __forceinline__ int get_hb() { int t = __builtin_amdgcn_readfirstlane((int)(threadIdx.x >> 8)); asm volatile("" : "+s"(t)); return t; }
__device__ __forceinline__ int get_rbid() { int t = blockIdx.x; asm volatile("" : "+s"(t)); return t; }
__device__ __forceinline__ int get_bid() { return 2 * get_rbid() + get_hb(); }
#define VGRID (2 * (int)gridDim.x)

__device__ __forceinline__ unsigned pack2(float a, float b) { unsigned r; asm("v_cvt_pk_bf16_f32 %0, %1, %2" : "=v"(r) : "v"(a), "v"(b)); return r; }
__device__ __forceinline__ bf16_t f2bf(float f) { return (bf16_t)(pack2(f, f) & 0xffffu); }
__device__ __forceinline__ float bf2f(bf16_t h) { return __uint_as_float(((unsigned)h) << 16); }
__device__ __forceinline__ float wave_sum(float v) {
#pragma unroll
  for (int o = 32; o; o >>= 1) v += __shfl_xor(v, o);
  return v;
}


#define XB_TMO      128
#define XB_XCNT(j)  (256  + 64 * (j))
#define XB_XSUB(j)  (1280 + 64 * (j))
#define XB_XGEN(j)  (2304 + 64 * (j))
#define XB_TOP      3328
#define XB_TOPGEN   3392
#define XCD_BAR_WORDS 3456
#define XB_SPIN_CAP (1u << 18)
#define LAS __attribute__((address_space(3)))
__device__ __forceinline__ unsigned xb_ld(unsigned* p)              { return __hip_atomic_load(p, __ATOMIC_RELAXED, __HIP_MEMORY_SCOPE_AGENT); }
__device__ __forceinline__ unsigned xb_add(unsigned* p, unsigned v) { return __hip_atomic_fetch_add(p, v, __ATOMIC_RELAXED, __HIP_MEMORY_SCOPE_AGENT); }
__device__ __forceinline__ unsigned xb_xcc_id() { return (unsigned)__builtin_amdgcn_s_getreg((3 << 11) | 20) & 0xFu; }
#define XB_SPIN(cond, bar) do { unsigned _sp = 0; while (cond) { __builtin_amdgcn_s_sleep(1); \
    if ((++_sp & 255u) == 0u) { if (xb_ld(&(bar)[XB_TMO])) break; if (_sp > XB_SPIN_CAP) { atomicAdd(&(bar)[XB_TMO], 1u); break; } } } } while (0)
struct XcdBarrier { unsigned* bar; unsigned x; volatile LAS unsigned* st; };
__device__ __forceinline__ XcdBarrier xcd_barrier_post(unsigned* bar, volatile LAS unsigned* st) {
    XcdBarrier b; b.bar = bar; b.x = xb_xcc_id(); b.st = st;
    if (threadIdx.x == 0) (void)xb_add(&bar[XB_XCNT(b.x)], 1u);
    return b;
}
__device__ __forceinline__ void xcd_barrier_complete(unsigned* bar, unsigned x, unsigned& nloc, unsigned& nx) {
    const unsigned G = gridDim.x * gridDim.y * gridDim.z;
    unsigned sum, cnt, mine, sp = 0u;
    for (;;) {
        sum = 0u; cnt = 0u; mine = 0u;
#pragma unroll
        for (unsigned j = 0; j < 16; ++j) { const unsigned c = xb_ld(&bar[XB_XCNT(j)]); sum += c; cnt += (c > 0u) ? 1u : 0u; mine = (j == x) ? c : mine; }
        if (sum == G) break;
        __builtin_amdgcn_s_sleep(1);
        if ((++sp & 255u) == 0u) { if (xb_ld(&bar[XB_TMO])) break; if (sp > XB_SPIN_CAP) { atomicAdd(&bar[XB_TMO], 1u); break; } }
    }
    nloc = mine > 0u ? mine : 1u; nx = cnt > 0u ? cnt : 1u;
}
__device__ __forceinline__ void xcd_barrier(const XcdBarrier& b) {
    asm volatile("s_waitcnt vmcnt(0)" ::: "memory");
    __syncthreads();
    if (threadIdx.x == 0) {
        unsigned* bar = b.bar;
        __builtin_amdgcn_s_waitcnt(0);
        unsigned nloc = b.st[0], nx = b.st[1];
        if (nloc == 0u) { xcd_barrier_complete(bar, b.x, nloc, nx); b.st[0] = nloc; b.st[1] = nx; }
        const unsigned old = xb_add(&bar[XB_XSUB(b.x)], 1u);
        const unsigned gen = old / nloc;
        if (old + 1u == (gen + 1u) * nloc) {
            __builtin_amdgcn_fence(__ATOMIC_RELEASE, "agent");
            asm volatile("s_waitcnt vmcnt(0)" ::: "memory");
            const unsigned og = xb_add(&bar[XB_TOP], 1u);
            const unsigned tg = og / nx;
            if (og + 1u == (tg + 1u) * nx) xb_add(&bar[XB_TOPGEN], 1u);
            else XB_SPIN(xb_ld(&bar[XB_TOPGEN]) == tg, bar);
            __builtin_amdgcn_fence(__ATOMIC_ACQUIRE, "agent");
            xb_add(&bar[XB_XGEN(b.x)], 1u);
            asm volatile("s_waitcnt vmcnt(0)" ::: "memory");
        } else {
            XB_SPIN(xb_ld(&bar[XB_XGEN(b.x)]) == gen, bar);
            __builtin_amdgcn_fence(__ATOMIC_ACQUIRE, "agent");
            asm volatile("s_waitcnt vmcnt(0)" ::: "memory");
        }
    }
    __syncthreads();
}

__device__ __forceinline__ void prep_weight_tile(CP& p, char* smem, int wt) {
  const int tid = get_tid();
  int id = 0;
  {
    const int cnt[13] = {64, 40, 96, 32, 32, 128, 384, 128, 704, 704, 352, 352, 32};
#pragma unroll
    for (int i = 0; i < 12; ++i) { if (id == i && wt >= cnt[i]) { wt -= cnt[i]; id = i + 1; } }
  }
  const float* src; int K, N; bf16_t* dst; const float* scale = nullptr; int perm = 0;
  switch (id) {
    case 0: src = p.w_dq; K = 1024; N = 512; dst = p.wt_dq; break;
    case 1: src = p.w_dkv; K = 1024; N = 288; dst = p.wt_dkv; break;
    case 2: src = p.w_uq; K = 512; N = 1536; dst = p.wt_uq; scale = p.g_q; break;
    case 3: src = p.w_uk; K = 256; N = 1024; dst = p.wt_uk; scale = p.g_kv; break;
    case 4: src = p.w_uv; K = 256; N = 1024; dst = p.wt_uv; scale = p.g_kv; break;
    case 5: src = p.w_o; K = 1024; N = 1024; dst = p.wt_o; break;
    case 6: src = p.hy_w_in; K = 1024; N = 3072; dst = p.wt_hin; perm = 2; break;
    case 7: src = p.hy_w_out; K = 1024; N = 1024; dst = p.wt_hout; break;
    case 8: src = p.ffn_w_up; K = 1024; N = 5632; dst = p.wt_up0; perm = 1; break;
    case 9: src = p.ffn_w_up + (size_t)1024 * 5632; K = 1024; N = 5632; dst = p.wt_up1; perm = 1; break;
    case 10: src = p.ffn_w_down; K = 2816; N = 1024; dst = p.wt_dn0; break;
    case 11: src = p.ffn_w_down + (size_t)2816 * 1024; K = 2816; N = 1024; dst = p.wt_dn1; break;
    default: src = p.f_w3; K = 64; N = 2048; dst = p.wt_f3; break;
  }
  const int ntn = (N + 63) >> 6;
  const int kt = wt / ntn, nt = wt - kt * ntn;
  const int k0 = kt * 128, n0 = nt * 64;
  int np0;
  if (perm == 1) { const int half = n0 / 2816, f = n0 - half * 2816; np0 = (f >> 6) * 128 + half * 64; }
  else if (perm == 2) { if (n0 < 1024) np0 = n0; else { const int m = n0 - 1024, half = m >> 10, f = m & 1023; np0 = 1024 + (f >> 6) * 128 + half * 64; } }
  else np0 = n0;
  bf16_t* t16 = (bf16_t*)smem;
  f32x4 v[8];
#pragma unroll
  for (int i = 0; i < 8; ++i) {
    const int idx = tid + 256 * i; const int kr = idx >> 4, c4 = idx & 15;
    v[i] = (f32x4){0.f, 0.f, 0.f, 0.f};
    if (n0 + 4 * c4 < N && k0 + kr < K) v[i] = *(const f32x4*)(src + (size_t)(k0 + kr) * N + n0 + 4 * c4);
  }
#pragma unroll
  for (int i = 0; i < 8; ++i) {
    const int idx = tid + 256 * i; const int kr = idx >> 4, c4 = idx & 15;
    const float sc = (scale && k0 + kr < K) ? scale[k0 + kr] : 1.f;
#pragma unroll
    for (int j = 0; j < 4; ++j) t16[(4 * c4 + j) * 136 + kr] = f2bf(v[i][j] * sc);
  }
  __syncthreads();
#pragma unroll
  for (int i = 0; i < 4; ++i) {
    const int idx = tid + 256 * i; const int n = idx >> 4, ch = idx & 15;
    if (n0 + n < N && k0 + ch * 8 < K) *(uint4*)(dst + (size_t)(np0 + n) * K + k0 + ch * 8) = *(const uint4*)(t16 + n * 136 + ch * 8);
  }
  __syncthreads();
}

__device__ __forceinline__ void prep_modvec(CP& p, char* smem, int it) {
  const int tid = get_tid();
  const int layer = it / 384, rem = it - layer * 384, cb = rem >> 2, ks = rem & 3;
  float* s_lds = (float*)smem;
  float* red = (float*)(smem + 12288);
  const int kbase = ks * 256;
  for (int idx = tid; idx < 9 * 256; idx += 256) {
    const int r = idx >> 8, k = idx & 255;
    const float v = r < 8 ? p.c[r * 1024 + kbase + k] : p.c_ctx[kbase + k];
    s_lds[k * 12 + r] = v / (1.f + __expf(-v));
  }
  __syncthreads();
  const int col = cb * 64 + (tid & 63), kg = tid >> 6;
  const float* W = p.mod_w + (size_t)layer * 1024 * 6144 + (size_t)kbase * 6144 + col;
  float acc[9];
#pragma unroll
  for (int r = 0; r < 9; ++r) acc[r] = 0.f;
#pragma unroll
  for (int kb = 0; kb < 4; ++kb) {
    float w[16];
#pragma unroll
    for (int u = 0; u < 16; ++u) w[u] = W[(size_t)(kg * 64 + kb * 16 + u) * 6144];
#pragma unroll
    for (int u = 0; u < 16; ++u) {
      const int k = kg * 64 + kb * 16 + u;
      const f32x4 s0 = *(const f32x4*)(s_lds + k * 12), s1 = *(const f32x4*)(s_lds + k * 12 + 4);
      const float s2 = s_lds[k * 12 + 8];
      acc[0] += s0[0] * w[u]; acc[1] += s0[1] * w[u]; acc[2] += s0[2] * w[u]; acc[3] += s0[3] * w[u];
      acc[4] += s1[0] * w[u]; acc[5] += s1[1] * w[u]; acc[6] += s1[2] * w[u]; acc[7] += s1[3] * w[u];
      acc[8] += s2 * w[u];
    }
  }
#pragma unroll
  for (int r = 0; r < 9; ++r) red[(kg * 9 + r) * 64 + (tid & 63)] = acc[r];
  __syncthreads();
  for (int o = tid; o < 9 * 64; o += 256) {
    const int r = o >> 6, cl = o & 63;
    const float sm = red[(0 * 9 + r) * 64 + cl] + red[(1 * 9 + r) * 64 + cl] + red[(2 * 9 + r) * 64 + cl] + red[(3 * 9 + r) * 64 + cl];
    p.modp[(size_t)ks * 110592 + (size_t)(layer * 9 + r) * 6144 + cb * 64 + cl] = sm;
  }
  __syncthreads();
}

__device__ __forceinline__ void prep_filter(CP& p, char* smem, int it) {
  const int tid = get_tid();
  float* z = (float*)smem;
  float* h1 = z + 8 * 33;
  float* h2 = h1 + 8 * 64;
  const int t0 = it * 8;
  for (int idx = tid; idx < 8 * 33; idx += 256) {
    const int pp = idx / 33, i = idx - pp * 33;
    const int t = t0 + pp;
    float v;
    if (i == 0) v = (float)t * (1.0f / 2047.0f);
    else {
      const int k = (i - 1) & 15;
      const float w = (6.283185307179586f * (float)t) / 2048.0f;
      const float f = 1e-4f + (float)k * ((15.0f - 1e-4f) / 15.0f);
      const float a = w * f;
      v = (i <= 16) ? __cosf(a) : -__sinf(a);
    }
    z[idx] = v;
  }
  __syncthreads();
  for (int idx = tid; idx < 8 * 64; idx += 256) {
    const int pp = idx >> 6, j = idx & 63;
    float s = p.f_b1[j];
#pragma unroll
    for (int i = 0; i < 33; ++i) s += z[pp * 33 + i] * p.f_w1[i * 64 + j];
    h1[idx] = __sinf(p.f_freq1[j] * s);
  }
  __syncthreads();
  for (int idx = tid; idx < 8 * 64; idx += 256) {
    const int pp = idx >> 6, j = idx & 63;
    float s = p.f_b2[j];
#pragma unroll 16
    for (int i = 0; i < 64; ++i) s += h1[pp * 64 + i] * p.f_w2[i * 64 + j];
    h2[idx] = __sinf(p.f_freq2[j] * s);
  }
  __syncthreads();
  for (int idx = tid; idx < 8 * 64; idx += 256) p.h2bf[(size_t)t0 * 64 + idx] = f2bf(h2[idx]);
  __syncthreads();
}

__device__ __forceinline__ void phase_prep(CP& p, char* smem) {
  const int total = 768 + 256 + 3048;
  for (int it = get_bid(); it < total; it += VGRID) {
    if (it < 768) prep_modvec(p, smem, it);
    else if (it < 1024) prep_filter(p, smem, it - 768);
    else prep_weight_tile(p, smem, it - 1024);
  }
}

__device__ __forceinline__ f32x4 ld4_bf16(const bf16_t* p) {
  const uint2 u = *(const uint2*)p;
  f32x4 r; r[0] = bf2f((bf16_t)(u.x & 0xffff)); r[1] = bf2f((bf16_t)(u.x >> 16)); r[2] = bf2f((bf16_t)(u.y & 0xffff)); r[3] = bf2f((bf16_t)(u.y >> 16));
  return r;
}
template <bool PART, bool SRC16 = false>
__device__ __forceinline__ void normmod_row2(const void* __restrict__ srcv, const float* __restrict__ g, const float* __restrict__ sh, const float* __restrict__ sc, bf16_t* __restrict__ dst, int lane, const float* __restrict__ bsh = nullptr) {
  f32x4 v[2][4]; float ss0 = 0.f, ss1 = 0.f;
#pragma unroll
  for (int i = 0; i < 4; ++i) {
    if (SRC16) { v[0][i] = ld4_bf16((const bf16_t*)srcv + lane * 4 + 256 * i); v[1][i] = ld4_bf16((const bf16_t*)srcv + 1024 + lane * 4 + 256 * i); }
    else { v[0][i] = *(const f32x4*)((const float*)srcv + lane * 4 + 256 * i); v[1][i] = *(const f32x4*)((const float*)srcv + 1024 + lane * 4 + 256 * i); }
  }
#pragma unroll
  for (int i = 0; i < 4; ++i) {
    ss0 += v[0][i][0] * v[0][i][0] + v[0][i][1] * v[0][i][1] + v[0][i][2] * v[0][i][2] + v[0][i][3] * v[0][i][3];
    ss1 += v[1][i][0] * v[1][i][0] + v[1][i][1] * v[1][i][1] + v[1][i][2] * v[1][i][2] + v[1][i][3] * v[1][i][3];
  }
  ss0 = wave_sum(ss0); ss1 = wave_sum(ss1);
  const float r0 = rsqrtf(ss0 * (1.0f / 1024.0f) + 1e-6f), r1 = rsqrtf(ss1 * (1.0f / 1024.0f) + 1e-6f);
#pragma unroll
  for (int i = 0; i < 4; ++i) {
    const int k = lane * 4 + 256 * i;
    const f32x4 g4 = *(const f32x4*)(g + k);
    f32x4 s4 = *(const f32x4*)(sh + k), c4 = *(const f32x4*)(sc + k);
    if (PART) {
#pragma unroll
      for (int q = 1; q < 4; ++q) { s4 += *(const f32x4*)(sh + (size_t)q * 110592 + k); c4 += *(const f32x4*)(sc + (size_t)q * 110592 + k); }
      s4 += *(const f32x4*)(bsh + k); c4 += *(const f32x4*)(bsh + 1024 + k);
    }
    float y[4], z[4];
#pragma unroll
    for (int j = 0; j < 4; ++j) { const float gm = g4[j] * (1.f + c4[j]); y[j] = (v[0][i][j] * r0) * gm + s4[j]; z[j] = (v[1][i][j] * r1) * gm + s4[j]; }
    uint2 u; u.x = pack2(y[0], y[1]); u.y = pack2(y[2], y[3]);
    *(uint2*)(dst + k) = u;
    u.x = pack2(z[0], z[1]); u.y = pack2(z[2], z[3]);
    *(uint2*)(dst + 1024 + k) = u;
  }
}

__device__ __forceinline__ void phase_normmod_kv(CP& p) {
  const int lane = get_tid() & 63, wv = get_tid() >> 6;
  const float* g = p.norm_mix_g;
  for (int idx = get_bid() * 256 + get_tid(); idx < 110592; idx += VGRID * 256) {
    const int lr = idx / 6144; const int n = idx - lr * 6144; const int layer = lr / 9;
    p.modv[idx] = p.modp[idx] + p.modp[110592 + idx] + p.modp[2 * 110592 + idx] + p.modp[3 * 110592 + idx] + p.mod_b[layer * 6144 + n];
  }
  for (int r = (get_bid() * 4 + wv) * 2; r < 18432; r += VGRID * 8) {
    const int b = r / 2304, pp = r - b * 2304;
    const float* src; const float* mv;
    if (pp < 256) { src = p.ctx + ((size_t)b * 256 + pp) * 1024; mv = p.modp + (size_t)8 * 6144; }
    else { src = p.x + ((size_t)b * 2048 + pp - 256) * 1024; mv = p.modp + (size_t)b * 6144; }
    normmod_row2<true>(src, g, mv, mv + 1024, p.hxc + (size_t)r * 1024, lane, p.mod_b);
  }
}
__device__ __forceinline__ void phase_normmod_x(CP& p, const float* g, int layer, int chunk) {
  const int lane = get_tid() & 63, wv = get_tid() >> 6;
  for (int r = (get_bid() * 4 + wv) * 2; r < 16384; r += VGRID * 8) {
    const int b = r >> 11;
    const float* mv = p.modv + (size_t)(layer * 9 + b) * 6144 + chunk * 1024;
    normmod_row2<false, true>(p.X16 + (size_t)r * 1024, g, mv, mv + 1024, p.hxc + (size_t)r * 1024, lane);
  }
}
__device__ __forceinline__ void phase_final_norm(CP& p) {
  const int lane = get_tid() & 63, wv = get_tid() >> 6;
  for (int r = get_bid() * 4 + wv; r < 16384; r += VGRID * 4) {
    const bf16_t* srow = p.X16 + (size_t)r * 1024;
    float* row = p.X + (size_t)r * 1024;
    f32x4 v[4]; float ss = 0.f;
#pragma unroll
    for (int i = 0; i < 4; ++i) { v[i] = ld4_bf16(srow + lane * 4 + 256 * i); ss += v[i][0] * v[i][0] + v[i][1] * v[i][1] + v[i][2] * v[i][2] + v[i][3] * v[i][3]; }
    ss = wave_sum(ss);
    const float rr = rsqrtf(ss * (1.0f / 1024.0f) + 1e-6f);
#pragma unroll
    for (int i = 0; i < 4; ++i) {
      const int k = lane * 4 + 256 * i;
      const f32x4 g4 = *(const f32x4*)(p.final_g + k);
      f32x4 o; o[0] = v[i][0] * rr * g4[0]; o[1] = v[i][1] * rr * g4[1]; o[2] = v[i][2] * rr * g4[2]; o[3] = v[i][3] * rr * g4[3];
      *(f32x4*)(row + k) = o;
    }
  }
}

__device__ __forceinline__ void phase_rowstat(CP& p) {
  const int lane = get_tid() & 63, wv = get_tid() >> 6;
  for (int r = get_bid() * 4 + wv; r < 18432; r += VGRID * 4) {
    const int b = r / 2304, pp = r - b * 2304;
    const bf16_t* kvr = p.kv + (size_t)r * 288;
    {
      const uint2 u = *(const uint2*)(kvr + lane * 4);
      const float a0 = bf2f((bf16_t)(u.x & 0xffff)), a1 = bf2f((bf16_t)(u.x >> 16)), a2 = bf2f((bf16_t)(u.y & 0xffff)), a3 = bf2f((bf16_t)(u.y >> 16));
      float ss = a0 * a0 + a1 * a1 + a2 * a2 + a3 * a3;
      ss = wave_sum(ss);
      if (lane == 0) p.rkv[r] = rsqrtf(ss * (1.0f / 256.0f) + 1e-6f);
    }
    {
      const int i = lane & 31;
      const float xv = bf2f(kvr[256 + i]);
      const float ov = __shfl_xor(xv, 8);
      float res = xv;
      if (pp >= 256) {
        const int t = pp - 256;
        const int quarter = i >> 3, idx = i & 7;
        const float pos = (quarter < 2) ? (float)(t >> 6) : (float)(t & 63);
        const float inv = exp2f(-(float)idx * (13.287712379549449f / 8.0f));
        const float ang = pos * inv;
        const float cs = __cosf(ang), sn = __sinf(ang);
        res = xv * cs + ((quarter & 1) ? ov : -ov) * sn;
      }
      if (lane < 32) p.kpe[(size_t)r * 32 + i] = f2bf(res);
    }
    if (pp >= 256) {
      const int xr = b * 2048 + pp - 256;
      const uint4 u = *(const uint4*)(p.cq + (size_t)xr * 512 + lane * 8);
      const unsigned uu[4] = {u.x, u.y, u.z, u.w};
      float ss = 0.f;
#pragma unroll
      for (int j = 0; j < 4; ++j) { const float a = bf2f((bf16_t)(uu[j] & 0xffff)), bb = bf2f((bf16_t)(uu[j] >> 16)); ss += a * a + bb * bb; }
      ss = wave_sum(ss);
      if (lane == 0) p.rq[xr] = rsqrtf(ss * (1.0f / 512.0f) + 1e-6f);
    }
  }
}

struct EpiStore {
  static constexpr int KIND = 0;
  bf16_t* out; int ld; int ostride; const float* rs;
  __device__ __forceinline__ void c4(int g, int rig, int col, f32x4 v) const {
    const size_t row = (size_t)g * ostride + rig;
    const float s = rs ? rs[row] : 1.f;
    uint2 u; u.x = pack2(v[0] * s, v[1] * s); u.y = pack2(v[2] * s, v[3] * s);
    *(uint2*)(out + row * ld + col) = u;
  }
};
struct EpiVt {
  static constexpr int KIND = 1;
  bf16_t* out; const float* rs;
  __device__ __forceinline__ void r4(int g, int rig, int col, f32x4 v) const {
    const size_t row = (size_t)g * 2304 + rig;
    const f32x4 s = *(const f32x4*)(rs + row);
    uint2 u; u.x = pack2(v[0] * s[0], v[1] * s[1]); u.y = pack2(v[2] * s[2], v[3] * s[3]);
    *(uint2*)(out + ((size_t)g * 1024 + col) * 2304 + rig) = u;
  }
};
struct EpiFilt {
  static constexpr int KIND = 1;
  bf16_t* Rf; const float* decay;
  __device__ __forceinline__ void r4(int g, int rig, int col, f32x4 v) const {
    const int c = col & 1023; const bool bwd = col >= 1024;
    const float dec = fabsf(decay[c]);
    bf16_t* rp = Rf + (size_t)c * 4096;
#pragma unroll
    for (int j = 0; j < 4; ++j) {
      const int t = rig + j;
      const float val = v[j] * __expf(-(float)t * (1.0f / 2047.0f) * dec);
      if (!bwd) rp[2048 - t] = f2bf(val);
      else if (t > 0) rp[2048 + t] = f2bf(val);
      else rp[0] = 0;
    }
  }
};
template <bool BASE_F32>
struct EpiResid {
  static constexpr int KIND = 0;
  bf16_t* X16; const void* base; const float* gate; const float* bias;
  __device__ __forceinline__ void c4(int g, int rig, int col, f32x4 v) const {
    const size_t o = ((size_t)g * 2048 + rig) * 1024 + col;
    f32x4 bs;
    if (BASE_F32) bs = *(const f32x4*)((const float*)base + o);
    else {
      const uint2 u = *(const uint2*)((const bf16_t*)base + o);
      bs[0] = bf2f((bf16_t)(u.x & 0xffff)); bs[1] = bf2f((bf16_t)(u.x >> 16)); bs[2] = bf2f((bf16_t)(u.y & 0xffff)); bs[3] = bf2f((bf16_t)(u.y >> 16));
    }
    const f32x4 gt = *(const f32x4*)(gate + (size_t)g * 6144 + col);
    f32x4 bi = {0.f, 0.f, 0.f, 0.f};
    if (bias) bi = *(const f32x4*)(bias + col);
    f32x4 r;
#pragma unroll
    for (int j = 0; j < 4; ++j) r[j] = bs[j] + gt[j] * (v[j] + bi[j]);
    uint2 w; w.x = pack2(r[0], r[1]); w.y = pack2(r[2], r[3]);
    *(uint2*)(X16 + o) = w;
  }
};
template <int MODE>
struct EpiConv {
  static constexpr int KIND = 2;
  const float* cw; const float* cb; int NC; const float* pre_bias;
  bf16_t* o0; bf16_t* o1;
  __device__ __forceinline__ int norig(int nt, int cl) const {
    if (MODE == 0) return (cl >> 6) * 2816 + nt * 64 + (cl & 63);
    if (nt < 8) return nt * 128 + cl;
    return 1024 + (cl >> 6) * 1024 + (nt - 8) * 64 + (cl & 63);
  }
  typedef float f32x2_t __attribute__((ext_vector_type(2)));
  static __device__ __forceinline__ f32x2_t ldz(const bf16_t* Z, int row, int col) {
    const unsigned u = *(const unsigned*)(Z + row * 132 + col);
    f32x2_t r; r[0] = __uint_as_float(u << 16); r[1] = __uint_as_float(u & 0xffff0000u); return r;
  }
  template <class F>
  __device__ __forceinline__ void finish(const bf16_t* Z, int g, int rig0, int nt, F&& pre) const {
    typedef f32x2_t f32x2;
    const int tid = get_tid();
    if (MODE == 0 || nt < 8) {
      if (MODE == 0) {
        const int f2 = (tid & 31) * 2, q8 = tid >> 5;
        const int q0 = 1 + 16 * q8, q1 = (q0 + 16 < 127) ? q0 + 16 : 127;
        const int na = norig(nt, f2), ng = norig(nt, 64 + f2);
        const f32x2 a0 = *(const f32x2*)(cw + na), a1 = *(const f32x2*)(cw + NC + na), a2 = *(const f32x2*)(cw + 2 * NC + na), ab = *(const f32x2*)(cb + na);
        const f32x2 g0 = *(const f32x2*)(cw + ng), g1 = *(const f32x2*)(cw + NC + ng), g2 = *(const f32x2*)(cw + 2 * NC + ng), gb = *(const f32x2*)(cb + ng);
        pre();
        f32x2 am = ldz(Z, q0 - 1, f2), ac = ldz(Z, q0, f2);
        f32x2 gm = ldz(Z, q0 - 1, 64 + f2), gc = ldz(Z, q0, 64 + f2);
#pragma unroll 2
        for (int pl = q0; pl < q1; ++pl) {
          const f32x2 an = ldz(Z, pl + 1, f2), gn = ldz(Z, pl + 1, 64 + f2);
          const int pos = rig0 + pl;
          if (pos < 2048) {
            const f32x2 av = a0 * am + a1 * ac + a2 * an + ab;
            const f32x2 gv = g0 * gm + g1 * gc + g2 * gn + gb;
            const float s0 = av[0] * gv[0] * __builtin_amdgcn_rcpf(1.f + __expf(-gv[0]));
            const float s1 = av[1] * gv[1] * __builtin_amdgcn_rcpf(1.f + __expf(-gv[1]));
            *(unsigned*)(o0 + ((size_t)g * 2048 + pos) * 2816 + nt * 64 + f2) = pack2(s0, s1);
          }
          am = ac; ac = an; gm = gc; gc = gn;
        }
      } else {
        const int cl = (tid & 63) * 2, q = tid >> 6;
        const int p0 = 1 + 32 * q, p1 = (p0 + 32 < 127) ? p0 + 32 : 127;
        const int na = norig(nt, cl);
        const f32x2 a0 = *(const f32x2*)(cw + na), a1 = *(const f32x2*)(cw + NC + na), a2 = *(const f32x2*)(cw + 2 * NC + na), ab = *(const f32x2*)(cb + na);
        pre();
        f32x2 am = ldz(Z, p0 - 1, cl), ac = ldz(Z, p0, cl);
#pragma unroll 2
        for (int pl = p0; pl < p1; ++pl) {
          const f32x2 an = ldz(Z, pl + 1, cl);
          const int pos = rig0 + pl;
          if (pos < 2048) {
            const f32x2 av = a0 * am + a1 * ac + a2 * an + ab;
            *(unsigned*)(o0 + ((size_t)g * 2048 + pos) * 1024 + nt * 128 + cl) = pack2(av[0], av[1]);
          }
          am = ac; ac = an;
        }
      }
    } else {
      pre();
      const int pl = tid & 127, fh = tid >> 7;
      const int pos = rig0 + pl;
      if (pl >= 1 && pl <= 126 && pos < 2048) {
        const int fb = nt - 8;
#pragma unroll 2
        for (int f = fh * 32; f < fh * 32 + 32; f += 2) {
          const int na = norig(nt, f), nb = norig(nt, 64 + f);
          const f32x2 va = *(const f32x2*)(cw + na) * ldz(Z, pl - 1, f) + *(const f32x2*)(cw + NC + na) * ldz(Z, pl, f)
                         + *(const f32x2*)(cw + 2 * NC + na) * ldz(Z, pl + 1, f) + *(const f32x2*)(cb + na);
          const f32x2 vb = *(const f32x2*)(cw + nb) * ldz(Z, pl - 1, 64 + f) + *(const f32x2*)(cw + NC + nb) * ldz(Z, pl, 64 + f)
                         + *(const f32x2*)(cw + 2 * NC + nb) * ldz(Z, pl + 1, 64 + f) + *(const f32x2*)(cb + nb);
          bf16_t* op = o1 + (size_t)(fb * 64 + f) * 16384 + g * 2048 + pos;
          op[0] = f2bf(va[0] * vb[0]);
          op[16384] = f2bf(va[1] * vb[1]);
        }
      }
    }
  }
};

#define GLDS16(gp, lp) __builtin_amdgcn_global_load_lds((const unsigned*)(gp), (__attribute__((address_space(3))) unsigned*)(lp), 16, 0, 0)

template <bool SWAP, class Epi>
__device__ __forceinline__ void gemm_job(char* smem, const bf16_t* __restrict__ A, int lda, const bf16_t* __restrict__ Bt, int K, int N,
                                         int tpg, int a_gstride, int a_goff, int step, int halo, int grows, int MTS, int voff, int vid0, int grid, const Epi& epi) {
  const int tid = get_tid512(), lane = tid & 63, wid = tid >> 6, wr = wid >> 1, wc = wid & 1, fr = lane & 15, fq = lane >> 4;
  const int NT = (N + 255) >> 8, MT = MTS >> 1, ntiles = MT * NT, ns = K >> 6;
  const int full = MT >> 3;
  int v = vid0;
  if (v < voff) v += ((voff - v + grid - 1) / grid) * grid;
  const int swz = (fr >> 1) & 7;
  bool pre_issued = false;
  for (; v < voff + ntiles; v += grid) {
    const int w = v - voff;
    int mt, nt;
    if (w < full * 8 * NT) { const int sr = w / (8 * NT), rem = w - sr * 8 * NT; nt = rem >> 3; mt = sr * 8 + (rem & 7); }
    else { const int w2 = w - full * 8 * NT, rl = MT - full * 8; nt = w2 / rl; mt = full * 8 + (w2 - nt * rl); }
    unsigned ap[4], bp[4];
#pragma unroll
    for (int i = 0; i < 4; ++i) {
      const int r = (tid >> 3) + 64 * i;
      const int cs = tid & 7;
      const int c = ((cs ^ ((r >> 1) & 7)) << 3);
      const int sub = 2 * mt + (r >> 7);
      const int g = sub / tpg, ti = sub - g * tpg;
      int rig = ti * step - halo + (r & 127); rig = rig < 0 ? 0 : (rig > grows - 1 ? grows - 1 : rig);
      ap[i] = (unsigned)((g * a_gstride + a_goff + rig) * lda + c);
      int br = nt * 256 + r; br = br > N - 1 ? N - 1 : br;
      bp[i] = (unsigned)(br * K + c);
    }
    const bool have_next = (Epi::KIND == 2) && (v + grid < voff + ntiles);
    f32x4 acc[4][8];
#pragma unroll
    for (int m = 0; m < 4; ++m)
#pragma unroll
      for (int n = 0; n < 8; ++n) acc[m][n] = (f32x4){0.f, 0.f, 0.f, 0.f};
    if (!pre_issued) {
#pragma unroll
      for (int i = 0; i < 4; ++i) { GLDS16(A + (size_t)ap[i], smem + tid * 16 + i * 8192); GLDS16(Bt + (size_t)bp[i], smem + 32768 + tid * 16 + i * 8192); }
    }
    pre_issued = have_next;
    for (int st = 0; st < ns; ++st) {
      asm volatile("s_waitcnt vmcnt(0)" ::: "memory");
      __builtin_amdgcn_s_barrier();
      asm volatile("" ::: "memory");
      if (st + 1 < ns) {
        char* nb = smem + ((st + 1) & 1) * 65536;
        const int ko = (st + 1) * 64;
#pragma unroll
        for (int i = 0; i < 4; ++i) { GLDS16(A + (size_t)(ap[i] + ko), nb + tid * 16 + i * 8192); GLDS16(Bt + (size_t)(bp[i] + ko), nb + 32768 + tid * 16 + i * 8192); }
      }
      const char* sa = smem + (st & 1) * 65536 + (wr * 64 + fr) * 128;
      const char* sb = smem + (st & 1) * 65536 + 32768 + (wc * 128 + fr) * 128;
      bf16x8 afA[4], afB[4], bfb[2][2];
#pragma unroll
      for (int m = 0; m < 4; ++m) afA[m] = *(const bf16x8*)(sa + m * 2048 + ((fq ^ swz) << 4));
#pragma unroll
      for (int n = 0; n < 2; ++n) bfb[0][n] = *(const bf16x8*)(sb + n * 2048 + ((fq ^ swz) << 4));
#pragma unroll
      for (int gq = 0; gq < 8; ++gq) {
        const int ks = gq >> 2, nh = gq & 3;
        if (gq < 7) {
          const int ks2 = (gq + 1) >> 2, nh2 = (gq + 1) & 3;
#pragma unroll
          for (int n = 0; n < 2; ++n) bfb[(gq + 1) & 1][n] = *(const bf16x8*)(sb + (nh2 * 2 + n) * 2048 + (((ks2 * 4 + fq) ^ swz) << 4));
        }
        if (gq == 3) {
#pragma unroll
          for (int m = 0; m < 4; ++m) afB[m] = *(const bf16x8*)(sa + m * 2048 + (((4 + fq) ^ swz) << 4));
        }
        __builtin_amdgcn_sched_barrier(0);
#pragma unroll
        for (int m = 0; m < 4; ++m)
#pragma unroll
          for (int n = 0; n < 2; ++n) {
            const bf16x8 av = ks ? afB[m] : afA[m];
            acc[m][nh * 2 + n] = SWAP ? __builtin_amdgcn_mfma_f32_16x16x32_bf16(bfb[gq & 1][n], av, acc[m][nh * 2 + n], 0, 0, 0)
                                      : __builtin_amdgcn_mfma_f32_16x16x32_bf16(av, bfb[gq & 1][n], acc[m][nh * 2 + n], 0, 0, 0);
          }
      }
    }
    __syncthreads();
    const int te = get_tid512();
    const int fr_e = te & 15, fq_e = (te & 63) >> 4, wr_e = te >> 7, wc_e = (te >> 6) & 1;
    const int sub = 2 * mt + (wr_e >> 1);
    const int g = sub / tpg, ti = sub - g * tpg;
    const int rig0 = ti * step - halo;
    const int rw = (wr_e & 1) * 64;
    if constexpr (Epi::KIND == 0) {
#pragma unroll
      for (int m = 0; m < 4; ++m) {
        const int rig = rig0 + rw + m * 16 + fr_e;
#pragma unroll
        for (int n = 0; n < 8; ++n) {
          const int col = nt * 256 + wc_e * 128 + n * 16 + fq_e * 4;
          if (col < N) epi.c4(g, rig, col, acc[m][n]);
        }
      }
    } else if constexpr (Epi::KIND == 1) {
#pragma unroll
      for (int m = 0; m < 4; ++m) {
        const int rig = rig0 + rw + m * 16 + fq_e * 4;
#pragma unroll
        for (int n = 0; n < 8; ++n) {
          const int col = nt * 256 + wc_e * 128 + n * 16 + fr_e;
          if (col < N) epi.r4(g, rig, col, acc[m][n]);
        }
      }
    } else {
      bf16_t* Z = (bf16_t*)(smem + 65536) + (wr_e >> 1) * (128 * 132);
      auto no_pre = []() {};
      auto do_pre = [&]() {
        if (have_next) {
          const int t5 = get_tid512();
          const int w5 = v + grid - voff;
          int mt5, nt5;
          if (w5 < full * 8 * NT) { const int sr = w5 / (8 * NT), rem = w5 - sr * 8 * NT; nt5 = rem >> 3; mt5 = sr * 8 + (rem & 7); }
          else { const int w2 = w5 - full * 8 * NT, rl = MT - full * 8; nt5 = w2 / rl; mt5 = full * 8 + (w2 - nt5 * rl); }
#pragma unroll
          for (int i = 0; i < 4; ++i) {
            const int r = (t5 >> 3) + 64 * i;
            const int cs = t5 & 7;
            const int c = ((cs ^ ((r >> 1) & 7)) << 3);
            const int sub5 = 2 * mt5 + (r >> 7);
            const int g5 = sub5 / tpg, ti5 = sub5 - g5 * tpg;
            int rig = ti5 * step - halo + (r & 127); rig = rig < 0 ? 0 : (rig > grows - 1 ? grows - 1 : rig);
            int br = nt5 * 256 + r; br = br > N - 1 ? N - 1 : br;
            GLDS16(A + (size_t)(unsigned)((g5 * a_gstride + a_goff + rig) * lda + c), smem + t5 * 16 + i * 8192);
            GLDS16(Bt + (size_t)(unsigned)(br * K + c), smem + 32768 + t5 * 16 + i * 8192);
          }
        }
      };
#pragma unroll
      for (int h = 0; h < 2; ++h) {
        const int nt2 = nt * 2 + h;
        if (wc_e == h) {
#pragma unroll
          for (int n = 0; n < 8; ++n) {
            const int cl = n * 16 + fq_e * 4;
            f32x4 b4 = {0.f, 0.f, 0.f, 0.f};
            if (epi.pre_bias) b4 = *(const f32x4*)(epi.pre_bias + epi.norig(nt2, cl));
#pragma unroll
            for (int m = 0; m < 4; ++m) {
              const int rl = rw + m * 16 + fr_e;
              const int pos = rig0 + rl;
              const bool ok = pos >= 0 && pos < grows;
              f32x4 vv = acc[m][n] + b4;
              if (!ok) vv = (f32x4){0.f, 0.f, 0.f, 0.f};
              uint2 u; u.x = pack2(vv[0], vv[1]); u.y = pack2(vv[2], vv[3]);
              *(uint2*)(Z + rl * 132 + cl) = u;
            }
          }
        }
        __syncthreads();
        if (h == 0) epi.finish(Z, g, rig0, nt2, no_pre); else epi.finish(Z, g, rig0, nt2, do_pre);
        __syncthreads();
      }
    }
    asm volatile("s_waitcnt vmcnt(0)" ::: "memory");
    __syncthreads();
  }
}

__device__ __forceinline__ void phase_attn(CP& p, char* smem, int vid0, int grid) {
  bf16_t* Ks = (bf16_t*)smem;
  bf16_t* Vs = (bf16_t*)(smem + 64 * 104 * 2);
  const int tid = get_tid(), lane = tid & 63, w = tid >> 6, r = lane & 31, hh = lane >> 5;
  const float cs = 1.4426950408889634f * 0.10206207261596577f;
  for (int it = vid0; it < 2048; it += grid) {
    const int qt = it & 15, h = (it >> 4) & 15, b = it >> 8;
    const int t = qt * 128 + w * 32 + r;
    const size_t xrow = (size_t)b * 2048 + t;
    const bf16_t* qp = p.Q + xrow * 1536 + h * 96;
    bf16x8 qf[6];
#pragma unroll
    for (int kk = 0; kk < 4; ++kk) qf[kk] = *(const bf16x8*)(qp + 16 * kk + 8 * hh);
#pragma unroll
    for (int part = 0; part < 2; ++part) {
      const bf16_t* pp = qp + 64 + 16 * part;
      const bf16x8 mine = *(const bf16x8*)(pp + 8 * hh), oth = *(const bf16x8*)(pp + 8 * (1 - hh));
      const float posf = part == 0 ? (float)(t >> 6) : (float)(t & 63);
      union { unsigned u[4]; bf16x8 v; } o;
      float res[8];
#pragma unroll
      for (int j = 0; j < 8; ++j) {
        const float inv = exp2f(-(float)j * (13.287712379549449f / 8.0f));
        const float ang = posf * inv;
        const float c = __cosf(ang), s = __sinf(ang);
        const float m = bf2f((bf16_t)mine[j]), ov = bf2f((bf16_t)oth[j]);
        res[j] = m * c + (hh ? ov : -ov) * s;
      }
#pragma unroll
      for (int j = 0; j < 4; ++j) o.u[j] = pack2(res[2 * j], res[2 * j + 1]);
      qf[4 + part] = o.v;
    }
    f32x16 oacc[2];
#pragma unroll
    for (int i = 0; i < 16; ++i) { oacc[0][i] = 0.f; oacc[1][i] = 0.f; }
    float mrun = -INFINITY, lrun = 0.f;
    const size_t kvrow0 = (size_t)b * 2304;
    const bf16_t* kn_base = p.Kn + kvrow0 * 1024 + h * 64;
    const bf16_t* kpe_base = p.kpe + kvrow0 * 32;
    const bf16_t* vt_base = p.Vt + ((size_t)(b * 16 + h) * 64) * 2304;
    uint4 rk0, rk1, rp, rv0, rv1;
    const int srow = tid >> 3, sch = tid & 7;
#define ATT_GLOAD(kt) do { \
      rk0 = *(const uint4*)(kn_base + (size_t)((kt) * 64 + srow) * 1024 + sch * 8); \
      rk1 = *(const uint4*)(kn_base + (size_t)((kt) * 64 + srow + 32) * 1024 + sch * 8); \
      rv0 = *(const uint4*)(vt_base + (size_t)srow * 2304 + (kt) * 64 + sch * 8); \
      rv1 = *(const uint4*)(vt_base + (size_t)(srow + 32) * 2304 + (kt) * 64 + sch * 8); \
      rp = *(const uint4*)(kpe_base + (size_t)((kt) * 64 + (tid >> 2)) * 32 + (tid & 3) * 8); } while (0)
    ATT_GLOAD(0);
    for (int kt = 0; kt < 36; ++kt) {
      __syncthreads();
      {
        *(uint4*)(Ks + srow * 104 + sch * 8) = rk0;
        *(uint4*)(Ks + (srow + 32) * 104 + sch * 8) = rk1;
        uint2 lo, hi;
        lo.x = rv0.x; lo.y = rv0.y; hi.x = rv0.z; hi.y = rv0.w;
        *(uint2*)(Vs + srow * 68 + sch * 8) = lo; *(uint2*)(Vs + srow * 68 + sch * 8 + 4) = hi;
        lo.x = rv1.x; lo.y = rv1.y; hi.x = rv1.z; hi.y = rv1.w;
        *(uint2*)(Vs + (srow + 32) * 68 + sch * 8) = lo; *(uint2*)(Vs + (srow + 32) * 68 + sch * 8 + 4) = hi;
      }
      *(uint4*)(Ks + (tid >> 2) * 104 + 64 + (tid & 3) * 8) = rp;
      __syncthreads();
      if (kt + 1 < 36) ATT_GLOAD(kt + 1);
      f32x16 s[2];
#pragma unroll
      for (int t2 = 0; t2 < 2; ++t2) {
#pragma unroll
        for (int i = 0; i < 16; ++i) s[t2][i] = 0.f;
#pragma unroll
        for (int kk = 0; kk < 6; ++kk) {
          const bf16x8 a = *(const bf16x8*)(Ks + (32 * t2 + r) * 104 + 16 * kk + 8 * hh);
          s[t2] = __builtin_amdgcn_mfma_f32_32x32x16_bf16(a, qf[kk], s[t2], 0, 0, 0);
        }
      }
      float mx = s[0][0];
#pragma unroll
      for (int i = 1; i < 16; ++i) mx = fmaxf(mx, s[0][i]);
#pragma unroll
      for (int i = 0; i < 16; ++i) mx = fmaxf(mx, s[1][i]);
      mx = fmaxf(mx, __shfl_xor(mx, 32));
      const float mnew = fmaxf(mrun, mx * cs);
      const float alpha = __builtin_amdgcn_exp2f(mrun - mnew);
      mrun = mnew;
      float psum = 0.f;
      bf16x8 pf[4];
#pragma unroll
      for (int t2 = 0; t2 < 2; ++t2)
#pragma unroll
        for (int hf = 0; hf < 2; ++hf) {
          union { unsigned u[4]; bf16x8 v; } cvp;
#pragma unroll
          for (int i = 0; i < 4; ++i) {
            const float p0 = __builtin_amdgcn_exp2f(s[t2][hf * 8 + 2 * i] * cs - mnew);
            const float p1 = __builtin_amdgcn_exp2f(s[t2][hf * 8 + 2 * i + 1] * cs - mnew);
            psum += p0 + p1;
            cvp.u[i] = pack2(p0, p1);
          }
          pf[t2 * 2 + hf] = cvp.v;
        }
      lrun = lrun * alpha + psum;
#pragma unroll
      for (int i = 0; i < 16; ++i) { oacc[0][i] *= alpha; oacc[1][i] *= alpha; }
#pragma unroll
      for (int dt = 0; dt < 2; ++dt)
#pragma unroll
        for (int s4 = 0; s4 < 4; ++s4) {
          const bf16_t* vp = Vs + (32 * dt + r) * 68 + 16 * s4 + 4 * hh;
          const uint2 lo = *(const uint2*)vp, hi = *(const uint2*)(vp + 8);
          union { uint4 u; bf16x8 v; } cv; cv.u.x = lo.x; cv.u.y = lo.y; cv.u.z = hi.x; cv.u.w = hi.y;
          oacc[dt] = __builtin_amdgcn_mfma_f32_32x32x16_bf16(cv.v, pf[s4], oacc[dt], 0, 0, 0);
        }
    }
    const float ltot = lrun + __shfl_xor(lrun, 32);
    const float inv = 1.f / ltot;
    bf16_t* op = p.hxc + xrow * 1024 + h * 64;
#pragma unroll
    for (int dt = 0; dt < 2; ++dt)
#pragma unroll
      for (int i4 = 0; i4 < 4; ++i4) {
        const int d = 32 * dt + 8 * i4 + 4 * hh;
        uint2 u; u.x = pack2(oacc[dt][4 * i4] * inv, oacc[dt][4 * i4 + 1] * inv); u.y = pack2(oacc[dt][4 * i4 + 2] * inv, oacc[dt][4 * i4 + 3] * inv);
        *(uint2*)(op + d) = u;
      }
  }
}

__device__ __forceinline__ void phase_hyconv(CP& p, char* smem) {
  bf16_t* cp = (bf16_t*)smem;
  bf16_t* Vl = (bf16_t*)(smem + 4 * 8256);
  const int tid = get_tid(), lane = tid & 63, w = tid >> 6, i16 = lane & 15, g4 = lane >> 4;
  const int si = (-i16) & 3;
  const int ocb = 64 * w;
  for (int c = get_bid(); c < 1024; c += VGRID) {
    __syncthreads();
#pragma unroll
    for (int i = 0; i < 2; ++i) { const int ch = tid + 256 * i; *(uint4*)(cp + ch * 8) = *(const uint4*)(p.Rf + (size_t)c * 4096 + ch * 8); }
#pragma unroll
    for (int i = 0; i < 8; ++i) {
      const int q = tid + 256 * i; const int b = q >> 8, l8 = q & 255; const int m1 = l8 >> 3, m2 = (l8 & 7) * 8;
      *(uint4*)(Vl + (8 + m1 * 8 + b) * 80 + m2) = *(const uint4*)(p.vvT + (size_t)c * 16384 + b * 2048 + l8 * 8);
    }
    if (tid < 144) {
      const int colp = tid / 9, part = tid - colp * 9;
      const int col = colp < 8 ? colp : 256 + colp;
      uint4 zz; zz.x = 0; zz.y = 0; zz.z = 0; zz.w = 0;
      *(uint4*)(Vl + col * 80 + part * 8) = zz;
    }
    __syncthreads();
#pragma unroll
    for (int s = 1; s < 4; ++s)
#pragma unroll
      for (int i = 0; i < 2; ++i) {
        const int ch = tid + 256 * i;
        unsigned e[8];
#pragma unroll
        for (int j = 0; j < 8; ++j) { const int idx = 8 * ch + s + j; e[j] = idx < 4096 ? (unsigned)cp[idx] : 0u; }
        uint4 u; u.x = e[0] | (e[1] << 16); u.y = e[2] | (e[3] << 16); u.z = e[4] | (e[5] << 16); u.w = e[6] | (e[7] << 16);
        *(uint4*)(cp + s * 4128 + 8 * ch) = u;
      }
    __syncthreads();
    const bf16_t* abase = cp + si * 4128 + (2048 - i16 - si + 8 * g4);
    f32x4 acc[4][4];
#pragma unroll
    for (int m = 0; m < 4; ++m)
#pragma unroll
      for (int n = 0; n < 4; ++n) acc[m][n] = (f32x4){0.f, 0.f, 0.f, 0.f};
    for (int dl = -31; dl <= 31; ++dl) {
      bf16x8 af[4][2];
#pragma unroll
      for (int mt = 0; mt < 4; ++mt)
#pragma unroll
        for (int kk = 0; kk < 2; ++kk) {
          const bf16_t* ap = abase - 64 * dl - 16 * mt + 32 * kk;
          const uint2 lo = *(const uint2*)ap, hi = *(const uint2*)(ap + 4);
          union { uint4 u; bf16x8 v; } cv; cv.u.x = lo.x; cv.u.y = lo.y; cv.u.z = hi.x; cv.u.w = hi.y;
          af[mt][kk] = cv.v;
        }
#pragma unroll
      for (int jt = 0; jt < 4; ++jt) {
        const int in0 = ocb + 16 * jt - 8 * dl;
        if (in0 >= -8 && in0 <= 248) {
          const bf16_t* bp = Vl + (in0 + 8 + i16) * 80 + 8 * g4;
          const bf16x8 b0 = *(const bf16x8*)bp, b1 = *(const bf16x8*)(bp + 32);
#pragma unroll
          for (int mt = 0; mt < 4; ++mt) {
            acc[mt][jt] = __builtin_amdgcn_mfma_f32_16x16x32_bf16(af[mt][0], b0, acc[mt][jt], 0, 0, 0);
            acc[mt][jt] = __builtin_amdgcn_mfma_f32_16x16x32_bf16(af[mt][1], b1, acc[mt][jt], 0, 0, 0);
          }
        }
      }
    }
    const float db = p.hy_d_bias[c];
#pragma unroll
    for (int mt = 0; mt < 4; ++mt)
#pragma unroll
      for (int jt = 0; jt < 4; ++jt) {
        const int col = ocb + 16 * jt + i16;
        const int n1 = col >> 3, b = col & 7;
        const int n2 = 16 * mt + 4 * g4;
        const uint2 vv = *(const uint2*)(Vl + (col + 8) * 80 + n2);
        const float y0 = acc[mt][jt][0] + bf2f((bf16_t)(vv.x & 0xffff)) * db;
        const float y1 = acc[mt][jt][1] + bf2f((bf16_t)(vv.x >> 16)) * db;
        const float y2 = acc[mt][jt][2] + bf2f((bf16_t)(vv.y & 0xffff)) * db;
        const float y3 = acc[mt][jt][3] + bf2f((bf16_t)(vv.y >> 16)) * db;
        uint2 u; u.x = pack2(y0, y1); u.y = pack2(y2, y3);
        *(uint2*)(p.Yp + (size_t)c * 16384 + b * 2048 + n1 * 64 + n2) = u;
      }
  }
}

__device__ __forceinline__ void phase_transmul(CP& p, char* smem) {
  bf16_t* tl = (bf16_t*)smem;
  const int tid = get_tid();
  for (int it = get_bid(); it < 4096; it += VGRID) {
    const int ct = it & 15, rt = it >> 4;
    const int c0 = ct * 64, r0 = rt * 64;
    __syncthreads();
#pragma unroll
    for (int i = 0; i < 2; ++i) {
      const int ci = tid + 256 * i; const int cc = ci >> 3, ch = ci & 7;
      const uint4 u = *(const uint4*)(p.Yp + (size_t)(c0 + cc) * 16384 + r0 + ch * 8);
      unsigned* d = (unsigned*)(tl + cc * 66 + ch * 8);
      d[0] = u.x; d[1] = u.y; d[2] = u.z; d[3] = u.w;
    }
    __syncthreads();
    const int row = tid >> 2, cq = tid & 3;
    const bf16_t* xp = p.x1h + (size_t)(r0 + row) * 1024 + c0 + cq * 16;
    const uint4 xa = *(const uint4*)xp, xb = *(const uint4*)(xp + 8);
    const unsigned xs[8] = {xa.x, xa.y, xa.z, xa.w, xb.x, xb.y, xb.z, xb.w};
    unsigned o[8];
#pragma unroll
    for (int j = 0; j < 8; ++j) {
      const float y0 = bf2f(tl[(cq * 16 + 2 * j) * 66 + row]) * bf2f((bf16_t)(xs[j] & 0xffff));
      const float y1 = bf2f(tl[(cq * 16 + 2 * j + 1) * 66 + row]) * bf2f((bf16_t)(xs[j] >> 16));
      o[j] = pack2(y0, y1);
    }
    bf16_t* op = p.hxc + (size_t)(r0 + row) * 1024 + c0 + cq * 16;
    uint4 oa; oa.x = o[0]; oa.y = o[1]; oa.z = o[2]; oa.w = o[3];
    uint4 ob; ob.x = o[4]; ob.y = o[5]; ob.z = o[6]; ob.w = o[7];
    *(uint4*)op = oa; *(uint4*)(op + 8) = ob;
  }
}

__global__ void __launch_bounds__(512, 2) mega(P p_arg) {
  __shared__ __attribute__((aligned(16))) char smem[LDS_BYTES];
  cg::grid_group grid = cg::this_grid();
  const int G = gridDim.x;
  CP* pp = (CP*)__builtin_amdgcn_kernarg_segment_ptr();
  const int ph0 = pp->ph0, ph1 = pp->ph1;
  volatile LAS unsigned* xst = (volatile LAS unsigned*)(smem + LDS_BYTES - 16);
  if (threadIdx.x == 0) { xst[0] = 0u; xst[1] = 0u; }
  __syncthreads();
  const XcdBarrier xb = xcd_barrier_post(pp->bar, xst);
  if (ph0 <= 0 && 0 < ph1) {
    asm volatile("" : "+s"(pp));
    CP& p = *pp;
    const int bid = get_rbid();
    const int vid0 = (G & 7) ? bid : ((bid & 7) * (G >> 3) + (bid >> 3));
    const int hb = get_hb();
    char* smem_h = smem + hb * HALF_LDS; (void)smem_h;
    const float* mv0 = p.modv; const float* mv1 = p.modv + (size_t)9 * 6144;
    (void)mv0; (void)mv1; (void)vid0;
    phase_prep(p, smem_h);
    if (0 + 1 < ph1) { if (ph1 > 1000) grid.sync(); else xcd_barrier(xb); }
  }
  if (ph0 <= 1 && 1 < ph1) {
    asm volatile("" : "+s"(pp));
    CP& p = *pp;
    const int bid = get_rbid();
    const int vid0 = (G & 7) ? bid : ((bid & 7) * (G >> 3) + (bid >> 3));
    const int hb = get_hb();
    char* smem_h = smem + hb * HALF_LDS; (void)smem_h;
    const float* mv0 = p.modv; const float* mv1 = p.modv + (size_t)9 * 6144;
    (void)mv0; (void)mv1; (void)vid0;
    phase_normmod_kv(p);
    if (1 + 1 < ph1) { if (ph1 > 1000) grid.sync(); else xcd_barrier(xb); }
  }
  if (ph0 <= 2 && 2 < ph1) {
    asm volatile("" : "+s"(pp));
    CP& p = *pp;
    const int bid = get_rbid();
    const int vid0 = (G & 7) ? bid : ((bid & 7) * (G >> 3) + (bid >> 3));
    const int hb = get_hb();
    char* smem_h = smem + hb * HALF_LDS; (void)smem_h;
    const float* mv0 = p.modv; const float* mv1 = p.modv + (size_t)9 * 6144;
    (void)mv0; (void)mv1; (void)vid0;
    {
        EpiStore e1{p.cq, 512, 2048, nullptr};
        gemm_job<true>(smem, p.hxc, 1024, p.wt_dq, 1024, 512, 16, 2304, 256, 128, 0, 2048, 128, 0, vid0, G, e1);
        EpiStore e2{p.kv, 288, 2304, nullptr};
        gemm_job<true>(smem, p.hxc, 1024, p.wt_dkv, 1024, 288, 18, 2304, 0, 128, 0, 2304, 144, 64 * 2, vid0, G, e2);
        EpiFilt e3{p.Rf, p.hy_decay};
        gemm_job<false>(smem, p.h2bf, 64, p.wt_f3, 64, 2048, 16, 0, 0, 128, 0, 2048, 16, 64 * 2 + 72 * 2, vid0, G, e3);
      }
    if (2 + 1 < ph1) { if (ph1 > 1000) grid.sync(); else xcd_barrier(xb); }
  }
  if (ph0 <= 3 && 3 < ph1) {
    asm volatile("" : "+s"(pp));
    CP& p = *pp;
    const int bid = get_rbid();
    const int vid0 = (G & 7) ? bid : ((bid & 7) * (G >> 3) + (bid >> 3));
    const int hb = get_hb();
    char* smem_h = smem + hb * HALF_LDS; (void)smem_h;
    const float* mv0 = p.modv; const float* mv1 = p.modv + (size_t)9 * 6144;
    (void)mv0; (void)mv1; (void)vid0;
    phase_rowstat(p);
    if (3 + 1 < ph1) { if (ph1 > 1000) grid.sync(); else xcd_barrier(xb); }
  }
  if (ph0 <= 4 && 4 < ph1) {
    asm volatile("" : "+s"(pp));
    CP& p = *pp;
    const int bid = get_rbid();
    const int vid0 = (G & 7) ? bid : ((bid & 7) * (G >> 3) + (bid >> 3));
    const int hb = get_hb();
    char* smem_h = smem + hb * HALF_LDS; (void)smem_h;
    const float* mv0 = p.modv; const float* mv1 = p.modv + (size_t)9 * 6144;
    (void)mv0; (void)mv1; (void)vid0;
    {
        EpiStore e1{p.Q, 1536, 2048, p.rq};
        gemm_job<true>(smem, p.cq, 512, p.wt_uq, 512, 1536, 16, 2048, 0, 128, 0, 2048, 128, 0, vid0, G, e1);
        EpiStore e2{p.Kn, 1024, 2304, p.rkv};
        gemm_job<true>(smem, p.kv, 288, p.wt_uk, 256, 1024, 18, 2304, 0, 128, 0, 2304, 144, 64 * 6, vid0, G, e2);
        EpiVt e3{p.Vt, p.rkv};
        gemm_job<false>(smem, p.kv, 288, p.wt_uv, 256, 1024, 18, 2304, 0, 128, 0, 2304, 144, 64 * 6 + 72 * 4, vid0, G, e3);
      }
    if (4 + 1 < ph1) { if (ph1 > 1000) grid.sync(); else xcd_barrier(xb); }
  }
  if (ph0 <= 5 && 5 < ph1) {
    asm volatile("" : "+s"(pp));
    CP& p = *pp;
    const int bid = get_rbid();
    const int vid0 = (G & 7) ? bid : ((bid & 7) * (G >> 3) + (bid >> 3));
    const int hb = get_hb();
    char* smem_h = smem + hb * HALF_LDS; (void)smem_h;
    const float* mv0 = p.modv; const float* mv1 = p.modv + (size_t)9 * 6144;
    (void)mv0; (void)mv1; (void)vid0;
    phase_attn(p, smem_h, 2 * vid0 + hb, 2 * G);
    if (5 + 1 < ph1) { if (ph1 > 1000) grid.sync(); else xcd_barrier(xb); }
  }
  if (ph0 <= 6 && 6 < ph1) {
    asm volatile("" : "+s"(pp));
    CP& p = *pp;
    const int bid = get_rbid();
    const int vid0 = (G & 7) ? bid : ((bid & 7) * (G >> 3) + (bid >> 3));
    const int hb = get_hb();
    char* smem_h = smem + hb * HALF_LDS; (void)smem_h;
    const float* mv0 = p.modv; const float* mv1 = p.modv + (size_t)9 * 6144;
    (void)mv0; (void)mv1; (void)vid0;
    {
        EpiResid<true> e{p.X16, p.x, mv0 + 2 * 1024, nullptr};
        gemm_job<true>(smem, p.hxc, 1024, p.wt_o, 1024, 1024, 16, 2048, 0, 128, 0, 2048, 128, 0, vid0, G, e);
      }
    if (6 + 1 < ph1) { if (ph1 > 1000) grid.sync(); else xcd_barrier(xb); }
  }
  if (ph0 <= 7 && 7 < ph1) {
    asm volatile("" : "+s"(pp));
    CP& p = *pp;
    const int bid = get_rbid();
    const int vid0 = (G & 7) ? bid : ((bid & 7) * (G >> 3) + (bid >> 3));
    const int hb = get_hb();
    char* smem_h = smem + hb * HALF_LDS; (void)smem_h;
    const float* mv0 = p.modv; const float* mv1 = p.modv + (size_t)9 * 6144;
    (void)mv0; (void)mv1; (void)vid0;
    phase_normmod_x(p, p.norm_ffn_g, 0, 3);
    if (7 + 1 < ph1) { if (ph1 > 1000) grid.sync(); else xcd_barrier(xb); }
  }
  if (ph0 <= 8 && 8 < ph1) {
    asm volatile("" : "+s"(pp));
    CP& p = *pp;
    const int bid = get_rbid();
    const int vid0 = (G & 7) ? bid : ((bid & 7) * (G >> 3) + (bid >> 3));
    const int hb = get_hb();
    char* smem_h = smem + hb * HALF_LDS; (void)smem_h;
    const float* mv0 = p.modv; const float* mv1 = p.modv + (size_t)9 * 6144;
    (void)mv0; (void)mv1; (void)vid0;
    {
        EpiConv<0> e{p.ffn_conv_w, p.ffn_conv_b, 5632, nullptr, p.act, nullptr};
        gemm_job<true>(smem, p.hxc, 1024, p.wt_up0, 1024, 5632, 17, 2048, 0, 126, 1, 2048, 136, 0, vid0, G, e);
      }
    if (8 + 1 < ph1) { if (ph1 > 1000) grid.sync(); else xcd_barrier(xb); }
  }
  if (ph0 <= 9 && 9 < ph1) {
    asm volatile("" : "+s"(pp));
    CP& p = *pp;
    const int bid = get_rbid();
    const int vid0 = (G & 7) ? bid : ((bid & 7) * (G >> 3) + (bid >> 3));
    const int hb = get_hb();
    char* smem_h = smem + hb * HALF_LDS; (void)smem_h;
    const float* mv0 = p.modv; const float* mv1 = p.modv + (size_t)9 * 6144;
    (void)mv0; (void)mv1; (void)vid0;
    {
        EpiResid<false> e{p.X16, p.X16, mv0 + 5 * 1024, nullptr};
        gemm_job<true>(smem, p.act, 2816, p.wt_dn0, 2816, 1024, 16, 2048, 0, 128, 0, 2048, 128, 0, vid0, G, e);
      }
    if (9 + 1 < ph1) { if (ph1 > 1000) grid.sync(); else xcd_barrier(xb); }
  }
  if (ph0 <= 10 && 10 < ph1) {
    asm volatile("" : "+s"(pp));
    CP& p = *pp;
    const int bid = get_rbid();
    const int vid0 = (G & 7) ? bid : ((bid & 7) * (G >> 3) + (bid >> 3));
    const int hb = get_hb();
    char* smem_h = smem + hb * HALF_LDS; (void)smem_h;
    const float* mv0 = p.modv; const float* mv1 = p.modv + (size_t)9 * 6144;
    (void)mv0; (void)mv1; (void)vid0;
    phase_normmod_x(p, p.norm_mix_g + 1024, 1, 0);
    if (10 + 1 < ph1) { if (ph1 > 1000) grid.sync(); else xcd_barrier(xb); }
  }
  if (ph0 <= 11 && 11 < ph1) {
    asm volatile("" : "+s"(pp));
    CP& p = *pp;
    const int bid = get_rbid();
    const int vid0 = (G & 7) ? bid : ((bid & 7) * (G >> 3) + (bid >> 3));
    const int hb = get_hb();
    char* smem_h = smem + hb * HALF_LDS; (void)smem_h;
    const float* mv0 = p.modv; const float* mv1 = p.modv + (size_t)9 * 6144;
    (void)mv0; (void)mv1; (void)vid0;
    {
        EpiConv<1> e{p.hy_conv_w, p.hy_conv_b, 3072, p.hy_b_in, p.x1h, p.vvT};
        gemm_job<true>(smem, p.hxc, 1024, p.wt_hin, 1024, 3072, 17, 2048, 0, 126, 1, 2048, 136, 0, vid0, G, e);
      }
    if (11 + 1 < ph1) { if (ph1 > 1000) grid.sync(); else xcd_barrier(xb); }
  }
  if (ph0 <= 12 && 12 < ph1) {
    asm volatile("" : "+s"(pp));
    CP& p = *pp;
    const int bid = get_rbid();
    const int vid0 = (G & 7) ? bid : ((bid & 7) * (G >> 3) + (bid >> 3));
    const int hb = get_hb();
    char* smem_h = smem + hb * HALF_LDS; (void)smem_h;
    const float* mv0 = p.modv; const float* mv1 = p.modv + (size_t)9 * 6144;
    (void)mv0; (void)mv1; (void)vid0;
    phase_hyconv(p, smem_h);
    if (12 + 1 < ph1) { if (ph1 > 1000) grid.sync(); else xcd_barrier(xb); }
  }
  if (ph0 <= 13 && 13 < ph1) {
    asm volatile("" : "+s"(pp));
    CP& p = *pp;
    const int bid = get_rbid();
    const int vid0 = (G & 7) ? bid : ((bid & 7) * (G >> 3) + (bid >> 3));
    const int hb = get_hb();
    char* smem_h = smem + hb * HALF_LDS; (void)smem_h;
    const float* mv0 = p.modv; const float* mv1 = p.modv + (size_t)9 * 6144;
    (void)mv0; (void)mv1; (void)vid0;
    phase_transmul(p, smem_h);
    if (13 + 1 < ph1) { if (ph1 > 1000) grid.sync(); else xcd_barrier(xb); }
  }
  if (ph0 <= 14 && 14 < ph1) {
    asm volatile("" : "+s"(pp));
    CP& p = *pp;
    const int bid = get_rbid();
    const int vid0 = (G & 7) ? bid : ((bid & 7) * (G >> 3) + (bid >> 3));
    const int hb = get_hb();
    char* smem_h = smem + hb * HALF_LDS; (void)smem_h;
    const float* mv0 = p.modv; const float* mv1 = p.modv + (size_t)9 * 6144;
    (void)mv0; (void)mv1; (void)vid0;
    {
        EpiResid<false> e{p.X16, p.X16, mv1 + 2 * 1024, p.hy_b_out};
        gemm_job<true>(smem, p.hxc, 1024, p.wt_hout, 1024, 1024, 16, 2048, 0, 128, 0, 2048, 128, 0, vid0, G, e);
      }
    if (14 + 1 < ph1) { if (ph1 > 1000) grid.sync(); else xcd_barrier(xb); }
  }
  if (ph0 <= 15 && 15 < ph1) {
    asm volatile("" : "+s"(pp));
    CP& p = *pp;
    const int bid = get_rbid();
    const int vid0 = (G & 7) ? bid : ((bid & 7) * (G >> 3) + (bid >> 3));
    const int hb = get_hb();
    char* smem_h = smem + hb * HALF_LDS; (void)smem_h;
    const float* mv0 = p.modv; const float* mv1 = p.modv + (size_t)9 * 6144;
    (void)mv0; (void)mv1; (void)vid0;
    phase_normmod_x(p, p.norm_ffn_g + 1024, 1, 3);
    if (15 + 1 < ph1) { if (ph1 > 1000) grid.sync(); else xcd_barrier(xb); }
  }
  if (ph0 <= 16 && 16 < ph1) {
    asm volatile("" : "+s"(pp));
    CP& p = *pp;
    const int bid = get_rbid();
    const int vid0 = (G & 7) ? bid : ((bid & 7) * (G >> 3) + (bid >> 3));
    const int hb = get_hb();
    char* smem_h = smem + hb * HALF_LDS; (void)smem_h;
    const float* mv0 = p.modv; const float* mv1 = p.modv + (size_t)9 * 6144;
    (void)mv0; (void)mv1; (void)vid0;
    {
        EpiConv<0> e{p.ffn_conv_w + (size_t)3 * 5632, p.ffn_conv_b + 5632, 5632, nullptr, p.act, nullptr};
        gemm_job<true>(smem, p.hxc, 1024, p.wt_up1, 1024, 5632, 17, 2048, 0, 126, 1, 2048, 136, 0, vid0, G, e);
      }
    if (16 + 1 < ph1) { if (ph1 > 1000) grid.sync(); else xcd_barrier(xb); }
  }
  if (ph0 <= 17 && 17 < ph1) {
    asm volatile("" : "+s"(pp));
    CP& p = *pp;
    const int bid = get_rbid();
    const int vid0 = (G & 7) ? bid : ((bid & 7) * (G >> 3) + (bid >> 3));
    const int hb = get_hb();
    char* smem_h = smem + hb * HALF_LDS; (void)smem_h;
    const float* mv0 = p.modv; const float* mv1 = p.modv + (size_t)9 * 6144;
    (void)mv0; (void)mv1; (void)vid0;
    {
        EpiResid<false> e{p.X16, p.X16, mv1 + 5 * 1024, nullptr};
        gemm_job<true>(smem, p.act, 2816, p.wt_dn1, 2816, 1024, 16, 2048, 0, 128, 0, 2048, 128, 0, vid0, G, e);
      }
    if (17 + 1 < ph1) { if (ph1 > 1000) grid.sync(); else xcd_barrier(xb); }
  }
  if (ph0 <= 18 && 18 < ph1) {
    asm volatile("" : "+s"(pp));
    CP& p = *pp;
    const int bid = get_rbid();
    const int vid0 = (G & 7) ? bid : ((bid & 7) * (G >> 3) + (bid >> 3));
    const int hb = get_hb();
    char* smem_h = smem + hb * HALF_LDS; (void)smem_h;
    const float* mv0 = p.modv; const float* mv1 = p.modv + (size_t)9 * 6144;
    (void)mv0; (void)mv1; (void)vid0;
    phase_final_norm(p);
    if (18 + 1 < ph1) { if (ph1 > 1000) grid.sync(); else xcd_barrier(xb); }
  }
}

extern "C" void kernel_launch(void* const* d_in, const int* in_sizes, int n_in, void* d_out, int out_size, void* d_ws, size_t ws_size, hipStream_t stream) {
  static int grid_blocks = 0;
  if (!grid_blocks) {
    int dev = 0, cus = 0, per_cu = 0;
    hipGetDevice(&dev);
    hipDeviceGetAttribute(&cus, hipDeviceAttributeMultiprocessorCount, dev);
    hipOccupancyMaxActiveBlocksPerMultiprocessor(&per_cu, (const void*)mega, 512, 0);
    per_cu = 1;
    grid_blocks = cus * per_cu;
  }
  P p{};
  const float** in = (const float**)&p;
  for (int i = 0; i < 36; ++i) in[i] = (const float*)d_in[i];
  p.X = (float*)d_out;
  char* ws = (char*)d_ws; size_t off = 0;
  auto take = [&](size_t bytes) { char* r = ws + off; off += (bytes + 255) & ~(size_t)255; return r; };
  p.wt_dq = (bf16_t*)take((size_t)512 * 1024 * 2);
  p.wt_dkv = (bf16_t*)take((size_t)288 * 1024 * 2);
  p.wt_uq = (bf16_t*)take((size_t)1536 * 512 * 2);
  p.wt_uk = (bf16_t*)take((size_t)1024 * 256 * 2);
  p.wt_uv = (bf16_t*)take((size_t)1024 * 256 * 2);
  p.wt_o = (bf16_t*)take((size_t)1024 * 1024 * 2);
  p.wt_hin = (bf16_t*)take((size_t)3072 * 1024 * 2);
  p.wt_hout = (bf16_t*)take((size_t)1024 * 1024 * 2);
  p.wt_up0 = (bf16_t*)take((size_t)5632 * 1024 * 2);
  p.wt_up1 = (bf16_t*)take((size_t)5632 * 1024 * 2);
  p.wt_dn0 = (bf16_t*)take((size_t)1024 * 2816 * 2);
  p.wt_dn1 = (bf16_t*)take((size_t)1024 * 2816 * 2);
  p.modv = (float*)take((size_t)2 * 9 * 6144 * 4);
  p.rq = (float*)take((size_t)16384 * 4);
  p.rkv = (float*)take((size_t)18432 * 4);
  p.modp = (float*)take((size_t)4 * 110592 * 4);
  p.bar = (unsigned*)take((size_t)XCD_BAR_WORDS * 4);
  p.wt_f3 = (bf16_t*)take((size_t)2048 * 64 * 2);
  p.h2bf = (bf16_t*)take((size_t)2048 * 64 * 2);
  p.Rf = (bf16_t*)take((size_t)1024 * 4096 * 2);
  p.kpe = (bf16_t*)take((size_t)18432 * 32 * 2);
  p.hxc = (bf16_t*)take((size_t)18432 * 1024 * 2);
  const size_t ubase = off;
  p.cq = (bf16_t*)take((size_t)16384 * 512 * 2);
  p.kv = (bf16_t*)take((size_t)18432 * 288 * 2);
  p.Q = (bf16_t*)take((size_t)16384 * 1536 * 2);
  p.Kn = (bf16_t*)take((size_t)18432 * 1024 * 2);
  p.Vt = (bf16_t*)take((size_t)18432 * 1024 * 2);
  const size_t uend1 = off;
  p.X16 = (bf16_t*)(ws + ubase + (size_t)104857600);
  off = ubase;
  p.act = (bf16_t*)take((size_t)16384 * 2816 * 2);
  off = ubase;
  p.x1h = (bf16_t*)take((size_t)16384 * 1024 * 2);
  p.vvT = (bf16_t*)take((size_t)16384 * 1024 * 2);
  p.Yp = (bf16_t*)take((size_t)16384 * 1024 * 2);
  if (uend1 > ws_size) { fprintf(stderr, "workspace too small: need %zu have %zu\n", uend1, ws_size); return; }
  p.ph0 = 0; p.ph1 = NPHASE;
  if (hipMemsetAsync(p.bar, 0, (size_t)XCD_BAR_WORDS * 4, stream) != hipSuccess) { fprintf(stderr, "memset failed\n"); return; }
  void* args[] = {&p};
  hipError_t e = hipLaunchCooperativeKernel((const void*)mega, dim3(grid_blocks), dim3(512), args, 0, stream);
  if (e != hipSuccess) fprintf(stderr, "cooperative launch failed: %s (grid %d)\n", hipGetErrorString(e), grid_blocks);
}
```

```cpp
#include <hip/hip_runtime.h>
#include <hip/hip_cooperative_groups.h>
#include <cstdio>
namespace cg = cooperative_groups;

typedef unsigned short bf16_t;
typedef short bf16x8 __attribute__((ext_vector_type(8)));
typedef float f32x4 __attribute__((ext_vector_type(4)));
typedef float f32x16 __attribute__((ext_vector_type(16)));

#define LDS_BYTES 163840
#define HALF_LDS 81920
#define NPHASE 19

struct P {
  const float *x, *c, *ctx, *c_ctx, *mod_w, *mod_b, *norm_mix_g, *norm_ffn_g;
  const float *w_dq, *g_q, *w_uq, *w_dkv, *g_kv, *w_uk, *w_uv, *w_o;
  const float *hy_w_in, *hy_b_in, *hy_conv_w, *hy_conv_b, *f_w1, *f_b1, *f_freq1, *f_w2, *f_b2, *f_freq2, *f_w3, *hy_decay, *hy_d_bias, *hy_w_out, *hy_b_out;
  const float *ffn_w_up, *ffn_conv_w, *ffn_conv_b, *ffn_w_down, *final_g;
  float* X;
  bf16_t *wt_dq, *wt_dkv, *wt_uq, *wt_uk, *wt_uv, *wt_o, *wt_hin, *wt_hout, *wt_up0, *wt_up1, *wt_dn0, *wt_dn1;
  float *modv, *rq, *rkv, *modp;
  unsigned* bar;
  bf16_t *wt_f3, *h2bf, *X16;
  bf16_t *Rf, *kpe, *hxc, *cq, *kv, *Q, *Kn, *Vt, *act, *x1h, *vvT, *Yp;
  int ph0, ph1;
};

typedef const __attribute__((address_space(4))) P CP;
__device__ __forceinline__ int get_tid512() { int t = threadIdx.x; asm volatile("" : "+v"(t)); return t; }
__device__ __forceinline__ int get_tid() { int t = threadIdx.x & 255; asm volatile("" : "+v"(t)); return t; }
__device__ __forceinline__ int get_hb() { int t = __builtin_amdgcn_readfirstlane((int)(threadIdx.x >> 8)); asm volatile("" : "+s"(t)); return t; }
__device__ __forceinline__ int get_rbid() { int t = blockIdx.x; asm volatile("" : "+s"(t)); return t; }
__device__ __forceinline__ int get_bid() { return 2 * get_rbid() + get_hb(); }
#define VGRID (2 * (int)gridDim.x)

__device__ __forceinline__ unsigned pack2(float a, float b) { unsigned r; asm("v_cvt_pk_bf16_f32 %0, %1, %2" : "=v"(r) : "v"(a), "v"(b)); return r; }
__device__ __forceinline__ bf16_t f2bf(float f) { return (bf16_t)(pack2(f, f) & 0xffffu); }
__device__ __forceinline__ float bf2f(bf16_t h) { return __uint_as_float(((unsigned)h) << 16); }
__device__ __forceinline__ float wave_sum(float v) {
#pragma unroll
  for (int o = 32; o; o >>= 1) v += __shfl_xor(v, o);
  return v;
}


#define XB_TMO      128
#define XB_XCNT(j)  (256  + 64 * (j))
#define XB_XSUB(j)  (1280 + 64 * (j))
#define XB_XGEN(j)  (2304 + 64 * (j))
#define XB_TOP      3328
#define XB_TOPGEN   3392
#define XCD_BAR_WORDS 3456
#define XB_SPIN_CAP (1u << 18)
#define LAS __attribute__((address_space(3)))
__device__ __forceinline__ unsigned xb_ld(unsigned* p)              { return __hip_atomic_load(p, __ATOMIC_RELAXED, __HIP_MEMORY_SCOPE_AGENT); }
__device__ __forceinline__ unsigned xb_add(unsigned* p, unsigned v) { return __hip_atomic_fetch_add(p, v, __ATOMIC_RELAXED, __HIP_MEMORY_SCOPE_AGENT); }
__device__ __forceinline__ unsigned xb_xcc_id() { return (unsigned)__builtin_amdgcn_s_getreg((3 << 11) | 20) & 0xFu; }
#define XB_SPIN(cond, bar) do { unsigned _sp = 0; while (cond) { __builtin_amdgcn_s_sleep(1); \
    if ((++_sp & 255u) == 0u) { if (xb_ld(&(bar)[XB_TMO])) break; if (_sp > XB_SPIN_CAP) { atomicAdd(&(bar)[XB_TMO], 1u); break; } } } } while (0)
struct XcdBarrier { unsigned* bar; unsigned x; volatile LAS unsigned* st; };
__device__ __forceinline__ XcdBarrier xcd_barrier_post(unsigned* bar, volatile LAS unsigned* st) {
    XcdBarrier b; b.bar = bar; b.x = xb_xcc_id(); b.st = st;
    if (threadIdx.x == 0) (void)xb_add(&bar[XB_XCNT(b.x)], 1u);
    return b;
}
__device__ __forceinline__ void xcd_barrier_complete(unsigned* bar, unsigned x, unsigned& nloc, unsigned& nx) {
    const unsigned G = gridDim.x * gridDim.y * gridDim.z;
    unsigned sum, cnt, mine, sp = 0u;
    for (;;) {
        sum = 0u; cnt = 0u; mine = 0u;
#pragma unroll
        for (unsigned j = 0; j < 16; ++j) { const unsigned c = xb_ld(&bar[XB_XCNT(j)]); sum += c; cnt += (c > 0u) ? 1u : 0u; mine = (j == x) ? c : mine; }
        if (sum == G) break;
        __builtin_amdgcn_s_sleep(1);
        if ((++sp & 255u) == 0u) { if (xb_ld(&bar[XB_TMO])) break; if (sp > XB_SPIN_CAP) { atomicAdd(&bar[XB_TMO], 1u); break; } }
    }
    nloc = mine > 0u ? mine : 1u; nx = cnt > 0u ? cnt : 1u;
}
__device__ __forceinline__ void xcd_barrier(const XcdBarrier& b) {
    asm volatile("s_waitcnt vmcnt(0)" ::: "memory");
    __syncthreads();
    if (threadIdx.x == 0) {
        unsigned* bar = b.bar;
        __builtin_amdgcn_s_waitcnt(0);
        unsigned nloc = b.st[0], nx = b.st[1];
        if (nloc == 0u) { xcd_barrier_complete(bar, b.x, nloc, nx); b.st[0] = nloc; b.st[1] = nx; }
        const unsigned old = xb_add(&bar[XB_XSUB(b.x)], 1u);
        const unsigned gen = old / nloc;
        if (old + 1u == (gen + 1u) * nloc) {
            __builtin_amdgcn_fence(__ATOMIC_RELEASE, "agent");
            asm volatile("s_waitcnt vmcnt(0)" ::: "memory");
            const unsigned og = xb_add(&bar[XB_TOP], 1u);
            const unsigned tg = og / nx;
            if (og + 1u == (tg + 1u) * nx) xb_add(&bar[XB_TOPGEN], 1u);
            else XB_SPIN(xb_ld(&bar[XB_TOPGEN]) == tg, bar);
            __builtin_amdgcn_fence(__ATOMIC_ACQUIRE, "agent");
            xb_add(&bar[XB_XGEN(b.x)], 1u);
            asm volatile("s_waitcnt vmcnt(0)" ::: "memory");
        } else {
            XB_SPIN(xb_ld(&bar[XB_XGEN(b.x)]) == gen, bar);
            __builtin_amdgcn_fence(__ATOMIC_ACQUIRE, "agent");
            asm volatile("s_waitcnt vmcnt(0)" ::: "memory");
        }
    }
    __syncthreads();
}

__device__ __forceinline__ void prep_weight_tile(CP& p, char* smem, int wt) {
  const int tid = get_tid();
  int id = 0;
  {
    const int cnt[13] = {64, 40, 96, 32, 32, 128, 384, 128, 704, 704, 352, 352, 32};
#pragma unroll
    for (int i = 0; i < 12; ++i) { if (id == i && wt >= cnt[i]) { wt -= cnt[i]; id = i + 1; } }
  }
  const float* src; int K, N; bf16_t* dst; const float* scale = nullptr; int perm = 0;
  switch (id) {
    case 0: src = p.w_dq; K = 1024; N = 512; dst = p.wt_dq; break;
    case 1: src = p.w_dkv; K = 1024; N = 288; dst = p.wt_dkv; break;
    case 2: src = p.w_uq; K = 512; N = 1536; dst = p.wt_uq; scale = p.g_q; break;
    case 3: src = p.w_uk; K = 256; N = 1024; dst = p.wt_uk; scale = p.g_kv; break;
    case 4: src = p.w_uv; K = 256; N = 1024; dst = p.wt_uv; scale = p.g_kv; break;
    case 5: src = p.w_o; K = 1024; N = 1024; dst = p.wt_o; break;
    case 6: src = p.hy_w_in; K = 1024; N = 3072; dst = p.wt_hin; perm = 2; break;
    case 7: src = p.hy_w_out; K = 1024; N = 1024; dst = p.wt_hout; break;
    case 8: src = p.ffn_w_up; K = 1024; N = 5632; dst = p.wt_up0; perm = 1; break;
    case 9: src = p.ffn_w_up + (size_t)1024 * 5632; K = 1024; N = 5632; dst = p.wt_up1; perm = 1; break;
    case 10: src = p.ffn_w_down; K = 2816; N = 1024; dst = p.wt_dn0; break;
    case 11: src = p.ffn_w_down + (size_t)2816 * 1024; K = 2816; N = 1024; dst = p.wt_dn1; break;
    default: src = p.f_w3; K = 64; N = 2048; dst = p.wt_f3; break;
  }
  const int ntn = (N + 63) >> 6;
  const int kt = wt / ntn, nt = wt - kt * ntn;
  const int k0 = kt * 128, n0 = nt * 64;
  int np0;
  if (perm == 1) { const int half = n0 / 2816, f = n0 - half * 2816; np0 = (f >> 6) * 128 + half * 64; }
  else if (perm == 2) { if (n0 < 1024) np0 = n0; else { const int m = n0 - 1024, half = m >> 10, f = m & 1023; np0 = 1024 + (f >> 6) * 128 + half * 64; } }
  else np0 = n0;
  bf16_t* t16 = (bf16_t*)smem;
  f32x4 v[8];
#pragma unroll
  for (int i = 0; i < 8; ++i) {
    const int idx = tid + 256 * i; const int kr = idx >> 4, c4 = idx & 15;
    v[i] = (f32x4){0.f, 0.f, 0.f, 0.f};
    if (n0 + 4 * c4 < N && k0 + kr < K) v[i] = *(const f32x4*)(src + (size_t)(k0 + kr) * N + n0 + 4 * c4);
  }
#pragma unroll
  for (int i = 0; i < 8; ++i) {
    const int idx = tid + 256 * i; const int kr = idx >> 4, c4 = idx & 15;
    const float sc = (scale && k0 + kr < K) ? scale[k0 + kr] : 1.f;
#pragma unroll
    for (int j = 0; j < 4; ++j) t16[(4 * c4 + j) * 136 + kr] = f2bf(v[i][j] * sc);
  }
  __syncthreads();
#pragma unroll
  for (int i = 0; i < 4; ++i) {
    const int idx = tid + 256 * i; const int n = idx >> 4, ch = idx & 15;
    if (n0 + n < N && k0 + ch * 8 < K) *(uint4*)(dst + (size_t)(np0 + n) * K + k0 + ch * 8) = *(const uint4*)(t16 + n * 136 + ch * 8);
  }
  __syncthreads();
}

__device__ __forceinline__ void prep_modvec(CP& p, char* smem, int it) {
  const int tid = get_tid();
  const int layer = it / 384, rem = it - layer * 384, cb = rem >> 2, ks = rem & 3;
  float* s_lds = (float*)smem;
  float* red = (float*)(smem + 12288);
  const int kbase = ks * 256;
  for (int idx = tid; idx < 9 * 256; idx += 256) {
    const int r = idx >> 8, k = idx & 255;
    const float v = r < 8 ? p.c[r * 1024 + kbase + k] : p.c_ctx[kbase + k];
    s_lds[k * 12 + r] = v / (1.f + __expf(-v));
  }
  __syncthreads();
  const int col = cb * 64 + (tid & 63), kg = tid >> 6;
  const float* W = p.mod_w + (size_t)layer * 1024 * 6144 + (size_t)kbase * 6144 + col;
  float acc[9];
#pragma unroll
  for (int r = 0; r < 9; ++r) acc[r] = 0.f;
#pragma unroll
  for (int kb = 0; kb < 4; ++kb) {
    float w[16];
#pragma unroll
    for (int u = 0; u < 16; ++u) w[u] = W[(size_t)(kg * 64 + kb * 16 + u) * 6144];
#pragma unroll
    for (int u = 0; u < 16; ++u) {
      const int k = kg * 64 + kb * 16 + u;
      const f32x4 s0 = *(const f32x4*)(s_lds + k * 12), s1 = *(const f32x4*)(s_lds + k * 12 + 4);
      const float s2 = s_lds[k * 12 + 8];
      acc[0] += s0[0] * w[u]; acc[1] += s0[1] * w[u]; acc[2] += s0[2] * w[u]; acc[3] += s0[3] * w[u];
      acc[4] += s1[0] * w[u]; acc[5] += s1[1] * w[u]; acc[6] += s1[2] * w[u]; acc[7] += s1[3] * w[u];
      acc[8] += s2 * w[u];
    }
  }
#pragma unroll
  for (int r = 0; r < 9; ++r) red[(kg * 9 + r) * 64 + (tid & 63)] = acc[r];
  __syncthreads();
  for (int o = tid; o < 9 * 64; o += 256) {
    const int r = o >> 6, cl = o & 63;
    const float sm = red[(0 * 9 + r) * 64 + cl] + red[(1 * 9 + r) * 64 + cl] + red[(2 * 9 + r) * 64 + cl] + red[(3 * 9 + r) * 64 + cl];
    p.modp[(size_t)ks * 110592 + (size_t)(layer * 9 + r) * 6144 + cb * 64 + cl] = sm;
  }
  __syncthreads();
}

__device__ __forceinline__ void prep_filter(CP& p, char* smem, int it) {
  const int tid = get_tid();
  float* z = (float*)smem;
  float* h1 = z + 8 * 33;
  float* h2 = h1 + 8 * 64;
  const int t0 = it * 8;
  for (int idx = tid; idx < 8 * 33; idx += 256) {
    const int pp = idx / 33, i = idx - pp * 33;
    const int t = t0 + pp;
    float v;
    if (i == 0) v = (float)t * (1.0f / 2047.0f);
    else {
      const int k = (i - 1) & 15;
      const float w = (6.283185307179586f * (float)t) / 2048.0f;
      const float f = 1e-4f + (float)k * ((15.0f - 1e-4f) / 15.0f);
      const float a = w * f;
      v = (i <= 16) ? __cosf(a) : -__sinf(a);
    }
    z[idx] = v;
  }
  __syncthreads();
  for (int idx = tid; idx < 8 * 64; idx += 256) {
    const int pp = idx >> 6, j = idx & 63;
    float s = p.f_b1[j];
#pragma unroll
    for (int i = 0; i < 33; ++i) s += z[pp * 33 + i] * p.f_w1[i * 64 + j];
    h1[idx] = __sinf(p.f_freq1[j] * s);
  }
  __syncthreads();
  for (int idx = tid; idx < 8 * 64; idx += 256) {
    const int pp = idx >> 6, j = idx & 63;
    float s = p.f_b2[j];
#pragma unroll 16
    for (int i = 0; i < 64; ++i) s += h1[pp * 64 + i] * p.f_w2[i * 64 + j];
    h2[idx] = __sinf(p.f_freq2[j] * s);
  }
  __syncthreads();
  for (int idx = tid; idx < 8 * 64; idx += 256) p.h2bf[(size_t)t0 * 64 + idx] = f2bf(h2[idx]);
  __syncthreads();
}

__device__ __forceinline__ void phase_prep(CP& p, char* smem) {
  const int total = 768 + 256 + 3048;
  for (int it = get_bid(); it < total; it += VGRID) {
    if (it < 768) prep_modvec(p, smem, it);
    else if (it < 1024) prep_filter(p, smem, it - 768);
    else prep_weight_tile(p, smem, it - 1024);
  }
}

__device__ __forceinline__ f32x4 ld4_bf16(const bf16_t* p) {
  const uint2 u = *(const uint2*)p;
  f32x4 r; r[0] = bf2f((bf16_t)(u.x & 0xffff)); r[1] = bf2f((bf16_t)(u.x >> 16)); r[2] = bf2f((bf16_t)(u.y & 0xffff)); r[3] = bf2f((bf16_t)(u.y >> 16));
  return r;
}
template <bool PART, bool SRC16 = false>
__device__ __forceinline__ void normmod_row2(const void* __restrict__ srcv, const float* __restrict__ g, const float* __restrict__ sh, const float* __restrict__ sc, bf16_t* __restrict__ dst, int lane, const float* __restrict__ bsh = nullptr) {
  f32x4 v[2][4]; float ss0 = 0.f, ss1 = 0.f;
#pragma unroll
  for (int i = 0; i < 4; ++i) {
    if (SRC16) { v[0][i] = ld4_bf16((const bf16_t*)srcv + lane * 4 + 256 * i); v[1][i] = ld4_bf16((const bf16_t*)srcv + 1024 + lane * 4 + 256 * i); }
    else { v[0][i] = *(const f32x4*)((const float*)srcv + lane * 4 + 256 * i); v[1][i] = *(const f32x4*)((const float*)srcv + 1024 + lane * 4 + 256 * i); }
  }
#pragma unroll
  for (int i = 0; i < 4; ++i) {
    ss0 += v[0][i][0] * v[0][i][0] + v[0][i][1] * v[0][i][1] + v[0][i][2] * v[0][i][2] + v[0][i][3] * v[0][i][3];
    ss1 += v[1][i][0] * v[1][i][0] + v[1][i][1] * v[1][i][1] + v[1][i][2] * v[1][i][2] + v[1][i][3] * v[1][i][3];
  }
  ss0 = wave_sum(ss0); ss1 = wave_sum(ss1);
  const float r0 = rsqrtf(ss0 * (1.0f / 1024.0f) + 1e-6f), r1 = rsqrtf(ss1 * (1.0f / 1024.0f) + 1e-6f);
#pragma unroll
  for (int i = 0; i < 4; ++i) {
    const int k = lane * 4 + 256 * i;
    const f32x4 g4 = *(const f32x4*)(g + k);
    f32x4 s4 = *(const f32x4*)(sh + k), c4 = *(const f32x4*)(sc + k);
    if (PART) {
#pragma unroll
      for (int q = 1; q < 4; ++q) { s4 += *(const f32x4*)(sh + (size_t)q * 110592 + k); c4 += *(const f32x4*)(sc + (size_t)q * 110592 + k); }
      s4 += *(const f32x4*)(bsh + k); c4 += *(const f32x4*)(bsh + 1024 + k);
    }
    float y[4], z[4];
#pragma unroll
    for (int j = 0; j < 4; ++j) { const float gm = g4[j] * (1.f + c4[j]); y[j] = (v[0][i][j] * r0) * gm + s4[j]; z[j] = (v[1][i][j] * r1) * gm + s4[j]; }
    uint2 u; u.x = pack2(y[0], y[1]); u.y = pack2(y[2], y[3]);
    *(uint2*)(dst + k) = u;
    u.x = pack2(z[0], z[1]); u.y = pack2(z[2], z[3]);
    *(uint2*)(dst + 1024 + k) = u;
  }
}

__device__ __forceinline__ void phase_normmod_kv(CP& p) {
  const int lane = get_tid() & 63, wv = get_tid() >> 6;
  const float* g = p.norm_mix_g;
  for (int idx = get_bid() * 256 + get_tid(); idx < 110592; idx += VGRID * 256) {
    const int lr = idx / 6144; const int n = idx - lr * 6144; const int layer = lr / 9;
    p.modv[idx] = p.modp[idx] + p.modp[110592 + idx] + p.modp[2 * 110592 + idx] + p.modp[3 * 110592 + idx] + p.mod_b[layer * 6144 + n];
  }
  for (int r = (get_bid() * 4 + wv) * 2; r < 18432; r += VGRID * 8) {
    const int b = r / 2304, pp = r - b * 2304;
    const float* src; const float* mv;
    if (pp < 256) { src = p.ctx + ((size_t)b * 256 + pp) * 1024; mv = p.modp + (size_t)8 * 6144; }
    else { src = p.x + ((size_t)b * 2048 + pp - 256) * 1024; mv = p.modp + (size_t)b * 6144; }
    normmod_row2<true>(src, g, mv, mv + 1024, p.hxc + (size_t)r * 1024, lane, p.mod_b);
  }
}
__device__ __forceinline__ void phase_normmod_x(CP& p, const float* g, int layer, int chunk) {
  const int lane = get_tid() & 63, wv = get_tid() >> 6;
  for (int r = (get_bid() * 4 + wv) * 2; r < 16384; r += VGRID * 8) {
    const int b = r >> 11;
    const float* mv = p.modv + (size_t)(layer * 9 + b) * 6144 + chunk * 1024;
    normmod_row2<false, true>(p.X16 + (size_t)r * 1024, g, mv, mv + 1024, p.hxc + (size_t)r * 1024, lane);
  }
}
__device__ __forceinline__ void phase_final_norm(CP& p) {
  const int lane = get_tid() & 63, wv = get_tid() >> 6;
  for (int r = get_bid() * 4 + wv; r < 16384; r += VGRID * 4) {
    const bf16_t* srow = p.X16 + (size_t)r * 1024;
    float* row = p.X + (size_t)r * 1024;
    f32x4 v[4]; float ss = 0.f;
#pragma unroll
    for (int i = 0; i < 4; ++i) { v[i] = ld4_bf16(srow + lane * 4 + 256 * i); ss += v[i][0] * v[i][0] + v[i][1] * v[i][1] + v[i][2] * v[i][2] + v[i][3] * v[i][3]; }
    ss = wave_sum(ss);
    const float rr = rsqrtf(ss * (1.0f / 1024.0f) + 1e-6f);
#pragma unroll
    for (int i = 0; i < 4; ++i) {
      const int k = lane * 4 + 256 * i;
      const f32x4 g4 = *(const f32x4*)(p.final_g + k);
      f32x4 o; o[0] = v[i][0] * rr * g4[0]; o[1] = v[i][1] * rr * g4[1]; o[2] = v[i][2] * rr * g4[2]; o[3] = v[i][3] * rr * g4[3];
      *(f32x4*)(row + k) = o;
    }
  }
}

__device__ __forceinline__ void phase_rowstat(CP& p) {
  const int lane = get_tid() & 63, wv = get_tid() >> 6;
  for (int r = get_bid() * 4 + wv; r < 18432; r += VGRID * 4) {
    const int b = r / 2304, pp = r - b * 2304;
    const bf16_t* kvr = p.kv + (size_t)r * 288;
    {
      const uint2 u = *(const uint2*)(kvr + lane * 4);
      const float a0 = bf2f((bf16_t)(u.x & 0xffff)), a1 = bf2f((bf16_t)(u.x >> 16)), a2 = bf2f((bf16_t)(u.y & 0xffff)), a3 = bf2f((bf16_t)(u.y >> 16));
      float ss = a0 * a0 + a1 * a1 + a2 * a2 + a3 * a3;
      ss = wave_sum(ss);
      if (lane == 0) p.rkv[r] = rsqrtf(ss * (1.0f / 256.0f) + 1e-6f);
    }
    {
      const int i = lane & 31;
      const float xv = bf2f(kvr[256 + i]);
      const float ov = __shfl_xor(xv, 8);
      float res = xv;
      if (pp >= 256) {
        const int t = pp - 256;
        const int quarter = i >> 3, idx = i & 7;
        const float pos = (quarter < 2) ? (float)(t >> 6) : (float)(t & 63);
        const float inv = exp2f(-(float)idx * (13.287712379549449f / 8.0f));
        const float ang = pos * inv;
        const float cs = __cosf(ang), sn = __sinf(ang);
        res = xv * cs + ((quarter & 1) ? ov : -ov) * sn;
      }
      if (lane < 32) p.kpe[(size_t)r * 32 + i] = f2bf(res);
    }
    if (pp >= 256) {
      const int xr = b * 2048 + pp - 256;
      const uint4 u = *(const uint4*)(p.cq + (size_t)xr * 512 + lane * 8);
      const unsigned uu[4] = {u.x, u.y, u.z, u.w};
      float ss = 0.f;
#pragma unroll
      for (int j = 0; j < 4; ++j) { const float a = bf2f((bf16_t)(uu[j] & 0xffff)), bb = bf2f((bf16_t)(uu[j] >> 16)); ss += a * a + bb * bb; }
      ss = wave_sum(ss);
      if (lane == 0) p.rq[xr] = rsqrtf(ss * (1.0f / 512.0f) + 1e-6f);
    }
  }
}

struct EpiStore {
  static constexpr int KIND = 0;
  bf16_t* out; int ld; int ostride; const float* rs;
  __device__ __forceinline__ void c4(int g, int rig, int col, f32x4 v) const {
    const size_t row = (size_t)g * ostride + rig;
    const float s = rs ? rs[row] : 1.f;
    uint2 u; u.x = pack2(v[0] * s, v[1] * s); u.y = pack2(v[2] * s, v[3] * s);
    *(uint2*)(out + row * ld + col) = u;
  }
};
struct EpiVt {
  static constexpr int KIND = 1;
  bf16_t* out; const float* rs;
  __device__ __forceinline__ void r4(int g, int rig, int col, f32x4 v) const {
    const size_t row = (size_t)g * 2304 + rig;
    const f32x4 s = *(const f32x4*)(rs + row);
    uint2 u; u.x = pack2(v[0] * s[0], v[1] * s[1]); u.y = pack2(v[2] * s[2], v[3] * s[3]);
    *(uint2*)(out + ((size_t)g * 1024 + col) * 2304 + rig) = u;
  }
};
struct EpiFilt {
  static constexpr int KIND = 1;
  bf16_t* Rf; const float* decay;
  __device__ __forceinline__ void r4(int g, int rig, int col, f32x4 v) const {
    const int c = col & 1023; const bool bwd = col >= 1024;
    const float dec = fabsf(decay[c]);
    bf16_t* rp = Rf + (size_t)c * 4096;
#pragma unroll
    for (int j = 0; j < 4; ++j) {
      const int t = rig + j;
      const float val = v[j] * __expf(-(float)t * (1.0f / 2047.0f) * dec);
      if (!bwd) rp[2048 - t] = f2bf(val);
      else if (t > 0) rp[2048 + t] = f2bf(val);
      else rp[0] = 0;
    }
  }
};
template <bool BASE_F32>
struct EpiResid {
  static constexpr int KIND = 0;
  bf16_t* X16; const void* base; const float* gate; const float* bias;
  __device__ __forceinline__ void c4(int g, int rig, int col, f32x4 v) const {
    const size_t o = ((size_t)g * 2048 + rig) * 1024 + col;
    f32x4 bs;
    if (BASE_F32) bs = *(const f32x4*)((const float*)base + o);
    else {
      const uint2 u = *(const uint2*)((const bf16_t*)base + o);
      bs[0] = bf2f((bf16_t)(u.x & 0xffff)); bs[1] = bf2f((bf16_t)(u.x >> 16)); bs[2] = bf2f((bf16_t)(u.y & 0xffff)); bs[3] = bf2f((bf16_t)(u.y >> 16));
    }
    const f32x4 gt = *(const f32x4*)(gate + (size_t)g * 6144 + col);
    f32x4 bi = {0.f, 0.f, 0.f, 0.f};
    if (bias) bi = *(const f32x4*)(bias + col);
    f32x4 r;
#pragma unroll
    for (int j = 0; j < 4; ++j) r[j] = bs[j] + gt[j] * (v[j] + bi[j]);
    uint2 w; w.x = pack2(r[0], r[1]); w.y = pack2(r[2], r[3]);
    *(uint2*)(X16 + o) = w;
  }
};
template <int MODE>
struct EpiConv {
  static constexpr int KIND = 2;
  const float* cw; const float* cb; int NC; const float* pre_bias;
  bf16_t* o0; bf16_t* o1;
  __device__ __forceinline__ int norig(int nt, int cl) const {
    if (MODE == 0) return (cl >> 6) * 2816 + nt * 64 + (cl & 63);
    if (nt < 8) return nt * 128 + cl;
    return 1024 + (cl >> 6) * 1024 + (nt - 8) * 64 + (cl & 63);
  }
  typedef float f32x2_t __attribute__((ext_vector_type(2)));
  static __device__ __forceinline__ f32x2_t ldz(const bf16_t* Z, int row, int col) {
    const unsigned u = *(const unsigned*)(Z + row * 132 + col);
    f32x2_t r; r[0] = __uint_as_float(u << 16); r[1] = __uint_as_float(u & 0xffff0000u); return r;
  }
  template <class F>
  __device__ __forceinline__ void finish(const bf16_t* Z, int g, int rig0, int nt, F&& pre) const {
    typedef f32x2_t f32x2;
    const int tid = get_tid();
    if (MODE == 0 || nt < 8) {
      if (MODE == 0) {
        const int f2 = (tid & 31) * 2, q8 = tid >> 5;
        const int q0 = 1 + 16 * q8, q1 = (q0 + 16 < 127) ? q0 + 16 : 127;
        const int na = norig(nt, f2), ng = norig(nt, 64 + f2);
        const f32x2 a0 = *(const f32x2*)(cw + na), a1 = *(const f32x2*)(cw + NC + na), a2 = *(const f32x2*)(cw + 2 * NC + na), ab = *(const f32x2*)(cb + na);
        const f32x2 g0 = *(const f32x2*)(cw + ng), g1 = *(const f32x2*)(cw + NC + ng), g2 = *(const f32x2*)(cw + 2 * NC + ng), gb = *(const f32x2*)(cb + ng);
        pre();
        f32x2 am = ldz(Z, q0 - 1, f2), ac = ldz(Z, q0, f2);
        f32x2 gm = ldz(Z, q0 - 1, 64 + f2), gc = ldz(Z, q0, 64 + f2);
#pragma unroll 2
        for (int pl = q0; pl < q1; ++pl) {
          const f32x2 an = ldz(Z, pl + 1, f2), gn = ldz(Z, pl + 1, 64 + f2);
          const int pos = rig0 + pl;
          if (pos < 2048) {
            const f32x2 av = a0 * am + a1 * ac + a2 * an + ab;
            const f32x2 gv = g0 * gm + g1 * gc + g2 * gn + gb;
            const float s0 = av[0] * gv[0] * __builtin_amdgcn_rcpf(1.f + __expf(-gv[0]));
            const float s1 = av[1] * gv[1] * __builtin_amdgcn_rcpf(1.f + __expf(-gv[1]));
            *(unsigned*)(o0 + ((size_t)g * 2048 + pos) * 2816 + nt * 64 + f2) = pack2(s0, s1);
          }
          am = ac; ac = an; gm = gc; gc = gn;
        }
      } else {
        const int cl = (tid & 63) * 2, q = tid >> 6;
        const int p0 = 1 + 32 * q, p1 = (p0 + 32 < 127) ? p0 + 32 : 127;
        const int na = norig(nt, cl);
        const f32x2 a0 = *(const f32x2*)(cw + na), a1 = *(const f32x2*)(cw + NC + na), a2 = *(const f32x2*)(cw + 2 * NC + na), ab = *(const f32x2*)(cb + na);
        pre();
        f32x2 am = ldz(Z, p0 - 1, cl), ac = ldz(Z, p0, cl);
#pragma unroll 2
        for (int pl = p0; pl < p1; ++pl) {
          const f32x2 an = ldz(Z, pl + 1, cl);
          const int pos = rig0 + pl;
          if (pos < 2048) {
            const f32x2 av = a0 * am + a1 * ac + a2 * an + ab;
            *(unsigned*)(o0 + ((size_t)g * 2048 + pos) * 1024 + nt * 128 + cl) = pack2(av[0], av[1]);
          }
          am = ac; ac = an;
        }
      }
    } else {
      pre();
      const int pl = tid & 127, fh = tid >> 7;
      const int pos = rig0 + pl;
      if (pl >= 1 && pl <= 126 && pos < 2048) {
        const int fb = nt - 8;
#pragma unroll 2
        for (int f = fh * 32; f < fh * 32 + 32; f += 2) {
          const int na = norig(nt, f), nb = norig(nt, 64 + f);
          const f32x2 va = *(const f32x2*)(cw + na) * ldz(Z, pl - 1, f) + *(const f32x2*)(cw + NC + na) * ldz(Z, pl, f)
                         + *(const f32x2*)(cw + 2 * NC + na) * ldz(Z, pl + 1, f) + *(const f32x2*)(cb + na);
          const f32x2 vb = *(const f32x2*)(cw + nb) * ldz(Z, pl - 1, 64 + f) + *(const f32x2*)(cw + NC + nb) * ldz(Z, pl, 64 + f)
                         + *(const f32x2*)(cw + 2 * NC + nb) * ldz(Z, pl + 1, 64 + f) + *(const f32x2*)(cb + nb);
          bf16_t* op = o1 + (size_t)(fb * 64 + f) * 16384 + g * 2048 + pos;
          op[0] = f2bf(va[0] * vb[0]);
          op[16384] = f2bf(va[1] * vb[1]);
        }
      }
    }
  }
};

#define GLDS16(gp, lp) __builtin_amdgcn_global_load_lds((const unsigned*)(gp), (__attribute__((address_space(3))) unsigned*)(lp), 16, 0, 0)

template <bool SWAP, class Epi>
__device__ __forceinline__ void gemm_job(char* smem, const bf16_t* __restrict__ A, int lda, const bf16_t* __restrict__ Bt, int K, int N,
                                         int tpg, int a_gstride, int a_goff, int step, int halo, int grows, int MTS, int voff, int vid0, int grid, const Epi& epi) {
  const int tid = get_tid512(), lane = tid & 63, wid = tid >> 6, wr = wid >> 1, wc = wid & 1, fr = lane & 15, fq = lane >> 4;
  const int NT = (N + 255) >> 8, MT = MTS >> 1, ntiles = MT * NT, ns = K >> 6;
  const int full = MT >> 3;
  int v = vid0;
  if (v < voff) v += ((voff - v + grid - 1) / grid) * grid;
  const int swz = (fr >> 1) & 7;
  bool pre_issued = false;
  for (; v < voff + ntiles; v += grid) {
    const int w = v - voff;
    int mt, nt;
    if (w < full * 8 * NT) { const int sr = w / (8 * NT), rem = w - sr * 8 * NT; nt = rem >> 3; mt = sr * 8 + (rem & 7); }
    else { const int w2 = w - full * 8 * NT, rl = MT - full * 8; nt = w2 / rl; mt = full * 8 + (w2 - nt * rl); }
    unsigned ap[4], bp[4];
#pragma unroll
    for (int i = 0; i < 4; ++i) {
      const int r = (tid >> 3) + 64 * i;
      const int cs = tid & 7;
      const int c = ((cs ^ ((r >> 1) & 7)) << 3);
      const int sub = 2 * mt + (r >> 7);
      const int g = sub / tpg, ti = sub - g * tpg;
      int rig = ti * step - halo + (r & 127); rig = rig < 0 ? 0 : (rig > grows - 1 ? grows - 1 : rig);
      ap[i] = (unsigned)((g * a_gstride + a_goff + rig) * lda + c);
      int br = nt * 256 + r; br = br > N - 1 ? N - 1 : br;
      bp[i] = (unsigned)(br * K + c);
    }
    const bool have_next = false;
    f32x4 acc[4][8];
#pragma unroll
    for (int m = 0; m < 4; ++m)
#pragma unroll
      for (int n = 0; n < 8; ++n) acc[m][n] = (f32x4){0.f, 0.f, 0.f, 0.f};
    if (!pre_issued) {
#pragma unroll
      for (int i = 0; i < 4; ++i) { GLDS16(A + (size_t)ap[i], smem + tid * 16 + i * 8192); GLDS16(Bt + (size_t)bp[i], smem + 32768 + tid * 16 + i * 8192); }
    }
    pre_issued = have_next;
    for (int st = 0; st < ns; ++st) {
      asm volatile("s_waitcnt vmcnt(0)" ::: "memory");
      __builtin_amdgcn_s_barrier();
      asm volatile("" ::: "memory");
      if (st + 1 < ns) {
        char* nb = smem + ((st + 1) & 1) * 65536;
        const int ko = (st + 1) * 64;
#pragma unroll
        for (int i = 0; i < 4; ++i) { GLDS16(A + (size_t)(ap[i] + ko), nb + tid * 16 + i * 8192); GLDS16(Bt + (size_t)(bp[i] + ko), nb + 32768 + tid * 16 + i * 8192); }
      }
      const char* sa = smem + (st & 1) * 65536 + (wr * 64 + fr) * 128;
      const char* sb = smem + (st & 1) * 65536 + 32768 + (wc * 128 + fr) * 128;
      bf16x8 afA[4], afB[4], bfb[2][2];
#pragma unroll
      for (int m = 0; m < 4; ++m) afA[m] = *(const bf16x8*)(sa + m * 2048 + ((fq ^ swz) << 4));
#pragma unroll
      for (int n = 0; n < 2; ++n) bfb[0][n] = *(const bf16x8*)(sb + n * 2048 + ((fq ^ swz) << 4));
#pragma unroll
      for (int gq = 0; gq < 8; ++gq) {
        const int ks = gq >> 2, nh = gq & 3;
        if (gq < 7) {
          const int ks2 = (gq + 1) >> 2, nh2 = (gq + 1) & 3;
#pragma unroll
          for (int n = 0; n < 2; ++n) bfb[(gq + 1) & 1][n] = *(const bf16x8*)(sb + (nh2 * 2 + n) * 2048 + (((ks2 * 4 + fq) ^ swz) << 4));
        }
        if (gq == 3) {
#pragma unroll
          for (int m = 0; m < 4; ++m) afB[m] = *(const bf16x8*)(sa + m * 2048 + (((4 + fq) ^ swz) << 4));
        }
        __builtin_amdgcn_sched_barrier(0);
#pragma unroll
        for (int m = 0; m < 4; ++m)
#pragma unroll
          for (int n = 0; n < 2; ++n) {
            const bf16x8 av = ks ? afB[m] : afA[m];
            acc[m][nh * 2 + n] = SWAP ? __builtin_amdgcn_mfma_f32_16x16x32_bf16(bfb[gq & 1][n], av, acc[m][nh * 2 + n], 0, 0, 0)
                                      : __builtin_amdgcn_mfma_f32_16x16x32_bf16(av, bfb[gq & 1][n], acc[m][nh * 2 + n], 0, 0, 0);
          }
      }
    }
    __syncthreads();
    const int te = get_tid512();
    const int fr_e = te & 15, fq_e = (te & 63) >> 4, wr_e = te >> 7, wc_e = (te >> 6) & 1;
    const int sub = 2 * mt + (wr_e >> 1);
    const int g = sub / tpg, ti = sub - g * tpg;
    const int rig0 = ti * step - halo;
    const int rw = (wr_e & 1) * 64;
    if constexpr (Epi::KIND == 0) {
#pragma unroll
      for (int m = 0; m < 4; ++m) {
        const int rig = rig0 + rw + m * 16 + fr_e;
#pragma unroll
        for (int n = 0; n < 8; ++n) {
          const int col = nt * 256 + wc_e * 128 + n * 16 + fq_e * 4;
          if (col < N) epi.c4(g, rig, col, acc[m][n]);
        }
      }
    } else if constexpr (Epi::KIND == 1) {
#pragma unroll
      for (int m = 0; m < 4; ++m) {
        const int rig = rig0 + rw + m * 16 + fq_e * 4;
#pragma unroll
        for (int n = 0; n < 8; ++n) {
          const int col = nt * 256 + wc_e * 128 + n * 16 + fr_e;
          if (col < N) epi.r4(g, rig, col, acc[m][n]);
        }
      }
    } else {
      bf16_t* Zw = (bf16_t*)smem + ((wr_e >> 1) * 2 + wc_e) * (128 * 132);
      const int nt2w = nt * 2 + wc_e;
#pragma unroll
      for (int n = 0; n < 8; ++n) {
        const int cl = n * 16 + fq_e * 4;
        f32x4 b4 = {0.f, 0.f, 0.f, 0.f};
        if (epi.pre_bias) b4 = *(const f32x4*)(epi.pre_bias + epi.norig(nt2w, cl));
#pragma unroll
        for (int m = 0; m < 4; ++m) {
          const int rl = rw + m * 16 + fr_e;
          const int pos = rig0 + rl;
          const bool ok = pos >= 0 && pos < grows;
          f32x4 vv = acc[m][n] + b4;
          if (!ok) vv = (f32x4){0.f, 0.f, 0.f, 0.f};
          uint2 u; u.x = pack2(vv[0], vv[1]); u.y = pack2(vv[2], vv[3]);
          *(uint2*)(Zw + rl * 132 + cl) = u;
        }
      }
      __syncthreads();
      {
        auto no_pre = []() {};
        const bf16_t* Zr = (const bf16_t*)smem + ((wr_e >> 1) * 2) * (128 * 132);
        epi.finish(Zr, g, rig0, nt * 2, no_pre);
        epi.finish(Zr + 128 * 132, g, rig0, nt * 2 + 1, no_pre);
      }
      __syncthreads();
    }
    asm volatile("s_waitcnt vmcnt(0)" ::: "memory");
    __syncthreads();
  }
}

__device__ __forceinline__ void phase_attn(CP& p, char* smem, int vid0, int grid) {
  bf16_t* Ks = (bf16_t*)smem;
  bf16_t* Vs = (bf16_t*)(smem + 64 * 104 * 2);
  const int tid = get_tid(), lane = tid & 63, w = tid >> 6, r = lane & 31, hh = lane >> 5;
  const float cs = 1.4426950408889634f * 0.10206207261596577f;
  for (int it = vid0; it < 2048; it += grid) {
    const int qt = it & 15, h = (it >> 4) & 15, b = it >> 8;
    const int t = qt * 128 + w * 32 + r;
    const size_t xrow = (size_t)b * 2048 + t;
    const bf16_t* qp = p.Q + xrow * 1536 + h * 96;
    bf16x8 qf[6];
#pragma unroll
    for (int kk = 0; kk < 4; ++kk) qf[kk] = *(const bf16x8*)(qp + 16 * kk + 8 * hh);
#pragma unroll
    for (int part = 0; part < 2; ++part) {
      const bf16_t* pp = qp + 64 + 16 * part;
      const bf16x8 mine = *(const bf16x8*)(pp + 8 * hh), oth = *(const bf16x8*)(pp + 8 * (1 - hh));
      const float posf = part == 0 ? (float)(t >> 6) : (float)(t & 63);
      union { unsigned u[4]; bf16x8 v; } o;
      float res[8];
#pragma unroll
      for (int j = 0; j < 8; ++j) {
        const float inv = exp2f(-(float)j * (13.287712379549449f / 8.0f));
        const float ang = posf * inv;
        const float c = __cosf(ang), s = __sinf(ang);
        const float m = bf2f((bf16_t)mine[j]), ov = bf2f((bf16_t)oth[j]);
        res[j] = m * c + (hh ? ov : -ov) * s;
      }
#pragma unroll
      for (int j = 0; j < 4; ++j) o.u[j] = pack2(res[2 * j], res[2 * j + 1]);
      qf[4 + part] = o.v;
    }
    f32x16 oacc[2];
#pragma unroll
    for (int i = 0; i < 16; ++i) { oacc[0][i] = 0.f; oacc[1][i] = 0.f; }
    float mrun = -INFINITY, lrun = 0.f;
    const size_t kvrow0 = (size_t)b * 2304;
    const bf16_t* kn_base = p.Kn + kvrow0 * 1024 + h * 64;
    const bf16_t* kpe_base = p.kpe + kvrow0 * 32;
    const bf16_t* vt_base = p.Vt + ((size_t)(b * 16 + h) * 64) * 2304;
    uint4 rk0, rk1, rp, rv0, rv1;
    const int srow = tid >> 3, sch = tid & 7;
#define ATT_GLOAD(kt) do { \
      rk0 = *(const uint4*)(kn_base + (size_t)((kt) * 64 + srow) * 1024 + sch * 8); \
      rk1 = *(const uint4*)(kn_base + (size_t)((kt) * 64 + srow + 32) * 1024 + sch * 8); \
      rv0 = *(const uint4*)(vt_base + (size_t)srow * 2304 + (kt) * 64 + sch * 8); \
      rv1 = *(const uint4*)(vt_base + (size_t)(srow + 32) * 2304 + (kt) * 64 + sch * 8); \
      rp = *(const uint4*)(kpe_base + (size_t)((kt) * 64 + (tid >> 2)) * 32 + (tid & 3) * 8); } while (0)
    ATT_GLOAD(0);
    for (int kt = 0; kt < 36; ++kt) {
      __syncthreads();
      {
        *(uint4*)(Ks + srow * 104 + sch * 8) = rk0;
        *(uint4*)(Ks + (srow + 32) * 104 + sch * 8) = rk1;
        uint2 lo, hi;
        lo.x = rv0.x; lo.y = rv0.y; hi.x = rv0.z; hi.y = rv0.w;
        *(uint2*)(Vs + srow * 68 + sch * 8) = lo; *(uint2*)(Vs + srow * 68 + sch * 8 + 4) = hi;
        lo.x = rv1.x; lo.y = rv1.y; hi.x = rv1.z; hi.y = rv1.w;
        *(uint2*)(Vs + (srow + 32) * 68 + sch * 8) = lo; *(uint2*)(Vs + (srow + 32) * 68 + sch * 8 + 4) = hi;
      }
      *(uint4*)(Ks + (tid >> 2) * 104 + 64 + (tid & 3) * 8) = rp;
      __syncthreads();
      if (kt + 1 < 36) ATT_GLOAD(kt + 1);
      f32x16 s[2];
#pragma unroll
      for (int t2 = 0; t2 < 2; ++t2) {
#pragma unroll
        for (int i = 0; i < 16; ++i) s[t2][i] = 0.f;
#pragma unroll
        for (int kk = 0; kk < 6; ++kk) {
          const bf16x8 a = *(const bf16x8*)(Ks + (32 * t2 + r) * 104 + 16 * kk + 8 * hh);
          s[t2] = __builtin_amdgcn_mfma_f32_32x32x16_bf16(a, qf[kk], s[t2], 0, 0, 0);
        }
      }
      float mx = s[0][0];
#pragma unroll
      for (int i = 1; i < 16; ++i) mx = fmaxf(mx, s[0][i]);
#pragma unroll
      for (int i = 0; i < 16; ++i) mx = fmaxf(mx, s[1][i]);
      mx = fmaxf(mx, __shfl_xor(mx, 32));
      const float mnew = fmaxf(mrun, mx * cs);
      const float alpha = __builtin_amdgcn_exp2f(mrun - mnew);
      mrun = mnew;
      float psum = 0.f;
      bf16x8 pf[4];
#pragma unroll
      for (int t2 = 0; t2 < 2; ++t2)
#pragma unroll
        for (int hf = 0; hf < 2; ++hf) {
          union { unsigned u[4]; bf16x8 v; } cvp;
#pragma unroll
          for (int i = 0; i < 4; ++i) {
            const float p0 = __builtin_amdgcn_exp2f(s[t2][hf * 8 + 2 * i] * cs - mnew);
            const float p1 = __builtin_amdgcn_exp2f(s[t2][hf * 8 + 2 * i + 1] * cs - mnew);
            psum += p0 + p1;
            cvp.u[i] = pack2(p0, p1);
          }
          pf[t2 * 2 + hf] = cvp.v;
        }
      lrun = lrun * alpha + psum;
#pragma unroll
      for (int i = 0; i < 16; ++i) { oacc[0][i] *= alpha; oacc[1][i] *= alpha; }
#pragma unroll
      for (int dt = 0; dt < 2; ++dt)
#pragma unroll
        for (int s4 = 0; s4 < 4; ++s4) {
          const bf16_t* vp = Vs + (32 * dt + r) * 68 + 16 * s4 + 4 * hh;
          const uint2 lo = *(const uint2*)vp, hi = *(const uint2*)(vp + 8);
          union { uint4 u; bf16x8 v; } cv; cv.u.x = lo.x; cv.u.y = lo.y; cv.u.z = hi.x; cv.u.w = hi.y;
          oacc[dt] = __builtin_amdgcn_mfma_f32_32x32x16_bf16(cv.v, pf[s4], oacc[dt], 0, 0, 0);
        }
    }
    const float ltot = lrun + __shfl_xor(lrun, 32);
    const float inv = 1.f / ltot;
    bf16_t* op = p.hxc + xrow * 1024 + h * 64;
#pragma unroll
    for (int dt = 0; dt < 2; ++dt)
#pragma unroll
      for (int i4 = 0; i4 < 4; ++i4) {
        const int d = 32 * dt + 8 * i4 + 4 * hh;
        uint2 u; u.x = pack2(oacc[dt][4 * i4] * inv, oacc[dt][4 * i4 + 1] * inv); u.y = pack2(oacc[dt][4 * i4 + 2] * inv, oacc[dt][4 * i4 + 3] * inv);
        *(uint2*)(op + d) = u;
      }
  }
}

__device__ __forceinline__ void phase_hyconv(CP& p, char* smem) {
  bf16_t* cp = (bf16_t*)smem;
  bf16_t* Vl = (bf16_t*)(smem + 4 * 8256);
  const int tid = get_tid(), lane = tid & 63, w = tid >> 6, i16 = lane & 15, g4 = lane >> 4;
  const int si = (-i16) & 3;
  const int ocb = 64 * w;
  for (int c = get_bid(); c < 1024; c += VGRID) {
    __syncthreads();
#pragma unroll
    for (int i = 0; i < 2; ++i) { const int ch = tid + 256 * i; *(uint4*)(cp + ch * 8) = *(const uint4*)(p.Rf + (size_t)c * 4096 + ch * 8); }
#pragma unroll
    for (int i = 0; i < 8; ++i) {
      const int q = tid + 256 * i; const int b = q >> 8, l8 = q & 255; const int m1 = l8 >> 3, m2 = (l8 & 7) * 8;
      *(uint4*)(Vl + (8 + m1 * 8 + b) * 80 + m2) = *(const uint4*)(p.vvT + (size_t)c * 16384 + b * 2048 + l8 * 8);
    }
    if (tid < 144) {
      const int colp = tid / 9, part = tid - colp * 9;
      const int col = colp < 8 ? colp : 256 + colp;
      uint4 zz; zz.x = 0; zz.y = 0; zz.z = 0; zz.w = 0;
      *(uint4*)(Vl + col * 80 + part * 8) = zz;
    }
    __syncthreads();
#pragma unroll
    for (int s = 1; s < 4; ++s)
#pragma unroll
      for (int i = 0; i < 2; ++i) {
        const int ch = tid + 256 * i;
        unsigned e[8];
#pragma unroll
        for (int j = 0; j < 8; ++j) { const int idx = 8 * ch + s + j; e[j] = idx < 4096 ? (unsigned)cp[idx] : 0u; }
        uint4 u; u.x = e[0] | (e[1] << 16); u.y = e[2] | (e[3] << 16); u.z = e[4] | (e[5] << 16); u.w = e[6] | (e[7] << 16);
        *(uint4*)(cp + s * 4128 + 8 * ch) = u;
      }
    __syncthreads();
    const bf16_t* abase = cp + si * 4128 + (2048 - i16 - si + 8 * g4);
    f32x4 acc[4][4];
#pragma unroll
    for (int m = 0; m < 4; ++m)
#pragma unroll
      for (int n = 0; n < 4; ++n) acc[m][n] = (f32x4){0.f, 0.f, 0.f, 0.f};
    for (int dl = -31; dl <= 31; ++dl) {
      bf16x8 af[4][2];
#pragma unroll
      for (int mt = 0; mt < 4; ++mt)
#pragma unroll
        for (int kk = 0; kk < 2; ++kk) {
          const bf16_t* ap = abase - 64 * dl - 16 * mt + 32 * kk;
          const uint2 lo = *(const uint2*)ap, hi = *(const uint2*)(ap + 4);
          union { uint4 u; bf16x8 v; } cv; cv.u.x = lo.x; cv.u.y = lo.y; cv.u.z = hi.x; cv.u.w = hi.y;
          af[mt][kk] = cv.v;
        }
#pragma unroll
      for (int jt = 0; jt < 4; ++jt) {
        const int in0 = ocb + 16 * jt - 8 * dl;
        if (in0 >= -8 && in0 <= 248) {
          const bf16_t* bp = Vl + (in0 + 8 + i16) * 80 + 8 * g4;
          const bf16x8 b0 = *(const bf16x8*)bp, b1 = *(const bf16x8*)(bp + 32);
#pragma unroll
          for (int mt = 0; mt < 4; ++mt) {
            acc[mt][jt] = __builtin_amdgcn_mfma_f32_16x16x32_bf16(af[mt][0], b0, acc[mt][jt], 0, 0, 0);
            acc[mt][jt] = __builtin_amdgcn_mfma_f32_16x16x32_bf16(af[mt][1], b1, acc[mt][jt], 0, 0, 0);
          }
        }
      }
    }
    const float db = p.hy_d_bias[c];
#pragma unroll
    for (int mt = 0; mt < 4; ++mt)
#pragma unroll
      for (int jt = 0; jt < 4; ++jt) {
        const int col = ocb + 16 * jt + i16;
        const int n1 = col >> 3, b = col & 7;
        const int n2 = 16 * mt + 4 * g4;
        const uint2 vv = *(const uint2*)(Vl + (col + 8) * 80 + n2);
        const float y0 = acc[mt][jt][0] + bf2f((bf16_t)(vv.x & 0xffff)) * db;
        const float y1 = acc[mt][jt][1] + bf2f((bf16_t)(vv.x >> 16)) * db;
        const float y2 = acc[mt][jt][2] + bf2f((bf16_t)(vv.y & 0xffff)) * db;
        const float y3 = acc[mt][jt][3] + bf2f((bf16_t)(vv.y >> 16)) * db;
        uint2 u; u.x = pack2(y0, y1); u.y = pack2(y2, y3);
        *(uint2*)(p.Yp + (size_t)c * 16384 + b * 2048 + n1 * 64 + n2) = u;
      }
  }
}

__device__ __forceinline__ void phase_transmul(CP& p, char* smem) {
  bf16_t* tl = (bf16_t*)smem;
  const int tid = get_tid();
  for (int it = get_bid(); it < 4096; it += VGRID) {
    const int ct = it & 15, rt = it >> 4;
    const int c0 = ct * 64, r0 = rt * 64;
    __syncthreads();
#pragma unroll
    for (int i = 0; i < 2; ++i) {
      const int ci = tid + 256 * i; const int cc = ci >> 3, ch = ci & 7;
      const uint4 u = *(const uint4*)(p.Yp + (size_t)(c0 + cc) * 16384 + r0 + ch * 8);
      unsigned* d = (unsigned*)(tl + cc * 66 + ch * 8);
      d[0] = u.x; d[1] = u.y; d[2] = u.z; d[3] = u.w;
    }
    __syncthreads();
    const int row = tid >> 2, cq = tid & 3;
    const bf16_t* xp = p.x1h + (size_t)(r0 + row) * 1024 + c0 + cq * 16;
    const uint4 xa = *(const uint4*)xp, xb = *(const uint4*)(xp + 8);
    const unsigned xs[8] = {xa.x, xa.y, xa.z, xa.w, xb.x, xb.y, xb.z, xb.w};
    unsigned o[8];
#pragma unroll
    for (int j = 0; j < 8; ++j) {
      const float y0 = bf2f(tl[(cq * 16 + 2 * j) * 66 + row]) * bf2f((bf16_t)(xs[j] & 0xffff));
      const float y1 = bf2f(tl[(cq * 16 + 2 * j + 1) * 66 + row]) * bf2f((bf16_t)(xs[j] >> 16));
      o[j] = pack2(y0, y1);
    }
    bf16_t* op = p.hxc + (size_t)(r0 + row) * 1024 + c0 + cq * 16;
    uint4 oa; oa.x = o[0]; oa.y = o[1]; oa.z = o[2]; oa.w = o[3];
    uint4 ob; ob.x = o[4]; ob.y = o[5]; ob.z = o[6]; ob.w = o[7];
    *(uint4*)op = oa; *(uint4*)(op + 8) = ob;
  }
}

__global__ void __launch_bounds__(512, 2) mega(P p_arg) {
  __shared__ __attribute__((aligned(16))) char smem[LDS_BYTES];
  cg::grid_group grid = cg::this_grid();
  const int G = gridDim.x;
  CP* pp = (CP*)__builtin_amdgcn_kernarg_segment_ptr();
  const int ph0 = pp->ph0, ph1 = pp->ph1;
  volatile LAS unsigned* xst = (volatile LAS unsigned*)(smem + LDS_BYTES - 16);
  if (threadIdx.x == 0) { xst[0] = 0u; xst[1] = 0u; }
  __syncthreads();
  const XcdBarrier xb = xcd_barrier_post(pp->bar, xst);
  if (ph0 <= 0 && 0 < ph1) {
    asm volatile("" : "+s"(pp));
    CP& p = *pp;
    const int bid = get_rbid();
    const int vid0 = (G & 7) ? bid : ((bid & 7) * (G >> 3) + (bid >> 3));
    const int hb = get_hb();
    char* smem_h = smem + hb * HALF_LDS; (void)smem_h;
    const float* mv0 = p.modv; const float* mv1 = p.modv + (size_t)9 * 6144;
    (void)mv0; (void)mv1; (void)vid0;
    phase_prep(p, smem_h);
    if (0 + 1 < ph1) { if (ph1 > 1000) grid.sync(); else xcd_barrier(xb); }
  }
  if (ph0 <= 1 && 1 < ph1) {
    asm volatile("" : "+s"(pp));
    CP& p = *pp;
    const int bid = get_rbid();
    const int vid0 = (G & 7) ? bid : ((bid & 7) * (G >> 3) + (bid >> 3));
    const int hb = get_hb();
    char* smem_h = smem + hb * HALF_LDS; (void)smem_h;
    const float* mv0 = p.modv; const float* mv1 = p.modv + (size_t)9 * 6144;
    (void)mv0; (void)mv1; (void)vid0;
    phase_normmod_kv(p);
    if (1 + 1 < ph1) { if (ph1 > 1000) grid.sync(); else xcd_barrier(xb); }
  }
  if (ph0 <= 2 && 2 < ph1) {
    asm volatile("" : "+s"(pp));
    CP& p = *pp;
    const int bid = get_rbid();
    const int vid0 = (G & 7) ? bid : ((bid & 7) * (G >> 3) + (bid >> 3));
    const int hb = get_hb();
    char* smem_h = smem + hb * HALF_LDS; (void)smem_h;
    const float* mv0 = p.modv; const float* mv1 = p.modv + (size_t)9 * 6144;
    (void)mv0; (void)mv1; (void)vid0;
    {
        EpiStore e1{p.cq, 512, 2048, nullptr};
        gemm_job<true>(smem, p.hxc, 1024, p.wt_dq, 1024, 512, 16, 2304, 256, 128, 0, 2048, 128, 0, vid0, G, e1);
        EpiStore e2{p.kv, 288, 2304, nullptr};
        gemm_job<true>(smem, p.hxc, 1024, p.wt_dkv, 1024, 288, 18, 2304, 0, 128, 0, 2304, 144, 64 * 2, vid0, G, e2);
        EpiFilt e3{p.Rf, p.hy_decay};
        gemm_job<false>(smem, p.h2bf, 64, p.wt_f3, 64, 2048, 16, 0, 0, 128, 0, 2048, 16, 64 * 2 + 72 * 2, vid0, G, e3);
      }
    if (2 + 1 < ph1) { if (ph1 > 1000) grid.sync(); else xcd_barrier(xb); }
  }
  if (ph0 <= 3 && 3 < ph1) {
    asm volatile("" : "+s"(pp));
    CP& p = *pp;
    const int bid = get_rbid();
    const int vid0 = (G & 7) ? bid : ((bid & 7) * (G >> 3) + (bid >> 3));
    const int hb = get_hb();
    char* smem_h = smem + hb * HALF_LDS; (void)smem_h;
    const float* mv0 = p.modv; const float* mv1 = p.modv + (size_t)9 * 6144;
    (void)mv0; (void)mv1; (void)vid0;
    phase_rowstat(p);
    if (3 + 1 < ph1) { if (ph1 > 1000) grid.sync(); else xcd_barrier(xb); }
  }
  if (ph0 <= 4 && 4 < ph1) {
    asm volatile("" : "+s"(pp));
    CP& p = *pp;
    const int bid = get_rbid();
    const int vid0 = (G & 7) ? bid : ((bid & 7) * (G >> 3) + (bid >> 3));
    const int hb = get_hb();
    char* smem_h = smem + hb * HALF_LDS; (void)smem_h;
    const float* mv0 = p.modv; const float* mv1 = p.modv + (size_t)9 * 6144;
    (void)mv0; (void)mv1; (void)vid0;
    {
        EpiStore e1{p.Q, 1536, 2048, p.rq};
        gemm_job<true>(smem, p.cq, 512, p.wt_uq, 512, 1536, 16, 2048, 0, 128, 0, 2048, 128, 0, vid0, G, e1);
        EpiStore e2{p.Kn, 1024, 2304, p.rkv};
        gemm_job<true>(smem, p.kv, 288, p.wt_uk, 256, 1024, 18, 2304, 0, 128, 0, 2304, 144, 64 * 6, vid0, G, e2);
        EpiVt e3{p.Vt, p.rkv};
        gemm_job<false>(smem, p.kv, 288, p.wt_uv, 256, 1024, 18, 2304, 0, 128, 0, 2304, 144, 64 * 6 + 72 * 4, vid0, G, e3);
      }
    if (4 + 1 < ph1) { if (ph1 > 1000) grid.sync(); else xcd_barrier(xb); }
  }
  if (ph0 <= 5 && 5 < ph1) {
    asm volatile("" : "+s"(pp));
    CP& p = *pp;
    const int bid = get_rbid();
    const int vid0 = (G & 7) ? bid : ((bid & 7) * (G >> 3) + (bid >> 3));
    const int hb = get_hb();
    char* smem_h = smem + hb * HALF_LDS; (void)smem_h;
    const float* mv0 = p.modv; const float* mv1 = p.modv + (size_t)9 * 6144;
    (void)mv0; (void)mv1; (void)vid0;
    phase_attn(p, smem_h, 2 * vid0 + hb, 2 * G);
    if (5 + 1 < ph1) { if (ph1 > 1000) grid.sync(); else xcd_barrier(xb); }
  }
  if (ph0 <= 6 && 6 < ph1) {
    asm volatile("" : "+s"(pp));
    CP& p = *pp;
    const int bid = get_rbid();
    const int vid0 = (G & 7) ? bid : ((bid & 7) * (G >> 3) + (bid >> 3));
    const int hb = get_hb();
    char* smem_h = smem + hb * HALF_LDS; (void)smem_h;
    const float* mv0 = p.modv; const float* mv1 = p.modv + (size_t)9 * 6144;
    (void)mv0; (void)mv1; (void)vid0;
    {
        EpiResid<true> e{p.X16, p.x, mv0 + 2 * 1024, nullptr};
        gemm_job<true>(smem, p.hxc, 1024, p.wt_o, 1024, 1024, 16, 2048, 0, 128, 0, 2048, 128, 0, vid0, G, e);
      }
    if (6 + 1 < ph1) { if (ph1 > 1000) grid.sync(); else xcd_barrier(xb); }
  }
  if (ph0 <= 7 && 7 < ph1) {
    asm volatile("" : "+s"(pp));
    CP& p = *pp;
    const int bid = get_rbid();
    const int vid0 = (G & 7) ? bid : ((bid & 7) * (G >> 3) + (bid >> 3));
    const int hb = get_hb();
    char* smem_h = smem + hb * HALF_LDS; (void)smem_h;
    const float* mv0 = p.modv; const float* mv1 = p.modv + (size_t)9 * 6144;
    (void)mv0; (void)mv1; (void)vid0;
    phase_normmod_x(p, p.norm_ffn_g, 0, 3);
    if (7 + 1 < ph1) { if (ph1 > 1000) grid.sync(); else xcd_barrier(xb); }
  }
  if (ph0 <= 8 && 8 < ph1) {
    asm volatile("" : "+s"(pp));
    CP& p = *pp;
    const int bid = get_rbid();
    const int vid0 = (G & 7) ? bid : ((bid & 7) * (G >> 3) + (bid >> 3));
    const int hb = get_hb();
    char* smem_h = smem + hb * HALF_LDS; (void)smem_h;
    const float* mv0 = p.modv; const float* mv1 = p.modv + (size_t)9 * 6144;
    (void)mv0; (void)mv1; (void)vid0;
    {
        EpiConv<0> e{p.ffn_conv_w, p.ffn_conv_b, 5632, nullptr, p.act, nullptr};
        gemm_job<true>(smem, p.hxc, 1024, p.wt_up0, 1024, 5632, 17, 2048, 0, 126, 1, 2048, 136, 0, vid0, G, e);
      }
    if (8 + 1 < ph1) { if (ph1 > 1000) grid.sync(); else xcd_barrier(xb); }
  }
  if (ph0 <= 9 && 9 < ph1) {
    asm volatile("" : "+s"(pp));
    CP& p = *pp;
    const int bid = get_rbid();
    const int vid0 = (G & 7) ? bid : ((bid & 7) * (G >> 3) + (bid >> 3));
    const int hb = get_hb();
    char* smem_h = smem + hb * HALF_LDS; (void)smem_h;
    const float* mv0 = p.modv; const float* mv1 = p.modv + (size_t)9 * 6144;
    (void)mv0; (void)mv1; (void)vid0;
    {
        EpiResid<false> e{p.X16, p.X16, mv0 + 5 * 1024, nullptr};
        gemm_job<true>(smem, p.act, 2816, p.wt_dn0, 2816, 1024, 16, 2048, 0, 128, 0, 2048, 128, 0, vid0, G, e);
      }
    if (9 + 1 < ph1) { if (ph1 > 1000) grid.sync(); else xcd_barrier(xb); }
  }
  if (ph0 <= 10 && 10 < ph1) {
    asm volatile("" : "+s"(pp));
    CP& p = *pp;
    const int bid = get_rbid();
    const int vid0 = (G & 7) ? bid : ((bid & 7) * (G >> 3) + (bid >> 3));
    const int hb = get_hb();
    char* smem_h = smem + hb * HALF_LDS; (void)smem_h;
    const float* mv0 = p.modv; const float* mv1 = p.modv + (size_t)9 * 6144;
    (void)mv0; (void)mv1; (void)vid0;
    phase_normmod_x(p, p.norm_mix_g + 1024, 1, 0);
    if (10 + 1 < ph1) { if (ph1 > 1000) grid.sync(); else xcd_barrier(xb); }
  }
  if (ph0 <= 11 && 11 < ph1) {
    asm volatile("" : "+s"(pp));
    CP& p = *pp;
    const int bid = get_rbid();
    const int vid0 = (G & 7) ? bid : ((bid & 7) * (G >> 3) + (bid >> 3));
    const int hb = get_hb();
    char* smem_h = smem + hb * HALF_LDS; (void)smem_h;
    const float* mv0 = p.modv; const float* mv1 = p.modv + (size_t)9 * 6144;
    (void)mv0; (void)mv1; (void)vid0;
    {
        EpiConv<1> e{p.hy_conv_w, p.hy_conv_b, 3072, p.hy_b_in, p.x1h, p.vvT};
        gemm_job<true>(smem, p.hxc, 1024, p.wt_hin, 1024, 3072, 17, 2048, 0, 126, 1, 2048, 136, 0, vid0, G, e);
      }
    if (11 + 1 < ph1) { if (ph1 > 1000) grid.sync(); else xcd_barrier(xb); }
  }
  if (ph0 <= 12 && 12 < ph1) {
    asm volatile("" : "+s"(pp));
    CP& p = *pp;
    const int bid = get_rbid();
    const int vid0 = (G & 7) ? bid : ((bid & 7) * (G >> 3) + (bid >> 3));
    const int hb = get_hb();
    char* smem_h = smem + hb * HALF_LDS; (void)smem_h;
    const float* mv0 = p.modv; const float* mv1 = p.modv + (size_t)9 * 6144;
    (void)mv0; (void)mv1; (void)vid0;
    phase_hyconv(p, smem_h);
    if (12 + 1 < ph1) { if (ph1 > 1000) grid.sync(); else xcd_barrier(xb); }
  }
  if (ph0 <= 13 && 13 < ph1) {
    asm volatile("" : "+s"(pp));
    CP& p = *pp;
    const int bid = get_rbid();
    const int vid0 = (G & 7) ? bid : ((bid & 7) * (G >> 3) + (bid >> 3));
    const int hb = get_hb();
    char* smem_h = smem + hb * HALF_LDS; (void)smem_h;
    const float* mv0 = p.modv; const float* mv1 = p.modv + (size_t)9 * 6144;
    (void)mv0; (void)mv1; (void)vid0;
    phase_transmul(p, smem_h);
    if (13 + 1 < ph1) { if (ph1 > 1000) grid.sync(); else xcd_barrier(xb); }
  }
  if (ph0 <= 14 && 14 < ph1) {
    asm volatile("" : "+s"(pp));
    CP& p = *pp;
    const int bid = get_rbid();
    const int vid0 = (G & 7) ? bid : ((bid & 7) * (G >> 3) + (bid >> 3));
    const int hb = get_hb();
    char* smem_h = smem + hb * HALF_LDS; (void)smem_h;
    const float* mv0 = p.modv; const float* mv1 = p.modv + (size_t)9 * 6144;
    (void)mv0; (void)mv1; (void)vid0;
    {
        EpiResid<false> e{p.X16, p.X16, mv1 + 2 * 1024, p.hy_b_out};
        gemm_job<true>(smem, p.hxc, 1024, p.wt_hout, 1024, 1024, 16, 2048, 0, 128, 0, 2048, 128, 0, vid0, G, e);
      }
    if (14 + 1 < ph1) { if (ph1 > 1000) grid.sync(); else xcd_barrier(xb); }
  }
  if (ph0 <= 15 && 15 < ph1) {
    asm volatile("" : "+s"(pp));
    CP& p = *pp;
    const int bid = get_rbid();
    const int vid0 = (G & 7) ? bid : ((bid & 7) * (G >> 3) + (bid >> 3));
    const int hb = get_hb();
    char* smem_h = smem + hb * HALF_LDS; (void)smem_h;
    const float* mv0 = p.modv; const float* mv1 = p.modv + (size_t)9 * 6144;
    (void)mv0; (void)mv1; (void)vid0;
    phase_normmod_x(p, p.norm_ffn_g + 1024, 1, 3);
    if (15 + 1 < ph1) { if (ph1 > 1000) grid.sync(); else xcd_barrier(xb); }
  }
  if (ph0 <= 16 && 16 < ph1) {
    asm volatile("" : "+s"(pp));
    CP& p = *pp;
    const int bid = get_rbid();
    const int vid0 = (G & 7) ? bid : ((bid & 7) * (G >> 3) + (bid >> 3));
    const int hb = get_hb();
    char* smem_h = smem + hb * HALF_LDS; (void)smem_h;
    const float* mv0 = p.modv; const float* mv1 = p.modv + (size_t)9 * 6144;
    (void)mv0; (void)mv1; (void)vid0;
    {
        EpiConv<0> e{p.ffn_conv_w + (size_t)3 * 5632, p.ffn_conv_b + 5632, 5632, nullptr, p.act, nullptr};
        gemm_job<true>(smem, p.hxc, 1024, p.wt_up1, 1024, 5632, 17, 2048, 0, 126, 1, 2048, 136, 0, vid0, G, e);
      }
    if (16 + 1 < ph1) { if (ph1 > 1000) grid.sync(); else xcd_barrier(xb); }
  }
  if (ph0 <= 17 && 17 < ph1) {
    asm volatile("" : "+s"(pp));
    CP& p = *pp;
    const int bid = get_rbid();
    const int vid0 = (G & 7) ? bid : ((bid & 7) * (G >> 3) + (bid >> 3));
    const int hb = get_hb();
    char* smem_h = smem + hb * HALF_LDS; (void)smem_h;
    const float* mv0 = p.modv; const float* mv1 = p.modv + (size_t)9 * 6144;
    (void)mv0; (void)mv1; (void)vid0;
    {
        EpiResid<false> e{p.X16, p.X16, mv1 + 5 * 1024, nullptr};
        gemm_job<true>(smem, p.act, 2816, p.wt_dn1, 2816, 1024, 16, 2048, 0, 128, 0, 2048, 128, 0, vid0, G, e);
      }
    if (17 + 1 < ph1) { if (ph1 > 1000) grid.sync(); else xcd_barrier(xb); }
  }
  if (ph0 <= 18 && 18 < ph1) {
    asm volatile("" : "+s"(pp));
    CP& p = *pp;
    const int bid = get_rbid();
    const int vid0 = (G & 7) ? bid : ((bid & 7) * (G >> 3) + (bid >> 3));
    const int hb = get_hb();
    char* smem_h = smem + hb * HALF_LDS; (void)smem_h;
    const float* mv0 = p.modv; const float* mv1 = p.modv + (size_t)9 * 6144;
    (void)mv0; (void)mv1; (void)vid0;
    phase_final_norm(p);
    if (18 + 1 < ph1) { if (ph1 > 1000) grid.sync(); else xcd_barrier(xb); }
  }
}

extern "C" void kernel_launch(void* const* d_in, const int* in_sizes, int n_in, void* d_out, int out_size, void* d_ws, size_t ws_size, hipStream_t stream) {
  static int grid_blocks = 0;
  if (!grid_blocks) {
    int dev = 0, cus = 0, per_cu = 0;
    hipGetDevice(&dev);
    hipDeviceGetAttribute(&cus, hipDeviceAttributeMultiprocessorCount, dev);
    hipOccupancyMaxActiveBlocksPerMultiprocessor(&per_cu, (const void*)mega, 512, 0);
    per_cu = 1;
    grid_blocks = cus * per_cu;
  }
  P p{};
  const float** in = (const float**)&p;
  for (int i = 0; i < 36; ++i) in[i] = (const float*)d_in[i];
  p.X = (float*)d_out;
  char* ws = (char*)d_ws; size_t off = 0;
  auto take = [&](size_t bytes) { char* r = ws + off; off += (bytes + 255) & ~(size_t)255; return r; };
  p.wt_dq = (bf16_t*)take((size_t)512 * 1024 * 2);
  p.wt_dkv = (bf16_t*)take((size_t)288 * 1024 * 2);
  p.wt_uq = (bf16_t*)take((size_t)1536 * 512 * 2);
  p.wt_uk = (bf16_t*)take((size_t)1024 * 256 * 2);
  p.wt_uv = (bf16_t*)take((size_t)1024 * 256 * 2);
  p.wt_o = (bf16_t*)take((size_t)1024 * 1024 * 2);
  p.wt_hin = (bf16_t*)take((size_t)3072 * 1024 * 2);
  p.wt_hout = (bf16_t*)take((size_t)1024 * 1024 * 2);
  p.wt_up0 = (bf16_t*)take((size_t)5632 * 1024 * 2);
  p.wt_up1 = (bf16_t*)take((size_t)5632 * 1024 * 2);
  p.wt_dn0 = (bf16_t*)take((size_t)1024 * 2816 * 2);
  p.wt_dn1 = (bf16_t*)take((size_t)1024 * 2816 * 2);
  p.modv = (float*)take((size_t)2 * 9 * 6144 * 4);
  p.rq = (float*)take((size_t)16384 * 4);
  p.rkv = (float*)take((size_t)18432 * 4);
  p.modp = (float*)take((size_t)4 * 110592 * 4);
  p.bar = (unsigned*)take((size_t)XCD_BAR_WORDS * 4);
  p.wt_f3 = (bf16_t*)take((size_t)2048 * 64 * 2);
  p.h2bf = (bf16_t*)take((size_t)2048 * 64 * 2);
  p.Rf = (bf16_t*)take((size_t)1024 * 4096 * 2);
  p.kpe = (bf16_t*)take((size_t)18432 * 32 * 2);
  p.hxc = (bf16_t*)take((size_t)18432 * 1024 * 2);
  const size_t ubase = off;
  p.cq = (bf16_t*)take((size_t)16384 * 512 * 2);
  p.kv = (bf16_t*)take((size_t)18432 * 288 * 2);
  p.Q = (bf16_t*)take((size_t)16384 * 1536 * 2);
  p.Kn = (bf16_t*)take((size_t)18432 * 1024 * 2);
  p.Vt = (bf16_t*)take((size_t)18432 * 1024 * 2);
  const size_t uend1 = off;
  p.X16 = (bf16_t*)(ws + ubase + (size_t)104857600);
  off = ubase;
  p.act = (bf16_t*)take((size_t)16384 * 2816 * 2);
  off = ubase;
  p.x1h = (bf16_t*)take((size_t)16384 * 1024 * 2);
  p.vvT = (bf16_t*)take((size_t)16384 * 1024 * 2);
  p.Yp = (bf16_t*)take((size_t)16384 * 1024 * 2);
  if (uend1 > ws_size) { fprintf(stderr, "workspace too small: need %zu have %zu\n", uend1, ws_size); return; }
  p.ph0 = 0; p.ph1 = NPHASE;
  if (hipMemsetAsync(p.bar, 0, (size_t)XCD_BAR_WORDS * 4, stream) != hipSuccess) { fprintf(stderr, "memset failed\n"); return; }
  void* args[] = {&p};
  hipError_t e = hipLaunchCooperativeKernel((const void*)mega, dim3(grid_blocks), dim3(512), args, 0, stream);
  if (e != hipSuccess) fprintf(stderr, "cooperative launch failed: %s (grid %d)\n", hipGetErrorString(e), grid_blocks);
}
```

```cpp
#include <hip/hip_runtime.h>
#include <hip/hip_cooperative_groups.h>
#include <cstdio>
namespace cg = cooperative_groups;

typedef unsigned short bf16_t;
typedef short bf16x8 __attribute__((ext_vector_type(8)));
typedef float f32x4 __attribute__((ext_vector_type(4)));
typedef float f32x16 __attribute__((ext_vector_type(16)));

#define LDS_BYTES 163840
#define HALF_LDS 81920
#define NPHASE 19

struct P {
  const float *x, *c, *ctx, *c_ctx, *mod_w, *mod_b, *norm_mix_g, *norm_ffn_g;
  const float *w_dq, *g_q, *w_uq, *w_dkv, *g_kv, *w_uk, *w_uv, *w_o;
  const float *hy_w_in, *hy_b_in, *hy_conv_w, *hy_conv_b, *f_w1, *f_b1, *f_freq1, *f_w2, *f_b2, *f_freq2, *f_w3, *hy_decay, *hy_d_bias, *hy_w_out, *hy_b_out;
  const float *ffn_w_up, *ffn_conv_w, *ffn_conv_b, *ffn_w_down, *final_g;
  float* X;
  bf16_t *wt_dq, *wt_dkv, *wt_uq, *wt_uk, *wt_uv, *wt_o, *wt_hin, *wt_hout, *wt_up0, *wt_up1, *wt_dn0, *wt_dn1;
  float *modv, *rq, *rkv, *modp;
  unsigned* bar;
  bf16_t *wt_f3, *h2bf, *X16;
  bf16_t *Rf, *kpe, *hxc, *cq, *kv, *Q, *Kn, *Vt, *act, *x1h, *vvT, *Yp;
  int ph0, ph1;
};

typedef const __attribute__((address_space(4))) P CP;
__device__ __forceinline__ int get_tid512() { int t = threadIdx.x; asm volatile("" : "+v"(t)); return t; }
__device__ __forceinline__ int get_tid() { int t = threadIdx.x & 255; asm volatile("" : "+v"(t)); return t; }
__device__ __forceinline__ int get_hb() { int t = __builtin_amdgcn_readfirstlane((int)(threadIdx.x >> 8)); asm volatile("" : "+s"(t)); return t; }
__device__ __forceinline__ int get_rbid() { int t = blockIdx.x; asm volatile("" : "+s"(t)); return t; }
__device__ __forceinline__ int get_bid() { return 2 * get_rbid() + get_hb(); }
#define VGRID (2 * (int)gridDim.x)

__device__ __forceinline__ unsigned pack2(float a, float b) { unsigned r; asm("v_cvt_pk_bf16_f32 %0, %1, %2" : "=v"(r) : "v"(a), "v"(b)); return r; }
__device__ __forceinline__ bf16_t f2bf(float f) { return (bf16_t)(pack2(f, f) & 0xffffu); }
__device__ __forceinline__ float bf2f(bf16_t h) { return __uint_as_float(((unsigned)h) << 16); }
__device__ __forceinline__ float wave_sum(float v) {
#pragma unroll
  for (int o = 32; o; o >>= 1) v += __shfl_xor(v, o);
  return v;
}


#define XB_TMO      128
#define XB_XCNT(j)  (256  + 64 * (j))
#define XB_XSUB(j)  (1280 + 64 * (j))
#define XB_XGEN(j)  (2304 + 64 * (j))
#define XB_TOP      3328
#define XB_TOPGEN   3392
#define XCD_BAR_WORDS 3456
#define XB_SPIN_CAP (1u << 18)
#define LAS __attribute__((address_space(3)))
__device__ __forceinline__ unsigned xb_ld(unsigned* p)              { return __hip_atomic_load(p, __ATOMIC_RELAXED, __HIP_MEMORY_SCOPE_AGENT); }
__device__ __forceinline__ unsigned xb_add(unsigned* p, unsigned v) { return __hip_atomic_fetch_add(p, v, __ATOMIC_RELAXED, __HIP_MEMORY_SCOPE_AGENT); }
__device__ __forceinline__ unsigned xb_xcc_id() { return (unsigned)__builtin_amdgcn_s_getreg((3 << 11) | 20) & 0xFu; }
#define XB_SPIN(cond, bar) do { unsigned _sp = 0; while (cond) { __builtin_amdgcn_s_sleep(1); \
    if ((++_sp & 255u) == 0u) { if (xb_ld(&(bar)[XB_TMO])) break; if (_sp > XB_SPIN_CAP) { atomicAdd(&(bar)[XB_TMO], 1u); break; } } } } while (0)
struct XcdBarrier { unsigned* bar; unsigned x; volatile LAS unsigned* st; };
__device__ __forceinline__ XcdBarrier xcd_barrier_post(unsigned* bar, volatile LAS unsigned* st) {
    XcdBarrier b; b.bar = bar; b.x = xb_xcc_id(); b.st = st;
    if (threadIdx.x == 0) (void)xb_add(&bar[XB_XCNT(b.x)], 1u);
    return b;
}
__device__ __forceinline__ void xcd_barrier_complete(unsigned* bar, unsigned x, unsigned& nloc, unsigned& nx) {
    const unsigned G = gridDim.x * gridDim.y * gridDim.z;
    unsigned sum, cnt, mine, sp = 0u;
    for (;;) {
        sum = 0u; cnt = 0u; mine = 0u;
#pragma unroll
        for (unsigned j = 0; j < 16; ++j) { const unsigned c = xb_ld(&bar[XB_XCNT(j)]); sum += c; cnt += (c > 0u) ? 1u : 0u; mine = (j == x) ? c : mine; }
        if (sum == G) break;
        __builtin_amdgcn_s_sleep(1);
        if ((++sp & 255u) == 0u) { if (xb_ld(&bar[XB_TMO])) break; if (sp > XB_SPIN_CAP) { atomicAdd(&bar[XB_TMO], 1u); break; } }
    }
    nloc = mine > 0u ? mine : 1u; nx = cnt > 0u ? cnt : 1u;
}
__device__ __forceinline__ void xcd_barrier(const XcdBarrier& b) {
    asm volatile("s_waitcnt vmcnt(0)" ::: "memory");
    __syncthreads();
    if (threadIdx.x == 0) {
        unsigned* bar = b.bar;
        __builtin_amdgcn_s_waitcnt(0);
        unsigned nloc = b.st[0], nx = b.st[1];
        if (nloc == 0u) { xcd_barrier_complete(bar, b.x, nloc, nx); b.st[0] = nloc; b.st[1] = nx; }
        const unsigned old = xb_add(&bar[XB_XSUB(b.x)], 1u);
        const unsigned gen = old / nloc;
        if (old + 1u == (gen + 1u) * nloc) {
            __builtin_amdgcn_fence(__ATOMIC_RELEASE, "agent");
            asm volatile("s_waitcnt vmcnt(0)" ::: "memory");
            const unsigned og = xb_add(&bar[XB_TOP], 1u);
            const unsigned tg = og / nx;
            if (og + 1u == (tg + 1u) * nx) xb_add(&bar[XB_TOPGEN], 1u);
            else XB_SPIN(xb_ld(&bar[XB_TOPGEN]) == tg, bar);
            __builtin_amdgcn_fence(__ATOMIC_ACQUIRE, "agent");
            xb_add(&bar[XB_XGEN(b.x)], 1u);
            asm volatile("s_waitcnt vmcnt(0)" ::: "memory");
        } else {
            XB_SPIN(xb_ld(&bar[XB_XGEN(b.x)]) == gen, bar);
            __builtin_amdgcn_fence(__ATOMIC_ACQUIRE, "agent");
            asm volatile("s_waitcnt vmcnt(0)" ::: "memory");
        }
    }
    __syncthreads();
}

__device__ __forceinline__ void prep_weight_tile(CP& p, char* smem, int wt) {
  const int tid = get_tid();
  int id = 0;
  {
    const int cnt[13] = {64, 40, 96, 32, 32, 128, 384, 128, 704, 704, 352, 352, 32};
#pragma unroll
    for (int i = 0; i < 12; ++i) { if (id == i && wt >= cnt[i]) { wt -= cnt[i]; id = i + 1; } }
  }
  const float* src; int K, N; bf16_t* dst; const float* scale = nullptr; int perm = 0;
  switch (id) {
    case 0: src = p.w_dq; K = 1024; N = 512; dst = p.wt_dq; break;
    case 1: src = p.w_dkv; K = 1024; N = 288; dst = p.wt_dkv; break;
    case 2: src = p.w_uq; K = 512; N = 1536; dst = p.wt_uq; scale = p.g_q; break;
    case 3: src = p.w_uk; K = 256; N = 1024; dst = p.wt_uk; scale = p.g_kv; break;
    case 4: src = p.w_uv; K = 256; N = 1024; dst = p.wt_uv; scale = p.g_kv; break;
    case 5: src = p.w_o; K = 1024; N = 1024; dst = p.wt_o; break;
    case 6: src = p.hy_w_in; K = 1024; N = 3072; dst = p.wt_hin; perm = 2; break;
    case 7: src = p.hy_w_out; K = 1024; N = 1024; dst = p.wt_hout; break;
    case 8: src = p.ffn_w_up; K = 1024; N = 5632; dst = p.wt_up0; perm = 1; break;
    case 9: src = p.ffn_w_up + (size_t)1024 * 5632; K = 1024; N = 5632; dst = p.wt_up1; perm = 1; break;
    case 10: src = p.ffn_w_down; K = 2816; N = 1024; dst = p.wt_dn0; break;
    case 11: src = p.ffn_w_down + (size_t)2816 * 1024; K = 2816; N = 1024; dst = p.wt_dn1; break;
    default: src = p.f_w3; K = 64; N = 2048; dst = p.wt_f3; break;
  }
  const int ntn = (N + 63) >> 6;
  const int kt = wt / ntn, nt = wt - kt * ntn;
  const int k0 = kt * 128, n0 = nt * 64;
  int np0;
  if (perm == 1) { const int half = n0 / 2816, f = n0 - half * 2816; np0 = (f >> 6) * 128 + half * 64; }
  else if (perm == 2) { if (n0 < 1024) np0 = n0; else { const int m = n0 - 1024, half = m >> 10, f = m & 1023; np0 = 1024 + (f >> 6) * 128 + half * 64; } }
  else np0 = n0;
  bf16_t* t16 = (bf16_t*)smem;
  f32x4 v[8];
#pragma unroll
  for (int i = 0; i < 8; ++i) {
    const int idx = tid + 256 * i; const int kr = idx >> 4, c4 = idx & 15;
    v[i] = (f32x4){0.f, 0.f, 0.f, 0.f};
    if (n0 + 4 * c4 < N && k0 + kr < K) v[i] = *(const f32x4*)(src + (size_t)(k0 + kr) * N + n0 + 4 * c4);
  }
#pragma unroll
  for (int i = 0; i < 8; ++i) {
    const int idx = tid + 256 * i; const int kr = idx >> 4, c4 = idx & 15;
    const float sc = (scale && k0 + kr < K) ? scale[k0 + kr] : 1.f;
#pragma unroll
    for (int j = 0; j < 4; ++j) t16[(4 * c4 + j) * 136 + kr] = f2bf(v[i][j] * sc);
  }
  __syncthreads();
#pragma unroll
  for (int i = 0; i < 4; ++i) {
    const int idx = tid + 256 * i; const int n = idx >> 4, ch = idx & 15;
    if (n0 + n < N && k0 + ch * 8 < K) *(uint4*)(dst + (size_t)(np0 + n) * K + k0 + ch * 8) = *(const uint4*)(t16 + n * 136 + ch * 8);
  }
  __syncthreads();
}

__device__ __forceinline__ void prep_modvec(CP& p, char* smem, int it) {
  const int tid = get_tid();
  const int layer = it / 384, rem = it - layer * 384, cb = rem >> 2, ks = rem & 3;
  float* s_lds = (float*)smem;
  float* red = (float*)(smem + 12288);
  const int kbase = ks * 256;
  for (int idx = tid; idx < 9 * 256; idx += 256) {
    const int r = idx >> 8, k = idx & 255;
    const float v = r < 8 ? p.c[r * 1024 + kbase + k] : p.c_ctx[kbase + k];
    s_lds[k * 12 + r] = v / (1.f + __expf(-v));
  }
  __syncthreads();
  const int col = cb * 64 + (tid & 63), kg = tid >> 6;
  const float* W = p.mod_w + (size_t)layer * 1024 * 6144 + (size_t)kbase * 6144 + col;
  float acc[9];
#pragma unroll
  for (int r = 0; r < 9; ++r) acc[r] = 0.f;
#pragma unroll
  for (int kb = 0; kb < 4; ++kb) {
    float w[16];
#pragma unroll
    for (int u = 0; u < 16; ++u) w[u] = W[(size_t)(kg * 64 + kb * 16 + u) * 6144];
#pragma unroll
    for (int u = 0; u < 16; ++u) {
      const int k = kg * 64 + kb * 16 + u;
      const f32x4 s0 = *(const f32x4*)(s_lds + k * 12), s1 = *(const f32x4*)(s_lds + k * 12 + 4);
      const float s2 = s_lds[k * 12 + 8];
      acc[0] += s0[0] * w[u]; acc[1] += s0[1] * w[u]; acc[2] += s0[2] * w[u]; acc[3] += s0[3] * w[u];
      acc[4] += s1[0] * w[u]; acc[5] += s1[1] * w[u]; acc[6] += s1[2] * w[u]; acc[7] += s1[3] * w[u];
      acc[8] += s2 * w[u];
    }
  }
#pragma unroll
  for (int r = 0; r < 9; ++r) red[(kg * 9 + r) * 64 + (tid & 63)] = acc[r];
  __syncthreads();
  for (int o = tid; o < 9 * 64; o += 256) {
    const int r = o >> 6, cl = o & 63;
    const float sm = red[(0 * 9 + r) * 64 + cl] + red[(1 * 9 + r) * 64 + cl] + red[(2 * 9 + r) * 64 + cl] + red[(3 * 9 + r) * 64 + cl];
    p.modp[(size_t)ks * 110592 + (size_t)(layer * 9 + r) * 6144 + cb * 64 + cl] = sm;
  }
  __syncthreads();
}

__device__ __forceinline__ void prep_filter(CP& p, char* smem, int it) {
  const int tid = get_tid();
  float* z = (float*)smem;
  float* h1 = z + 8 * 33;
  float* h2 = h1 + 8 * 64;
  const int t0 = it * 8;
  for (int idx = tid; idx < 8 * 33; idx += 256) {
    const int pp = idx / 33, i = idx - pp * 33;
    const int t = t0 + pp;
    float v;
    if (i == 0) v = (float)t * (1.0f / 2047.0f);
    else {
      const int k = (i - 1) & 15;
      const float w = (6.283185307179586f * (float)t) / 2048.0f;
      const float f = 1e-4f + (float)k * ((15.0f - 1e-4f) / 15.0f);
      const float a = w * f;
      v = (i <= 16) ? __cosf(a) : -__sinf(a);
    }
    z[idx] = v;
  }
  __syncthreads();
  for (int idx = tid; idx < 8 * 64; idx += 256) {
    const int pp = idx >> 6, j = idx & 63;
    float s = p.f_b1[j];
#pragma unroll
    for (int i = 0; i < 33; ++i) s += z[pp * 33 + i] * p.f_w1[i * 64 + j];
    h1[idx] = __sinf(p.f_freq1[j] * s);
  }
  __syncthreads();
  for (int idx = tid; idx < 8 * 64; idx += 256) {
    const int pp = idx >> 6, j = idx & 63;
    float s = p.f_b2[j];
#pragma unroll 16
    for (int i = 0; i < 64; ++i) s += h1[pp * 64 + i] * p.f_w2[i * 64 + j];
    h2[idx] = __sinf(p.f_freq2[j] * s);
  }
  __syncthreads();
  for (int idx = tid; idx < 8 * 64; idx += 256) p.h2bf[(size_t)t0 * 64 + idx] = f2bf(h2[idx]);
  __syncthreads();
}

__device__ __forceinline__ void phase_prep(CP& p, char* smem) {
  const int total = 768 + 256 + 3048;
  for (int it = get_bid(); it < total; it += VGRID) {
    if (it < 768) prep_modvec(p, smem, it);
    else if (it < 1024) prep_filter(p, smem, it - 768);
    else prep_weight_tile(p, smem, it - 1024);
  }
}

__device__ __forceinline__ f32x4 ld4_bf16(const bf16_t* p) {
  const uint2 u = *(const uint2*)p;
  f32x4 r; r[0] = bf2f((bf16_t)(u.x & 0xffff)); r[1] = bf2f((bf16_t)(u.x >> 16)); r[2] = bf2f((bf16_t)(u.y & 0xffff)); r[3] = bf2f((bf16_t)(u.y >> 16));
  return r;
}
template <bool PART, bool SRC16 = false>
__device__ __forceinline__ void normmod_row2(const void* __restrict__ srcv, const float* __restrict__ g, const float* __restrict__ sh, const float* __restrict__ sc, bf16_t* __restrict__ dst, int lane, const float* __restrict__ bsh = nullptr) {
  f32x4 v[2][4]; float ss0 = 0.f, ss1 = 0.f;
#pragma unroll
  for (int i = 0; i < 4; ++i) {
    if (SRC16) { v[0][i] = ld4_bf16((const bf16_t*)srcv + lane * 4 + 256 * i); v[1][i] = ld4_bf16((const bf16_t*)srcv + 1024 + lane * 4 + 256 * i); }
    else { v[0][i] = *(const f32x4*)((const float*)srcv + lane * 4 + 256 * i); v[1][i] = *(const f32x4*)((const float*)srcv + 1024 + lane * 4 + 256 * i); }
  }
#pragma unroll
  for (int i = 0; i < 4; ++i) {
    ss0 += v[0][i][0] * v[0][i][0] + v[0][i][1] * v[0][i][1] + v[0][i][2] * v[0][i][2] + v[0][i][3] * v[0][i][3];
    ss1 += v[1][i][0] * v[1][i][0] + v[1][i][1] * v[1][i][1] + v[1][i][2] * v[1][i][2] + v[1][i][3] * v[1][i][3];
  }
  ss0 = wave_sum(ss0); ss1 = wave_sum(ss1);
  const float r0 = rsqrtf(ss0 * (1.0f / 1024.0f) + 1e-6f), r1 = rsqrtf(ss1 * (1.0f / 1024.0f) + 1e-6f);
#pragma unroll
  for (int i = 0; i < 4; ++i) {
    const int k = lane * 4 + 256 * i;
    const f32x4 g4 = *(const f32x4*)(g + k);
    f32x4 s4 = *(const f32x4*)(sh + k), c4 = *(const f32x4*)(sc + k);
    if (PART) {
#pragma unroll
      for (int q = 1; q < 4; ++q) { s4 += *(const f32x4*)(sh + (size_t)q * 110592 + k); c4 += *(const f32x4*)(sc + (size_t)q * 110592 + k); }
      s4 += *(const f32x4*)(bsh + k); c4 += *(const f32x4*)(bsh + 1024 + k);
    }
    float y[4], z[4];
#pragma unroll
    for (int j = 0; j < 4; ++j) { const float gm = g4[j] * (1.f + c4[j]); y[j] = (v[0][i][j] * r0) * gm + s4[j]; z[j] = (v[1][i][j] * r1) * gm + s4[j]; }
    uint2 u; u.x = pack2(y[0], y[1]); u.y = pack2(y[2], y[3]);
    *(uint2*)(dst + k) = u;
    u.x = pack2(z[0], z[1]); u.y = pack2(z[2], z[3]);
    *(uint2*)(dst + 1024 + k) = u;
  }
}

__device__ __forceinline__ void phase_normmod_kv(CP& p) {
  const int lane = get_tid() & 63, wv = get_tid() >> 6;
  const float* g = p.norm_mix_g;
  for (int idx = get_bid() * 256 + get_tid(); idx < 110592; idx += VGRID * 256) {
    const int lr = idx / 6144; const int n = idx - lr * 6144; const int layer = lr / 9;
    p.modv[idx] = p.modp[idx] + p.modp[110592 + idx] + p.modp[2 * 110592 + idx] + p.modp[3 * 110592 + idx] + p.mod_b[layer * 6144 + n];
  }
  for (int r = (get_bid() * 4 + wv) * 2; r < 18432; r += VGRID * 8) {
    const int b = r / 2304, pp = r - b * 2304;
    const float* src; const float* mv;
    if (pp < 256) { src = p.ctx + ((size_t)b * 256 + pp) * 1024; mv = p.modp + (size_t)8 * 6144; }
    else { src = p.x + ((size_t)b * 2048 + pp - 256) * 1024; mv = p.modp + (size_t)b * 6144; }
    normmod_row2<true>(src, g, mv, mv + 1024, p.hxc + (size_t)r * 1024, lane, p.mod_b);
  }
}
__device__ __forceinline__ void phase_normmod_x(CP& p, const float* g, int layer, int chunk) {
  const int lane = get_tid() & 63, wv = get_tid() >> 6;
  for (int r = (get_bid() * 4 + wv) * 2; r < 16384; r += VGRID * 8) {
    const int b = r >> 11;
    const float* mv = p.modv + (size_t)(layer * 9 + b) * 6144 + chunk * 1024;
    normmod_row2<false, true>(p.X16 + (size_t)r * 1024, g, mv, mv + 1024, p.hxc + (size_t)r * 1024, lane);
  }
}
__device__ __forceinline__ void phase_final_norm(CP& p) {
  const int lane = get_tid() & 63, wv = get_tid() >> 6;
  for (int r = get_bid() * 4 + wv; r < 16384; r += VGRID * 4) {
    const bf16_t* srow = p.X16 + (size_t)r * 1024;
    float* row = p.X + (size_t)r * 1024;
    f32x4 v[4]; float ss = 0.f;
#pragma unroll
    for (int i = 0; i < 4; ++i) { v[i] = ld4_bf16(srow + lane * 4 + 256 * i); ss += v[i][0] * v[i][0] + v[i][1] * v[i][1] + v[i][2] * v[i][2] + v[i][3] * v[i][3]; }
    ss = wave_sum(ss);
    const float rr = rsqrtf(ss * (1.0f / 1024.0f) + 1e-6f);
#pragma unroll
    for (int i = 0; i < 4; ++i) {
      const int k = lane * 4 + 256 * i;
      const f32x4 g4 = *(const f32x4*)(p.final_g + k);
      f32x4 o; o[0] = v[i][0] * rr * g4[0]; o[1] = v[i][1] * rr * g4[1]; o[2] = v[i][2] * rr * g4[2]; o[3] = v[i][3] * rr * g4[3];
      *(f32x4*)(row + k) = o;
    }
  }
}

__device__ __forceinline__ void phase_rowstat(CP& p) {
  const int lane = get_tid() & 63, wv = get_tid() >> 6;
  for (int r = get_bid() * 4 + wv; r < 18432; r += VGRID * 4) {
    const int b = r / 2304, pp = r - b * 2304;
    const bf16_t* kvr = p.kv + (size_t)r * 288;
    {
      const uint2 u = *(const uint2*)(kvr + lane * 4);
      const float a0 = bf2f((bf16_t)(u.x & 0xffff)), a1 = bf2f((bf16_t)(u.x >> 16)), a2 = bf2f((bf16_t)(u.y & 0xffff)), a3 = bf2f((bf16_t)(u.y >> 16));
      float ss = a0 * a0 + a1 * a1 + a2 * a2 + a3 * a3;
      ss = wave_sum(ss);
      if (lane == 0) p.rkv[r] = rsqrtf(ss * (1.0f / 256.0f) + 1e-6f);
    }
    {
      const int i = lane & 31;
      const float xv = bf2f(kvr[256 + i]);
      const float ov = __shfl_xor(xv, 8);
      float res = xv;
      if (pp >= 256) {
        const int t = pp - 256;
        const int quarter = i >> 3, idx = i & 7;
        const float pos = (quarter < 2) ? (float)(t >> 6) : (float)(t & 63);
        const float inv = exp2f(-(float)idx * (13.287712379549449f / 8.0f));
        const float ang = pos * inv;
        const float cs = __cosf(ang), sn = __sinf(ang);
        res = xv * cs + ((quarter & 1) ? ov : -ov) * sn;
      }
      if (lane < 32) p.kpe[(size_t)r * 32 + i] = f2bf(res);
    }
    if (pp >= 256) {
      const int xr = b * 2048 + pp - 256;
      const uint4 u = *(const uint4*)(p.cq + (size_t)xr * 512 + lane * 8);
      const unsigned uu[4] = {u.x, u.y, u.z, u.w};
      float ss = 0.f;
#pragma unroll
      for (int j = 0; j < 4; ++j) { const float a = bf2f((bf16_t)(uu[j] & 0xffff)), bb = bf2f((bf16_t)(uu[j] >> 16)); ss += a * a + bb * bb; }
      ss = wave_sum(ss);
      if (lane == 0) p.rq[xr] = rsqrtf(ss * (1.0f / 512.0f) + 1e-6f);
    }
  }
}

template <int NP>
struct EpiStore {
  static constexpr int KIND = 0; static constexpr bool ROWSUM = false;
  bf16_t* out; int ld; int ostride; const float* part; int pstride; float inv_n;
  __device__ __forceinline__ void c4(int g, int rig, int col, f32x4 v) const {
    const size_t row = (size_t)g * ostride + rig;
    float s = 1.f;
    if (NP > 0) {
      float t = 0.f;
#pragma unroll
      for (int q = 0; q < NP; ++q) t += part[(size_t)q * pstride + row];
      s = rsqrtf(t * inv_n + 1e-6f);
    }
    uint2 u; u.x = pack2(v[0] * s, v[1] * s); u.y = pack2(v[2] * s, v[3] * s);
    *(uint2*)(out + row * ld + col) = u;
  }
};
struct EpiDown {
  static constexpr int KIND = 0; static constexpr bool ROWSUM = true;
  bf16_t* out; int ld; int ostride; float* part; int nslots; bf16_t* kpe; int ropecol;
  __device__ __forceinline__ float c4(int g, int rig, int col, f32x4 v) const {
    const size_t row = (size_t)g * ostride + rig;
    if (kpe && col >= ropecol) {
      const int i0 = col - ropecol;
      f32x4 o = v;
      const float p0 = __shfl_xor(v[0], 32), p1 = __shfl_xor(v[1], 32), p2 = __shfl_xor(v[2], 32), p3 = __shfl_xor(v[3], 32);
      const float pv[4] = {p0, p1, p2, p3};
      if (rig >= 256) {
        const int t = rig - 256;
        const int quarter = i0 >> 3;
        const float pos = (quarter < 2) ? (float)(t >> 6) : (float)(t & 63);
#pragma unroll
        for (int j = 0; j < 4; ++j) {
          const int idx = (i0 & 7) + j;
          const float inv = exp2f(-(float)idx * (13.287712379549449f / 8.0f));
          const float ang = pos * inv;
          const float cs = __cosf(ang), sn = __sinf(ang);
          o[j] = v[j] * cs + ((quarter & 1) ? pv[j] : -pv[j]) * sn;
        }
      }
      uint2 u; u.x = pack2(o[0], o[1]); u.y = pack2(o[2], o[3]);
      *(uint2*)(kpe + row * 32 + i0) = u;
      return 0.f;
    }
    uint2 u; u.x = pack2(v[0], v[1]); u.y = pack2(v[2], v[3]);
    *(uint2*)(out + row * ld + col) = u;
    return v[0] * v[0] + v[1] * v[1] + v[2] * v[2] + v[3] * v[3];
  }
  __device__ __forceinline__ void rowsum(int g, int rig, int slot, float ss) const {
    if (slot < nslots) part[(size_t)slot * ((size_t)8 * ostride) + (size_t)g * ostride + rig] = ss;
  }
};
struct EpiVt {
  static constexpr int KIND = 1;
  bf16_t* out; const float* part;
  __device__ __forceinline__ void r4(int g, int rig, int col, f32x4 v) const {
    const size_t row = (size_t)g * 2304 + rig;
    const f32x4 t = *(const f32x4*)(part + row) + *(const f32x4*)(part + 18432 + row);
    f32x4 s;
#pragma unroll
    for (int j = 0; j < 4; ++j) s[j] = rsqrtf(t[j] * (1.0f / 256.0f) + 1e-6f);
    uint2 u; u.x = pack2(v[0] * s[0], v[1] * s[1]); u.y = pack2(v[2] * s[2], v[3] * s[3]);
    *(uint2*)(out + ((size_t)g * 1024 + col) * 2304 + rig) = u;
  }
};
struct EpiFilt {
  static constexpr int KIND = 1;
  bf16_t* Rf; const float* decay;
  __device__ __forceinline__ void r4(int g, int rig, int col, f32x4 v) const {
    const int c = col & 1023; const bool bwd = col >= 1024;
    const float dec = fabsf(decay[c]);
    bf16_t* rp = Rf + (size_t)c * 4096;
#pragma unroll
    for (int j = 0; j < 4; ++j) {
      const int t = rig + j;
      const float val = v[j] * __expf(-(float)t * (1.0f / 2047.0f) * dec);
      if (!bwd) rp[2048 - t] = f2bf(val);
      else if (t > 0) rp[2048 + t] = f2bf(val);
      else rp[0] = 0;
    }
  }
};
template <bool BASE_F32>
struct EpiResid {
  static constexpr int KIND = 0; static constexpr bool ROWSUM = false;
  bf16_t* X16; const void* base; const float* gate; const float* bias;
  __device__ __forceinline__ void c4(int g, int rig, int col, f32x4 v) const {
    const size_t o = ((size_t)g * 2048 + rig) * 1024 + col;
    f32x4 bs;
    if (BASE_F32) bs = *(const f32x4*)((const float*)base + o);
    else {
      const uint2 u = *(const uint2*)((const bf16_t*)base + o);
      bs[0] = bf2f((bf16_t)(u.x & 0xffff)); bs[1] = bf2f((bf16_t)(u.x >> 16)); bs[2] = bf2f((bf16_t)(u.y & 0xffff)); bs[3] = bf2f((bf16_t)(u.y >> 16));
    }
    const f32x4 gt = *(const f32x4*)(gate + (size_t)g * 6144 + col);
    f32x4 bi = {0.f, 0.f, 0.f, 0.f};
    if (bias) bi = *(const f32x4*)(bias + col);
    f32x4 r;
#pragma unroll
    for (int j = 0; j < 4; ++j) r[j] = bs[j] + gt[j] * (v[j] + bi[j]);
    uint2 w; w.x = pack2(r[0], r[1]); w.y = pack2(r[2], r[3]);
    *(uint2*)(X16 + o) = w;
  }
};
template <int MODE>
struct EpiConv {
  static constexpr int KIND = 2;
  const float* cw; const float* cb; int NC; const float* pre_bias;
  bf16_t* o0; bf16_t* o1;
  __device__ __forceinline__ int norig(int nt, int cl) const {
    if (MODE == 0) return (cl >> 6) * 2816 + nt * 64 + (cl & 63);
    if (nt < 8) return nt * 128 + cl;
    return 1024 + (cl >> 6) * 1024 + (nt - 8) * 64 + (cl & 63);
  }
  typedef float f32x2_t __attribute__((ext_vector_type(2)));
  static __device__ __forceinline__ f32x2_t ldz(const bf16_t* Z, int row, int col) {
    const unsigned u = *(const unsigned*)(Z + row * 132 + col);
    f32x2_t r; r[0] = __uint_as_float(u << 16); r[1] = __uint_as_float(u & 0xffff0000u); return r;
  }
  template <class F>
  __device__ __forceinline__ void finish(const bf16_t* Z, int g, int rig0, int nt, F&& pre) const {
    typedef f32x2_t f32x2;
    const int tid = get_tid();
    if (MODE == 0 || nt < 8) {
      if (MODE == 0) {
        const int f2 = (tid & 31) * 2, q8 = tid >> 5;
        const int q0 = 1 + 16 * q8, q1 = (q0 + 16 < 127) ? q0 + 16 : 127;
        const int na = norig(nt, f2), ng = norig(nt, 64 + f2);
        const f32x2 a0 = *(const f32x2*)(cw + na), a1 = *(const f32x2*)(cw + NC + na), a2 = *(const f32x2*)(cw + 2 * NC + na), ab = *(const f32x2*)(cb + na);
        const f32x2 g0 = *(const f32x2*)(cw + ng), g1 = *(const f32x2*)(cw + NC + ng), g2 = *(const f32x2*)(cw + 2 * NC + ng), gb = *(const f32x2*)(cb + ng);
        pre();
        f32x2 am = ldz(Z, q0 - 1, f2), ac = ldz(Z, q0, f2);
        f32x2 gm = ldz(Z, q0 - 1, 64 + f2), gc = ldz(Z, q0, 64 + f2);
#pragma unroll 2
        for (int pl = q0; pl < q1; ++pl) {
          const f32x2 an = ldz(Z, pl + 1, f2), gn = ldz(Z, pl + 1, 64 + f2);
          const int pos = rig0 + pl;
          if (pos < 2048) {
            const f32x2 av = a0 * am + a1 * ac + a2 * an + ab;
            const f32x2 gv = g0 * gm + g1 * gc + g2 * gn + gb;
            const float s0 = av[0] * gv[0] * __builtin_amdgcn_rcpf(1.f + __expf(-gv[0]));
            const float s1 = av[1] * gv[1] * __builtin_amdgcn_rcpf(1.f + __expf(-gv[1]));
            *(unsigned*)(o0 + ((size_t)g * 2048 + pos) * 2816 + nt * 64 + f2) = pack2(s0, s1);
          }
          am = ac; ac = an; gm = gc; gc = gn;
        }
      } else {
        const int cl = (tid & 63) * 2, q = tid >> 6;
        const int p0 = 1 + 32 * q, p1 = (p0 + 32 < 127) ? p0 + 32 : 127;
        const int na = norig(nt, cl);
        const f32x2 a0 = *(const f32x2*)(cw + na), a1 = *(const f32x2*)(cw + NC + na), a2 = *(const f32x2*)(cw + 2 * NC + na), ab = *(const f32x2*)(cb + na);
        pre();
        f32x2 am = ldz(Z, p0 - 1, cl), ac = ldz(Z, p0, cl);
#pragma unroll 2
        for (int pl = p0; pl < p1; ++pl) {
          const f32x2 an = ldz(Z, pl + 1, cl);
          const int pos = rig0 + pl;
          if (pos < 2048) {
            const f32x2 av = a0 * am + a1 * ac + a2 * an + ab;
            *(unsigned*)(o0 + ((size_t)g * 2048 + pos) * 1024 + nt * 128 + cl) = pack2(av[0], av[1]);
          }
          am = ac; ac = an;
        }
      }
    } else {
      pre();
      const int pl = tid & 127, fh = tid >> 7;
      const int pos = rig0 + pl;
      if (pl >= 1 && pl <= 126 && pos < 2048) {
        const int fb = nt - 8;
#pragma unroll 2
        for (int f = fh * 32; f < fh * 32 + 32; f += 2) {
          const int na = norig(nt, f), nb = norig(nt, 64 + f);
          const f32x2 va = *(const f32x2*)(cw + na) * ldz(Z, pl - 1, f) + *(const f32x2*)(cw + NC + na) * ldz(Z, pl, f)
                         + *(const f32x2*)(cw + 2 * NC + na) * ldz(Z, pl + 1, f) + *(const f32x2*)(cb + na);
          const f32x2 vb = *(const f32x2*)(cw + nb) * ldz(Z, pl - 1, 64 + f) + *(const f32x2*)(cw + NC + nb) * ldz(Z, pl, 64 + f)
                         + *(const f32x2*)(cw + 2 * NC + nb) * ldz(Z, pl + 1, 64 + f) + *(const f32x2*)(cb + nb);
          bf16_t* op = o1 + (size_t)(fb * 64 + f) * 16384 + g * 2048 + pos;
          op[0] = f2bf(va[0] * vb[0]);
          op[16384] = f2bf(va[1] * vb[1]);
        }
      }
    }
  }
};

#define GLDS16(gp, lp) __builtin_amdgcn_global_load_lds((const unsigned*)(gp), (__attribute__((address_space(3))) unsigned*)(lp), 16, 0, 0)

template <bool SWAP, class Epi>
__device__ __forceinline__ void gemm_job(char* smem, const bf16_t* __restrict__ A, int lda, const bf16_t* __restrict__ Bt, int K, int N,
                                         int tpg, int a_gstride, int a_goff, int step, int halo, int grows, int MTS, int voff, int vid0, int grid, const Epi& epi) {
  const int tid = get_tid512(), lane = tid & 63, wid = tid >> 6, wr = wid >> 1, wc = wid & 1, fr = lane & 15, fq = lane >> 4;
  const int NT = (N + 255) >> 8, MT = MTS >> 1, ntiles = MT * NT, ns = K >> 6;
  const int full = MT >> 3;
  int v = vid0;
  if (v < voff) v += ((voff - v + grid - 1) / grid) * grid;
  const int swz = (fr >> 1) & 7;
  bool pre_issued = false;
  for (; v < voff + ntiles; v += grid) {
    const int w = v - voff;
    int mt, nt;
    if (w < full * 8 * NT) { const int sr = w / (8 * NT), rem = w - sr * 8 * NT; nt = rem >> 3; mt = sr * 8 + (rem & 7); }
    else { const int w2 = w - full * 8 * NT, rl = MT - full * 8; nt = w2 / rl; mt = full * 8 + (w2 - nt * rl); }
    unsigned ap[4], bp[4];
#pragma unroll
    for (int i = 0; i < 4; ++i) {
      const int r = (tid >> 3) + 64 * i;
      const int cs = tid & 7;
      const int c = ((cs ^ ((r >> 1) & 7)) << 3);
      const int sub = 2 * mt + (r >> 7);
      const int g = sub / tpg, ti = sub - g * tpg;
      int rig = ti * step - halo + (r & 127); rig = rig < 0 ? 0 : (rig > grows - 1 ? grows - 1 : rig);
      ap[i] = (unsigned)((g * a_gstride + a_goff + rig) * lda + c);
      int br = nt * 256 + r; br = br > N - 1 ? N - 1 : br;
      bp[i] = (unsigned)(br * K + c);
    }
    const bool have_next = false;
    f32x4 acc[4][8];
#pragma unroll
    for (int m = 0; m < 4; ++m)
#pragma unroll
      for (int n = 0; n < 8; ++n) acc[m][n] = (f32x4){0.f, 0.f, 0.f, 0.f};
    if (!pre_issued) {
#pragma unroll
      for (int i = 0; i < 4; ++i) { GLDS16(A + (size_t)ap[i], smem + tid * 16 + i * 8192); GLDS16(Bt + (size_t)bp[i], smem + 32768 + tid * 16 + i * 8192); }
    }
    pre_issued = have_next;
    for (int st = 0; st < ns; ++st) {
      asm volatile("s_waitcnt vmcnt(0)" ::: "memory");
      __builtin_amdgcn_s_barrier();
      asm volatile("" ::: "memory");
      if (st + 1 < ns) {
        char* nb = smem + ((st + 1) & 1) * 65536;
        const int ko = (st + 1) * 64;
#pragma unroll
        for (int i = 0; i < 4; ++i) { GLDS16(A + (size_t)(ap[i] + ko), nb + tid * 16 + i * 8192); GLDS16(Bt + (size_t)(bp[i] + ko), nb + 32768 + tid * 16 + i * 8192); }
      }
      const char* sa = smem + (st & 1) * 65536 + (wr * 64 + fr) * 128;
      const char* sb = smem + (st & 1) * 65536 + 32768 + (wc * 128 + fr) * 128;
      bf16x8 afA[4], afB[4], bfb[2][2];
#pragma unroll
      for (int m = 0; m < 4; ++m) afA[m] = *(const bf16x8*)(sa + m * 2048 + ((fq ^ swz) << 4));
#pragma unroll
      for (int n = 0; n < 2; ++n) bfb[0][n] = *(const bf16x8*)(sb + n * 2048 + ((fq ^ swz) << 4));
#pragma unroll
      for (int gq = 0; gq < 8; ++gq) {
        const int ks = gq >> 2, nh = gq & 3;
        if (gq < 7) {
          const int ks2 = (gq + 1) >> 2, nh2 = (gq + 1) & 3;
#pragma unroll
          for (int n = 0; n < 2; ++n) bfb[(gq + 1) & 1][n] = *(const bf16x8*)(sb + (nh2 * 2 + n) * 2048 + (((ks2 * 4 + fq) ^ swz) << 4));
        }
        if (gq == 3) {
#pragma unroll
          for (int m = 0; m < 4; ++m) afB[m] = *(const bf16x8*)(sa + m * 2048 + (((4 + fq) ^ swz) << 4));
        }
        __builtin_amdgcn_sched_barrier(0);
#pragma unroll
        for (int m = 0; m < 4; ++m)
#pragma unroll
          for (int n = 0; n < 2; ++n) {
            const bf16x8 av = ks ? afB[m] : afA[m];
            acc[m][nh * 2 + n] = SWAP ? __builtin_amdgcn_mfma_f32_16x16x32_bf16(bfb[gq & 1][n], av, acc[m][nh * 2 + n], 0, 0, 0)
                                      : __builtin_amdgcn_mfma_f32_16x16x32_bf16(av, bfb[gq & 1][n], acc[m][nh * 2 + n], 0, 0, 0);
          }
      }
    }
    __syncthreads();
    const int te = get_tid512();
    const int fr_e = te & 15, fq_e = (te & 63) >> 4, wr_e = te >> 7, wc_e = (te >> 6) & 1;
    const int sub = 2 * mt + (wr_e >> 1);
    const int g = sub / tpg, ti = sub - g * tpg;
    const int rig0 = ti * step - halo;
    const int rw = (wr_e & 1) * 64;
    if constexpr (Epi::KIND == 0) {
#pragma unroll
      for (int m = 0; m < 4; ++m) {
        const int rig = rig0 + rw + m * 16 + fr_e;
        if constexpr (Epi::ROWSUM) {
          float ss = 0.f;
#pragma unroll
          for (int n = 0; n < 8; ++n) {
            const int col = nt * 256 + wc_e * 128 + n * 16 + fq_e * 4;
            if (col < N) ss += epi.c4(g, rig, col, acc[m][n]);
          }
          ss += __shfl_xor(ss, 16); ss += __shfl_xor(ss, 32);
          if (fq_e == 0) epi.rowsum(g, rig, nt * 2 + wc_e, ss);
        } else {
#pragma unroll
          for (int n = 0; n < 8; ++n) {
            const int col = nt * 256 + wc_e * 128 + n * 16 + fq_e * 4;
            if (col < N) epi.c4(g, rig, col, acc[m][n]);
          }
        }
      }
    } else if constexpr (Epi::KIND == 1) {
#pragma unroll
      for (int m = 0; m < 4; ++m) {
        const int rig = rig0 + rw + m * 16 + fq_e * 4;
#pragma unroll
        for (int n = 0; n < 8; ++n) {
          const int col = nt * 256 + wc_e * 128 + n * 16 + fr_e;
          if (col < N) epi.r4(g, rig, col, acc[m][n]);
        }
      }
    } else {
      bf16_t* Zw = (bf16_t*)smem + ((wr_e >> 1) * 2 + wc_e) * (128 * 132);
      const int nt2w = nt * 2 + wc_e;
#pragma unroll
      for (int n = 0; n < 8; ++n) {
        const int cl = n * 16 + fq_e * 4;
        f32x4 b4 = {0.f, 0.f, 0.f, 0.f};
        if (epi.pre_bias) b4 = *(const f32x4*)(epi.pre_bias + epi.norig(nt2w, cl));
#pragma unroll
        for (int m = 0; m < 4; ++m) {
          const int rl = rw + m * 16 + fr_e;
          const int pos = rig0 + rl;
          const bool ok = pos >= 0 && pos < grows;
          f32x4 vv = acc[m][n] + b4;
          if (!ok) vv = (f32x4){0.f, 0.f, 0.f, 0.f};
          uint2 u; u.x = pack2(vv[0], vv[1]); u.y = pack2(vv[2], vv[3]);
          *(uint2*)(Zw + rl * 132 + cl) = u;
        }
      }
      __syncthreads();
      {
        auto no_pre = []() {};
        const bf16_t* Zr = (const bf16_t*)smem + ((wr_e >> 1) * 2) * (128 * 132);
        epi.finish(Zr, g, rig0, nt * 2, no_pre);
        epi.finish(Zr + 128 * 132, g, rig0, nt * 2 + 1, no_pre);
      }
      __syncthreads();
    }
    asm volatile("s_waitcnt vmcnt(0)" ::: "memory");
    __syncthreads();
  }
}

__device__ __forceinline__ void phase_attn(CP& p, char* smem, int vid0, int grid) {
  bf16_t* Ks = (bf16_t*)smem;
  bf16_t* Vs = (bf16_t*)(smem + 64 * 104 * 2);
  const int tid = get_tid(), lane = tid & 63, w = tid >> 6, r = lane & 31, hh = lane >> 5;
  const float cs = 1.4426950408889634f * 0.10206207261596577f;
  for (int it = vid0; it < 2048; it += grid) {
    const int qt = it & 15, h = (it >> 4) & 15, b = it >> 8;
    const int t = qt * 128 + w * 32 + r;
    const size_t xrow = (size_t)b * 2048 + t;
    const bf16_t* qp = p.Q + xrow * 1536 + h * 96;
    bf16x8 qf[6];
#pragma unroll
    for (int kk = 0; kk < 4; ++kk) qf[kk] = *(const bf16x8*)(qp + 16 * kk + 8 * hh);
#pragma unroll
    for (int part = 0; part < 2; ++part) {
      const bf16_t* pp = qp + 64 + 16 * part;
      const bf16x8 mine = *(const bf16x8*)(pp + 8 * hh), oth = *(const bf16x8*)(pp + 8 * (1 - hh));
      const float posf = part == 0 ? (float)(t >> 6) : (float)(t & 63);
      union { unsigned u[4]; bf16x8 v; } o;
      float res[8];
#pragma unroll
      for (int j = 0; j < 8; ++j) {
        const float inv = exp2f(-(float)j * (13.287712379549449f / 8.0f));
        const float ang = posf * inv;
        const float c = __cosf(ang), s = __sinf(ang);
        const float m = bf2f((bf16_t)mine[j]), ov = bf2f((bf16_t)oth[j]);
        res[j] = m * c + (hh ? ov : -ov) * s;
      }
#pragma unroll
      for (int j = 0; j < 4; ++j) o.u[j] = pack2(res[2 * j], res[2 * j + 1]);
      qf[4 + part] = o.v;
    }
    f32x16 oacc[2];
#pragma unroll
    for (int i = 0; i < 16; ++i) { oacc[0][i] = 0.f; oacc[1][i] = 0.f; }
    float mrun = -INFINITY, lrun = 0.f;
    const size_t kvrow0 = (size_t)b * 2304;
    const bf16_t* kn_base = p.Kn + kvrow0 * 1024 + h * 64;
    const bf16_t* kpe_base = p.kpe + kvrow0 * 32;
    const bf16_t* vt_base = p.Vt + ((size_t)(b * 16 + h) * 64) * 2304;
    uint4 rk0, rk1, rp, rv0, rv1;
    const int srow = tid >> 3, sch = tid & 7;
#define ATT_GLOAD(kt) do { \
      rk0 = *(const uint4*)(kn_base + (size_t)((kt) * 64 + srow) * 1024 + sch * 8); \
      rk1 = *(const uint4*)(kn_base + (size_t)((kt) * 64 + srow + 32) * 1024 + sch * 8); \
      rv0 = *(const uint4*)(vt_base + (size_t)srow * 2304 + (kt) * 64 + sch * 8); \
      rv1 = *(const uint4*)(vt_base + (size_t)(srow + 32) * 2304 + (kt) * 64 + sch * 8); \
      rp = *(const uint4*)(kpe_base + (size_t)((kt) * 64 + (tid >> 2)) * 32 + (tid & 3) * 8); } while (0)
    ATT_GLOAD(0);
    for (int kt = 0; kt < 36; ++kt) {
      __syncthreads();
      {
        *(uint4*)(Ks + srow * 104 + sch * 8) = rk0;
        *(uint4*)(Ks + (srow + 32) * 104 + sch * 8) = rk1;
        uint2 lo, hi;
        lo.x = rv0.x; lo.y = rv0.y; hi.x = rv0.z; hi.y = rv0.w;
        *(uint2*)(Vs + srow * 68 + sch * 8) = lo; *(uint2*)(Vs + srow * 68 + sch * 8 + 4) = hi;
        lo.x = rv1.x; lo.y = rv1.y; hi.x = rv1.z; hi.y = rv1.w;
        *(uint2*)(Vs + (srow + 32) * 68 + sch * 8) = lo; *(uint2*)(Vs + (srow + 32) * 68 + sch * 8 + 4) = hi;
      }
      *(uint4*)(Ks + (tid >> 2) * 104 + 64 + (tid & 3) * 8) = rp;
      __syncthreads();
      if (kt + 1 < 36) ATT_GLOAD(kt + 1);
      f32x16 s[2];
#pragma unroll
      for (int t2 = 0; t2 < 2; ++t2) {
#pragma unroll
        for (int i = 0; i < 16; ++i) s[t2][i] = 0.f;
#pragma unroll
        for (int kk = 0; kk < 6; ++kk) {
          const bf16x8 a = *(const bf16x8*)(Ks + (32 * t2 + r) * 104 + 16 * kk + 8 * hh);
          s[t2] = __builtin_amdgcn_mfma_f32_32x32x16_bf16(a, qf[kk], s[t2], 0, 0, 0);
        }
      }
      float mx = s[0][0];
#pragma unroll
      for (int i = 1; i < 16; ++i) mx = fmaxf(mx, s[0][i]);
#pragma unroll
      for (int i = 0; i < 16; ++i) mx = fmaxf(mx, s[1][i]);
      mx = fmaxf(mx, __shfl_xor(mx, 32));
      const float mnew = fmaxf(mrun, mx * cs);
      const float alpha = __builtin_amdgcn_exp2f(mrun - mnew);
      mrun = mnew;
      float psum = 0.f;
      bf16x8 pf[4];
#pragma unroll
      for (int t2 = 0; t2 < 2; ++t2)
#pragma unroll
        for (int hf = 0; hf < 2; ++hf) {
          union { unsigned u[4]; bf16x8 v; } cvp;
#pragma unroll
          for (int i = 0; i < 4; ++i) {
            const float p0 = __builtin_amdgcn_exp2f(s[t2][hf * 8 + 2 * i] * cs - mnew);
            const float p1 = __builtin_amdgcn_exp2f(s[t2][hf * 8 + 2 * i + 1] * cs - mnew);
            psum += p0 + p1;
            cvp.u[i] = pack2(p0, p1);
          }
          pf[t2 * 2 + hf] = cvp.v;
        }
      lrun = lrun * alpha + psum;
#pragma unroll
      for (int i = 0; i < 16; ++i) { oacc[0][i] *= alpha; oacc[1][i] *= alpha; }
#pragma unroll
      for (int dt = 0; dt < 2; ++dt)
#pragma unroll
        for (int s4 = 0; s4 < 4; ++s4) {
          const bf16_t* vp = Vs + (32 * dt + r) * 68 + 16 * s4 + 4 * hh;
          const uint2 lo = *(const uint2*)vp, hi = *(const uint2*)(vp + 8);
          union { uint4 u; bf16x8 v; } cv; cv.u.x = lo.x; cv.u.y = lo.y; cv.u.z = hi.x; cv.u.w = hi.y;
          oacc[dt] = __builtin_amdgcn_mfma_f32_32x32x16_bf16(cv.v, pf[s4], oacc[dt], 0, 0, 0);
        }
    }
    const float ltot = lrun + __shfl_xor(lrun, 32);
    const float inv = 1.f / ltot;
    bf16_t* op = p.hxc + xrow * 1024 + h * 64;
#pragma unroll
    for (int dt = 0; dt < 2; ++dt)
#pragma unroll
      for (int i4 = 0; i4 < 4; ++i4) {
        const int d = 32 * dt + 8 * i4 + 4 * hh;
        uint2 u; u.x = pack2(oacc[dt][4 * i4] * inv, oacc[dt][4 * i4 + 1] * inv); u.y = pack2(oacc[dt][4 * i4 + 2] * inv, oacc[dt][4 * i4 + 3] * inv);
        *(uint2*)(op + d) = u;
      }
  }
}

__device__ __forceinline__ void phase_hyconv(CP& p, char* smem) {
  bf16_t* cp = (bf16_t*)smem;
  bf16_t* Vl = (bf16_t*)(smem + 4 * 8256);
  const int tid = get_tid(), lane = tid & 63, w = tid >> 6, i16 = lane & 15, g4 = lane >> 4;
  const int si = (-i16) & 3;
  const int ocb = 64 * w;
  for (int c = get_bid(); c < 1024; c += VGRID) {
    __syncthreads();
#pragma unroll
    for (int i = 0; i < 2; ++i) { const int ch = tid + 256 * i; *(uint4*)(cp + ch * 8) = *(const uint4*)(p.Rf + (size_t)c * 4096 + ch * 8); }
#pragma unroll
    for (int i = 0; i < 8; ++i) {
      const int q = tid + 256 * i; const int b = q >> 8, l8 = q & 255; const int m1 = l8 >> 3, m2 = (l8 & 7) * 8;
      *(uint4*)(Vl + (8 + m1 * 8 + b) * 80 + m2) = *(const uint4*)(p.vvT + (size_t)c * 16384 + b * 2048 + l8 * 8);
    }
    if (tid < 144) {
      const int colp = tid / 9, part = tid - colp * 9;
      const int col = colp < 8 ? colp : 256 + colp;
      uint4 zz; zz.x = 0; zz.y = 0; zz.z = 0; zz.w = 0;
      *(uint4*)(Vl + col * 80 + part * 8) = zz;
    }
    __syncthreads();
#pragma unroll
    for (int s = 1; s < 4; ++s)
#pragma unroll
      for (int i = 0; i < 2; ++i) {
        const int ch = tid + 256 * i;
        unsigned e[8];
#pragma unroll
        for (int j = 0; j < 8; ++j) { const int idx = 8 * ch + s + j; e[j] = idx < 4096 ? (unsigned)cp[idx] : 0u; }
        uint4 u; u.x = e[0] | (e[1] << 16); u.y = e[2] | (e[3] << 16); u.z = e[4] | (e[5] << 16); u.w = e[6] | (e[7] << 16);
        *(uint4*)(cp + s * 4128 + 8 * ch) = u;
      }
    __syncthreads();
    const bf16_t* abase = cp + si * 4128 + (2048 - i16 - si + 8 * g4);
    f32x4 acc[4][4];
#pragma unroll
    for (int m = 0; m < 4; ++m)
#pragma unroll
      for (int n = 0; n < 4; ++n) acc[m][n] = (f32x4){0.f, 0.f, 0.f, 0.f};
    for (int dl = -31; dl <= 31; ++dl) {
      bf16x8 af[4][2];
#pragma unroll
      for (int mt = 0; mt < 4; ++mt)
#pragma unroll
        for (int kk = 0; kk < 2; ++kk) {
          const bf16_t* ap = abase - 64 * dl - 16 * mt + 32 * kk;
          const uint2 lo = *(const uint2*)ap, hi = *(const uint2*)(ap + 4);
          union { uint4 u; bf16x8 v; } cv; cv.u.x = lo.x; cv.u.y = lo.y; cv.u.z = hi.x; cv.u.w = hi.y;
          af[mt][kk] = cv.v;
        }
#pragma unroll
      for (int jt = 0; jt < 4; ++jt) {
        const int in0 = ocb + 16 * jt - 8 * dl;
        if (in0 >= -8 && in0 <= 248) {
          const bf16_t* bp = Vl + (in0 + 8 + i16) * 80 + 8 * g4;
          const bf16x8 b0 = *(const bf16x8*)bp, b1 = *(const bf16x8*)(bp + 32);
#pragma unroll
          for (int mt = 0; mt < 4; ++mt) {
            acc[mt][jt] = __builtin_amdgcn_mfma_f32_16x16x32_bf16(af[mt][0], b0, acc[mt][jt], 0, 0, 0);
            acc[mt][jt] = __builtin_amdgcn_mfma_f32_16x16x32_bf16(af[mt][1], b1, acc[mt][jt], 0, 0, 0);
          }
        }
      }
    }
    const float db = p.hy_d_bias[c];
#pragma unroll
    for (int mt = 0; mt < 4; ++mt)
#pragma unroll
      for (int jt = 0; jt < 4; ++jt) {
        const int col = ocb + 16 * jt + i16;
        const int n1 = col >> 3, b = col & 7;
        const int n2 = 16 * mt + 4 * g4;
        const uint2 vv = *(const uint2*)(Vl + (col + 8) * 80 + n2);
        const float y0 = acc[mt][jt][0] + bf2f((bf16_t)(vv.x & 0xffff)) * db;
        const float y1 = acc[mt][jt][1] + bf2f((bf16_t)(vv.x >> 16)) * db;
        const float y2 = acc[mt][jt][2] + bf2f((bf16_t)(vv.y & 0xffff)) * db;
        const float y3 = acc[mt][jt][3] + bf2f((bf16_t)(vv.y >> 16)) * db;
        uint2 u; u.x = pack2(y0, y1); u.y = pack2(y2, y3);
        *(uint2*)(p.Yp + (size_t)c * 16384 + b * 2048 + n1 * 64 + n2) = u;
      }
  }
}

__device__ __forceinline__ void phase_transmul(CP& p, char* smem) {
  bf16_t* tl = (bf16_t*)smem;
  const int tid = get_tid();
  for (int it = get_bid(); it < 4096; it += VGRID) {
    const int ct = it & 15, rt = it >> 4;
    const int c0 = ct * 64, r0 = rt * 64;
    __syncthreads();
#pragma unroll
    for (int i = 0; i < 2; ++i) {
      const int ci = tid + 256 * i; const int cc = ci >> 3, ch = ci & 7;
      const uint4 u = *(const uint4*)(p.Yp + (size_t)(c0 + cc) * 16384 + r0 + ch * 8);
      unsigned* d = (unsigned*)(tl + cc * 66 + ch * 8);
      d[0] = u.x; d[1] = u.y; d[2] = u.z; d[3] = u.w;
    }
    __syncthreads();
    const int row = tid >> 2, cq = tid & 3;
    const bf16_t* xp = p.x1h + (size_t)(r0 + row) * 1024 + c0 + cq * 16;
    const uint4 xa = *(const uint4*)xp, xb = *(const uint4*)(xp + 8);
    const unsigned xs[8] = {xa.x, xa.y, xa.z, xa.w, xb.x, xb.y, xb.z, xb.w};
    unsigned o[8];
#pragma unroll
    for (int j = 0; j < 8; ++j) {
      const float y0 = bf2f(tl[(cq * 16 + 2 * j) * 66 + row]) * bf2f((bf16_t)(xs[j] & 0xffff));
      const float y1 = bf2f(tl[(cq * 16 + 2 * j + 1) * 66 + row]) * bf2f((bf16_t)(xs[j] >> 16));
      o[j] = pack2(y0, y1);
    }
    bf16_t* op = p.hxc + (size_t)(r0 + row) * 1024 + c0 + cq * 16;
    uint4 oa; oa.x = o[0]; oa.y = o[1]; oa.z = o[2]; oa.w = o[3];
    uint4 ob; ob.x = o[4]; ob.y = o[5]; ob.z = o[6]; ob.w = o[7];
    *(uint4*)op = oa; *(uint4*)(op + 8) = ob;
  }
}

__global__ void __launch_bounds__(512, 2) mega(P p_arg) {
  __shared__ __attribute__((aligned(16))) char smem[LDS_BYTES];
  cg::grid_group grid = cg::this_grid();
  const int G = gridDim.x;
  CP* pp = (CP*)__builtin_amdgcn_kernarg_segment_ptr();
  const int ph0 = pp->ph0, ph1 = pp->ph1;
  volatile LAS unsigned* xst = (volatile LAS unsigned*)(smem + LDS_BYTES - 16);
  if (threadIdx.x == 0) { xst[0] = 0u; xst[1] = 0u; }
  __syncthreads();
  const XcdBarrier xb = xcd_barrier_post(pp->bar, xst);
  if (ph0 <= 0 && 0 < ph1) {
    asm volatile("" : "+s"(pp));
    CP& p = *pp;
    const int bid = get_rbid();
    const int vid0 = (G & 7) ? bid : ((bid & 7) * (G >> 3) + (bid >> 3));
    const int hb = get_hb();
    char* smem_h = smem + hb * HALF_LDS; (void)smem_h;
    const float* mv0 = p.modv; const float* mv1 = p.modv + (size_t)9 * 6144;
    (void)mv0; (void)mv1; (void)vid0;
    phase_prep(p, smem_h);
    if (0 + 1 < ph1) { if (ph1 > 1000) grid.sync(); else xcd_barrier(xb); }
  }
  if (ph0 <= 1 && 1 < ph1) {
    asm volatile("" : "+s"(pp));
    CP& p = *pp;
    const int bid = get_rbid();
    const int vid0 = (G & 7) ? bid : ((bid & 7) * (G >> 3) + (bid >> 3));
    const int hb = get_hb();
    char* smem_h = smem + hb * HALF_LDS; (void)smem_h;
    const float* mv0 = p.modv; const float* mv1 = p.modv + (size_t)9 * 6144;
    (void)mv0; (void)mv1; (void)vid0;
    phase_normmod_kv(p);
    if (1 + 1 < ph1) { if (ph1 > 1000) grid.sync(); else xcd_barrier(xb); }
  }
  if (ph0 <= 2 && 2 < ph1) {
    asm volatile("" : "+s"(pp));
    CP& p = *pp;
    const int bid = get_rbid();
    const int vid0 = (G & 7) ? bid : ((bid & 7) * (G >> 3) + (bid >> 3));
    const int hb = get_hb();
    char* smem_h = smem + hb * HALF_LDS; (void)smem_h;
    const float* mv0 = p.modv; const float* mv1 = p.modv + (size_t)9 * 6144;
    (void)mv0; (void)mv1; (void)vid0;
    {
        EpiDown e1{p.cq, 512, 2048, p.rq, 4, nullptr, 1 << 30};
        gemm_job<true>(smem, p.hxc, 1024, p.wt_dq, 1024, 512, 16, 2304, 256, 128, 0, 2048, 128, 0, vid0, G, e1);
        EpiDown e2{p.kv, 288, 2304, p.rkv, 2, p.kpe, 256};
        gemm_job<true>(smem, p.hxc, 1024, p.wt_dkv, 1024, 288, 18, 2304, 0, 128, 0, 2304, 144, 64 * 2, vid0, G, e2);
        EpiFilt e3{p.Rf, p.hy_decay};
        gemm_job<false>(smem, p.h2bf, 64, p.wt_f3, 64, 2048, 16, 0, 0, 128, 0, 2048, 16, 64 * 2 + 72 * 2, vid0, G, e3);
      }
    if (2 + 1 < ph1) { if (ph1 > 1000) grid.sync(); else xcd_barrier(xb); }
  }
  if (ph0 <= 4 && 4 < ph1) {
    asm volatile("" : "+s"(pp));
    CP& p = *pp;
    const int bid = get_rbid();
    const int vid0 = (G & 7) ? bid : ((bid & 7) * (G >> 3) + (bid >> 3));
    const int hb = get_hb();
    char* smem_h = smem + hb * HALF_LDS; (void)smem_h;
    const float* mv0 = p.modv; const float* mv1 = p.modv + (size_t)9 * 6144;
    (void)mv0; (void)mv1; (void)vid0;
    {
        EpiStore<4> e1{p.Q, 1536, 2048, p.rq, 16384, 1.0f / 512.0f};
        gemm_job<true>(smem, p.cq, 512, p.wt_uq, 512, 1536, 16, 2048, 0, 128, 0, 2048, 128, 0, vid0, G, e1);
        EpiStore<2> e2{p.Kn, 1024, 2304, p.rkv, 18432, 1.0f / 256.0f};
        gemm_job<true>(smem, p.kv, 288, p.wt_uk, 256, 1024, 18, 2304, 0, 128, 0, 2304, 144, 64 * 6, vid0, G, e2);
        EpiVt e3{p.Vt, p.rkv};
        gemm_job<false>(smem, p.kv, 288, p.wt_uv, 256, 1024, 18, 2304, 0, 128, 0, 2304, 144, 64 * 6 + 72 * 4, vid0, G, e3);
      }
    if (4 + 1 < ph1) { if (ph1 > 1000) grid.sync(); else xcd_barrier(xb); }
  }
  if (ph0 <= 5 && 5 < ph1) {
    asm volatile("" : "+s"(pp));
    CP& p = *pp;
    const int bid = get_rbid();
    const int vid0 = (G & 7) ? bid : ((bid & 7) * (G >> 3) + (bid >> 3));
    const int hb = get_hb();
    char* smem_h = smem + hb * HALF_LDS; (void)smem_h;
    const float* mv0 = p.modv; const float* mv1 = p.modv + (size_t)9 * 6144;
    (void)mv0; (void)mv1; (void)vid0;
    phase_attn(p, smem_h, 2 * vid0 + hb, 2 * G);
    if (5 + 1 < ph1) { if (ph1 > 1000) grid.sync(); else xcd_barrier(xb); }
  }
  if (ph0 <= 6 && 6 < ph1) {
    asm volatile("" : "+s"(pp));
    CP& p = *pp;
    const int bid = get_rbid();
    const int vid0 = (G & 7) ? bid : ((bid & 7) * (G >> 3) + (bid >> 3));
    const int hb = get_hb();
    char* smem_h = smem + hb * HALF_LDS; (void)smem_h;
    const float* mv0 = p.modv; const float* mv1 = p.modv + (size_t)9 * 6144;
    (void)mv0; (void)mv1; (void)vid0;
    {
        EpiResid<true> e{p.X16, p.x, mv0 + 2 * 1024, nullptr};
        gemm_job<true>(smem, p.hxc, 1024, p.wt_o, 1024, 1024, 16, 2048, 0, 128, 0, 2048, 128, 0, vid0, G, e);
      }
    if (6 + 1 < ph1) { if (ph1 > 1000) grid.sync(); else xcd_barrier(xb); }
  }
  if (ph0 <= 7 && 7 < ph1) {
    asm volatile("" : "+s"(pp));
    CP& p = *pp;
    const int bid = get_rbid();
    const int vid0 = (G & 7) ? bid : ((bid & 7) * (G >> 3) + (bid >> 3));
    const int hb = get_hb();
    char* smem_h = smem + hb * HALF_LDS; (void)smem_h;
    const float* mv0 = p.modv; const float* mv1 = p.modv + (size_t)9 * 6144;
    (void)mv0; (void)mv1; (void)vid0;
    phase_normmod_x(p, p.norm_ffn_g, 0, 3);
    if (7 + 1 < ph1) { if (ph1 > 1000) grid.sync(); else xcd_barrier(xb); }
  }
  if (ph0 <= 8 && 8 < ph1) {
    asm volatile("" : "+s"(pp));
    CP& p = *pp;
    const int bid = get_rbid();
    const int vid0 = (G & 7) ? bid : ((bid & 7) * (G >> 3) + (bid >> 3));
    const int hb = get_hb();
    char* smem_h = smem + hb * HALF_LDS; (void)smem_h;
    const float* mv0 = p.modv; const float* mv1 = p.modv + (size_t)9 * 6144;
    (void)mv0; (void)mv1; (void)vid0;
    {
        EpiConv<0> e{p.ffn_conv_w, p.ffn_conv_b, 5632, nullptr, p.act, nullptr};
        gemm_job<true>(smem, p.hxc, 1024, p.wt_up0, 1024, 5632, 17, 2048, 0, 126, 1, 2048, 136, 0, vid0, G, e);
      }
    if (8 + 1 < ph1) { if (ph1 > 1000) grid.sync(); else xcd_barrier(xb); }
  }
  if (ph0 <= 9 && 9 < ph1) {
    asm volatile("" : "+s"(pp));
    CP& p = *pp;
    const int bid = get_rbid();
    const int vid0 = (G & 7) ? bid : ((bid & 7) * (G >> 3) + (bid >> 3));
    const int hb = get_hb();
    char* smem_h = smem + hb * HALF_LDS; (void)smem_h;
    const float* mv0 = p.modv; const float* mv1 = p.modv + (size_t)9 * 6144;
    (void)mv0; (void)mv1; (void)vid0;
    {
        EpiResid<false> e{p.X16, p.X16, mv0 + 5 * 1024, nullptr};
        gemm_job<true>(smem, p.act, 2816, p.wt_dn0, 2816, 1024, 16, 2048, 0, 128, 0, 2048, 128, 0, vid0, G, e);
      }
    if (9 + 1 < ph1) { if (ph1 > 1000) grid.sync(); else xcd_barrier(xb); }
  }
  if (ph0 <= 10 && 10 < ph1) {
    asm volatile("" : "+s"(pp));
    CP& p = *pp;
    const int bid = get_rbid();
    const int vid0 = (G & 7) ? bid : ((bid & 7) * (G >> 3) + (bid >> 3));
    const int hb = get_hb();
    char* smem_h = smem + hb * HALF_LDS; (void)smem_h;
    const float* mv0 = p.modv; const float* mv1 = p.modv + (size_t)9 * 6144;
    (void)mv0; (void)mv1; (void)vid0;
    phase_normmod_x(p, p.norm_mix_g + 1024, 1, 0);
    if (10 + 1 < ph1) { if (ph1 > 1000) grid.sync(); else xcd_barrier(xb); }
  }
  if (ph0 <= 11 && 11 < ph1) {
    asm volatile("" : "+s"(pp));
    CP& p = *pp;
    const int bid = get_rbid();
    const int vid0 = (G & 7) ? bid : ((bid & 7) * (G >> 3) + (bid >> 3));
    const int hb = get_hb();
    char* smem_h = smem + hb * HALF_LDS; (void)smem_h;
    const float* mv0 = p.modv; const float* mv1 = p.modv + (size_t)9 * 6144;
    (void)mv0; (void)mv1; (void)vid0;
    {
        EpiConv<1> e{p.hy_conv_w, p.hy_conv_b, 3072, p.hy_b_in, p.x1h, p.vvT};
        gemm_job<true>(smem, p.hxc, 1024, p.wt_hin, 1024, 3072, 17, 2048, 0, 126, 1, 2048, 136, 0, vid0, G, e);
      }
    if (11 + 1 < ph1) { if (ph1 > 1000) grid.sync(); else xcd_barrier(xb); }
  }
  if (ph0 <= 12 && 12 < ph1) {
    asm volatile("" : "+s"(pp));
    CP& p = *pp;
    const int bid = get_rbid();
    const int vid0 = (G & 7) ? bid : ((bid & 7) * (G >> 3) + (bid >> 3));
    const int hb = get_hb();
    char* smem_h = smem + hb * HALF_LDS; (void)smem_h;
    const float* mv0 = p.modv; const float* mv1 = p.modv + (size_t)9 * 6144;
    (void)mv0; (void)mv1; (void)vid0;
    phase_hyconv(p, smem_h);
    if (12 + 1 < ph1) { if (ph1 > 1000) grid.sync(); else xcd_barrier(xb); }
  }
  if (ph0 <= 13 && 13 < ph1) {
    asm volatile("" : "+s"(pp));
    CP& p = *pp;
    const int bid = get_rbid();
    const int vid0 = (G & 7) ? bid : ((bid & 7) * (G >> 3) + (bid >> 3));
    const int hb = get_hb();
    char* smem_h = smem + hb * HALF_LDS; (void)smem_h;
    const float* mv0 = p.modv; const float* mv1 = p.modv + (size_t)9 * 6144;
    (void)mv0; (void)mv1; (void)vid0;
    phase_transmul(p, smem_h);
    if (13 + 1 < ph1) { if (ph1 > 1000) grid.sync(); else xcd_barrier(xb); }
  }
  if (ph0 <= 14 && 14 < ph1) {
    asm volatile("" : "+s"(pp));
    CP& p = *pp;
    const int bid = get_rbid();
    const int vid0 = (G & 7) ? bid : ((bid & 7) * (G >> 3) + (bid >> 3));
    const int hb = get_hb();
    char* smem_h = smem + hb * HALF_LDS; (void)smem_h;
    const float* mv0 = p.modv; const float* mv1 = p.modv + (size_t)9 * 6144;
    (void)mv0; (void)mv1; (void)vid0;
    {
        EpiResid<false> e{p.X16, p.X16, mv1 + 2 * 1024, p.hy_b_out};
        gemm_job<true>(smem, p.hxc, 1024, p.wt_hout, 1024, 1024, 16, 2048, 0, 128, 0, 2048, 128, 0, vid0, G, e);
      }
    if (14 + 1 < ph1) { if (ph1 > 1000) grid.sync(); else xcd_barrier(xb); }
  }
  if (ph0 <= 15 && 15 < ph1) {
    asm volatile("" : "+s"(pp));
    CP& p = *pp;
    const int bid = get_rbid();
    const int vid0 = (G & 7) ? bid : ((bid & 7) * (G >> 3) + (bid >> 3));
    const int hb = get_hb();
    char* smem_h = smem + hb * HALF_LDS; (void)smem_h;
    const float* mv0 = p.modv; const float* mv1 = p.modv + (size_t)9 * 6144;
    (void)mv0; (void)mv1; (void)vid0;
    phase_normmod_x(p, p.norm_ffn_g + 1024, 1, 3);
    if (15 + 1 < ph1) { if (ph1 > 1000) grid.sync(); else xcd_barrier(xb); }
  }
  if (ph0 <= 16 && 16 < ph1) {
    asm volatile("" : "+s"(pp));
    CP& p = *pp;
    const int bid = get_rbid();
    const int vid0 = (G & 7) ? bid : ((bid & 7) * (G >> 3) + (bid >> 3));
    const int hb = get_hb();
    char* smem_h = smem + hb * HALF_LDS; (void)smem_h;
    const float* mv0 = p.modv; const float* mv1 = p.modv + (size_t)9 * 6144;
    (void)mv0; (void)mv1; (void)vid0;
    {
        EpiConv<0> e{p.ffn_conv_w + (size_t)3 * 5632, p.ffn_conv_b + 5632, 5632, nullptr, p.act, nullptr};
        gemm_job<true>(smem, p.hxc, 1024, p.wt_up1, 1024, 5632, 17, 2048, 0, 126, 1, 2048, 136, 0, vid0, G, e);
      }
    if (16 + 1 < ph1) { if (ph1 > 1000) grid.sync(); else xcd_barrier(xb); }
  }
  if (ph0 <= 17 && 17 < ph1) {
    asm volatile("" : "+s"(pp));
    CP& p = *pp;
    const int bid = get_rbid();
    const int vid0 = (G & 7) ? bid : ((bid & 7) * (G >> 3) + (bid >> 3));
    const int hb = get_hb();
    char* smem_h = smem + hb * HALF_LDS; (void)smem_h;
    const float* mv0 = p.modv; const float* mv1 = p.modv + (size_t)9 * 6144;
    (void)mv0; (void)mv1; (void)vid0;
    {
        EpiResid<false> e{p.X16, p.X16, mv1 + 5 * 1024, nullptr};
        gemm_job<true>(smem, p.act, 2816, p.wt_dn1, 2816, 1024, 16, 2048, 0, 128, 0, 2048, 128, 0, vid0, G, e);
      }
    if (17 + 1 < ph1) { if (ph1 > 1000) grid.sync(); else xcd_barrier(xb); }
  }
  if (ph0 <= 18 && 18 < ph1) {
    asm volatile("" : "+s"(pp));
    CP& p = *pp;
    const int bid = get_rbid();
    const int vid0 = (G & 7) ? bid : ((bid & 7) * (G >> 3) + (bid >> 3));
    const int hb = get_hb();
    char* smem_h = smem + hb * HALF_LDS; (void)smem_h;
    const float* mv0 = p.modv; const float* mv1 = p.modv + (size_t)9 * 6144;
    (void)mv0; (void)mv1; (void)vid0;
    phase_final_norm(p);
    if (18 + 1 < ph1) { if (ph1 > 1000) grid.sync(); else xcd_barrier(xb); }
  }
}

extern "C" void kernel_launch(void* const* d_in, const int* in_sizes, int n_in, void* d_out, int out_size, void* d_ws, size_t ws_size, hipStream_t stream) {
  static int grid_blocks = 0;
  if (!grid_blocks) {
    int dev = 0, cus = 0, per_cu = 0;
    hipGetDevice(&dev);
    hipDeviceGetAttribute(&cus, hipDeviceAttributeMultiprocessorCount, dev);
    hipOccupancyMaxActiveBlocksPerMultiprocessor(&per_cu, (const void*)mega, 512, 0);
    per_cu = 1;
    grid_blocks = cus * per_cu;
  }
  P p{};
  const float** in = (const float**)&p;
  for (int i = 0; i < 36; ++i) in[i] = (const float*)d_in[i];
  p.X = (float*)d_out;
  char* ws = (char*)d_ws; size_t off = 0;
  auto take = [&](size_t bytes) { char* r = ws + off; off += (bytes + 255) & ~(size_t)255; return r; };
  p.wt_dq = (bf16_t*)take((size_t)512 * 1024 * 2);
  p.wt_dkv = (bf16_t*)take((size_t)288 * 1024 * 2);
  p.wt_uq = (bf16_t*)take((size_t)1536 * 512 * 2);
  p.wt_uk = (bf16_t*)take((size_t)1024 * 256 * 2);
  p.wt_uv = (bf16_t*)take((size_t)1024 * 256 * 2);
  p.wt_o = (bf16_t*)take((size_t)1024 * 1024 * 2);
  p.wt_hin = (bf16_t*)take((size_t)3072 * 1024 * 2);
  p.wt_hout = (bf16_t*)take((size_t)1024 * 1024 * 2);
  p.wt_up0 = (bf16_t*)take((size_t)5632 * 1024 * 2);
  p.wt_up1 = (bf16_t*)take((size_t)5632 * 1024 * 2);
  p.wt_dn0 = (bf16_t*)take((size_t)1024 * 2816 * 2);
  p.wt_dn1 = (bf16_t*)take((size_t)1024 * 2816 * 2);
  p.modv = (float*)take((size_t)2 * 9 * 6144 * 4);
  p.rq = (float*)take((size_t)4 * 16384 * 4);
  p.rkv = (float*)take((size_t)2 * 18432 * 4);
  p.modp = (float*)take((size_t)4 * 110592 * 4);
  p.bar = (unsigned*)take((size_t)XCD_BAR_WORDS * 4);
  p.wt_f3 = (bf16_t*)take((size_t)2048 * 64 * 2);
  p.h2bf = (bf16_t*)take((size_t)2048 * 64 * 2);
  p.Rf = (bf16_t*)take((size_t)1024 * 4096 * 2);
  p.kpe = (bf16_t*)take((size_t)18432 * 32 * 2);
  p.hxc = (bf16_t*)take((size_t)18432 * 1024 * 2);
  const size_t ubase = off;
  p.cq = (bf16_t*)take((size_t)16384 * 512 * 2);
  p.kv = (bf16_t*)take((size_t)18432 * 288 * 2);
  p.Q = (bf16_t*)take((size_t)16384 * 1536 * 2);
  p.Kn = (bf16_t*)take((size_t)18432 * 1024 * 2);
  p.Vt = (bf16_t*)take((size_t)18432 * 1024 * 2);
  const size_t uend1 = off;
  p.X16 = (bf16_t*)(ws + ubase + (size_t)104857600);
  off = ubase;
  p.act = (bf16_t*)take((size_t)16384 * 2816 * 2);
  off = ubase;
  p.x1h = (bf16_t*)take((size_t)16384 * 1024 * 2);
  p.vvT = (bf16_t*)take((size_t)16384 * 1024 * 2);
  p.Yp = (bf16_t*)take((size_t)16384 * 1024 * 2);
  if (uend1 > ws_size) { fprintf(stderr, "workspace too small: need %zu have %zu\n", uend1, ws_size); return; }
  p.ph0 = 0; p.ph1 = NPHASE;
  if (hipMemsetAsync(p.bar, 0, (size_t)XCD_BAR_WORDS * 4, stream) != hipSuccess) { fprintf(stderr, "memset failed\n"); return; }
  void* args[] = {&p};
  hipError_t e = hipLaunchCooperativeKernel((const void*)mega, dim3(grid_blocks), dim3(512), args, 0, stream);
  if (e != hipSuccess) fprintf(stderr, "cooperative launch failed: %s (grid %d)\n", hipGetErrorString(e), grid_blocks);
}
```

```cpp
#include <hip/hip_runtime.h>
#include <hip/hip_cooperative_groups.h>
#include <cstdio>
namespace cg = cooperative_groups;

typedef unsigned short bf16_t;
typedef short bf16x8 __attribute__((ext_vector_type(8)));
typedef float f32x4 __attribute__((ext_vector_type(4)));
typedef float f32x16 __attribute__((ext_vector_type(16)));

#define LDS_BYTES 163840
#define HALF_LDS 81920
#define NPHASE 19

struct P {
  const float *x, *c, *ctx, *c_ctx, *mod_w, *mod_b, *norm_mix_g, *norm_ffn_g;
  const float *w_dq, *g_q, *w_uq, *w_dkv, *g_kv, *w_uk, *w_uv, *w_o;
  const float *hy_w_in, *hy_b_in, *hy_conv_w, *hy_conv_b, *f_w1, *f_b1, *f_freq1, *f_w2, *f_b2, *f_freq2, *f_w3, *hy_decay, *hy_d_bias, *hy_w_out, *hy_b_out;
  const float *ffn_w_up, *ffn_conv_w, *ffn_conv_b, *ffn_w_down, *final_g;
  float* X;
  bf16_t *wt_dq, *wt_dkv, *wt_uq, *wt_uk, *wt_uv, *wt_o, *wt_hin, *wt_hout, *wt_up0, *wt_up1, *wt_dn0, *wt_dn1;
  float *modv, *rq, *rkv, *modp;
  unsigned* bar;
  bf16_t *wt_f3, *h2bf, *X16;
  bf16_t *Rf, *kpe, *hxc, *cq, *kv, *Q, *Kn, *Vt, *act, *x1h, *vvT, *Yp;
  int ph0, ph1;
};

typedef const __attribute__((address_space(4))) P CP;
__device__ __forceinline__ int get_tid512() { int t = threadIdx.x; asm volatile("" : "+v"(t)); return t; }
__device__ __forceinline__ int get_tid() { int t = threadIdx.x & 255; asm volatile("" : "+v"(t)); return t; }
__device__ __forceinline__ int get_hb() { int t = __builtin_amdgcn_readfirstlane((int)(threadIdx.x >> 8)); asm volatile("" : "+s"(t)); return t; }
__device__ __forceinline__ int get_rbid() { int t = blockIdx.x; asm volatile("" : "+s"(t)); return t; }
__device__ __forceinline__ int get_bid() { return 2 * get_rbid() + get_hb(); }
#define VGRID (2 * (int)gridDim.x)

__device__ __forceinline__ unsigned pack2(float a, float b) { unsigned r; asm("v_cvt_pk_bf16_f32 %0, %1, %2" : "=v"(r) : "v"(a), "v"(b)); return r; }
__device__ __forceinline__ bf16_t f2bf(float f) { return (bf16_t)(pack2(f, f) & 0xffffu); }
__device__ __forceinline__ float bf2f(bf16_t h) { return __uint_as_float(((unsigned)h) << 16); }
__device__ __forceinline__ float wave_sum(float v) {
#pragma unroll
  for (int o = 32; o; o >>= 1) v += __shfl_xor(v, o);
  return v;
}


#define XB_TMO      128
#define XB_XCNT(j)  (256  + 64 * (j))
#define XB_XSUB(j)  (1280 + 64 * (j))
#define XB_XGEN(j)  (2304 + 64 * (j))
#define XB_TOP      3328
#define XB_TOPGEN   3392
#define XCD_BAR_WORDS 3456
#define XB_SPIN_CAP (1u << 18)
#define LAS __attribute__((address_space(3)))
__device__ __forceinline__ unsigned xb_ld(unsigned* p)              { return __hip_atomic_load(p, __ATOMIC_RELAXED, __HIP_MEMORY_SCOPE_AGENT); }
__device__ __forceinline__ unsigned xb_add(unsigned* p, unsigned v) { return __hip_atomic_fetch_add(p, v, __ATOMIC_RELAXED, __HIP_MEMORY_SCOPE_AGENT); }
__device__ __forceinline__ unsigned xb_xcc_id() { return (unsigned)__builtin_amdgcn_s_getreg((3 << 11) | 20) & 0xFu; }
#define XB_SPIN(cond, bar) do { unsigned _sp = 0; while (cond) { __builtin_amdgcn_s_sleep(1); \
    if ((++_sp & 255u) == 0u) { if (xb_ld(&(bar)[XB_TMO])) break; if (_sp > XB_SPIN_CAP) { atomicAdd(&(bar)[XB_TMO], 1u); break; } } } } while (0)
struct XcdBarrier { unsigned* bar; unsigned x; volatile LAS unsigned* st; };
__device__ __forceinline__ XcdBarrier xcd_barrier_post(unsigned* bar, volatile LAS unsigned* st) {
    XcdBarrier b; b.bar = bar; b.x = xb_xcc_id(); b.st = st;
    if (threadIdx.x == 0) (void)xb_add(&bar[XB_XCNT(b.x)], 1u);
    return b;
}
__device__ __forceinline__ void xcd_barrier_complete(unsigned* bar, unsigned x, unsigned& nloc, unsigned& nx) {
    const unsigned G = gridDim.x * gridDim.y * gridDim.z;
    unsigned sum, cnt, mine, sp = 0u;
    for (;;) {
        sum = 0u; cnt = 0u; mine = 0u;
#pragma unroll
        for (unsigned j = 0; j < 16; ++j) { const unsigned c = xb_ld(&bar[XB_XCNT(j)]); sum += c; cnt += (c > 0u) ? 1u : 0u; mine = (j == x) ? c : mine; }
        if (sum == G) break;
        __builtin_amdgcn_s_sleep(1);
        if ((++sp & 255u) == 0u) { if (xb_ld(&bar[XB_TMO])) break; if (sp > XB_SPIN_CAP) { atomicAdd(&bar[XB_TMO], 1u); break; } }
    }
    nloc = mine > 0u ? mine : 1u; nx = cnt > 0u ? cnt : 1u;
}
__device__ __forceinline__ void xcd_barrier(const XcdBarrier& b) {
    asm volatile("s_waitcnt vmcnt(0)" ::: "memory");
    __syncthreads();
    if (threadIdx.x == 0) {
        unsigned* bar = b.bar;
        __builtin_amdgcn_s_waitcnt(0);
        unsigned nloc = b.st[0], nx = b.st[1];
        if (nloc == 0u) { xcd_barrier_complete(bar, b.x, nloc, nx); b.st[0] = nloc; b.st[1] = nx; }
        const unsigned old = xb_add(&bar[XB_XSUB(b.x)], 1u);
        const unsigned gen = old / nloc;
        if (old + 1u == (gen + 1u) * nloc) {
            __builtin_amdgcn_fence(__ATOMIC_RELEASE, "agent");
            asm volatile("s_waitcnt vmcnt(0)" ::: "memory");
            const unsigned og = xb_add(&bar[XB_TOP], 1u);
            const unsigned tg = og / nx;
            if (og + 1u == (tg + 1u) * nx) xb_add(&bar[XB_TOPGEN], 1u);
            else XB_SPIN(xb_ld(&bar[XB_TOPGEN]) == tg, bar);
            __builtin_amdgcn_fence(__ATOMIC_ACQUIRE, "agent");
            xb_add(&bar[XB_XGEN(b.x)], 1u);
            asm volatile("s_waitcnt vmcnt(0)" ::: "memory");
        } else {
            XB_SPIN(xb_ld(&bar[XB_XGEN(b.x)]) == gen, bar);
            __builtin_amdgcn_fence(__ATOMIC_ACQUIRE, "agent");
            asm volatile("s_waitcnt vmcnt(0)" ::: "memory");
        }
    }
    __syncthreads();
}

__device__ __forceinline__ void prep_weight_tile(CP& p, char* smem, int wt) {
  const int tid = get_tid();
  int id = 0;
  {
    const int cnt[13] = {64, 40, 96, 32, 32, 128, 384, 128, 704, 704, 352, 352, 32};
#pragma unroll
    for (int i = 0; i < 12; ++i) { if (id == i && wt >= cnt[i]) { wt -= cnt[i]; id = i + 1; } }
  }
  const float* src; int K, N; bf16_t* dst; const float* scale = nullptr; int perm = 0;
  switch (id) {
    case 0: src = p.w_dq; K = 1024; N = 512; dst = p.wt_dq; break;
    case 1: src = p.w_dkv; K = 1024; N = 288; dst = p.wt_dkv; break;
    case 2: src = p.w_uq; K = 512; N = 1536; dst = p.wt_uq; scale = p.g_q; break;
    case 3: src = p.w_uk; K = 256; N = 1024; dst = p.wt_uk; scale = p.g_kv; break;
    case 4: src = p.w_uv; K = 256; N = 1024; dst = p.wt_uv; scale = p.g_kv; break;
    case 5: src = p.w_o; K = 1024; N = 1024; dst = p.wt_o; break;
    case 6: src = p.hy_w_in; K = 1024; N = 3072; dst = p.wt_hin; perm = 2; break;
    case 7: src = p.hy_w_out; K = 1024; N = 1024; dst = p.wt_hout; break;
    case 8: src = p.ffn_w_up; K = 1024; N = 5632; dst = p.wt_up0; perm = 1; break;
    case 9: src = p.ffn_w_up + (size_t)1024 * 5632; K = 1024; N = 5632; dst = p.wt_up1; perm = 1; break;
    case 10: src = p.ffn_w_down; K = 2816; N = 1024; dst = p.wt_dn0; break;
    case 11: src = p.ffn_w_down + (size_t)2816 * 1024; K = 2816; N = 1024; dst = p.wt_dn1; break;
    default: src = p.f_w3; K = 64; N = 2048; dst = p.wt_f3; break;
  }
  const int ntn = (N + 63) >> 6;
  const int kt = wt / ntn, nt = wt - kt * ntn;
  const int k0 = kt * 128, n0 = nt * 64;
  int np0;
  if (perm == 1) { const int half = n0 / 2816, f = n0 - half * 2816; np0 = (f >> 6) * 128 + half * 64; }
  else if (perm == 2) { if (n0 < 1024) np0 = n0; else { const int m = n0 - 1024, half = m >> 10, f = m & 1023; np0 = 1024 + (f >> 6) * 128 + half * 64; } }
  else np0 = n0;
  bf16_t* t16 = (bf16_t*)smem;
  f32x4 v[8];
#pragma unroll
  for (int i = 0; i < 8; ++i) {
    const int idx = tid + 256 * i; const int kr = idx >> 4, c4 = idx & 15;
    v[i] = (f32x4){0.f, 0.f, 0.f, 0.f};
    if (n0 + 4 * c4 < N && k0 + kr < K) v[i] = *(const f32x4*)(src + (size_t)(k0 + kr) * N + n0 + 4 * c4);
  }
#pragma unroll
  for (int i = 0; i < 8; ++i) {
    const int idx = tid + 256 * i; const int kr = idx >> 4, c4 = idx & 15;
    const float sc = (scale && k0 + kr < K) ? scale[k0 + kr] : 1.f;
#pragma unroll
    for (int j = 0; j < 4; ++j) t16[(4 * c4 + j) * 136 + kr] = f2bf(v[i][j] * sc);
  }
  __syncthreads();
#pragma unroll
  for (int i = 0; i < 4; ++i) {
    const int idx = tid + 256 * i; const int n = idx >> 4, ch = idx & 15;
    if (n0 + n < N && k0 + ch * 8 < K) *(uint4*)(dst + (size_t)(np0 + n) * K + k0 + ch * 8) = *(const uint4*)(t16 + n * 136 + ch * 8);
  }
  __syncthreads();
}

__device__ __forceinline__ void prep_modvec(CP& p, char* smem, int it) {
  const int tid = get_tid();
  const int layer = it / 384, rem = it - layer * 384, cb = rem >> 2, ks = rem & 3;
  float* s_lds = (float*)smem;
  float* red = (float*)(smem + 12288);
  const int kbase = ks * 256;
  for (int idx = tid; idx < 9 * 256; idx += 256) {
    const int r = idx >> 8, k = idx & 255;
    const float v = r < 8 ? p.c[r * 1024 + kbase + k] : p.c_ctx[kbase + k];
    s_lds[k * 12 + r] = v / (1.f + __expf(-v));
  }
  __syncthreads();
  const int col = cb * 64 + (tid & 63), kg = tid >> 6;
  const float* W = p.mod_w + (size_t)layer * 1024 * 6144 + (size_t)kbase * 6144 + col;
  float acc[9];
#pragma unroll
  for (int r = 0; r < 9; ++r) acc[r] = 0.f;
#pragma unroll
  for (int kb = 0; kb < 4; ++kb) {
    float w[16];
#pragma unroll
    for (int u = 0; u < 16; ++u) w[u] = W[(size_t)(kg * 64 + kb * 16 + u) * 6144];
#pragma unroll
    for (int u = 0; u < 16; ++u) {
      const int k = kg * 64 + kb * 16 + u;
      const f32x4 s0 = *(const f32x4*)(s_lds + k * 12), s1 = *(const f32x4*)(s_lds + k * 12 + 4);
      const float s2 = s_lds[k * 12 + 8];
      acc[0] += s0[0] * w[u]; acc[1] += s0[1] * w[u]; acc[2] += s0[2] * w[u]; acc[3] += s0[3] * w[u];
      acc[4] += s1[0] * w[u]; acc[5] += s1[1] * w[u]; acc[6] += s1[2] * w[u]; acc[7] += s1[3] * w[u];
      acc[8] += s2 * w[u];
    }
  }
#pragma unroll
  for (int r = 0; r < 9; ++r) red[(kg * 9 + r) * 64 + (tid & 63)] = acc[r];
  __syncthreads();
  for (int o = tid; o < 9 * 64; o += 256) {
    const int r = o >> 6, cl = o & 63;
    const float sm = red[(0 * 9 + r) * 64 + cl] + red[(1 * 9 + r) * 64 + cl] + red[(2 * 9 + r) * 64 + cl] + red[(3 * 9 + r) * 64 + cl];
    p.modp[(size_t)ks * 110592 + (size_t)(layer * 9 + r) * 6144 + cb * 64 + cl] = sm;
  }
  __syncthreads();
}

__device__ __forceinline__ void prep_filter(CP& p, char* smem, int it) {
  const int tid = get_tid();
  float* z = (float*)smem;
  float* h1 = z + 8 * 33;
  float* h2 = h1 + 8 * 64;
  const int t0 = it * 8;
  for (int idx = tid; idx < 8 * 33; idx += 256) {
    const int pp = idx / 33, i = idx - pp * 33;
    const int t = t0 + pp;
    float v;
    if (i == 0) v = (float)t * (1.0f / 2047.0f);
    else {
      const int k = (i - 1) & 15;
      const float w = (6.283185307179586f * (float)t) / 2048.0f;
      const float f = 1e-4f + (float)k * ((15.0f - 1e-4f) / 15.0f);
      const float a = w * f;
      v = (i <= 16) ? __cosf(a) : -__sinf(a);
    }
    z[idx] = v;
  }
  __syncthreads();
  for (int idx = tid; idx < 8 * 64; idx += 256) {
    const int pp = idx >> 6, j = idx & 63;
    float s = p.f_b1[j];
#pragma unroll
    for (int i = 0; i < 33; ++i) s += z[pp * 33 + i] * p.f_w1[i * 64 + j];
    h1[idx] = __sinf(p.f_freq1[j] * s);
  }
  __syncthreads();
  for (int idx = tid; idx < 8 * 64; idx += 256) {
    const int pp = idx >> 6, j = idx & 63;
    float s = p.f_b2[j];
#pragma unroll 16
    for (int i = 0; i < 64; ++i) s += h1[pp * 64 + i] * p.f_w2[i * 64 + j];
    h2[idx] = __sinf(p.f_freq2[j] * s);
  }
  __syncthreads();
  for (int idx = tid; idx < 8 * 64; idx += 256) p.h2bf[(size_t)t0 * 64 + idx] = f2bf(h2[idx]);
  __syncthreads();
}

__device__ __forceinline__ void phase_prep(CP& p, char* smem) {
  const int total = 768 + 256 + 3048;
  for (int it = get_bid(); it < total; it += VGRID) {
    if (it < 768) prep_modvec(p, smem, it);
    else if (it < 1024) prep_filter(p, smem, it - 768);
    else prep_weight_tile(p, smem, it - 1024);
  }
}

__device__ __forceinline__ f32x4 ld4_bf16(const bf16_t* p) {
  const uint2 u = *(const uint2*)p;
  f32x4 r; r[0] = bf2f((bf16_t)(u.x & 0xffff)); r[1] = bf2f((bf16_t)(u.x >> 16)); r[2] = bf2f((bf16_t)(u.y & 0xffff)); r[3] = bf2f((bf16_t)(u.y >> 16));
  return r;
}
template <bool PART, bool SRC16 = false>
__device__ __forceinline__ void normmod_row2(const void* __restrict__ srcv, const float* __restrict__ g, const float* __restrict__ sh, const float* __restrict__ sc, bf16_t* __restrict__ dst, int lane, const float* __restrict__ bsh = nullptr) {
  f32x4 v[2][4]; float ss0 = 0.f, ss1 = 0.f;
#pragma unroll
  for (int i = 0; i < 4; ++i) {
    if (SRC16) { v[0][i] = ld4_bf16((const bf16_t*)srcv + lane * 4 + 256 * i); v[1][i] = ld4_bf16((const bf16_t*)srcv + 1024 + lane * 4 + 256 * i); }
    else { v[0][i] = *(const f32x4*)((const float*)srcv + lane * 4 + 256 * i); v[1][i] = *(const f32x4*)((const float*)srcv + 1024 + lane * 4 + 256 * i); }
  }
#pragma unroll
  for (int i = 0; i < 4; ++i) {
    ss0 += v[0][i][0] * v[0][i][0] + v[0][i][1] * v[0][i][1] + v[0][i][2] * v[0][i][2] + v[0][i][3] * v[0][i][3];
    ss1 += v[1][i][0] * v[1][i][0] + v[1][i][1] * v[1][i][1] + v[1][i][2] * v[1][i][2] + v[1][i][3] * v[1][i][3];
  }
  ss0 = wave_sum(ss0); ss1 = wave_sum(ss1);
  const float r0 = rsqrtf(ss0 * (1.0f / 1024.0f) + 1e-6f), r1 = rsqrtf(ss1 * (1.0f / 1024.0f) + 1e-6f);
#pragma unroll
  for (int i = 0; i < 4; ++i) {
    const int k = lane * 4 + 256 * i;
    const f32x4 g4 = *(const f32x4*)(g + k);
    f32x4 s4 = *(const f32x4*)(sh + k), c4 = *(const f32x4*)(sc + k);
    if (PART) {
#pragma unroll
      for (int q = 1; q < 4; ++q) { s4 += *(const f32x4*)(sh + (size_t)q * 110592 + k); c4 += *(const f32x4*)(sc + (size_t)q * 110592 + k); }
      s4 += *(const f32x4*)(bsh + k); c4 += *(const f32x4*)(bsh + 1024 + k);
    }
    float y[4], z[4];
#pragma unroll
    for (int j = 0; j < 4; ++j) { const float gm = g4[j] * (1.f + c4[j]); y[j] = (v[0][i][j] * r0) * gm + s4[j]; z[j] = (v[1][i][j] * r1) * gm + s4[j]; }
    uint2 u; u.x = pack2(y[0], y[1]); u.y = pack2(y[2], y[3]);
    *(uint2*)(dst + k) = u;
    u.x = pack2(z[0], z[1]); u.y = pack2(z[2], z[3]);
    *(uint2*)(dst + 1024 + k) = u;
  }
}

__device__ __forceinline__ void phase_normmod_kv(CP& p) {
  const int lane = get_tid() & 63, wv = get_tid() >> 6;
  const float* g = p.norm_mix_g;
  for (int idx = get_bid() * 256 + get_tid(); idx < 110592; idx += VGRID * 256) {
    const int lr = idx / 6144; const int n = idx - lr * 6144; const int layer = lr / 9;
    p.modv[idx] = p.modp[idx] + p.modp[110592 + idx] + p.modp[2 * 110592 + idx] + p.modp[3 * 110592 + idx] + p.mod_b[layer * 6144 + n];
  }
  for (int r = (get_bid() * 4 + wv) * 2; r < 18432; r += VGRID * 8) {
    const int b = r / 2304, pp = r - b * 2304;
    const float* src; const float* mv;
    if (pp < 256) { src = p.ctx + ((size_t)b * 256 + pp) * 1024; mv = p.modp + (size_t)8 * 6144; }
    else { src = p.x + ((size_t)b * 2048 + pp - 256) * 1024; mv = p.modp + (size_t)b * 6144; }
    normmod_row2<true>(src, g, mv, mv + 1024, p.hxc + (size_t)r * 1024, lane, p.mod_b);
  }
}
__device__ __forceinline__ void phase_normmod_x(CP& p, const float* g, int layer, int chunk) {
  const int lane = get_tid() & 63, wv = get_tid() >> 6;
  for (int r = (get_bid() * 4 + wv) * 2; r < 16384; r += VGRID * 8) {
    const int b = r >> 11;
    const float* mv = p.modv + (size_t)(layer * 9 + b) * 6144 + chunk * 1024;
    normmod_row2<false, true>(p.X16 + (size_t)r * 1024, g, mv, mv + 1024, p.hxc + (size_t)r * 1024, lane);
  }
}
__device__ __forceinline__ void phase_final_norm(CP& p) {
  const int lane = get_tid() & 63, wv = get_tid() >> 6;
  for (int r = get_bid() * 4 + wv; r < 16384; r += VGRID * 4) {
    const bf16_t* srow = p.X16 + (size_t)r * 1024;
    float* row = p.X + (size_t)r * 1024;
    f32x4 v[4]; float ss = 0.f;
#pragma unroll
    for (int i = 0; i < 4; ++i) { v[i] = ld4_bf16(srow + lane * 4 + 256 * i); ss += v[i][0] * v[i][0] + v[i][1] * v[i][1] + v[i][2] * v[i][2] + v[i][3] * v[i][3]; }
    ss = wave_sum(ss);
    const float rr = rsqrtf(ss * (1.0f / 1024.0f) + 1e-6f);
#pragma unroll
    for (int i = 0; i < 4; ++i) {
      const int k = lane * 4 + 256 * i;
      const f32x4 g4 = *(const f32x4*)(p.final_g + k);
      f32x4 o; o[0] = v[i][0] * rr * g4[0]; o[1] = v[i][1] * rr * g4[1]; o[2] = v[i][2] * rr * g4[2]; o[3] = v[i][3] * rr * g4[3];
      *(f32x4*)(row + k) = o;
    }
  }
}

__device__ __forceinline__ void phase_rowstat(CP& p) {
  const int lane = get_tid() & 63, wv = get_tid() >> 6;
  for (int r = get_bid() * 4 + wv; r < 18432; r += VGRID * 4) {
    const int b = r / 2304, pp = r - b * 2304;
    const bf16_t* kvr = p.kv + (size_t)r * 288;
    {
      const uint2 u = *(const uint2*)(kvr + lane * 4);
      const float a0 = bf2f((bf16_t)(u.x & 0xffff)), a1 = bf2f((bf16_t)(u.x >> 16)), a2 = bf2f((bf16_t)(u.y & 0xffff)), a3 = bf2f((bf16_t)(u.y >> 16));
      float ss = a0 * a0 + a1 * a1 + a2 * a2 + a3 * a3;
      ss = wave_sum(ss);
      if (lane == 0) p.rkv[r] = rsqrtf(ss * (1.0f / 256.0f) + 1e-6f);
    }
    {
      const int i = lane & 31;
      const float xv = bf2f(kvr[256 + i]);
      const float ov = __shfl_xor(xv, 8);
      float res = xv;
      if (pp >= 256) {
        const int t = pp - 256;
        const int quarter = i >> 3, idx = i & 7;
        const float pos = (quarter < 2) ? (float)(t >> 6) : (float)(t & 63);
        const float inv = exp2f(-(float)idx * (13.287712379549449f / 8.0f));
        const float ang = pos * inv;
        const float cs = __cosf(ang), sn = __sinf(ang);
        res = xv * cs + ((quarter & 1) ? ov : -ov) * sn;
      }
      if (lane < 32) p.kpe[(size_t)r * 32 + i] = f2bf(res);
    }
    if (pp >= 256) {
      const int xr = b * 2048 + pp - 256;
      const uint4 u = *(const uint4*)(p.cq + (size_t)xr * 512 + lane * 8);
      const unsigned uu[4] = {u.x, u.y, u.z, u.w};
      float ss = 0.f;
#pragma unroll
      for (int j = 0; j < 4; ++j) { const float a = bf2f((bf16_t)(uu[j] & 0xffff)), bb = bf2f((bf16_t)(uu[j] >> 16)); ss += a * a + bb * bb; }
      ss = wave_sum(ss);
      if (lane == 0) p.rq[xr] = rsqrtf(ss * (1.0f / 512.0f) + 1e-6f);
    }
  }
}

template <int NP>
struct EpiStore {
  static constexpr int KIND = 0; static constexpr bool ROWSUM = false;
  bf16_t* out; int ld; int ostride; const float* part; int pstride; float inv_n;
  __device__ __forceinline__ void c4(int g, int rig, int col, f32x4 v) const {
    const size_t row = (size_t)g * ostride + rig;
    float s = 1.f;
    if (NP > 0) {
      float t = 0.f;
#pragma unroll
      for (int q = 0; q < NP; ++q) t += part[(size_t)q * pstride + row];
      s = rsqrtf(t * inv_n + 1e-6f);
    }
    uint2 u; u.x = pack2(v[0] * s, v[1] * s); u.y = pack2(v[2] * s, v[3] * s);
    *(uint2*)(out + row * ld + col) = u;
  }
};
struct EpiDown {
  static constexpr int KIND = 0; static constexpr bool ROWSUM = true;
  bf16_t* out; int ld; int ostride; float* part; int nslots; bf16_t* kpe; int ropecol;
  __device__ __forceinline__ float c4(int g, int rig, int col, f32x4 v) const {
    const size_t row = (size_t)g * ostride + rig;
    if (kpe && col >= ropecol) {
      const int i0 = col - ropecol;
      f32x4 o = v;
      const float p0 = __shfl_xor(v[0], 32), p1 = __shfl_xor(v[1], 32), p2 = __shfl_xor(v[2], 32), p3 = __shfl_xor(v[3], 32);
      const float pv[4] = {p0, p1, p2, p3};
      if (rig >= 256) {
        const int t = rig - 256;
        const int quarter = i0 >> 3;
        const float pos = (quarter < 2) ? (float)(t >> 6) : (float)(t & 63);
#pragma unroll
        for (int j = 0; j < 4; ++j) {
          const int idx = (i0 & 7) + j;
          const float inv = exp2f(-(float)idx * (13.287712379549449f / 8.0f));
          const float ang = pos * inv;
          const float cs = __cosf(ang), sn = __sinf(ang);
          o[j] = v[j] * cs + ((quarter & 1) ? pv[j] : -pv[j]) * sn;
        }
      }
      uint2 u; u.x = pack2(o[0], o[1]); u.y = pack2(o[2], o[3]);
      *(uint2*)(kpe + row * 32 + i0) = u;
      return 0.f;
    }
    uint2 u; u.x = pack2(v[0], v[1]); u.y = pack2(v[2], v[3]);
    *(uint2*)(out + row * ld + col) = u;
    return v[0] * v[0] + v[1] * v[1] + v[2] * v[2] + v[3] * v[3];
  }
  __device__ __forceinline__ void rowsum(int g, int rig, int slot, float ss) const {
    if (slot < nslots) part[(size_t)slot * ((size_t)8 * ostride) + (size_t)g * ostride + rig] = ss;
  }
};
struct EpiVt {
  static constexpr int KIND = 1;
  bf16_t* out; const float* part;
  __device__ __forceinline__ void r4(int g, int rig, int col, f32x4 v) const {
    const size_t row = (size_t)g * 2304 + rig;
    const f32x4 t = *(const f32x4*)(part + row) + *(const f32x4*)(part + 18432 + row);
    f32x4 s;
#pragma unroll
    for (int j = 0; j < 4; ++j) s[j] = rsqrtf(t[j] * (1.0f / 256.0f) + 1e-6f);
    uint2 u; u.x = pack2(v[0] * s[0], v[1] * s[1]); u.y = pack2(v[2] * s[2], v[3] * s[3]);
    *(uint2*)(out + ((size_t)g * 1024 + col) * 2304 + rig) = u;
  }
};
struct EpiFilt {
  static constexpr int KIND = 1;
  bf16_t* Rf; const float* decay;
  __device__ __forceinline__ void r4(int g, int rig, int col, f32x4 v) const {
    const int c = col & 1023; const bool bwd = col >= 1024;
    const float dec = fabsf(decay[c]);
    bf16_t* rp = Rf + (size_t)c * 4096;
#pragma unroll
    for (int j = 0; j < 4; ++j) {
      const int t = rig + j;
      const float val = v[j] * __expf(-(float)t * (1.0f / 2047.0f) * dec);
      if (!bwd) rp[2048 - t] = f2bf(val);
      else if (t > 0) rp[2048 + t] = f2bf(val);
      else rp[0] = 0;
    }
  }
};
template <bool BASE_F32>
struct EpiResid {
  static constexpr int KIND = 0; static constexpr bool ROWSUM = false;
  bf16_t* X16; const void* base; const float* gate; const float* bias;
  __device__ __forceinline__ void c4(int g, int rig, int col, f32x4 v) const {
    const size_t o = ((size_t)g * 2048 + rig) * 1024 + col;
    f32x4 bs;
    if (BASE_F32) bs = *(const f32x4*)((const float*)base + o);
    else {
      const uint2 u = *(const uint2*)((const bf16_t*)base + o);
      bs[0] = bf2f((bf16_t)(u.x & 0xffff)); bs[1] = bf2f((bf16_t)(u.x >> 16)); bs[2] = bf2f((bf16_t)(u.y & 0xffff)); bs[3] = bf2f((bf16_t)(u.y >> 16));
    }
    const f32x4 gt = *(const f32x4*)(gate + (size_t)g * 6144 + col);
    f32x4 bi = {0.f, 0.f, 0.f, 0.f};
    if (bias) bi = *(const f32x4*)(bias + col);
    f32x4 r;
#pragma unroll
    for (int j = 0; j < 4; ++j) r[j] = bs[j] + gt[j] * (v[j] + bi[j]);
    uint2 w; w.x = pack2(r[0], r[1]); w.y = pack2(r[2], r[3]);
    *(uint2*)(X16 + o) = w;
  }
};
template <int MODE>
struct EpiConv {
  static constexpr int KIND = 2;
  const float* cw; const float* cb; int NC; const float* pre_bias;
  bf16_t* o0; bf16_t* o1;
  __device__ __forceinline__ int norig(int nt, int cl) const {
    if (MODE == 0) return (cl >> 6) * 2816 + nt * 64 + (cl & 63);
    if (nt < 8) return nt * 128 + cl;
    return 1024 + (cl >> 6) * 1024 + (nt - 8) * 64 + (cl & 63);
  }
  typedef float f32x2_t __attribute__((ext_vector_type(2)));
  static __device__ __forceinline__ f32x2_t ldz(const bf16_t* Z, int row, int col) {
    const unsigned u = *(const unsigned*)(Z + row * 132 + col);
    f32x2_t r; r[0] = __uint_as_float(u << 16); r[1] = __uint_as_float(u & 0xffff0000u); return r;
  }
  template <class F>
  __device__ __forceinline__ void finish(const bf16_t* Z, int g, int rig0, int nt, F&& pre) const {
    typedef f32x2_t f32x2;
    const int tid = get_tid();
    if (MODE == 0 || nt < 8) {
      if (MODE == 0) {
        const int f2 = (tid & 31) * 2, q8 = tid >> 5;
        const int q0 = 1 + 16 * q8, q1 = (q0 + 16 < 127) ? q0 + 16 : 127;
        const int na = norig(nt, f2), ng = norig(nt, 64 + f2);
        const f32x2 a0 = *(const f32x2*)(cw + na), a1 = *(const f32x2*)(cw + NC + na), a2 = *(const f32x2*)(cw + 2 * NC + na), ab = *(const f32x2*)(cb + na);
        const f32x2 g0 = *(const f32x2*)(cw + ng), g1 = *(const f32x2*)(cw + NC + ng), g2 = *(const f32x2*)(cw + 2 * NC + ng), gb = *(const f32x2*)(cb + ng);
        pre();
        f32x2 am = ldz(Z, q0 - 1, f2), ac = ldz(Z, q0, f2);
        f32x2 gm = ldz(Z, q0 - 1, 64 + f2), gc = ldz(Z, q0, 64 + f2);
#pragma unroll 2
        for (int pl = q0; pl < q1; ++pl) {
          const f32x2 an = ldz(Z, pl + 1, f2), gn = ldz(Z, pl + 1, 64 + f2);
          const int pos = rig0 + pl;
          if (pos < 2048) {
            const f32x2 av = a0 * am + a1 * ac + a2 * an + ab;
            const f32x2 gv = g0 * gm + g1 * gc + g2 * gn + gb;
            const float s0 = av[0] * gv[0] * __builtin_amdgcn_rcpf(1.f + __expf(-gv[0]));
            const float s1 = av[1] * gv[1] * __builtin_amdgcn_rcpf(1.f + __expf(-gv[1]));
            *(unsigned*)(o0 + ((size_t)g * 2048 + pos) * 2816 + nt * 64 + f2) = pack2(s0, s1);
          }
          am = ac; ac = an; gm = gc; gc = gn;
        }
      } else {
        const int cl = (tid & 63) * 2, q = tid >> 6;
        const int p0 = 1 + 32 * q, p1 = (p0 + 32 < 127) ? p0 + 32 : 127;
        const int na = norig(nt, cl);
        const f32x2 a0 = *(const f32x2*)(cw + na), a1 = *(const f32x2*)(cw + NC + na), a2 = *(const f32x2*)(cw + 2 * NC + na), ab = *(const f32x2*)(cb + na);
        pre();
        f32x2 am = ldz(Z, p0 - 1, cl), ac = ldz(Z, p0, cl);
#pragma unroll 2
        for (int pl = p0; pl < p1; ++pl) {
          const f32x2 an = ldz(Z, pl + 1, cl);
          const int pos = rig0 + pl;
          if (pos < 2048) {
            const f32x2 av = a0 * am + a1 * ac + a2 * an + ab;
            *(unsigned*)(o0 + ((size_t)g * 2048 + pos) * 1024 + nt * 128 + cl) = pack2(av[0], av[1]);
          }
          am = ac; ac = an;
        }
      }
    } else {
      pre();
      const int pl = tid & 127, fh = tid >> 7;
      const int pos = rig0 + pl;
      if (pl >= 1 && pl <= 126 && pos < 2048) {
        const int fb = nt - 8;
#pragma unroll 2
        for (int f = fh * 32; f < fh * 32 + 32; f += 2) {
          const int na = norig(nt, f), nb = norig(nt, 64 + f);
          const f32x2 va = *(const f32x2*)(cw + na) * ldz(Z, pl - 1, f) + *(const f32x2*)(cw + NC + na) * ldz(Z, pl, f)
                         + *(const f32x2*)(cw + 2 * NC + na) * ldz(Z, pl + 1, f) + *(const f32x2*)(cb + na);
          const f32x2 vb = *(const f32x2*)(cw + nb) * ldz(Z, pl - 1, 64 + f) + *(const f32x2*)(cw + NC + nb) * ldz(Z, pl, 64 + f)
                         + *(const f32x2*)(cw + 2 * NC + nb) * ldz(Z, pl + 1, 64 + f) + *(const f32x2*)(cb + nb);
          bf16_t* op = o1 + (size_t)(fb * 64 + f) * 16384 + g * 2048 + pos;
          op[0] = f2bf(va[0] * vb[0]);
          op[16384] = f2bf(va[1] * vb[1]);
        }
      }
    }
  }
};

#define GLDS16(gp, lp) __builtin_amdgcn_global_load_lds((const unsigned*)(gp), (__attribute__((address_space(3))) unsigned*)(lp), 16, 0, 0)

template <bool SWAP, class Epi>
__device__ __forceinline__ void gemm_job(char* smem, const bf16_t* __restrict__ A, int lda, const bf16_t* __restrict__ Bt, int K, int N,
                                         int tpg, int a_gstride, int a_goff, int step, int halo, int grows, int MTS, int voff, int vid0, int grid, const Epi& epi) {
  const int tid = get_tid512(), lane = tid & 63, wid = tid >> 6, wr = wid >> 1, wc = wid & 1, fr = lane & 15, fq = lane >> 4;
  const int NT = (N + 255) >> 8, MT = MTS >> 1, ntiles = MT * NT, ns = K >> 6;
  const int full = MT >> 3;
  int v = vid0;
  if (v < voff) v += ((voff - v + grid - 1) / grid) * grid;
  const int swz = (fr >> 1) & 7;
  bool pre_issued = false;
  for (; v < voff + ntiles; v += grid) {
    const int w = v - voff;
    int mt, nt;
    if (w < full * 8 * NT) { const int sr = w / (8 * NT), rem = w - sr * 8 * NT; nt = rem >> 3; mt = sr * 8 + (rem & 7); }
    else { const int w2 = w - full * 8 * NT, rl = MT - full * 8; nt = w2 / rl; mt = full * 8 + (w2 - nt * rl); }
    unsigned ap[4], bp[4];
#pragma unroll
    for (int i = 0; i < 4; ++i) {
      const int r = (tid >> 3) + 64 * i;
      const int cs = tid & 7;
      const int c = ((cs ^ ((r >> 1) & 7)) << 3);
      const int sub = 2 * mt + (r >> 7);
      const int g = sub / tpg, ti = sub - g * tpg;
      int rig = ti * step - halo + (r & 127); rig = rig < 0 ? 0 : (rig > grows - 1 ? grows - 1 : rig);
      ap[i] = (unsigned)((g * a_gstride + a_goff + rig) * lda + c);
      int br = nt * 256 + r; br = br > N - 1 ? N - 1 : br;
      bp[i] = (unsigned)(br * K + c);
    }
    const bool have_next = false;
    f32x4 acc[4][8];
#pragma unroll
    for (int m = 0; m < 4; ++m)
#pragma unroll
      for (int n = 0; n < 8; ++n) acc[m][n] = (f32x4){0.f, 0.f, 0.f, 0.f};
    if (!pre_issued) {
#pragma unroll
      for (int i = 0; i < 4; ++i) { GLDS16(A + (size_t)ap[i], smem + tid * 16 + i * 8192); GLDS16(Bt + (size_t)bp[i], smem + 32768 + tid * 16 + i * 8192); }
    }
    pre_issued = have_next;
    for (int st = 0; st < ns; ++st) {
      asm volatile("s_waitcnt vmcnt(0)" ::: "memory");
      __builtin_amdgcn_s_barrier();
      asm volatile("" ::: "memory");
      if (st + 1 < ns) {
        char* nb = smem + ((st + 1) & 1) * 65536;
        const int ko = (st + 1) * 64;
#pragma unroll
        for (int i = 0; i < 4; ++i) { GLDS16(A + (size_t)(ap[i] + ko), nb + tid * 16 + i * 8192); GLDS16(Bt + (size_t)(bp[i] + ko), nb + 32768 + tid * 16 + i * 8192); }
      }
      const char* sa = smem + (st & 1) * 65536 + (wr * 64 + fr) * 128;
      const char* sb = smem + (st & 1) * 65536 + 32768 + (wc * 128 + fr) * 128;
      bf16x8 afA[4], afB[4], bfb[2][2];
#pragma unroll
      for (int m = 0; m < 4; ++m) afA[m] = *(const bf16x8*)(sa + m * 2048 + ((fq ^ swz) << 4));
#pragma unroll
      for (int n = 0; n < 2; ++n) bfb[0][n] = *(const bf16x8*)(sb + n * 2048 + ((fq ^ swz) << 4));
#pragma unroll
      for (int gq = 0; gq < 8; ++gq) {
        const int ks = gq >> 2, nh = gq & 3;
        if (gq < 7) {
          const int ks2 = (gq + 1) >> 2, nh2 = (gq + 1) & 3;
#pragma unroll
          for (int n = 0; n < 2; ++n) bfb[(gq + 1) & 1][n] = *(const bf16x8*)(sb + (nh2 * 2 + n) * 2048 + (((ks2 * 4 + fq) ^ swz) << 4));
        }
        if (gq == 3) {
#pragma unroll
          for (int m = 0; m < 4; ++m) afB[m] = *(const bf16x8*)(sa + m * 2048 + (((4 + fq) ^ swz) << 4));
        }
        __builtin_amdgcn_sched_barrier(0);
#pragma unroll
        for (int m = 0; m < 4; ++m)
#pragma unroll
          for (int n = 0; n < 2; ++n) {
            const bf16x8 av = ks ? afB[m] : afA[m];
            acc[m][nh * 2 + n] = SWAP ? __builtin_amdgcn_mfma_f32_16x16x32_bf16(bfb[gq & 1][n], av, acc[m][nh * 2 + n], 0, 0, 0)
                                      : __builtin_amdgcn_mfma_f32_16x16x32_bf16(av, bfb[gq & 1][n], acc[m][nh * 2 + n], 0, 0, 0);
          }
      }
    }
    __syncthreads();
    const int te = get_tid512();
    const int fr_e = te & 15, fq_e = (te & 63) >> 4, wr_e = te >> 7, wc_e = (te >> 6) & 1;
    const int sub = 2 * mt + (wr_e >> 1);
    const int g = sub / tpg, ti = sub - g * tpg;
    const int rig0 = ti * step - halo;
    const int rw = (wr_e & 1) * 64;
    if constexpr (Epi::KIND == 0) {
#pragma unroll
      for (int m = 0; m < 4; ++m) {
        const int rig = rig0 + rw + m * 16 + fr_e;
        if constexpr (Epi::ROWSUM) {
          float ss = 0.f;
#pragma unroll
          for (int n = 0; n < 8; ++n) {
            const int col = nt * 256 + wc_e * 128 + n * 16 + fq_e * 4;
            if (col < N) ss += epi.c4(g, rig, col, acc[m][n]);
          }
          ss += __shfl_xor(ss, 16); ss += __shfl_xor(ss, 32);
          if (fq_e == 0) epi.rowsum(g, rig, nt * 2 + wc_e, ss);
        } else {
#pragma unroll
          for (int n = 0; n < 8; ++n) {
            const int col = nt * 256 + wc_e * 128 + n * 16 + fq_e * 4;
            if (col < N) epi.c4(g, rig, col, acc[m][n]);
          }
        }
      }
    } else if constexpr (Epi::KIND == 1) {
#pragma unroll
      for (int m = 0; m < 4; ++m) {
        const int rig = rig0 + rw + m * 16 + fq_e * 4;
#pragma unroll
        for (int n = 0; n < 8; ++n) {
          const int col = nt * 256 + wc_e * 128 + n * 16 + fr_e;
          if (col < N) epi.r4(g, rig, col, acc[m][n]);
        }
      }
    } else {
      bf16_t* Zw = (bf16_t*)smem + ((wr_e >> 1) * 2 + wc_e) * (128 * 132);
      const int nt2w = nt * 2 + wc_e;
#pragma unroll
      for (int n = 0; n < 8; ++n) {
        const int cl = n * 16 + fq_e * 4;
        f32x4 b4 = {0.f, 0.f, 0.f, 0.f};
        if (epi.pre_bias) b4 = *(const f32x4*)(epi.pre_bias + epi.norig(nt2w, cl));
#pragma unroll
        for (int m = 0; m < 4; ++m) {
          const int rl = rw + m * 16 + fr_e;
          const int pos = rig0 + rl;
          const bool ok = pos >= 0 && pos < grows;
          f32x4 vv = acc[m][n] + b4;
          if (!ok) vv = (f32x4){0.f, 0.f, 0.f, 0.f};
          uint2 u; u.x = pack2(vv[0], vv[1]); u.y = pack2(vv[2], vv[3]);
          *(uint2*)(Zw + rl * 132 + cl) = u;
        }
      }
      __syncthreads();
      {
        auto no_pre = []() {};
        const bf16_t* Zr = (const bf16_t*)smem + ((wr_e >> 1) * 2) * (128 * 132);
        epi.finish(Zr, g, rig0, nt * 2, no_pre);
        epi.finish(Zr + 128 * 132, g, rig0, nt * 2 + 1, no_pre);
      }
      __syncthreads();
    }
    asm volatile("s_waitcnt vmcnt(0)" ::: "memory");
    __syncthreads();
  }
}

__device__ __forceinline__ void phase_attn(CP& p, char* smem, int vid0, int grid) {
  bf16_t* Ks = (bf16_t*)smem;
  bf16_t* Vs = (bf16_t*)(smem + 64 * 104 * 2);
  const int tid = get_tid(), lane = tid & 63, w = tid >> 6, r = lane & 31, hh = lane >> 5;
  const float cs = 1.4426950408889634f * 0.10206207261596577f;
  for (int it = vid0; it < 2048; it += grid) {
    const int qt = it & 15, h = (it >> 4) & 15, b = it >> 8;
    const int t = qt * 128 + w * 32 + r;
    const size_t xrow = (size_t)b * 2048 + t;
    const bf16_t* qp = p.Q + xrow * 1536 + h * 96;
    bf16x8 qf[6];
#pragma unroll
    for (int kk = 0; kk < 4; ++kk) qf[kk] = *(const bf16x8*)(qp + 16 * kk + 8 * hh);
#pragma unroll
    for (int part = 0; part < 2; ++part) {
      const bf16_t* pp = qp + 64 + 16 * part;
      const bf16x8 mine = *(const bf16x8*)(pp + 8 * hh), oth = *(const bf16x8*)(pp + 8 * (1 - hh));
      const float posf = part == 0 ? (float)(t >> 6) : (float)(t & 63);
      union { unsigned u[4]; bf16x8 v; } o;
      float res[8];
#pragma unroll
      for (int j = 0; j < 8; ++j) {
        const float inv = exp2f(-(float)j * (13.287712379549449f / 8.0f));
        const float ang = posf * inv;
        const float c = __cosf(ang), s = __sinf(ang);
        const float m = bf2f((bf16_t)mine[j]), ov = bf2f((bf16_t)oth[j]);
        res[j] = m * c + (hh ? ov : -ov) * s;
      }
#pragma unroll
      for (int j = 0; j < 4; ++j) o.u[j] = pack2(res[2 * j], res[2 * j + 1]);
      qf[4 + part] = o.v;
    }
    f32x16 oacc[2];
#pragma unroll
    for (int i = 0; i < 16; ++i) { oacc[0][i] = 0.f; oacc[1][i] = 0.f; }
    float mrun = -INFINITY, lrun = 0.f;
    const size_t kvrow0 = (size_t)b * 2304;
    const bf16_t* kn_base = p.Kn + kvrow0 * 1024 + h * 64;
    const bf16_t* kpe_base = p.kpe + kvrow0 * 32;
    const bf16_t* vt_base = p.Vt + ((size_t)(b * 16 + h) * 64) * 2304;
    uint4 rk0, rk1, rp, rv0, rv1;
    const int srow = tid >> 3, sch = tid & 7;
#define ATT_GLOAD(kt) do { \
      rk0 = *(const uint4*)(kn_base + (size_t)((kt) * 64 + srow) * 1024 + sch * 8); \
      rk1 = *(const uint4*)(kn_base + (size_t)((kt) * 64 + srow + 32) * 1024 + sch * 8); \
      rv0 = *(const uint4*)(vt_base + (size_t)srow * 2304 + (kt) * 64 + sch * 8); \
      rv1 = *(const uint4*)(vt_base + (size_t)(srow + 32) * 2304 + (kt) * 64 + sch * 8); \
      rp = *(const uint4*)(kpe_base + (size_t)((kt) * 64 + (tid >> 2)) * 32 + (tid & 3) * 8); } while (0)
    ATT_GLOAD(0);
    for (int kt = 0; kt < 36; ++kt) {
      __syncthreads();
      {
        *(uint4*)(Ks + srow * 104 + sch * 8) = rk0;
        *(uint4*)(Ks + (srow + 32) * 104 + sch * 8) = rk1;
        uint2 lo, hi;
        lo.x = rv0.x; lo.y = rv0.y; hi.x = rv0.z; hi.y = rv0.w;
        *(uint2*)(Vs + srow * 68 + sch * 8) = lo; *(uint2*)(Vs + srow * 68 + sch * 8 + 4) = hi;
        lo.x = rv1.x; lo.y = rv1.y; hi.x = rv1.z; hi.y = rv1.w;
        *(uint2*)(Vs + (srow + 32) * 68 + sch * 8) = lo; *(uint2*)(Vs + (srow + 32) * 68 + sch * 8 + 4) = hi;
      }
      *(uint4*)(Ks + (tid >> 2) * 104 + 64 + (tid & 3) * 8) = rp;
      __syncthreads();
      if (kt + 1 < 36) ATT_GLOAD(kt + 1);
      f32x16 s[2];
#pragma unroll
      for (int t2 = 0; t2 < 2; ++t2) {
#pragma unroll
        for (int i = 0; i < 16; ++i) s[t2][i] = 0.f;
#pragma unroll
        for (int kk = 0; kk < 6; ++kk) {
          const bf16x8 a = *(const bf16x8*)(Ks + (32 * t2 + r) * 104 + 16 * kk + 8 * hh);
          s[t2] = __builtin_amdgcn_mfma_f32_32x32x16_bf16(a, qf[kk], s[t2], 0, 0, 0);
        }
      }
      float mx = s[0][0];
#pragma unroll
      for (int i = 1; i < 16; ++i) mx = fmaxf(mx, s[0][i]);
#pragma unroll
      for (int i = 0; i < 16; ++i) mx = fmaxf(mx, s[1][i]);
      mx = fmaxf(mx, __shfl_xor(mx, 32));
      const float mcand = mx * cs;
      if (__builtin_amdgcn_ballot_w64(mcand > mrun + 6.0f) != 0ull) {
        const float mnew_ = fmaxf(mrun, mcand);
        const float alpha = __builtin_amdgcn_exp2f(mrun - mnew_);
        mrun = mnew_;
        lrun *= alpha;
#pragma unroll
        for (int i = 0; i < 16; ++i) { oacc[0][i] *= alpha; oacc[1][i] *= alpha; }
      }
      const float mnew = mrun;
      float psum = 0.f;
      bf16x8 pf[4];
#pragma unroll
      for (int t2 = 0; t2 < 2; ++t2)
#pragma unroll
        for (int hf = 0; hf < 2; ++hf) {
          union { unsigned u[4]; bf16x8 v; } cvp;
#pragma unroll
          for (int i = 0; i < 4; ++i) {
            const float p0 = __builtin_amdgcn_exp2f(s[t2][hf * 8 + 2 * i] * cs - mnew);
            const float p1 = __builtin_amdgcn_exp2f(s[t2][hf * 8 + 2 * i + 1] * cs - mnew);
            psum += p0 + p1;
            cvp.u[i] = pack2(p0, p1);
          }
          pf[t2 * 2 + hf] = cvp.v;
        }
      lrun += psum;
#pragma unroll
      for (int dt = 0; dt < 2; ++dt)
#pragma unroll
        for (int s4 = 0; s4 < 4; ++s4) {
          const bf16_t* vp = Vs + (32 * dt + r) * 68 + 16 * s4 + 4 * hh;
          const uint2 lo = *(const uint2*)vp, hi = *(const uint2*)(vp + 8);
          union { uint4 u; bf16x8 v; } cv; cv.u.x = lo.x; cv.u.y = lo.y; cv.u.z = hi.x; cv.u.w = hi.y;
          oacc[dt] = __builtin_amdgcn_mfma_f32_32x32x16_bf16(cv.v, pf[s4], oacc[dt], 0, 0, 0);
        }
    }
    const float ltot = lrun + __shfl_xor(lrun, 32);
    const float inv = 1.f / ltot;
    bf16_t* op = p.hxc + xrow * 1024 + h * 64;
#pragma unroll
    for (int dt = 0; dt < 2; ++dt)
#pragma unroll
      for (int i4 = 0; i4 < 4; ++i4) {
        const int d = 32 * dt + 8 * i4 + 4 * hh;
        uint2 u; u.x = pack2(oacc[dt][4 * i4] * inv, oacc[dt][4 * i4 + 1] * inv); u.y = pack2(oacc[dt][4 * i4 + 2] * inv, oacc[dt][4 * i4 + 3] * inv);
        *(uint2*)(op + d) = u;
      }
  }
}

__device__ __forceinline__ void phase_hyconv(CP& p, char* smem) {
  bf16_t* cp = (bf16_t*)smem;
  bf16_t* Vl = (bf16_t*)(smem + 4 * 8256);
  const int tid = get_tid(), lane = tid & 63, w = tid >> 6, i16 = lane & 15, g4 = lane >> 4;
  const int si = (-i16) & 3;
  const int ocb = 64 * w;
  for (int c = get_bid(); c < 1024; c += VGRID) {
    __syncthreads();
#pragma unroll
    for (int i = 0; i < 2; ++i) { const int ch = tid + 256 * i; *(uint4*)(cp + ch * 8) = *(const uint4*)(p.Rf + (size_t)c * 4096 + ch * 8); }
#pragma unroll
    for (int i = 0; i < 8; ++i) {
      const int q = tid + 256 * i; const int b = q >> 8, l8 = q & 255; const int m1 = l8 >> 3, m2 = (l8 & 7) * 8;
      *(uint4*)(Vl + (8 + m1 * 8 + b) * 80 + m2) = *(const uint4*)(p.vvT + (size_t)c * 16384 + b * 2048 + l8 * 8);
    }
    if (tid < 144) {
      const int colp = tid / 9, part = tid - colp * 9;
      const int col = colp < 8 ? colp : 256 + colp;
      uint4 zz; zz.x = 0; zz.y = 0; zz.z = 0; zz.w = 0;
      *(uint4*)(Vl + col * 80 + part * 8) = zz;
    }
    __syncthreads();
#pragma unroll
    for (int s = 1; s < 4; ++s)
#pragma unroll
      for (int i = 0; i < 2; ++i) {
        const int ch = tid + 256 * i;
        unsigned e[8];
#pragma unroll
        for (int j = 0; j < 8; ++j) { const int idx = 8 * ch + s + j; e[j] = idx < 4096 ? (unsigned)cp[idx] : 0u; }
        uint4 u; u.x = e[0] | (e[1] << 16); u.y = e[2] | (e[3] << 16); u.z = e[4] | (e[5] << 16); u.w = e[6] | (e[7] << 16);
        *(uint4*)(cp + s * 4128 + 8 * ch) = u;
      }
    __syncthreads();
    const bf16_t* abase = cp + si * 4128 + (2048 - i16 - si + 8 * g4);
    f32x4 acc[4][4];
#pragma unroll
    for (int m = 0; m < 4; ++m)
#pragma unroll
      for (int n = 0; n < 4; ++n) acc[m][n] = (f32x4){0.f, 0.f, 0.f, 0.f};
    for (int dl = -31; dl <= 31; ++dl) {
      bf16x8 af[4][2];
#pragma unroll
      for (int mt = 0; mt < 4; ++mt)
#pragma unroll
        for (int kk = 0; kk < 2; ++kk) {
          const bf16_t* ap = abase - 64 * dl - 16 * mt + 32 * kk;
          const uint2 lo = *(const uint2*)ap, hi = *(const uint2*)(ap + 4);
          union { uint4 u; bf16x8 v; } cv; cv.u.x = lo.x; cv.u.y = lo.y; cv.u.z = hi.x; cv.u.w = hi.y;
          af[mt][kk] = cv.v;
        }
#pragma unroll
      for (int jt = 0; jt < 4; ++jt) {
        const int in0 = ocb + 16 * jt - 8 * dl;
        if (in0 >= -8 && in0 <= 248) {
          const bf16_t* bp = Vl + (in0 + 8 + i16) * 80 + 8 * g4;
          const bf16x8 b0 = *(const bf16x8*)bp, b1 = *(const bf16x8*)(bp + 32);
#pragma unroll
          for (int mt = 0; mt < 4; ++mt) {
            acc[mt][jt] = __builtin_amdgcn_mfma_f32_16x16x32_bf16(af[mt][0], b0, acc[mt][jt], 0, 0, 0);
            acc[mt][jt] = __builtin_amdgcn_mfma_f32_16x16x32_bf16(af[mt][1], b1, acc[mt][jt], 0, 0, 0);
          }
        }
      }
    }
    const float db = p.hy_d_bias[c];
#pragma unroll
    for (int mt = 0; mt < 4; ++mt)
#pragma unroll
      for (int jt = 0; jt < 4; ++jt) {
        const int col = ocb + 16 * jt + i16;
        const int n1 = col >> 3, b = col & 7;
        const int n2 = 16 * mt + 4 * g4;
        const uint2 vv = *(const uint2*)(Vl + (col + 8) * 80 + n2);
        const float y0 = acc[mt][jt][0] + bf2f((bf16_t)(vv.x & 0xffff)) * db;
        const float y1 = acc[mt][jt][1] + bf2f((bf16_t)(vv.x >> 16)) * db;
        const float y2 = acc[mt][jt][2] + bf2f((bf16_t)(vv.y & 0xffff)) * db;
        const float y3 = acc[mt][jt][3] + bf2f((bf16_t)(vv.y >> 16)) * db;
        uint2 u; u.x = pack2(y0, y1); u.y = pack2(y2, y3);
        *(uint2*)(p.Yp + (size_t)c * 16384 + b * 2048 + n1 * 64 + n2) = u;
      }
  }
}

__device__ __forceinline__ void phase_transmul(CP& p, char* smem) {
  bf16_t* tl = (bf16_t*)smem;
  const int tid = get_tid();
  for (int it = get_bid(); it < 4096; it += VGRID) {
    const int ct = it & 15, rt = it >> 4;
    const int c0 = ct * 64, r0 = rt * 64;
    __syncthreads();
#pragma unroll
    for (int i = 0; i < 2; ++i) {
      const int ci = tid + 256 * i; const int cc = ci >> 3, ch = ci & 7;
      const uint4 u = *(const uint4*)(p.Yp + (size_t)(c0 + cc) * 16384 + r0 + ch * 8);
      unsigned* d = (unsigned*)(tl + cc * 66 + ch * 8);
      d[0] = u.x; d[1] = u.y; d[2] = u.z; d[3] = u.w;
    }
    __syncthreads();
    const int row = tid >> 2, cq = tid & 3;
    const bf16_t* xp = p.x1h + (size_t)(r0 + row) * 1024 + c0 + cq * 16;
    const uint4 xa = *(const uint4*)xp, xb = *(const uint4*)(xp + 8);
    const unsigned xs[8] = {xa.x, xa.y, xa.z, xa.w, xb.x, xb.y, xb.z, xb.w};
    unsigned o[8];
#pragma unroll
    for (int j = 0; j < 8; ++j) {
      const float y0 = bf2f(tl[(cq * 16 + 2 * j) * 66 + row]) * bf2f((bf16_t)(xs[j] & 0xffff));
      const float y1 = bf2f(tl[(cq * 16 + 2 * j + 1) * 66 + row]) * bf2f((bf16_t)(xs[j] >> 16));
      o[j] = pack2(y0, y1);
    }
    bf16_t* op = p.hxc + (size_t)(r0 + row) * 1024 + c0 + cq * 16;
    uint4 oa; oa.x = o[0]; oa.y = o[1]; oa.z = o[2]; oa.w = o[3];
    uint4 ob; ob.x = o[4]; ob.y = o[5]; ob.z = o[6]; ob.w = o[7];
    *(uint4*)op = oa; *(uint4*)(op + 8) = ob;
  }
}

__global__ void __launch_bounds__(512, 2) mega(P p_arg) {
  __shared__ __attribute__((aligned(16))) char smem[LDS_BYTES];
  cg::grid_group grid = cg::this_grid();
  const int G = gridDim.x;
  CP* pp = (CP*)__builtin_amdgcn_kernarg_segment_ptr();
  const int ph0 = pp->ph0, ph1 = pp->ph1;
  volatile LAS unsigned* xst = (volatile LAS unsigned*)(smem + LDS_BYTES - 16);
  if (threadIdx.x == 0) { xst[0] = 0u; xst[1] = 0u; }
  __syncthreads();
  const XcdBarrier xb = xcd_barrier_post(pp->bar, xst);
  if (ph0 <= 0 && 0 < ph1) {
    asm volatile("" : "+s"(pp));
    CP& p = *pp;
    const int bid = get_rbid();
    const int vid0 = (G & 7) ? bid : ((bid & 7) * (G >> 3) + (bid >> 3));
    const int hb = get_hb();
    char* smem_h = smem + hb * HALF_LDS; (void)smem_h;
    const float* mv0 = p.modv; const float* mv1 = p.modv + (size_t)9 * 6144;
    (void)mv0; (void)mv1; (void)vid0;
    phase_prep(p, smem_h);
    if (0 + 1 < ph1) { if (ph1 > 1000) grid.sync(); else xcd_barrier(xb); }
  }
  if (ph0 <= 1 && 1 < ph1) {
    asm volatile("" : "+s"(pp));
    CP& p = *pp;
    const int bid = get_rbid();
    const int vid0 = (G & 7) ? bid : ((bid & 7) * (G >> 3) + (bid >> 3));
    const int hb = get_hb();
    char* smem_h = smem + hb * HALF_LDS; (void)smem_h;
    const float* mv0 = p.modv; const float* mv1 = p.modv + (size_t)9 * 6144;
    (void)mv0; (void)mv1; (void)vid0;
    phase_normmod_kv(p);
    if (1 + 1 < ph1) { if (ph1 > 1000) grid.sync(); else xcd_barrier(xb); }
  }
  if (ph0 <= 2 && 2 < ph1) {
    asm volatile("" : "+s"(pp));
    CP& p = *pp;
    const int bid = get_rbid();
    const int vid0 = (G & 7) ? bid : ((bid & 7) * (G >> 3) + (bid >> 3));
    const int hb = get_hb();
    char* smem_h = smem + hb * HALF_LDS; (void)smem_h;
    const float* mv0 = p.modv; const float* mv1 = p.modv + (size_t)9 * 6144;
    (void)mv0; (void)mv1; (void)vid0;
    {
        EpiDown e1{p.cq, 512, 2048, p.rq, 4, nullptr, 1 << 30};
        gemm_job<true>(smem, p.hxc, 1024, p.wt_dq, 1024, 512, 16, 2304, 256, 128, 0, 2048, 128, 0, vid0, G, e1);
        EpiDown e2{p.kv, 288, 2304, p.rkv, 2, p.kpe, 256};
        gemm_job<true>(smem, p.hxc, 1024, p.wt_dkv, 1024, 288, 18, 2304, 0, 128, 0, 2304, 144, 64 * 2, vid0, G, e2);
        EpiFilt e3{p.Rf, p.hy_decay};
        gemm_job<false>(smem, p.h2bf, 64, p.wt_f3, 64, 2048, 16, 0, 0, 128, 0, 2048, 16, 64 * 2 + 72 * 2, vid0, G, e3);
      }
    if (2 + 1 < ph1) { if (ph1 > 1000) grid.sync(); else xcd_barrier(xb); }
  }
  if (ph0 <= 4 && 4 < ph1) {
    asm volatile("" : "+s"(pp));
    CP& p = *pp;
    const int bid = get_rbid();
    const int vid0 = (G & 7) ? bid : ((bid & 7) * (G >> 3) + (bid >> 3));
    const int hb = get_hb();
    char* smem_h = smem + hb * HALF_LDS; (void)smem_h;
    const float* mv0 = p.modv; const float* mv1 = p.modv + (size_t)9 * 6144;
    (void)mv0; (void)mv1; (void)vid0;
    {
        EpiStore<4> e1{p.Q, 1536, 2048, p.rq, 16384, 1.0f / 512.0f};
        gemm_job<true>(smem, p.cq, 512, p.wt_uq, 512, 1536, 16, 2048, 0, 128, 0, 2048, 128, 0, vid0, G, e1);
        EpiStore<2> e2{p.Kn, 1024, 2304, p.rkv, 18432, 1.0f / 256.0f};
        gemm_job<true>(smem, p.kv, 288, p.wt_uk, 256, 1024, 18, 2304, 0, 128, 0, 2304, 144, 64 * 6, vid0, G, e2);
        EpiVt e3{p.Vt, p.rkv};
        gemm_job<false>(smem, p.kv, 288, p.wt_uv, 256, 1024, 18, 2304, 0, 128, 0, 2304, 144, 64 * 6 + 72 * 4, vid0, G, e3);
      }
    if (4 + 1 < ph1) { if (ph1 > 1000) grid.sync(); else xcd_barrier(xb); }
  }
  if (ph0 <= 5 && 5 < ph1) {
    asm volatile("" : "+s"(pp));
    CP& p = *pp;
    const int bid = get_rbid();
    const int vid0 = (G & 7) ? bid : ((bid & 7) * (G >> 3) + (bid >> 3));
    const int hb = get_hb();
    char* smem_h = smem + hb * HALF_LDS; (void)smem_h;
    const float* mv0 = p.modv; const float* mv1 = p.modv + (size_t)9 * 6144;
    (void)mv0; (void)mv1; (void)vid0;
    phase_attn(p, smem_h, 2 * vid0 + hb, 2 * G);
    if (5 + 1 < ph1) { if (ph1 > 1000) grid.sync(); else xcd_barrier(xb); }
  }
  if (ph0 <= 6 && 6 < ph1) {
    asm volatile("" : "+s"(pp));
    CP& p = *pp;
    const int bid = get_rbid();
    const int vid0 = (G & 7) ? bid : ((bid & 7) * (G >> 3) + (bid >> 3));
    const int hb = get_hb();
    char* smem_h = smem + hb * HALF_LDS; (void)smem_h;
    const float* mv0 = p.modv; const float* mv1 = p.modv + (size_t)9 * 6144;
    (void)mv0; (void)mv1; (void)vid0;
    {
        EpiResid<true> e{p.X16, p.x, mv0 + 2 * 1024, nullptr};
        gemm_job<true>(smem, p.hxc, 1024, p.wt_o, 1024, 1024, 16, 2048, 0, 128, 0, 2048, 128, 0, vid0, G, e);
      }
    if (6 + 1 < ph1) { if (ph1 > 1000) grid.sync(); else xcd_barrier(xb); }
  }
  if (ph0 <= 7 && 7 < ph1) {
    asm volatile("" : "+s"(pp));
    CP& p = *pp;
    const int bid = get_rbid();
    const int vid0 = (G & 7) ? bid : ((bid & 7) * (G >> 3) + (bid >> 3));
    const int hb = get_hb();
    char* smem_h = smem + hb * HALF_LDS; (void)smem_h;
    const float* mv0 = p.modv; const float* mv1 = p.modv + (size_t)9 * 6144;
    (void)mv0; (void)mv1; (void)vid0;
    phase_normmod_x(p, p.norm_ffn_g, 0, 3);
    if (7 + 1 < ph1) { if (ph1 > 1000) grid.sync(); else xcd_barrier(xb); }
  }
  if (ph0 <= 8 && 8 < ph1) {
    asm volatile("" : "+s"(pp));
    CP& p = *pp;
    const int bid = get_rbid();
    const int vid0 = (G & 7) ? bid : ((bid & 7) * (G >> 3) + (bid >> 3));
    const int hb = get_hb();
    char* smem_h = smem + hb * HALF_LDS; (void)smem_h;
    const float* mv0 = p.modv; const float* mv1 = p.modv + (size_t)9 * 6144;
    (void)mv0; (void)mv1; (void)vid0;
    {
        EpiConv<0> e{p.ffn_conv_w, p.ffn_conv_b, 5632, nullptr, p.act, nullptr};
        gemm_job<true>(smem, p.hxc, 1024, p.wt_up0, 1024, 5632, 17, 2048, 0, 126, 1, 2048, 136, 0, vid0, G, e);
      }
    if (8 + 1 < ph1) { if (ph1 > 1000) grid.sync(); else xcd_barrier(xb); }
  }
  if (ph0 <= 9 && 9 < ph1) {
    asm volatile("" : "+s"(pp));
    CP& p = *pp;
    const int bid = get_rbid();
    const int vid0 = (G & 7) ? bid : ((bid & 7) * (G >> 3) + (bid >> 3));
    const int hb = get_hb();
    char* smem_h = smem + hb * HALF_LDS; (void)smem_h;
    const float* mv0 = p.modv; const float* mv1 = p.modv + (size_t)9 * 6144;
    (void)mv0; (void)mv1; (void)vid0;
    {
        EpiResid<false> e{p.X16, p.X16, mv0 + 5 * 1024, nullptr};
        gemm_job<true>(smem, p.act, 2816, p.wt_dn0, 2816, 1024, 16, 2048, 0, 128, 0, 2048, 128, 0, vid0, G, e);
      }
    if (9 + 1 < ph1) { if (ph1 > 1000) grid.sync(); else xcd_barrier(xb); }
  }
  if (ph0 <= 10 && 10 < ph1) {
    asm volatile("" : "+s"(pp));
    CP& p = *pp;
    const int bid = get_rbid();
    const int vid0 = (G & 7) ? bid : ((bid & 7) * (G >> 3) + (bid >> 3));
    const int hb = get_hb();
    char* smem_h = smem + hb * HALF_LDS; (void)smem_h;
    const float* mv0 = p.modv; const float* mv1 = p.modv + (size_t)9 * 6144;
    (void)mv0; (void)mv1; (void)vid0;
    phase_normmod_x(p, p.norm_mix_g + 1024, 1, 0);
    if (10 + 1 < ph1) { if (ph1 > 1000) grid.sync(); else xcd_barrier(xb); }
  }
  if (ph0 <= 11 && 11 < ph1) {
    asm volatile("" : "+s"(pp));
    CP& p = *pp;
    const int bid = get_rbid();
    const int vid0 = (G & 7) ? bid : ((bid & 7) * (G >> 3) + (bid >> 3));
    const int hb = get_hb();
    char* smem_h = smem + hb * HALF_LDS; (void)smem_h;
    const float* mv0 = p.modv; const float* mv1 = p.modv + (size_t)9 * 6144;
    (void)mv0; (void)mv1; (void)vid0;
    {
        EpiConv<1> e{p.hy_conv_w, p.hy_conv_b, 3072, p.hy_b_in, p.x1h, p.vvT};
        gemm_job<true>(smem, p.hxc, 1024, p.wt_hin, 1024, 3072, 17, 2048, 0, 126, 1, 2048, 136, 0, vid0, G, e);
      }
    if (11 + 1 < ph1) { if (ph1 > 1000) grid.sync(); else xcd_barrier(xb); }
  }
  if (ph0 <= 12 && 12 < ph1) {
    asm volatile("" : "+s"(pp));
    CP& p = *pp;
    const int bid = get_rbid();
    const int vid0 = (G & 7) ? bid : ((bid & 7) * (G >> 3) + (bid >> 3));
    const int hb = get_hb();
    char* smem_h = smem + hb * HALF_LDS; (void)smem_h;
    const float* mv0 = p.modv; const float* mv1 = p.modv + (size_t)9 * 6144;
    (void)mv0; (void)mv1; (void)vid0;
    phase_hyconv(p, smem_h);
    if (12 + 1 < ph1) { if (ph1 > 1000) grid.sync(); else xcd_barrier(xb); }
  }
  if (ph0 <= 13 && 13 < ph1) {
    asm volatile("" : "+s"(pp));
    CP& p = *pp;
    const int bid = get_rbid();
    const int vid0 = (G & 7) ? bid : ((bid & 7) * (G >> 3) + (bid >> 3));
    const int hb = get_hb();
    char* smem_h = smem + hb * HALF_LDS; (void)smem_h;
    const float* mv0 = p.modv; const float* mv1 = p.modv + (size_t)9 * 6144;
    (void)mv0; (void)mv1; (void)vid0;
    phase_transmul(p, smem_h);
    if (13 + 1 < ph1) { if (ph1 > 1000) grid.sync(); else xcd_barrier(xb); }
  }
  if (ph0 <= 14 && 14 < ph1) {
    asm volatile("" : "+s"(pp));
    CP& p = *pp;
    const int bid = get_rbid();
    const int vid0 = (G & 7) ? bid : ((bid & 7) * (G >> 3) + (bid >> 3));
    const int hb = get_hb();
    char* smem_h = smem + hb * HALF_LDS; (void)smem_h;
    const float* mv0 = p.modv; const float* mv1 = p.modv + (size_t)9 * 6144;
    (void)mv0; (void)mv1; (void)vid0;
    {
        EpiResid<false> e{p.X16, p.X16, mv1 + 2 * 1024, p.hy_b_out};
        gemm_job<true>(smem, p.hxc, 1024, p.wt_hout, 1024, 1024, 16, 2048, 0, 128, 0, 2048, 128, 0, vid0, G, e);
      }
    if (14 + 1 < ph1) { if (ph1 > 1000) grid.sync(); else xcd_barrier(xb); }
  }
  if (ph0 <= 15 && 15 < ph1) {
    asm volatile("" : "+s"(pp));
    CP& p = *pp;
    const int bid = get_rbid();
    const int vid0 = (G & 7) ? bid : ((bid & 7) * (G >> 3) + (bid >> 3));
    const int hb = get_hb();
    char* smem_h = smem + hb * HALF_LDS; (void)smem_h;
    const float* mv0 = p.modv; const float* mv1 = p.modv + (size_t)9 * 6144;
    (void)mv0; (void)mv1; (void)vid0;
    phase_normmod_x(p, p.norm_ffn_g + 1024, 1, 3);
    if (15 + 1 < ph1) { if (ph1 > 1000) grid.sync(); else xcd_barrier(xb); }
  }
  if (ph0 <= 16 && 16 < ph1) {
    asm volatile("" : "+s"(pp));
    CP& p = *pp;
    const int bid = get_rbid();
    const int vid0 = (G & 7) ? bid : ((bid & 7) * (G >> 3) + (bid >> 3));
    const int hb = get_hb();
    char* smem_h = smem + hb * HALF_LDS; (void)smem_h;
    const float* mv0 = p.modv; const float* mv1 = p.modv + (size_t)9 * 6144;
    (void)mv0; (void)mv1; (void)vid0;
    {
        EpiConv<0> e{p.ffn_conv_w + (size_t)3 * 5632, p.ffn_conv_b + 5632, 5632, nullptr, p.act, nullptr};
        gemm_job<true>(smem, p.hxc, 1024, p.wt_up1, 1024, 5632, 17, 2048, 0, 126, 1, 2048, 136, 0, vid0, G, e);
      }
    if (16 + 1 < ph1) { if (ph1 > 1000) grid.sync(); else xcd_barrier(xb); }
  }
  if (ph0 <= 17 && 17 < ph1) {
    asm volatile("" : "+s"(pp));
    CP& p = *pp;
    const int bid = get_rbid();
    const int vid0 = (G & 7) ? bid : ((bid & 7) * (G >> 3) + (bid >> 3));
    const int hb = get_hb();
    char* smem_h = smem + hb * HALF_LDS; (void)smem_h;
    const float* mv0 = p.modv; const float* mv1 = p.modv + (size_t)9 * 6144;
    (void)mv0; (void)mv1; (void)vid0;
    {
        EpiResid<false> e{p.X16, p.X16, mv1 + 5 * 1024, nullptr};
        gemm_job<true>(smem, p.act, 2816, p.wt_dn1, 2816, 1024, 16, 2048, 0, 128, 0, 2048, 128, 0, vid0, G, e);
      }
    if (17 + 1 < ph1) { if (ph1 > 1000) grid.sync(); else xcd_barrier(xb); }
  }
  if (ph0 <= 18 && 18 < ph1) {
    asm volatile("" : "+s"(pp));
    CP& p = *pp;
    const int bid = get_rbid();
    const int vid0 = (G & 7) ? bid : ((bid & 7) * (G >> 3) + (bid >> 3));
    const int hb = get_hb();
    char* smem_h = smem + hb * HALF_LDS; (void)smem_h;
    const float* mv0 = p.modv; const float* mv1 = p.modv + (size_t)9 * 6144;
    (void)mv0; (void)mv1; (void)vid0;
    phase_final_norm(p);
    if (18 + 1 < ph1) { if (ph1 > 1000) grid.sync(); else xcd_barrier(xb); }
  }
}

extern "C" void kernel_launch(void* const* d_in, const int* in_sizes, int n_in, void* d_out, int out_size, void* d_ws, size_t ws_size, hipStream_t stream) {
  static int grid_blocks = 0;
  if (!grid_blocks) {
    int dev = 0, cus = 0, per_cu = 0;
    hipGetDevice(&dev);
    hipDeviceGetAttribute(&cus, hipDeviceAttributeMultiprocessorCount, dev);
    hipOccupancyMaxActiveBlocksPerMultiprocessor(&per_cu, (const void*)mega, 512, 0);
    per_cu = 1;
    grid_blocks = cus * per_cu;
  }
  P p{};
  const float** in = (const float**)&p;
  for (int i = 0; i < 36; ++i) in[i] = (const float*)d_in[i];
  p.X = (float*)d_out;
  char* ws = (char*)d_ws; size_t off = 0;
  auto take = [&](size_t bytes) { char* r = ws + off; off += (bytes + 255) & ~(size_t)255; return r; };
  p.wt_dq = (bf16_t*)take((size_t)512 * 1024 * 2);
  p.wt_dkv = (bf16_t*)take((size_t)288 * 1024 * 2);
  p.wt_uq = (bf16_t*)take((size_t)1536 * 512 * 2);
  p.wt_uk = (bf16_t*)take((size_t)1024 * 256 * 2);
  p.wt_uv = (bf16_t*)take((size_t)1024 * 256 * 2);
  p.wt_o = (bf16_t*)take((size_t)1024 * 1024 * 2);
  p.wt_hin = (bf16_t*)take((size_t)3072 * 1024 * 2);
  p.wt_hout = (bf16_t*)take((size_t)1024 * 1024 * 2);
  p.wt_up0 = (bf16_t*)take((size_t)5632 * 1024 * 2);
  p.wt_up1 = (bf16_t*)take((size_t)5632 * 1024 * 2);
  p.wt_dn0 = (bf16_t*)take((size_t)1024 * 2816 * 2);
  p.wt_dn1 = (bf16_t*)take((size_t)1024 * 2816 * 2);
  p.modv = (float*)take((size_t)2 * 9 * 6144 * 4);
  p.rq = (float*)take((size_t)4 * 16384 * 4);
  p.rkv = (float*)take((size_t)2 * 18432 * 4);
  p.modp = (float*)take((size_t)4 * 110592 * 4);
  p.bar = (unsigned*)take((size_t)XCD_BAR_WORDS * 4);
  p.wt_f3 = (bf16_t*)take((size_t)2048 * 64 * 2);
  p.h2bf = (bf16_t*)take((size_t)2048 * 64 * 2);
  p.Rf = (bf16_t*)take((size_t)1024 * 4096 * 2);
  p.kpe = (bf16_t*)take((size_t)18432 * 32 * 2);
  p.hxc = (bf16_t*)take((size_t)18432 * 1024 * 2);
  const size_t ubase = off;
  p.cq = (bf16_t*)take((size_t)16384 * 512 * 2);
  p.kv = (bf16_t*)take((size_t)18432 * 288 * 2);
  p.Q = (bf16_t*)take((size_t)16384 * 1536 * 2);
  p.Kn = (bf16_t*)take((size_t)18432 * 1024 * 2);
  p.Vt = (bf16_t*)take((size_t)18432 * 1024 * 2);
  const size_t uend1 = off;
  p.X16 = (bf16_t*)(ws + ubase + (size_t)104857600);
  off = ubase;
  p.act = (bf16_t*)take((size_t)16384 * 2816 * 2);
  off = ubase;
  p.x1h = (bf16_t*)take((size_t)16384 * 1024 * 2);
  p.vvT = (bf16_t*)take((size_t)16384 * 1024 * 2);
  p.Yp = (bf16_t*)take((size_t)16384 * 1024 * 2);
  if (uend1 > ws_size) { fprintf(stderr, "workspace too small: need %zu have %zu\n", uend1, ws_size); return; }
  p.ph0 = 0; p.ph1 = NPHASE;
  if (hipMemsetAsync(p.bar, 0, (size_t)XCD_BAR_WORDS * 4, stream) != hipSuccess) { fprintf(stderr, "memset failed\n"); return; }
  void* args[] = {&p};
  hipError_t e = hipLaunchCooperativeKernel((const void*)mega, dim3(grid_blocks), dim3(512), args, 0, stream);
  if (e != hipSuccess) fprintf(stderr, "cooperative launch failed: %s (grid %d)\n", hipGetErrorString(e), grid_blocks);
}
```

```cpp
#include <hip/hip_runtime.h>
#include <hip/hip_cooperative_groups.h>
#include <cstdio>
namespace cg = cooperative_groups;

typedef unsigned short bf16_t;
typedef short bf16x8 __attribute__((ext_vector_type(8)));
typedef float f32x4 __attribute__((ext_vector_type(4)));
typedef float f32x16 __attribute__((ext_vector_type(16)));

#define LDS_BYTES 163840
#define HALF_LDS 81920
#define NPHASE 19

struct P {
  const float *x, *c, *ctx, *c_ctx, *mod_w, *mod_b, *norm_mix_g, *norm_ffn_g;
  const float *w_dq, *g_q, *w_uq, *w_dkv, *g_kv, *w_uk, *w_uv, *w_o;
  const float *hy_w_in, *hy_b_in, *hy_conv_w, *hy_conv_b, *f_w1, *f_b1, *f_freq1, *f_w2, *f_b2, *f_freq2, *f_w3, *hy_decay, *hy_d_bias, *hy_w_out, *hy_b_out;
  const float *ffn_w_up, *ffn_conv_w, *ffn_conv_b, *ffn_w_down, *final_g;
  float* X;
  bf16_t *wt_dq, *wt_dkv, *wt_uq, *wt_uk, *wt_uv, *wt_o, *wt_hin, *wt_hout, *wt_up0, *wt_up1, *wt_dn0, *wt_dn1;
  float *modv, *rq, *rkv, *modp;
  unsigned* bar;
  bf16_t *wt_f3, *h2bf, *X16;
  bf16_t *Rf, *kpe, *hxc, *cq, *kv, *Q, *Kn, *Vt, *act, *x1h, *vvT, *Yp;
  int ph0, ph1;
};

typedef const __attribute__((address_space(4))) P CP;
__device__ __forceinline__ int get_tid512() { int t = threadIdx.x; asm volatile("" : "+v"(t)); return t; }
__device__ __forceinline__ int get_tid() { int t = threadIdx.x & 255; asm volatile("" : "+v"(t)); return t; }
__device__ __forceinline__ int get_hb() { int t = __builtin_amdgcn_readfirstlane((int)(threadIdx.x >> 8)); asm volatile("" : "+s"(t)); return t; }
__device__ __forceinline__ int get_rbid() { int t = blockIdx.x; asm volatile("" : "+s"(t)); return t; }
__device__ __forceinline__ int get_bid() { return 2 * get_rbid() + get_hb(); }
#define VGRID (2 * (int)gridDim.x)

__device__ __forceinline__ unsigned pack2(float a, float b) { unsigned r; asm("v_cvt_pk_bf16_f32 %0, %1, %2" : "=v"(r) : "v"(a), "v"(b)); return r; }
__device__ __forceinline__ bf16_t f2bf(float f) { return (bf16_t)(pack2(f, f) & 0xffffu); }
__device__ __forceinline__ float bf2f(bf16_t h) { return __uint_as_float(((unsigned)h) << 16); }
__device__ __forceinline__ float wave_sum(float v) {
#pragma unroll
  for (int o = 32; o; o >>= 1) v += __shfl_xor(v, o);
  return v;
}


#define XB_TMO      128
#define XB_XCNT(j)  (256  + 64 * (j))
#define XB_XSUB(j)  (1280 + 64 * (j))
#define XB_XGEN(j)  (2304 + 64 * (j))
#define XB_TOP      3328
#define XB_TOPGEN   3392
#define XCD_BAR_WORDS 3456
#define XB_SPIN_CAP (1u << 18)
#define LAS __attribute__((address_space(3)))
__device__ __forceinline__ unsigned xb_ld(unsigned* p)              { return __hip_atomic_load(p, __ATOMIC_RELAXED, __HIP_MEMORY_SCOPE_AGENT); }
__device__ __forceinline__ unsigned xb_add(unsigned* p, unsigned v) { return __hip_atomic_fetch_add(p, v, __ATOMIC_RELAXED, __HIP_MEMORY_SCOPE_AGENT); }
__device__ __forceinline__ unsigned xb_xcc_id() { return (unsigned)__builtin_amdgcn_s_getreg((3 << 11) | 20) & 0xFu; }
#define XB_SPIN(cond, bar) do { unsigned _sp = 0; while (cond) { __builtin_amdgcn_s_sleep(1); \
    if ((++_sp & 255u) == 0u) { if (xb_ld(&(bar)[XB_TMO])) break; if (_sp > XB_SPIN_CAP) { atomicAdd(&(bar)[XB_TMO], 1u); break; } } } } while (0)
struct XcdBarrier { unsigned* bar; unsigned x; volatile LAS unsigned* st; };
__device__ __forceinline__ XcdBarrier xcd_barrier_post(unsigned* bar, volatile LAS unsigned* st) {
    XcdBarrier b; b.bar = bar; b.x = xb_xcc_id(); b.st = st;
    if (threadIdx.x == 0) (void)xb_add(&bar[XB_XCNT(b.x)], 1u);
    return b;
}
__device__ __forceinline__ void xcd_barrier_complete(unsigned* bar, unsigned x, unsigned& nloc, unsigned& nx) {
    const unsigned G = gridDim.x * gridDim.y * gridDim.z;
    unsigned sum, cnt, mine, sp = 0u;
    for (;;) {
        sum = 0u; cnt = 0u; mine = 0u;
#pragma unroll
        for (unsigned j = 0; j < 16; ++j) { const unsigned c = xb_ld(&bar[XB_XCNT(j)]); sum += c; cnt += (c > 0u) ? 1u : 0u; mine = (j == x) ? c : mine; }
        if (sum == G) break;
        __builtin_amdgcn_s_sleep(1);
        if ((++sp & 255u) == 0u) { if (xb_ld(&bar[XB_TMO])) break; if (sp > XB_SPIN_CAP) { atomicAdd(&bar[XB_TMO], 1u); break; } }
    }
    nloc = mine > 0u ? mine : 1u; nx = cnt > 0u ? cnt : 1u;
}
__device__ __forceinline__ void xcd_barrier(const XcdBarrier& b) {
    asm volatile("s_waitcnt vmcnt(0)" ::: "memory");
    __syncthreads();
    if (threadIdx.x == 0) {
        unsigned* bar = b.bar;
        __builtin_amdgcn_s_waitcnt(0);
        unsigned nloc = b.st[0], nx = b.st[1];
        if (nloc == 0u) { xcd_barrier_complete(bar, b.x, nloc, nx); b.st[0] = nloc; b.st[1] = nx; }
        const unsigned old = xb_add(&bar[XB_XSUB(b.x)], 1u);
        const unsigned gen = old / nloc;
        if (old + 1u == (gen + 1u) * nloc) {
            __builtin_amdgcn_fence(__ATOMIC_RELEASE, "agent");
            asm volatile("s_waitcnt vmcnt(0)" ::: "memory");
            const unsigned og = xb_add(&bar[XB_TOP], 1u);
            const unsigned tg = og / nx;
            if (og + 1u == (tg + 1u) * nx) xb_add(&bar[XB_TOPGEN], 1u);
            else XB_SPIN(xb_ld(&bar[XB_TOPGEN]) == tg, bar);
            __builtin_amdgcn_fence(__ATOMIC_ACQUIRE, "agent");
            xb_add(&bar[XB_XGEN(b.x)], 1u);
            asm volatile("s_waitcnt vmcnt(0)" ::: "memory");
        } else {
            XB_SPIN(xb_ld(&bar[XB_XGEN(b.x)]) == gen, bar);
            __builtin_amdgcn_fence(__ATOMIC_ACQUIRE, "agent");
            asm volatile("s_waitcnt vmcnt(0)" ::: "memory");
        }
    }
    __syncthreads();
}

__device__ __forceinline__ void prep_weight_tile(CP& p, char* smem, int wt) {
  const int tid = get_tid();
  int id = 0;
  {
    const int cnt[13] = {64, 40, 96, 32, 32, 128, 384, 128, 704, 704, 352, 352, 32};
#pragma unroll
    for (int i = 0; i < 12; ++i) { if (id == i && wt >= cnt[i]) { wt -= cnt[i]; id = i + 1; } }
  }
  const float* src; int K, N; bf16_t* dst; const float* scale = nullptr; int perm = 0;
  switch (id) {
    case 0: src = p.w_dq; K = 1024; N = 512; dst = p.wt_dq; break;
    case 1: src = p.w_dkv; K = 1024; N = 288; dst = p.wt_dkv; break;
    case 2: src = p.w_uq; K = 512; N = 1536; dst = p.wt_uq; scale = p.g_q; break;
    case 3: src = p.w_uk; K = 256; N = 1024; dst = p.wt_uk; scale = p.g_kv; break;
    case 4: src = p.w_uv; K = 256; N = 1024; dst = p.wt_uv; scale = p.g_kv; break;
    case 5: src = p.w_o; K = 1024; N = 1024; dst = p.wt_o; break;
    case 6: src = p.hy_w_in; K = 1024; N = 3072; dst = p.wt_hin; break;
    case 7: src = p.hy_w_out; K = 1024; N = 1024; dst = p.wt_hout; break;
    case 8: src = p.ffn_w_up; K = 1024; N = 5632; dst = p.wt_up0; perm = 1; break;
    case 9: src = p.ffn_w_up + (size_t)1024 * 5632; K = 1024; N = 5632; dst = p.wt_up1; perm = 1; break;
    case 10: src = p.ffn_w_down; K = 2816; N = 1024; dst = p.wt_dn0; break;
    case 11: src = p.ffn_w_down + (size_t)2816 * 1024; K = 2816; N = 1024; dst = p.wt_dn1; break;
    default: src = p.f_w3; K = 64; N = 2048; dst = p.wt_f3; break;
  }
  const int ntn = (N + 63) >> 6;
  const int kt = wt / ntn, nt = wt - kt * ntn;
  const int k0 = kt * 128, n0 = nt * 64;
  int np0;
  if (perm == 1) { const int half = n0 / 2816, f = n0 - half * 2816; np0 = (f >> 6) * 128 + half * 64; }
  else if (perm == 2) { if (n0 < 1024) np0 = n0; else { const int m = n0 - 1024, half = m >> 10, f = m & 1023; np0 = 1024 + (f >> 6) * 128 + half * 64; } }
  else np0 = n0;
  bf16_t* t16 = (bf16_t*)smem;
  f32x4 v[8];
#pragma unroll
  for (int i = 0; i < 8; ++i) {
    const int idx = tid + 256 * i; const int kr = idx >> 4, c4 = idx & 15;
    v[i] = (f32x4){0.f, 0.f, 0.f, 0.f};
    if (n0 + 4 * c4 < N && k0 + kr < K) v[i] = *(const f32x4*)(src + (size_t)(k0 + kr) * N + n0 + 4 * c4);
  }
#pragma unroll
  for (int i = 0; i < 8; ++i) {
    const int idx = tid + 256 * i; const int kr = idx >> 4, c4 = idx & 15;
    const float sc = (scale && k0 + kr < K) ? scale[k0 + kr] : 1.f;
#pragma unroll
    for (int j = 0; j < 4; ++j) t16[(4 * c4 + j) * 136 + kr] = f2bf(v[i][j] * sc);
  }
  __syncthreads();
#pragma unroll
  for (int i = 0; i < 4; ++i) {
    const int idx = tid + 256 * i; const int n = idx >> 4, ch = idx & 15;
    if (n0 + n < N && k0 + ch * 8 < K) *(uint4*)(dst + (size_t)(np0 + n) * K + k0 + ch * 8) = *(const uint4*)(t16 + n * 136 + ch * 8);
  }
  __syncthreads();
}

__device__ __forceinline__ void prep_modvec(CP& p, char* smem, int it) {
  const int tid = get_tid();
  const int layer = it / 384, rem = it - layer * 384, cb = rem >> 2, ks = rem & 3;
  float* s_lds = (float*)smem;
  float* red = (float*)(smem + 12288);
  const int kbase = ks * 256;
  for (int idx = tid; idx < 9 * 256; idx += 256) {
    const int r = idx >> 8, k = idx & 255;
    const float v = r < 8 ? p.c[r * 1024 + kbase + k] : p.c_ctx[kbase + k];
    s_lds[k * 12 + r] = v / (1.f + __expf(-v));
  }
  __syncthreads();
  const int col = cb * 64 + (tid & 63), kg = tid >> 6;
  const float* W = p.mod_w + (size_t)layer * 1024 * 6144 + (size_t)kbase * 6144 + col;
  float acc[9];
#pragma unroll
  for (int r = 0; r < 9; ++r) acc[r] = 0.f;
#pragma unroll
  for (int kb = 0; kb < 4; ++kb) {
    float w[16];
#pragma unroll
    for (int u = 0; u < 16; ++u) w[u] = W[(size_t)(kg * 64 + kb * 16 + u) * 6144];
#pragma unroll
    for (int u = 0; u < 16; ++u) {
      const int k = kg * 64 + kb * 16 + u;
      const f32x4 s0 = *(const f32x4*)(s_lds + k * 12), s1 = *(const f32x4*)(s_lds + k * 12 + 4);
      const float s2 = s_lds[k * 12 + 8];
      acc[0] += s0[0] * w[u]; acc[1] += s0[1] * w[u]; acc[2] += s0[2] * w[u]; acc[3] += s0[3] * w[u];
      acc[4] += s1[0] * w[u]; acc[5] += s1[1] * w[u]; acc[6] += s1[2] * w[u]; acc[7] += s1[3] * w[u];
      acc[8] += s2 * w[u];
    }
  }
#pragma unroll
  for (int r = 0; r < 9; ++r) red[(kg * 9 + r) * 64 + (tid & 63)] = acc[r];
  __syncthreads();
  for (int o = tid; o < 9 * 64; o += 256) {
    const int r = o >> 6, cl = o & 63;
    const float sm = red[(0 * 9 + r) * 64 + cl] + red[(1 * 9 + r) * 64 + cl] + red[(2 * 9 + r) * 64 + cl] + red[(3 * 9 + r) * 64 + cl];
    p.modp[(size_t)ks * 110592 + (size_t)(layer * 9 + r) * 6144 + cb * 64 + cl] = sm;
  }
  __syncthreads();
}

__device__ __forceinline__ void prep_filter(CP& p, char* smem, int it) {
  const int tid = get_tid();
  float* z = (float*)smem;
  float* h1 = z + 8 * 33;
  float* h2 = h1 + 8 * 64;
  const int t0 = it * 8;
  for (int idx = tid; idx < 8 * 33; idx += 256) {
    const int pp = idx / 33, i = idx - pp * 33;
    const int t = t0 + pp;
    float v;
    if (i == 0) v = (float)t * (1.0f / 2047.0f);
    else {
      const int k = (i - 1) & 15;
      const float w = (6.283185307179586f * (float)t) / 2048.0f;
      const float f = 1e-4f + (float)k * ((15.0f - 1e-4f) / 15.0f);
      const float a = w * f;
      v = (i <= 16) ? __cosf(a) : -__sinf(a);
    }
    z[idx] = v;
  }
  __syncthreads();
  for (int idx = tid; idx < 8 * 64; idx += 256) {
    const int pp = idx >> 6, j = idx & 63;
    float s = p.f_b1[j];
#pragma unroll
    for (int i = 0; i < 33; ++i) s += z[pp * 33 + i] * p.f_w1[i * 64 + j];
    h1[idx] = __sinf(p.f_freq1[j] * s);
  }
  __syncthreads();
  for (int idx = tid; idx < 8 * 64; idx += 256) {
    const int pp = idx >> 6, j = idx & 63;
    float s = p.f_b2[j];
#pragma unroll 16
    for (int i = 0; i < 64; ++i) s += h1[pp * 64 + i] * p.f_w2[i * 64 + j];
    h2[idx] = __sinf(p.f_freq2[j] * s);
  }
  __syncthreads();
  for (int idx = tid; idx < 8 * 64; idx += 256) p.h2bf[(size_t)t0 * 64 + idx] = f2bf(h2[idx]);
  __syncthreads();
}

__device__ __forceinline__ void phase_prep(CP& p, char* smem) {
  const int total = 768 + 256 + 3048;
  for (int it = get_bid(); it < total; it += VGRID) {
    if (it < 768) prep_modvec(p, smem, it);
    else if (it < 1024) prep_filter(p, smem, it - 768);
    else prep_weight_tile(p, smem, it - 1024);
  }
}

__device__ __forceinline__ f32x4 ld4_bf16(const bf16_t* p) {
  const uint2 u = *(const uint2*)p;
  f32x4 r; r[0] = bf2f((bf16_t)(u.x & 0xffff)); r[1] = bf2f((bf16_t)(u.x >> 16)); r[2] = bf2f((bf16_t)(u.y & 0xffff)); r[3] = bf2f((bf16_t)(u.y >> 16));
  return r;
}
template <bool PART, bool SRC16 = false>
__device__ __forceinline__ void normmod_row2(const void* __restrict__ srcv, const float* __restrict__ g, const float* __restrict__ sh, const float* __restrict__ sc, bf16_t* __restrict__ dst, int lane, const float* __restrict__ bsh = nullptr) {
  f32x4 v[2][4]; float ss0 = 0.f, ss1 = 0.f;
#pragma unroll
  for (int i = 0; i < 4; ++i) {
    if (SRC16) { v[0][i] = ld4_bf16((const bf16_t*)srcv + lane * 4 + 256 * i); v[1][i] = ld4_bf16((const bf16_t*)srcv + 1024 + lane * 4 + 256 * i); }
    else { v[0][i] = *(const f32x4*)((const float*)srcv + lane * 4 + 256 * i); v[1][i] = *(const f32x4*)((const float*)srcv + 1024 + lane * 4 + 256 * i); }
  }
#pragma unroll
  for (int i = 0; i < 4; ++i) {
    ss0 += v[0][i][0] * v[0][i][0] + v[0][i][1] * v[0][i][1] + v[0][i][2] * v[0][i][2] + v[0][i][3] * v[0][i][3];
    ss1 += v[1][i][0] * v[1][i][0] + v[1][i][1] * v[1][i][1] + v[1][i][2] * v[1][i][2] + v[1][i][3] * v[1][i][3];
  }
  ss0 = wave_sum(ss0); ss1 = wave_sum(ss1);
  const float r0 = rsqrtf(ss0 * (1.0f / 1024.0f) + 1e-6f), r1 = rsqrtf(ss1 * (1.0f / 1024.0f) + 1e-6f);
#pragma unroll
  for (int i = 0; i < 4; ++i) {
    const int k = lane * 4 + 256 * i;
    const f32x4 g4 = *(const f32x4*)(g + k);
    f32x4 s4 = *(const f32x4*)(sh + k), c4 = *(const f32x4*)(sc + k);
    if (PART) {
#pragma unroll
      for (int q = 1; q < 4; ++q) { s4 += *(const f32x4*)(sh + (size_t)q * 110592 + k); c4 += *(const f32x4*)(sc + (size_t)q * 110592 + k); }
      s4 += *(const f32x4*)(bsh + k); c4 += *(const f32x4*)(bsh + 1024 + k);
    }
    float y[4], z[4];
#pragma unroll
    for (int j = 0; j < 4; ++j) { const float gm = g4[j] * (1.f + c4[j]); y[j] = (v[0][i][j] * r0) * gm + s4[j]; z[j] = (v[1][i][j] * r1) * gm + s4[j]; }
    uint2 u; u.x = pack2(y[0], y[1]); u.y = pack2(y[2], y[3]);
    *(uint2*)(dst + k) = u;
    u.x = pack2(z[0], z[1]); u.y = pack2(z[2], z[3]);
    *(uint2*)(dst + 1024 + k) = u;
  }
}

__device__ __forceinline__ void phase_normmod_kv(CP& p) {
  const int lane = get_tid() & 63, wv = get_tid() >> 6;
  const float* g = p.norm_mix_g;
  for (int idx = get_bid() * 256 + get_tid(); idx < 110592; idx += VGRID * 256) {
    const int lr = idx / 6144; const int n = idx - lr * 6144; const int layer = lr / 9;
    p.modv[idx] = p.modp[idx] + p.modp[110592 + idx] + p.modp[2 * 110592 + idx] + p.modp[3 * 110592 + idx] + p.mod_b[layer * 6144 + n];
  }
  for (int r = (get_bid() * 4 + wv) * 2; r < 18432; r += VGRID * 8) {
    const int b = r / 2304, pp = r - b * 2304;
    const float* src; const float* mv;
    if (pp < 256) { src = p.ctx + ((size_t)b * 256 + pp) * 1024; mv = p.modp + (size_t)8 * 6144; }
    else { src = p.x + ((size_t)b * 2048 + pp - 256) * 1024; mv = p.modp + (size_t)b * 6144; }
    normmod_row2<true>(src, g, mv, mv + 1024, p.hxc + (size_t)r * 1024, lane, p.mod_b);
  }
}
__device__ __forceinline__ void phase_normmod_x(CP& p, const float* g, int layer, int chunk) {
  const int lane = get_tid() & 63, wv = get_tid() >> 6;
  for (int r = (get_bid() * 4 + wv) * 2; r < 16384; r += VGRID * 8) {
    const int b = r >> 11;
    const float* mv = p.modv + (size_t)(layer * 9 + b) * 6144 + chunk * 1024;
    normmod_row2<false, true>(p.X16 + (size_t)r * 1024, g, mv, mv + 1024, p.hxc + (size_t)r * 1024, lane);
  }
}
__device__ __forceinline__ void phase_final_norm(CP& p) {
  const int lane = get_tid() & 63, wv = get_tid() >> 6;
  for (int r = get_bid() * 4 + wv; r < 16384; r += VGRID * 4) {
    const bf16_t* srow = p.X16 + (size_t)r * 1024;
    float* row = p.X + (size_t)r * 1024;
    f32x4 v[4]; float ss = 0.f;
#pragma unroll
    for (int i = 0; i < 4; ++i) { v[i] = ld4_bf16(srow + lane * 4 + 256 * i); ss += v[i][0] * v[i][0] + v[i][1] * v[i][1] + v[i][2] * v[i][2] + v[i][3] * v[i][3]; }
    ss = wave_sum(ss);
    const float rr = rsqrtf(ss * (1.0f / 1024.0f) + 1e-6f);
#pragma unroll
    for (int i = 0; i < 4; ++i) {
      const int k = lane * 4 + 256 * i;
      const f32x4 g4 = *(const f32x4*)(p.final_g + k);
      f32x4 o; o[0] = v[i][0] * rr * g4[0]; o[1] = v[i][1] * rr * g4[1]; o[2] = v[i][2] * rr * g4[2]; o[3] = v[i][3] * rr * g4[3];
      *(f32x4*)(row + k) = o;
    }
  }
}

__device__ __forceinline__ void phase_rowstat(CP& p) {
  const int lane = get_tid() & 63, wv = get_tid() >> 6;
  for (int r = get_bid() * 4 + wv; r < 18432; r += VGRID * 4) {
    const int b = r / 2304, pp = r - b * 2304;
    const bf16_t* kvr = p.kv + (size_t)r * 288;
    {
      const uint2 u = *(const uint2*)(kvr + lane * 4);
      const float a0 = bf2f((bf16_t)(u.x & 0xffff)), a1 = bf2f((bf16_t)(u.x >> 16)), a2 = bf2f((bf16_t)(u.y & 0xffff)), a3 = bf2f((bf16_t)(u.y >> 16));
      float ss = a0 * a0 + a1 * a1 + a2 * a2 + a3 * a3;
      ss = wave_sum(ss);
      if (lane == 0) p.rkv[r] = rsqrtf(ss * (1.0f / 256.0f) + 1e-6f);
    }
    {
      const int i = lane & 31;
      const float xv = bf2f(kvr[256 + i]);
      const float ov = __shfl_xor(xv, 8);
      float res = xv;
      if (pp >= 256) {
        const int t = pp - 256;
        const int quarter = i >> 3, idx = i & 7;
        const float pos = (quarter < 2) ? (float)(t >> 6) : (float)(t & 63);
        const float inv = exp2f(-(float)idx * (13.287712379549449f / 8.0f));
        const float ang = pos * inv;
        const float cs = __cosf(ang), sn = __sinf(ang);
        res = xv * cs + ((quarter & 1) ? ov : -ov) * sn;
      }
      if (lane < 32) p.kpe[(size_t)r * 32 + i] = f2bf(res);
    }
    if (pp >= 256) {
      const int xr = b * 2048 + pp - 256;
      const uint4 u = *(const uint4*)(p.cq + (size_t)xr * 512 + lane * 8);
      const unsigned uu[4] = {u.x, u.y, u.z, u.w};
      float ss = 0.f;
#pragma unroll
      for (int j = 0; j < 4; ++j) { const float a = bf2f((bf16_t)(uu[j] & 0xffff)), bb = bf2f((bf16_t)(uu[j] >> 16)); ss += a * a + bb * bb; }
      ss = wave_sum(ss);
      if (lane == 0) p.rq[xr] = rsqrtf(ss * (1.0f / 512.0f) + 1e-6f);
    }
  }
}

template <int NP>
struct EpiStore {
  static constexpr int KIND = 0; static constexpr bool ROWSUM = false;
  bf16_t* out; int ld; int ostride; const float* part; int pstride; float inv_n;
  __device__ __forceinline__ void c4(int g, int rig, int col, f32x4 v) const {
    const size_t row = (size_t)g * ostride + rig;
    float s = 1.f;
    if (NP > 0) {
      float t = 0.f;
#pragma unroll
      for (int q = 0; q < NP; ++q) t += part[(size_t)q * pstride + row];
      s = rsqrtf(t * inv_n + 1e-6f);
    }
    uint2 u; u.x = pack2(v[0] * s, v[1] * s); u.y = pack2(v[2] * s, v[3] * s);
    *(uint2*)(out + row * ld + col) = u;
  }
};
struct EpiDown {
  static constexpr int KIND = 0; static constexpr bool ROWSUM = true;
  bf16_t* out; int ld; int ostride; float* part; int nslots; bf16_t* kpe; int ropecol;
  __device__ __forceinline__ float c4(int g, int rig, int col, f32x4 v) const {
    const size_t row = (size_t)g * ostride + rig;
    if (kpe && col >= ropecol) {
      const int i0 = col - ropecol;
      f32x4 o = v;
      const float p0 = __shfl_xor(v[0], 32), p1 = __shfl_xor(v[1], 32), p2 = __shfl_xor(v[2], 32), p3 = __shfl_xor(v[3], 32);
      const float pv[4] = {p0, p1, p2, p3};
      if (rig >= 256) {
        const int t = rig - 256;
        const int quarter = i0 >> 3;
        const float pos = (quarter < 2) ? (float)(t >> 6) : (float)(t & 63);
#pragma unroll
        for (int j = 0; j < 4; ++j) {
          const int idx = (i0 & 7) + j;
          const float inv = exp2f(-(float)idx * (13.287712379549449f / 8.0f));
          const float ang = pos * inv;
          const float cs = __cosf(ang), sn = __sinf(ang);
          o[j] = v[j] * cs + ((quarter & 1) ? pv[j] : -pv[j]) * sn;
        }
      }
      uint2 u; u.x = pack2(o[0], o[1]); u.y = pack2(o[2], o[3]);
      *(uint2*)(kpe + row * 32 + i0) = u;
      return 0.f;
    }
    uint2 u; u.x = pack2(v[0], v[1]); u.y = pack2(v[2], v[3]);
    *(uint2*)(out + row * ld + col) = u;
    return v[0] * v[0] + v[1] * v[1] + v[2] * v[2] + v[3] * v[3];
  }
  __device__ __forceinline__ void rowsum(int g, int rig, int slot, float ss) const {
    if (slot < nslots) part[(size_t)slot * ((size_t)8 * ostride) + (size_t)g * ostride + rig] = ss;
  }
};
struct EpiVt {
  static constexpr int KIND = 1;
  bf16_t* out; const float* part;
  __device__ __forceinline__ void r4(int g, int rig, int col, f32x4 v) const {
    const size_t row = (size_t)g * 2304 + rig;
    const f32x4 t = *(const f32x4*)(part + row) + *(const f32x4*)(part + 18432 + row);
    f32x4 s;
#pragma unroll
    for (int j = 0; j < 4; ++j) s[j] = rsqrtf(t[j] * (1.0f / 256.0f) + 1e-6f);
    uint2 u; u.x = pack2(v[0] * s[0], v[1] * s[1]); u.y = pack2(v[2] * s[2], v[3] * s[3]);
    *(uint2*)(out + ((size_t)g * 1024 + col) * 2304 + rig) = u;
  }
};
struct EpiBiasStore {
  static constexpr int KIND = 0; static constexpr bool ROWSUM = false;
  bf16_t* out; int ld; const float* bias;
  __device__ __forceinline__ void c4(int g, int rig, int col, f32x4 v) const {
    const size_t row = (size_t)g * 2048 + rig;
    const f32x4 b4 = *(const f32x4*)(bias + col);
    uint2 u; u.x = pack2(v[0] + b4[0], v[1] + b4[1]); u.y = pack2(v[2] + b4[2], v[3] + b4[3]);
    *(uint2*)(out + row * ld + col) = u;
  }
};
struct EpiBiasT {
  static constexpr int KIND = 1;
  bf16_t* out; const float* bias;
  __device__ __forceinline__ void r4(int g, int rig, int col, f32x4 v) const {
    const float b = bias[col];
    uint2 u; u.x = pack2(v[0] + b, v[1] + b); u.y = pack2(v[2] + b, v[3] + b);
    *(uint2*)(out + (size_t)col * 16384 + (size_t)g * 2048 + rig) = u;
  }
};
struct EpiFilt {
  static constexpr int KIND = 1;
  bf16_t* Rf; const float* decay;
  __device__ __forceinline__ void r4(int g, int rig, int col, f32x4 v) const {
    const int c = col & 1023; const bool bwd = col >= 1024;
    const float dec = fabsf(decay[c]);
    bf16_t* rp = Rf + (size_t)c * 4096;
#pragma unroll
    for (int j = 0; j < 4; ++j) {
      const int t = rig + j;
      const float val = v[j] * __expf(-(float)t * (1.0f / 2047.0f) * dec);
      if (!bwd) rp[2048 - t] = f2bf(val);
      else if (t > 0) rp[2048 + t] = f2bf(val);
      else rp[0] = 0;
    }
  }
};
template <bool BASE_F32>
struct EpiResid {
  static constexpr int KIND = 0; static constexpr bool ROWSUM = false;
  bf16_t* X16; const void* base; const float* gate; const float* bias;
  __device__ __forceinline__ void c4(int g, int rig, int col, f32x4 v) const {
    const size_t o = ((size_t)g * 2048 + rig) * 1024 + col;
    f32x4 bs;
    if (BASE_F32) bs = *(const f32x4*)((const float*)base + o);
    else {
      const uint2 u = *(const uint2*)((const bf16_t*)base + o);
      bs[0] = bf2f((bf16_t)(u.x & 0xffff)); bs[1] = bf2f((bf16_t)(u.x >> 16)); bs[2] = bf2f((bf16_t)(u.y & 0xffff)); bs[3] = bf2f((bf16_t)(u.y >> 16));
    }
    const f32x4 gt = *(const f32x4*)(gate + (size_t)g * 6144 + col);
    f32x4 bi = {0.f, 0.f, 0.f, 0.f};
    if (bias) bi = *(const f32x4*)(bias + col);
    f32x4 r;
#pragma unroll
    for (int j = 0; j < 4; ++j) r[j] = bs[j] + gt[j] * (v[j] + bi[j]);
    uint2 w; w.x = pack2(r[0], r[1]); w.y = pack2(r[2], r[3]);
    *(uint2*)(X16 + o) = w;
  }
};
template <int MODE>
struct EpiConv {
  static constexpr int KIND = 2;
  const float* cw; const float* cb; int NC; const float* pre_bias;
  bf16_t* o0; bf16_t* o1;
  __device__ __forceinline__ int norig(int nt, int cl) const {
    if (MODE == 0) return (cl >> 6) * 2816 + nt * 64 + (cl & 63);
    if (nt < 8) return nt * 128 + cl;
    return 1024 + (cl >> 6) * 1024 + (nt - 8) * 64 + (cl & 63);
  }
  typedef float f32x2_t __attribute__((ext_vector_type(2)));
  static __device__ __forceinline__ f32x2_t ldz(const bf16_t* Z, int row, int col) {
    const unsigned u = *(const unsigned*)(Z + row * 132 + col);
    f32x2_t r; r[0] = __uint_as_float(u << 16); r[1] = __uint_as_float(u & 0xffff0000u); return r;
  }
  template <class F>
  __device__ __forceinline__ void finish(const bf16_t* Z, int g, int rig0, int nt, F&& pre) const {
    typedef f32x2_t f32x2;
    const int tid = get_tid();
    if (MODE == 0 || nt < 8) {
      if (MODE == 0) {
        const int f2 = (tid & 31) * 2, q8 = tid >> 5;
        const int q0 = 1 + 16 * q8, q1 = (q0 + 16 < 127) ? q0 + 16 : 127;
        const int na = norig(nt, f2), ng = norig(nt, 64 + f2);
        const f32x2 a0 = *(const f32x2*)(cw + na), a1 = *(const f32x2*)(cw + NC + na), a2 = *(const f32x2*)(cw + 2 * NC + na), ab = *(const f32x2*)(cb + na);
        const f32x2 g0 = *(const f32x2*)(cw + ng), g1 = *(const f32x2*)(cw + NC + ng), g2 = *(const f32x2*)(cw + 2 * NC + ng), gb = *(const f32x2*)(cb + ng);
        pre();
        f32x2 am = ldz(Z, q0 - 1, f2), ac = ldz(Z, q0, f2);
        f32x2 gm = ldz(Z, q0 - 1, 64 + f2), gc = ldz(Z, q0, 64 + f2);
#pragma unroll 2
        for (int pl = q0; pl < q1; ++pl) {
          const f32x2 an = ldz(Z, pl + 1, f2), gn = ldz(Z, pl + 1, 64 + f2);
          const int pos = rig0 + pl;
          if (pos < 2048) {
            const f32x2 av = a0 * am + a1 * ac + a2 * an + ab;
            const f32x2 gv = g0 * gm + g1 * gc + g2 * gn + gb;
            const float s0 = av[0] * gv[0] * __builtin_amdgcn_rcpf(1.f + __expf(-gv[0]));
            const float s1 = av[1] * gv[1] * __builtin_amdgcn_rcpf(1.f + __expf(-gv[1]));
            *(unsigned*)(o0 + ((size_t)g * 2048 + pos) * 2816 + nt * 64 + f2) = pack2(s0, s1);
          }
          am = ac; ac = an; gm = gc; gc = gn;
        }
      } else {
        const int cl = (tid & 63) * 2, q = tid >> 6;
        const int p0 = 1 + 32 * q, p1 = (p0 + 32 < 127) ? p0 + 32 : 127;
        const int na = norig(nt, cl);
        const f32x2 a0 = *(const f32x2*)(cw + na), a1 = *(const f32x2*)(cw + NC + na), a2 = *(const f32x2*)(cw + 2 * NC + na), ab = *(const f32x2*)(cb + na);
        pre();
        f32x2 am = ldz(Z, p0 - 1, cl), ac = ldz(Z, p0, cl);
#pragma unroll 2
        for (int pl = p0; pl < p1; ++pl) {
          const f32x2 an = ldz(Z, pl + 1, cl);
          const int pos = rig0 + pl;
          if (pos < 2048) {
            const f32x2 av = a0 * am + a1 * ac + a2 * an + ab;
            *(unsigned*)(o0 + ((size_t)g * 2048 + pos) * 1024 + nt * 128 + cl) = pack2(av[0], av[1]);
          }
          am = ac; ac = an;
        }
      }
    } else {
      pre();
      const int pl = tid & 127, fh = tid >> 7;
      const int pos = rig0 + pl;
      if (pl >= 1 && pl <= 126 && pos < 2048) {
        const int fb = nt - 8;
#pragma unroll 2
        for (int f = fh * 32; f < fh * 32 + 32; f += 2) {
          const int na = norig(nt, f), nb = norig(nt, 64 + f);
          const f32x2 va = *(const f32x2*)(cw + na) * ldz(Z, pl - 1, f) + *(const f32x2*)(cw + NC + na) * ldz(Z, pl, f)
                         + *(const f32x2*)(cw + 2 * NC + na) * ldz(Z, pl + 1, f) + *(const f32x2*)(cb + na);
          const f32x2 vb = *(const f32x2*)(cw + nb) * ldz(Z, pl - 1, 64 + f) + *(const f32x2*)(cw + NC + nb) * ldz(Z, pl, 64 + f)
                         + *(const f32x2*)(cw + 2 * NC + nb) * ldz(Z, pl + 1, 64 + f) + *(const f32x2*)(cb + nb);
          bf16_t* op = o1 + (size_t)(fb * 64 + f) * 16384 + g * 2048 + pos;
          op[0] = f2bf(va[0] * vb[0]);
          op[16384] = f2bf(va[1] * vb[1]);
        }
      }
    }
  }
};

#define GLDS16(gp, lp) __builtin_amdgcn_global_load_lds((const unsigned*)(gp), (__attribute__((address_space(3))) unsigned*)(lp), 16, 0, 0)

template <bool SWAP, class Epi>
__device__ __forceinline__ void gemm_job(char* smem, const bf16_t* __restrict__ A, int lda, const bf16_t* __restrict__ Bt, int K, int N,
                                         int tpg, int a_gstride, int a_goff, int step, int halo, int grows, int MTS, int voff, int vid0, int grid, const Epi& epi) {
  const int tid = get_tid512(), lane = tid & 63, wid = tid >> 6, wr = wid >> 1, wc = wid & 1, fr = lane & 15, fq = lane >> 4;
  const int NT = (N + 255) >> 8, MT = MTS >> 1, ntiles = MT * NT, ns = K >> 6;
  const int full = MT >> 3;
  int v = vid0;
  if (v < voff) v += ((voff - v + grid - 1) / grid) * grid;
  const int swz = (fr >> 1) & 7;
  bool pre_issued = false;
  for (; v < voff + ntiles; v += grid) {
    const int w = v - voff;
    int mt, nt;
    if (w < full * 8 * NT) { const int sr = w / (8 * NT), rem = w - sr * 8 * NT; nt = rem >> 3; mt = sr * 8 + (rem & 7); }
    else { const int w2 = w - full * 8 * NT, rl = MT - full * 8; nt = w2 / rl; mt = full * 8 + (w2 - nt * rl); }
    unsigned ap[4], bp[4];
#pragma unroll
    for (int i = 0; i < 4; ++i) {
      const int r = (tid >> 3) + 64 * i;
      const int cs = tid & 7;
      const int c = ((cs ^ ((r >> 1) & 7)) << 3);
      const int sub = 2 * mt + (r >> 7);
      const int g = sub / tpg, ti = sub - g * tpg;
      int rig = ti * step - halo + (r & 127); rig = rig < 0 ? 0 : (rig > grows - 1 ? grows - 1 : rig);
      ap[i] = (unsigned)((g * a_gstride + a_goff + rig) * lda + c);
      int br = nt * 256 + r; br = br > N - 1 ? N - 1 : br;
      bp[i] = (unsigned)(br * K + c);
    }
    const bool have_next = false;
    f32x4 acc[4][8];
#pragma unroll
    for (int m = 0; m < 4; ++m)
#pragma unroll
      for (int n = 0; n < 8; ++n) acc[m][n] = (f32x4){0.f, 0.f, 0.f, 0.f};
    if (!pre_issued) {
#pragma unroll
      for (int i = 0; i < 4; ++i) { GLDS16(A + (size_t)ap[i], smem + tid * 16 + i * 8192); GLDS16(Bt + (size_t)bp[i], smem + 32768 + tid * 16 + i * 8192); }
    }
    pre_issued = have_next;
    for (int st = 0; st < ns; ++st) {
      asm volatile("s_waitcnt vmcnt(0)" ::: "memory");
      __builtin_amdgcn_s_barrier();
      asm volatile("" ::: "memory");
      if (st + 1 < ns) {
        char* nb = smem + ((st + 1) & 1) * 65536;
        const int ko = (st + 1) * 64;
#pragma unroll
        for (int i = 0; i < 4; ++i) { GLDS16(A + (size_t)(ap[i] + ko), nb + tid * 16 + i * 8192); GLDS16(Bt + (size_t)(bp[i] + ko), nb + 32768 + tid * 16 + i * 8192); }
      }
      const char* sa = smem + (st & 1) * 65536 + (wr * 64 + fr) * 128;
      const char* sb = smem + (st & 1) * 65536 + 32768 + (wc * 128 + fr) * 128;
      bf16x8 afA[4], afB[4], bfb[2][2];
#pragma unroll
      for (int m = 0; m < 4; ++m) afA[m] = *(const bf16x8*)(sa + m * 2048 + ((fq ^ swz) << 4));
#pragma unroll
      for (int n = 0; n < 2; ++n) bfb[0][n] = *(const bf16x8*)(sb + n * 2048 + ((fq ^ swz) << 4));
#pragma unroll
      for (int gq = 0; gq < 8; ++gq) {
        const int ks = gq >> 2, nh = gq & 3;
        if (gq < 7) {
          const int ks2 = (gq + 1) >> 2, nh2 = (gq + 1) & 3;
#pragma unroll
          for (int n = 0; n < 2; ++n) bfb[(gq + 1) & 1][n] = *(const bf16x8*)(sb + (nh2 * 2 + n) * 2048 + (((ks2 * 4 + fq) ^ swz) << 4));
        }
        if (gq == 3) {
#pragma unroll
          for (int m = 0; m < 4; ++m) afB[m] = *(const bf16x8*)(sa + m * 2048 + (((4 + fq) ^ swz) << 4));
        }
        __builtin_amdgcn_sched_barrier(0);
#pragma unroll
        for (int m = 0; m < 4; ++m)
#pragma unroll
          for (int n = 0; n < 2; ++n) {
            const bf16x8 av = ks ? afB[m] : afA[m];
            acc[m][nh * 2 + n] = SWAP ? __builtin_amdgcn_mfma_f32_16x16x32_bf16(bfb[gq & 1][n], av, acc[m][nh * 2 + n], 0, 0, 0)
                                      : __builtin_amdgcn_mfma_f32_16x16x32_bf16(av, bfb[gq & 1][n], acc[m][nh * 2 + n], 0, 0, 0);
          }
      }
    }
    __syncthreads();
    const int te = get_tid512();
    const int fr_e = te & 15, fq_e = (te & 63) >> 4, wr_e = te >> 7, wc_e = (te >> 6) & 1;
    const int sub = 2 * mt + (wr_e >> 1);
    const int g = sub / tpg, ti = sub - g * tpg;
    const int rig0 = ti * step - halo;
    const int rw = (wr_e & 1) * 64;
    if constexpr (Epi::KIND == 0) {
#pragma unroll
      for (int m = 0; m < 4; ++m) {
        const int rig = rig0 + rw + m * 16 + fr_e;
        if constexpr (Epi::ROWSUM) {
          float ss = 0.f;
#pragma unroll
          for (int n = 0; n < 8; ++n) {
            const int col = nt * 256 + wc_e * 128 + n * 16 + fq_e * 4;
            if (col < N) ss += epi.c4(g, rig, col, acc[m][n]);
          }
          ss += __shfl_xor(ss, 16); ss += __shfl_xor(ss, 32);
          if (fq_e == 0) epi.rowsum(g, rig, nt * 2 + wc_e, ss);
        } else {
#pragma unroll
          for (int n = 0; n < 8; ++n) {
            const int col = nt * 256 + wc_e * 128 + n * 16 + fq_e * 4;
            if (col < N) epi.c4(g, rig, col, acc[m][n]);
          }
        }
      }
    } else if constexpr (Epi::KIND == 1) {
#pragma unroll
      for (int m = 0; m < 4; ++m) {
        const int rig = rig0 + rw + m * 16 + fq_e * 4;
#pragma unroll
        for (int n = 0; n < 8; ++n) {
          const int col = nt * 256 + wc_e * 128 + n * 16 + fr_e;
          if (col < N) epi.r4(g, rig, col, acc[m][n]);
        }
      }
    } else {
      bf16_t* Zw = (bf16_t*)smem + ((wr_e >> 1) * 2 + wc_e) * (128 * 132);
      const int nt2w = nt * 2 + wc_e;
#pragma unroll
      for (int n = 0; n < 8; ++n) {
        const int cl = n * 16 + fq_e * 4;
        f32x4 b4 = {0.f, 0.f, 0.f, 0.f};
        if (epi.pre_bias) b4 = *(const f32x4*)(epi.pre_bias + epi.norig(nt2w, cl));
#pragma unroll
        for (int m = 0; m < 4; ++m) {
          const int rl = rw + m * 16 + fr_e;
          const int pos = rig0 + rl;
          const bool ok = pos >= 0 && pos < grows;
          f32x4 vv = acc[m][n] + b4;
          if (!ok) vv = (f32x4){0.f, 0.f, 0.f, 0.f};
          uint2 u; u.x = pack2(vv[0], vv[1]); u.y = pack2(vv[2], vv[3]);
          *(uint2*)(Zw + rl * 132 + cl) = u;
        }
      }
      __syncthreads();
      {
        auto no_pre = []() {};
        const bf16_t* Zr = (const bf16_t*)smem + ((wr_e >> 1) * 2) * (128 * 132);
        epi.finish(Zr, g, rig0, nt * 2, no_pre);
        epi.finish(Zr + 128 * 132, g, rig0, nt * 2 + 1, no_pre);
      }
      __syncthreads();
    }
    asm volatile("s_waitcnt vmcnt(0)" ::: "memory");
    __syncthreads();
  }
}

__device__ __forceinline__ void phase_attn(CP& p, char* smem, int vid0, int grid) {
  bf16_t* Ks = (bf16_t*)smem;
  bf16_t* Vs = (bf16_t*)(smem + 64 * 104 * 2);
  const int tid = get_tid(), lane = tid & 63, w = tid >> 6, r = lane & 31, hh = lane >> 5;
  const float cs = 1.4426950408889634f * 0.10206207261596577f;
  for (int it = vid0; it < 2048; it += grid) {
    const int qt = it & 15, h = (it >> 4) & 15, b = it >> 8;
    const int t = qt * 128 + w * 32 + r;
    const size_t xrow = (size_t)b * 2048 + t;
    const bf16_t* qp = p.Q + xrow * 1536 + h * 96;
    bf16x8 qf[6];
#pragma unroll
    for (int kk = 0; kk < 4; ++kk) qf[kk] = *(const bf16x8*)(qp + 16 * kk + 8 * hh);
#pragma unroll
    for (int part = 0; part < 2; ++part) {
      const bf16_t* pp = qp + 64 + 16 * part;
      const bf16x8 mine = *(const bf16x8*)(pp + 8 * hh), oth = *(const bf16x8*)(pp + 8 * (1 - hh));
      const float posf = part == 0 ? (float)(t >> 6) : (float)(t & 63);
      union { unsigned u[4]; bf16x8 v; } o;
      float res[8];
#pragma unroll
      for (int j = 0; j < 8; ++j) {
        const float inv = exp2f(-(float)j * (13.287712379549449f / 8.0f));
        const float ang = posf * inv;
        const float c = __cosf(ang), s = __sinf(ang);
        const float m = bf2f((bf16_t)mine[j]), ov = bf2f((bf16_t)oth[j]);
        res[j] = m * c + (hh ? ov : -ov) * s;
      }
#pragma unroll
      for (int j = 0; j < 4; ++j) o.u[j] = pack2(res[2 * j], res[2 * j + 1]);
      qf[4 + part] = o.v;
    }
    f32x16 oacc[2];
#pragma unroll
    for (int i = 0; i < 16; ++i) { oacc[0][i] = 0.f; oacc[1][i] = 0.f; }
    float mrun = -INFINITY, lrun = 0.f;
    const size_t kvrow0 = (size_t)b * 2304;
    const bf16_t* kn_base = p.Kn + kvrow0 * 1024 + h * 64;
    const bf16_t* kpe_base = p.kpe + kvrow0 * 32;
    const bf16_t* vt_base = p.Vt + ((size_t)(b * 16 + h) * 64) * 2304;
    uint4 rk0, rk1, rp, rv0, rv1;
    const int srow = tid >> 3, sch = tid & 7;
#define ATT_GLOAD(kt) do { \
      rk0 = *(const uint4*)(kn_base + (size_t)((kt) * 64 + srow) * 1024 + sch * 8); \
      rk1 = *(const uint4*)(kn_base + (size_t)((kt) * 64 + srow + 32) * 1024 + sch * 8); \
      rv0 = *(const uint4*)(vt_base + (size_t)srow * 2304 + (kt) * 64 + sch * 8); \
      rv1 = *(const uint4*)(vt_base + (size_t)(srow + 32) * 2304 + (kt) * 64 + sch * 8); \
      rp = *(const uint4*)(kpe_base + (size_t)((kt) * 64 + (tid >> 2)) * 32 + (tid & 3) * 8); } while (0)
    ATT_GLOAD(0);
    for (int kt = 0; kt < 36; ++kt) {
      __syncthreads();
      {
        *(uint4*)(Ks + srow * 104 + sch * 8) = rk0;
        *(uint4*)(Ks + (srow + 32) * 104 + sch * 8) = rk1;
        uint2 lo, hi;
        lo.x = rv0.x; lo.y = rv0.y; hi.x = rv0.z; hi.y = rv0.w;
        *(uint2*)(Vs + srow * 68 + sch * 8) = lo; *(uint2*)(Vs + srow * 68 + sch * 8 + 4) = hi;
        lo.x = rv1.x; lo.y = rv1.y; hi.x = rv1.z; hi.y = rv1.w;
        *(uint2*)(Vs + (srow + 32) * 68 + sch * 8) = lo; *(uint2*)(Vs + (srow + 32) * 68 + sch * 8 + 4) = hi;
      }
      *(uint4*)(Ks + (tid >> 2) * 104 + 64 + (tid & 3) * 8) = rp;
      __syncthreads();
      if (kt + 1 < 36) ATT_GLOAD(kt + 1);
      f32x16 s[2];
#pragma unroll
      for (int t2 = 0; t2 < 2; ++t2) {
#pragma unroll
        for (int i = 0; i < 16; ++i) s[t2][i] = 0.f;
#pragma unroll
        for (int kk = 0; kk < 6; ++kk) {
          const bf16x8 a = *(const bf16x8*)(Ks + (32 * t2 + r) * 104 + 16 * kk + 8 * hh);
          s[t2] = __builtin_amdgcn_mfma_f32_32x32x16_bf16(a, qf[kk], s[t2], 0, 0, 0);
        }
      }
      float mx = s[0][0];
#pragma unroll
      for (int i = 1; i < 16; ++i) mx = fmaxf(mx, s[0][i]);
#pragma unroll
      for (int i = 0; i < 16; ++i) mx = fmaxf(mx, s[1][i]);
      mx = fmaxf(mx, __shfl_xor(mx, 32));
      const float mcand = mx * cs;
      if (__builtin_amdgcn_ballot_w64(mcand > mrun + 6.0f) != 0ull) {
        const float mnew_ = fmaxf(mrun, mcand);
        const float alpha = __builtin_amdgcn_exp2f(mrun - mnew_);
        mrun = mnew_;
        lrun *= alpha;
#pragma unroll
        for (int i = 0; i < 16; ++i) { oacc[0][i] *= alpha; oacc[1][i] *= alpha; }
      }
      const float mnew = mrun;
      float psum = 0.f;
      bf16x8 pf[4];
#pragma unroll
      for (int t2 = 0; t2 < 2; ++t2)
#pragma unroll
        for (int hf = 0; hf < 2; ++hf) {
          union { unsigned u[4]; bf16x8 v; } cvp;
#pragma unroll
          for (int i = 0; i < 4; ++i) {
            const float p0 = __builtin_amdgcn_exp2f(s[t2][hf * 8 + 2 * i] * cs - mnew);
            const float p1 = __builtin_amdgcn_exp2f(s[t2][hf * 8 + 2 * i + 1] * cs - mnew);
            psum += p0 + p1;
            cvp.u[i] = pack2(p0, p1);
          }
          pf[t2 * 2 + hf] = cvp.v;
        }
      lrun += psum;
#pragma unroll
      for (int dt = 0; dt < 2; ++dt)
#pragma unroll
        for (int s4 = 0; s4 < 4; ++s4) {
          const bf16_t* vp = Vs + (32 * dt + r) * 68 + 16 * s4 + 4 * hh;
          const uint2 lo = *(const uint2*)vp, hi = *(const uint2*)(vp + 8);
          union { uint4 u; bf16x8 v; } cv; cv.u.x = lo.x; cv.u.y = lo.y; cv.u.z = hi.x; cv.u.w = hi.y;
          oacc[dt] = __builtin_amdgcn_mfma_f32_32x32x16_bf16(cv.v, pf[s4], oacc[dt], 0, 0, 0);
        }
    }
    const float ltot = lrun + __shfl_xor(lrun, 32);
    const float inv = 1.f / ltot;
    bf16_t* op = p.hxc + xrow * 1024 + h * 64;
#pragma unroll
    for (int dt = 0; dt < 2; ++dt)
#pragma unroll
      for (int i4 = 0; i4 < 4; ++i4) {
        const int d = 32 * dt + 8 * i4 + 4 * hh;
        uint2 u; u.x = pack2(oacc[dt][4 * i4] * inv, oacc[dt][4 * i4 + 1] * inv); u.y = pack2(oacc[dt][4 * i4 + 2] * inv, oacc[dt][4 * i4 + 3] * inv);
        *(uint2*)(op + d) = u;
      }
  }
}

__device__ __forceinline__ void phase_hyconv(CP& p, char* smem) {
  bf16_t* cp = (bf16_t*)smem;
  bf16_t* Vl = (bf16_t*)(smem + 4 * 8256);
  const int tid = get_tid(), lane = tid & 63, w = tid >> 6, i16 = lane & 15, g4 = lane >> 4;
  const int si = (-i16) & 3;
  const int ocb = 64 * w;
  for (int c = get_bid(); c < 1024; c += VGRID) {
    __syncthreads();
#pragma unroll
    for (int i = 0; i < 2; ++i) { const int ch = tid + 256 * i; *(uint4*)(cp + ch * 8) = *(const uint4*)(p.Rf + (size_t)c * 4096 + ch * 8); }
    {
      const float a0 = p.hy_conv_w[1024 + c], a1 = p.hy_conv_w[3072 + 1024 + c], a2 = p.hy_conv_w[2 * 3072 + 1024 + c], ab = p.hy_conv_b[1024 + c];
      const float v0 = p.hy_conv_w[2048 + c], v1 = p.hy_conv_w[3072 + 2048 + c], v2 = p.hy_conv_w[2 * 3072 + 2048 + c], vb = p.hy_conv_b[2048 + c];
#pragma unroll 2
      for (int i = 0; i < 8; ++i) {
        const int q = tid + 256 * i; const int b = q >> 8, l8 = q & 255; const int m1 = l8 >> 3, m2 = (l8 & 7) * 8;
        const int l0 = l8 * 8;
        const bf16_t* z2 = p.vvT + (size_t)c * 16384 + b * 2048;
        const bf16_t* zv = p.vvT + (size_t)(1024 + c) * 16384 + b * 2048;
        const uint4 u2 = *(const uint4*)(z2 + l0), uv = *(const uint4*)(zv + l0);
        float e2[10], ev[10];
        const int lp = l0 > 0 ? l0 - 1 : 0, ln = l0 + 8 < 2048 ? l0 + 8 : 2047;
        const float pm = l0 > 0 ? 1.f : 0.f, nm = l0 + 8 < 2048 ? 1.f : 0.f;
        const bf16_t q2p = z2[lp], qvp = zv[lp], q2n = z2[ln], qvn = zv[ln];
        e2[0] = bf2f(q2p) * pm; ev[0] = bf2f(qvp) * pm;
        e2[9] = bf2f(q2n) * nm; ev[9] = bf2f(qvn) * nm;
        const unsigned w2[4] = {u2.x, u2.y, u2.z, u2.w}, wv[4] = {uv.x, uv.y, uv.z, uv.w};
#pragma unroll
        for (int j = 0; j < 4; ++j) {
          e2[1 + 2 * j] = __uint_as_float(w2[j] << 16); e2[2 + 2 * j] = __uint_as_float(w2[j] & 0xffff0000u);
          ev[1 + 2 * j] = __uint_as_float(wv[j] << 16); ev[2 + 2 * j] = __uint_as_float(wv[j] & 0xffff0000u);
        }
        unsigned o[4];
#pragma unroll
        for (int j = 0; j < 4; ++j) {
          const float xa = a0 * e2[2 * j] + a1 * e2[2 * j + 1] + a2 * e2[2 * j + 2] + ab;
          const float xb = a0 * e2[2 * j + 1] + a1 * e2[2 * j + 2] + a2 * e2[2 * j + 3] + ab;
          const float ya = v0 * ev[2 * j] + v1 * ev[2 * j + 1] + v2 * ev[2 * j + 2] + vb;
          const float yb = v0 * ev[2 * j + 1] + v1 * ev[2 * j + 2] + v2 * ev[2 * j + 3] + vb;
          o[j] = pack2(xa * ya, xb * yb);
        }
        uint4 ou; ou.x = o[0]; ou.y = o[1]; ou.z = o[2]; ou.w = o[3];
        *(uint4*)(Vl + (8 + m1 * 8 + b) * 80 + m2) = ou;
      }
    }
    if (tid < 144) {
      const int colp = tid / 9, part = tid - colp * 9;
      const int col = colp < 8 ? colp : 256 + colp;
      uint4 zz; zz.x = 0; zz.y = 0; zz.z = 0; zz.w = 0;
      *(uint4*)(Vl + col * 80 + part * 8) = zz;
    }
    __syncthreads();
#pragma unroll
    for (int s = 1; s < 4; ++s)
#pragma unroll
      for (int i = 0; i < 2; ++i) {
        const int ch = tid + 256 * i;
        unsigned e[8];
#pragma unroll
        for (int j = 0; j < 8; ++j) { const int idx = 8 * ch + s + j; e[j] = idx < 4096 ? (unsigned)cp[idx] : 0u; }
        uint4 u; u.x = e[0] | (e[1] << 16); u.y = e[2] | (e[3] << 16); u.z = e[4] | (e[5] << 16); u.w = e[6] | (e[7] << 16);
        *(uint4*)(cp + s * 4128 + 8 * ch) = u;
      }
    __syncthreads();
    const bf16_t* abase = cp + si * 4128 + (2048 - i16 - si + 8 * g4);
    f32x4 acc[4][4];
#pragma unroll
    for (int m = 0; m < 4; ++m)
#pragma unroll
      for (int n = 0; n < 4; ++n) acc[m][n] = (f32x4){0.f, 0.f, 0.f, 0.f};
    for (int dl = -31; dl <= 31; ++dl) {
      bf16x8 af[4][2];
#pragma unroll
      for (int mt = 0; mt < 4; ++mt)
#pragma unroll
        for (int kk = 0; kk < 2; ++kk) {
          const bf16_t* ap = abase - 64 * dl - 16 * mt + 32 * kk;
          const uint2 lo = *(const uint2*)ap, hi = *(const uint2*)(ap + 4);
          union { uint4 u; bf16x8 v; } cv; cv.u.x = lo.x; cv.u.y = lo.y; cv.u.z = hi.x; cv.u.w = hi.y;
          af[mt][kk] = cv.v;
        }
#pragma unroll
      for (int jt = 0; jt < 4; ++jt) {
        const int in0 = ocb + 16 * jt - 8 * dl;
        if (in0 >= -8 && in0 <= 248) {
          const bf16_t* bp = Vl + (in0 + 8 + i16) * 80 + 8 * g4;
          const bf16x8 b0 = *(const bf16x8*)bp, b1 = *(const bf16x8*)(bp + 32);
#pragma unroll
          for (int mt = 0; mt < 4; ++mt) {
            acc[mt][jt] = __builtin_amdgcn_mfma_f32_16x16x32_bf16(af[mt][0], b0, acc[mt][jt], 0, 0, 0);
            acc[mt][jt] = __builtin_amdgcn_mfma_f32_16x16x32_bf16(af[mt][1], b1, acc[mt][jt], 0, 0, 0);
          }
        }
      }
    }
    const float db = p.hy_d_bias[c];
#pragma unroll
    for (int mt = 0; mt < 4; ++mt)
#pragma unroll
      for (int jt = 0; jt < 4; ++jt) {
        const int col = ocb + 16 * jt + i16;
        const int n1 = col >> 3, b = col & 7;
        const int n2 = 16 * mt + 4 * g4;
        const uint2 vv = *(const uint2*)(Vl + (col + 8) * 80 + n2);
        const float y0 = acc[mt][jt][0] + bf2f((bf16_t)(vv.x & 0xffff)) * db;
        const float y1 = acc[mt][jt][1] + bf2f((bf16_t)(vv.x >> 16)) * db;
        const float y2 = acc[mt][jt][2] + bf2f((bf16_t)(vv.y & 0xffff)) * db;
        const float y3 = acc[mt][jt][3] + bf2f((bf16_t)(vv.y >> 16)) * db;
        uint2 u; u.x = pack2(y0, y1); u.y = pack2(y2, y3);
        *(uint2*)(p.Yp + (size_t)c * 16384 + b * 2048 + n1 * 64 + n2) = u;
      }
  }
}

__device__ __forceinline__ void phase_transmul(CP& p, char* smem) {
  bf16_t* tl = (bf16_t*)smem;
  const int tid = get_tid();
  for (int it = get_bid(); it < 4096; it += VGRID) {
    const int ct = it & 15, rt = it >> 4;
    const int c0 = ct * 64, r0 = rt * 64;
    __syncthreads();
#pragma unroll
    for (int i = 0; i < 2; ++i) {
      const int ci = tid + 256 * i; const int cc = ci >> 3, ch = ci & 7;
      const uint4 u = *(const uint4*)(p.Yp + (size_t)(c0 + cc) * 16384 + r0 + ch * 8);
      unsigned* d = (unsigned*)(tl + cc * 66 + ch * 8);
      d[0] = u.x; d[1] = u.y; d[2] = u.z; d[3] = u.w;
    }
    __syncthreads();
    const int row = tid >> 2, cq = tid & 3;
    const int grow = r0 + row, pos = grow & 2047;
    const int cbase = c0 + cq * 16;
    const bf16_t* xp = p.x1h + (size_t)grow * 1024 + cbase;
    uint4 zero4; zero4.x = 0; zero4.y = 0; zero4.z = 0; zero4.w = 0;
    const uint4 xa = *(const uint4*)xp, xb = *(const uint4*)(xp + 8);
    const bf16_t* xpp = pos > 0 ? xp - 1024 : xp;
    const bf16_t* xpn = pos < 2047 ? xp + 1024 : xp;
    const float pmk = pos > 0 ? 1.f : 0.f, nmk = pos < 2047 ? 1.f : 0.f;
    const uint4 pa = *(const uint4*)xpp, pb = *(const uint4*)(xpp + 8);
    const uint4 na = *(const uint4*)xpn, nb = *(const uint4*)(xpn + 8);
    (void)zero4;
    const unsigned xs[8] = {xa.x, xa.y, xa.z, xa.w, xb.x, xb.y, xb.z, xb.w};
    const unsigned ps[8] = {pa.x, pa.y, pa.z, pa.w, pb.x, pb.y, pb.z, pb.w};
    const unsigned ns[8] = {na.x, na.y, na.z, na.w, nb.x, nb.y, nb.z, nb.w};
    unsigned o[8];
#pragma unroll
    for (int j4 = 0; j4 < 4; ++j4) {
      const f32x4 w0 = *(const f32x4*)(p.hy_conv_w + cbase + 4 * j4) * pmk, w1 = *(const f32x4*)(p.hy_conv_w + 3072 + cbase + 4 * j4);
      const f32x4 w2 = *(const f32x4*)(p.hy_conv_w + 2 * 3072 + cbase + 4 * j4) * nmk, wb = *(const f32x4*)(p.hy_conv_b + cbase + 4 * j4);
#pragma unroll
      for (int jj = 0; jj < 2; ++jj) {
        const int j = 2 * j4 + jj;
        const float x0 = w0[2 * jj] * __uint_as_float(ps[j] << 16) + w1[2 * jj] * __uint_as_float(xs[j] << 16) + w2[2 * jj] * __uint_as_float(ns[j] << 16) + wb[2 * jj];
        const float x1 = w0[2 * jj + 1] * __uint_as_float(ps[j] & 0xffff0000u) + w1[2 * jj + 1] * __uint_as_float(xs[j] & 0xffff0000u) + w2[2 * jj + 1] * __uint_as_float(ns[j] & 0xffff0000u) + wb[2 * jj + 1];
        const float y0 = bf2f(tl[(cq * 16 + 2 * j) * 66 + row]) * x0;
        const float y1 = bf2f(tl[(cq * 16 + 2 * j + 1) * 66 + row]) * x1;
        o[j] = pack2(y0, y1);
      }
    }
    bf16_t* op = p.hxc + (size_t)(r0 + row) * 1024 + c0 + cq * 16;
    uint4 oa; oa.x = o[0]; oa.y = o[1]; oa.z = o[2]; oa.w = o[3];
    uint4 ob; ob.x = o[4]; ob.y = o[5]; ob.z = o[6]; ob.w = o[7];
    *(uint4*)op = oa; *(uint4*)(op + 8) = ob;
  }
}

__global__ void __launch_bounds__(512, 2) mega(P p_arg) {
  __shared__ __attribute__((aligned(16))) char smem[LDS_BYTES];
  cg::grid_group grid = cg::this_grid();
  const int G = gridDim.x;
  CP* pp = (CP*)__builtin_amdgcn_kernarg_segment_ptr();
  const int ph0 = pp->ph0, ph1 = pp->ph1;
  volatile LAS unsigned* xst = (volatile LAS unsigned*)(smem + LDS_BYTES - 16);
  if (threadIdx.x == 0) { xst[0] = 0u; xst[1] = 0u; }
  __syncthreads();
  const XcdBarrier xb = xcd_barrier_post(pp->bar, xst);
  if (ph0 <= 0 && 0 < ph1) {
    asm volatile("" : "+s"(pp));
    CP& p = *pp;
    const int bid = get_rbid();
    const int vid0 = (G & 7) ? bid : ((bid & 7) * (G >> 3) + (bid >> 3));
    const int hb = get_hb();
    char* smem_h = smem + hb * HALF_LDS; (void)smem_h;
    const float* mv0 = p.modv; const float* mv1 = p.modv + (size_t)9 * 6144;
    (void)mv0; (void)mv1; (void)vid0;
    phase_prep(p, smem_h);
    if (0 + 1 < ph1) { if (ph1 > 1000) grid.sync(); else xcd_barrier(xb); }
  }
  if (ph0 <= 1 && 1 < ph1) {
    asm volatile("" : "+s"(pp));
    CP& p = *pp;
    const int bid = get_rbid();
    const int vid0 = (G & 7) ? bid : ((bid & 7) * (G >> 3) + (bid >> 3));
    const int hb = get_hb();
    char* smem_h = smem + hb * HALF_LDS; (void)smem_h;
    const float* mv0 = p.modv; const float* mv1 = p.modv + (size_t)9 * 6144;
    (void)mv0; (void)mv1; (void)vid0;
    phase_normmod_kv(p);
    if (1 + 1 < ph1) { if (ph1 > 1000) grid.sync(); else xcd_barrier(xb); }
  }
  if (ph0 <= 2 && 2 < ph1) {
    asm volatile("" : "+s"(pp));
    CP& p = *pp;
    const int bid = get_rbid();
    const int vid0 = (G & 7) ? bid : ((bid & 7) * (G >> 3) + (bid >> 3));
    const int hb = get_hb();
    char* smem_h = smem + hb * HALF_LDS; (void)smem_h;
    const float* mv0 = p.modv; const float* mv1 = p.modv + (size_t)9 * 6144;
    (void)mv0; (void)mv1; (void)vid0;
    {
        EpiDown e1{p.cq, 512, 2048, p.rq, 4, nullptr, 1 << 30};
        gemm_job<true>(smem, p.hxc, 1024, p.wt_dq, 1024, 512, 16, 2304, 256, 128, 0, 2048, 128, 0, vid0, G, e1);
        EpiDown e2{p.kv, 288, 2304, p.rkv, 2, p.kpe, 256};
        gemm_job<true>(smem, p.hxc, 1024, p.wt_dkv, 1024, 288, 18, 2304, 0, 128, 0, 2304, 144, 64 * 2, vid0, G, e2);
        EpiFilt e3{p.Rf, p.hy_decay};
        gemm_job<false>(smem, p.h2bf, 64, p.wt_f3, 64, 2048, 16, 0, 0, 128, 0, 2048, 16, 64 * 2 + 72 * 2, vid0, G, e3);
      }
    if (2 + 1 < ph1) { if (ph1 > 1000) grid.sync(); else xcd_barrier(xb); }
  }
  if (ph0 <= 4 && 4 < ph1) {
    asm volatile("" : "+s"(pp));
    CP& p = *pp;
    const int bid = get_rbid();
    const int vid0 = (G & 7) ? bid : ((bid & 7) * (G >> 3) + (bid >> 3));
    const int hb = get_hb();
    char* smem_h = smem + hb * HALF_LDS; (void)smem_h;
    const float* mv0 = p.modv; const float* mv1 = p.modv + (size_t)9 * 6144;
    (void)mv0; (void)mv1; (void)vid0;
    {
        EpiStore<4> e1{p.Q, 1536, 2048, p.rq, 16384, 1.0f / 512.0f};
        gemm_job<true>(smem, p.cq, 512, p.wt_uq, 512, 1536, 16, 2048, 0, 128, 0, 2048, 128, 0, vid0, G, e1);
        EpiStore<2> e2{p.Kn, 1024, 2304, p.rkv, 18432, 1.0f / 256.0f};
        gemm_job<true>(smem, p.kv, 288, p.wt_uk, 256, 1024, 18, 2304, 0, 128, 0, 2304, 144, 64 * 6, vid0, G, e2);
        EpiVt e3{p.Vt, p.rkv};
        gemm_job<false>(smem, p.kv, 288, p.wt_uv, 256, 1024, 18, 2304, 0, 128, 0, 2304, 144, 64 * 6 + 72 * 4, vid0, G, e3);
      }
    if (4 + 1 < ph1) { if (ph1 > 1000) grid.sync(); else xcd_barrier(xb); }
  }
  if (ph0 <= 5 && 5 < ph1) {
    asm volatile("" : "+s"(pp));
    CP& p = *pp;
    const int bid = get_rbid();
    const int vid0 = (G & 7) ? bid : ((bid & 7) * (G >> 3) + (bid >> 3));
    const int hb = get_hb();
    char* smem_h = smem + hb * HALF_LDS; (void)smem_h;
    const float* mv0 = p.modv; const float* mv1 = p.modv + (size_t)9 * 6144;
    (void)mv0; (void)mv1; (void)vid0;
    phase_attn(p, smem_h, 2 * vid0 + hb, 2 * G);
    if (5 + 1 < ph1) { if (ph1 > 1000) grid.sync(); else xcd_barrier(xb); }
  }
  if (ph0 <= 6 && 6 < ph1) {
    asm volatile("" : "+s"(pp));
    CP& p = *pp;
    const int bid = get_rbid();
    const int vid0 = (G & 7) ? bid : ((bid & 7) * (G >> 3) + (bid >> 3));
    const int hb = get_hb();
    char* smem_h = smem + hb * HALF_LDS; (void)smem_h;
    const float* mv0 = p.modv; const float* mv1 = p.modv + (size_t)9 * 6144;
    (void)mv0; (void)mv1; (void)vid0;
    {
        EpiResid<true> e{p.X16, p.x, mv0 + 2 * 1024, nullptr};
        gemm_job<true>(smem, p.hxc, 1024, p.wt_o, 1024, 1024, 16, 2048, 0, 128, 0, 2048, 128, 0, vid0, G, e);
      }
    if (6 + 1 < ph1) { if (ph1 > 1000) grid.sync(); else xcd_barrier(xb); }
  }
  if (ph0 <= 7 && 7 < ph1) {
    asm volatile("" : "+s"(pp));
    CP& p = *pp;
    const int bid = get_rbid();
    const int vid0 = (G & 7) ? bid : ((bid & 7) * (G >> 3) + (bid >> 3));
    const int hb = get_hb();
    char* smem_h = smem + hb * HALF_LDS; (void)smem_h;
    const float* mv0 = p.modv; const float* mv1 = p.modv + (size_t)9 * 6144;
    (void)mv0; (void)mv1; (void)vid0;
    phase_normmod_x(p, p.norm_ffn_g, 0, 3);
    if (7 + 1 < ph1) { if (ph1 > 1000) grid.sync(); else xcd_barrier(xb); }
  }
  if (ph0 <= 8 && 8 < ph1) {
    asm volatile("" : "+s"(pp));
    CP& p = *pp;
    const int bid = get_rbid();
    const int vid0 = (G & 7) ? bid : ((bid & 7) * (G >> 3) + (bid >> 3));
    const int hb = get_hb();
    char* smem_h = smem + hb * HALF_LDS; (void)smem_h;
    const float* mv0 = p.modv; const float* mv1 = p.modv + (size_t)9 * 6144;
    (void)mv0; (void)mv1; (void)vid0;
    {
        EpiConv<0> e{p.ffn_conv_w, p.ffn_conv_b, 5632, nullptr, p.act, nullptr};
        gemm_job<true>(smem, p.hxc, 1024, p.wt_up0, 1024, 5632, 17, 2048, 0, 126, 1, 2048, 136, 0, vid0, G, e);
      }
    if (8 + 1 < ph1) { if (ph1 > 1000) grid.sync(); else xcd_barrier(xb); }
  }
  if (ph0 <= 9 && 9 < ph1) {
    asm volatile("" : "+s"(pp));
    CP& p = *pp;
    const int bid = get_rbid();
    const int vid0 = (G & 7) ? bid : ((bid & 7) * (G >> 3) + (bid >> 3));
    const int hb = get_hb();
    char* smem_h = smem + hb * HALF_LDS; (void)smem_h;
    const float* mv0 = p.modv; const float* mv1 = p.modv + (size_t)9 * 6144;
    (void)mv0; (void)mv1; (void)vid0;
    {
        EpiResid<false> e{p.X16, p.X16, mv0 + 5 * 1024, nullptr};
        gemm_job<true>(smem, p.act, 2816, p.wt_dn0, 2816, 1024, 16, 2048, 0, 128, 0, 2048, 128, 0, vid0, G, e);
      }
    if (9 + 1 < ph1) { if (ph1 > 1000) grid.sync(); else xcd_barrier(xb); }
  }
  if (ph0 <= 10 && 10 < ph1) {
    asm volatile("" : "+s"(pp));
    CP& p = *pp;
    const int bid = get_rbid();
    const int vid0 = (G & 7) ? bid : ((bid & 7) * (G >> 3) + (bid >> 3));
    const int hb = get_hb();
    char* smem_h = smem + hb * HALF_LDS; (void)smem_h;
    const float* mv0 = p.modv; const float* mv1 = p.modv + (size_t)9 * 6144;
    (void)mv0; (void)mv1; (void)vid0;
    phase_normmod_x(p, p.norm_mix_g + 1024, 1, 0);
    if (10 + 1 < ph1) { if (ph1 > 1000) grid.sync(); else xcd_barrier(xb); }
  }
  if (ph0 <= 11 && 11 < ph1) {
    asm volatile("" : "+s"(pp));
    CP& p = *pp;
    const int bid = get_rbid();
    const int vid0 = (G & 7) ? bid : ((bid & 7) * (G >> 3) + (bid >> 3));
    const int hb = get_hb();
    char* smem_h = smem + hb * HALF_LDS; (void)smem_h;
    const float* mv0 = p.modv; const float* mv1 = p.modv + (size_t)9 * 6144;
    (void)mv0; (void)mv1; (void)vid0;
    {
        EpiBiasStore e1{p.x1h, 1024, p.hy_b_in};
        gemm_job<true>(smem, p.hxc, 1024, p.wt_hin, 1024, 1024, 16, 2048, 0, 128, 0, 2048, 128, 0, vid0, G, e1);
        EpiBiasT e2{p.vvT, p.hy_b_in + 1024};
        gemm_job<false>(smem, p.hxc, 1024, p.wt_hin + (size_t)1024 * 1024, 1024, 2048, 16, 2048, 0, 128, 0, 2048, 128, 64 * 4, vid0, G, e2);
      }
    if (11 + 1 < ph1) { if (ph1 > 1000) grid.sync(); else xcd_barrier(xb); }
  }
  if (ph0 <= 12 && 12 < ph1) {
    asm volatile("" : "+s"(pp));
    CP& p = *pp;
    const int bid = get_rbid();
    const int vid0 = (G & 7) ? bid : ((bid & 7) * (G >> 3) + (bid >> 3));
    const int hb = get_hb();
    char* smem_h = smem + hb * HALF_LDS; (void)smem_h;
    const float* mv0 = p.modv; const float* mv1 = p.modv + (size_t)9 * 6144;
    (void)mv0; (void)mv1; (void)vid0;
    phase_hyconv(p, smem_h);
    if (12 + 1 < ph1) { if (ph1 > 1000) grid.sync(); else xcd_barrier(xb); }
  }
  if (ph0 <= 13 && 13 < ph1) {
    asm volatile("" : "+s"(pp));
    CP& p = *pp;
    const int bid = get_rbid();
    const int vid0 = (G & 7) ? bid : ((bid & 7) * (G >> 3) + (bid >> 3));
    const int hb = get_hb();
    char* smem_h = smem + hb * HALF_LDS; (void)smem_h;
    const float* mv0 = p.modv; const float* mv1 = p.modv + (size_t)9 * 6144;
    (void)mv0; (void)mv1; (void)vid0;
    phase_transmul(p, smem_h);
    if (13 + 1 < ph1) { if (ph1 > 1000) grid.sync(); else xcd_barrier(xb); }
  }
  if (ph0 <= 14 && 14 < ph1) {
    asm volatile("" : "+s"(pp));
    CP& p = *pp;
    const int bid = get_rbid();
    const int vid0 = (G & 7) ? bid : ((bid & 7) * (G >> 3) + (bid >> 3));
    const int hb = get_hb();
    char* smem_h = smem + hb * HALF_LDS; (void)smem_h;
    const float* mv0 = p.modv; const float* mv1 = p.modv + (size_t)9 * 6144;
    (void)mv0; (void)mv1; (void)vid0;
    {
        EpiResid<false> e{p.X16, p.X16, mv1 + 2 * 1024, p.hy_b_out};
        gemm_job<true>(smem, p.hxc, 1024, p.wt_hout, 1024, 1024, 16, 2048, 0, 128, 0, 2048, 128, 0, vid0, G, e);
      }
    if (14 + 1 < ph1) { if (ph1 > 1000) grid.sync(); else xcd_barrier(xb); }
  }
  if (ph0 <= 15 && 15 < ph1) {
    asm volatile("" : "+s"(pp));
    CP& p = *pp;
    const int bid = get_rbid();
    const int vid0 = (G & 7) ? bid : ((bid & 7) * (G >> 3) + (bid >> 3));
    const int hb = get_hb();
    char* smem_h = smem + hb * HALF_LDS; (void)smem_h;
    const float* mv0 = p.modv; const float* mv1 = p.modv + (size_t)9 * 6144;
    (void)mv0; (void)mv1; (void)vid0;
    phase_normmod_x(p, p.norm_ffn_g + 1024, 1, 3);
    if (15 + 1 < ph1) { if (ph1 > 1000) grid.sync(); else xcd_barrier(xb); }
  }
  if (ph0 <= 16 && 16 < ph1) {
    asm volatile("" : "+s"(pp));
    CP& p = *pp;
    const int bid = get_rbid();
    const int vid0 = (G & 7) ? bid : ((bid & 7) * (G >> 3) + (bid >> 3));
    const int hb = get_hb();
    char* smem_h = smem + hb * HALF_LDS; (void)smem_h;
    const float* mv0 = p.modv; const float* mv1 = p.modv + (size_t)9 * 6144;
    (void)mv0; (void)mv1; (void)vid0;
    {
        EpiConv<0> e{p.ffn_conv_w + (size_t)3 * 5632, p.ffn_conv_b + 5632, 5632, nullptr, p.act, nullptr};
        gemm_job<true>(smem, p.hxc, 1024, p.wt_up1, 1024, 5632, 17, 2048, 0, 126, 1, 2048, 136, 0, vid0, G, e);
      }
    if (16 + 1 < ph1) { if (ph1 > 1000) grid.sync(); else xcd_barrier(xb); }
  }
  if (ph0 <= 17 && 17 < ph1) {
    asm volatile("" : "+s"(pp));
    CP& p = *pp;
    const int bid = get_rbid();
    const int vid0 = (G & 7) ? bid : ((bid & 7) * (G >> 3) + (bid >> 3));
    const int hb = get_hb();
    char* smem_h = smem + hb * HALF_LDS; (void)smem_h;
    const float* mv0 = p.modv; const float* mv1 = p.modv + (size_t)9 * 6144;
    (void)mv0; (void)mv1; (void)vid0;
    {
        EpiResid<false> e{p.X16, p.X16, mv1 + 5 * 1024, nullptr};
        gemm_job<true>(smem, p.act, 2816, p.wt_dn1, 2816, 1024, 16, 2048, 0, 128, 0, 2048, 128, 0, vid0, G, e);
      }
    if (17 + 1 < ph1) { if (ph1 > 1000) grid.sync(); else xcd_barrier(xb); }
  }
  if (ph0 <= 18 && 18 < ph1) {
    asm volatile("" : "+s"(pp));
    CP& p = *pp;
    const int bid = get_rbid();
    const int vid0 = (G & 7) ? bid : ((bid & 7) * (G >> 3) + (bid >> 3));
    const int hb = get_hb();
    char* smem_h = smem + hb * HALF_LDS; (void)smem_h;
    const float* mv0 = p.modv; const float* mv1 = p.modv + (size_t)9 * 6144;
    (void)mv0; (void)mv1; (void)vid0;
    phase_final_norm(p);
    if (18 + 1 < ph1) { if (ph1 > 1000) grid.sync(); else xcd_barrier(xb); }
  }
}

extern "C" void kernel_launch(void* const* d_in, const int* in_sizes, int n_in, void* d_out, int out_size, void* d_ws, size_t ws_size, hipStream_t stream) {
  static int grid_blocks = 0;
  if (!grid_blocks) {
    int dev = 0, cus = 0, per_cu = 0;
    hipGetDevice(&dev);
    hipDeviceGetAttribute(&cus, hipDeviceAttributeMultiprocessorCount, dev);
    hipOccupancyMaxActiveBlocksPerMultiprocessor(&per_cu, (const void*)mega, 512, 0);
    per_cu = 1;
    grid_blocks = cus * per_cu;
  }
  P p{};
  const float** in = (const float**)&p;
  for (int i = 0; i < 36; ++i) in[i] = (const float*)d_in[i];
  p.X = (float*)d_out;
  char* ws = (char*)d_ws; size_t off = 0;
  auto take = [&](size_t bytes) { char* r = ws + off; off += (bytes + 255) & ~(size_t)255; return r; };
  p.wt_dq = (bf16_t*)take((size_t)512 * 1024 * 2);
  p.wt_dkv = (bf16_t*)take((size_t)288 * 1024 * 2);
  p.wt_uq = (bf16_t*)take((size_t)1536 * 512 * 2);
  p.wt_uk = (bf16_t*)take((size_t)1024 * 256 * 2);
  p.wt_uv = (bf16_t*)take((size_t)1024 * 256 * 2);
  p.wt_o = (bf16_t*)take((size_t)1024 * 1024 * 2);
  p.wt_hin = (bf16_t*)take((size_t)3072 * 1024 * 2);
  p.wt_hout = (bf16_t*)take((size_t)1024 * 1024 * 2);
  p.wt_up0 = (bf16_t*)take((size_t)5632 * 1024 * 2);
  p.wt_up1 = (bf16_t*)take((size_t)5632 * 1024 * 2);
  p.wt_dn0 = (bf16_t*)take((size_t)1024 * 2816 * 2);
  p.wt_dn1 = (bf16_t*)take((size_t)1024 * 2816 * 2);
  p.modv = (float*)take((size_t)2 * 9 * 6144 * 4);
  p.rq = (float*)take((size_t)4 * 16384 * 4);
  p.rkv = (float*)take((size_t)2 * 18432 * 4);
  p.modp = (float*)take((size_t)4 * 110592 * 4);
  p.bar = (unsigned*)take((size_t)XCD_BAR_WORDS * 4);
  p.wt_f3 = (bf16_t*)take((size_t)2048 * 64 * 2);
  p.h2bf = (bf16_t*)take((size_t)2048 * 64 * 2);
  p.Rf = (bf16_t*)take((size_t)1024 * 4096 * 2);
  p.kpe = (bf16_t*)take((size_t)18432 * 32 * 2);
  p.hxc = (bf16_t*)take((size_t)18432 * 1024 * 2);
  const size_t ubase = off;
  p.cq = (bf16_t*)take((size_t)16384 * 512 * 2);
  p.kv = (bf16_t*)take((size_t)18432 * 288 * 2);
  p.Q = (bf16_t*)take((size_t)16384 * 1536 * 2);
  p.Kn = (bf16_t*)take((size_t)18432 * 1024 * 2);
  p.Vt = (bf16_t*)take((size_t)18432 * 1024 * 2);
  const size_t uend1 = off;
  p.X16 = (bf16_t*)(ws + ubase + (size_t)104857600);
  off = ubase;
  p.act = (bf16_t*)take((size_t)16384 * 2816 * 2);
  off = ubase;
  p.x1h = (bf16_t*)take((size_t)16384 * 1024 * 2);
  p.vvT = (bf16_t*)take((size_t)2 * 16384 * 1024 * 2);
  p.Yp = p.vvT;
  if (uend1 > ws_size) { fprintf(stderr, "workspace too small: need %zu have %zu\n", uend1, ws_size); return; }
  p.ph0 = 0; p.ph1 = NPHASE;
  if (hipMemsetAsync(p.bar, 0, (size_t)XCD_BAR_WORDS * 4, stream) != hipSuccess) { fprintf(stderr, "memset failed\n"); return; }
  void* args[] = {&p};
  hipError_t e = hipLaunchCooperativeKernel((const void*)mega, dim3(grid_blocks), dim3(512), args, 0, stream);
  if (e != hipSuccess) fprintf(stderr, "cooperative launch failed: %s (grid %d)\n", hipGetErrorString(e), grid_blocks);
}
```

```cpp
#include <hip/hip_runtime.h>
#include <hip/hip_cooperative_groups.h>
#include <cstdio>
namespace cg = cooperative_groups;

typedef unsigned short bf16_t;
typedef short bf16x8 __attribute__((ext_vector_type(8)));
typedef float f32x4 __attribute__((ext_vector_type(4)));
typedef float f32x16 __attribute__((ext_vector_type(16)));

#define LDS_BYTES 163840
#define HALF_LDS 81920
#define NPHASE 19

struct P {
  const float *x, *c, *ctx, *c_ctx, *mod_w, *mod_b, *norm_mix_g, *norm_ffn_g;
  const float *w_dq, *g_q, *w_uq, *w_dkv, *g_kv, *w_uk, *w_uv, *w_o;
  const float *hy_w_in, *hy_b_in, *hy_conv_w, *hy_conv_b, *f_w1, *f_b1, *f_freq1, *f_w2, *f_b2, *f_freq2, *f_w3, *hy_decay, *hy_d_bias, *hy_w_out, *hy_b_out;
  const float *ffn_w_up, *ffn_conv_w, *ffn_conv_b, *ffn_w_down, *final_g;
  float* X;
  bf16_t *wt_dq, *wt_dkv, *wt_uq, *wt_uk, *wt_uv, *wt_o, *wt_hin, *wt_hout, *wt_up0, *wt_up1, *wt_dn0, *wt_dn1;
  float *modv, *rq, *rkv, *modp;
  unsigned* bar;
  bf16_t *wt_f3, *h2bf, *X16;
  bf16_t *Rf, *kpe, *hxc, *cq, *kv, *Q, *Kn, *Vt, *act, *x1h, *vvT, *Yp;
  int ph0, ph1;
};

typedef const __attribute__((address_space(4))) P CP;
__device__ __forceinline__ int get_tid512() { int t = threadIdx.x; asm volatile("" : "+v"(t)); return t; }
__device__ __forceinline__ int get_tid() { int t = threadIdx.x & 255; asm volatile("" : "+v"(t)); return t; }
__device__ __forceinline__ int get_hb() { int t = __builtin_amdgcn_readfirstlane((int)(threadIdx.x >> 8)); asm volatile("" : "+s"(t)); return t; }
__device__ __forceinline__ int get_rbid() { int t = blockIdx.x; asm volatile("" : "+s"(t)); return t; }
__device__ __forceinline__ int get_bid() { return 2 * get_rbid() + get_hb(); }
#define VGRID (2 * (int)gridDim.x)

__device__ __forceinline__ unsigned pack2(float a, float b) { unsigned r; asm("v_cvt_pk_bf16_f32 %0, %1, %2" : "=v"(r) : "v"(a), "v"(b)); return r; }
__device__ __forceinline__ bf16_t f2bf(float f) { return (bf16_t)(pack2(f, f) & 0xffffu); }
__device__ __forceinline__ float bf2f(bf16_t h) { return __uint_as_float(((unsigned)h) << 16); }
__device__ __forceinline__ float wave_sum(float v) {
#pragma unroll
  for (int o = 32; o; o >>= 1) v += __shfl_xor(v, o);
  return v;
}


#define XB_TMO      128
#define XB_XCNT(j)  (256  + 64 * (j))
#define XB_XSUB(j)  (1280 + 64 * (j))
#define XB_XGEN(j)  (2304 + 64 * (j))
#define XB_TOP      3328
#define XB_TOPGEN   3392
#define XCD_BAR_WORDS 3456
#define XB_SPIN_CAP (1u << 18)
#define LAS __attribute__((address_space(3)))
__device__ __forceinline__ unsigned xb_ld(unsigned* p)              { return __hip_atomic_load(p, __ATOMIC_RELAXED, __HIP_MEMORY_SCOPE_AGENT); }
__device__ __forceinline__ unsigned xb_add(unsigned* p, unsigned v) { return __hip_atomic_fetch_add(p, v, __ATOMIC_RELAXED, __HIP_MEMORY_SCOPE_AGENT); }
__device__ __forceinline__ unsigned xb_xcc_id() { return (unsigned)__builtin_amdgcn_s_getreg((3 << 11) | 20) & 0xFu; }
#define XB_SPIN(cond, bar) do { unsigned _sp = 0; while (cond) { __builtin_amdgcn_s_sleep(1); \
    if ((++_sp & 255u) == 0u) { if (xb_ld(&(bar)[XB_TMO])) break; if (_sp > XB_SPIN_CAP) { atomicAdd(&(bar)[XB_TMO], 1u); break; } } } } while (0)
struct XcdBarrier { unsigned* bar; unsigned x; volatile LAS unsigned* st; };
__device__ __forceinline__ XcdBarrier xcd_barrier_post(unsigned* bar, volatile LAS unsigned* st) {
    XcdBarrier b; b.bar = bar; b.x = xb_xcc_id(); b.st = st;
    if (threadIdx.x == 0) (void)xb_add(&bar[XB_XCNT(b.x)], 1u);
    return b;
}
__device__ __forceinline__ void xcd_barrier_complete(unsigned* bar, unsigned x, unsigned& nloc, unsigned& nx) {
    const unsigned G = gridDim.x * gridDim.y * gridDim.z;
    unsigned sum, cnt, mine, sp = 0u;
    for (;;) {
        sum = 0u; cnt = 0u; mine = 0u;
#pragma unroll
        for (unsigned j = 0; j < 16; ++j) { const unsigned c = xb_ld(&bar[XB_XCNT(j)]); sum += c; cnt += (c > 0u) ? 1u : 0u; mine = (j == x) ? c : mine; }
        if (sum == G) break;
        __builtin_amdgcn_s_sleep(1);
        if ((++sp & 255u) == 0u) { if (xb_ld(&bar[XB_TMO])) break; if (sp > XB_SPIN_CAP) { atomicAdd(&bar[XB_TMO], 1u); break; } }
    }
    nloc = mine > 0u ? mine : 1u; nx = cnt > 0u ? cnt : 1u;
}
__device__ __forceinline__ void xcd_barrier(const XcdBarrier& b) {
    asm volatile("s_waitcnt vmcnt(0)" ::: "memory");
    __syncthreads();
    if (threadIdx.x == 0) {
        unsigned* bar = b.bar;
        __builtin_amdgcn_s_waitcnt(0);
        unsigned nloc = b.st[0], nx = b.st[1];
        if (nloc == 0u) { xcd_barrier_complete(bar, b.x, nloc, nx); b.st[0] = nloc; b.st[1] = nx; }
        const unsigned old = xb_add(&bar[XB_XSUB(b.x)], 1u);
        const unsigned gen = old / nloc;
        if (old + 1u == (gen + 1u) * nloc) {
            __builtin_amdgcn_fence(__ATOMIC_RELEASE, "agent");
            asm volatile("s_waitcnt vmcnt(0)" ::: "memory");
            const unsigned og = xb_add(&bar[XB_TOP], 1u);
            const unsigned tg = og / nx;
            if (og + 1u == (tg + 1u) * nx) xb_add(&bar[XB_TOPGEN], 1u);
            else XB_SPIN(xb_ld(&bar[XB_TOPGEN]) == tg, bar);
            __builtin_amdgcn_fence(__ATOMIC_ACQUIRE, "agent");
            xb_add(&bar[XB_XGEN(b.x)], 1u);
            asm volatile("s_waitcnt vmcnt(0)" ::: "memory");
        } else {
            XB_SPIN(xb_ld(&bar[XB_XGEN(b.x)]) == gen, bar);
            __builtin_amdgcn_fence(__ATOMIC_ACQUIRE, "agent");
            asm volatile("s_waitcnt vmcnt(0)" ::: "memory");
        }
    }
    __syncthreads();
}

__device__ __forceinline__ void prep_weight_tile(CP& p, char* smem, int wt) {
  const int tid = get_tid();
  int id = 0;
  {
    const int cnt[13] = {64, 40, 96, 32, 32, 128, 384, 128, 704, 704, 352, 352, 32};
#pragma unroll
    for (int i = 0; i < 12; ++i) { if (id == i && wt >= cnt[i]) { wt -= cnt[i]; id = i + 1; } }
  }
  const float* src; int K, N; bf16_t* dst; const float* scale = nullptr; int perm = 0;
  switch (id) {
    case 0: src = p.w_dq; K = 1024; N = 512; dst = p.wt_dq; break;
    case 1: src = p.w_dkv; K = 1024; N = 288; dst = p.wt_dkv; break;
    case 2: src = p.w_uq; K = 512; N = 1536; dst = p.wt_uq; scale = p.g_q; break;
    case 3: src = p.w_uk; K = 256; N = 1024; dst = p.wt_uk; scale = p.g_kv; break;
    case 4: src = p.w_uv; K = 256; N = 1024; dst = p.wt_uv; scale = p.g_kv; break;
    case 5: src = p.w_o; K = 1024; N = 1024; dst = p.wt_o; break;
    case 6: src = p.hy_w_in; K = 1024; N = 3072; dst = p.wt_hin; break;
    case 7: src = p.hy_w_out; K = 1024; N = 1024; dst = p.wt_hout; break;
    case 8: src = p.ffn_w_up; K = 1024; N = 5632; dst = p.wt_up0; perm = 1; break;
    case 9: src = p.ffn_w_up + (size_t)1024 * 5632; K = 1024; N = 5632; dst = p.wt_up1; perm = 1; break;
    case 10: src = p.ffn_w_down; K = 2816; N = 1024; dst = p.wt_dn0; break;
    case 11: src = p.ffn_w_down + (size_t)2816 * 1024; K = 2816; N = 1024; dst = p.wt_dn1; break;
    default: src = p.f_w3; K = 64; N = 2048; dst = p.wt_f3; break;
  }
  const int ntn = (N + 63) >> 6;
  const int kt = wt / ntn, nt = wt - kt * ntn;
  const int k0 = kt * 128, n0 = nt * 64;
  int np0;
  if (perm == 1) { const int half = n0 / 2816, f = n0 - half * 2816; np0 = (f >> 6) * 128 + half * 64; }
  else if (perm == 2) { if (n0 < 1024) np0 = n0; else { const int m = n0 - 1024, half = m >> 10, f = m & 1023; np0 = 1024 + (f >> 6) * 128 + half * 64; } }
  else np0 = n0;
  bf16_t* t16 = (bf16_t*)smem;
  f32x4 v[8];
#pragma unroll
  for (int i = 0; i < 8; ++i) {
    const int idx = tid + 256 * i; const int kr = idx >> 4, c4 = idx & 15;
    v[i] = (f32x4){0.f, 0.f, 0.f, 0.f};
    if (n0 + 4 * c4 < N && k0 + kr < K) v[i] = *(const f32x4*)(src + (size_t)(k0 + kr) * N + n0 + 4 * c4);
  }
#pragma unroll
  for (int i = 0; i < 8; ++i) {
    const int idx = tid + 256 * i; const int kr = idx >> 4, c4 = idx & 15;
    const float sc = (scale && k0 + kr < K) ? scale[k0 + kr] : 1.f;
#pragma unroll
    for (int j = 0; j < 4; ++j) t16[(4 * c4 + j) * 136 + kr] = f2bf(v[i][j] * sc);
  }
  __syncthreads();
#pragma unroll
  for (int i = 0; i < 4; ++i) {
    const int idx = tid + 256 * i; const int n = idx >> 4, ch = idx & 15;
    if (n0 + n < N && k0 + ch * 8 < K) *(uint4*)(dst + (size_t)(np0 + n) * K + k0 + ch * 8) = *(const uint4*)(t16 + n * 136 + ch * 8);
  }
  __syncthreads();
}

__device__ __forceinline__ void prep_modvec(CP& p, char* smem, int it) {
  const int tid = get_tid();
  const int layer = it / 384, rem = it - layer * 384, cb = rem >> 2, ks = rem & 3;
  float* s_lds = (float*)smem;
  float* red = (float*)(smem + 12288);
  const int kbase = ks * 256;
  for (int idx = tid; idx < 9 * 256; idx += 256) {
    const int r = idx >> 8, k = idx & 255;
    const float v = r < 8 ? p.c[r * 1024 + kbase + k] : p.c_ctx[kbase + k];
    s_lds[k * 12 + r] = v / (1.f + __expf(-v));
  }
  __syncthreads();
  const int col = cb * 64 + (tid & 63), kg = tid >> 6;
  const float* W = p.mod_w + (size_t)layer * 1024 * 6144 + (size_t)kbase * 6144 + col;
  float acc[9];
#pragma unroll
  for (int r = 0; r < 9; ++r) acc[r] = 0.f;
#pragma unroll
  for (int kb = 0; kb < 4; ++kb) {
    float w[16];
#pragma unroll
    for (int u = 0; u < 16; ++u) w[u] = W[(size_t)(kg * 64 + kb * 16 + u) * 6144];
#pragma unroll
    for (int u = 0; u < 16; ++u) {
      const int k = kg * 64 + kb * 16 + u;
      const f32x4 s0 = *(const f32x4*)(s_lds + k * 12), s1 = *(const f32x4*)(s_lds + k * 12 + 4);
      const float s2 = s_lds[k * 12 + 8];
      acc[0] += s0[0] * w[u]; acc[1] += s0[1] * w[u]; acc[2] += s0[2] * w[u]; acc[3] += s0[3] * w[u];
      acc[4] += s1[0] * w[u]; acc[5] += s1[1] * w[u]; acc[6] += s1[2] * w[u]; acc[7] += s1[3] * w[u];
      acc[8] += s2 * w[u];
    }
  }
#pragma unroll
  for (int r = 0; r < 9; ++r) red[(kg * 9 + r) * 64 + (tid & 63)] = acc[r];
  __syncthreads();
  for (int o = tid; o < 9 * 64; o += 256) {
    const int r = o >> 6, cl = o & 63;
    const float sm = red[(0 * 9 + r) * 64 + cl] + red[(1 * 9 + r) * 64 + cl] + red[(2 * 9 + r) * 64 + cl] + red[(3 * 9 + r) * 64 + cl];
    p.modp[(size_t)ks * 110592 + (size_t)(layer * 9 + r) * 6144 + cb * 64 + cl] = sm;
  }
  __syncthreads();
}

__device__ __forceinline__ void prep_filter(CP& p, char* smem, int it) {
  const int tid = get_tid();
  float* z = (float*)smem;
  float* h1 = z + 8 * 33;
  float* h2 = h1 + 8 * 64;
  const int t0 = it * 8;
  for (int idx = tid; idx < 8 * 33; idx += 256) {
    const int pp = idx / 33, i = idx - pp * 33;
    const int t = t0 + pp;
    float v;
    if (i == 0) v = (float)t * (1.0f / 2047.0f);
    else {
      const int k = (i - 1) & 15;
      const float w = (6.283185307179586f * (float)t) / 2048.0f;
      const float f = 1e-4f + (float)k * ((15.0f - 1e-4f) / 15.0f);
      const float a = w * f;
      v = (i <= 16) ? __cosf(a) : -__sinf(a);
    }
    z[idx] = v;
  }
  __syncthreads();
  for (int idx = tid; idx < 8 * 64; idx += 256) {
    const int pp = idx >> 6, j = idx & 63;
    float s = p.f_b1[j];
#pragma unroll
    for (int i = 0; i < 33; ++i) s += z[pp * 33 + i] * p.f_w1[i * 64 + j];
    h1[idx] = __sinf(p.f_freq1[j] * s);
  }
  __syncthreads();
  for (int idx = tid; idx < 8 * 64; idx += 256) {
    const int pp = idx >> 6, j = idx & 63;
    float s = p.f_b2[j];
#pragma unroll 16
    for (int i = 0; i < 64; ++i) s += h1[pp * 64 + i] * p.f_w2[i * 64 + j];
    h2[idx] = __sinf(p.f_freq2[j] * s);
  }
  __syncthreads();
  for (int idx = tid; idx < 8 * 64; idx += 256) p.h2bf[(size_t)t0 * 64 + idx] = f2bf(h2[idx]);
  __syncthreads();
}

__device__ __forceinline__ void phase_prep(CP& p, char* smem) {
  const int total = 768 + 256 + 3048;
  for (int it = get_bid(); it < total; it += VGRID) {
    if (it < 768) prep_modvec(p, smem, it);
    else if (it < 1024) prep_filter(p, smem, it - 768);
    else prep_weight_tile(p, smem, it - 1024);
  }
}

__device__ __forceinline__ f32x4 ld4_bf16(const bf16_t* p) {
  const uint2 u = *(const uint2*)p;
  f32x4 r; r[0] = bf2f((bf16_t)(u.x & 0xffff)); r[1] = bf2f((bf16_t)(u.x >> 16)); r[2] = bf2f((bf16_t)(u.y & 0xffff)); r[3] = bf2f((bf16_t)(u.y >> 16));
  return r;
}
template <bool PART, bool SRC16 = false>
__device__ __forceinline__ void normmod_row2(const void* __restrict__ srcv, const float* __restrict__ g, const float* __restrict__ sh, const float* __restrict__ sc, bf16_t* __restrict__ dst, int lane, const float* __restrict__ bsh = nullptr) {
  f32x4 v[2][4]; float ss0 = 0.f, ss1 = 0.f;
#pragma unroll
  for (int i = 0; i < 4; ++i) {
    if (SRC16) { v[0][i] = ld4_bf16((const bf16_t*)srcv + lane * 4 + 256 * i); v[1][i] = ld4_bf16((const bf16_t*)srcv + 1024 + lane * 4 + 256 * i); }
    else { v[0][i] = *(const f32x4*)((const float*)srcv + lane * 4 + 256 * i); v[1][i] = *(const f32x4*)((const float*)srcv + 1024 + lane * 4 + 256 * i); }
  }
#pragma unroll
  for (int i = 0; i < 4; ++i) {
    ss0 += v[0][i][0] * v[0][i][0] + v[0][i][1] * v[0][i][1] + v[0][i][2] * v[0][i][2] + v[0][i][3] * v[0][i][3];
    ss1 += v[1][i][0] * v[1][i][0] + v[1][i][1] * v[1][i][1] + v[1][i][2] * v[1][i][2] + v[1][i][3] * v[1][i][3];
  }
  ss0 = wave_sum(ss0); ss1 = wave_sum(ss1);
  const float r0 = rsqrtf(ss0 * (1.0f / 1024.0f) + 1e-6f), r1 = rsqrtf(ss1 * (1.0f / 1024.0f) + 1e-6f);
#pragma unroll
  for (int i = 0; i < 4; ++i) {
    const int k = lane * 4 + 256 * i;
    const f32x4 g4 = *(const f32x4*)(g + k);
    f32x4 s4 = *(const f32x4*)(sh + k), c4 = *(const f32x4*)(sc + k);
    if (PART) {
#pragma unroll
      for (int q = 1; q < 4; ++q) { s4 += *(const f32x4*)(sh + (size_t)q * 110592 + k); c4 += *(const f32x4*)(sc + (size_t)q * 110592 + k); }
      s4 += *(const f32x4*)(bsh + k); c4 += *(const f32x4*)(bsh + 1024 + k);
    }
    float y[4], z[4];
#pragma unroll
    for (int j = 0; j < 4; ++j) { const float gm = g4[j] * (1.f + c4[j]); y[j] = (v[0][i][j] * r0) * gm + s4[j]; z[j] = (v[1][i][j] * r1) * gm + s4[j]; }
    uint2 u; u.x = pack2(y[0], y[1]); u.y = pack2(y[2], y[3]);
    *(uint2*)(dst + k) = u;
    u.x = pack2(z[0], z[1]); u.y = pack2(z[2], z[3]);
    *(uint2*)(dst + 1024 + k) = u;
  }
}

__device__ __forceinline__ void phase_normmod_kv(CP& p) {
  const int lane = get_tid() & 63, wv = get_tid() >> 6;
  const float* g = p.norm_mix_g;
  for (int idx = get_bid() * 256 + get_tid(); idx < 110592; idx += VGRID * 256) {
    const int lr = idx / 6144; const int n = idx - lr * 6144; const int layer = lr / 9;
    p.modv[idx] = p.modp[idx] + p.modp[110592 + idx] + p.modp[2 * 110592 + idx] + p.modp[3 * 110592 + idx] + p.mod_b[layer * 6144 + n];
  }
  for (int r = (get_bid() * 4 + wv) * 2; r < 18432; r += VGRID * 8) {
    const int b = r / 2304, pp = r - b * 2304;
    const float* src; const float* mv;
    if (pp < 256) { src = p.ctx + ((size_t)b * 256 + pp) * 1024; mv = p.modp + (size_t)8 * 6144; }
    else { src = p.x + ((size_t)b * 2048 + pp - 256) * 1024; mv = p.modp + (size_t)b * 6144; }
    normmod_row2<true>(src, g, mv, mv + 1024, p.hxc + (size_t)r * 1024, lane, p.mod_b);
  }
}
__device__ __forceinline__ void phase_normmod_x(CP& p, const float* g, int layer, int chunk) {
  const int lane = get_tid() & 63, wv = get_tid() >> 6;
  for (int r = (get_bid() * 4 + wv) * 2; r < 16384; r += VGRID * 8) {
    const int b = r >> 11;
    const float* mv = p.modv + (size_t)(layer * 9 + b) * 6144 + chunk * 1024;
    normmod_row2<false, true>(p.X16 + (size_t)r * 1024, g, mv, mv + 1024, p.hxc + (size_t)r * 1024, lane);
  }
}
__device__ __forceinline__ void phase_final_norm(CP& p) {
  const int lane = get_tid() & 63, wv = get_tid() >> 6;
  for (int r = get_bid() * 4 + wv; r < 16384; r += VGRID * 4) {
    const bf16_t* srow = p.X16 + (size_t)r * 1024;
    float* row = p.X + (size_t)r * 1024;
    f32x4 v[4]; float ss = 0.f;
#pragma unroll
    for (int i = 0; i < 4; ++i) { v[i] = ld4_bf16(srow + lane * 4 + 256 * i); ss += v[i][0] * v[i][0] + v[i][1] * v[i][1] + v[i][2] * v[i][2] + v[i][3] * v[i][3]; }
    ss = wave_sum(ss);
    const float rr = rsqrtf(ss * (1.0f / 1024.0f) + 1e-6f);
#pragma unroll
    for (int i = 0; i < 4; ++i) {
      const int k = lane * 4 + 256 * i;
      const f32x4 g4 = *(const f32x4*)(p.final_g + k);
      f32x4 o; o[0] = v[i][0] * rr * g4[0]; o[1] = v[i][1] * rr * g4[1]; o[2] = v[i][2] * rr * g4[2]; o[3] = v[i][3] * rr * g4[3];
      *(f32x4*)(row + k) = o;
    }
  }
}

__device__ __forceinline__ void phase_rowstat(CP& p) {
  const int lane = get_tid() & 63, wv = get_tid() >> 6;
  for (int r = get_bid() * 4 + wv; r < 18432; r += VGRID * 4) {
    const int b = r / 2304, pp = r - b * 2304;
    const bf16_t* kvr = p.kv + (size_t)r * 288;
    {
      const uint2 u = *(const uint2*)(kvr + lane * 4);
      const float a0 = bf2f((bf16_t)(u.x & 0xffff)), a1 = bf2f((bf16_t)(u.x >> 16)), a2 = bf2f((bf16_t)(u.y & 0xffff)), a3 = bf2f((bf16_t)(u.y >> 16));
      float ss = a0 * a0 + a1 * a1 + a2 * a2 + a3 * a3;
      ss = wave_sum(ss);
      if (lane == 0) p.rkv[r] = rsqrtf(ss * (1.0f / 256.0f) + 1e-6f);
    }
    {
      const int i = lane & 31;
      const float xv = bf2f(kvr[256 + i]);
      const float ov = __shfl_xor(xv, 8);
      float res = xv;
      if (pp >= 256) {
        const int t = pp - 256;
        const int quarter = i >> 3, idx = i & 7;
        const float pos = (quarter < 2) ? (float)(t >> 6) : (float)(t & 63);
        const float inv = exp2f(-(float)idx * (13.287712379549449f / 8.0f));
        const float ang = pos * inv;
        const float cs = __cosf(ang), sn = __sinf(ang);
        res = xv * cs + ((quarter & 1) ? ov : -ov) * sn;
      }
      if (lane < 32) p.kpe[(size_t)r * 32 + i] = f2bf(res);
    }
    if (pp >= 256) {
      const int xr = b * 2048 + pp - 256;
      const uint4 u = *(const uint4*)(p.cq + (size_t)xr * 512 + lane * 8);
      const unsigned uu[4] = {u.x, u.y, u.z, u.w};
      float ss = 0.f;
#pragma unroll
      for (int j = 0; j < 4; ++j) { const float a = bf2f((bf16_t)(uu[j] & 0xffff)), bb = bf2f((bf16_t)(uu[j] >> 16)); ss += a * a + bb * bb; }
      ss = wave_sum(ss);
      if (lane == 0) p.rq[xr] = rsqrtf(ss * (1.0f / 512.0f) + 1e-6f);
    }
  }
}

template <int NP>
struct EpiStore {
  static constexpr int KIND = 0; static constexpr bool ROWSUM = false;
  bf16_t* out; int ld; int ostride; const float* part; int pstride; float inv_n;
  __device__ __forceinline__ void c4(int g, int rig, int col, f32x4 v) const {
    const size_t row = (size_t)g * ostride + rig;
    float s = 1.f;
    if (NP > 0) {
      float t = 0.f;
#pragma unroll
      for (int q = 0; q < NP; ++q) t += part[(size_t)q * pstride + row];
      s = rsqrtf(t * inv_n + 1e-6f);
    }
    uint2 u; u.x = pack2(v[0] * s, v[1] * s); u.y = pack2(v[2] * s, v[3] * s);
    *(uint2*)(out + row * ld + col) = u;
  }
};
struct EpiDown {
  static constexpr int KIND = 0; static constexpr bool ROWSUM = true;
  bf16_t* out; int ld; int ostride; float* part; int nslots; bf16_t* kpe; int ropecol;
  __device__ __forceinline__ float c4(int g, int rig, int col, f32x4 v) const {
    const size_t row = (size_t)g * ostride + rig;
    if (kpe && col >= ropecol) {
      const int i0 = col - ropecol;
      f32x4 o = v;
      const float p0 = __shfl_xor(v[0], 32), p1 = __shfl_xor(v[1], 32), p2 = __shfl_xor(v[2], 32), p3 = __shfl_xor(v[3], 32);
      const float pv[4] = {p0, p1, p2, p3};
      if (rig >= 256) {
        const int t = rig - 256;
        const int quarter = i0 >> 3;
        const float pos = (quarter < 2) ? (float)(t >> 6) : (float)(t & 63);
#pragma unroll
        for (int j = 0; j < 4; ++j) {
          const int idx = (i0 & 7) + j;
          const float inv = exp2f(-(float)idx * (13.287712379549449f / 8.0f));
          const float ang = pos * inv;
          const float cs = __cosf(ang), sn = __sinf(ang);
          o[j] = v[j] * cs + ((quarter & 1) ? pv[j] : -pv[j]) * sn;
        }
      }
      uint2 u; u.x = pack2(o[0], o[1]); u.y = pack2(o[2], o[3]);
      *(uint2*)(kpe + row * 32 + i0) = u;
      return 0.f;
    }
    uint2 u; u.x = pack2(v[0], v[1]); u.y = pack2(v[2], v[3]);
    *(uint2*)(out + row * ld + col) = u;
    return v[0] * v[0] + v[1] * v[1] + v[2] * v[2] + v[3] * v[3];
  }
  __device__ __forceinline__ void rowsum(int g, int rig, int slot, float ss) const {
    if (slot < nslots) part[(size_t)slot * ((size_t)8 * ostride) + (size_t)g * ostride + rig] = ss;
  }
};
struct EpiVt {
  static constexpr int KIND = 1;
  bf16_t* out; const float* part;
  __device__ __forceinline__ void r4(int g, int rig, int col, f32x4 v) const {
    const size_t row = (size_t)g * 2304 + rig;
    const f32x4 t = *(const f32x4*)(part + row) + *(const f32x4*)(part + 18432 + row);
    f32x4 s;
#pragma unroll
    for (int j = 0; j < 4; ++j) s[j] = rsqrtf(t[j] * (1.0f / 256.0f) + 1e-6f);
    uint2 u; u.x = pack2(v[0] * s[0], v[1] * s[1]); u.y = pack2(v[2] * s[2], v[3] * s[3]);
    *(uint2*)(out + ((size_t)g * 1024 + col) * 2304 + rig) = u;
  }
};
struct EpiBiasStore {
  static constexpr int KIND = 0; static constexpr bool ROWSUM = false;
  bf16_t* out; int ld; const float* bias;
  __device__ __forceinline__ void c4(int g, int rig, int col, f32x4 v) const {
    const size_t row = (size_t)g * 2048 + rig;
    const f32x4 b4 = *(const f32x4*)(bias + col);
    uint2 u; u.x = pack2(v[0] + b4[0], v[1] + b4[1]); u.y = pack2(v[2] + b4[2], v[3] + b4[3]);
    *(uint2*)(out + row * ld + col) = u;
  }
};
struct EpiBiasT {
  static constexpr int KIND = 1;
  bf16_t* out; const float* bias;
  __device__ __forceinline__ void r4(int g, int rig, int col, f32x4 v) const {
    const float b = bias[col];
    uint2 u; u.x = pack2(v[0] + b, v[1] + b); u.y = pack2(v[2] + b, v[3] + b);
    *(uint2*)(out + (size_t)col * 16384 + (size_t)g * 2048 + rig) = u;
  }
};
struct EpiFilt {
  static constexpr int KIND = 1;
  bf16_t* Rf; const float* decay;
  __device__ __forceinline__ void r4(int g, int rig, int col, f32x4 v) const {
    const int c = col & 1023; const bool bwd = col >= 1024;
    const float dec = fabsf(decay[c]);
    bf16_t* rp = Rf + (size_t)c * 4096;
#pragma unroll
    for (int j = 0; j < 4; ++j) {
      const int t = rig + j;
      const float val = v[j] * __expf(-(float)t * (1.0f / 2047.0f) * dec);
      if (!bwd) rp[2048 - t] = f2bf(val);
      else if (t > 0) rp[2048 + t] = f2bf(val);
      else rp[0] = 0;
    }
  }
};
template <bool BASE_F32>
struct EpiResid {
  static constexpr int KIND = 0; static constexpr bool ROWSUM = false;
  bf16_t* X16; const void* base; const float* gate; const float* bias;
  __device__ __forceinline__ void c4(int g, int rig, int col, f32x4 v) const {
    const size_t o = ((size_t)g * 2048 + rig) * 1024 + col;
    f32x4 bs;
    if (BASE_F32) bs = *(const f32x4*)((const float*)base + o);
    else {
      const uint2 u = *(const uint2*)((const bf16_t*)base + o);
      bs[0] = bf2f((bf16_t)(u.x & 0xffff)); bs[1] = bf2f((bf16_t)(u.x >> 16)); bs[2] = bf2f((bf16_t)(u.y & 0xffff)); bs[3] = bf2f((bf16_t)(u.y >> 16));
    }
    const f32x4 gt = *(const f32x4*)(gate + (size_t)g * 6144 + col);
    f32x4 bi = {0.f, 0.f, 0.f, 0.f};
    if (bias) bi = *(const f32x4*)(bias + col);
    f32x4 r;
#pragma unroll
    for (int j = 0; j < 4; ++j) r[j] = bs[j] + gt[j] * (v[j] + bi[j]);
    uint2 w; w.x = pack2(r[0], r[1]); w.y = pack2(r[2], r[3]);
    *(uint2*)(X16 + o) = w;
  }
};
template <int MODE>
struct EpiConv {
  static constexpr int KIND = 2;
  const float* cw; const float* cb; int NC; const float* pre_bias;
  bf16_t* o0; bf16_t* o1;
  __device__ __forceinline__ int norig(int nt, int cl) const {
    if (MODE == 0) return (cl >> 6) * 2816 + nt * 64 + (cl & 63);
    if (nt < 8) return nt * 128 + cl;
    return 1024 + (cl >> 6) * 1024 + (nt - 8) * 64 + (cl & 63);
  }
  typedef float f32x2_t __attribute__((ext_vector_type(2)));
  static __device__ __forceinline__ f32x2_t ldz(const bf16_t* Z, int row, int col) {
    const unsigned u = *(const unsigned*)(Z + row * 132 + col);
    f32x2_t r; r[0] = __uint_as_float(u << 16); r[1] = __uint_as_float(u & 0xffff0000u); return r;
  }
  template <class F>
  __device__ __forceinline__ void finish(const bf16_t* Z, int g, int rig0, int nt, F&& pre) const {
    typedef f32x2_t f32x2;
    const int tid = get_tid();
    if (MODE == 0 || nt < 8) {
      if (MODE == 0) {
        const int f2 = (tid & 31) * 2, q8 = tid >> 5;
        const int q0 = 1 + 16 * q8, q1 = (q0 + 16 < 127) ? q0 + 16 : 127;
        const int na = norig(nt, f2), ng = norig(nt, 64 + f2);
        const f32x2 a0 = *(const f32x2*)(cw + na), a1 = *(const f32x2*)(cw + NC + na), a2 = *(const f32x2*)(cw + 2 * NC + na), ab = *(const f32x2*)(cb + na);
        const f32x2 g0 = *(const f32x2*)(cw + ng), g1 = *(const f32x2*)(cw + NC + ng), g2 = *(const f32x2*)(cw + 2 * NC + ng), gb = *(const f32x2*)(cb + ng);
        pre();
        f32x2 am = ldz(Z, q0 - 1, f2), ac = ldz(Z, q0, f2);
        f32x2 gm = ldz(Z, q0 - 1, 64 + f2), gc = ldz(Z, q0, 64 + f2);
#pragma unroll 2
        for (int pl = q0; pl < q1; ++pl) {
          const f32x2 an = ldz(Z, pl + 1, f2), gn = ldz(Z, pl + 1, 64 + f2);
          const int pos = rig0 + pl;
          if (pos < 2048) {
            const f32x2 av = a0 * am + a1 * ac + a2 * an + ab;
            const f32x2 gv = g0 * gm + g1 * gc + g2 * gn + gb;
            const float s0 = av[0] * gv[0] * __builtin_amdgcn_rcpf(1.f + __expf(-gv[0]));
            const float s1 = av[1] * gv[1] * __builtin_amdgcn_rcpf(1.f + __expf(-gv[1]));
            *(unsigned*)(o0 + ((size_t)g * 2048 + pos) * 2816 + nt * 64 + f2) = pack2(s0, s1);
          }
          am = ac; ac = an; gm = gc; gc = gn;
        }
      } else {
        const int cl = (tid & 63) * 2, q = tid >> 6;
        const int p0 = 1 + 32 * q, p1 = (p0 + 32 < 127) ? p0 + 32 : 127;
        const int na = norig(nt, cl);
        const f32x2 a0 = *(const f32x2*)(cw + na), a1 = *(const f32x2*)(cw + NC + na), a2 = *(const f32x2*)(cw + 2 * NC + na), ab = *(const f32x2*)(cb + na);
        pre();
        f32x2 am = ldz(Z, p0 - 1, cl), ac = ldz(Z, p0, cl);
#pragma unroll 2
        for (int pl = p0; pl < p1; ++pl) {
          const f32x2 an = ldz(Z, pl + 1, cl);
          const int pos = rig0 + pl;
          if (pos < 2048) {
            const f32x2 av = a0 * am + a1 * ac + a2 * an + ab;
            *(unsigned*)(o0 + ((size_t)g * 2048 + pos) * 1024 + nt * 128 + cl) = pack2(av[0], av[1]);
          }
          am = ac; ac = an;
        }
      }
    } else {
      pre();
      const int pl = tid & 127, fh = tid >> 7;
      const int pos = rig0 + pl;
      if (pl >= 1 && pl <= 126 && pos < 2048) {
        const int fb = nt - 8;
#pragma unroll 2
        for (int f = fh * 32; f < fh * 32 + 32; f += 2) {
          const int na = norig(nt, f), nb = norig(nt, 64 + f);
          const f32x2 va = *(const f32x2*)(cw + na) * ldz(Z, pl - 1, f) + *(const f32x2*)(cw + NC + na) * ldz(Z, pl, f)
                         + *(const f32x2*)(cw + 2 * NC + na) * ldz(Z, pl + 1, f) + *(const f32x2*)(cb + na);
          const f32x2 vb = *(const f32x2*)(cw + nb) * ldz(Z, pl - 1, 64 + f) + *(const f32x2*)(cw + NC + nb) * ldz(Z, pl, 64 + f)
                         + *(const f32x2*)(cw + 2 * NC + nb) * ldz(Z, pl + 1, 64 + f) + *(const f32x2*)(cb + nb);
          bf16_t* op = o1 + (size_t)(fb * 64 + f) * 16384 + g * 2048 + pos;
          op[0] = f2bf(va[0] * vb[0]);
          op[16384] = f2bf(va[1] * vb[1]);
        }
      }
    }
  }
};

#define GLDS16(gp, lp) __builtin_amdgcn_global_load_lds((const unsigned*)(gp), (__attribute__((address_space(3))) unsigned*)(lp), 16, 0, 0)

template <bool SWAP, class Epi>
__device__ __forceinline__ void gemm_job(char* smem, const bf16_t* __restrict__ A, int lda, const bf16_t* __restrict__ Bt, int K, int N,
                                         int tpg, int a_gstride, int a_goff, int step, int halo, int grows, int MTS, int voff, int vid0, int grid, const Epi& epi) {
  const int tid = get_tid512(), lane = tid & 63, wid = tid >> 6, wr = wid >> 1, wc = wid & 1, fr = lane & 15, fq = lane >> 4;
  const int NT = (N + 255) >> 8, MT = MTS >> 1, ntiles = MT * NT, ns = K >> 6;
  const int full = MT >> 3;
  int v = vid0;
  if (v < voff) v += ((voff - v + grid - 1) / grid) * grid;
  const int swz = (fr >> 1) & 7;
  bool pre_issued = false;
  for (; v < voff + ntiles; v += grid) {
    const int w = v - voff;
    int mt, nt;
    if (w < full * 8 * NT) { const int sr = w / (8 * NT), rem = w - sr * 8 * NT; nt = rem >> 3; mt = sr * 8 + (rem & 7); }
    else { const int w2 = w - full * 8 * NT, rl = MT - full * 8; nt = w2 / rl; mt = full * 8 + (w2 - nt * rl); }
    unsigned ap[4], bp[4];
#pragma unroll
    for (int i = 0; i < 4; ++i) {
      const int r = (tid >> 3) + 64 * i;
      const int cs = tid & 7;
      const int c = ((cs ^ ((r >> 1) & 7)) << 3);
      const int sub = 2 * mt + (r >> 7);
      const int g = sub / tpg, ti = sub - g * tpg;
      int rig = ti * step - halo + (r & 127); rig = rig < 0 ? 0 : (rig > grows - 1 ? grows - 1 : rig);
      ap[i] = (unsigned)((g * a_gstride + a_goff + rig) * lda + c);
      int br = nt * 256 + r; br = br > N - 1 ? N - 1 : br;
      bp[i] = (unsigned)(br * K + c);
    }
    const bool have_next = false;
    f32x4 acc[4][8];
#pragma unroll
    for (int m = 0; m < 4; ++m)
#pragma unroll
      for (int n = 0; n < 8; ++n) acc[m][n] = (f32x4){0.f, 0.f, 0.f, 0.f};
    if (!pre_issued) {
#pragma unroll
      for (int i = 0; i < 4; ++i) { GLDS16(A + (size_t)ap[i], smem + tid * 16 + i * 8192); GLDS16(Bt + (size_t)bp[i], smem + 32768 + tid * 16 + i * 8192); }
    }
    pre_issued = have_next;
    for (int st = 0; st < ns; ++st) {
      asm volatile("s_waitcnt vmcnt(0)" ::: "memory");
      __builtin_amdgcn_s_barrier();
      asm volatile("" ::: "memory");
      if (st + 1 < ns) {
        char* nb = smem + ((st + 1) & 1) * 65536;
        const int ko = (st + 1) * 64;
#pragma unroll
        for (int i = 0; i < 4; ++i) { GLDS16(A + (size_t)(ap[i] + ko), nb + tid * 16 + i * 8192); GLDS16(Bt + (size_t)(bp[i] + ko), nb + 32768 + tid * 16 + i * 8192); }
      }
      const char* sa = smem + (st & 1) * 65536 + (wr * 64 + fr) * 128;
      const char* sb = smem + (st & 1) * 65536 + 32768 + (wc * 128 + fr) * 128;
      bf16x8 afA[4], afB[4], bfb[2][2];
#pragma unroll
      for (int m = 0; m < 4; ++m) afA[m] = *(const bf16x8*)(sa + m * 2048 + ((fq ^ swz) << 4));
#pragma unroll
      for (int n = 0; n < 2; ++n) bfb[0][n] = *(const bf16x8*)(sb + n * 2048 + ((fq ^ swz) << 4));
#pragma unroll
      for (int gq = 0; gq < 8; ++gq) {
        const int ks = gq >> 2, nh = gq & 3;
        if (gq < 7) {
          const int ks2 = (gq + 1) >> 2, nh2 = (gq + 1) & 3;
#pragma unroll
          for (int n = 0; n < 2; ++n) bfb[(gq + 1) & 1][n] = *(const bf16x8*)(sb + (nh2 * 2 + n) * 2048 + (((ks2 * 4 + fq) ^ swz) << 4));
        }
        if (gq == 3) {
#pragma unroll
          for (int m = 0; m < 4; ++m) afB[m] = *(const bf16x8*)(sa + m * 2048 + (((4 + fq) ^ swz) << 4));
        }
        __builtin_amdgcn_sched_barrier(0);
#pragma unroll
        for (int m = 0; m < 4; ++m)
#pragma unroll
          for (int n = 0; n < 2; ++n) {
            const bf16x8 av = ks ? afB[m] : afA[m];
            acc[m][nh * 2 + n] = SWAP ? __builtin_amdgcn_mfma_f32_16x16x32_bf16(bfb[gq & 1][n], av, acc[m][nh * 2 + n], 0, 0, 0)
                                      : __builtin_amdgcn_mfma_f32_16x16x32_bf16(av, bfb[gq & 1][n], acc[m][nh * 2 + n], 0, 0, 0);
          }
      }
    }
    __syncthreads();
    const int te = get_tid512();
    const int fr_e = te & 15, fq_e = (te & 63) >> 4, wr_e = te >> 7, wc_e = (te >> 6) & 1;
    const int sub = 2 * mt + (wr_e >> 1);
    const int g = sub / tpg, ti = sub - g * tpg;
    const int rig0 = ti * step - halo;
    const int rw = (wr_e & 1) * 64;
    if constexpr (Epi::KIND == 0) {
#pragma unroll
      for (int m = 0; m < 4; ++m) {
        const int rig = rig0 + rw + m * 16 + fr_e;
        if constexpr (Epi::ROWSUM) {
          float ss = 0.f;
#pragma unroll
          for (int n = 0; n < 8; ++n) {
            const int col = nt * 256 + wc_e * 128 + n * 16 + fq_e * 4;
            if (col < N) ss += epi.c4(g, rig, col, acc[m][n]);
          }
          ss += __shfl_xor(ss, 16); ss += __shfl_xor(ss, 32);
          if (fq_e == 0) epi.rowsum(g, rig, nt * 2 + wc_e, ss);
        } else {
#pragma unroll
          for (int n = 0; n < 8; ++n) {
            const int col = nt * 256 + wc_e * 128 + n * 16 + fq_e * 4;
            if (col < N) epi.c4(g, rig, col, acc[m][n]);
          }
        }
      }
    } else if constexpr (Epi::KIND == 1) {
#pragma unroll
      for (int m = 0; m < 4; ++m) {
        const int rig = rig0 + rw + m * 16 + fq_e * 4;
#pragma unroll
        for (int n = 0; n < 8; ++n) {
          const int col = nt * 256 + wc_e * 128 + n * 16 + fr_e;
          if (col < N) epi.r4(g, rig, col, acc[m][n]);
        }
      }
    } else {
      bf16_t* Zw = (bf16_t*)smem + ((wr_e >> 1) * 2 + wc_e) * (128 * 132);
      const int nt2w = nt * 2 + wc_e;
#pragma unroll
      for (int n = 0; n < 8; ++n) {
        const int cl = n * 16 + fq_e * 4;
        f32x4 b4 = {0.f, 0.f, 0.f, 0.f};
        if (epi.pre_bias) b4 = *(const f32x4*)(epi.pre_bias + epi.norig(nt2w, cl));
#pragma unroll
        for (int m = 0; m < 4; ++m) {
          const int rl = rw + m * 16 + fr_e;
          const int pos = rig0 + rl;
          const bool ok = pos >= 0 && pos < grows;
          f32x4 vv = acc[m][n] + b4;
          if (!ok) vv = (f32x4){0.f, 0.f, 0.f, 0.f};
          uint2 u; u.x = pack2(vv[0], vv[1]); u.y = pack2(vv[2], vv[3]);
          *(uint2*)(Zw + rl * 132 + cl) = u;
        }
      }
      __syncthreads();
      {
        auto no_pre = []() {};
        const bf16_t* Zr = (const bf16_t*)smem + ((wr_e >> 1) * 2) * (128 * 132);
        epi.finish(Zr, g, rig0, nt * 2, no_pre);
        epi.finish(Zr + 128 * 132, g, rig0, nt * 2 + 1, no_pre);
      }
      __syncthreads();
    }
    asm volatile("s_waitcnt vmcnt(0)" ::: "memory");
    __syncthreads();
  }
}

__device__ __forceinline__ void phase_attn(CP& p, char* smem, int vid0, int grid) {
  bf16_t* Ks = (bf16_t*)smem;
  bf16_t* Vs = (bf16_t*)(smem + 64 * 104 * 2);
  const int tid = get_tid512(), lane = tid & 63, w = tid >> 6, r = lane & 31, hh = lane >> 5;
  const float cs = 1.4426950408889634f * 0.10206207261596577f;
  for (int it = vid0; it < 1024; it += grid) {
    const int qt = it & 7, h = (it >> 3) & 15, b = it >> 7;
    const int t = qt * 256 + w * 32 + r;
    const size_t xrow = (size_t)b * 2048 + t;
    const bf16_t* qp = p.Q + xrow * 1536 + h * 96;
    bf16x8 qf[6];
#pragma unroll
    for (int kk = 0; kk < 4; ++kk) qf[kk] = *(const bf16x8*)(qp + 16 * kk + 8 * hh);
#pragma unroll
    for (int part = 0; part < 2; ++part) {
      const bf16_t* pp = qp + 64 + 16 * part;
      const bf16x8 mine = *(const bf16x8*)(pp + 8 * hh), oth = *(const bf16x8*)(pp + 8 * (1 - hh));
      const float posf = part == 0 ? (float)(t >> 6) : (float)(t & 63);
      union { unsigned u[4]; bf16x8 v; } o;
      float res[8];
#pragma unroll
      for (int j = 0; j < 8; ++j) {
        const float inv = exp2f(-(float)j * (13.287712379549449f / 8.0f));
        const float ang = posf * inv;
        const float c = __cosf(ang), s = __sinf(ang);
        const float m = bf2f((bf16_t)mine[j]), ov = bf2f((bf16_t)oth[j]);
        res[j] = m * c + (hh ? ov : -ov) * s;
      }
#pragma unroll
      for (int j = 0; j < 4; ++j) o.u[j] = pack2(res[2 * j], res[2 * j + 1]);
      qf[4 + part] = o.v;
    }
    f32x16 oacc[2];
#pragma unroll
    for (int i = 0; i < 16; ++i) { oacc[0][i] = 0.f; oacc[1][i] = 0.f; }
    float mrun = -INFINITY, lrun = 0.f;
    const size_t kvrow0 = (size_t)b * 2304;
    const bf16_t* kn_base = p.Kn + kvrow0 * 1024 + h * 64;
    const bf16_t* kpe_base = p.kpe + kvrow0 * 32;
    const bf16_t* vt_base = p.Vt + ((size_t)(b * 16 + h) * 64) * 2304;
    uint4 rk0, rp, rv0;
    rp.x = 0; rp.y = 0; rp.z = 0; rp.w = 0;
    const int srow = tid >> 3, sch = tid & 7;
#define ATT_GLOAD(kt) do { \
      rk0 = *(const uint4*)(kn_base + (size_t)((kt) * 64 + srow) * 1024 + sch * 8); \
      rv0 = *(const uint4*)(vt_base + (size_t)srow * 2304 + (kt) * 64 + sch * 8); \
      if (tid < 256) rp = *(const uint4*)(kpe_base + (size_t)((kt) * 64 + (tid >> 2)) * 32 + (tid & 3) * 8); } while (0)
    ATT_GLOAD(0);
    for (int kt = 0; kt < 36; ++kt) {
      __syncthreads();
      {
        *(uint4*)(Ks + srow * 104 + sch * 8) = rk0;
        uint2 lo, hi;
        lo.x = rv0.x; lo.y = rv0.y; hi.x = rv0.z; hi.y = rv0.w;
        *(uint2*)(Vs + srow * 68 + sch * 8) = lo; *(uint2*)(Vs + srow * 68 + sch * 8 + 4) = hi;
      }
      if (tid < 256) *(uint4*)(Ks + (tid >> 2) * 104 + 64 + (tid & 3) * 8) = rp;
      __syncthreads();
      if (kt + 1 < 36) ATT_GLOAD(kt + 1);
      f32x16 s[2];
#pragma unroll
      for (int t2 = 0; t2 < 2; ++t2) {
#pragma unroll
        for (int i = 0; i < 16; ++i) s[t2][i] = 0.f;
#pragma unroll
        for (int kk = 0; kk < 6; ++kk) {
          const bf16x8 a = *(const bf16x8*)(Ks + (32 * t2 + r) * 104 + 16 * kk + 8 * hh);
          s[t2] = __builtin_amdgcn_mfma_f32_32x32x16_bf16(a, qf[kk], s[t2], 0, 0, 0);
        }
      }
      float mx = s[0][0];
#pragma unroll
      for (int i = 1; i < 16; ++i) mx = fmaxf(mx, s[0][i]);
#pragma unroll
      for (int i = 0; i < 16; ++i) mx = fmaxf(mx, s[1][i]);
      mx = fmaxf(mx, __shfl_xor(mx, 32));
      const float mcand = mx * cs;
      if (__builtin_amdgcn_ballot_w64(mcand > mrun + 6.0f) != 0ull) {
        const float mnew_ = fmaxf(mrun, mcand);
        const float alpha = __builtin_amdgcn_exp2f(mrun - mnew_);
        mrun = mnew_;
        lrun *= alpha;
#pragma unroll
        for (int i = 0; i < 16; ++i) { oacc[0][i] *= alpha; oacc[1][i] *= alpha; }
      }
      const float mnew = mrun;
      float psum = 0.f;
      bf16x8 pf[4];
#pragma unroll
      for (int t2 = 0; t2 < 2; ++t2)
#pragma unroll
        for (int hf = 0; hf < 2; ++hf) {
          union { unsigned u[4]; bf16x8 v; } cvp;
#pragma unroll
          for (int i = 0; i < 4; ++i) {
            const float p0 = __builtin_amdgcn_exp2f(s[t2][hf * 8 + 2 * i] * cs - mnew);
            const float p1 = __builtin_amdgcn_exp2f(s[t2][hf * 8 + 2 * i + 1] * cs - mnew);
            psum += p0 + p1;
            cvp.u[i] = pack2(p0, p1);
          }
          pf[t2 * 2 + hf] = cvp.v;
        }
      lrun += psum;
#pragma unroll
      for (int dt = 0; dt < 2; ++dt)
#pragma unroll
        for (int s4 = 0; s4 < 4; ++s4) {
          const bf16_t* vp = Vs + (32 * dt + r) * 68 + 16 * s4 + 4 * hh;
          const uint2 lo = *(const uint2*)vp, hi = *(const uint2*)(vp + 8);
          union { uint4 u; bf16x8 v; } cv; cv.u.x = lo.x; cv.u.y = lo.y; cv.u.z = hi.x; cv.u.w = hi.y;
          oacc[dt] = __builtin_amdgcn_mfma_f32_32x32x16_bf16(cv.v, pf[s4], oacc[dt], 0, 0, 0);
        }
    }
    const float ltot = lrun + __shfl_xor(lrun, 32);
    const float inv = 1.f / ltot;
    bf16_t* op = p.hxc + xrow * 1024 + h * 64;
#pragma unroll
    for (int dt = 0; dt < 2; ++dt)
#pragma unroll
      for (int i4 = 0; i4 < 4; ++i4) {
        const int d = 32 * dt + 8 * i4 + 4 * hh;
        uint2 u; u.x = pack2(oacc[dt][4 * i4] * inv, oacc[dt][4 * i4 + 1] * inv); u.y = pack2(oacc[dt][4 * i4 + 2] * inv, oacc[dt][4 * i4 + 3] * inv);
        *(uint2*)(op + d) = u;
      }
  }
}

__device__ __forceinline__ void phase_hyconv(CP& p, char* smem) {
  bf16_t* cp = (bf16_t*)smem;
  bf16_t* Vl = (bf16_t*)(smem + 4 * 8256);
  const int tid = get_tid(), lane = tid & 63, w = tid >> 6, i16 = lane & 15, g4 = lane >> 4;
  const int si = (-i16) & 3;
  const int ocb = 64 * w;
  for (int c = get_bid(); c < 1024; c += VGRID) {
    __syncthreads();
#pragma unroll
    for (int i = 0; i < 2; ++i) { const int ch = tid + 256 * i; *(uint4*)(cp + ch * 8) = *(const uint4*)(p.Rf + (size_t)c * 4096 + ch * 8); }
    {
      const float a0 = p.hy_conv_w[1024 + c], a1 = p.hy_conv_w[3072 + 1024 + c], a2 = p.hy_conv_w[2 * 3072 + 1024 + c], ab = p.hy_conv_b[1024 + c];
      const float v0 = p.hy_conv_w[2048 + c], v1 = p.hy_conv_w[3072 + 2048 + c], v2 = p.hy_conv_w[2 * 3072 + 2048 + c], vb = p.hy_conv_b[2048 + c];
#pragma unroll 2
      for (int i = 0; i < 8; ++i) {
        const int q = tid + 256 * i; const int b = q >> 8, l8 = q & 255; const int m1 = l8 >> 3, m2 = (l8 & 7) * 8;
        const int l0 = l8 * 8;
        const bf16_t* z2 = p.vvT + (size_t)c * 16384 + b * 2048;
        const bf16_t* zv = p.vvT + (size_t)(1024 + c) * 16384 + b * 2048;
        const uint4 u2 = *(const uint4*)(z2 + l0), uv = *(const uint4*)(zv + l0);
        float e2[10], ev[10];
        const int lp = l0 > 0 ? l0 - 1 : 0, ln = l0 + 8 < 2048 ? l0 + 8 : 2047;
        const float pm = l0 > 0 ? 1.f : 0.f, nm = l0 + 8 < 2048 ? 1.f : 0.f;
        const bf16_t q2p = z2[lp], qvp = zv[lp], q2n = z2[ln], qvn = zv[ln];
        e2[0] = bf2f(q2p) * pm; ev[0] = bf2f(qvp) * pm;
        e2[9] = bf2f(q2n) * nm; ev[9] = bf2f(qvn) * nm;
        const unsigned w2[4] = {u2.x, u2.y, u2.z, u2.w}, wv[4] = {uv.x, uv.y, uv.z, uv.w};
#pragma unroll
        for (int j = 0; j < 4; ++j) {
          e2[1 + 2 * j] = __uint_as_float(w2[j] << 16); e2[2 + 2 * j] = __uint_as_float(w2[j] & 0xffff0000u);
          ev[1 + 2 * j] = __uint_as_float(wv[j] << 16); ev[2 + 2 * j] = __uint_as_float(wv[j] & 0xffff0000u);
        }
        unsigned o[4];
#pragma unroll
        for (int j = 0; j < 4; ++j) {
          const float xa = a0 * e2[2 * j] + a1 * e2[2 * j + 1] + a2 * e2[2 * j + 2] + ab;
          const float xb = a0 * e2[2 * j + 1] + a1 * e2[2 * j + 2] + a2 * e2[2 * j + 3] + ab;
          const float ya = v0 * ev[2 * j] + v1 * ev[2 * j + 1] + v2 * ev[2 * j + 2] + vb;
          const float yb = v0 * ev[2 * j + 1] + v1 * ev[2 * j + 2] + v2 * ev[2 * j + 3] + vb;
          o[j] = pack2(xa * ya, xb * yb);
        }
        uint4 ou; ou.x = o[0]; ou.y = o[1]; ou.z = o[2]; ou.w = o[3];
        *(uint4*)(Vl + (8 + m1 * 8 + b) * 80 + m2) = ou;
      }
    }
    if (tid < 144) {
      const int colp = tid / 9, part = tid - colp * 9;
      const int col = colp < 8 ? colp : 256 + colp;
      uint4 zz; zz.x = 0; zz.y = 0; zz.z = 0; zz.w = 0;
      *(uint4*)(Vl + col * 80 + part * 8) = zz;
    }
    __syncthreads();
#pragma unroll
    for (int s = 1; s < 4; ++s)
#pragma unroll
      for (int i = 0; i < 2; ++i) {
        const int ch = tid + 256 * i;
        unsigned e[8];
#pragma unroll
        for (int j = 0; j < 8; ++j) { const int idx = 8 * ch + s + j; e[j] = idx < 4096 ? (unsigned)cp[idx] : 0u; }
        uint4 u; u.x = e[0] | (e[1] << 16); u.y = e[2] | (e[3] << 16); u.z = e[4] | (e[5] << 16); u.w = e[6] | (e[7] << 16);
        *(uint4*)(cp + s * 4128 + 8 * ch) = u;
      }
    __syncthreads();
    const bf16_t* abase = cp + si * 4128 + (2048 - i16 - si + 8 * g4);
    f32x4 acc[4][4];
#pragma unroll
    for (int m = 0; m < 4; ++m)
#pragma unroll
      for (int n = 0; n < 4; ++n) acc[m][n] = (f32x4){0.f, 0.f, 0.f, 0.f};
    for (int dl = -31; dl <= 31; ++dl) {
      bf16x8 af[4][2];
#pragma unroll
      for (int mt = 0; mt < 4; ++mt)
#pragma unroll
        for (int kk = 0; kk < 2; ++kk) {
          const bf16_t* ap = abase - 64 * dl - 16 * mt + 32 * kk;
          const uint2 lo = *(const uint2*)ap, hi = *(const uint2*)(ap + 4);
          union { uint4 u; bf16x8 v; } cv; cv.u.x = lo.x; cv.u.y = lo.y; cv.u.z = hi.x; cv.u.w = hi.y;
          af[mt][kk] = cv.v;
        }
#pragma unroll
      for (int jt = 0; jt < 4; ++jt) {
        const int in0 = ocb + 16 * jt - 8 * dl;
        if (in0 >= -8 && in0 <= 248) {
          const bf16_t* bp = Vl + (in0 + 8 + i16) * 80 + 8 * g4;
          const bf16x8 b0 = *(const bf16x8*)bp, b1 = *(const bf16x8*)(bp + 32);
#pragma unroll
          for (int mt = 0; mt < 4; ++mt) {
            acc[mt][jt] = __builtin_amdgcn_mfma_f32_16x16x32_bf16(af[mt][0], b0, acc[mt][jt], 0, 0, 0);
            acc[mt][jt] = __builtin_amdgcn_mfma_f32_16x16x32_bf16(af[mt][1], b1, acc[mt][jt], 0, 0, 0);
          }
        }
      }
    }
    const float db = p.hy_d_bias[c];
#pragma unroll
    for (int mt = 0; mt < 4; ++mt)
#pragma unroll
      for (int jt = 0; jt < 4; ++jt) {
        const int col = ocb + 16 * jt + i16;
        const int n1 = col >> 3, b = col & 7;
        const int n2 = 16 * mt + 4 * g4;
        const uint2 vv = *(const uint2*)(Vl + (col + 8) * 80 + n2);
        const float y0 = acc[mt][jt][0] + bf2f((bf16_t)(vv.x & 0xffff)) * db;
        const float y1 = acc[mt][jt][1] + bf2f((bf16_t)(vv.x >> 16)) * db;
        const float y2 = acc[mt][jt][2] + bf2f((bf16_t)(vv.y & 0xffff)) * db;
        const float y3 = acc[mt][jt][3] + bf2f((bf16_t)(vv.y >> 16)) * db;
        uint2 u; u.x = pack2(y0, y1); u.y = pack2(y2, y3);
        *(uint2*)(p.Yp + (size_t)c * 16384 + b * 2048 + n1 * 64 + n2) = u;
      }
  }
}

__device__ __forceinline__ void phase_transmul(CP& p, char* smem) {
  bf16_t* tl = (bf16_t*)smem;
  const int tid = get_tid();
  for (int it = get_bid(); it < 4096; it += VGRID) {
    const int ct = it & 15, rt = it >> 4;
    const int c0 = ct * 64, r0 = rt * 64;
    __syncthreads();
#pragma unroll
    for (int i = 0; i < 2; ++i) {
      const int ci = tid + 256 * i; const int cc = ci >> 3, ch = ci & 7;
      const uint4 u = *(const uint4*)(p.Yp + (size_t)(c0 + cc) * 16384 + r0 + ch * 8);
      unsigned* d = (unsigned*)(tl + cc * 66 + ch * 8);
      d[0] = u.x; d[1] = u.y; d[2] = u.z; d[3] = u.w;
    }
    __syncthreads();
    const int row = tid >> 2, cq = tid & 3;
    const int grow = r0 + row, pos = grow & 2047;
    const int cbase = c0 + cq * 16;
    const bf16_t* xp = p.x1h + (size_t)grow * 1024 + cbase;
    uint4 zero4; zero4.x = 0; zero4.y = 0; zero4.z = 0; zero4.w = 0;
    const uint4 xa = *(const uint4*)xp, xb = *(const uint4*)(xp + 8);
    const bf16_t* xpp = pos > 0 ? xp - 1024 : xp;
    const bf16_t* xpn = pos < 2047 ? xp + 1024 : xp;
    const float pmk = pos > 0 ? 1.f : 0.f, nmk = pos < 2047 ? 1.f : 0.f;
    const uint4 pa = *(const uint4*)xpp, pb = *(const uint4*)(xpp + 8);
    const uint4 na = *(const uint4*)xpn, nb = *(const uint4*)(xpn + 8);
    (void)zero4;
    const unsigned xs[8] = {xa.x, xa.y, xa.z, xa.w, xb.x, xb.y, xb.z, xb.w};
    const unsigned ps[8] = {pa.x, pa.y, pa.z, pa.w, pb.x, pb.y, pb.z, pb.w};
    const unsigned ns[8] = {na.x, na.y, na.z, na.w, nb.x, nb.y, nb.z, nb.w};
    unsigned o[8];
#pragma unroll
    for (int j4 = 0; j4 < 4; ++j4) {
      const f32x4 w0 = *(const f32x4*)(p.hy_conv_w + cbase + 4 * j4) * pmk, w1 = *(const f32x4*)(p.hy_conv_w + 3072 + cbase + 4 * j4);
      const f32x4 w2 = *(const f32x4*)(p.hy_conv_w + 2 * 3072 + cbase + 4 * j4) * nmk, wb = *(const f32x4*)(p.hy_conv_b + cbase + 4 * j4);
#pragma unroll
      for (int jj = 0; jj < 2; ++jj) {
        const int j = 2 * j4 + jj;
        const float x0 = w0[2 * jj] * __uint_as_float(ps[j] << 16) + w1[2 * jj] * __uint_as_float(xs[j] << 16) + w2[2 * jj] * __uint_as_float(ns[j] << 16) + wb[2 * jj];
        const float x1 = w0[2 * jj + 1] * __uint_as_float(ps[j] & 0xffff0000u) + w1[2 * jj + 1] * __uint_as_float(xs[j] & 0xffff0000u) + w2[2 * jj + 1] * __uint_as_float(ns[j] & 0xffff0000u) + wb[2 * jj + 1];
        const float y0 = bf2f(tl[(cq * 16 + 2 * j) * 66 + row]) * x0;
        const float y1 = bf2f(tl[(cq * 16 + 2 * j + 1) * 66 + row]) * x1;
        o[j] = pack2(y0, y1);
      }
    }
    bf16_t* op = p.hxc + (size_t)(r0 + row) * 1024 + c0 + cq * 16;
    uint4 oa; oa.x = o[0]; oa.y = o[1]; oa.z = o[2]; oa.w = o[3];
    uint4 ob; ob.x = o[4]; ob.y = o[5]; ob.z = o[6]; ob.w = o[7];
    *(uint4*)op = oa; *(uint4*)(op + 8) = ob;
  }
}

__global__ void __launch_bounds__(512, 2) mega(P p_arg) {
  __shared__ __attribute__((aligned(16))) char smem[LDS_BYTES];
  cg::grid_group grid = cg::this_grid();
  const int G = gridDim.x;
  CP* pp = (CP*)__builtin_amdgcn_kernarg_segment_ptr();
  const int ph0 = pp->ph0, ph1 = pp->ph1;
  volatile LAS unsigned* xst = (volatile LAS unsigned*)(smem + LDS_BYTES - 16);
  if (threadIdx.x == 0) { xst[0] = 0u; xst[1] = 0u; }
  __syncthreads();
  const XcdBarrier xb = xcd_barrier_post(pp->bar, xst);
  if (ph0 <= 0 && 0 < ph1) {
    asm volatile("" : "+s"(pp));
    CP& p = *pp;
    const int bid = get_rbid();
    const int vid0 = (G & 7) ? bid : ((bid & 7) * (G >> 3) + (bid >> 3));
    const int hb = get_hb();
    char* smem_h = smem + hb * HALF_LDS; (void)smem_h;
    const float* mv0 = p.modv; const float* mv1 = p.modv + (size_t)9 * 6144;
    (void)mv0; (void)mv1; (void)vid0;
    phase_prep(p, smem_h);
    if (0 + 1 < ph1) { if (ph1 > 1000) grid.sync(); else xcd_barrier(xb); }
  }
  if (ph0 <= 1 && 1 < ph1) {
    asm volatile("" : "+s"(pp));
    CP& p = *pp;
    const int bid = get_rbid();
    const int vid0 = (G & 7) ? bid : ((bid & 7) * (G >> 3) + (bid >> 3));
    const int hb = get_hb();
    char* smem_h = smem + hb * HALF_LDS; (void)smem_h;
    const float* mv0 = p.modv; const float* mv1 = p.modv + (size_t)9 * 6144;
    (void)mv0; (void)mv1; (void)vid0;
    phase_normmod_kv(p);
    if (1 + 1 < ph1) { if (ph1 > 1000) grid.sync(); else xcd_barrier(xb); }
  }
  if (ph0 <= 2 && 2 < ph1) {
    asm volatile("" : "+s"(pp));
    CP& p = *pp;
    const int bid = get_rbid();
    const int vid0 = (G & 7) ? bid : ((bid & 7) * (G >> 3) + (bid >> 3));
    const int hb = get_hb();
    char* smem_h = smem + hb * HALF_LDS; (void)smem_h;
    const float* mv0 = p.modv; const float* mv1 = p.modv + (size_t)9 * 6144;
    (void)mv0; (void)mv1; (void)vid0;
    {
        EpiDown e1{p.cq, 512, 2048, p.rq, 4, nullptr, 1 << 30};
        gemm_job<true>(smem, p.hxc, 1024, p.wt_dq, 1024, 512, 16, 2304, 256, 128, 0, 2048, 128, 0, vid0, G, e1);
        EpiDown e2{p.kv, 288, 2304, p.rkv, 2, p.kpe, 256};
        gemm_job<true>(smem, p.hxc, 1024, p.wt_dkv, 1024, 288, 18, 2304, 0, 128, 0, 2304, 144, 64 * 2, vid0, G, e2);
        EpiFilt e3{p.Rf, p.hy_decay};
        gemm_job<false>(smem, p.h2bf, 64, p.wt_f3, 64, 2048, 16, 0, 0, 128, 0, 2048, 16, 64 * 2 + 72 * 2, vid0, G, e3);
      }
    if (2 + 1 < ph1) { if (ph1 > 1000) grid.sync(); else xcd_barrier(xb); }
  }
  if (ph0 <= 4 && 4 < ph1) {
    asm volatile("" : "+s"(pp));
    CP& p = *pp;
    const int bid = get_rbid();
    const int vid0 = (G & 7) ? bid : ((bid & 7) * (G >> 3) + (bid >> 3));
    const int hb = get_hb();
    char* smem_h = smem + hb * HALF_LDS; (void)smem_h;
    const float* mv0 = p.modv; const float* mv1 = p.modv + (size_t)9 * 6144;
    (void)mv0; (void)mv1; (void)vid0;
    {
        EpiStore<4> e1{p.Q, 1536, 2048, p.rq, 16384, 1.0f / 512.0f};
        gemm_job<true>(smem, p.cq, 512, p.wt_uq, 512, 1536, 16, 2048, 0, 128, 0, 2048, 128, 0, vid0, G, e1);
        EpiStore<2> e2{p.Kn, 1024, 2304, p.rkv, 18432, 1.0f / 256.0f};
        gemm_job<true>(smem, p.kv, 288, p.wt_uk, 256, 1024, 18, 2304, 0, 128, 0, 2304, 144, 64 * 6, vid0, G, e2);
        EpiVt e3{p.Vt, p.rkv};
        gemm_job<false>(smem, p.kv, 288, p.wt_uv, 256, 1024, 18, 2304, 0, 128, 0, 2304, 144, 64 * 6 + 72 * 4, vid0, G, e3);
      }
    if (4 + 1 < ph1) { if (ph1 > 1000) grid.sync(); else xcd_barrier(xb); }
  }
  if (ph0 <= 5 && 5 < ph1) {
    asm volatile("" : "+s"(pp));
    CP& p = *pp;
    const int bid = get_rbid();
    const int vid0 = (G & 7) ? bid : ((bid & 7) * (G >> 3) + (bid >> 3));
    const int hb = get_hb();
    char* smem_h = smem + hb * HALF_LDS; (void)smem_h;
    const float* mv0 = p.modv; const float* mv1 = p.modv + (size_t)9 * 6144;
    (void)mv0; (void)mv1; (void)vid0;
    phase_attn(p, smem, vid0, G);
    if (5 + 1 < ph1) { if (ph1 > 1000) grid.sync(); else xcd_barrier(xb); }
  }
  if (ph0 <= 6 && 6 < ph1) {
    asm volatile("" : "+s"(pp));
    CP& p = *pp;
    const int bid = get_rbid();
    const int vid0 = (G & 7) ? bid : ((bid & 7) * (G >> 3) + (bid >> 3));
    const int hb = get_hb();
    char* smem_h = smem + hb * HALF_LDS; (void)smem_h;
    const float* mv0 = p.modv; const float* mv1 = p.modv + (size_t)9 * 6144;
    (void)mv0; (void)mv1; (void)vid0;
    {
        EpiResid<true> e{p.X16, p.x, mv0 + 2 * 1024, nullptr};
        gemm_job<true>(smem, p.hxc, 1024, p.wt_o, 1024, 1024, 16, 2048, 0, 128, 0, 2048, 128, 0, vid0, G, e);
      }
    if (6 + 1 < ph1) { if (ph1 > 1000) grid.sync(); else xcd_barrier(xb); }
  }
  if (ph0 <= 7 && 7 < ph1) {
    asm volatile("" : "+s"(pp));
    CP& p = *pp;
    const int bid = get_rbid();
    const int vid0 = (G & 7) ? bid : ((bid & 7) * (G >> 3) + (bid >> 3));
    const int hb = get_hb();
    char* smem_h = smem + hb * HALF_LDS; (void)smem_h;
    const float* mv0 = p.modv; const float* mv1 = p.modv + (size_t)9 * 6144;
    (void)mv0; (void)mv1; (void)vid0;
    phase_normmod_x(p, p.norm_ffn_g, 0, 3);
    if (7 + 1 < ph1) { if (ph1 > 1000) grid.sync(); else xcd_barrier(xb); }
  }
  if (ph0 <= 8 && 8 < ph1) {
    asm volatile("" : "+s"(pp));
    CP& p = *pp;
    const int bid = get_rbid();
    const int vid0 = (G & 7) ? bid : ((bid & 7) * (G >> 3) + (bid >> 3));
    const int hb = get_hb();
    char* smem_h = smem + hb * HALF_LDS; (void)smem_h;
    const float* mv0 = p.modv; const float* mv1 = p.modv + (size_t)9 * 6144;
    (void)mv0; (void)mv1; (void)vid0;
    {
        EpiConv<0> e{p.ffn_conv_w, p.ffn_conv_b, 5632, nullptr, p.act, nullptr};
        gemm_job<true>(smem, p.hxc, 1024, p.wt_up0, 1024, 5632, 17, 2048, 0, 126, 1, 2048, 136, 0, vid0, G, e);
      }
    if (8 + 1 < ph1) { if (ph1 > 1000) grid.sync(); else xcd_barrier(xb); }
  }
  if (ph0 <= 9 && 9 < ph1) {
    asm volatile("" : "+s"(pp));
    CP& p = *pp;
    const int bid = get_rbid();
    const int vid0 = (G & 7) ? bid : ((bid & 7) * (G >> 3) + (bid >> 3));
    const int hb = get_hb();
    char* smem_h = smem + hb * HALF_LDS; (void)smem_h;
    const float* mv0 = p.modv; const float* mv1 = p.modv + (size_t)9 * 6144;
    (void)mv0; (void)mv1; (void)vid0;
    {
        EpiResid<false> e{p.X16, p.X16, mv0 + 5 * 1024, nullptr};
        gemm_job<true>(smem, p.act, 2816, p.wt_dn0, 2816, 1024, 16, 2048, 0, 128, 0, 2048, 128, 0, vid0, G, e);
      }
    if (9 + 1 < ph1) { if (ph1 > 1000) grid.sync(); else xcd_barrier(xb); }
  }
  if (ph0 <= 10 && 10 < ph1) {
    asm volatile("" : "+s"(pp));
    CP& p = *pp;
    const int bid = get_rbid();
    const int vid0 = (G & 7) ? bid : ((bid & 7) * (G >> 3) + (bid >> 3));
    const int hb = get_hb();
    char* smem_h = smem + hb * HALF_LDS; (void)smem_h;
    const float* mv0 = p.modv; const float* mv1 = p.modv + (size_t)9 * 6144;
    (void)mv0; (void)mv1; (void)vid0;
    phase_normmod_x(p, p.norm_mix_g + 1024, 1, 0);
    if (10 + 1 < ph1) { if (ph1 > 1000) grid.sync(); else xcd_barrier(xb); }
  }
  if (ph0 <= 11 && 11 < ph1) {
    asm volatile("" : "+s"(pp));
    CP& p = *pp;
    const int bid = get_rbid();
    const int vid0 = (G & 7) ? bid : ((bid & 7) * (G >> 3) + (bid >> 3));
    const int hb = get_hb();
    char* smem_h = smem + hb * HALF_LDS; (void)smem_h;
    const float* mv0 = p.modv; const float* mv1 = p.modv + (size_t)9 * 6144;
    (void)mv0; (void)mv1; (void)vid0;
    {
        EpiBiasStore e1{p.x1h, 1024, p.hy_b_in};
        gemm_job<true>(smem, p.hxc, 1024, p.wt_hin, 1024, 1024, 16, 2048, 0, 128, 0, 2048, 128, 0, vid0, G, e1);
        EpiBiasT e2{p.vvT, p.hy_b_in + 1024};
        gemm_job<false>(smem, p.hxc, 1024, p.wt_hin + (size_t)1024 * 1024, 1024, 2048, 16, 2048, 0, 128, 0, 2048, 128, 64 * 4, vid0, G, e2);
      }
    if (11 + 1 < ph1) { if (ph1 > 1000) grid.sync(); else xcd_barrier(xb); }
  }
  if (ph0 <= 12 && 12 < ph1) {
    asm volatile("" : "+s"(pp));
    CP& p = *pp;
    const int bid = get_rbid();
    const int vid0 = (G & 7) ? bid : ((bid & 7) * (G >> 3) + (bid >> 3));
    const int hb = get_hb();
    char* smem_h = smem + hb * HALF_LDS; (void)smem_h;
    const float* mv0 = p.modv; const float* mv1 = p.modv + (size_t)9 * 6144;
    (void)mv0; (void)mv1; (void)vid0;
    phase_hyconv(p, smem_h);
    if (12 + 1 < ph1) { if (ph1 > 1000) grid.sync(); else xcd_barrier(xb); }
  }
  if (ph0 <= 13 && 13 < ph1) {
    asm volatile("" : "+s"(pp));
    CP& p = *pp;
    const int bid = get_rbid();
    const int vid0 = (G & 7) ? bid : ((bid & 7) * (G >> 3) + (bid >> 3));
    const int hb = get_hb();
    char* smem_h = smem + hb * HALF_LDS; (void)smem_h;
    const float* mv0 = p.modv; const float* mv1 = p.modv + (size_t)9 * 6144;
    (void)mv0; (void)mv1; (void)vid0;
    phase_transmul(p, smem_h);
    if (13 + 1 < ph1) { if (ph1 > 1000) grid.sync(); else xcd_barrier(xb); }
  }
  if (ph0 <= 14 && 14 < ph1) {
    asm volatile("" : "+s"(pp));
    CP& p = *pp;
    const int bid = get_rbid();
    const int vid0 = (G & 7) ? bid : ((bid & 7) * (G >> 3) + (bid >> 3));
    const int hb = get_hb();
    char* smem_h = smem + hb * HALF_LDS; (void)smem_h;
    const float* mv0 = p.modv; const float* mv1 = p.modv + (size_t)9 * 6144;
    (void)mv0; (void)mv1; (void)vid0;
    {
        EpiResid<false> e{p.X16, p.X16, mv1 + 2 * 1024, p.hy_b_out};
        gemm_job<true>(smem, p.hxc, 1024, p.wt_hout, 1024, 1024, 16, 2048, 0, 128, 0, 2048, 128, 0, vid0, G, e);
      }
    if (14 + 1 < ph1) { if (ph1 > 1000) grid.sync(); else xcd_barrier(xb); }
  }
  if (ph0 <= 15 && 15 < ph1) {
    asm volatile("" : "+s"(pp));
    CP& p = *pp;
    const int bid = get_rbid();
    const int vid0 = (G & 7) ? bid : ((bid & 7) * (G >> 3) + (bid >> 3));
    const int hb = get_hb();
    char* smem_h = smem + hb * HALF_LDS; (void)smem_h;
    const float* mv0 = p.modv; const float* mv1 = p.modv + (size_t)9 * 6144;
    (void)mv0; (void)mv1; (void)vid0;
    phase_normmod_x(p, p.norm_ffn_g + 1024, 1, 3);
    if (15 + 1 < ph1) { if (ph1 > 1000) grid.sync(); else xcd_barrier(xb); }
  }
  if (ph0 <= 16 && 16 < ph1) {
    asm volatile("" : "+s"(pp));
    CP& p = *pp;
    const int bid = get_rbid();
    const int vid0 = (G & 7) ? bid : ((bid & 7) * (G >> 3) + (bid >> 3));
    const int hb = get_hb();
    char* smem_h = smem + hb * HALF_LDS; (void)smem_h;
    const float* mv0 = p.modv; const float* mv1 = p.modv + (size_t)9 * 6144;
    (void)mv0; (void)mv1; (void)vid0;
    {
        EpiConv<0> e{p.ffn_conv_w + (size_t)3 * 5632, p.ffn_conv_b + 5632, 5632, nullptr, p.act, nullptr};
        gemm_job<true>(smem, p.hxc, 1024, p.wt_up1, 1024, 5632, 17, 2048, 0, 126, 1, 2048, 136, 0, vid0, G, e);
      }
    if (16 + 1 < ph1) { if (ph1 > 1000) grid.sync(); else xcd_barrier(xb); }
  }
  if (ph0 <= 17 && 17 < ph1) {
    asm volatile("" : "+s"(pp));
    CP& p = *pp;
    const int bid = get_rbid();
    const int vid0 = (G & 7) ? bid : ((bid & 7) * (G >> 3) + (bid >> 3));
    const int hb = get_hb();
    char* smem_h = smem + hb * HALF_LDS; (void)smem_h;
    const float* mv0 = p.modv; const float* mv1 = p.modv + (size_t)9 * 6144;
    (void)mv0; (void)mv1; (void)vid0;
    {
        EpiResid<false> e{p.X16, p.X16, mv1 + 5 * 1024, nullptr};
        gemm_job<true>(smem, p.act, 2816, p.wt_dn1, 2816, 1024, 16, 2048, 0, 128, 0, 2048, 128, 0, vid0, G, e);
      }
    if (17 + 1 < ph1) { if (ph1 > 1000) grid.sync(); else xcd_barrier(xb); }
  }
  if (ph0 <= 18 && 18 < ph1) {
    asm volatile("" : "+s"(pp));
    CP& p = *pp;
    const int bid = get_rbid();
    const int vid0 = (G & 7) ? bid : ((bid & 7) * (G >> 3) + (bid >> 3));
    const int hb = get_hb();
    char* smem_h = smem + hb * HALF_LDS; (void)smem_h;
    const float* mv0 = p.modv; const float* mv1 = p.modv + (size_t)9 * 6144;
    (void)mv0; (void)mv1; (void)vid0;
    phase_final_norm(p);
    if (18 + 1 < ph1) { if (ph1 > 1000) grid.sync(); else xcd_barrier(xb); }
  }
}

extern "C" void kernel_launch(void* const* d_in, const int* in_sizes, int n_in, void* d_out, int out_size, void* d_ws, size_t ws_size, hipStream_t stream) {
  static int grid_blocks = 0;
  if (!grid_blocks) {
    int dev = 0, cus = 0, per_cu = 0;
    hipGetDevice(&dev);
    hipDeviceGetAttribute(&cus, hipDeviceAttributeMultiprocessorCount, dev);
    hipOccupancyMaxActiveBlocksPerMultiprocessor(&per_cu, (const void*)mega, 512, 0);
    per_cu = 1;
    grid_blocks = cus * per_cu;
  }
  P p{};
  const float** in = (const float**)&p;
  for (int i = 0; i < 36; ++i) in[i] = (const float*)d_in[i];
  p.X = (float*)d_out;
  char* ws = (char*)d_ws; size_t off = 0;
  auto take = [&](size_t bytes) { char* r = ws + off; off += (bytes + 255) & ~(size_t)255; return r; };
  p.wt_dq = (bf16_t*)take((size_t)512 * 1024 * 2);
  p.wt_dkv = (bf16_t*)take((size_t)288 * 1024 * 2);
  p.wt_uq = (bf16_t*)take((size_t)1536 * 512 * 2);
  p.wt_uk = (bf16_t*)take((size_t)1024 * 256 * 2);
  p.wt_uv = (bf16_t*)take((size_t)1024 * 256 * 2);
  p.wt_o = (bf16_t*)take((size_t)1024 * 1024 * 2);
  p.wt_hin = (bf16_t*)take((size_t)3072 * 1024 * 2);
  p.wt_hout = (bf16_t*)take((size_t)1024 * 1024 * 2);
  p.wt_up0 = (bf16_t*)take((size_t)5632 * 1024 * 2);
  p.wt_up1 = (bf16_t*)take((size_t)5632 * 1024 * 2);
  p.wt_dn0 = (bf16_t*)take((size_t)1024 * 2816 * 2);
  p.wt_dn1 = (bf16_t*)take((size_t)1024 * 2816 * 2);
  p.modv = (float*)take((size_t)2 * 9 * 6144 * 4);
  p.rq = (float*)take((size_t)4 * 16384 * 4);
  p.rkv = (float*)take((size_t)2 * 18432 * 4);
  p.modp = (float*)take((size_t)4 * 110592 * 4);
  p.bar = (unsigned*)take((size_t)XCD_BAR_WORDS * 4);
  p.wt_f3 = (bf16_t*)take((size_t)2048 * 64 * 2);
  p.h2bf = (bf16_t*)take((size_t)2048 * 64 * 2);
  p.Rf = (bf16_t*)take((size_t)1024 * 4096 * 2);
  p.kpe = (bf16_t*)take((size_t)18432 * 32 * 2);
  p.hxc = (bf16_t*)take((size_t)18432 * 1024 * 2);
  const size_t ubase = off;
  p.cq = (bf16_t*)take((size_t)16384 * 512 * 2);
  p.kv = (bf16_t*)take((size_t)18432 * 288 * 2);
  p.Q = (bf16_t*)take((size_t)16384 * 1536 * 2);
  p.Kn = (bf16_t*)take((size_t)18432 * 1024 * 2);
  p.Vt = (bf16_t*)take((size_t)18432 * 1024 * 2);
  const size_t uend1 = off;
  p.X16 = (bf16_t*)(ws + ubase + (size_t)104857600);
  off = ubase;
  p.act = (bf16_t*)take((size_t)16384 * 2816 * 2);
  off = ubase;
  p.x1h = (bf16_t*)take((size_t)16384 * 1024 * 2);
  p.vvT = (bf16_t*)take((size_t)2 * 16384 * 1024 * 2);
  p.Yp = p.vvT;
  if (uend1 > ws_size) { fprintf(stderr, "workspace too small: need %zu have %zu\n", uend1, ws_size); return; }
  p.ph0 = 0; p.ph1 = NPHASE;
  if (hipMemsetAsync(p.bar, 0, (size_t)XCD_BAR_WORDS * 4, stream) != hipSuccess) { fprintf(stderr, "memset failed\n"); return; }
  void* args[] = {&p};
  hipError_t e = hipLaunchCooperativeKernel((const void*)mega, dim3(grid_blocks), dim3(512), args, 0, stream);
  if (e != hipSuccess) fprintf(stderr, "cooperative launch failed: %s (grid %d)\n", hipGetErrorString(e), grid_blocks);
}
```

```cpp
#include <hip/hip_runtime.h>
#include <hip/hip_cooperative_groups.h>
#include <cstdio>
namespace cg = cooperative_groups;

typedef unsigned short bf16_t;
typedef short bf16x8 __attribute__((ext_vector_type(8)));
typedef float f32x4 __attribute__((ext_vector_type(4)));
typedef float f32x16 __attribute__((ext_vector_type(16)));

#define LDS_BYTES 163840
#define HALF_LDS 81920
#define NPHASE 19

struct P {
  const float *x, *c, *ctx, *c_ctx, *mod_w, *mod_b, *norm_mix_g, *norm_ffn_g;
  const float *w_dq, *g_q, *w_uq, *w_dkv, *g_kv, *w_uk, *w_uv, *w_o;
  const float *hy_w_in, *hy_b_in, *hy_conv_w, *hy_conv_b, *f_w1, *f_b1, *f_freq1, *f_w2, *f_b2, *f_freq2, *f_w3, *hy_decay, *hy_d_bias, *hy_w_out, *hy_b_out;
  const float *ffn_w_up, *ffn_conv_w, *ffn_conv_b, *ffn_w_down, *final_g;
  float* X;
  bf16_t *wt_dq, *wt_dkv, *wt_uq, *wt_uk, *wt_uv, *wt_o, *wt_hin, *wt_hout, *wt_up0, *wt_up1, *wt_dn0, *wt_dn1;
  float *modv, *rq, *rkv, *modp;
  unsigned* bar;
  bf16_t *wt_f3, *h2bf, *X16;
  bf16_t *Rf, *kpe, *hxc, *cq, *kv, *Q, *Kn, *Vt, *act, *x1h, *vvT, *Yp;
  int ph0, ph1;
};

typedef const __attribute__((address_space(4))) P CP;
__device__ __forceinline__ int get_tid512() { int t = threadIdx.x; asm volatile("" : "+v"(t)); return t; }
__device__ __forceinline__ int get_tid() { int t = threadIdx.x & 255; asm volatile("" : "+v"(t)); return t; }
__device__ __forceinline__ int get_hb() { int t = __builtin_amdgcn_readfirstlane((int)(threadIdx.x >> 8)); asm volatile("" : "+s"(t)); return t; }
__device__ __forceinline__ int get_rbid() { int t = blockIdx.x; asm volatile("" : "+s"(t)); return t; }
__device__ __forceinline__ int get_bid() { return 2 * get_rbid() + get_hb(); }
#define VGRID (2 * (int)gridDim.x)

__device__ __forceinline__ unsigned pack2(float a, float b) { unsigned r; asm("v_cvt_pk_bf16_f32 %0, %1, %2" : "=v"(r) : "v"(a), "v"(b)); return r; }
__device__ __forceinline__ bf16_t f2bf(float f) { return (bf16_t)(pack2(f, f) & 0xffffu); }
__device__ __forceinline__ float bf2f(bf16_t h) { return __uint_as_float(((unsigned)h) << 16); }
__device__ __forceinline__ float wave_sum(float v) {
#pragma unroll
  for (int o = 32; o; o >>= 1) v += __shfl_xor(v, o);
  return v;
}


#define XB_TMO      128
#define XB_XCNT(j)  (256  + 64 * (j))
#define XB_XSUB(j)  (1280 + 64 * (j))
#define XB_XGEN(j)  (2304 + 64 * (j))
#define XB_TOP      3328
#define XB_TOPGEN   3392
#define XCD_BAR_WORDS 3456
#define XB_SPIN_CAP (1u << 18)
#define LAS __attribute__((address_space(3)))
__device__ __forceinline__ unsigned xb_ld(unsigned* p)              { return __hip_atomic_load(p, __ATOMIC_RELAXED, __HIP_MEMORY_SCOPE_AGENT); }
__device__ __forceinline__ unsigned xb_add(unsigned* p, unsigned v) { return __hip_atomic_fetch_add(p, v, __ATOMIC_RELAXED, __HIP_MEMORY_SCOPE_AGENT); }
__device__ __forceinline__ unsigned xb_xcc_id() { return (unsigned)__builtin_amdgcn_s_getreg((3 << 11) | 20) & 0xFu; }
#define XB_SPIN(cond, bar) do { unsigned _sp = 0; while (cond) { __builtin_amdgcn_s_sleep(1); \
    if ((++_sp & 255u) == 0u) { if (xb_ld(&(bar)[XB_TMO])) break; if (_sp > XB_SPIN_CAP) { atomicAdd(&(bar)[XB_TMO], 1u); break; } } } } while (0)
struct XcdBarrier { unsigned* bar; unsigned x; volatile LAS unsigned* st; };
__device__ __forceinline__ XcdBarrier xcd_barrier_post(unsigned* bar, volatile LAS unsigned* st) {
    XcdBarrier b; b.bar = bar; b.x = xb_xcc_id(); b.st = st;
    if (threadIdx.x == 0) (void)xb_add(&bar[XB_XCNT(b.x)], 1u);
    return b;
}
__device__ __forceinline__ void xcd_barrier_complete(unsigned* bar, unsigned x, unsigned& nloc, unsigned& nx) {
    const unsigned G = gridDim.x * gridDim.y * gridDim.z;
    unsigned sum, cnt, mine, sp = 0u;
    for (;;) {
        sum = 0u; cnt = 0u; mine = 0u;
#pragma unroll
        for (unsigned j = 0; j < 16; ++j) { const unsigned c = xb_ld(&bar[XB_XCNT(j)]); sum += c; cnt += (c > 0u) ? 1u : 0u; mine = (j == x) ? c : mine; }
        if (sum == G) break;
        __builtin_amdgcn_s_sleep(1);
        if ((++sp & 255u) == 0u) { if (xb_ld(&bar[XB_TMO])) break; if (sp > XB_SPIN_CAP) { atomicAdd(&bar[XB_TMO], 1u); break; } }
    }
    nloc = mine > 0u ? mine : 1u; nx = cnt > 0u ? cnt : 1u;
}
__device__ __forceinline__ void xcd_barrier(const XcdBarrier& b) {
    asm volatile("s_waitcnt vmcnt(0)" ::: "memory");
    __syncthreads();
    if (threadIdx.x == 0) {
        unsigned* bar = b.bar;
        __builtin_amdgcn_s_waitcnt(0);
        unsigned nloc = b.st[0], nx = b.st[1];
        if (nloc == 0u) { xcd_barrier_complete(bar, b.x, nloc, nx); b.st[0] = nloc; b.st[1] = nx; }
        const unsigned old = xb_add(&bar[XB_XSUB(b.x)], 1u);
        const unsigned gen = old / nloc;
        if (old + 1u == (gen + 1u) * nloc) {
            __builtin_amdgcn_fence(__ATOMIC_RELEASE, "agent");
            asm volatile("s_waitcnt vmcnt(0)" ::: "memory");
            const unsigned og = xb_add(&bar[XB_TOP], 1u);
            const unsigned tg = og / nx;
            if (og + 1u == (tg + 1u) * nx) xb_add(&bar[XB_TOPGEN], 1u);
            else XB_SPIN(xb_ld(&bar[XB_TOPGEN]) == tg, bar);
            __builtin_amdgcn_fence(__ATOMIC_ACQUIRE, "agent");
            xb_add(&bar[XB_XGEN(b.x)], 1u);
            asm volatile("s_waitcnt vmcnt(0)" ::: "memory");
        } else {
            XB_SPIN(xb_ld(&bar[XB_XGEN(b.x)]) == gen, bar);
            __builtin_amdgcn_fence(__ATOMIC_ACQUIRE, "agent");
            asm volatile("s_waitcnt vmcnt(0)" ::: "memory");
        }
    }
    __syncthreads();
}

__device__ __forceinline__ void prep_weight_tile(CP& p, char* smem, int wt) {
  const int tid = get_tid();
  int id = 0;
  {
    const int cnt[13] = {64, 40, 96, 32, 32, 128, 384, 128, 704, 704, 352, 352, 32};
#pragma unroll
    for (int i = 0; i < 12; ++i) { if (id == i && wt >= cnt[i]) { wt -= cnt[i]; id = i + 1; } }
  }
  const float* src; int K, N; bf16_t* dst; const float* scale = nullptr; int perm = 0;
  switch (id) {
    case 0: src = p.w_dq; K = 1024; N = 512; dst = p.wt_dq; break;
    case 1: src = p.w_dkv; K = 1024; N = 288; dst = p.wt_dkv; break;
    case 2: src = p.w_uq; K = 512; N = 1536; dst = p.wt_uq; scale = p.g_q; break;
    case 3: src = p.w_uk; K = 256; N = 1024; dst = p.wt_uk; scale = p.g_kv; break;
    case 4: src = p.w_uv; K = 256; N = 1024; dst = p.wt_uv; scale = p.g_kv; break;
    case 5: src = p.w_o; K = 1024; N = 1024; dst = p.wt_o; break;
    case 6: src = p.hy_w_in; K = 1024; N = 3072; dst = p.wt_hin; break;
    case 7: src = p.hy_w_out; K = 1024; N = 1024; dst = p.wt_hout; break;
    case 8: src = p.ffn_w_up; K = 1024; N = 5632; dst = p.wt_up0; perm = 1; break;
    case 9: src = p.ffn_w_up + (size_t)1024 * 5632; K = 1024; N = 5632; dst = p.wt_up1; perm = 1; break;
    case 10: src = p.ffn_w_down; K = 2816; N = 1024; dst = p.wt_dn0; break;
    case 11: src = p.ffn_w_down + (size_t)2816 * 1024; K = 2816; N = 1024; dst = p.wt_dn1; break;
    default: src = p.f_w3; K = 64; N = 2048; dst = p.wt_f3; break;
  }
  const int ntn = (N + 63) >> 6;
  const int kt = wt / ntn, nt = wt - kt * ntn;
  const int k0 = kt * 128, n0 = nt * 64;
  int np0;
  if (perm == 1) { const int half = n0 / 2816, f = n0 - half * 2816; np0 = (f >> 6) * 128 + half * 64; }
  else if (perm == 2) { if (n0 < 1024) np0 = n0; else { const int m = n0 - 1024, half = m >> 10, f = m & 1023; np0 = 1024 + (f >> 6) * 128 + half * 64; } }
  else np0 = n0;
  bf16_t* t16 = (bf16_t*)smem;
  f32x4 v[8];
#pragma unroll
  for (int i = 0; i < 8; ++i) {
    const int idx = tid + 256 * i; const int kr = idx >> 4, c4 = idx & 15;
    v[i] = (f32x4){0.f, 0.f, 0.f, 0.f};
    if (n0 + 4 * c4 < N && k0 + kr < K) v[i] = *(const f32x4*)(src + (size_t)(k0 + kr) * N + n0 + 4 * c4);
  }
#pragma unroll
  for (int i = 0; i < 8; ++i) {
    const int idx = tid + 256 * i; const int kr = idx >> 4, c4 = idx & 15;
    const float sc = (scale && k0 + kr < K) ? scale[k0 + kr] : 1.f;
#pragma unroll
    for (int j = 0; j < 4; ++j) t16[(4 * c4 + j) * 136 + kr] = f2bf(v[i][j] * sc);
  }
  __syncthreads();
#pragma unroll
  for (int i = 0; i < 4; ++i) {
    const int idx = tid + 256 * i; const int n = idx >> 4, ch = idx & 15;
    if (n0 + n < N && k0 + ch * 8 < K) *(uint4*)(dst + (size_t)(np0 + n) * K + k0 + ch * 8) = *(const uint4*)(t16 + n * 136 + ch * 8);
  }
  __syncthreads();
}

__device__ __forceinline__ void prep_modvec(CP& p, char* smem, int it) {
  const int tid = get_tid();
  const int layer = it / 384, rem = it - layer * 384, cb = rem >> 2, ks = rem & 3;
  float* s_lds = (float*)smem;
  float* red = (float*)(smem + 12288);
  const int kbase = ks * 256;
  for (int idx = tid; idx < 9 * 256; idx += 256) {
    const int r = idx >> 8, k = idx & 255;
    const float v = r < 8 ? p.c[r * 1024 + kbase + k] : p.c_ctx[kbase + k];
    s_lds[k * 12 + r] = v / (1.f + __expf(-v));
  }
  __syncthreads();
  const int col = cb * 64 + (tid & 63), kg = tid >> 6;
  const float* W = p.mod_w + (size_t)layer * 1024 * 6144 + (size_t)kbase * 6144 + col;
  float acc[9];
#pragma unroll
  for (int r = 0; r < 9; ++r) acc[r] = 0.f;
#pragma unroll
  for (int kb = 0; kb < 4; ++kb) {
    float w[16];
#pragma unroll
    for (int u = 0; u < 16; ++u) w[u] = W[(size_t)(kg * 64 + kb * 16 + u) * 6144];
#pragma unroll
    for (int u = 0; u < 16; ++u) {
      const int k = kg * 64 + kb * 16 + u;
      const f32x4 s0 = *(const f32x4*)(s_lds + k * 12), s1 = *(const f32x4*)(s_lds + k * 12 + 4);
      const float s2 = s_lds[k * 12 + 8];
      acc[0] += s0[0] * w[u]; acc[1] += s0[1] * w[u]; acc[2] += s0[2] * w[u]; acc[3] += s0[3] * w[u];
      acc[4] += s1[0] * w[u]; acc[5] += s1[1] * w[u]; acc[6] += s1[2] * w[u]; acc[7] += s1[3] * w[u];
      acc[8] += s2 * w[u];
    }
  }
#pragma unroll
  for (int r = 0; r < 9; ++r) red[(kg * 9 + r) * 64 + (tid & 63)] = acc[r];
  __syncthreads();
  for (int o = tid; o < 9 * 64; o += 256) {
    const int r = o >> 6, cl = o & 63;
    const float sm = red[(0 * 9 + r) * 64 + cl] + red[(1 * 9 + r) * 64 + cl] + red[(2 * 9 + r) * 64 + cl] + red[(3 * 9 + r) * 64 + cl];
    p.modp[(size_t)ks * 110592 + (size_t)(layer * 9 + r) * 6144 + cb * 64 + cl] = sm;
  }
  __syncthreads();
}

__device__ __forceinline__ void prep_filter(CP& p, char* smem, int it) {
  const int tid = get_tid();
  float* z = (float*)smem;
  float* h1 = z + 8 * 33;
  float* h2 = h1 + 8 * 64;
  const int t0 = it * 8;
  for (int idx = tid; idx < 8 * 33; idx += 256) {
    const int pp = idx / 33, i = idx - pp * 33;
    const int t = t0 + pp;
    float v;
    if (i == 0) v = (float)t * (1.0f / 2047.0f);
    else {
      const int k = (i - 1) & 15;
      const float w = (6.283185307179586f * (float)t) / 2048.0f;
      const float f = 1e-4f + (float)k * ((15.0f - 1e-4f) / 15.0f);
      const float a = w * f;
      v = (i <= 16) ? __cosf(a) : -__sinf(a);
    }
    z[idx] = v;
  }
  __syncthreads();
  for (int idx = tid; idx < 8 * 64; idx += 256) {
    const int pp = idx >> 6, j = idx & 63;
    float s = p.f_b1[j];
#pragma unroll
    for (int i = 0; i < 33; ++i) s += z[pp * 33 + i] * p.f_w1[i * 64 + j];
    h1[idx] = __sinf(p.f_freq1[j] * s);
  }
  __syncthreads();
  for (int idx = tid; idx < 8 * 64; idx += 256) {
    const int pp = idx >> 6, j = idx & 63;
    float s = p.f_b2[j];
#pragma unroll 16
    for (int i = 0; i < 64; ++i) s += h1[pp * 64 + i] * p.f_w2[i * 64 + j];
    h2[idx] = __sinf(p.f_freq2[j] * s);
  }
  __syncthreads();
  for (int idx = tid; idx < 8 * 64; idx += 256) p.h2bf[(size_t)t0 * 64 + idx] = f2bf(h2[idx]);
  __syncthreads();
}

__device__ __forceinline__ void phase_prep(CP& p, char* smem) {
  const int total = 768 + 256 + 3048;
  for (int it = get_bid(); it < total; it += VGRID) {
    if (it < 768) prep_modvec(p, smem, it);
    else if (it < 1024) prep_filter(p, smem, it - 768);
    else prep_weight_tile(p, smem, it - 1024);
  }
}

__device__ __forceinline__ f32x4 ld4_bf16(const bf16_t* p) {
  const uint2 u = *(const uint2*)p;
  f32x4 r; r[0] = bf2f((bf16_t)(u.x & 0xffff)); r[1] = bf2f((bf16_t)(u.x >> 16)); r[2] = bf2f((bf16_t)(u.y & 0xffff)); r[3] = bf2f((bf16_t)(u.y >> 16));
  return r;
}
template <bool PART, bool SRC16 = false>
__device__ __forceinline__ void normmod_row2(const void* __restrict__ srcv, const float* __restrict__ g, const float* __restrict__ sh, const float* __restrict__ sc, bf16_t* __restrict__ dst, int lane, const float* __restrict__ bsh = nullptr) {
  f32x4 v[2][4]; float ss0 = 0.f, ss1 = 0.f;
#pragma unroll
  for (int i = 0; i < 4; ++i) {
    if (SRC16) { v[0][i] = ld4_bf16((const bf16_t*)srcv + lane * 4 + 256 * i); v[1][i] = ld4_bf16((const bf16_t*)srcv + 1024 + lane * 4 + 256 * i); }
    else { v[0][i] = *(const f32x4*)((const float*)srcv + lane * 4 + 256 * i); v[1][i] = *(const f32x4*)((const float*)srcv + 1024 + lane * 4 + 256 * i); }
  }
#pragma unroll
  for (int i = 0; i < 4; ++i) {
    ss0 += v[0][i][0] * v[0][i][0] + v[0][i][1] * v[0][i][1] + v[0][i][2] * v[0][i][2] + v[0][i][3] * v[0][i][3];
    ss1 += v[1][i][0] * v[1][i][0] + v[1][i][1] * v[1][i][1] + v[1][i][2] * v[1][i][2] + v[1][i][3] * v[1][i][3];
  }
  ss0 = wave_sum(ss0); ss1 = wave_sum(ss1);
  const float r0 = rsqrtf(ss0 * (1.0f / 1024.0f) + 1e-6f), r1 = rsqrtf(ss1 * (1.0f / 1024.0f) + 1e-6f);
#pragma unroll
  for (int i = 0; i < 4; ++i) {
    const int k = lane * 4 + 256 * i;
    const f32x4 g4 = *(const f32x4*)(g + k);
    f32x4 s4 = *(const f32x4*)(sh + k), c4 = *(const f32x4*)(sc + k);
    if (PART) {
#pragma unroll
      for (int q = 1; q < 4; ++q) { s4 += *(const f32x4*)(sh + (size_t)q * 110592 + k); c4 += *(const f32x4*)(sc + (size_t)q * 110592 + k); }
      s4 += *(const f32x4*)(bsh + k); c4 += *(const f32x4*)(bsh + 1024 + k);
    }
    float y[4], z[4];
#pragma unroll
    for (int j = 0; j < 4; ++j) { const float gm = g4[j] * (1.f + c4[j]); y[j] = (v[0][i][j] * r0) * gm + s4[j]; z[j] = (v[1][i][j] * r1) * gm + s4[j]; }
    uint2 u; u.x = pack2(y[0], y[1]); u.y = pack2(y[2], y[3]);
    *(uint2*)(dst + k) = u;
    u.x = pack2(z[0], z[1]); u.y = pack2(z[2], z[3]);
    *(uint2*)(dst + 1024 + k) = u;
  }
}

__device__ __forceinline__ void phase_normmod_kv(CP& p) {
  const int lane = get_tid() & 63, wv = get_tid() >> 6;
  const float* g = p.norm_mix_g;
  for (int idx = get_bid() * 256 + get_tid(); idx < 110592; idx += VGRID * 256) {
    const int lr = idx / 6144; const int n = idx - lr * 6144; const int layer = lr / 9;
    p.modv[idx] = p.modp[idx] + p.modp[110592 + idx] + p.modp[2 * 110592 + idx] + p.modp[3 * 110592 + idx] + p.mod_b[layer * 6144 + n];
  }
  for (int r = (get_bid() * 4 + wv) * 2; r < 18432; r += VGRID * 8) {
    const int b = r / 2304, pp = r - b * 2304;
    const float* src; const float* mv;
    if (pp < 256) { src = p.ctx + ((size_t)b * 256 + pp) * 1024; mv = p.modp + (size_t)8 * 6144; }
    else { src = p.x + ((size_t)b * 2048 + pp - 256) * 1024; mv = p.modp + (size_t)b * 6144; }
    normmod_row2<true>(src, g, mv, mv + 1024, p.hxc + (size_t)r * 1024, lane, p.mod_b);
  }
}
__device__ __forceinline__ void phase_normmod_x(CP& p, const float* g, int layer, int chunk) {
  const int lane = get_tid() & 63, wv = get_tid() >> 6;
  for (int r = (get_bid() * 4 + wv) * 2; r < 16384; r += VGRID * 8) {
    const int b = r >> 11;
    const float* mv = p.modv + (size_t)(layer * 9 + b) * 6144 + chunk * 1024;
    normmod_row2<false, true>(p.X16 + (size_t)r * 1024, g, mv, mv + 1024, p.hxc + (size_t)r * 1024, lane);
  }
}
__device__ __forceinline__ void phase_final_norm(CP& p) {
  const int lane = get_tid() & 63, wv = get_tid() >> 6;
  for (int r = get_bid() * 4 + wv; r < 16384; r += VGRID * 4) {
    const bf16_t* srow = p.X16 + (size_t)r * 1024;
    float* row = p.X + (size_t)r * 1024;
    f32x4 v[4]; float ss = 0.f;
#pragma unroll
    for (int i = 0; i < 4; ++i) { v[i] = ld4_bf16(srow + lane * 4 + 256 * i); ss += v[i][0] * v[i][0] + v[i][1] * v[i][1] + v[i][2] * v[i][2] + v[i][3] * v[i][3]; }
    ss = wave_sum(ss);
    const float rr = rsqrtf(ss * (1.0f / 1024.0f) + 1e-6f);
#pragma unroll
    for (int i = 0; i < 4; ++i) {
      const int k = lane * 4 + 256 * i;
      const f32x4 g4 = *(const f32x4*)(p.final_g + k);
      f32x4 o; o[0] = v[i][0] * rr * g4[0]; o[1] = v[i][1] * rr * g4[1]; o[2] = v[i][2] * rr * g4[2]; o[3] = v[i][3] * rr * g4[3];
      *(f32x4*)(row + k) = o;
    }
  }
}

__device__ __forceinline__ void phase_rowstat(CP& p) {
  const int lane = get_tid() & 63, wv = get_tid() >> 6;
  for (int r = get_bid() * 4 + wv; r < 18432; r += VGRID * 4) {
    const int b = r / 2304, pp = r - b * 2304;
    const bf16_t* kvr = p.kv + (size_t)r * 288;
    {
      const uint2 u = *(const uint2*)(kvr + lane * 4);
      const float a0 = bf2f((bf16_t)(u.x & 0xffff)), a1 = bf2f((bf16_t)(u.x >> 16)), a2 = bf2f((bf16_t)(u.y & 0xffff)), a3 = bf2f((bf16_t)(u.y >> 16));
      float ss = a0 * a0 + a1 * a1 + a2 * a2 + a3 * a3;
      ss = wave_sum(ss);
      if (lane == 0) p.rkv[r] = rsqrtf(ss * (1.0f / 256.0f) + 1e-6f);
    }
    {
      const int i = lane & 31;
      const float xv = bf2f(kvr[256 + i]);
      const float ov = __shfl_xor(xv, 8);
      float res = xv;
      if (pp >= 256) {
        const int t = pp - 256;
        const int quarter = i >> 3, idx = i & 7;
        const float pos = (quarter < 2) ? (float)(t >> 6) : (float)(t & 63);
        const float inv = exp2f(-(float)idx * (13.287712379549449f / 8.0f));
        const float ang = pos * inv;
        const float cs = __cosf(ang), sn = __sinf(ang);
        res = xv * cs + ((quarter & 1) ? ov : -ov) * sn;
      }
      if (lane < 32) p.kpe[(size_t)r * 32 + i] = f2bf(res);
    }
    if (pp >= 256) {
      const int xr = b * 2048 + pp - 256;
      const uint4 u = *(const uint4*)(p.cq + (size_t)xr * 512 + lane * 8);
      const unsigned uu[4] = {u.x, u.y, u.z, u.w};
      float ss = 0.f;
#pragma unroll
      for (int j = 0; j < 4; ++j) { const float a = bf2f((bf16_t)(uu[j] & 0xffff)), bb = bf2f((bf16_t)(uu[j] >> 16)); ss += a * a + bb * bb; }
      ss = wave_sum(ss);
      if (lane == 0) p.rq[xr] = rsqrtf(ss * (1.0f / 512.0f) + 1e-6f);
    }
  }
}

template <int NP>
struct EpiStore {
  static constexpr int KIND = 0; static constexpr bool ROWSUM = false;
  bf16_t* out; int ld; int ostride; const float* part; int pstride; float inv_n;
  __device__ __forceinline__ void c4(int g, int rig, int col, f32x4 v) const {
    const size_t row = (size_t)g * ostride + rig;
    float s = 1.f;
    if (NP > 0) {
      float t = 0.f;
#pragma unroll
      for (int q = 0; q < NP; ++q) t += part[(size_t)q * pstride + row];
      s = rsqrtf(t * inv_n + 1e-6f);
    }
    uint2 u; u.x = pack2(v[0] * s, v[1] * s); u.y = pack2(v[2] * s, v[3] * s);
    *(uint2*)(out + row * ld + col) = u;
  }
};
struct EpiDown {
  static constexpr int KIND = 0; static constexpr bool ROWSUM = true;
  bf16_t* out; int ld; int ostride; float* part; int nslots; bf16_t* kpe; int ropecol;
  __device__ __forceinline__ float c4(int g, int rig, int col, f32x4 v) const {
    const size_t row = (size_t)g * ostride + rig;
    if (kpe && col >= ropecol) {
      const int i0 = col - ropecol;
      f32x4 o = v;
      const float p0 = __shfl_xor(v[0], 32), p1 = __shfl_xor(v[1], 32), p2 = __shfl_xor(v[2], 32), p3 = __shfl_xor(v[3], 32);
      const float pv[4] = {p0, p1, p2, p3};
      if (rig >= 256) {
        const int t = rig - 256;
        const int quarter = i0 >> 3;
        const float pos = (quarter < 2) ? (float)(t >> 6) : (float)(t & 63);
#pragma unroll
        for (int j = 0; j < 4; ++j) {
          const int idx = (i0 & 7) + j;
          const float inv = exp2f(-(float)idx * (13.287712379549449f / 8.0f));
          const float ang = pos * inv;
          const float cs = __cosf(ang), sn = __sinf(ang);
          o[j] = v[j] * cs + ((quarter & 1) ? pv[j] : -pv[j]) * sn;
        }
      }
      uint2 u; u.x = pack2(o[0], o[1]); u.y = pack2(o[2], o[3]);
      *(uint2*)(kpe + row * 32 + i0) = u;
      return 0.f;
    }
    uint2 u; u.x = pack2(v[0], v[1]); u.y = pack2(v[2], v[3]);
    *(uint2*)(out + row * ld + col) = u;
    return v[0] * v[0] + v[1] * v[1] + v[2] * v[2] + v[3] * v[3];
  }
  __device__ __forceinline__ void rowsum(int g, int rig, int slot, float ss) const {
    if (slot < nslots) part[(size_t)slot * ((size_t)8 * ostride) + (size_t)g * ostride + rig] = ss;
  }
};
struct EpiVt {
  static constexpr int KIND = 1;
  bf16_t* out; const float* part;
  __device__ __forceinline__ void r4(int g, int rig, int col, f32x4 v) const {
    const size_t row = (size_t)g * 2304 + rig;
    const f32x4 t = *(const f32x4*)(part + row) + *(const f32x4*)(part + 18432 + row);
    f32x4 s;
#pragma unroll
    for (int j = 0; j < 4; ++j) s[j] = rsqrtf(t[j] * (1.0f / 256.0f) + 1e-6f);
    uint2 u; u.x = pack2(v[0] * s[0], v[1] * s[1]); u.y = pack2(v[2] * s[2], v[3] * s[3]);
    *(uint2*)(out + ((size_t)g * 1024 + col) * 2304 + rig) = u;
  }
};
struct EpiBiasStore {
  static constexpr int KIND = 0; static constexpr bool ROWSUM = false;
  bf16_t* out; int ld; const float* bias;
  __device__ __forceinline__ void c4(int g, int rig, int col, f32x4 v) const {
    const size_t row = (size_t)g * 2048 + rig;
    const f32x4 b4 = *(const f32x4*)(bias + col);
    uint2 u; u.x = pack2(v[0] + b4[0], v[1] + b4[1]); u.y = pack2(v[2] + b4[2], v[3] + b4[3]);
    *(uint2*)(out + row * ld + col) = u;
  }
};
struct EpiBiasT {
  static constexpr int KIND = 1;
  bf16_t* out; const float* bias;
  __device__ __forceinline__ void r4(int g, int rig, int col, f32x4 v) const {
    const float b = bias[col];
    uint2 u; u.x = pack2(v[0] + b, v[1] + b); u.y = pack2(v[2] + b, v[3] + b);
    *(uint2*)(out + (size_t)col * 16384 + (size_t)g * 2048 + rig) = u;
  }
};
struct EpiFilt {
  static constexpr int KIND = 1;
  bf16_t* Rf; const float* decay;
  __device__ __forceinline__ void r4(int g, int rig, int col, f32x4 v) const {
    const int c = col & 1023; const bool bwd = col >= 1024;
    const float dec = fabsf(decay[c]);
    bf16_t* rp = Rf + (size_t)c * 4096;
#pragma unroll
    for (int j = 0; j < 4; ++j) {
      const int t = rig + j;
      const float val = v[j] * __expf(-(float)t * (1.0f / 2047.0f) * dec);
      if (!bwd) rp[2048 - t] = f2bf(val);
      else if (t > 0) rp[2048 + t] = f2bf(val);
      else rp[0] = 0;
    }
  }
};
template <bool BASE_F32>
struct EpiResid {
  static constexpr int KIND = 0; static constexpr bool ROWSUM = false;
  bf16_t* X16; const void* base; const float* gate; const float* bias;
  __device__ __forceinline__ void c4(int g, int rig, int col, f32x4 v) const {
    const size_t o = ((size_t)g * 2048 + rig) * 1024 + col;
    f32x4 bs;
    if (BASE_F32) bs = *(const f32x4*)((const float*)base + o);
    else {
      const uint2 u = *(const uint2*)((const bf16_t*)base + o);
      bs[0] = bf2f((bf16_t)(u.x & 0xffff)); bs[1] = bf2f((bf16_t)(u.x >> 16)); bs[2] = bf2f((bf16_t)(u.y & 0xffff)); bs[3] = bf2f((bf16_t)(u.y >> 16));
    }
    const f32x4 gt = *(const f32x4*)(gate + (size_t)g * 6144 + col);
    f32x4 bi = {0.f, 0.f, 0.f, 0.f};
    if (bias) bi = *(const f32x4*)(bias + col);
    f32x4 r;
#pragma unroll
    for (int j = 0; j < 4; ++j) r[j] = bs[j] + gt[j] * (v[j] + bi[j]);
    uint2 w; w.x = pack2(r[0], r[1]); w.y = pack2(r[2], r[3]);
    *(uint2*)(X16 + o) = w;
  }
};
template <int MODE>
struct EpiConv {
  static constexpr int KIND = 2;
  const float* cw; const float* cb; int NC; const float* pre_bias;
  bf16_t* o0; bf16_t* o1;
  __device__ __forceinline__ int norig(int nt, int cl) const {
    if (MODE == 0) return (cl >> 6) * 2816 + nt * 64 + (cl & 63);
    if (nt < 8) return nt * 128 + cl;
    return 1024 + (cl >> 6) * 1024 + (nt - 8) * 64 + (cl & 63);
  }
  typedef float f32x2_t __attribute__((ext_vector_type(2)));
  static __device__ __forceinline__ f32x2_t ldz(const bf16_t* Z, int row, int col) {
    const unsigned u = *(const unsigned*)(Z + row * 132 + col);
    f32x2_t r; r[0] = __uint_as_float(u << 16); r[1] = __uint_as_float(u & 0xffff0000u); return r;
  }
  template <class F>
  __device__ __forceinline__ void finish(const bf16_t* Z, int g, int rig0, int nt, F&& pre) const {
    typedef f32x2_t f32x2;
    const int tid = get_tid();
    if (MODE == 0 || nt < 8) {
      if (MODE == 0) {
        const int f2 = (tid & 31) * 2, q8 = tid >> 5;
        const int q0 = 1 + 16 * q8, q1 = (q0 + 16 < 127) ? q0 + 16 : 127;
        const int na = norig(nt, f2), ng = norig(nt, 64 + f2);
        const f32x2 a0 = *(const f32x2*)(cw + na), a1 = *(const f32x2*)(cw + NC + na), a2 = *(const f32x2*)(cw + 2 * NC + na), ab = *(const f32x2*)(cb + na);
        const f32x2 g0 = *(const f32x2*)(cw + ng), g1 = *(const f32x2*)(cw + NC + ng), g2 = *(const f32x2*)(cw + 2 * NC + ng), gb = *(const f32x2*)(cb + ng);
        pre();
        f32x2 am = ldz(Z, q0 - 1, f2), ac = ldz(Z, q0, f2);
        f32x2 gm = ldz(Z, q0 - 1, 64 + f2), gc = ldz(Z, q0, 64 + f2);
#pragma unroll 2
        for (int pl = q0; pl < q1; ++pl) {
          const f32x2 an = ldz(Z, pl + 1, f2), gn = ldz(Z, pl + 1, 64 + f2);
          const int pos = rig0 + pl;
          if (pos < 2048) {
            const f32x2 av = a0 * am + a1 * ac + a2 * an + ab;
            const f32x2 gv = g0 * gm + g1 * gc + g2 * gn + gb;
            const float s0 = av[0] * gv[0] * __builtin_amdgcn_rcpf(1.f + __expf(-gv[0]));
            const float s1 = av[1] * gv[1] * __builtin_amdgcn_rcpf(1.f + __expf(-gv[1]));
            *(unsigned*)(o0 + ((size_t)g * 2048 + pos) * 2816 + nt * 64 + f2) = pack2(s0, s1);
          }
          am = ac; ac = an; gm = gc; gc = gn;
        }
      } else {
        const int cl = (tid & 63) * 2, q = tid >> 6;
        const int p0 = 1 + 32 * q, p1 = (p0 + 32 < 127) ? p0 + 32 : 127;
        const int na = norig(nt, cl);
        const f32x2 a0 = *(const f32x2*)(cw + na), a1 = *(const f32x2*)(cw + NC + na), a2 = *(const f32x2*)(cw + 2 * NC + na), ab = *(const f32x2*)(cb + na);
        pre();
        f32x2 am = ldz(Z, p0 - 1, cl), ac = ldz(Z, p0, cl);
#pragma unroll 2
        for (int pl = p0; pl < p1; ++pl) {
          const f32x2 an = ldz(Z, pl + 1, cl);
          const int pos = rig0 + pl;
          if (pos < 2048) {
            const f32x2 av = a0 * am + a1 * ac + a2 * an + ab;
            *(unsigned*)(o0 + ((size_t)g * 2048 + pos) * 1024 + nt * 128 + cl) = pack2(av[0], av[1]);
          }
          am = ac; ac = an;
        }
      }
    } else {
      pre();
      const int pl = tid & 127, fh = tid >> 7;
      const int pos = rig0 + pl;
      if (pl >= 1 && pl <= 126 && pos < 2048) {
        const int fb = nt - 8;
#pragma unroll 2
        for (int f = fh * 32; f < fh * 32 + 32; f += 2) {
          const int na = norig(nt, f), nb = norig(nt, 64 + f);
          const f32x2 va = *(const f32x2*)(cw + na) * ldz(Z, pl - 1, f) + *(const f32x2*)(cw + NC + na) * ldz(Z, pl, f)
                         + *(const f32x2*)(cw + 2 * NC + na) * ldz(Z, pl + 1, f) + *(const f32x2*)(cb + na);
          const f32x2 vb = *(const f32x2*)(cw + nb) * ldz(Z, pl - 1, 64 + f) + *(const f32x2*)(cw + NC + nb) * ldz(Z, pl, 64 + f)
                         + *(const f32x2*)(cw + 2 * NC + nb) * ldz(Z, pl + 1, 64 + f) + *(const f32x2*)(cb + nb);
          bf16_t* op = o1 + (size_t)(fb * 64 + f) * 16384 + g * 2048 + pos;
          op[0] = f2bf(va[0] * vb[0]);
          op[16384] = f2bf(va[1] * vb[1]);
        }
      }
    }
  }
};

#define GLDS16(gp, lp) __builtin_amdgcn_global_load_lds((const unsigned*)(gp), (__attribute__((address_space(3))) unsigned*)(lp), 16, 0, 0)

template <bool SWAP, class Epi, bool THIN = false>
__device__ __forceinline__ void gemm_job(char* smem, const bf16_t* __restrict__ A, int lda, const bf16_t* __restrict__ Bt, int K, int N,
                                         int tpg, int a_gstride, int a_goff, int step, int halo, int grows, int MTS, int voff, int vid0, int grid, const Epi& epi) {
  const int tid = get_tid512(), lane = tid & 63, wid = tid >> 6, wr = wid >> 1, wc = wid & 1, fr = lane & 15, fq = lane >> 4;
  const int NT = (N + 255) >> 8, MT = MTS >> 1, ntiles = MT * NT, ns = K >> 6;
  const int full = MT >> 3;
  int v = vid0;
  if (v < voff) v += ((voff - v + grid - 1) / grid) * grid;
  const int swz = (fr >> 1) & 7;
  bool pre_issued = false;
  for (; v < voff + ntiles; v += grid) {
    const int w = v - voff;
    int mt, nt;
    if (w < full * 8 * NT) { const int sr = w / (8 * NT), rem = w - sr * 8 * NT; nt = rem >> 3; mt = sr * 8 + (rem & 7); }
    else { const int w2 = w - full * 8 * NT, rl = MT - full * 8; nt = w2 / rl; mt = full * 8 + (w2 - nt * rl); }
    unsigned ap[4], bp[4];
#pragma unroll
    for (int i = 0; i < 4; ++i) {
      const int r = (tid >> 3) + 64 * i;
      const int cs = tid & 7;
      const int c = ((cs ^ ((r >> 1) & 7)) << 3);
      const int sub = 2 * mt + (r >> 7);
      const int g = sub / tpg, ti = sub - g * tpg;
      int rig = ti * step - halo + (r & 127); rig = rig < 0 ? 0 : (rig > grows - 1 ? grows - 1 : rig);
      ap[i] = (unsigned)((g * a_gstride + a_goff + rig) * lda + c);
      int br = nt * 256 + r; br = br > N - 1 ? N - 1 : br;
      bp[i] = (unsigned)(br * K + c);
    }
    const bool have_next = false;
    f32x4 acc[4][8];
#pragma unroll
    for (int m = 0; m < 4; ++m)
#pragma unroll
      for (int n = 0; n < 8; ++n) acc[m][n] = (f32x4){0.f, 0.f, 0.f, 0.f};
    if (!pre_issued) {
#pragma unroll
      for (int i = 0; i < 4; ++i) { GLDS16(A + (size_t)ap[i], smem + tid * 16 + i * 8192); GLDS16(Bt + (size_t)bp[i], smem + 32768 + tid * 16 + i * 8192); }
    }
    pre_issued = have_next;
    for (int st = 0; st < ns; ++st) {
      asm volatile("s_waitcnt vmcnt(0)" ::: "memory");
      __builtin_amdgcn_s_barrier();
      asm volatile("" ::: "memory");
      if (st + 1 < ns) {
        char* nb = smem + ((st + 1) & 1) * 65536;
        const int ko = (st + 1) * 64;
#pragma unroll
        for (int i = 0; i < 4; ++i) { GLDS16(A + (size_t)(ap[i] + ko), nb + tid * 16 + i * 8192); GLDS16(Bt + (size_t)(bp[i] + ko), nb + 32768 + tid * 16 + i * 8192); }
      }
      const char* sa = smem + (st & 1) * 65536 + (wr * 64 + fr) * 128;
      const char* sb = smem + (st & 1) * 65536 + 32768 + (wc * 128 + fr) * 128;
      if constexpr (THIN) {
        if (wc == 0) {
#pragma unroll
          for (int ks = 0; ks < 2; ++ks) {
            bf16x8 af[4], bf[2];
#pragma unroll
            for (int m = 0; m < 4; ++m) af[m] = *(const bf16x8*)(sa + m * 2048 + (((ks * 4 + fq) ^ swz) << 4));
#pragma unroll
            for (int n = 0; n < 2; ++n) bf[n] = *(const bf16x8*)(sb + n * 2048 + (((ks * 4 + fq) ^ swz) << 4));
#pragma unroll
            for (int m = 0; m < 4; ++m)
#pragma unroll
              for (int n = 0; n < 2; ++n)
                acc[m][n] = SWAP ? __builtin_amdgcn_mfma_f32_16x16x32_bf16(bf[n], af[m], acc[m][n], 0, 0, 0)
                                 : __builtin_amdgcn_mfma_f32_16x16x32_bf16(af[m], bf[n], acc[m][n], 0, 0, 0);
          }
        }
      } else {
      bf16x8 afA[4], afB[4], bfb[2][2];
#pragma unroll
      for (int m = 0; m < 4; ++m) afA[m] = *(const bf16x8*)(sa + m * 2048 + ((fq ^ swz) << 4));
#pragma unroll
      for (int n = 0; n < 2; ++n) bfb[0][n] = *(const bf16x8*)(sb + n * 2048 + ((fq ^ swz) << 4));
#pragma unroll
      for (int gq = 0; gq < 8; ++gq) {
        const int ks = gq >> 2, nh = gq & 3;
        if (gq < 7) {
          const int ks2 = (gq + 1) >> 2, nh2 = (gq + 1) & 3;
#pragma unroll
          for (int n = 0; n < 2; ++n) bfb[(gq + 1) & 1][n] = *(const bf16x8*)(sb + (nh2 * 2 + n) * 2048 + (((ks2 * 4 + fq) ^ swz) << 4));
        }
        if (gq == 3) {
#pragma unroll
          for (int m = 0; m < 4; ++m) afB[m] = *(const bf16x8*)(sa + m * 2048 + (((4 + fq) ^ swz) << 4));
        }
        __builtin_amdgcn_sched_barrier(0);
#pragma unroll
        for (int m = 0; m < 4; ++m)
#pragma unroll
          for (int n = 0; n < 2; ++n) {
            const bf16x8 av = ks ? afB[m] : afA[m];
            acc[m][nh * 2 + n] = SWAP ? __builtin_amdgcn_mfma_f32_16x16x32_bf16(bfb[gq & 1][n], av, acc[m][nh * 2 + n], 0, 0, 0)
                                      : __builtin_amdgcn_mfma_f32_16x16x32_bf16(av, bfb[gq & 1][n], acc[m][nh * 2 + n], 0, 0, 0);
          }
      }
      }
    }
    __syncthreads();
    const int te = get_tid512();
    const int fr_e = te & 15, fq_e = (te & 63) >> 4, wr_e = te >> 7, wc_e = (te >> 6) & 1;
    const int sub = 2 * mt + (wr_e >> 1);
    const int g = sub / tpg, ti = sub - g * tpg;
    const int rig0 = ti * step - halo;
    const int rw = (wr_e & 1) * 64;
    if constexpr (Epi::KIND == 0) {
#pragma unroll
      for (int m = 0; m < 4; ++m) {
        const int rig = rig0 + rw + m * 16 + fr_e;
        if constexpr (Epi::ROWSUM) {
          float ss = 0.f;
#pragma unroll
          for (int n = 0; n < 8; ++n) {
            const int col = nt * 256 + wc_e * 128 + n * 16 + fq_e * 4;
            if (col < N) ss += epi.c4(g, rig, col, acc[m][n]);
          }
          ss += __shfl_xor(ss, 16); ss += __shfl_xor(ss, 32);
          if (fq_e == 0) epi.rowsum(g, rig, nt * 2 + wc_e, ss);
        } else {
#pragma unroll
          for (int n = 0; n < 8; ++n) {
            const int col = nt * 256 + wc_e * 128 + n * 16 + fq_e * 4;
            if (col < N) epi.c4(g, rig, col, acc[m][n]);
          }
        }
      }
    } else if constexpr (Epi::KIND == 1) {
#pragma unroll
      for (int m = 0; m < 4; ++m) {
        const int rig = rig0 + rw + m * 16 + fq_e * 4;
#pragma unroll
        for (int n = 0; n < 8; ++n) {
          const int col = nt * 256 + wc_e * 128 + n * 16 + fr_e;
          if (col < N) epi.r4(g, rig, col, acc[m][n]);
        }
      }
    } else {
      bf16_t* Zw = (bf16_t*)smem + ((wr_e >> 1) * 2 + wc_e) * (128 * 132);
      const int nt2w = nt * 2 + wc_e;
#pragma unroll
      for (int n = 0; n < 8; ++n) {
        const int cl = n * 16 + fq_e * 4;
        f32x4 b4 = {0.f, 0.f, 0.f, 0.f};
        if (epi.pre_bias) b4 = *(const f32x4*)(epi.pre_bias + epi.norig(nt2w, cl));
#pragma unroll
        for (int m = 0; m < 4; ++m) {
          const int rl = rw + m * 16 + fr_e;
          const int pos = rig0 + rl;
          const bool ok = pos >= 0 && pos < grows;
          f32x4 vv = acc[m][n] + b4;
          if (!ok) vv = (f32x4){0.f, 0.f, 0.f, 0.f};
          uint2 u; u.x = pack2(vv[0], vv[1]); u.y = pack2(vv[2], vv[3]);
          *(uint2*)(Zw + rl * 132 + cl) = u;
        }
      }
      __syncthreads();
      {
        auto no_pre = []() {};
        const bf16_t* Zr = (const bf16_t*)smem + ((wr_e >> 1) * 2) * (128 * 132);
        epi.finish(Zr, g, rig0, nt * 2, no_pre);
        epi.finish(Zr + 128 * 132, g, rig0, nt * 2 + 1, no_pre);
      }
      __syncthreads();
    }
    asm volatile("s_waitcnt vmcnt(0)" ::: "memory");
    __syncthreads();
  }
}

__device__ __forceinline__ void phase_attn(CP& p, char* smem, int vid0, int grid) {
  bf16_t* Ks = (bf16_t*)smem;
  bf16_t* Vs = (bf16_t*)(smem + 64 * 104 * 2);
  const int tid = get_tid512(), lane = tid & 63, w = tid >> 6, r = lane & 31, hh = lane >> 5;
  const float cs = 1.4426950408889634f * 0.10206207261596577f;
  for (int it = vid0; it < 1024; it += grid) {
    const int qt = it & 7, h = (it >> 3) & 15, b = it >> 7;
    const int t = qt * 256 + w * 32 + r;
    const size_t xrow = (size_t)b * 2048 + t;
    const bf16_t* qp = p.Q + xrow * 1536 + h * 96;
    bf16x8 qf[6];
#pragma unroll
    for (int kk = 0; kk < 4; ++kk) qf[kk] = *(const bf16x8*)(qp + 16 * kk + 8 * hh);
#pragma unroll
    for (int part = 0; part < 2; ++part) {
      const bf16_t* pp = qp + 64 + 16 * part;
      const bf16x8 mine = *(const bf16x8*)(pp + 8 * hh), oth = *(const bf16x8*)(pp + 8 * (1 - hh));
      const float posf = part == 0 ? (float)(t >> 6) : (float)(t & 63);
      union { unsigned u[4]; bf16x8 v; } o;
      float res[8];
#pragma unroll
      for (int j = 0; j < 8; ++j) {
        const float inv = exp2f(-(float)j * (13.287712379549449f / 8.0f));
        const float ang = posf * inv;
        const float c = __cosf(ang), s = __sinf(ang);
        const float m = bf2f((bf16_t)mine[j]), ov = bf2f((bf16_t)oth[j]);
        res[j] = m * c + (hh ? ov : -ov) * s;
      }
#pragma unroll
      for (int j = 0; j < 4; ++j) o.u[j] = pack2(res[2 * j], res[2 * j + 1]);
      qf[4 + part] = o.v;
    }
    f32x16 oacc[2];
#pragma unroll
    for (int i = 0; i < 16; ++i) { oacc[0][i] = 0.f; oacc[1][i] = 0.f; }
    float mrun = -INFINITY, lrun = 0.f;
    const size_t kvrow0 = (size_t)b * 2304;
    const bf16_t* kn_base = p.Kn + kvrow0 * 1024 + h * 64;
    const bf16_t* kpe_base = p.kpe + kvrow0 * 32;
    const bf16_t* vt_base = p.Vt + ((size_t)(b * 16 + h) * 64) * 2304;
    uint4 rk0, rp, rv0;
    rp.x = 0; rp.y = 0; rp.z = 0; rp.w = 0;
    const int srow = tid >> 3, sch = tid & 7;
#define ATT_GLOAD(kt) do { \
      rk0 = *(const uint4*)(kn_base + (size_t)((kt) * 64 + srow) * 1024 + sch * 8); \
      rv0 = *(const uint4*)(vt_base + (size_t)srow * 2304 + (kt) * 64 + sch * 8); \
      if (tid < 256) rp = *(const uint4*)(kpe_base + (size_t)((kt) * 64 + (tid >> 2)) * 32 + (tid & 3) * 8); } while (0)
    ATT_GLOAD(0);
    for (int kt = 0; kt < 36; ++kt) {
      __syncthreads();
      {
        *(uint4*)(Ks + srow * 104 + sch * 8) = rk0;
        uint2 lo, hi;
        lo.x = rv0.x; lo.y = rv0.y; hi.x = rv0.z; hi.y = rv0.w;
        *(uint2*)(Vs + srow * 68 + sch * 8) = lo; *(uint2*)(Vs + srow * 68 + sch * 8 + 4) = hi;
      }
      if (tid < 256) *(uint4*)(Ks + (tid >> 2) * 104 + 64 + (tid & 3) * 8) = rp;
      __syncthreads();
      if (kt + 1 < 36) ATT_GLOAD(kt + 1);
      f32x16 s[2];
#pragma unroll
      for (int t2 = 0; t2 < 2; ++t2) {
#pragma unroll
        for (int i = 0; i < 16; ++i) s[t2][i] = 0.f;
#pragma unroll
        for (int kk = 0; kk < 6; ++kk) {
          const bf16x8 a = *(const bf16x8*)(Ks + (32 * t2 + r) * 104 + 16 * kk + 8 * hh);
          s[t2] = __builtin_amdgcn_mfma_f32_32x32x16_bf16(a, qf[kk], s[t2], 0, 0, 0);
        }
      }
      float mx = s[0][0];
#pragma unroll
      for (int i = 1; i < 16; ++i) mx = fmaxf(mx, s[0][i]);
#pragma unroll
      for (int i = 0; i < 16; ++i) mx = fmaxf(mx, s[1][i]);
      mx = fmaxf(mx, __shfl_xor(mx, 32));
      const float mcand = mx * cs;
      if (__builtin_amdgcn_ballot_w64(mcand > mrun + 6.0f) != 0ull) {
        const float mnew_ = fmaxf(mrun, mcand);
        const float alpha = __builtin_amdgcn_exp2f(mrun - mnew_);
        mrun = mnew_;
        lrun *= alpha;
#pragma unroll
        for (int i = 0; i < 16; ++i) { oacc[0][i] *= alpha; oacc[1][i] *= alpha; }
      }
      const float mnew = mrun;
      float psum = 0.f;
      bf16x8 pf[4];
#pragma unroll
      for (int t2 = 0; t2 < 2; ++t2)
#pragma unroll
        for (int hf = 0; hf < 2; ++hf) {
          union { unsigned u[4]; bf16x8 v; } cvp;
#pragma unroll
          for (int i = 0; i < 4; ++i) {
            const float p0 = __builtin_amdgcn_exp2f(s[t2][hf * 8 + 2 * i] * cs - mnew);
            const float p1 = __builtin_amdgcn_exp2f(s[t2][hf * 8 + 2 * i + 1] * cs - mnew);
            psum += p0 + p1;
            cvp.u[i] = pack2(p0, p1);
          }
          pf[t2 * 2 + hf] = cvp.v;
        }
      lrun += psum;
#pragma unroll
      for (int dt = 0; dt < 2; ++dt)
#pragma unroll
        for (int s4 = 0; s4 < 4; ++s4) {
          const bf16_t* vp = Vs + (32 * dt + r) * 68 + 16 * s4 + 4 * hh;
          const uint2 lo = *(const uint2*)vp, hi = *(const uint2*)(vp + 8);
          union { uint4 u; bf16x8 v; } cv; cv.u.x = lo.x; cv.u.y = lo.y; cv.u.z = hi.x; cv.u.w = hi.y;
          oacc[dt] = __builtin_amdgcn_mfma_f32_32x32x16_bf16(cv.v, pf[s4], oacc[dt], 0, 0, 0);
        }
    }
    const float ltot = lrun + __shfl_xor(lrun, 32);
    const float inv = 1.f / ltot;
    bf16_t* op = p.hxc + xrow * 1024 + h * 64;
#pragma unroll
    for (int dt = 0; dt < 2; ++dt)
#pragma unroll
      for (int i4 = 0; i4 < 4; ++i4) {
        const int d = 32 * dt + 8 * i4 + 4 * hh;
        uint2 u; u.x = pack2(oacc[dt][4 * i4] * inv, oacc[dt][4 * i4 + 1] * inv); u.y = pack2(oacc[dt][4 * i4 + 2] * inv, oacc[dt][4 * i4 + 3] * inv);
        *(uint2*)(op + d) = u;
      }
  }
}

__device__ __forceinline__ void phase_hyconv(CP& p, char* smem) {
  bf16_t* cp = (bf16_t*)smem;
  bf16_t* Vl = (bf16_t*)(smem + 4 * 8256);
  const int tid = get_tid(), lane = tid & 63, w = tid >> 6, i16 = lane & 15, g4 = lane >> 4;
  const int si = (-i16) & 3;
  const int ocb = 64 * w;
  for (int c = get_bid(); c < 1024; c += VGRID) {
    __syncthreads();
#pragma unroll
    for (int i = 0; i < 2; ++i) { const int ch = tid + 256 * i; *(uint4*)(cp + ch * 8) = *(const uint4*)(p.Rf + (size_t)c * 4096 + ch * 8); }
    {
      const float a0 = p.hy_conv_w[1024 + c], a1 = p.hy_conv_w[3072 + 1024 + c], a2 = p.hy_conv_w[2 * 3072 + 1024 + c], ab = p.hy_conv_b[1024 + c];
      const float v0 = p.hy_conv_w[2048 + c], v1 = p.hy_conv_w[3072 + 2048 + c], v2 = p.hy_conv_w[2 * 3072 + 2048 + c], vb = p.hy_conv_b[2048 + c];
#pragma unroll 2
      for (int i = 0; i < 8; ++i) {
        const int q = tid + 256 * i; const int b = q >> 8, l8 = q & 255; const int m1 = l8 >> 3, m2 = (l8 & 7) * 8;
        const int l0 = l8 * 8;
        const bf16_t* z2 = p.vvT + (size_t)c * 16384 + b * 2048;
        const bf16_t* zv = p.vvT + (size_t)(1024 + c) * 16384 + b * 2048;
        const uint4 u2 = *(const uint4*)(z2 + l0), uv = *(const uint4*)(zv + l0);
        float e2[10], ev[10];
        const int lp = l0 > 0 ? l0 - 1 : 0, ln = l0 + 8 < 2048 ? l0 + 8 : 2047;
        const float pm = l0 > 0 ? 1.f : 0.f, nm = l0 + 8 < 2048 ? 1.f : 0.f;
        const bf16_t q2p = z2[lp], qvp = zv[lp], q2n = z2[ln], qvn = zv[ln];
        e2[0] = bf2f(q2p) * pm; ev[0] = bf2f(qvp) * pm;
        e2[9] = bf2f(q2n) * nm; ev[9] = bf2f(qvn) * nm;
        const unsigned w2[4] = {u2.x, u2.y, u2.z, u2.w}, wv[4] = {uv.x, uv.y, uv.z, uv.w};
#pragma unroll
        for (int j = 0; j < 4; ++j) {
          e2[1 + 2 * j] = __uint_as_float(w2[j] << 16); e2[2 + 2 * j] = __uint_as_float(w2[j] & 0xffff0000u);
          ev[1 + 2 * j] = __uint_as_float(wv[j] << 16); ev[2 + 2 * j] = __uint_as_float(wv[j] & 0xffff0000u);
        }
        unsigned o[4];
#pragma unroll
        for (int j = 0; j < 4; ++j) {
          const float xa = a0 * e2[2 * j] + a1 * e2[2 * j + 1] + a2 * e2[2 * j + 2] + ab;
          const float xb = a0 * e2[2 * j + 1] + a1 * e2[2 * j + 2] + a2 * e2[2 * j + 3] + ab;
          const float ya = v0 * ev[2 * j] + v1 * ev[2 * j + 1] + v2 * ev[2 * j + 2] + vb;
          const float yb = v0 * ev[2 * j + 1] + v1 * ev[2 * j + 2] + v2 * ev[2 * j + 3] + vb;
          o[j] = pack2(xa * ya, xb * yb);
        }
        uint4 ou; ou.x = o[0]; ou.y = o[1]; ou.z = o[2]; ou.w = o[3];
        *(uint4*)(Vl + (8 + m1 * 8 + b) * 80 + m2) = ou;
      }
    }
    if (tid < 144) {
      const int colp = tid / 9, part = tid - colp * 9;
      const int col = colp < 8 ? colp : 256 + colp;
      uint4 zz; zz.x = 0; zz.y = 0; zz.z = 0; zz.w = 0;
      *(uint4*)(Vl + col * 80 + part * 8) = zz;
    }
    __syncthreads();
#pragma unroll
    for (int s = 1; s < 4; ++s)
#pragma unroll
      for (int i = 0; i < 2; ++i) {
        const int ch = tid + 256 * i;
        unsigned e[8];
#pragma unroll
        for (int j = 0; j < 8; ++j) { const int idx = 8 * ch + s + j; e[j] = idx < 4096 ? (unsigned)cp[idx] : 0u; }
        uint4 u; u.x = e[0] | (e[1] << 16); u.y = e[2] | (e[3] << 16); u.z = e[4] | (e[5] << 16); u.w = e[6] | (e[7] << 16);
        *(uint4*)(cp + s * 4128 + 8 * ch) = u;
      }
    __syncthreads();
    const bf16_t* abase = cp + si * 4128 + (2048 - i16 - si + 8 * g4);
    f32x4 acc[4][4];
#pragma unroll
    for (int m = 0; m < 4; ++m)
#pragma unroll
      for (int n = 0; n < 4; ++n) acc[m][n] = (f32x4){0.f, 0.f, 0.f, 0.f};
    for (int dl = -31; dl <= 31; ++dl) {
      bf16x8 af[4][2];
#pragma unroll
      for (int mt = 0; mt < 4; ++mt)
#pragma unroll
        for (int kk = 0; kk < 2; ++kk) {
          const bf16_t* ap = abase - 64 * dl - 16 * mt + 32 * kk;
          const uint2 lo = *(const uint2*)ap, hi = *(const uint2*)(ap + 4);
          union { uint4 u; bf16x8 v; } cv; cv.u.x = lo.x; cv.u.y = lo.y; cv.u.z = hi.x; cv.u.w = hi.y;
          af[mt][kk] = cv.v;
        }
#pragma unroll
      for (int jt = 0; jt < 4; ++jt) {
        const int in0 = ocb + 16 * jt - 8 * dl;
        if (in0 >= -8 && in0 <= 248) {
          const bf16_t* bp = Vl + (in0 + 8 + i16) * 80 + 8 * g4;
          const bf16x8 b0 = *(const bf16x8*)bp, b1 = *(const bf16x8*)(bp + 32);
#pragma unroll
          for (int mt = 0; mt < 4; ++mt) {
            acc[mt][jt] = __builtin_amdgcn_mfma_f32_16x16x32_bf16(af[mt][0], b0, acc[mt][jt], 0, 0, 0);
            acc[mt][jt] = __builtin_amdgcn_mfma_f32_16x16x32_bf16(af[mt][1], b1, acc[mt][jt], 0, 0, 0);
          }
        }
      }
    }
    const float db = p.hy_d_bias[c];
#pragma unroll
    for (int mt = 0; mt < 4; ++mt)
#pragma unroll
      for (int jt = 0; jt < 4; ++jt) {
        const int col = ocb + 16 * jt + i16;
        const int n1 = col >> 3, b = col & 7;
        const int n2 = 16 * mt + 4 * g4;
        const uint2 vv = *(const uint2*)(Vl + (col + 8) * 80 + n2);
        const float y0 = acc[mt][jt][0] + bf2f((bf16_t)(vv.x & 0xffff)) * db;
        const float y1 = acc[mt][jt][1] + bf2f((bf16_t)(vv.x >> 16)) * db;
        const float y2 = acc[mt][jt][2] + bf2f((bf16_t)(vv.y & 0xffff)) * db;
        const float y3 = acc[mt][jt][3] + bf2f((bf16_t)(vv.y >> 16)) * db;
        uint2 u; u.x = pack2(y0, y1); u.y = pack2(y2, y3);
        *(uint2*)(p.Yp + (size_t)c * 16384 + b * 2048 + n1 * 64 + n2) = u;
      }
  }
}

__device__ __forceinline__ void phase_transmul(CP& p, char* smem) {
  bf16_t* tl = (bf16_t*)smem;
  const int tid = get_tid();
  for (int it = get_bid(); it < 4096; it += VGRID) {
    const int ct = it & 15, rt = it >> 4;
    const int c0 = ct * 64, r0 = rt * 64;
    __syncthreads();
#pragma unroll
    for (int i = 0; i < 2; ++i) {
      const int ci = tid + 256 * i; const int cc = ci >> 3, ch = ci & 7;
      const uint4 u = *(const uint4*)(p.Yp + (size_t)(c0 + cc) * 16384 + r0 + ch * 8);
      unsigned* d = (unsigned*)(tl + cc * 66 + ch * 8);
      d[0] = u.x; d[1] = u.y; d[2] = u.z; d[3] = u.w;
    }
    __syncthreads();
    const int row = tid >> 2, cq = tid & 3;
    const int grow = r0 + row, pos = grow & 2047;
    const int cbase = c0 + cq * 16;
    const bf16_t* xp = p.x1h + (size_t)grow * 1024 + cbase;
    uint4 zero4; zero4.x = 0; zero4.y = 0; zero4.z = 0; zero4.w = 0;
    const uint4 xa = *(const uint4*)xp, xb = *(const uint4*)(xp + 8);
    const bf16_t* xpp = pos > 0 ? xp - 1024 : xp;
    const bf16_t* xpn = pos < 2047 ? xp + 1024 : xp;
    const float pmk = pos > 0 ? 1.f : 0.f, nmk = pos < 2047 ? 1.f : 0.f;
    const uint4 pa = *(const uint4*)xpp, pb = *(const uint4*)(xpp + 8);
    const uint4 na = *(const uint4*)xpn, nb = *(const uint4*)(xpn + 8);
    (void)zero4;
    const unsigned xs[8] = {xa.x, xa.y, xa.z, xa.w, xb.x, xb.y, xb.z, xb.w};
    const unsigned ps[8] = {pa.x, pa.y, pa.z, pa.w, pb.x, pb.y, pb.z, pb.w};
    const unsigned ns[8] = {na.x, na.y, na.z, na.w, nb.x, nb.y, nb.z, nb.w};
    unsigned o[8];
#pragma unroll
    for (int j4 = 0; j4 < 4; ++j4) {
      const f32x4 w0 = *(const f32x4*)(p.hy_conv_w + cbase + 4 * j4) * pmk, w1 = *(const f32x4*)(p.hy_conv_w + 3072 + cbase + 4 * j4);
      const f32x4 w2 = *(const f32x4*)(p.hy_conv_w + 2 * 3072 + cbase + 4 * j4) * nmk, wb = *(const f32x4*)(p.hy_conv_b + cbase + 4 * j4);
#pragma unroll
      for (int jj = 0; jj < 2; ++jj) {
        const int j = 2 * j4 + jj;
        const float x0 = w0[2 * jj] * __uint_as_float(ps[j] << 16) + w1[2 * jj] * __uint_as_float(xs[j] << 16) + w2[2 * jj] * __uint_as_float(ns[j] << 16) + wb[2 * jj];
        const float x1 = w0[2 * jj + 1] * __uint_as_float(ps[j] & 0xffff0000u) + w1[2 * jj + 1] * __uint_as_float(xs[j] & 0xffff0000u) + w2[2 * jj + 1] * __uint_as_float(ns[j] & 0xffff0000u) + wb[2 * jj + 1];
        const float y0 = bf2f(tl[(cq * 16 + 2 * j) * 66 + row]) * x0;
        const float y1 = bf2f(tl[(cq * 16 + 2 * j + 1) * 66 + row]) * x1;
        o[j] = pack2(y0, y1);
      }
    }
    bf16_t* op = p.hxc + (size_t)(r0 + row) * 1024 + c0 + cq * 16;
    uint4 oa; oa.x = o[0]; oa.y = o[1]; oa.z = o[2]; oa.w = o[3];
    uint4 ob; ob.x = o[4]; ob.y = o[5]; ob.z = o[6]; ob.w = o[7];
    *(uint4*)op = oa; *(uint4*)(op + 8) = ob;
  }
}

__global__ void __launch_bounds__(512, 2) mega(P p_arg) {
  __shared__ __attribute__((aligned(16))) char smem[LDS_BYTES];
  cg::grid_group grid = cg::this_grid();
  const int G = gridDim.x;
  CP* pp = (CP*)__builtin_amdgcn_kernarg_segment_ptr();
  const int ph0 = pp->ph0, ph1 = pp->ph1;
  volatile LAS unsigned* xst = (volatile LAS unsigned*)(smem + LDS_BYTES - 16);
  if (threadIdx.x == 0) { xst[0] = 0u; xst[1] = 0u; }
  __syncthreads();
  const XcdBarrier xb = xcd_barrier_post(pp->bar, xst);
  if (ph0 <= 0 && 0 < ph1) {
    asm volatile("" : "+s"(pp));
    CP& p = *pp;
    const int bid = get_rbid();
    const int vid0 = (G & 7) ? bid : ((bid & 7) * (G >> 3) + (bid >> 3));
    const int hb = get_hb();
    char* smem_h = smem + hb * HALF_LDS; (void)smem_h;
    const float* mv0 = p.modv; const float* mv1 = p.modv + (size_t)9 * 6144;
    (void)mv0; (void)mv1; (void)vid0;
    phase_prep(p, smem_h);
    if (0 + 1 < ph1) { if (ph1 > 1000) grid.sync(); else xcd_barrier(xb); }
  }
  if (ph0 <= 1 && 1 < ph1) {
    asm volatile("" : "+s"(pp));
    CP& p = *pp;
    const int bid = get_rbid();
    const int vid0 = (G & 7) ? bid : ((bid & 7) * (G >> 3) + (bid >> 3));
    const int hb = get_hb();
    char* smem_h = smem + hb * HALF_LDS; (void)smem_h;
    const float* mv0 = p.modv; const float* mv1 = p.modv + (size_t)9 * 6144;
    (void)mv0; (void)mv1; (void)vid0;
    phase_normmod_kv(p);
    if (1 + 1 < ph1) { if (ph1 > 1000) grid.sync(); else xcd_barrier(xb); }
  }
  if (ph0 <= 2 && 2 < ph1) {
    asm volatile("" : "+s"(pp));
    CP& p = *pp;
    const int bid = get_rbid();
    const int vid0 = (G & 7) ? bid : ((bid & 7) * (G >> 3) + (bid >> 3));
    const int hb = get_hb();
    char* smem_h = smem + hb * HALF_LDS; (void)smem_h;
    const float* mv0 = p.modv; const float* mv1 = p.modv + (size_t)9 * 6144;
    (void)mv0; (void)mv1; (void)vid0;
    {
        EpiDown e1{p.cq, 512, 2048, p.rq, 4, nullptr, 1 << 30};
        gemm_job<true>(smem, p.hxc, 1024, p.wt_dq, 1024, 512, 16, 2304, 256, 128, 0, 2048, 128, 0, vid0, G, e1);
        EpiDown e2{p.kv, 288, 2304, p.rkv, 2, nullptr, 1 << 30};
        gemm_job<true>(smem, p.hxc, 1024, p.wt_dkv, 1024, 256, 18, 2304, 0, 128, 0, 2304, 144, 128, vid0, G, e2);
        EpiFilt e3{p.Rf, p.hy_decay};
        gemm_job<false>(smem, p.h2bf, 64, p.wt_f3, 64, 2048, 16, 0, 0, 128, 0, 2048, 16, 128 + 72, vid0, G, e3);
        EpiDown e4{p.kv, 288, 2304, p.rkv, 0, p.kpe, 0};
        gemm_job<true, EpiDown, true>(smem, p.hxc, 1024, p.wt_dkv + (size_t)256 * 1024, 1024, 32, 18, 2304, 0, 128, 0, 2304, 144, 128 + 72 + 64, vid0, G, e4);
      }
    if (2 + 1 < ph1) { if (ph1 > 1000) grid.sync(); else xcd_barrier(xb); }
  }
  if (ph0 <= 4 && 4 < ph1) {
    asm volatile("" : "+s"(pp));
    CP& p = *pp;
    const int bid = get_rbid();
    const int vid0 = (G & 7) ? bid : ((bid & 7) * (G >> 3) + (bid >> 3));
    const int hb = get_hb();
    char* smem_h = smem + hb * HALF_LDS; (void)smem_h;
    const float* mv0 = p.modv; const float* mv1 = p.modv + (size_t)9 * 6144;
    (void)mv0; (void)mv1; (void)vid0;
    {
        EpiStore<4> e1{p.Q, 1536, 2048, p.rq, 16384, 1.0f / 512.0f};
        gemm_job<true>(smem, p.cq, 512, p.wt_uq, 512, 1536, 16, 2048, 0, 128, 0, 2048, 128, 0, vid0, G, e1);
        EpiStore<2> e2{p.Kn, 1024, 2304, p.rkv, 18432, 1.0f / 256.0f};
        gemm_job<true>(smem, p.kv, 288, p.wt_uk, 256, 1024, 18, 2304, 0, 128, 0, 2304, 144, 64 * 6, vid0, G, e2);
        EpiVt e3{p.Vt, p.rkv};
        gemm_job<false>(smem, p.kv, 288, p.wt_uv, 256, 1024, 18, 2304, 0, 128, 0, 2304, 144, 64 * 6 + 72 * 4, vid0, G, e3);
      }
    if (4 + 1 < ph1) { if (ph1 > 1000) grid.sync(); else xcd_barrier(xb); }
  }
  if (ph0 <= 5 && 5 < ph1) {
    asm volatile("" : "+s"(pp));
    CP& p = *pp;
    const int bid = get_rbid();
    const int vid0 = (G & 7) ? bid : ((bid & 7) * (G >> 3) + (bid >> 3));
    const int hb = get_hb();
    char* smem_h = smem + hb * HALF_LDS; (void)smem_h;
    const float* mv0 = p.modv; const float* mv1 = p.modv + (size_t)9 * 6144;
    (void)mv0; (void)mv1; (void)vid0;
    phase_attn(p, smem, vid0, G);
    if (5 + 1 < ph1) { if (ph1 > 1000) grid.sync(); else xcd_barrier(xb); }
  }
  if (ph0 <= 6 && 6 < ph1) {
    asm volatile("" : "+s"(pp));
    CP& p = *pp;
    const int bid = get_rbid();
    const int vid0 = (G & 7) ? bid : ((bid & 7) * (G >> 3) + (bid >> 3));
    const int hb = get_hb();
    char* smem_h = smem + hb * HALF_LDS; (void)smem_h;
    const float* mv0 = p.modv; const float* mv1 = p.modv + (size_t)9 * 6144;
    (void)mv0; (void)mv1; (void)vid0;
    {
        EpiResid<true> e{p.X16, p.x, mv0 + 2 * 1024, nullptr};
        gemm_job<true>(smem, p.hxc, 1024, p.wt_o, 1024, 1024, 16, 2048, 0, 128, 0, 2048, 128, 0, vid0, G, e);
      }
    if (6 + 1 < ph1) { if (ph1 > 1000) grid.sync(); else xcd_barrier(xb); }
  }
  if (ph0 <= 7 && 7 < ph1) {
    asm volatile("" : "+s"(pp));
    CP& p = *pp;
    const int bid = get_rbid();
    const int vid0 = (G & 7) ? bid : ((bid & 7) * (G >> 3) + (bid >> 3));
    const int hb = get_hb();
    char* smem_h = smem + hb * HALF_LDS; (void)smem_h;
    const float* mv0 = p.modv; const float* mv1 = p.modv + (size_t)9 * 6144;
    (void)mv0; (void)mv1; (void)vid0;
    phase_normmod_x(p, p.norm_ffn_g, 0, 3);
    if (7 + 1 < ph1) { if (ph1 > 1000) grid.sync(); else xcd_barrier(xb); }
  }
  if (ph0 <= 8 && 8 < ph1) {
    asm volatile("" : "+s"(pp));
    CP& p = *pp;
    const int bid = get_rbid();
    const int vid0 = (G & 7) ? bid : ((bid & 7) * (G >> 3) + (bid >> 3));
    const int hb = get_hb();
    char* smem_h = smem + hb * HALF_LDS; (void)smem_h;
    const float* mv0 = p.modv; const float* mv1 = p.modv + (size_t)9 * 6144;
    (void)mv0; (void)mv1; (void)vid0;
    {
        EpiConv<0> e{p.ffn_conv_w, p.ffn_conv_b, 5632, nullptr, p.act, nullptr};
        gemm_job<true>(smem, p.hxc, 1024, p.wt_up0, 1024, 5632, 17, 2048, 0, 126, 1, 2048, 136, 0, vid0, G, e);
      }
    if (8 + 1 < ph1) { if (ph1 > 1000) grid.sync(); else xcd_barrier(xb); }
  }
  if (ph0 <= 9 && 9 < ph1) {
    asm volatile("" : "+s"(pp));
    CP& p = *pp;
    const int bid = get_rbid();
    const int vid0 = (G & 7) ? bid : ((bid & 7) * (G >> 3) + (bid >> 3));
    const int hb = get_hb();
    char* smem_h = smem + hb * HALF_LDS; (void)smem_h;
    const float* mv0 = p.modv; const float* mv1 = p.modv + (size_t)9 * 6144;
    (void)mv0; (void)mv1; (void)vid0;
    {
        EpiResid<false> e{p.X16, p.X16, mv0 + 5 * 1024, nullptr};
        gemm_job<true>(smem, p.act, 2816, p.wt_dn0, 2816, 1024, 16, 2048, 0, 128, 0, 2048, 128, 0, vid0, G, e);
      }
    if (9 + 1 < ph1) { if (ph1 > 1000) grid.sync(); else xcd_barrier(xb); }
  }
  if (ph0 <= 10 && 10 < ph1) {
    asm volatile("" : "+s"(pp));
    CP& p = *pp;
    const int bid = get_rbid();
    const int vid0 = (G & 7) ? bid : ((bid & 7) * (G >> 3) + (bid >> 3));
    const int hb = get_hb();
    char* smem_h = smem + hb * HALF_LDS; (void)smem_h;
    const float* mv0 = p.modv; const float* mv1 = p.modv + (size_t)9 * 6144;
    (void)mv0; (void)mv1; (void)vid0;
    phase_normmod_x(p, p.norm_mix_g + 1024, 1, 0);
    if (10 + 1 < ph1) { if (ph1 > 1000) grid.sync(); else xcd_barrier(xb); }
  }
  if (ph0 <= 11 && 11 < ph1) {
    asm volatile("" : "+s"(pp));
    CP& p = *pp;
    const int bid = get_rbid();
    const int vid0 = (G & 7) ? bid : ((bid & 7) * (G >> 3) + (bid >> 3));
    const int hb = get_hb();
    char* smem_h = smem + hb * HALF_LDS; (void)smem_h;
    const float* mv0 = p.modv; const float* mv1 = p.modv + (size_t)9 * 6144;
    (void)mv0; (void)mv1; (void)vid0;
    {
        EpiBiasStore e1{p.x1h, 1024, p.hy_b_in};
        gemm_job<true>(smem, p.hxc, 1024, p.wt_hin, 1024, 1024, 16, 2048, 0, 128, 0, 2048, 128, 0, vid0, G, e1);
        EpiBiasT e2{p.vvT, p.hy_b_in + 1024};
        gemm_job<false>(smem, p.hxc, 1024, p.wt_hin + (size_t)1024 * 1024, 1024, 2048, 16, 2048, 0, 128, 0, 2048, 128, 64 * 4, vid0, G, e2);
      }
    if (11 + 1 < ph1) { if (ph1 > 1000) grid.sync(); else xcd_barrier(xb); }
  }
  if (ph0 <= 12 && 12 < ph1) {
    asm volatile("" : "+s"(pp));
    CP& p = *pp;
    const int bid = get_rbid();
    const int vid0 = (G & 7) ? bid : ((bid & 7) * (G >> 3) + (bid >> 3));
    const int hb = get_hb();
    char* smem_h = smem + hb * HALF_LDS; (void)smem_h;
    const float* mv0 = p.modv; const float* mv1 = p.modv + (size_t)9 * 6144;
    (void)mv0; (void)mv1; (void)vid0;
    phase_hyconv(p, smem_h);
    if (12 + 1 < ph1) { if (ph1 > 1000) grid.sync(); else xcd_barrier(xb); }
  }
  if (ph0 <= 13 && 13 < ph1) {
    asm volatile("" : "+s"(pp));
    CP& p = *pp;
    const int bid = get_rbid();
    const int vid0 = (G & 7) ? bid : ((bid & 7) * (G >> 3) + (bid >> 3));
    const int hb = get_hb();
    char* smem_h = smem + hb * HALF_LDS; (void)smem_h;
    const float* mv0 = p.modv; const float* mv1 = p.modv + (size_t)9 * 6144;
    (void)mv0; (void)mv1; (void)vid0;
    phase_transmul(p, smem_h);
    if (13 + 1 < ph1) { if (ph1 > 1000) grid.sync(); else xcd_barrier(xb); }
  }
  if (ph0 <= 14 && 14 < ph1) {
    asm volatile("" : "+s"(pp));
    CP& p = *pp;
    const int bid = get_rbid();
    const int vid0 = (G & 7) ? bid : ((bid & 7) * (G >> 3) + (bid >> 3));
    const int hb = get_hb();
    char* smem_h = smem + hb * HALF_LDS; (void)smem_h;
    const float* mv0 = p.modv; const float* mv1 = p.modv + (size_t)9 * 6144;
    (void)mv0; (void)mv1; (void)vid0;
    {
        EpiResid<false> e{p.X16, p.X16, mv1 + 2 * 1024, p.hy_b_out};
        gemm_job<true>(smem, p.hxc, 1024, p.wt_hout, 1024, 1024, 16, 2048, 0, 128, 0, 2048, 128, 0, vid0, G, e);
      }
    if (14 + 1 < ph1) { if (ph1 > 1000) grid.sync(); else xcd_barrier(xb); }
  }
  if (ph0 <= 15 && 15 < ph1) {
    asm volatile("" : "+s"(pp));
    CP& p = *pp;
    const int bid = get_rbid();
    const int vid0 = (G & 7) ? bid : ((bid & 7) * (G >> 3) + (bid >> 3));
    const int hb = get_hb();
    char* smem_h = smem + hb * HALF_LDS; (void)smem_h;
    const float* mv0 = p.modv; const float* mv1 = p.modv + (size_t)9 * 6144;
    (void)mv0; (void)mv1; (void)vid0;
    phase_normmod_x(p, p.norm_ffn_g + 1024, 1, 3);
    if (15 + 1 < ph1) { if (ph1 > 1000) grid.sync(); else xcd_barrier(xb); }
  }
  if (ph0 <= 16 && 16 < ph1) {
    asm volatile("" : "+s"(pp));
    CP& p = *pp;
    const int bid = get_rbid();
    const int vid0 = (G & 7) ? bid : ((bid & 7) * (G >> 3) + (bid >> 3));
    const int hb = get_hb();
    char* smem_h = smem + hb * HALF_LDS; (void)smem_h;
    const float* mv0 = p.modv; const float* mv1 = p.modv + (size_t)9 * 6144;
    (void)mv0; (void)mv1; (void)vid0;
    {
        EpiConv<0> e{p.ffn_conv_w + (size_t)3 * 5632, p.ffn_conv_b + 5632, 5632, nullptr, p.act, nullptr};
        gemm_job<true>(smem, p.hxc, 1024, p.wt_up1, 1024, 5632, 17, 2048, 0, 126, 1, 2048, 136, 0, vid0, G, e);
      }
    if (16 + 1 < ph1) { if (ph1 > 1000) grid.sync(); else xcd_barrier(xb); }
  }
  if (ph0 <= 17 && 17 < ph1) {
    asm volatile("" : "+s"(pp));
    CP& p = *pp;
    const int bid = get_rbid();
    const int vid0 = (G & 7) ? bid : ((bid & 7) * (G >> 3) + (bid >> 3));
    const int hb = get_hb();
    char* smem_h = smem + hb * HALF_LDS; (void)smem_h;
    const float* mv0 = p.modv; const float* mv1 = p.modv + (size_t)9 * 6144;
    (void)mv0; (void)mv1; (void)vid0;
    {
        EpiResid<false> e{p.X16, p.X16, mv1 + 5 * 1024, nullptr};
        gemm_job<true>(smem, p.act, 2816, p.wt_dn1, 2816, 1024, 16, 2048, 0, 128, 0, 2048, 128, 0, vid0, G, e);
      }
    if (17 + 1 < ph1) { if (ph1 > 1000) grid.sync(); else xcd_barrier(xb); }
  }
  if (ph0 <= 18 && 18 < ph1) {
    asm volatile("" : "+s"(pp));
    CP& p = *pp;
    const int bid = get_rbid();
    const int vid0 = (G & 7) ? bid : ((bid & 7) * (G >> 3) + (bid >> 3));
    const int hb = get_hb();
    char* smem_h = smem + hb * HALF_LDS; (void)smem_h;
    const float* mv0 = p.modv; const float* mv1 = p.modv + (size_t)9 * 6144;
    (void)mv0; (void)mv1; (void)vid0;
    phase_final_norm(p);
    if (18 + 1 < ph1) { if (ph1 > 1000) grid.sync(); else xcd_barrier(xb); }
  }
}

extern "C" void kernel_launch(void* const* d_in, const int* in_sizes, int n_in, void* d_out, int out_size, void* d_ws, size_t ws_size, hipStream_t stream) {
  static int grid_blocks = 0;
  if (!grid_blocks) {
    int dev = 0, cus = 0, per_cu = 0;
    hipGetDevice(&dev);
    hipDeviceGetAttribute(&cus, hipDeviceAttributeMultiprocessorCount, dev);
    hipOccupancyMaxActiveBlocksPerMultiprocessor(&per_cu, (const void*)mega, 512, 0);
    per_cu = 1;
    grid_blocks = cus * per_cu;
  }
  P p{};
  const float** in = (const float**)&p;
  for (int i = 0; i < 36; ++i) in[i] = (const float*)d_in[i];
  p.X = (float*)d_out;
  char* ws = (char*)d_ws; size_t off = 0;
  auto take = [&](size_t bytes) { char* r = ws + off; off += (bytes + 255) & ~(size_t)255; return r; };
  p.wt_dq = (bf16_t*)take((size_t)512 * 1024 * 2);
  p.wt_dkv = (bf16_t*)take((size_t)288 * 1024 * 2);
  p.wt_uq = (bf16_t*)take((size_t)1536 * 512 * 2);
  p.wt_uk = (bf16_t*)take((size_t)1024 * 256 * 2);
  p.wt_uv = (bf16_t*)take((size_t)1024 * 256 * 2);
  p.wt_o = (bf16_t*)take((size_t)1024 * 1024 * 2);
  p.wt_hin = (bf16_t*)take((size_t)3072 * 1024 * 2);
  p.wt_hout = (bf16_t*)take((size_t)1024 * 1024 * 2);
  p.wt_up0 = (bf16_t*)take((size_t)5632 * 1024 * 2);
  p.wt_up1 = (bf16_t*)take((size_t)5632 * 1024 * 2);
  p.wt_dn0 = (bf16_t*)take((size_t)1024 * 2816 * 2);
  p.wt_dn1 = (bf16_t*)take((size_t)1024 * 2816 * 2);
  p.modv = (float*)take((size_t)2 * 9 * 6144 * 4);
  p.rq = (float*)take((size_t)4 * 16384 * 4);
  p.rkv = (float*)take((size_t)2 * 18432 * 4);
  p.modp = (float*)take((size_t)4 * 110592 * 4);
  p.bar = (unsigned*)take((size_t)XCD_BAR_WORDS * 4);
  p.wt_f3 = (bf16_t*)take((size_t)2048 * 64 * 2);
  p.h2bf = (bf16_t*)take((size_t)2048 * 64 * 2);
  p.Rf = (bf16_t*)take((size_t)1024 * 4096 * 2);
  p.kpe = (bf16_t*)take((size_t)18432 * 32 * 2);
  p.hxc = (bf16_t*)take((size_t)18432 * 1024 * 2);
  const size_t ubase = off;
  p.cq = (bf16_t*)take((size_t)16384 * 512 * 2);
  p.kv = (bf16_t*)take((size_t)18432 * 288 * 2);
  p.Q = (bf16_t*)take((size_t)16384 * 1536 * 2);
  p.Kn = (bf16_t*)take((size_t)18432 * 1024 * 2);
  p.Vt = (bf16_t*)take((size_t)18432 * 1024 * 2);
  const size_t uend1 = off;
  p.X16 = (bf16_t*)(ws + ubase + (size_t)104857600);
  off = ubase;
  p.act = (bf16_t*)take((size_t)16384 * 2816 * 2);
  off = ubase;
  p.x1h = (bf16_t*)take((size_t)16384 * 1024 * 2);
  p.vvT = (bf16_t*)take((size_t)2 * 16384 * 1024 * 2);
  p.Yp = p.vvT;
  if (uend1 > ws_size) { fprintf(stderr, "workspace too small: need %zu have %zu\n", uend1, ws_size); return; }
  p.ph0 = 0; p.ph1 = NPHASE;
  if (hipMemsetAsync(p.bar, 0, (size_t)XCD_BAR_WORDS * 4, stream) != hipSuccess) { fprintf(stderr, "memset failed\n"); return; }
  void* args[] = {&p};
  hipError_t e = hipLaunchCooperativeKernel((const void*)mega, dim3(grid_blocks), dim3(512), args, 0, stream);
  if (e != hipSuccess) fprintf(stderr, "cooperative launch failed: %s (grid %d)\n", hipGetErrorString(e), grid_blocks);
}
```

```cpp
#include <hip/hip_runtime.h>
#include <hip/hip_cooperative_groups.h>
#include <cstdio>
namespace cg = cooperative_groups;

typedef unsigned short bf16_t;
typedef short bf16x8 __attribute__((ext_vector_type(8)));
typedef float f32x4 __attribute__((ext_vector_type(4)));
typedef float f32x16 __attribute__((ext_vector_type(16)));

#define LDS_BYTES 163840
#define HALF_LDS 81920
#define NPHASE 19

struct P {
  const float *x, *c, *ctx, *c_ctx, *mod_w, *mod_b, *norm_mix_g, *norm_ffn_g;
  const float *w_dq, *g_q, *w_uq, *w_dkv, *g_kv, *w_uk, *w_uv, *w_o;
  const float *hy_w_in, *hy_b_in, *hy_conv_w, *hy_conv_b, *f_w1, *f_b1, *f_freq1, *f_w2, *f_b2, *f_freq2, *f_w3, *hy_decay, *hy_d_bias, *hy_w_out, *hy_b_out;
  const float *ffn_w_up, *ffn_conv_w, *ffn_conv_b, *ffn_w_down, *final_g;
  float* X;
  bf16_t *wt_dq, *wt_dkv, *wt_uq, *wt_uk, *wt_uv, *wt_o, *wt_hin, *wt_hout, *wt_up0, *wt_up1, *wt_dn0, *wt_dn1;
  float *modv, *rq, *rkv, *modp;
  unsigned* bar;
  bf16_t *wt_f3, *h2bf, *X16;
  bf16_t *Rf, *kpe, *hxc, *cq, *kv, *Q, *Kn, *Vt, *act, *x1h, *vvT, *Yp;
  int ph0, ph1;
};

typedef const __attribute__((address_space(4))) P CP;
__device__ __forceinline__ int get_tid512() { int t = threadIdx.x; asm volatile("" : "+v"(t)); return t; }
__device__ __forceinline__ int get_tid() { int t = threadIdx.x & 255; asm volatile("" : "+v"(t)); return t; }
__device__ __forceinline__ int get_hb() { int t = __builtin_amdgcn_readfirstlane((int)(threadIdx.x >> 8)); asm volatile("" : "+s"(t)); return t; }
__device__ __forceinline__ int get_rbid() { int t = blockIdx.x; asm volatile("" : "+s"(t)); return t; }
__device__ __forceinline__ int get_bid() { return 2 * get_rbid() + get_hb(); }
#define VGRID (2 * (int)gridDim.x)

__device__ __forceinline__ unsigned pack2(float a, float b) { unsigned r; asm("v_cvt_pk_bf16_f32 %0, %1, %2" : "=v"(r) : "v"(a), "v"(b)); return r; }
__device__ __forceinline__ bf16_t f2bf(float f) { return (bf16_t)(pack2(f, f) & 0xffffu); }
__device__ __forceinline__ float bf2f(bf16_t h) { return __uint_as_float(((unsigned)h) << 16); }
__device__ __forceinline__ float wave_sum(float v) {
#pragma unroll
  for (int o = 32; o; o >>= 1) v += __shfl_xor(v, o);
  return v;
}


#define XB_TMO      128
#define XB_XCNT(j)  (256  + 64 * (j))
#define XB_XSUB(j)  (1280 + 64 * (j))
#define XB_XGEN(j)  (2304 + 64 * (j))
#define XB_TOP      3328
#define XB_TOPGEN   3392
#define XCD_BAR_WORDS 3456
#define XB_SPIN_CAP (1u << 18)
#define LAS __attribute__((address_space(3)))
__device__ __forceinline__ unsigned xb_ld(unsigned* p)              { return __hip_atomic_load(p, __ATOMIC_RELAXED, __HIP_MEMORY_SCOPE_AGENT); }
__device__ __forceinline__ unsigned xb_add(unsigned* p, unsigned v) { return __hip_atomic_fetch_add(p, v, __ATOMIC_RELAXED, __HIP_MEMORY_SCOPE_AGENT); }
__device__ __forceinline__ unsigned xb_xcc_id() { return (unsigned)__builtin_amdgcn_s_getreg((3 << 11) | 20) & 0xFu; }
#define XB_SPIN(cond, bar) do { unsigned _sp = 0; while (cond) { __builtin_amdgcn_s_sleep(1); \
    if ((++_sp & 255u) == 0u) { if (xb_ld(&(bar)[XB_TMO])) break; if (_sp > XB_SPIN_CAP) { atomicAdd(&(bar)[XB_TMO], 1u); break; } } } } while (0)
struct XcdBarrier { unsigned* bar; unsigned x; volatile LAS unsigned* st; };
__device__ __forceinline__ XcdBarrier xcd_barrier_post(unsigned* bar, volatile LAS unsigned* st) {
    XcdBarrier b; b.bar = bar; b.x = xb_xcc_id(); b.st = st;
    if (threadIdx.x == 0) (void)xb_add(&bar[XB_XCNT(b.x)], 1u);
    return b;
}
__device__ __forceinline__ void xcd_barrier_complete(unsigned* bar, unsigned x, unsigned& nloc, unsigned& nx) {
    const unsigned G = gridDim.x * gridDim.y * gridDim.z;
    unsigned sum, cnt, mine, sp = 0u;
    for (;;) {
        sum = 0u; cnt = 0u; mine = 0u;
#pragma unroll
        for (unsigned j = 0; j < 16; ++j) { const unsigned c = xb_ld(&bar[XB_XCNT(j)]); sum += c; cnt += (c > 0u) ? 1u : 0u; mine = (j == x) ? c : mine; }
        if (sum == G) break;
        __builtin_amdgcn_s_sleep(1);
        if ((++sp & 255u) == 0u) { if (xb_ld(&bar[XB_TMO])) break; if (sp > XB_SPIN_CAP) { atomicAdd(&bar[XB_TMO], 1u); break; } }
    }
    nloc = mine > 0u ? mine : 1u; nx = cnt > 0u ? cnt : 1u;
}
__device__ __forceinline__ void xcd_barrier(const XcdBarrier& b) {
    asm volatile("s_waitcnt vmcnt(0)" ::: "memory");
    __syncthreads();
    if (threadIdx.x == 0) {
        unsigned* bar = b.bar;
        __builtin_amdgcn_s_waitcnt(0);
        unsigned nloc = b.st[0], nx = b.st[1];
        if (nloc == 0u) { xcd_barrier_complete(bar, b.x, nloc, nx); b.st[0] = nloc; b.st[1] = nx; }
        const unsigned old = xb_add(&bar[XB_XSUB(b.x)], 1u);
        const unsigned gen = old / nloc;
        if (old + 1u == (gen + 1u) * nloc) {
            __builtin_amdgcn_fence(__ATOMIC_RELEASE, "agent");
            asm volatile("s_waitcnt vmcnt(0)" ::: "memory");
            const unsigned og = xb_add(&bar[XB_TOP], 1u);
            const unsigned tg = og / nx;
            if (og + 1u == (tg + 1u) * nx) xb_add(&bar[XB_TOPGEN], 1u);
            else XB_SPIN(xb_ld(&bar[XB_TOPGEN]) == tg, bar);
            __builtin_amdgcn_fence(__ATOMIC_ACQUIRE, "agent");
            xb_add(&bar[XB_XGEN(b.x)], 1u);
            asm volatile("s_waitcnt vmcnt(0)" ::: "memory");
        } else {
            XB_SPIN(xb_ld(&bar[XB_XGEN(b.x)]) == gen, bar);
            __builtin_amdgcn_fence(__ATOMIC_ACQUIRE, "agent");
            asm volatile("s_waitcnt vmcnt(0)" ::: "memory");
        }
    }
    __syncthreads();
}

__device__ __forceinline__ void prep_weight_tile(CP& p, char* smem, int wt) {
  const int tid = get_tid();
  int id = 0;
  {
    const int cnt[13] = {64, 40, 96, 32, 32, 128, 384, 128, 704, 704, 352, 352, 32};
#pragma unroll
    for (int i = 0; i < 12; ++i) { if (id == i && wt >= cnt[i]) { wt -= cnt[i]; id = i + 1; } }
  }
  const float* src; int K, N; bf16_t* dst; const float* scale = nullptr; int perm = 0;
  switch (id) {
    case 0: src = p.w_dq; K = 1024; N = 512; dst = p.wt_dq; break;
    case 1: src = p.w_dkv; K = 1024; N = 288; dst = p.wt_dkv; break;
    case 2: src = p.w_uq; K = 512; N = 1536; dst = p.wt_uq; scale = p.g_q; break;
    case 3: src = p.w_uk; K = 256; N = 1024; dst = p.wt_uk; scale = p.g_kv; break;
    case 4: src = p.w_uv; K = 256; N = 1024; dst = p.wt_uv; scale = p.g_kv; break;
    case 5: src = p.w_o; K = 1024; N = 1024; dst = p.wt_o; break;
    case 6: src = p.hy_w_in; K = 1024; N = 3072; dst = p.wt_hin; break;
    case 7: src = p.hy_w_out; K = 1024; N = 1024; dst = p.wt_hout; break;
    case 8: src = p.ffn_w_up; K = 1024; N = 5632; dst = p.wt_up0; perm = 1; break;
    case 9: src = p.ffn_w_up + (size_t)1024 * 5632; K = 1024; N = 5632; dst = p.wt_up1; perm = 1; break;
    case 10: src = p.ffn_w_down; K = 2816; N = 1024; dst = p.wt_dn0; break;
    case 11: src = p.ffn_w_down + (size_t)2816 * 1024; K = 2816; N = 1024; dst = p.wt_dn1; break;
    default: src = p.f_w3; K = 64; N = 2048; dst = p.wt_f3; break;
  }
  const int ntn = (N + 63) >> 6;
  const int kt = wt / ntn, nt = wt - kt * ntn;
  const int k0 = kt * 128, n0 = nt * 64;
  int np0;
  if (perm == 1) { const int half = n0 / 2816, f = n0 - half * 2816; np0 = (f >> 6) * 128 + half * 64; }
  else if (perm == 2) { if (n0 < 1024) np0 = n0; else { const int m = n0 - 1024, half = m >> 10, f = m & 1023; np0 = 1024 + (f >> 6) * 128 + half * 64; } }
  else np0 = n0;
  bf16_t* t16 = (bf16_t*)smem;
  f32x4 v[8];
#pragma unroll
  for (int i = 0; i < 8; ++i) {
    const int idx = tid + 256 * i; const int kr = idx >> 4, c4 = idx & 15;
    v[i] = (f32x4){0.f, 0.f, 0.f, 0.f};
    if (n0 + 4 * c4 < N && k0 + kr < K) v[i] = *(const f32x4*)(src + (size_t)(k0 + kr) * N + n0 + 4 * c4);
  }
#pragma unroll
  for (int i = 0; i < 8; ++i) {
    const int idx = tid + 256 * i; const int kr = idx >> 4, c4 = idx & 15;
    const float sc = (scale && k0 + kr < K) ? scale[k0 + kr] : 1.f;
#pragma unroll
    for (int j = 0; j < 4; ++j) t16[(4 * c4 + j) * 136 + kr] = f2bf(v[i][j] * sc);
  }
  __syncthreads();
#pragma unroll
  for (int i = 0; i < 4; ++i) {
    const int idx = tid + 256 * i; const int n = idx >> 4, ch = idx & 15;
    if (n0 + n < N && k0 + ch * 8 < K) *(uint4*)(dst + (size_t)(np0 + n) * K + k0 + ch * 8) = *(const uint4*)(t16 + n * 136 + ch * 8);
  }
  __syncthreads();
}

__device__ __forceinline__ void prep_modvec(CP& p, char* smem, int it) {
  const int tid = get_tid();
  const int layer = it / 384, rem = it - layer * 384, cb = rem >> 2, ks = rem & 3;
  float* s_lds = (float*)smem;
  float* red = (float*)(smem + 12288);
  const int kbase = ks * 256;
  for (int idx = tid; idx < 9 * 256; idx += 256) {
    const int r = idx >> 8, k = idx & 255;
    const float v = r < 8 ? p.c[r * 1024 + kbase + k] : p.c_ctx[kbase + k];
    s_lds[k * 12 + r] = v / (1.f + __expf(-v));
  }
  __syncthreads();
  const int col = cb * 64 + (tid & 63), kg = tid >> 6;
  const float* W = p.mod_w + (size_t)layer * 1024 * 6144 + (size_t)kbase * 6144 + col;
  float acc[9];
#pragma unroll
  for (int r = 0; r < 9; ++r) acc[r] = 0.f;
#pragma unroll
  for (int kb = 0; kb < 4; ++kb) {
    float w[16];
#pragma unroll
    for (int u = 0; u < 16; ++u) w[u] = W[(size_t)(kg * 64 + kb * 16 + u) * 6144];
#pragma unroll
    for (int u = 0; u < 16; ++u) {
      const int k = kg * 64 + kb * 16 + u;
      const f32x4 s0 = *(const f32x4*)(s_lds + k * 12), s1 = *(const f32x4*)(s_lds + k * 12 + 4);
      const float s2 = s_lds[k * 12 + 8];
      acc[0] += s0[0] * w[u]; acc[1] += s0[1] * w[u]; acc[2] += s0[2] * w[u]; acc[3] += s0[3] * w[u];
      acc[4] += s1[0] * w[u]; acc[5] += s1[1] * w[u]; acc[6] += s1[2] * w[u]; acc[7] += s1[3] * w[u];
      acc[8] += s2 * w[u];
    }
  }
#pragma unroll
  for (int r = 0; r < 9; ++r) red[(kg * 9 + r) * 64 + (tid & 63)] = acc[r];
  __syncthreads();
  for (int o = tid; o < 9 * 64; o += 256) {
    const int r = o >> 6, cl = o & 63;
    const float sm = red[(0 * 9 + r) * 64 + cl] + red[(1 * 9 + r) * 64 + cl] + red[(2 * 9 + r) * 64 + cl] + red[(3 * 9 + r) * 64 + cl];
    p.modp[(size_t)ks * 110592 + (size_t)(layer * 9 + r) * 6144 + cb * 64 + cl] = sm;
  }
  __syncthreads();
}

__device__ __forceinline__ void prep_filter(CP& p, char* smem, int it) {
  const int tid = get_tid();
  float* z = (float*)smem;
  float* h1 = z + 8 * 33;
  float* h2 = h1 + 8 * 64;
  const int t0 = it * 8;
  for (int idx = tid; idx < 8 * 33; idx += 256) {
    const int pp = idx / 33, i = idx - pp * 33;
    const int t = t0 + pp;
    float v;
    if (i == 0) v = (float)t * (1.0f / 2047.0f);
    else {
      const int k = (i - 1) & 15;
      const float w = (6.283185307179586f * (float)t) / 2048.0f;
      const float f = 1e-4f + (float)k * ((15.0f - 1e-4f) / 15.0f);
      const float a = w * f;
      v = (i <= 16) ? __cosf(a) : -__sinf(a);
    }
    z[idx] = v;
  }
  __syncthreads();
  for (int idx = tid; idx < 8 * 64; idx += 256) {
    const int pp = idx >> 6, j = idx & 63;
    float s = p.f_b1[j];
#pragma unroll
    for (int i = 0; i < 33; ++i) s += z[pp * 33 + i] * p.f_w1[i * 64 + j];
    h1[idx] = __sinf(p.f_freq1[j] * s);
  }
  __syncthreads();
  for (int idx = tid; idx < 8 * 64; idx += 256) {
    const int pp = idx >> 6, j = idx & 63;
    float s = p.f_b2[j];
#pragma unroll 16
    for (int i = 0; i < 64; ++i) s += h1[pp * 64 + i] * p.f_w2[i * 64 + j];
    h2[idx] = __sinf(p.f_freq2[j] * s);
  }
  __syncthreads();
  for (int idx = tid; idx < 8 * 64; idx += 256) p.h2bf[(size_t)t0 * 64 + idx] = f2bf(h2[idx]);
  __syncthreads();
}

__device__ __forceinline__ void phase_prep(CP& p, char* smem) {
  const int total = 768 + 256 + 3048;
  for (int it = get_bid(); it < total; it += VGRID) {
    if (it < 768) prep_modvec(p, smem, it);
    else if (it < 1024) prep_filter(p, smem, it - 768);
    else prep_weight_tile(p, smem, it - 1024);
  }
}

__device__ __forceinline__ f32x4 ld4_bf16(const bf16_t* p) {
  const uint2 u = *(const uint2*)p;
  f32x4 r; r[0] = bf2f((bf16_t)(u.x & 0xffff)); r[1] = bf2f((bf16_t)(u.x >> 16)); r[2] = bf2f((bf16_t)(u.y & 0xffff)); r[3] = bf2f((bf16_t)(u.y >> 16));
  return r;
}
template <bool PART, bool SRC16 = false>
__device__ __forceinline__ void normmod_row2(const void* __restrict__ srcv, const float* __restrict__ g, const float* __restrict__ sh, const float* __restrict__ sc, bf16_t* __restrict__ dst, int lane, const float* __restrict__ bsh = nullptr) {
  f32x4 v[2][4]; float ss0 = 0.f, ss1 = 0.f;
#pragma unroll
  for (int i = 0; i < 4; ++i) {
    if (SRC16) { v[0][i] = ld4_bf16((const bf16_t*)srcv + lane * 4 + 256 * i); v[1][i] = ld4_bf16((const bf16_t*)srcv + 1024 + lane * 4 + 256 * i); }
    else { v[0][i] = *(const f32x4*)((const float*)srcv + lane * 4 + 256 * i); v[1][i] = *(const f32x4*)((const float*)srcv + 1024 + lane * 4 + 256 * i); }
  }
#pragma unroll
  for (int i = 0; i < 4; ++i) {
    ss0 += v[0][i][0] * v[0][i][0] + v[0][i][1] * v[0][i][1] + v[0][i][2] * v[0][i][2] + v[0][i][3] * v[0][i][3];
    ss1 += v[1][i][0] * v[1][i][0] + v[1][i][1] * v[1][i][1] + v[1][i][2] * v[1][i][2] + v[1][i][3] * v[1][i][3];
  }
  ss0 = wave_sum(ss0); ss1 = wave_sum(ss1);
  const float r0 = rsqrtf(ss0 * (1.0f / 1024.0f) + 1e-6f), r1 = rsqrtf(ss1 * (1.0f / 1024.0f) + 1e-6f);
#pragma unroll
  for (int i = 0; i < 4; ++i) {
    const int k = lane * 4 + 256 * i;
    const f32x4 g4 = *(const f32x4*)(g + k);
    f32x4 s4 = *(const f32x4*)(sh + k), c4 = *(const f32x4*)(sc + k);
    if (PART) {
#pragma unroll
      for (int q = 1; q < 4; ++q) { s4 += *(const f32x4*)(sh + (size_t)q * 110592 + k); c4 += *(const f32x4*)(sc + (size_t)q * 110592 + k); }
      s4 += *(const f32x4*)(bsh + k); c4 += *(const f32x4*)(bsh + 1024 + k);
    }
    float y[4], z[4];
#pragma unroll
    for (int j = 0; j < 4; ++j) { const float gm = g4[j] * (1.f + c4[j]); y[j] = (v[0][i][j] * r0) * gm + s4[j]; z[j] = (v[1][i][j] * r1) * gm + s4[j]; }
    uint2 u; u.x = pack2(y[0], y[1]); u.y = pack2(y[2], y[3]);
    *(uint2*)(dst + k) = u;
    u.x = pack2(z[0], z[1]); u.y = pack2(z[2], z[3]);
    *(uint2*)(dst + 1024 + k) = u;
  }
}

__device__ __forceinline__ void phase_normmod_kv(CP& p) {
  const int lane = get_tid() & 63, wv = get_tid() >> 6;
  const float* g = p.norm_mix_g;
  for (int idx = get_bid() * 256 + get_tid(); idx < 110592; idx += VGRID * 256) {
    const int lr = idx / 6144; const int n = idx - lr * 6144; const int layer = lr / 9;
    p.modv[idx] = p.modp[idx] + p.modp[110592 + idx] + p.modp[2 * 110592 + idx] + p.modp[3 * 110592 + idx] + p.mod_b[layer * 6144 + n];
  }
  for (int r = (get_bid() * 4 + wv) * 2; r < 18432; r += VGRID * 8) {
    const int b = r / 2304, pp = r - b * 2304;
    const float* src; const float* mv;
    if (pp < 256) { src = p.ctx + ((size_t)b * 256 + pp) * 1024; mv = p.modp + (size_t)8 * 6144; }
    else { src = p.x + ((size_t)b * 2048 + pp - 256) * 1024; mv = p.modp + (size_t)b * 6144; }
    normmod_row2<true>(src, g, mv, mv + 1024, p.hxc + (size_t)r * 1024, lane, p.mod_b);
  }
}
__device__ __forceinline__ void phase_normmod_x(CP& p, const float* g, int layer, int chunk) {
  const int lane = get_tid() & 63, wv = get_tid() >> 6;
  for (int r = (get_bid() * 4 + wv) * 2; r < 16384; r += VGRID * 8) {
    const int b = r >> 11;
    const float* mv = p.modv + (size_t)(layer * 9 + b) * 6144 + chunk * 1024;
    normmod_row2<false, true>(p.X16 + (size_t)r * 1024, g, mv, mv + 1024, p.hxc + (size_t)r * 1024, lane);
  }
}
__device__ __forceinline__ void phase_final_norm(CP& p) {
  const int lane = get_tid() & 63, wv = get_tid() >> 6;
  for (int r = get_bid() * 4 + wv; r < 16384; r += VGRID * 4) {
    const bf16_t* srow = p.X16 + (size_t)r * 1024;
    float* row = p.X + (size_t)r * 1024;
    f32x4 v[4]; float ss = 0.f;
#pragma unroll
    for (int i = 0; i < 4; ++i) { v[i] = ld4_bf16(srow + lane * 4 + 256 * i); ss += v[i][0] * v[i][0] + v[i][1] * v[i][1] + v[i][2] * v[i][2] + v[i][3] * v[i][3]; }
    ss = wave_sum(ss);
    const float rr = rsqrtf(ss * (1.0f / 1024.0f) + 1e-6f);
#pragma unroll
    for (int i = 0; i < 4; ++i) {
      const int k = lane * 4 + 256 * i;
      const f32x4 g4 = *(const f32x4*)(p.final_g + k);
      f32x4 o; o[0] = v[i][0] * rr * g4[0]; o[1] = v[i][1] * rr * g4[1]; o[2] = v[i][2] * rr * g4[2]; o[3] = v[i][3] * rr * g4[3];
      *(f32x4*)(row + k) = o;
    }
  }
}

__device__ __forceinline__ void phase_rowstat(CP& p) {
  const int lane = get_tid() & 63, wv = get_tid() >> 6;
  for (int r = get_bid() * 4 + wv; r < 18432; r += VGRID * 4) {
    const int b = r / 2304, pp = r - b * 2304;
    const bf16_t* kvr = p.kv + (size_t)r * 288;
    {
      const uint2 u = *(const uint2*)(kvr + lane * 4);
      const float a0 = bf2f((bf16_t)(u.x & 0xffff)), a1 = bf2f((bf16_t)(u.x >> 16)), a2 = bf2f((bf16_t)(u.y & 0xffff)), a3 = bf2f((bf16_t)(u.y >> 16));
      float ss = a0 * a0 + a1 * a1 + a2 * a2 + a3 * a3;
      ss = wave_sum(ss);
      if (lane == 0) p.rkv[r] = rsqrtf(ss * (1.0f / 256.0f) + 1e-6f);
    }
    {
      const int i = lane & 31;
      const float xv = bf2f(kvr[256 + i]);
      const float ov = __shfl_xor(xv, 8);
      float res = xv;
      if (pp >= 256) {
        const int t = pp - 256;
        const int quarter = i >> 3, idx = i & 7;
        const float pos = (quarter < 2) ? (float)(t >> 6) : (float)(t & 63);
        const float inv = exp2f(-(float)idx * (13.287712379549449f / 8.0f));
        const float ang = pos * inv;
        const float cs = __cosf(ang), sn = __sinf(ang);
        res = xv * cs + ((quarter & 1) ? ov : -ov) * sn;
      }
      if (lane < 32) p.kpe[(size_t)r * 32 + i] = f2bf(res);
    }
    if (pp >= 256) {
      const int xr = b * 2048 + pp - 256;
      const uint4 u = *(const uint4*)(p.cq + (size_t)xr * 512 + lane * 8);
      const unsigned uu[4] = {u.x, u.y, u.z, u.w};
      float ss = 0.f;
#pragma unroll
      for (int j = 0; j < 4; ++j) { const float a = bf2f((bf16_t)(uu[j] & 0xffff)), bb = bf2f((bf16_t)(uu[j] >> 16)); ss += a * a + bb * bb; }
      ss = wave_sum(ss);
      if (lane == 0) p.rq[xr] = rsqrtf(ss * (1.0f / 512.0f) + 1e-6f);
    }
  }
}

template <int NP>
struct EpiStore {
  static constexpr int KIND = 0; static constexpr bool ROWSUM = false;
  bf16_t* out; int ld; int ostride; const float* part; int pstride; float inv_n;
  __device__ __forceinline__ void c4(int g, int rig, int col, f32x4 v) const {
    const size_t row = (size_t)g * ostride + rig;
    float s = 1.f;
    if (NP > 0) {
      float t = 0.f;
#pragma unroll
      for (int q = 0; q < NP; ++q) t += part[(size_t)q * pstride + row];
      s = rsqrtf(t * inv_n + 1e-6f);
    }
    uint2 u; u.x = pack2(v[0] * s, v[1] * s); u.y = pack2(v[2] * s, v[3] * s);
    *(uint2*)(out + row * ld + col) = u;
  }
};
struct EpiDown {
  static constexpr int KIND = 0; static constexpr bool ROWSUM = true;
  bf16_t* out; int ld; int ostride; float* part; int nslots; bf16_t* kpe; int ropecol;
  __device__ __forceinline__ float c4(int g, int rig, int col, f32x4 v) const {
    const size_t row = (size_t)g * ostride + rig;
    if (kpe && col >= ropecol) {
      const int i0 = col - ropecol;
      f32x4 o = v;
      const float p0 = __shfl_xor(v[0], 32), p1 = __shfl_xor(v[1], 32), p2 = __shfl_xor(v[2], 32), p3 = __shfl_xor(v[3], 32);
      const float pv[4] = {p0, p1, p2, p3};
      if (rig >= 256) {
        const int t = rig - 256;
        const int quarter = i0 >> 3;
        const float pos = (quarter < 2) ? (float)(t >> 6) : (float)(t & 63);
#pragma unroll
        for (int j = 0; j < 4; ++j) {
          const int idx = (i0 & 7) + j;
          const float inv = exp2f(-(float)idx * (13.287712379549449f / 8.0f));
          const float ang = pos * inv;
          const float cs = __cosf(ang), sn = __sinf(ang);
          o[j] = v[j] * cs + ((quarter & 1) ? pv[j] : -pv[j]) * sn;
        }
      }
      uint2 u; u.x = pack2(o[0], o[1]); u.y = pack2(o[2], o[3]);
      *(uint2*)(kpe + row * 32 + i0) = u;
      return 0.f;
    }
    uint2 u; u.x = pack2(v[0], v[1]); u.y = pack2(v[2], v[3]);
    *(uint2*)(out + row * ld + col) = u;
    return v[0] * v[0] + v[1] * v[1] + v[2] * v[2] + v[3] * v[3];
  }
  __device__ __forceinline__ void rowsum(int g, int rig, int slot, float ss) const {
    if (slot < nslots) part[(size_t)slot * ((size_t)8 * ostride) + (size_t)g * ostride + rig] = ss;
  }
};
struct EpiVt {
  static constexpr int KIND = 1;
  bf16_t* out; const float* part;
  __device__ __forceinline__ void r4(int g, int rig, int col, f32x4 v) const {
    const size_t row = (size_t)g * 2304 + rig;
    const f32x4 t = *(const f32x4*)(part + row) + *(const f32x4*)(part + 18432 + row);
    f32x4 s;
#pragma unroll
    for (int j = 0; j < 4; ++j) s[j] = rsqrtf(t[j] * (1.0f / 256.0f) + 1e-6f);
    uint2 u; u.x = pack2(v[0] * s[0], v[1] * s[1]); u.y = pack2(v[2] * s[2], v[3] * s[3]);
    *(uint2*)(out + ((size_t)g * 1024 + col) * 2304 + rig) = u;
  }
};
struct EpiBiasStore {
  static constexpr int KIND = 0; static constexpr bool ROWSUM = false;
  bf16_t* out; int ld; const float* bias;
  __device__ __forceinline__ void c4(int g, int rig, int col, f32x4 v) const {
    const size_t row = (size_t)g * 2048 + rig;
    const f32x4 b4 = *(const f32x4*)(bias + col);
    uint2 u; u.x = pack2(v[0] + b4[0], v[1] + b4[1]); u.y = pack2(v[2] + b4[2], v[3] + b4[3]);
    *(uint2*)(out + row * ld + col) = u;
  }
};
struct EpiBiasT {
  static constexpr int KIND = 1;
  bf16_t* out; const float* bias;
  __device__ __forceinline__ void r4(int g, int rig, int col, f32x4 v) const {
    const float b = bias[col];
    uint2 u; u.x = pack2(v[0] + b, v[1] + b); u.y = pack2(v[2] + b, v[3] + b);
    *(uint2*)(out + (size_t)col * 16384 + (size_t)g * 2048 + rig) = u;
  }
};
struct EpiFilt {
  static constexpr int KIND = 1;
  bf16_t* Rf; const float* decay;
  __device__ __forceinline__ void r4(int g, int rig, int col, f32x4 v) const {
    const int c = col & 1023; const bool bwd = col >= 1024;
    const float dec = fabsf(decay[c]);
    bf16_t* rp = Rf + (size_t)c * 4096;
#pragma unroll
    for (int j = 0; j < 4; ++j) {
      const int t = rig + j;
      const float val = v[j] * __expf(-(float)t * (1.0f / 2047.0f) * dec);
      if (!bwd) rp[2048 - t] = f2bf(val);
      else if (t > 0) rp[2048 + t] = f2bf(val);
      else rp[0] = 0;
    }
  }
};
template <bool BASE_F32>
struct EpiResid {
  static constexpr int KIND = 0; static constexpr bool ROWSUM = false;
  bf16_t* X16; const void* base; const float* gate; const float* bias;
  __device__ __forceinline__ void c4(int g, int rig, int col, f32x4 v) const {
    const size_t o = ((size_t)g * 2048 + rig) * 1024 + col;
    f32x4 bs;
    if (BASE_F32) bs = *(const f32x4*)((const float*)base + o);
    else {
      const uint2 u = *(const uint2*)((const bf16_t*)base + o);
      bs[0] = bf2f((bf16_t)(u.x & 0xffff)); bs[1] = bf2f((bf16_t)(u.x >> 16)); bs[2] = bf2f((bf16_t)(u.y & 0xffff)); bs[3] = bf2f((bf16_t)(u.y >> 16));
    }
    const f32x4 gt = *(const f32x4*)(gate + (size_t)g * 6144 + col);
    f32x4 bi = {0.f, 0.f, 0.f, 0.f};
    if (bias) bi = *(const f32x4*)(bias + col);
    f32x4 r;
#pragma unroll
    for (int j = 0; j < 4; ++j) r[j] = bs[j] + gt[j] * (v[j] + bi[j]);
    uint2 w; w.x = pack2(r[0], r[1]); w.y = pack2(r[2], r[3]);
    *(uint2*)(X16 + o) = w;
  }
};
template <int MODE>
struct EpiConv {
  static constexpr int KIND = 2;
  const float* cw; const float* cb; int NC; const float* pre_bias;
  bf16_t* o0; bf16_t* o1;
  __device__ __forceinline__ int norig(int nt, int cl) const {
    if (MODE == 0) return (cl >> 6) * 2816 + nt * 64 + (cl & 63);
    if (nt < 8) return nt * 128 + cl;
    return 1024 + (cl >> 6) * 1024 + (nt - 8) * 64 + (cl & 63);
  }
  typedef float f32x2_t __attribute__((ext_vector_type(2)));
  static __device__ __forceinline__ f32x2_t ldz(const bf16_t* Z, int row, int col) {
    const unsigned u = *(const unsigned*)(Z + row * 132 + col);
    f32x2_t r; r[0] = __uint_as_float(u << 16); r[1] = __uint_as_float(u & 0xffff0000u); return r;
  }
  template <class F>
  __device__ __forceinline__ void finish(const bf16_t* Z, int g, int rig0, int nt, F&& pre) const {
    typedef f32x2_t f32x2;
    const int tid = get_tid();
    if (MODE == 0 || nt < 8) {
      if (MODE == 0) {
        const int f2 = (tid & 31) * 2, q8 = tid >> 5;
        const int q0 = 1 + 16 * q8, q1 = (q0 + 16 < 127) ? q0 + 16 : 127;
        const int na = norig(nt, f2), ng = norig(nt, 64 + f2);
        const f32x2 a0 = *(const f32x2*)(cw + na), a1 = *(const f32x2*)(cw + NC + na), a2 = *(const f32x2*)(cw + 2 * NC + na), ab = *(const f32x2*)(cb + na);
        const f32x2 g0 = *(const f32x2*)(cw + ng), g1 = *(const f32x2*)(cw + NC + ng), g2 = *(const f32x2*)(cw + 2 * NC + ng), gb = *(const f32x2*)(cb + ng);
        pre();
        f32x2 am = ldz(Z, q0 - 1, f2), ac = ldz(Z, q0, f2);
        f32x2 gm = ldz(Z, q0 - 1, 64 + f2), gc = ldz(Z, q0, 64 + f2);
#pragma unroll 2
        for (int pl = q0; pl < q1; ++pl) {
          const f32x2 an = ldz(Z, pl + 1, f2), gn = ldz(Z, pl + 1, 64 + f2);
          const int pos = rig0 + pl;
          if (pos < 2048) {
            const f32x2 av = a0 * am + a1 * ac + a2 * an + ab;
            const f32x2 gv = g0 * gm + g1 * gc + g2 * gn + gb;
            const float s0 = av[0] * gv[0] * __builtin_amdgcn_rcpf(1.f + __expf(-gv[0]));
            const float s1 = av[1] * gv[1] * __builtin_amdgcn_rcpf(1.f + __expf(-gv[1]));
            *(unsigned*)(o0 + ((size_t)g * 2048 + pos) * 2816 + nt * 64 + f2) = pack2(s0, s1);
          }
          am = ac; ac = an; gm = gc; gc = gn;
        }
      } else {
        const int cl = (tid & 63) * 2, q = tid >> 6;
        const int p0 = 1 + 32 * q, p1 = (p0 + 32 < 127) ? p0 + 32 : 127;
        const int na = norig(nt, cl);
        const f32x2 a0 = *(const f32x2*)(cw + na), a1 = *(const f32x2*)(cw + NC + na), a2 = *(const f32x2*)(cw + 2 * NC + na), ab = *(const f32x2*)(cb + na);
        pre();
        f32x2 am = ldz(Z, p0 - 1, cl), ac = ldz(Z, p0, cl);
#pragma unroll 2
        for (int pl = p0; pl < p1; ++pl) {
          const f32x2 an = ldz(Z, pl + 1, cl);
          const int pos = rig0 + pl;
          if (pos < 2048) {
            const f32x2 av = a0 * am + a1 * ac + a2 * an + ab;
            *(unsigned*)(o0 + ((size_t)g * 2048 + pos) * 1024 + nt * 128 + cl) = pack2(av[0], av[1]);
          }
          am = ac; ac = an;
        }
      }
    } else {
      pre();
      const int pl = tid & 127, fh = tid >> 7;
      const int pos = rig0 + pl;
      if (pl >= 1 && pl <= 126 && pos < 2048) {
        const int fb = nt - 8;
#pragma unroll 2
        for (int f = fh * 32; f < fh * 32 + 32; f += 2) {
          const int na = norig(nt, f), nb = norig(nt, 64 + f);
          const f32x2 va = *(const f32x2*)(cw + na) * ldz(Z, pl - 1, f) + *(const f32x2*)(cw + NC + na) * ldz(Z, pl, f)
                         + *(const f32x2*)(cw + 2 * NC + na) * ldz(Z, pl + 1, f) + *(const f32x2*)(cb + na);
          const f32x2 vb = *(const f32x2*)(cw + nb) * ldz(Z, pl - 1, 64 + f) + *(const f32x2*)(cw + NC + nb) * ldz(Z, pl, 64 + f)
                         + *(const f32x2*)(cw + 2 * NC + nb) * ldz(Z, pl + 1, 64 + f) + *(const f32x2*)(cb + nb);
          bf16_t* op = o1 + (size_t)(fb * 64 + f) * 16384 + g * 2048 + pos;
          op[0] = f2bf(va[0] * vb[0]);
          op[16384] = f2bf(va[1] * vb[1]);
        }
      }
    }
  }
};

#define GLDS16(gp, lp) __builtin_amdgcn_global_load_lds((const unsigned*)(gp), (__attribute__((address_space(3))) unsigned*)(lp), 16, 0, 0)

template <bool SWAP, class Epi, bool THIN = false>
__device__ __forceinline__ void gemm_job(char* smem, const bf16_t* __restrict__ A, int lda, const bf16_t* __restrict__ Bt, int K, int N,
                                         int tpg, int a_gstride, int a_goff, int step, int halo, int grows, int MTS, int voff, int vid0, int grid, const Epi& epi) {
  const int tid = get_tid512(), lane = tid & 63, wid = tid >> 6, wr = wid >> 1, wc = wid & 1, fr = lane & 15, fq = lane >> 4;
  const int NT = (N + 255) >> 8, MT = MTS >> 1, ntiles = MT * NT, ns = K >> 6;
  const int full = MT >> 3;
  int v = vid0;
  if (v < voff) v += ((voff - v + grid - 1) / grid) * grid;
  const int swz = (fr >> 1) & 7;
  bool pre_issued = false;
  for (; v < voff + ntiles; v += grid) {
    const int w = v - voff;
    int mt, nt;
    if (w < full * 8 * NT) { const int sr = w / (8 * NT), rem = w - sr * 8 * NT; nt = rem >> 3; mt = sr * 8 + (rem & 7); }
    else { const int w2 = w - full * 8 * NT, rl = MT - full * 8; nt = w2 / rl; mt = full * 8 + (w2 - nt * rl); }
    unsigned ap[4], bp[4];
#pragma unroll
    for (int i = 0; i < 4; ++i) {
      const int r = (tid >> 3) + 64 * i;
      const int cs = tid & 7;
      const int c = ((cs ^ ((r >> 1) & 7)) << 3);
      const int sub = 2 * mt + (r >> 7);
      const int g = sub / tpg, ti = sub - g * tpg;
      int rig = ti * step - halo + (r & 127); rig = rig < 0 ? 0 : (rig > grows - 1 ? grows - 1 : rig);
      ap[i] = (unsigned)((g * a_gstride + a_goff + rig) * lda + c);
      int br = nt * 256 + r; br = br > N - 1 ? N - 1 : br;
      bp[i] = (unsigned)(br * K + c);
    }
    const bool have_next = false;
    f32x4 acc[4][8];
#pragma unroll
    for (int m = 0; m < 4; ++m)
#pragma unroll
      for (int n = 0; n < 8; ++n) acc[m][n] = (f32x4){0.f, 0.f, 0.f, 0.f};
    if (!pre_issued) {
#pragma unroll
      for (int i = 0; i < 4; ++i) { GLDS16(A + (size_t)ap[i], smem + tid * 16 + i * 8192); GLDS16(Bt + (size_t)bp[i], smem + 32768 + tid * 16 + i * 8192); }
    }
    pre_issued = have_next;
    for (int st = 0; st < ns; ++st) {
      asm volatile("s_waitcnt vmcnt(0)" ::: "memory");
      __builtin_amdgcn_s_barrier();
      asm volatile("" ::: "memory");
      if (st + 1 < ns) {
        char* nb = smem + ((st + 1) & 1) * 65536;
        const int ko = (st + 1) * 64;
#pragma unroll
        for (int i = 0; i < 4; ++i) { GLDS16(A + (size_t)(ap[i] + ko), nb + tid * 16 + i * 8192); GLDS16(Bt + (size_t)(bp[i] + ko), nb + 32768 + tid * 16 + i * 8192); }
      }
      const char* sa = smem + (st & 1) * 65536 + (wr * 64 + fr) * 128;
      const char* sb = smem + (st & 1) * 65536 + 32768 + (wc * 128 + fr) * 128;
      if constexpr (THIN) {
        if (wc == 0) {
#pragma unroll
          for (int ks = 0; ks < 2; ++ks) {
            bf16x8 af[4], bf[2];
#pragma unroll
            for (int m = 0; m < 4; ++m) af[m] = *(const bf16x8*)(sa + m * 2048 + (((ks * 4 + fq) ^ swz) << 4));
#pragma unroll
            for (int n = 0; n < 2; ++n) bf[n] = *(const bf16x8*)(sb + n * 2048 + (((ks * 4 + fq) ^ swz) << 4));
#pragma unroll
            for (int m = 0; m < 4; ++m)
#pragma unroll
              for (int n = 0; n < 2; ++n)
                acc[m][n] = SWAP ? __builtin_amdgcn_mfma_f32_16x16x32_bf16(bf[n], af[m], acc[m][n], 0, 0, 0)
                                 : __builtin_amdgcn_mfma_f32_16x16x32_bf16(af[m], bf[n], acc[m][n], 0, 0, 0);
          }
        }
      } else {
      bf16x8 afA[4], afB[4], bfb[2][2];
#pragma unroll
      for (int m = 0; m < 4; ++m) afA[m] = *(const bf16x8*)(sa + m * 2048 + ((fq ^ swz) << 4));
#pragma unroll
      for (int n = 0; n < 2; ++n) bfb[0][n] = *(const bf16x8*)(sb + n * 2048 + ((fq ^ swz) << 4));
#pragma unroll
      for (int gq = 0; gq < 8; ++gq) {
        const int ks = gq >> 2, nh = gq & 3;
        if (gq < 7) {
          const int ks2 = (gq + 1) >> 2, nh2 = (gq + 1) & 3;
#pragma unroll
          for (int n = 0; n < 2; ++n) bfb[(gq + 1) & 1][n] = *(const bf16x8*)(sb + (nh2 * 2 + n) * 2048 + (((ks2 * 4 + fq) ^ swz) << 4));
        }
        if (gq == 3) {
#pragma unroll
          for (int m = 0; m < 4; ++m) afB[m] = *(const bf16x8*)(sa + m * 2048 + (((4 + fq) ^ swz) << 4));
        }
        __builtin_amdgcn_sched_barrier(0);
#pragma unroll
        for (int m = 0; m < 4; ++m)
#pragma unroll
          for (int n = 0; n < 2; ++n) {
            const bf16x8 av = ks ? afB[m] : afA[m];
            acc[m][nh * 2 + n] = SWAP ? __builtin_amdgcn_mfma_f32_16x16x32_bf16(bfb[gq & 1][n], av, acc[m][nh * 2 + n], 0, 0, 0)
                                      : __builtin_amdgcn_mfma_f32_16x16x32_bf16(av, bfb[gq & 1][n], acc[m][nh * 2 + n], 0, 0, 0);
          }
      }
      }
    }
    __syncthreads();
    const int te = get_tid512();
    const int fr_e = te & 15, fq_e = (te & 63) >> 4, wr_e = te >> 7, wc_e = (te >> 6) & 1;
    const int sub = 2 * mt + (wr_e >> 1);
    const int g = sub / tpg, ti = sub - g * tpg;
    const int rig0 = ti * step - halo;
    const int rw = (wr_e & 1) * 64;
    if constexpr (Epi::KIND == 0) {
#pragma unroll
      for (int m = 0; m < 4; ++m) {
        const int rig = rig0 + rw + m * 16 + fr_e;
        if constexpr (Epi::ROWSUM) {
          float ss = 0.f;
#pragma unroll
          for (int n = 0; n < 8; ++n) {
            const int col = nt * 256 + wc_e * 128 + n * 16 + fq_e * 4;
            if (col < N) ss += epi.c4(g, rig, col, acc[m][n]);
          }
          ss += __shfl_xor(ss, 16); ss += __shfl_xor(ss, 32);
          if (fq_e == 0) epi.rowsum(g, rig, nt * 2 + wc_e, ss);
        } else {
#pragma unroll
          for (int n = 0; n < 8; ++n) {
            const int col = nt * 256 + wc_e * 128 + n * 16 + fq_e * 4;
            if (col < N) epi.c4(g, rig, col, acc[m][n]);
          }
        }
      }
    } else if constexpr (Epi::KIND == 1) {
#pragma unroll
      for (int m = 0; m < 4; ++m) {
        const int rig = rig0 + rw + m * 16 + fq_e * 4;
#pragma unroll
        for (int n = 0; n < 8; ++n) {
          const int col = nt * 256 + wc_e * 128 + n * 16 + fr_e;
          if (col < N) epi.r4(g, rig, col, acc[m][n]);
        }
      }
    } else {
      bf16_t* Zw = (bf16_t*)smem + ((wr_e >> 1) * 2 + wc_e) * (128 * 132);
      const int nt2w = nt * 2 + wc_e;
#pragma unroll
      for (int n = 0; n < 8; ++n) {
        const int cl = n * 16 + fq_e * 4;
        f32x4 b4 = {0.f, 0.f, 0.f, 0.f};
        if (epi.pre_bias) b4 = *(const f32x4*)(epi.pre_bias + epi.norig(nt2w, cl));
#pragma unroll
        for (int m = 0; m < 4; ++m) {
          const int rl = rw + m * 16 + fr_e;
          const int pos = rig0 + rl;
          const bool ok = pos >= 0 && pos < grows;
          f32x4 vv = acc[m][n] + b4;
          if (!ok) vv = (f32x4){0.f, 0.f, 0.f, 0.f};
          uint2 u; u.x = pack2(vv[0], vv[1]); u.y = pack2(vv[2], vv[3]);
          *(uint2*)(Zw + rl * 132 + cl) = u;
        }
      }
      __syncthreads();
      {
        auto no_pre = []() {};
        const bf16_t* Zr = (const bf16_t*)smem + ((wr_e >> 1) * 2) * (128 * 132);
        epi.finish(Zr, g, rig0, nt * 2, no_pre);
        epi.finish(Zr + 128 * 132, g, rig0, nt * 2 + 1, no_pre);
      }
      __syncthreads();
    }
    asm volatile("s_waitcnt vmcnt(0)" ::: "memory");
    __syncthreads();
  }
}

__device__ __forceinline__ void phase_attn(CP& p, char* smem, int vid0, int grid) {
  bf16_t* Ks = (bf16_t*)smem;
  bf16_t* Vs = (bf16_t*)(smem + 64 * 104 * 2);
  const int tid = get_tid512(), lane = tid & 63, w = tid >> 6, r = lane & 31, hh = lane >> 5;
  const float cs = 1.4426950408889634f * 0.10206207261596577f;
  for (int it = vid0; it < 1024; it += grid) {
    const int qt = it & 7, h = (it >> 3) & 15, b = it >> 7;
    const int t = qt * 256 + w * 32 + r;
    const size_t xrow = (size_t)b * 2048 + t;
    const bf16_t* qp = p.Q + xrow * 1536 + h * 96;
    bf16x8 qf[6];
#pragma unroll
    for (int kk = 0; kk < 4; ++kk) qf[kk] = *(const bf16x8*)(qp + 16 * kk + 8 * hh);
#pragma unroll
    for (int part = 0; part < 2; ++part) {
      const bf16_t* pp = qp + 64 + 16 * part;
      const bf16x8 mine = *(const bf16x8*)(pp + 8 * hh), oth = *(const bf16x8*)(pp + 8 * (1 - hh));
      const float posf = part == 0 ? (float)(t >> 6) : (float)(t & 63);
      union { unsigned u[4]; bf16x8 v; } o;
      float res[8];
#pragma unroll
      for (int j = 0; j < 8; ++j) {
        const float inv = exp2f(-(float)j * (13.287712379549449f / 8.0f));
        const float ang = posf * inv;
        const float c = __cosf(ang), s = __sinf(ang);
        const float m = bf2f((bf16_t)mine[j]), ov = bf2f((bf16_t)oth[j]);
        res[j] = m * c + (hh ? ov : -ov) * s;
      }
#pragma unroll
      for (int j = 0; j < 4; ++j) o.u[j] = pack2(res[2 * j], res[2 * j + 1]);
      qf[4 + part] = o.v;
    }
    f32x16 oacc[2];
#pragma unroll
    for (int i = 0; i < 16; ++i) { oacc[0][i] = 0.f; oacc[1][i] = 0.f; }
    float mrun = -INFINITY, lrun = 0.f;
    const size_t kvrow0 = (size_t)b * 2304;
    const bf16_t* kn_base = p.Kn + kvrow0 * 1024 + h * 64;
    const bf16_t* kpe_base = p.kpe + kvrow0 * 32;
    const bf16_t* vt_base = p.Vt + ((size_t)(b * 16 + h) * 64) * 2304;
    uint4 rk0, rp, rv0;
    rp.x = 0; rp.y = 0; rp.z = 0; rp.w = 0;
    const int srow = tid >> 3, sch = tid & 7;
#define ATT_GLOAD(kt) do { \
      rk0 = *(const uint4*)(kn_base + (size_t)((kt) * 64 + srow) * 1024 + sch * 8); \
      rv0 = *(const uint4*)(vt_base + (size_t)srow * 2304 + (kt) * 64 + sch * 8); \
      if (tid < 256) rp = *(const uint4*)(kpe_base + (size_t)((kt) * 64 + (tid >> 2)) * 32 + (tid & 3) * 8); } while (0)
    ATT_GLOAD(0);
    for (int kt = 0; kt < 36; ++kt) {
      __syncthreads();
      {
        *(uint4*)(Ks + srow * 104 + sch * 8) = rk0;
        uint2 lo, hi;
        lo.x = rv0.x; lo.y = rv0.y; hi.x = rv0.z; hi.y = rv0.w;
        *(uint2*)(Vs + srow * 72 + (sch >> 1) * 16 + (sch & 1) * 4) = lo; *(uint2*)(Vs + srow * 72 + (sch >> 1) * 16 + 8 + (sch & 1) * 4) = hi;
      }
      if (tid < 256) *(uint4*)(Ks + (tid >> 2) * 104 + 64 + (tid & 3) * 8) = rp;
      __syncthreads();
      if (kt + 1 < 36) ATT_GLOAD(kt + 1);
      f32x16 s[2];
#pragma unroll
      for (int t2 = 0; t2 < 2; ++t2) {
#pragma unroll
        for (int i = 0; i < 16; ++i) s[t2][i] = 0.f;
#pragma unroll
        for (int kk = 0; kk < 6; ++kk) {
          const bf16x8 a = *(const bf16x8*)(Ks + (32 * t2 + r) * 104 + 16 * kk + 8 * hh);
          s[t2] = __builtin_amdgcn_mfma_f32_32x32x16_bf16(a, qf[kk], s[t2], 0, 0, 0);
        }
      }
      float mx = s[0][0];
#pragma unroll
      for (int i = 1; i < 16; ++i) mx = fmaxf(mx, s[0][i]);
#pragma unroll
      for (int i = 0; i < 16; ++i) mx = fmaxf(mx, s[1][i]);
      mx = fmaxf(mx, __shfl_xor(mx, 32));
      const float mcand = mx * cs;
      if (__builtin_amdgcn_ballot_w64(mcand > mrun + 6.0f) != 0ull) {
        const float mnew_ = fmaxf(mrun, mcand);
        const float alpha = __builtin_amdgcn_exp2f(mrun - mnew_);
        mrun = mnew_;
        lrun *= alpha;
#pragma unroll
        for (int i = 0; i < 16; ++i) { oacc[0][i] *= alpha; oacc[1][i] *= alpha; }
      }
      const float mnew = mrun;
      float psum = 0.f;
      bf16x8 pf[4];
#pragma unroll
      for (int t2 = 0; t2 < 2; ++t2)
#pragma unroll
        for (int hf = 0; hf < 2; ++hf) {
          union { unsigned u[4]; bf16x8 v; } cvp;
#pragma unroll
          for (int i = 0; i < 4; ++i) {
            const float p0 = __builtin_amdgcn_exp2f(s[t2][hf * 8 + 2 * i] * cs - mnew);
            const float p1 = __builtin_amdgcn_exp2f(s[t2][hf * 8 + 2 * i + 1] * cs - mnew);
            psum += p0 + p1;
            cvp.u[i] = pack2(p0, p1);
          }
          pf[t2 * 2 + hf] = cvp.v;
        }
      lrun += psum;
#pragma unroll
      for (int dt = 0; dt < 2; ++dt)
#pragma unroll
        for (int s4 = 0; s4 < 4; ++s4) {
          const bf16x8 vfr = *(const bf16x8*)(Vs + (32 * dt + r) * 72 + 16 * s4 + 8 * hh);
          oacc[dt] = __builtin_amdgcn_mfma_f32_32x32x16_bf16(vfr, pf[s4], oacc[dt], 0, 0, 0);
        }
    }
    const float ltot = lrun + __shfl_xor(lrun, 32);
    const float inv = 1.f / ltot;
    bf16_t* op = p.hxc + xrow * 1024 + h * 64;
#pragma unroll
    for (int dt = 0; dt < 2; ++dt)
#pragma unroll
      for (int i4 = 0; i4 < 4; ++i4) {
        const int d = 32 * dt + 8 * i4 + 4 * hh;
        uint2 u; u.x = pack2(oacc[dt][4 * i4] * inv, oacc[dt][4 * i4 + 1] * inv); u.y = pack2(oacc[dt][4 * i4 + 2] * inv, oacc[dt][4 * i4 + 3] * inv);
        *(uint2*)(op + d) = u;
      }
  }
}

__device__ __forceinline__ void phase_hyconv(CP& p, char* smem) {
  bf16_t* cp = (bf16_t*)smem;
  bf16_t* Vl = (bf16_t*)(smem + 4 * 8256);
  const int tid = get_tid(), lane = tid & 63, w = tid >> 6, i16 = lane & 15, g4 = lane >> 4;
  const int si = (-i16) & 3;
  const int ocb = 64 * w;
  for (int c = get_bid(); c < 1024; c += VGRID) {
    __syncthreads();
#pragma unroll
    for (int i = 0; i < 2; ++i) { const int ch = tid + 256 * i; *(uint4*)(cp + ch * 8) = *(const uint4*)(p.Rf + (size_t)c * 4096 + ch * 8); }
    {
      const float a0 = p.hy_conv_w[1024 + c], a1 = p.hy_conv_w[3072 + 1024 + c], a2 = p.hy_conv_w[2 * 3072 + 1024 + c], ab = p.hy_conv_b[1024 + c];
      const float v0 = p.hy_conv_w[2048 + c], v1 = p.hy_conv_w[3072 + 2048 + c], v2 = p.hy_conv_w[2 * 3072 + 2048 + c], vb = p.hy_conv_b[2048 + c];
#pragma unroll 2
      for (int i = 0; i < 8; ++i) {
        const int q = tid + 256 * i; const int b = q >> 8, l8 = q & 255; const int m1 = l8 >> 3, m2 = (l8 & 7) * 8;
        const int l0 = l8 * 8;
        const bf16_t* z2 = p.vvT + (size_t)c * 16384 + b * 2048;
        const bf16_t* zv = p.vvT + (size_t)(1024 + c) * 16384 + b * 2048;
        const uint4 u2 = *(const uint4*)(z2 + l0), uv = *(const uint4*)(zv + l0);
        float e2[10], ev[10];
        const int lp = l0 > 0 ? l0 - 1 : 0, ln = l0 + 8 < 2048 ? l0 + 8 : 2047;
        const float pm = l0 > 0 ? 1.f : 0.f, nm = l0 + 8 < 2048 ? 1.f : 0.f;
        const bf16_t q2p = z2[lp], qvp = zv[lp], q2n = z2[ln], qvn = zv[ln];
        e2[0] = bf2f(q2p) * pm; ev[0] = bf2f(qvp) * pm;
        e2[9] = bf2f(q2n) * nm; ev[9] = bf2f(qvn) * nm;
        const unsigned w2[4] = {u2.x, u2.y, u2.z, u2.w}, wv[4] = {uv.x, uv.y, uv.z, uv.w};
#pragma unroll
        for (int j = 0; j < 4; ++j) {
          e2[1 + 2 * j] = __uint_as_float(w2[j] << 16); e2[2 + 2 * j] = __uint_as_float(w2[j] & 0xffff0000u);
          ev[1 + 2 * j] = __uint_as_float(wv[j] << 16); ev[2 + 2 * j] = __uint_as_float(wv[j] & 0xffff0000u);
        }
        unsigned o[4];
#pragma unroll
        for (int j = 0; j < 4; ++j) {
          const float xa = a0 * e2[2 * j] + a1 * e2[2 * j + 1] + a2 * e2[2 * j + 2] + ab;
          const float xb = a0 * e2[2 * j + 1] + a1 * e2[2 * j + 2] + a2 * e2[2 * j + 3] + ab;
          const float ya = v0 * ev[2 * j] + v1 * ev[2 * j + 1] + v2 * ev[2 * j + 2] + vb;
          const float yb = v0 * ev[2 * j + 1] + v1 * ev[2 * j + 2] + v2 * ev[2 * j + 3] + vb;
          o[j] = pack2(xa * ya, xb * yb);
        }
        uint4 ou; ou.x = o[0]; ou.y = o[1]; ou.z = o[2]; ou.w = o[3];
        *(uint4*)(Vl + (8 + m1 * 8 + b) * 80 + m2) = ou;
      }
    }
    if (tid < 144) {
      const int colp = tid / 9, part = tid - colp * 9;
      const int col = colp < 8 ? colp : 256 + colp;
      uint4 zz; zz.x = 0; zz.y = 0; zz.z = 0; zz.w = 0;
      *(uint4*)(Vl + col * 80 + part * 8) = zz;
    }
    __syncthreads();
#pragma unroll
    for (int s = 1; s < 4; ++s)
#pragma unroll
      for (int i = 0; i < 2; ++i) {
        const int ch = tid + 256 * i;
        unsigned e[8];
#pragma unroll
        for (int j = 0; j < 8; ++j) { const int idx = 8 * ch + s + j; e[j] = idx < 4096 ? (unsigned)cp[idx] : 0u; }
        uint4 u; u.x = e[0] | (e[1] << 16); u.y = e[2] | (e[3] << 16); u.z = e[4] | (e[5] << 16); u.w = e[6] | (e[7] << 16);
        *(uint4*)(cp + s * 4128 + 8 * ch) = u;
      }
    __syncthreads();
    const bf16_t* abase = cp + si * 4128 + (2048 - i16 - si + 8 * g4);
    f32x4 acc[4][4];
#pragma unroll
    for (int m = 0; m < 4; ++m)
#pragma unroll
      for (int n = 0; n < 4; ++n) acc[m][n] = (f32x4){0.f, 0.f, 0.f, 0.f};
    for (int dl = -31; dl <= 31; ++dl) {
      bf16x8 af[4][2];
#pragma unroll
      for (int mt = 0; mt < 4; ++mt)
#pragma unroll
        for (int kk = 0; kk < 2; ++kk) {
          const bf16_t* ap = abase - 64 * dl - 16 * mt + 32 * kk;
          const uint2 lo = *(const uint2*)ap, hi = *(const uint2*)(ap + 4);
          union { uint4 u; bf16x8 v; } cv; cv.u.x = lo.x; cv.u.y = lo.y; cv.u.z = hi.x; cv.u.w = hi.y;
          af[mt][kk] = cv.v;
        }
#pragma unroll
      for (int jt = 0; jt < 4; ++jt) {
        const int in0 = ocb + 16 * jt - 8 * dl;
        if (in0 >= -8 && in0 <= 248) {
          const bf16_t* bp = Vl + (in0 + 8 + i16) * 80 + 8 * g4;
          const bf16x8 b0 = *(const bf16x8*)bp, b1 = *(const bf16x8*)(bp + 32);
#pragma unroll
          for (int mt = 0; mt < 4; ++mt) {
            acc[mt][jt] = __builtin_amdgcn_mfma_f32_16x16x32_bf16(af[mt][0], b0, acc[mt][jt], 0, 0, 0);
            acc[mt][jt] = __builtin_amdgcn_mfma_f32_16x16x32_bf16(af[mt][1], b1, acc[mt][jt], 0, 0, 0);
          }
        }
      }
    }
    const float db = p.hy_d_bias[c];
#pragma unroll
    for (int mt = 0; mt < 4; ++mt)
#pragma unroll
      for (int jt = 0; jt < 4; ++jt) {
        const int col = ocb + 16 * jt + i16;
        const int n1 = col >> 3, b = col & 7;
        const int n2 = 16 * mt + 4 * g4;
        const uint2 vv = *(const uint2*)(Vl + (col + 8) * 80 + n2);
        const float y0 = acc[mt][jt][0] + bf2f((bf16_t)(vv.x & 0xffff)) * db;
        const float y1 = acc[mt][jt][1] + bf2f((bf16_t)(vv.x >> 16)) * db;
        const float y2 = acc[mt][jt][2] + bf2f((bf16_t)(vv.y & 0xffff)) * db;
        const float y3 = acc[mt][jt][3] + bf2f((bf16_t)(vv.y >> 16)) * db;
        uint2 u; u.x = pack2(y0, y1); u.y = pack2(y2, y3);
        *(uint2*)(p.Yp + (size_t)c * 16384 + b * 2048 + n1 * 64 + n2) = u;
      }
  }
}

__device__ __forceinline__ void phase_transmul(CP& p, char* smem) {
  bf16_t* tl = (bf16_t*)smem;
  const int tid = get_tid();
  for (int it = get_bid(); it < 4096; it += VGRID) {
    const int ct = it & 15, rt = it >> 4;
    const int c0 = ct * 64, r0 = rt * 64;
    __syncthreads();
#pragma unroll
    for (int i = 0; i < 2; ++i) {
      const int ci = tid + 256 * i; const int cc = ci >> 3, ch = ci & 7;
      const uint4 u = *(const uint4*)(p.Yp + (size_t)(c0 + cc) * 16384 + r0 + ch * 8);
      unsigned* d = (unsigned*)(tl + cc * 66 + ch * 8);
      d[0] = u.x; d[1] = u.y; d[2] = u.z; d[3] = u.w;
    }
    __syncthreads();
    const int row = tid >> 2, cq = tid & 3;
    const int grow = r0 + row, pos = grow & 2047;
    const int cbase = c0 + cq * 16;
    const bf16_t* xp = p.x1h + (size_t)grow * 1024 + cbase;
    uint4 zero4; zero4.x = 0; zero4.y = 0; zero4.z = 0; zero4.w = 0;
    const uint4 xa = *(const uint4*)xp, xb = *(const uint4*)(xp + 8);
    const bf16_t* xpp = pos > 0 ? xp - 1024 : xp;
    const bf16_t* xpn = pos < 2047 ? xp + 1024 : xp;
    const float pmk = pos > 0 ? 1.f : 0.f, nmk = pos < 2047 ? 1.f : 0.f;
    const uint4 pa = *(const uint4*)xpp, pb = *(const uint4*)(xpp + 8);
    const uint4 na = *(const uint4*)xpn, nb = *(const uint4*)(xpn + 8);
    (void)zero4;
    const unsigned xs[8] = {xa.x, xa.y, xa.z, xa.w, xb.x, xb.y, xb.z, xb.w};
    const unsigned ps[8] = {pa.x, pa.y, pa.z, pa.w, pb.x, pb.y, pb.z, pb.w};
    const unsigned ns[8] = {na.x, na.y, na.z, na.w, nb.x, nb.y, nb.z, nb.w};
    unsigned o[8];
#pragma unroll
    for (int j4 = 0; j4 < 4; ++j4) {
      const f32x4 w0 = *(const f32x4*)(p.hy_conv_w + cbase + 4 * j4) * pmk, w1 = *(const f32x4*)(p.hy_conv_w + 3072 + cbase + 4 * j4);
      const f32x4 w2 = *(const f32x4*)(p.hy_conv_w + 2 * 3072 + cbase + 4 * j4) * nmk, wb = *(const f32x4*)(p.hy_conv_b + cbase + 4 * j4);
#pragma unroll
      for (int jj = 0; jj < 2; ++jj) {
        const int j = 2 * j4 + jj;
        const float x0 = w0[2 * jj] * __uint_as_float(ps[j] << 16) + w1[2 * jj] * __uint_as_float(xs[j] << 16) + w2[2 * jj] * __uint_as_float(ns[j] << 16) + wb[2 * jj];
        const float x1 = w0[2 * jj + 1] * __uint_as_float(ps[j] & 0xffff0000u) + w1[2 * jj + 1] * __uint_as_float(xs[j] & 0xffff0000u) + w2[2 * jj + 1] * __uint_as_float(ns[j] & 0xffff0000u) + wb[2 * jj + 1];
        const float y0 = bf2f(tl[(cq * 16 + 2 * j) * 66 + row]) * x0;
        const float y1 = bf2f(tl[(cq * 16 + 2 * j + 1) * 66 + row]) * x1;
        o[j] = pack2(y0, y1);
      }
    }
    bf16_t* op = p.hxc + (size_t)(r0 + row) * 1024 + c0 + cq * 16;
    uint4 oa; oa.x = o[0]; oa.y = o[1]; oa.z = o[2]; oa.w = o[3];
    uint4 ob; ob.x = o[4]; ob.y = o[5]; ob.z = o[6]; ob.w = o[7];
    *(uint4*)op = oa; *(uint4*)(op + 8) = ob;
  }
}

__global__ void __launch_bounds__(512, 2) mega(P p_arg) {
  __shared__ __attribute__((aligned(16))) char smem[LDS_BYTES];
  cg::grid_group grid = cg::this_grid();
  const int G = gridDim.x;
  CP* pp = (CP*)__builtin_amdgcn_kernarg_segment_ptr();
  const int ph0 = pp->ph0, ph1 = pp->ph1;
  volatile LAS unsigned* xst = (volatile LAS unsigned*)(smem + LDS_BYTES - 16);
  if (threadIdx.x == 0) { xst[0] = 0u; xst[1] = 0u; }
  __syncthreads();
  const XcdBarrier xb = xcd_barrier_post(pp->bar, xst);
  if (ph0 <= 0 && 0 < ph1) {
    asm volatile("" : "+s"(pp));
    CP& p = *pp;
    const int bid = get_rbid();
    const int vid0 = (G & 7) ? bid : ((bid & 7) * (G >> 3) + (bid >> 3));
    const int hb = get_hb();
    char* smem_h = smem + hb * HALF_LDS; (void)smem_h;
    const float* mv0 = p.modv; const float* mv1 = p.modv + (size_t)9 * 6144;
    (void)mv0; (void)mv1; (void)vid0;
    phase_prep(p, smem_h);
    if (0 + 1 < ph1) { if (ph1 > 1000) grid.sync(); else xcd_barrier(xb); }
  }
  if (ph0 <= 1 && 1 < ph1) {
    asm volatile("" : "+s"(pp));
    CP& p = *pp;
    const int bid = get_rbid();
    const int vid0 = (G & 7) ? bid : ((bid & 7) * (G >> 3) + (bid >> 3));
    const int hb = get_hb();
    char* smem_h = smem + hb * HALF_LDS; (void)smem_h;
    const float* mv0 = p.modv; const float* mv1 = p.modv + (size_t)9 * 6144;
    (void)mv0; (void)mv1; (void)vid0;
    phase_normmod_kv(p);
    if (1 + 1 < ph1) { if (ph1 > 1000) grid.sync(); else xcd_barrier(xb); }
  }
  if (ph0 <= 2 && 2 < ph1) {
    asm volatile("" : "+s"(pp));
    CP& p = *pp;
    const int bid = get_rbid();
    const int vid0 = (G & 7) ? bid : ((bid & 7) * (G >> 3) + (bid >> 3));
    const int hb = get_hb();
    char* smem_h = smem + hb * HALF_LDS; (void)smem_h;
    const float* mv0 = p.modv; const float* mv1 = p.modv + (size_t)9 * 6144;
    (void)mv0; (void)mv1; (void)vid0;
    {
        EpiDown e1{p.cq, 512, 2048, p.rq, 4, nullptr, 1 << 30};
        gemm_job<true>(smem, p.hxc, 1024, p.wt_dq, 1024, 512, 16, 2304, 256, 128, 0, 2048, 128, 0, vid0, G, e1);
        EpiDown e2{p.kv, 288, 2304, p.rkv, 2, nullptr, 1 << 30};
        gemm_job<true>(smem, p.hxc, 1024, p.wt_dkv, 1024, 256, 18, 2304, 0, 128, 0, 2304, 144, 128, vid0, G, e2);
        EpiFilt e3{p.Rf, p.hy_decay};
        gemm_job<false>(smem, p.h2bf, 64, p.wt_f3, 64, 2048, 16, 0, 0, 128, 0, 2048, 16, 128 + 72, vid0, G, e3);
        EpiDown e4{p.kv, 288, 2304, p.rkv, 0, p.kpe, 0};
        gemm_job<true, EpiDown, true>(smem, p.hxc, 1024, p.wt_dkv + (size_t)256 * 1024, 1024, 32, 18, 2304, 0, 128, 0, 2304, 144, 128 + 72 + 64, vid0, G, e4);
      }
    if (2 + 1 < ph1) { if (ph1 > 1000) grid.sync(); else xcd_barrier(xb); }
  }
  if (ph0 <= 4 && 4 < ph1) {
    asm volatile("" : "+s"(pp));
    CP& p = *pp;
    const int bid = get_rbid();
    const int vid0 = (G & 7) ? bid : ((bid & 7) * (G >> 3) + (bid >> 3));
    const int hb = get_hb();
    char* smem_h = smem + hb * HALF_LDS; (void)smem_h;
    const float* mv0 = p.modv; const float* mv1 = p.modv + (size_t)9 * 6144;
    (void)mv0; (void)mv1; (void)vid0;
    {
        EpiStore<4> e1{p.Q, 1536, 2048, p.rq, 16384, 1.0f / 512.0f};
        gemm_job<true>(smem, p.cq, 512, p.wt_uq, 512, 1536, 16, 2048, 0, 128, 0, 2048, 128, 0, vid0, G, e1);
        EpiStore<2> e2{p.Kn, 1024, 2304, p.rkv, 18432, 1.0f / 256.0f};
        gemm_job<true>(smem, p.kv, 288, p.wt_uk, 256, 1024, 18, 2304, 0, 128, 0, 2304, 144, 64 * 6, vid0, G, e2);
        EpiVt e3{p.Vt, p.rkv};
        gemm_job<false>(smem, p.kv, 288, p.wt_uv, 256, 1024, 18, 2304, 0, 128, 0, 2304, 144, 64 * 6 + 72 * 4, vid0, G, e3);
      }
    if (4 + 1 < ph1) { if (ph1 > 1000) grid.sync(); else xcd_barrier(xb); }
  }
  if (ph0 <= 5 && 5 < ph1) {
    asm volatile("" : "+s"(pp));
    CP& p = *pp;
    const int bid = get_rbid();
    const int vid0 = (G & 7) ? bid : ((bid & 7) * (G >> 3) + (bid >> 3));
    const int hb = get_hb();
    char* smem_h = smem + hb * HALF_LDS; (void)smem_h;
    const float* mv0 = p.modv; const float* mv1 = p.modv + (size_t)9 * 6144;
    (void)mv0; (void)mv1; (void)vid0;
    phase_attn(p, smem, vid0, G);
    if (5 + 1 < ph1) { if (ph1 > 1000) grid.sync(); else xcd_barrier(xb); }
  }
  if (ph0 <= 6 && 6 < ph1) {
    asm volatile("" : "+s"(pp));
    CP& p = *pp;
    const int bid = get_rbid();
    const int vid0 = (G & 7) ? bid : ((bid & 7) * (G >> 3) + (bid >> 3));
    const int hb = get_hb();
    char* smem_h = smem + hb * HALF_LDS; (void)smem_h;
    const float* mv0 = p.modv; const float* mv1 = p.modv + (size_t)9 * 6144;
    (void)mv0; (void)mv1; (void)vid0;
    {
        EpiResid<true> e{p.X16, p.x, mv0 + 2 * 1024, nullptr};
        gemm_job<true>(smem, p.hxc, 1024, p.wt_o, 1024, 1024, 16, 2048, 0, 128, 0, 2048, 128, 0, vid0, G, e);
      }
    if (6 + 1 < ph1) { if (ph1 > 1000) grid.sync(); else xcd_barrier(xb); }
  }
  if (ph0 <= 7 && 7 < ph1) {
    asm volatile("" : "+s"(pp));
    CP& p = *pp;
    const int bid = get_rbid();
    const int vid0 = (G & 7) ? bid : ((bid & 7) * (G >> 3) + (bid >> 3));
    const int hb = get_hb();
    char* smem_h = smem + hb * HALF_LDS; (void)smem_h;
    const float* mv0 = p.modv; const float* mv1 = p.modv + (size_t)9 * 6144;
    (void)mv0; (void)mv1; (void)vid0;
    phase_normmod_x(p, p.norm_ffn_g, 0, 3);
    if (7 + 1 < ph1) { if (ph1 > 1000) grid.sync(); else xcd_barrier(xb); }
  }
  if (ph0 <= 8 && 8 < ph1) {
    asm volatile("" : "+s"(pp));
    CP& p = *pp;
    const int bid = get_rbid();
    const int vid0 = (G & 7) ? bid : ((bid & 7) * (G >> 3) + (bid >> 3));
    const int hb = get_hb();
    char* smem_h = smem + hb * HALF_LDS; (void)smem_h;
    const float* mv0 = p.modv; const float* mv1 = p.modv + (size_t)9 * 6144;
    (void)mv0; (void)mv1; (void)vid0;
    {
        EpiConv<0> e{p.ffn_conv_w, p.ffn_conv_b, 5632, nullptr, p.act, nullptr};
        gemm_job<true>(smem, p.hxc, 1024, p.wt_up0, 1024, 5632, 17, 2048, 0, 126, 1, 2048, 136, 0, vid0, G, e);
      }
    if (8 + 1 < ph1) { if (ph1 > 1000) grid.sync(); else xcd_barrier(xb); }
  }
  if (ph0 <= 9 && 9 < ph1) {
    asm volatile("" : "+s"(pp));
    CP& p = *pp;
    const int bid = get_rbid();
    const int vid0 = (G & 7) ? bid : ((bid & 7) * (G >> 3) + (bid >> 3));
    const int hb = get_hb();
    char* smem_h = smem + hb * HALF_LDS; (void)smem_h;
    const float* mv0 = p.modv; const float* mv1 = p.modv + (size_t)9 * 6144;
    (void)mv0; (void)mv1; (void)vid0;
    {
        EpiResid<false> e{p.X16, p.X16, mv0 + 5 * 1024, nullptr};
        gemm_job<true>(smem, p.act, 2816, p.wt_dn0, 2816, 1024, 16, 2048, 0, 128, 0, 2048, 128, 0, vid0, G, e);
      }
    if (9 + 1 < ph1) { if (ph1 > 1000) grid.sync(); else xcd_barrier(xb); }
  }
  if (ph0 <= 10 && 10 < ph1) {
    asm volatile("" : "+s"(pp));
    CP& p = *pp;
    const int bid = get_rbid();
    const int vid0 = (G & 7) ? bid : ((bid & 7) * (G >> 3) + (bid >> 3));
    const int hb = get_hb();
    char* smem_h = smem + hb * HALF_LDS; (void)smem_h;
    const float* mv0 = p.modv; const float* mv1 = p.modv + (size_t)9 * 6144;
    (void)mv0; (void)mv1; (void)vid0;
    phase_normmod_x(p, p.norm_mix_g + 1024, 1, 0);
    if (10 + 1 < ph1) { if (ph1 > 1000) grid.sync(); else xcd_barrier(xb); }
  }
  if (ph0 <= 11 && 11 < ph1) {
    asm volatile("" : "+s"(pp));
    CP& p = *pp;
    const int bid = get_rbid();
    const int vid0 = (G & 7) ? bid : ((bid & 7) * (G >> 3) + (bid >> 3));
    const int hb = get_hb();
    char* smem_h = smem + hb * HALF_LDS; (void)smem_h;
    const float* mv0 = p.modv; const float* mv1 = p.modv + (size_t)9 * 6144;
    (void)mv0; (void)mv1; (void)vid0;
    {
        EpiBiasStore e1{p.x1h, 1024, p.hy_b_in};
        gemm_job<true>(smem, p.hxc, 1024, p.wt_hin, 1024, 1024, 16, 2048, 0, 128, 0, 2048, 128, 0, vid0, G, e1);
        EpiBiasT e2{p.vvT, p.hy_b_in + 1024};
        gemm_job<false>(smem, p.hxc, 1024, p.wt_hin + (size_t)1024 * 1024, 1024, 2048, 16, 2048, 0, 128, 0, 2048, 128, 64 * 4, vid0, G, e2);
      }
    if (11 + 1 < ph1) { if (ph1 > 1000) grid.sync(); else xcd_barrier(xb); }
  }
  if (ph0 <= 12 && 12 < ph1) {
    asm volatile("" : "+s"(pp));
    CP& p = *pp;
    const int bid = get_rbid();
    const int vid0 = (G & 7) ? bid : ((bid & 7) * (G >> 3) + (bid >> 3));
    const int hb = get_hb();
    char* smem_h = smem + hb * HALF_LDS; (void)smem_h;
    const float* mv0 = p.modv; const float* mv1 = p.modv + (size_t)9 * 6144;
    (void)mv0; (void)mv1; (void)vid0;
    phase_hyconv(p, smem_h);
    if (12 + 1 < ph1) { if (ph1 > 1000) grid.sync(); else xcd_barrier(xb); }
  }
  if (ph0 <= 13 && 13 < ph1) {
    asm volatile("" : "+s"(pp));
    CP& p = *pp;
    const int bid = get_rbid();
    const int vid0 = (G & 7) ? bid : ((bid & 7) * (G >> 3) + (bid >> 3));
    const int hb = get_hb();
    char* smem_h = smem + hb * HALF_LDS; (void)smem_h;
    const float* mv0 = p.modv; const float* mv1 = p.modv + (size_t)9 * 6144;
    (void)mv0; (void)mv1; (void)vid0;
    phase_transmul(p, smem_h);
    if (13 + 1 < ph1) { if (ph1 > 1000) grid.sync(); else xcd_barrier(xb); }
  }
  if (ph0 <= 14 && 14 < ph1) {
    asm volatile("" : "+s"(pp));
    CP& p = *pp;
    const int bid = get_rbid();
    const int vid0 = (G & 7) ? bid : ((bid & 7) * (G >> 3) + (bid >> 3));
    const int hb = get_hb();
    char* smem_h = smem + hb * HALF_LDS; (void)smem_h;
    const float* mv0 = p.modv; const float* mv1 = p.modv + (size_t)9 * 6144;
    (void)mv0; (void)mv1; (void)vid0;
    {
        EpiResid<false> e{p.X16, p.X16, mv1 + 2 * 1024, p.hy_b_out};
        gemm_job<true>(smem, p.hxc, 1024, p.wt_hout, 1024, 1024, 16, 2048, 0, 128, 0, 2048, 128, 0, vid0, G, e);
      }
    if (14 + 1 < ph1) { if (ph1 > 1000) grid.sync(); else xcd_barrier(xb); }
  }
  if (ph0 <= 15 && 15 < ph1) {
    asm volatile("" : "+s"(pp));
    CP& p = *pp;
    const int bid = get_rbid();
    const int vid0 = (G & 7) ? bid : ((bid & 7) * (G >> 3) + (bid >> 3));
    const int hb = get_hb();
    char* smem_h = smem + hb * HALF_LDS; (void)smem_h;
    const float* mv0 = p.modv; const float* mv1 = p.modv + (size_t)9 * 6144;
    (void)mv0; (void)mv1; (void)vid0;
    phase_normmod_x(p, p.norm_ffn_g + 1024, 1, 3);
    if (15 + 1 < ph1) { if (ph1 > 1000) grid.sync(); else xcd_barrier(xb); }
  }
  if (ph0 <= 16 && 16 < ph1) {
    asm volatile("" : "+s"(pp));
    CP& p = *pp;
    const int bid = get_rbid();
    const int vid0 = (G & 7) ? bid : ((bid & 7) * (G >> 3) + (bid >> 3));
    const int hb = get_hb();
    char* smem_h = smem + hb * HALF_LDS; (void)smem_h;
    const float* mv0 = p.modv; const float* mv1 = p.modv + (size_t)9 * 6144;
    (void)mv0; (void)mv1; (void)vid0;
    {
        EpiConv<0> e{p.ffn_conv_w + (size_t)3 * 5632, p.ffn_conv_b + 5632, 5632, nullptr, p.act, nullptr};
        gemm_job<true>(smem, p.hxc, 1024, p.wt_up1, 1024, 5632, 17, 2048, 0, 126, 1, 2048, 136, 0, vid0, G, e);
      }
    if (16 + 1 < ph1) { if (ph1 > 1000) grid.sync(); else xcd_barrier(xb); }
  }
  if (ph0 <= 17 && 17 < ph1) {
    asm volatile("" : "+s"(pp));
    CP& p = *pp;
    const int bid = get_rbid();
    const int vid0 = (G & 7) ? bid : ((bid & 7) * (G >> 3) + (bid >> 3));
    const int hb = get_hb();
    char* smem_h = smem + hb * HALF_LDS; (void)smem_h;
    const float* mv0 = p.modv; const float* mv1 = p.modv + (size_t)9 * 6144;
    (void)mv0; (void)mv1; (void)vid0;
    {
        EpiResid<false> e{p.X16, p.X16, mv1 + 5 * 1024, nullptr};
        gemm_job<true>(smem, p.act, 2816, p.wt_dn1, 2816, 1024, 16, 2048, 0, 128, 0, 2048, 128, 0, vid0, G, e);
      }
    if (17 + 1 < ph1) { if (ph1 > 1000) grid.sync(); else xcd_barrier(xb); }
  }
  if (ph0 <= 18 && 18 < ph1) {
    asm volatile("" : "+s"(pp));
    CP& p = *pp;
    const int bid = get_rbid();
    const int vid0 = (G & 7) ? bid : ((bid & 7) * (G >> 3) + (bid >> 3));
    const int hb = get_hb();
    char* smem_h = smem + hb * HALF_LDS; (void)smem_h;
    const float* mv0 = p.modv; const float* mv1 = p.modv + (size_t)9 * 6144;
    (void)mv0; (void)mv1; (void)vid0;
    phase_final_norm(p);
    if (18 + 1 < ph1) { if (ph1 > 1000) grid.sync(); else xcd_barrier(xb); }
  }
}

extern "C" void kernel_launch(void* const* d_in, const int* in_sizes, int n_in, void* d_out, int out_size, void* d_ws, size_t ws_size, hipStream_t stream) {
  static int grid_blocks = 0;
  if (!grid_blocks) {
    int dev = 0, cus = 0, per_cu = 0;
    hipGetDevice(&dev);
    hipDeviceGetAttribute(&cus, hipDeviceAttributeMultiprocessorCount, dev);
    hipOccupancyMaxActiveBlocksPerMultiprocessor(&per_cu, (const void*)mega, 512, 0);
    per_cu = 1;
    grid_blocks = cus * per_cu;
  }
  P p{};
  const float** in = (const float**)&p;
  for (int i = 0; i < 36; ++i) in[i] = (const float*)d_in[i];
  p.X = (float*)d_out;
  char* ws = (char*)d_ws; size_t off = 0;
  auto take = [&](size_t bytes) { char* r = ws + off; off += (bytes + 255) & ~(size_t)255; return r; };
  p.wt_dq = (bf16_t*)take((size_t)512 * 1024 * 2);
  p.wt_dkv = (bf16_t*)take((size_t)288 * 1024 * 2);
  p.wt_uq = (bf16_t*)take((size_t)1536 * 512 * 2);
  p.wt_uk = (bf16_t*)take((size_t)1024 * 256 * 2);
  p.wt_uv = (bf16_t*)take((size_t)1024 * 256 * 2);
  p.wt_o = (bf16_t*)take((size_t)1024 * 1024 * 2);
  p.wt_hin = (bf16_t*)take((size_t)3072 * 1024 * 2);
  p.wt_hout = (bf16_t*)take((size_t)1024 * 1024 * 2);
  p.wt_up0 = (bf16_t*)take((size_t)5632 * 1024 * 2);
  p.wt_up1 = (bf16_t*)take((size_t)5632 * 1024 * 2);
  p.wt_dn0 = (bf16_t*)take((size_t)1024 * 2816 * 2);
  p.wt_dn1 = (bf16_t*)take((size_t)1024 * 2816 * 2);
  p.modv = (float*)take((size_t)2 * 9 * 6144 * 4);
  p.rq = (float*)take((size_t)4 * 16384 * 4);
  p.rkv = (float*)take((size_t)2 * 18432 * 4);
  p.modp = (float*)take((size_t)4 * 110592 * 4);
  p.bar = (unsigned*)take((size_t)XCD_BAR_WORDS * 4);
  p.wt_f3 = (bf16_t*)take((size_t)2048 * 64 * 2);
  p.h2bf = (bf16_t*)take((size_t)2048 * 64 * 2);
  p.Rf = (bf16_t*)take((size_t)1024 * 4096 * 2);
  p.kpe = (bf16_t*)take((size_t)18432 * 32 * 2);
  p.hxc = (bf16_t*)take((size_t)18432 * 1024 * 2);
  const size_t ubase = off;
  p.cq = (bf16_t*)take((size_t)16384 * 512 * 2);
  p.kv = (bf16_t*)take((size_t)18432 * 288 * 2);
  p.Q = (bf16_t*)take((size_t)16384 * 1536 * 2);
  p.Kn = (bf16_t*)take((size_t)18432 * 1024 * 2);
  p.Vt = (bf16_t*)take((size_t)18432 * 1024 * 2);
  const size_t uend1 = off;
  p.X16 = (bf16_t*)(ws + ubase + (size_t)104857600);
  off = ubase;
  p.act = (bf16_t*)take((size_t)16384 * 2816 * 2);
  off = ubase;
  p.x1h = (bf16_t*)take((size_t)16384 * 1024 * 2);
  p.vvT = (bf16_t*)take((size_t)2 * 16384 * 1024 * 2);
  p.Yp = p.vvT;
  if (uend1 > ws_size) { fprintf(stderr, "workspace too small: need %zu have %zu\n", uend1, ws_size); return; }
  p.ph0 = 0; p.ph1 = NPHASE;
  if (hipMemsetAsync(p.bar, 0, (size_t)XCD_BAR_WORDS * 4, stream) != hipSuccess) { fprintf(stderr, "memset failed\n"); return; }
  void* args[] = {&p};
  hipError_t e = hipLaunchCooperativeKernel((const void*)mega, dim3(grid_blocks), dim3(512), args, 0, stream);
  if (e != hipSuccess) fprintf(stderr, "cooperative launch failed: %s (grid %d)\n", hipGetErrorString(e), grid_blocks);
}
```

```cpp
#include <hip/hip_runtime.h>
#include <hip/hip_cooperative_groups.h>
#include <cstdio>
namespace cg = cooperative_groups;

typedef unsigned short bf16_t;
typedef short bf16x8 __attribute__((ext_vector_type(8)));
typedef float f32x4 __attribute__((ext_vector_type(4)));
typedef float f32x16 __attribute__((ext_vector_type(16)));

#define LDS_BYTES 163840
#define HALF_LDS 81920
#define NPHASE 19

struct P {
  const float *x, *c, *ctx, *c_ctx, *mod_w, *mod_b, *norm_mix_g, *norm_ffn_g;
  const float *w_dq, *g_q, *w_uq, *w_dkv, *g_kv, *w_uk, *w_uv, *w_o;
  const float *hy_w_in, *hy_b_in, *hy_conv_w, *hy_conv_b, *f_w1, *f_b1, *f_freq1, *f_w2, *f_b2, *f_freq2, *f_w3, *hy_decay, *hy_d_bias, *hy_w_out, *hy_b_out;
  const float *ffn_w_up, *ffn_conv_w, *ffn_conv_b, *ffn_w_down, *final_g;
  float* X;
  bf16_t *wt_dq, *wt_dkv, *wt_uq, *wt_uk, *wt_uv, *wt_o, *wt_hin, *wt_hout, *wt_up0, *wt_up1, *wt_dn0, *wt_dn1;
  float *modv, *rq, *rkv, *modp;
  unsigned* bar;
  bf16_t *wt_f3, *h2bf, *X16;
  bf16_t *Rf, *kpe, *hxc, *cq, *kv, *Q, *Kn, *Vt, *act, *x1h, *vvT, *Yp;
  int ph0, ph1;
};

typedef const __attribute__((address_space(4))) P CP;
__device__ __forceinline__ int get_tid512() { int t = threadIdx.x; asm volatile("" : "+v"(t)); return t; }
__device__ __forceinline__ int get_tid() { int t = threadIdx.x & 255; asm volatile("" : "+v"(t)); return t; }
__device__ __forceinline__ int get_hb() { int t = __builtin_amdgcn_readfirstlane((int)(threadIdx.x >> 8)); asm volatile("" : "+s"(t)); return t; }
__device__ __forceinline__ int get_rbid() { int t = blockIdx.x; asm volatile("" : "+s"(t)); return t; }
__device__ __forceinline__ int get_bid() { return 2 * get_rbid() + get_hb(); }
#define VGRID (2 * (int)gridDim.x)

__device__ __forceinline__ unsigned pack2(float a, float b) { unsigned r; asm("v_cvt_pk_bf16_f32 %0, %1, %2" : "=v"(r) : "v"(a), "v"(b)); return r; }
__device__ __forceinline__ bf16_t f2bf(float f) { return (bf16_t)(pack2(f, f) & 0xffffu); }
__device__ __forceinline__ float bf2f(bf16_t h) { return __uint_as_float(((unsigned)h) << 16); }
__device__ __forceinline__ float wave_sum(float v) {
#pragma unroll
  for (int o = 32; o; o >>= 1) v += __shfl_xor(v, o);
  return v;
}


#define XB_TMO      128
#define XB_XCNT(j)  (256  + 64 * (j))
#define XB_XSUB(j)  (1280 + 64 * (j))
#define XB_XGEN(j)  (2304 + 64 * (j))
#define XB_TOP      3328
#define XB_TOPGEN   3392
#define XCD_BAR_WORDS 3456
#define XB_SPIN_CAP (1u << 18)
#define LAS __attribute__((address_space(3)))
__device__ __forceinline__ unsigned xb_ld(unsigned* p)              { return __hip_atomic_load(p, __ATOMIC_RELAXED, __HIP_MEMORY_SCOPE_AGENT); }
__device__ __forceinline__ unsigned xb_add(unsigned* p, unsigned v) { return __hip_atomic_fetch_add(p, v, __ATOMIC_RELAXED, __HIP_MEMORY_SCOPE_AGENT); }
__device__ __forceinline__ unsigned xb_xcc_id() { return (unsigned)__builtin_amdgcn_s_getreg((3 << 11) | 20) & 0xFu; }
#define XB_SPIN(cond, bar) do { unsigned _sp = 0; while (cond) { __builtin_amdgcn_s_sleep(1); \
    if ((++_sp & 255u) == 0u) { if (xb_ld(&(bar)[XB_TMO])) break; if (_sp > XB_SPIN_CAP) { atomicAdd(&(bar)[XB_TMO], 1u); break; } } } } while (0)
struct XcdBarrier { unsigned* bar; unsigned x; volatile LAS unsigned* st; };
__device__ __forceinline__ XcdBarrier xcd_barrier_post(unsigned* bar, volatile LAS unsigned* st) {
    XcdBarrier b; b.bar = bar; b.x = xb_xcc_id(); b.st = st;
    if (threadIdx.x == 0) (void)xb_add(&bar[XB_XCNT(b.x)], 1u);
    return b;
}
__device__ __forceinline__ void xcd_barrier_complete(unsigned* bar, unsigned x, unsigned& nloc, unsigned& nx) {
    const unsigned G = gridDim.x * gridDim.y * gridDim.z;
    unsigned sum, cnt, mine, sp = 0u;
    for (;;) {
        sum = 0u; cnt = 0u; mine = 0u;
#pragma unroll
        for (unsigned j = 0; j < 16; ++j) { const unsigned c = xb_ld(&bar[XB_XCNT(j)]); sum += c; cnt += (c > 0u) ? 1u : 0u; mine = (j == x) ? c : mine; }
        if (sum == G) break;
        __builtin_amdgcn_s_sleep(1);
        if ((++sp & 255u) == 0u) { if (xb_ld(&bar[XB_TMO])) break; if (sp > XB_SPIN_CAP) { atomicAdd(&bar[XB_TMO], 1u); break; } }
    }
    nloc = mine > 0u ? mine : 1u; nx = cnt > 0u ? cnt : 1u;
}
__device__ __forceinline__ void xcd_barrier(const XcdBarrier& b) {
    asm volatile("s_waitcnt vmcnt(0)" ::: "memory");
    __syncthreads();
    if (threadIdx.x == 0) {
        unsigned* bar = b.bar;
        __builtin_amdgcn_s_waitcnt(0);
        unsigned nloc = b.st[0], nx = b.st[1];
        if (nloc == 0u) { xcd_barrier_complete(bar, b.x, nloc, nx); b.st[0] = nloc; b.st[1] = nx; }
        const unsigned old = xb_add(&bar[XB_XSUB(b.x)], 1u);
        const unsigned gen = old / nloc;
        if (old + 1u == (gen + 1u) * nloc) {
            __builtin_amdgcn_fence(__ATOMIC_RELEASE, "agent");
            asm volatile("s_waitcnt vmcnt(0)" ::: "memory");
            const unsigned og = xb_add(&bar[XB_TOP], 1u);
            const unsigned tg = og / nx;
            if (og + 1u == (tg + 1u) * nx) xb_add(&bar[XB_TOPGEN], 1u);
            else XB_SPIN(xb_ld(&bar[XB_TOPGEN]) == tg, bar);
            __builtin_amdgcn_fence(__ATOMIC_ACQUIRE, "agent");
            xb_add(&bar[XB_XGEN(b.x)], 1u);
            asm volatile("s_waitcnt vmcnt(0)" ::: "memory");
        } else {
            XB_SPIN(xb_ld(&bar[XB_XGEN(b.x)]) == gen, bar);
            __builtin_amdgcn_fence(__ATOMIC_ACQUIRE, "agent");
            asm volatile("s_waitcnt vmcnt(0)" ::: "memory");
        }
    }
    __syncthreads();
}

__device__ __forceinline__ void prep_weight_tile(CP& p, char* smem, int wt) {
  const int tid = get_tid();
  int id = 0;
  {
    const int cnt[13] = {64, 40, 96, 32, 32, 128, 384, 128, 704, 704, 352, 352, 32};
#pragma unroll
    for (int i = 0; i < 12; ++i) { if (id == i && wt >= cnt[i]) { wt -= cnt[i]; id = i + 1; } }
  }
  const float* src; int K, N; bf16_t* dst; const float* scale = nullptr; int perm = 0;
  switch (id) {
    case 0: src = p.w_dq; K = 1024; N = 512; dst = p.wt_dq; break;
    case 1: src = p.w_dkv; K = 1024; N = 288; dst = p.wt_dkv; break;
    case 2: src = p.w_uq; K = 512; N = 1536; dst = p.wt_uq; scale = p.g_q; break;
    case 3: src = p.w_uk; K = 256; N = 1024; dst = p.wt_uk; scale = p.g_kv; break;
    case 4: src = p.w_uv; K = 256; N = 1024; dst = p.wt_uv; scale = p.g_kv; break;
    case 5: src = p.w_o; K = 1024; N = 1024; dst = p.wt_o; break;
    case 6: src = p.hy_w_in; K = 1024; N = 3072; dst = p.wt_hin; break;
    case 7: src = p.hy_w_out; K = 1024; N = 1024; dst = p.wt_hout; break;
    case 8: src = p.ffn_w_up; K = 1024; N = 5632; dst = p.wt_up0; perm = 1; break;
    case 9: src = p.ffn_w_up + (size_t)1024 * 5632; K = 1024; N = 5632; dst = p.wt_up1; perm = 1; break;
    case 10: src = p.ffn_w_down; K = 2816; N = 1024; dst = p.wt_dn0; break;
    case 11: src = p.ffn_w_down + (size_t)2816 * 1024; K = 2816; N = 1024; dst = p.wt_dn1; break;
    default: src = p.f_w3; K = 64; N = 2048; dst = p.wt_f3; break;
  }
  const int ntn = (N + 63) >> 6;
  const int kt = wt / ntn, nt = wt - kt * ntn;
  const int k0 = kt * 128, n0 = nt * 64;
  int np0;
  if (perm == 1) { const int half = n0 / 2816, f = n0 - half * 2816; np0 = (f >> 6) * 128 + half * 64; }
  else if (perm == 2) { if (n0 < 1024) np0 = n0; else { const int m = n0 - 1024, half = m >> 10, f = m & 1023; np0 = 1024 + (f >> 6) * 128 + half * 64; } }
  else np0 = n0;
  bf16_t* t16 = (bf16_t*)smem;
  f32x4 v[8];
#pragma unroll
  for (int i = 0; i < 8; ++i) {
    const int idx = tid + 256 * i; const int kr = idx >> 4, c4 = idx & 15;
    v[i] = (f32x4){0.f, 0.f, 0.f, 0.f};
    if (n0 + 4 * c4 < N && k0 + kr < K) v[i] = *(const f32x4*)(src + (size_t)(k0 + kr) * N + n0 + 4 * c4);
  }
#pragma unroll
  for (int i = 0; i < 8; ++i) {
    const int idx = tid + 256 * i; const int kr = idx >> 4, c4 = idx & 15;
    const float sc = (scale && k0 + kr < K) ? scale[k0 + kr] : 1.f;
#pragma unroll
    for (int j = 0; j < 4; ++j) t16[(4 * c4 + j) * 136 + kr] = f2bf(v[i][j] * sc);
  }
  __syncthreads();
#pragma unroll
  for (int i = 0; i < 4; ++i) {
    const int idx = tid + 256 * i; const int n = idx >> 4, ch = idx & 15;
    if (n0 + n < N && k0 + ch * 8 < K) *(uint4*)(dst + (size_t)(np0 + n) * K + k0 + ch * 8) = *(const uint4*)(t16 + n * 136 + ch * 8);
  }
  __syncthreads();
}

__device__ __forceinline__ void prep_modvec(CP& p, char* smem, int it) {
  const int tid = get_tid();
  const int layer = it / 384, rem = it - layer * 384, cb = rem >> 2, ks = rem & 3;
  float* s_lds = (float*)smem;
  float* red = (float*)(smem + 12288);
  const int kbase = ks * 256;
  for (int idx = tid; idx < 9 * 256; idx += 256) {
    const int r = idx >> 8, k = idx & 255;
    const float v = r < 8 ? p.c[r * 1024 + kbase + k] : p.c_ctx[kbase + k];
    s_lds[k * 12 + r] = v / (1.f + __expf(-v));
  }
  __syncthreads();
  const int col = cb * 64 + (tid & 63), kg = tid >> 6;
  const float* W = p.mod_w + (size_t)layer * 1024 * 6144 + (size_t)kbase * 6144 + col;
  float acc[9];
#pragma unroll
  for (int r = 0; r < 9; ++r) acc[r] = 0.f;
#pragma unroll
  for (int kb = 0; kb < 4; ++kb) {
    float w[16];
#pragma unroll
    for (int u = 0; u < 16; ++u) w[u] = W[(size_t)(kg * 64 + kb * 16 + u) * 6144];
#pragma unroll
    for (int u = 0; u < 16; ++u) {
      const int k = kg * 64 + kb * 16 + u;
      const f32x4 s0 = *(const f32x4*)(s_lds + k * 12), s1 = *(const f32x4*)(s_lds + k * 12 + 4);
      const float s2 = s_lds[k * 12 + 8];
      acc[0] += s0[0] * w[u]; acc[1] += s0[1] * w[u]; acc[2] += s0[2] * w[u]; acc[3] += s0[3] * w[u];
      acc[4] += s1[0] * w[u]; acc[5] += s1[1] * w[u]; acc[6] += s1[2] * w[u]; acc[7] += s1[3] * w[u];
      acc[8] += s2 * w[u];
    }
  }
#pragma unroll
  for (int r = 0; r < 9; ++r) red[(kg * 9 + r) * 64 + (tid & 63)] = acc[r];
  __syncthreads();
  for (int o = tid; o < 9 * 64; o += 256) {
    const int r = o >> 6, cl = o & 63;
    const float sm = red[(0 * 9 + r) * 64 + cl] + red[(1 * 9 + r) * 64 + cl] + red[(2 * 9 + r) * 64 + cl] + red[(3 * 9 + r) * 64 + cl];
    p.modp[(size_t)ks * 110592 + (size_t)(layer * 9 + r) * 6144 + cb * 64 + cl] = sm;
  }
  __syncthreads();
}

__device__ __forceinline__ void prep_filter(CP& p, char* smem, int it) {
  const int tid = get_tid();
  float* z = (float*)smem;
  float* h1 = z + 8 * 33;
  float* h2 = h1 + 8 * 64;
  const int t0 = it * 8;
  for (int idx = tid; idx < 8 * 33; idx += 256) {
    const int pp = idx / 33, i = idx - pp * 33;
    const int t = t0 + pp;
    float v;
    if (i == 0) v = (float)t * (1.0f / 2047.0f);
    else {
      const int k = (i - 1) & 15;
      const float w = (6.283185307179586f * (float)t) / 2048.0f;
      const float f = 1e-4f + (float)k * ((15.0f - 1e-4f) / 15.0f);
      const float a = w * f;
      v = (i <= 16) ? __cosf(a) : -__sinf(a);
    }
    z[idx] = v;
  }
  __syncthreads();
  for (int idx = tid; idx < 8 * 64; idx += 256) {
    const int pp = idx >> 6, j = idx & 63;
    float s = p.f_b1[j];
#pragma unroll
    for (int i = 0; i < 33; ++i) s += z[pp * 33 + i] * p.f_w1[i * 64 + j];
    h1[idx] = __sinf(p.f_freq1[j] * s);
  }
  __syncthreads();
  for (int idx = tid; idx < 8 * 64; idx += 256) {
    const int pp = idx >> 6, j = idx & 63;
    float s = p.f_b2[j];
#pragma unroll 16
    for (int i = 0; i < 64; ++i) s += h1[pp * 64 + i] * p.f_w2[i * 64 + j];
    h2[idx] = __sinf(p.f_freq2[j] * s);
  }
  __syncthreads();
  for (int idx = tid; idx < 8 * 64; idx += 256) p.h2bf[(size_t)t0 * 64 + idx] = f2bf(h2[idx]);
  __syncthreads();
}

__device__ __forceinline__ void phase_prep(CP& p, char* smem) {
  const int total = 768 + 256 + 3048;
  for (int it = get_bid(); it < total; it += VGRID) {
    if (it < 768) prep_modvec(p, smem, it);
    else if (it < 1024) prep_filter(p, smem, it - 768);
    else prep_weight_tile(p, smem, it - 1024);
  }
}

__device__ __forceinline__ f32x4 ld4_bf16(const bf16_t* p) {
  const uint2 u = *(const uint2*)p;
  f32x4 r; r[0] = bf2f((bf16_t)(u.x & 0xffff)); r[1] = bf2f((bf16_t)(u.x >> 16)); r[2] = bf2f((bf16_t)(u.y & 0xffff)); r[3] = bf2f((bf16_t)(u.y >> 16));
  return r;
}
template <bool PART, bool SRC16 = false>
__device__ __forceinline__ void normmod_row2(const void* __restrict__ srcv, const float* __restrict__ g, const float* __restrict__ sh, const float* __restrict__ sc, bf16_t* __restrict__ dst, int lane, const float* __restrict__ bsh = nullptr) {
  f32x4 v[2][4]; float ss0 = 0.f, ss1 = 0.f;
#pragma unroll
  for (int i = 0; i < 4; ++i) {
    if (SRC16) { v[0][i] = ld4_bf16((const bf16_t*)srcv + lane * 4 + 256 * i); v[1][i] = ld4_bf16((const bf16_t*)srcv + 1024 + lane * 4 + 256 * i); }
    else { v[0][i] = *(const f32x4*)((const float*)srcv + lane * 4 + 256 * i); v[1][i] = *(const f32x4*)((const float*)srcv + 1024 + lane * 4 + 256 * i); }
  }
#pragma unroll
  for (int i = 0; i < 4; ++i) {
    ss0 += v[0][i][0] * v[0][i][0] + v[0][i][1] * v[0][i][1] + v[0][i][2] * v[0][i][2] + v[0][i][3] * v[0][i][3];
    ss1 += v[1][i][0] * v[1][i][0] + v[1][i][1] * v[1][i][1] + v[1][i][2] * v[1][i][2] + v[1][i][3] * v[1][i][3];
  }
  ss0 = wave_sum(ss0); ss1 = wave_sum(ss1);
  const float r0 = rsqrtf(ss0 * (1.0f / 1024.0f) + 1e-6f), r1 = rsqrtf(ss1 * (1.0f / 1024.0f) + 1e-6f);
#pragma unroll
  for (int i = 0; i < 4; ++i) {
    const int k = lane * 4 + 256 * i;
    const f32x4 g4 = *(const f32x4*)(g + k);
    f32x4 s4 = *(const f32x4*)(sh + k), c4 = *(const f32x4*)(sc + k);
    if (PART) {
#pragma unroll
      for (int q = 1; q < 4; ++q) { s4 += *(const f32x4*)(sh + (size_t)q * 110592 + k); c4 += *(const f32x4*)(sc + (size_t)q * 110592 + k); }
      s4 += *(const f32x4*)(bsh + k); c4 += *(const f32x4*)(bsh + 1024 + k);
    }
    float y[4], z[4];
#pragma unroll
    for (int j = 0; j < 4; ++j) { const float gm = g4[j] * (1.f + c4[j]); y[j] = (v[0][i][j] * r0) * gm + s4[j]; z[j] = (v[1][i][j] * r1) * gm + s4[j]; }
    uint2 u; u.x = pack2(y[0], y[1]); u.y = pack2(y[2], y[3]);
    *(uint2*)(dst + k) = u;
    u.x = pack2(z[0], z[1]); u.y = pack2(z[2], z[3]);
    *(uint2*)(dst + 1024 + k) = u;
  }
}

__device__ __forceinline__ void phase_normmod_kv(CP& p) {
  const int lane = get_tid() & 63, wv = get_tid() >> 6;
  const float* g = p.norm_mix_g;
  for (int idx = get_bid() * 256 + get_tid(); idx < 110592; idx += VGRID * 256) {
    const int lr = idx / 6144; const int n = idx - lr * 6144; const int layer = lr / 9;
    p.modv[idx] = p.modp[idx] + p.modp[110592 + idx] + p.modp[2 * 110592 + idx] + p.modp[3 * 110592 + idx] + p.mod_b[layer * 6144 + n];
  }
  for (int r = (get_bid() * 4 + wv) * 2; r < 18432; r += VGRID * 8) {
    const int b = r / 2304, pp = r - b * 2304;
    const float* src; const float* mv;
    if (pp < 256) { src = p.ctx + ((size_t)b * 256 + pp) * 1024; mv = p.modp + (size_t)8 * 6144; }
    else { src = p.x + ((size_t)b * 2048 + pp - 256) * 1024; mv = p.modp + (size_t)b * 6144; }
    normmod_row2<true>(src, g, mv, mv + 1024, p.hxc + (size_t)r * 1024, lane, p.mod_b);
  }
}
__device__ __forceinline__ void phase_normmod_x(CP& p, const float* g, int layer, int chunk) {
  const int lane = get_tid() & 63, wv = get_tid() >> 6;
  for (int r = (get_bid() * 4 + wv) * 2; r < 16384; r += VGRID * 8) {
    const int b = r >> 11;
    const float* mv = p.modv + (size_t)(layer * 9 + b) * 6144 + chunk * 1024;
    normmod_row2<false, true>(p.X16 + (size_t)r * 1024, g, mv, mv + 1024, p.hxc + (size_t)r * 1024, lane);
  }
}
__device__ __forceinline__ void phase_final_norm(CP& p) {
  const int lane = get_tid() & 63, wv = get_tid() >> 6;
  for (int r = get_bid() * 4 + wv; r < 16384; r += VGRID * 4) {
    const bf16_t* srow = p.X16 + (size_t)r * 1024;
    float* row = p.X + (size_t)r * 1024;
    f32x4 v[4]; float ss = 0.f;
#pragma unroll
    for (int i = 0; i < 4; ++i) { v[i] = ld4_bf16(srow + lane * 4 + 256 * i); ss += v[i][0] * v[i][0] + v[i][1] * v[i][1] + v[i][2] * v[i][2] + v[i][3] * v[i][3]; }
    ss = wave_sum(ss);
    const float rr = rsqrtf(ss * (1.0f / 1024.0f) + 1e-6f);
#pragma unroll
    for (int i = 0; i < 4; ++i) {
      const int k = lane * 4 + 256 * i;
      const f32x4 g4 = *(const f32x4*)(p.final_g + k);
      f32x4 o; o[0] = v[i][0] * rr * g4[0]; o[1] = v[i][1] * rr * g4[1]; o[2] = v[i][2] * rr * g4[2]; o[3] = v[i][3] * rr * g4[3];
      *(f32x4*)(row + k) = o;
    }
  }
}

__device__ __forceinline__ void phase_rowstat(CP& p) {
  const int lane = get_tid() & 63, wv = get_tid() >> 6;
  for (int r = get_bid() * 4 + wv; r < 18432; r += VGRID * 4) {
    const int b = r / 2304, pp = r - b * 2304;
    const bf16_t* kvr = p.kv + (size_t)r * 288;
    {
      const uint2 u = *(const uint2*)(kvr + lane * 4);
      const float a0 = bf2f((bf16_t)(u.x & 0xffff)), a1 = bf2f((bf16_t)(u.x >> 16)), a2 = bf2f((bf16_t)(u.y & 0xffff)), a3 = bf2f((bf16_t)(u.y >> 16));
      float ss = a0 * a0 + a1 * a1 + a2 * a2 + a3 * a3;
      ss = wave_sum(ss);
      if (lane == 0) p.rkv[r] = rsqrtf(ss * (1.0f / 256.0f) + 1e-6f);
    }
    {
      const int i = lane & 31;
      const float xv = bf2f(kvr[256 + i]);
      const float ov = __shfl_xor(xv, 8);
      float res = xv;
      if (pp >= 256) {
        const int t = pp - 256;
        const int quarter = i >> 3, idx = i & 7;
        const float pos = (quarter < 2) ? (float)(t >> 6) : (float)(t & 63);
        const float inv = exp2f(-(float)idx * (13.287712379549449f / 8.0f));
        const float ang = pos * inv;
        const float cs = __cosf(ang), sn = __sinf(ang);
        res = xv * cs + ((quarter & 1) ? ov : -ov) * sn;
      }
      if (lane < 32) p.kpe[(size_t)r * 32 + i] = f2bf(res);
    }
    if (pp >= 256) {
      const int xr = b * 2048 + pp - 256;
      const uint4 u = *(const uint4*)(p.cq + (size_t)xr * 512 + lane * 8);
      const unsigned uu[4] = {u.x, u.y, u.z, u.w};
      float ss = 0.f;
#pragma unroll
      for (int j = 0; j < 4; ++j) { const float a = bf2f((bf16_t)(uu[j] & 0xffff)), bb = bf2f((bf16_t)(uu[j] >> 16)); ss += a * a + bb * bb; }
      ss = wave_sum(ss);
      if (lane == 0) p.rq[xr] = rsqrtf(ss * (1.0f / 512.0f) + 1e-6f);
    }
  }
}

template <int NP>
struct EpiStore {
  static constexpr int KIND = 0; static constexpr bool ROWSUM = false;
  bf16_t* out; int ld; int ostride; const float* part; int pstride; float inv_n;
  __device__ __forceinline__ void c4(int g, int rig, int col, f32x4 v) const {
    const size_t row = (size_t)g * ostride + rig;
    float s = 1.f;
    if (NP > 0) {
      float t = 0.f;
#pragma unroll
      for (int q = 0; q < NP; ++q) t += part[(size_t)q * pstride + row];
      s = rsqrtf(t * inv_n + 1e-6f);
    }
    uint2 u; u.x = pack2(v[0] * s, v[1] * s); u.y = pack2(v[2] * s, v[3] * s);
    *(uint2*)(out + row * ld + col) = u;
  }
};
struct EpiDown {
  static constexpr int KIND = 0; static constexpr bool ROWSUM = true;
  bf16_t* out; int ld; int ostride; float* part; int nslots; bf16_t* kpe; int ropecol;
  __device__ __forceinline__ float c4(int g, int rig, int col, f32x4 v) const {
    const size_t row = (size_t)g * ostride + rig;
    if (kpe && col >= ropecol) {
      const int i0 = col - ropecol;
      f32x4 o = v;
      const float p0 = __shfl_xor(v[0], 32), p1 = __shfl_xor(v[1], 32), p2 = __shfl_xor(v[2], 32), p3 = __shfl_xor(v[3], 32);
      const float pv[4] = {p0, p1, p2, p3};
      if (rig >= 256) {
        const int t = rig - 256;
        const int quarter = i0 >> 3;
        const float pos = (quarter < 2) ? (float)(t >> 6) : (float)(t & 63);
#pragma unroll
        for (int j = 0; j < 4; ++j) {
          const int idx = (i0 & 7) + j;
          const float inv = exp2f(-(float)idx * (13.287712379549449f / 8.0f));
          const float ang = pos * inv;
          const float cs = __cosf(ang), sn = __sinf(ang);
          o[j] = v[j] * cs + ((quarter & 1) ? pv[j] : -pv[j]) * sn;
        }
      }
      uint2 u; u.x = pack2(o[0], o[1]); u.y = pack2(o[2], o[3]);
      *(uint2*)(kpe + row * 32 + i0) = u;
      return 0.f;
    }
    uint2 u; u.x = pack2(v[0], v[1]); u.y = pack2(v[2], v[3]);
    *(uint2*)(out + row * ld + col) = u;
    return v[0] * v[0] + v[1] * v[1] + v[2] * v[2] + v[3] * v[3];
  }
  __device__ __forceinline__ void rowsum(int g, int rig, int slot, float ss) const {
    if (slot < nslots) part[(size_t)slot * ((size_t)8 * ostride) + (size_t)g * ostride + rig] = ss;
  }
};
struct EpiVt {
  static constexpr int KIND = 1;
  bf16_t* out; const float* part;
  __device__ __forceinline__ void r4(int g, int rig, int col, f32x4 v) const {
    const size_t row = (size_t)g * 2304 + rig;
    const f32x4 t = *(const f32x4*)(part + row) + *(const f32x4*)(part + 18432 + row);
    f32x4 s;
#pragma unroll
    for (int j = 0; j < 4; ++j) s[j] = rsqrtf(t[j] * (1.0f / 256.0f) + 1e-6f);
    uint2 u; u.x = pack2(v[0] * s[0], v[1] * s[1]); u.y = pack2(v[2] * s[2], v[3] * s[3]);
    *(uint2*)(out + ((size_t)g * 1024 + col) * 2304 + rig) = u;
  }
};
struct EpiBiasStore {
  static constexpr int KIND = 0; static constexpr bool ROWSUM = false;
  bf16_t* out; int ld; const float* bias;
  __device__ __forceinline__ void c4(int g, int rig, int col, f32x4 v) const {
    const size_t row = (size_t)g * 2048 + rig;
    const f32x4 b4 = *(const f32x4*)(bias + col);
    uint2 u; u.x = pack2(v[0] + b4[0], v[1] + b4[1]); u.y = pack2(v[2] + b4[2], v[3] + b4[3]);
    *(uint2*)(out + row * ld + col) = u;
  }
};
struct EpiBiasT {
  static constexpr int KIND = 1;
  bf16_t* out; const float* bias;
  __device__ __forceinline__ void r4(int g, int rig, int col, f32x4 v) const {
    const float b = bias[col];
    uint2 u; u.x = pack2(v[0] + b, v[1] + b); u.y = pack2(v[2] + b, v[3] + b);
    *(uint2*)(out + (size_t)col * 16384 + (size_t)g * 2048 + rig) = u;
  }
};
struct EpiFilt {
  static constexpr int KIND = 1;
  bf16_t* Rf; const float* decay;
  __device__ __forceinline__ void r4(int g, int rig, int col, f32x4 v) const {
    const int c = col & 1023; const bool bwd = col >= 1024;
    const float dec = fabsf(decay[c]);
    bf16_t* rp = Rf + (size_t)c * 4096;
#pragma unroll
    for (int j = 0; j < 4; ++j) {
      const int t = rig + j;
      const float val = v[j] * __expf(-(float)t * (1.0f / 2047.0f) * dec);
      if (!bwd) rp[2048 - t] = f2bf(val);
      else if (t > 0) rp[2048 + t] = f2bf(val);
      else rp[0] = 0;
    }
  }
};
template <bool BASE_F32>
struct EpiResid {
  static constexpr int KIND = 0; static constexpr bool ROWSUM = false;
  bf16_t* X16; const void* base; const float* gate; const float* bias;
  __device__ __forceinline__ void c4(int g, int rig, int col, f32x4 v) const {
    const size_t o = ((size_t)g * 2048 + rig) * 1024 + col;
    f32x4 bs;
    if (BASE_F32) bs = *(const f32x4*)((const float*)base + o);
    else {
      const uint2 u = *(const uint2*)((const bf16_t*)base + o);
      bs[0] = bf2f((bf16_t)(u.x & 0xffff)); bs[1] = bf2f((bf16_t)(u.x >> 16)); bs[2] = bf2f((bf16_t)(u.y & 0xffff)); bs[3] = bf2f((bf16_t)(u.y >> 16));
    }
    const f32x4 gt = *(const f32x4*)(gate + (size_t)g * 6144 + col);
    f32x4 bi = {0.f, 0.f, 0.f, 0.f};
    if (bias) bi = *(const f32x4*)(bias + col);
    f32x4 r;
#pragma unroll
    for (int j = 0; j < 4; ++j) r[j] = bs[j] + gt[j] * (v[j] + bi[j]);
    uint2 w; w.x = pack2(r[0], r[1]); w.y = pack2(r[2], r[3]);
    *(uint2*)(X16 + o) = w;
  }
};
template <int MODE>
struct EpiConv {
  static constexpr int KIND = 2;
  const float* cw; const float* cb; int NC; const float* pre_bias;
  bf16_t* o0; bf16_t* o1;
  __device__ __forceinline__ int norig(int nt, int cl) const {
    if (MODE == 0) return (cl >> 6) * 2816 + nt * 64 + (cl & 63);
    if (nt < 8) return nt * 128 + cl;
    return 1024 + (cl >> 6) * 1024 + (nt - 8) * 64 + (cl & 63);
  }
  typedef float f32x2_t __attribute__((ext_vector_type(2)));
  static __device__ __forceinline__ f32x2_t ldz(const bf16_t* Z, int row, int col) {
    const unsigned u = *(const unsigned*)(Z + row * 132 + col);
    f32x2_t r; r[0] = __uint_as_float(u << 16); r[1] = __uint_as_float(u & 0xffff0000u); return r;
  }
  template <class F>
  __device__ __forceinline__ void finish(const bf16_t* Z, int g, int rig0, int nt, F&& pre) const {
    typedef f32x2_t f32x2;
    const int tid = get_tid();
    if (MODE == 0 || nt < 8) {
      if (MODE == 0) {
        const int f2 = (tid & 31) * 2, q8 = tid >> 5;
        const int q0 = 1 + 16 * q8, q1 = (q0 + 16 < 127) ? q0 + 16 : 127;
        const int na = norig(nt, f2), ng = norig(nt, 64 + f2);
        const f32x2 a0 = *(const f32x2*)(cw + na), a1 = *(const f32x2*)(cw + NC + na), a2 = *(const f32x2*)(cw + 2 * NC + na), ab = *(const f32x2*)(cb + na);
        const f32x2 g0 = *(const f32x2*)(cw + ng), g1 = *(const f32x2*)(cw + NC + ng), g2 = *(const f32x2*)(cw + 2 * NC + ng), gb = *(const f32x2*)(cb + ng);
        pre();
        f32x2 am = ldz(Z, q0 - 1, f2), ac = ldz(Z, q0, f2);
        f32x2 gm = ldz(Z, q0 - 1, 64 + f2), gc = ldz(Z, q0, 64 + f2);
#pragma unroll 4
        for (int pl = q0; pl < q1; ++pl) {
          const f32x2 an = ldz(Z, pl + 1, f2), gn = ldz(Z, pl + 1, 64 + f2);
          const int pos = rig0 + pl;
          if (pos < 2048) {
            const f32x2 av = a0 * am + a1 * ac + a2 * an + ab;
            const f32x2 gv = g0 * gm + g1 * gc + g2 * gn + gb;
            const float s0 = av[0] * gv[0] * __builtin_amdgcn_rcpf(1.f + __expf(-gv[0]));
            const float s1 = av[1] * gv[1] * __builtin_amdgcn_rcpf(1.f + __expf(-gv[1]));
            *(unsigned*)(o0 + ((size_t)g * 2048 + pos) * 2816 + nt * 64 + f2) = pack2(s0, s1);
          }
          am = ac; ac = an; gm = gc; gc = gn;
        }
      } else {
        const int cl = (tid & 63) * 2, q = tid >> 6;
        const int p0 = 1 + 32 * q, p1 = (p0 + 32 < 127) ? p0 + 32 : 127;
        const int na = norig(nt, cl);
        const f32x2 a0 = *(const f32x2*)(cw + na), a1 = *(const f32x2*)(cw + NC + na), a2 = *(const f32x2*)(cw + 2 * NC + na), ab = *(const f32x2*)(cb + na);
        pre();
        f32x2 am = ldz(Z, p0 - 1, cl), ac = ldz(Z, p0, cl);
#pragma unroll 2
        for (int pl = p0; pl < p1; ++pl) {
          const f32x2 an = ldz(Z, pl + 1, cl);
          const int pos = rig0 + pl;
          if (pos < 2048) {
            const f32x2 av = a0 * am + a1 * ac + a2 * an + ab;
            *(unsigned*)(o0 + ((size_t)g * 2048 + pos) * 1024 + nt * 128 + cl) = pack2(av[0], av[1]);
          }
          am = ac; ac = an;
        }
      }
    } else {
      pre();
      const int pl = tid & 127, fh = tid >> 7;
      const int pos = rig0 + pl;
      if (pl >= 1 && pl <= 126 && pos < 2048) {
        const int fb = nt - 8;
#pragma unroll 2
        for (int f = fh * 32; f < fh * 32 + 32; f += 2) {
          const int na = norig(nt, f), nb = norig(nt, 64 + f);
          const f32x2 va = *(const f32x2*)(cw + na) * ldz(Z, pl - 1, f) + *(const f32x2*)(cw + NC + na) * ldz(Z, pl, f)
                         + *(const f32x2*)(cw + 2 * NC + na) * ldz(Z, pl + 1, f) + *(const f32x2*)(cb + na);
          const f32x2 vb = *(const f32x2*)(cw + nb) * ldz(Z, pl - 1, 64 + f) + *(const f32x2*)(cw + NC + nb) * ldz(Z, pl, 64 + f)
                         + *(const f32x2*)(cw + 2 * NC + nb) * ldz(Z, pl + 1, 64 + f) + *(const f32x2*)(cb + nb);
          bf16_t* op = o1 + (size_t)(fb * 64 + f) * 16384 + g * 2048 + pos;
          op[0] = f2bf(va[0] * vb[0]);
          op[16384] = f2bf(va[1] * vb[1]);
        }
      }
    }
  }
};

#define GLDS16(gp, lp) __builtin_amdgcn_global_load_lds((const unsigned*)(gp), (__attribute__((address_space(3))) unsigned*)(lp), 16, 0, 0)

template <bool SWAP, class Epi, bool THIN = false>
__device__ __forceinline__ void gemm_job(char* smem, const bf16_t* __restrict__ A, int lda, const bf16_t* __restrict__ Bt, int K, int N,
                                         int tpg, int a_gstride, int a_goff, int step, int halo, int grows, int MTS, int voff, int vid0, int grid, const Epi& epi) {
  const int tid = get_tid512(), lane = tid & 63, wid = tid >> 6, wr = wid >> 1, wc = wid & 1, fr = lane & 15, fq = lane >> 4;
  const int NT = (N + 255) >> 8, MT = MTS >> 1, ntiles = MT * NT, ns = K >> 6;
  const int full = MT >> 3;
  int v = vid0;
  if (v < voff) v += ((voff - v + grid - 1) / grid) * grid;
  const int swz = (fr >> 1) & 7;
  bool pre_issued = false;
  for (; v < voff + ntiles; v += grid) {
    const int w = v - voff;
    int mt, nt;
    if (w < full * 8 * NT) { const int sr = w / (8 * NT), rem = w - sr * 8 * NT; nt = rem >> 3; mt = sr * 8 + (rem & 7); }
    else { const int w2 = w - full * 8 * NT, rl = MT - full * 8; nt = w2 / rl; mt = full * 8 + (w2 - nt * rl); }
    unsigned ap[4], bp[4];
#pragma unroll
    for (int i = 0; i < 4; ++i) {
      const int r = (tid >> 3) + 64 * i;
      const int cs = tid & 7;
      const int c = ((cs ^ ((r >> 1) & 7)) << 3);
      const int sub = 2 * mt + (r >> 7);
      const int g = sub / tpg, ti = sub - g * tpg;
      int rig = ti * step - halo + (r & 127); rig = rig < 0 ? 0 : (rig > grows - 1 ? grows - 1 : rig);
      ap[i] = (unsigned)((g * a_gstride + a_goff + rig) * lda + c);
      int br = nt * 256 + r; br = br > N - 1 ? N - 1 : br;
      bp[i] = (unsigned)(br * K + c);
    }
    const bool have_next = false;
    f32x4 acc[4][8];
#pragma unroll
    for (int m = 0; m < 4; ++m)
#pragma unroll
      for (int n = 0; n < 8; ++n) acc[m][n] = (f32x4){0.f, 0.f, 0.f, 0.f};
    if (!pre_issued) {
#pragma unroll
      for (int i = 0; i < 4; ++i) { GLDS16(A + (size_t)ap[i], smem + tid * 16 + i * 8192); GLDS16(Bt + (size_t)bp[i], smem + 32768 + tid * 16 + i * 8192); }
    }
    pre_issued = have_next;
    for (int st = 0; st < ns; ++st) {
      asm volatile("s_waitcnt vmcnt(0)" ::: "memory");
      __builtin_amdgcn_s_barrier();
      asm volatile("" ::: "memory");
      if (st + 1 < ns) {
        char* nb = smem + ((st + 1) & 1) * 65536;
        const int ko = (st + 1) * 64;
#pragma unroll
        for (int i = 0; i < 4; ++i) { GLDS16(A + (size_t)(ap[i] + ko), nb + tid * 16 + i * 8192); GLDS16(Bt + (size_t)(bp[i] + ko), nb + 32768 + tid * 16 + i * 8192); }
      }
      const char* sa = smem + (st & 1) * 65536 + (wr * 64 + fr) * 128;
      const char* sb = smem + (st & 1) * 65536 + 32768 + (wc * 128 + fr) * 128;
      if constexpr (THIN) {
        if (wc == 0) {
#pragma unroll
          for (int ks = 0; ks < 2; ++ks) {
            bf16x8 af[4], bf[2];
#pragma unroll
            for (int m = 0; m < 4; ++m) af[m] = *(const bf16x8*)(sa + m * 2048 + (((ks * 4 + fq) ^ swz) << 4));
#pragma unroll
            for (int n = 0; n < 2; ++n) bf[n] = *(const bf16x8*)(sb + n * 2048 + (((ks * 4 + fq) ^ swz) << 4));
#pragma unroll
            for (int m = 0; m < 4; ++m)
#pragma unroll
              for (int n = 0; n < 2; ++n)
                acc[m][n] = SWAP ? __builtin_amdgcn_mfma_f32_16x16x32_bf16(bf[n], af[m], acc[m][n], 0, 0, 0)
                                 : __builtin_amdgcn_mfma_f32_16x16x32_bf16(af[m], bf[n], acc[m][n], 0, 0, 0);
          }
        }
      } else {
      bf16x8 afA[4], afB[4], bfb[2][2];
#pragma unroll
      for (int m = 0; m < 4; ++m) afA[m] = *(const bf16x8*)(sa + m * 2048 + ((fq ^ swz) << 4));
#pragma unroll
      for (int n = 0; n < 2; ++n) bfb[0][n] = *(const bf16x8*)(sb + n * 2048 + ((fq ^ swz) << 4));
#pragma unroll
      for (int gq = 0; gq < 8; ++gq) {
        const int ks = gq >> 2, nh = gq & 3;
        if (gq < 7) {
          const int ks2 = (gq + 1) >> 2, nh2 = (gq + 1) & 3;
#pragma unroll
          for (int n = 0; n < 2; ++n) bfb[(gq + 1) & 1][n] = *(const bf16x8*)(sb + (nh2 * 2 + n) * 2048 + (((ks2 * 4 + fq) ^ swz) << 4));
        }
        if (gq == 3) {
#pragma unroll
          for (int m = 0; m < 4; ++m) afB[m] = *(const bf16x8*)(sa + m * 2048 + (((4 + fq) ^ swz) << 4));
        }
        __builtin_amdgcn_sched_barrier(0);
#pragma unroll
        for (int m = 0; m < 4; ++m)
#pragma unroll
          for (int n = 0; n < 2; ++n) {
            const bf16x8 av = ks ? afB[m] : afA[m];
            acc[m][nh * 2 + n] = SWAP ? __builtin_amdgcn_mfma_f32_16x16x32_bf16(bfb[gq & 1][n], av, acc[m][nh * 2 + n], 0, 0, 0)
                                      : __builtin_amdgcn_mfma_f32_16x16x32_bf16(av, bfb[gq & 1][n], acc[m][nh * 2 + n], 0, 0, 0);
          }
      }
      }
    }
    __syncthreads();
    const int te = get_tid512();
    const int fr_e = te & 15, fq_e = (te & 63) >> 4, wr_e = te >> 7, wc_e = (te >> 6) & 1;
    const int sub = 2 * mt + (wr_e >> 1);
    const int g = sub / tpg, ti = sub - g * tpg;
    const int rig0 = ti * step - halo;
    const int rw = (wr_e & 1) * 64;
    if constexpr (Epi::KIND == 0) {
#pragma unroll
      for (int m = 0; m < 4; ++m) {
        const int rig = rig0 + rw + m * 16 + fr_e;
        if constexpr (Epi::ROWSUM) {
          float ss = 0.f;
#pragma unroll
          for (int n = 0; n < 8; ++n) {
            const int col = nt * 256 + wc_e * 128 + n * 16 + fq_e * 4;
            if (col < N) ss += epi.c4(g, rig, col, acc[m][n]);
          }
          ss += __shfl_xor(ss, 16); ss += __shfl_xor(ss, 32);
          if (fq_e == 0) epi.rowsum(g, rig, nt * 2 + wc_e, ss);
        } else {
#pragma unroll
          for (int n = 0; n < 8; ++n) {
            const int col = nt * 256 + wc_e * 128 + n * 16 + fq_e * 4;
            if (col < N) epi.c4(g, rig, col, acc[m][n]);
          }
        }
      }
    } else if constexpr (Epi::KIND == 1) {
#pragma unroll
      for (int m = 0; m < 4; ++m) {
        const int rig = rig0 + rw + m * 16 + fq_e * 4;
#pragma unroll
        for (int n = 0; n < 8; ++n) {
          const int col = nt * 256 + wc_e * 128 + n * 16 + fr_e;
          if (col < N) epi.r4(g, rig, col, acc[m][n]);
        }
      }
    } else {
      bf16_t* Zw = (bf16_t*)smem + ((wr_e >> 1) * 2 + wc_e) * (128 * 132);
      const int nt2w = nt * 2 + wc_e;
#pragma unroll
      for (int n = 0; n < 8; ++n) {
        const int cl = n * 16 + fq_e * 4;
        f32x4 b4 = {0.f, 0.f, 0.f, 0.f};
        if (epi.pre_bias) b4 = *(const f32x4*)(epi.pre_bias + epi.norig(nt2w, cl));
#pragma unroll
        for (int m = 0; m < 4; ++m) {
          const int rl = rw + m * 16 + fr_e;
          const int pos = rig0 + rl;
          const bool ok = pos >= 0 && pos < grows;
          f32x4 vv = acc[m][n] + b4;
          if (!ok) vv = (f32x4){0.f, 0.f, 0.f, 0.f};
          uint2 u; u.x = pack2(vv[0], vv[1]); u.y = pack2(vv[2], vv[3]);
          *(uint2*)(Zw + rl * 132 + cl) = u;
        }
      }
      __syncthreads();
      {
        auto no_pre = []() {};
        const bf16_t* Zr = (const bf16_t*)smem + ((wr_e >> 1) * 2) * (128 * 132);
        epi.finish(Zr, g, rig0, nt * 2, no_pre);
        epi.finish(Zr + 128 * 132, g, rig0, nt * 2 + 1, no_pre);
      }
      __syncthreads();
    }
    asm volatile("s_waitcnt vmcnt(0)" ::: "memory");
    __syncthreads();
  }
}

__device__ __forceinline__ void phase_attn(CP& p, char* smem, int vid0, int grid) {
  bf16_t* Ks = (bf16_t*)smem;
  bf16_t* Vs = (bf16_t*)(smem + 64 * 104 * 2);
  const int tid = get_tid512(), lane = tid & 63, w = tid >> 6, r = lane & 31, hh = lane >> 5;
  const float cs = 1.4426950408889634f * 0.10206207261596577f;
  for (int it = vid0; it < 1024; it += grid) {
    const int qt = it & 7, h = (it >> 3) & 15, b = it >> 7;
    const int t = qt * 256 + w * 32 + r;
    const size_t xrow = (size_t)b * 2048 + t;
    const bf16_t* qp = p.Q + xrow * 1536 + h * 96;
    bf16x8 qf[6];
#pragma unroll
    for (int kk = 0; kk < 4; ++kk) qf[kk] = *(const bf16x8*)(qp + 16 * kk + 8 * hh);
#pragma unroll
    for (int part = 0; part < 2; ++part) {
      const bf16_t* pp = qp + 64 + 16 * part;
      const bf16x8 mine = *(const bf16x8*)(pp + 8 * hh), oth = *(const bf16x8*)(pp + 8 * (1 - hh));
      const float posf = part == 0 ? (float)(t >> 6) : (float)(t & 63);
      union { unsigned u[4]; bf16x8 v; } o;
      float res[8];
#pragma unroll
      for (int j = 0; j < 8; ++j) {
        const float inv = exp2f(-(float)j * (13.287712379549449f / 8.0f));
        const float ang = posf * inv;
        const float c = __cosf(ang), s = __sinf(ang);
        const float m = bf2f((bf16_t)mine[j]), ov = bf2f((bf16_t)oth[j]);
        res[j] = m * c + (hh ? ov : -ov) * s;
      }
#pragma unroll
      for (int j = 0; j < 4; ++j) o.u[j] = pack2(res[2 * j], res[2 * j + 1]);
      qf[4 + part] = o.v;
    }
    f32x16 oacc[2];
#pragma unroll
    for (int i = 0; i < 16; ++i) { oacc[0][i] = 0.f; oacc[1][i] = 0.f; }
    float mrun = -INFINITY, lrun = 0.f;
    const size_t kvrow0 = (size_t)b * 2304;
    const bf16_t* kn_base = p.Kn + kvrow0 * 1024 + h * 64;
    const bf16_t* kpe_base = p.kpe + kvrow0 * 32;
    const bf16_t* vt_base = p.Vt + ((size_t)(b * 16 + h) * 64) * 2304;
    uint4 rk0, rp, rv0;
    rp.x = 0; rp.y = 0; rp.z = 0; rp.w = 0;
    const int srow = tid >> 3, sch = tid & 7;
#define ATT_GLOAD(kt) do { \
      rk0 = *(const uint4*)(kn_base + (size_t)((kt) * 64 + srow) * 1024 + sch * 8); \
      rv0 = *(const uint4*)(vt_base + (size_t)srow * 2304 + (kt) * 64 + sch * 8); \
      if (tid < 256) rp = *(const uint4*)(kpe_base + (size_t)((kt) * 64 + (tid >> 2)) * 32 + (tid & 3) * 8); } while (0)
    ATT_GLOAD(0);
    for (int kt = 0; kt < 36; ++kt) {
      __syncthreads();
      {
        *(uint4*)(Ks + srow * 104 + sch * 8) = rk0;
        uint2 lo, hi;
        lo.x = rv0.x; lo.y = rv0.y; hi.x = rv0.z; hi.y = rv0.w;
        *(uint2*)(Vs + srow * 72 + (sch >> 1) * 16 + (sch & 1) * 4) = lo; *(uint2*)(Vs + srow * 72 + (sch >> 1) * 16 + 8 + (sch & 1) * 4) = hi;
      }
      if (tid < 256) *(uint4*)(Ks + (tid >> 2) * 104 + 64 + (tid & 3) * 8) = rp;
      __syncthreads();
      if (kt + 1 < 36) ATT_GLOAD(kt + 1);
      f32x16 s[2];
#pragma unroll
      for (int t2 = 0; t2 < 2; ++t2) {
#pragma unroll
        for (int i = 0; i < 16; ++i) s[t2][i] = 0.f;
#pragma unroll
        for (int kk = 0; kk < 6; ++kk) {
          const bf16x8 a = *(const bf16x8*)(Ks + (32 * t2 + r) * 104 + 16 * kk + 8 * hh);
          s[t2] = __builtin_amdgcn_mfma_f32_32x32x16_bf16(a, qf[kk], s[t2], 0, 0, 0);
        }
      }
      float mx = s[0][0];
#pragma unroll
      for (int i = 1; i < 16; ++i) mx = fmaxf(mx, s[0][i]);
#pragma unroll
      for (int i = 0; i < 16; ++i) mx = fmaxf(mx, s[1][i]);
      mx = fmaxf(mx, __shfl_xor(mx, 32));
      const float mcand = mx * cs;
      if (__builtin_amdgcn_ballot_w64(mcand > mrun + 6.0f) != 0ull) {
        const float mnew_ = fmaxf(mrun, mcand);
        const float alpha = __builtin_amdgcn_exp2f(mrun - mnew_);
        mrun = mnew_;
        lrun *= alpha;
#pragma unroll
        for (int i = 0; i < 16; ++i) { oacc[0][i] *= alpha; oacc[1][i] *= alpha; }
      }
      const float mnew = mrun;
      float psum = 0.f;
      bf16x8 pf[4];
#pragma unroll
      for (int t2 = 0; t2 < 2; ++t2)
#pragma unroll
        for (int hf = 0; hf < 2; ++hf) {
          union { unsigned u[4]; bf16x8 v; } cvp;
#pragma unroll
          for (int i = 0; i < 4; ++i) {
            const float p0 = __builtin_amdgcn_exp2f(s[t2][hf * 8 + 2 * i] * cs - mnew);
            const float p1 = __builtin_amdgcn_exp2f(s[t2][hf * 8 + 2 * i + 1] * cs - mnew);
            psum += p0 + p1;
            cvp.u[i] = pack2(p0, p1);
          }
          pf[t2 * 2 + hf] = cvp.v;
        }
      lrun += psum;
#pragma unroll
      for (int dt = 0; dt < 2; ++dt)
#pragma unroll
        for (int s4 = 0; s4 < 4; ++s4) {
          const bf16x8 vfr = *(const bf16x8*)(Vs + (32 * dt + r) * 72 + 16 * s4 + 8 * hh);
          oacc[dt] = __builtin_amdgcn_mfma_f32_32x32x16_bf16(vfr, pf[s4], oacc[dt], 0, 0, 0);
        }
    }
    const float ltot = lrun + __shfl_xor(lrun, 32);
    const float inv = 1.f / ltot;
    bf16_t* op = p.hxc + xrow * 1024 + h * 64;
#pragma unroll
    for (int dt = 0; dt < 2; ++dt)
#pragma unroll
      for (int i4 = 0; i4 < 4; ++i4) {
        const int d = 32 * dt + 8 * i4 + 4 * hh;
        uint2 u; u.x = pack2(oacc[dt][4 * i4] * inv, oacc[dt][4 * i4 + 1] * inv); u.y = pack2(oacc[dt][4 * i4 + 2] * inv, oacc[dt][4 * i4 + 3] * inv);
        *(uint2*)(op + d) = u;
      }
  }
}

__device__ __forceinline__ void phase_hyconv(CP& p, char* smem) {
  bf16_t* cp = (bf16_t*)smem;
  bf16_t* Vl = (bf16_t*)(smem + 4 * 8256);
  const int tid = get_tid(), lane = tid & 63, w = tid >> 6, i16 = lane & 15, g4 = lane >> 4;
  const int si = (-i16) & 3;
  const int ocb = 64 * w;
  for (int c = get_bid(); c < 1024; c += VGRID) {
    __syncthreads();
#pragma unroll
    for (int i = 0; i < 2; ++i) { const int ch = tid + 256 * i; *(uint4*)(cp + ch * 8) = *(const uint4*)(p.Rf + (size_t)c * 4096 + ch * 8); }
    {
      const float a0 = p.hy_conv_w[1024 + c], a1 = p.hy_conv_w[3072 + 1024 + c], a2 = p.hy_conv_w[2 * 3072 + 1024 + c], ab = p.hy_conv_b[1024 + c];
      const float v0 = p.hy_conv_w[2048 + c], v1 = p.hy_conv_w[3072 + 2048 + c], v2 = p.hy_conv_w[2 * 3072 + 2048 + c], vb = p.hy_conv_b[2048 + c];
#pragma unroll 2
      for (int i = 0; i < 8; ++i) {
        const int q = tid + 256 * i; const int b = q >> 8, l8 = q & 255; const int m1 = l8 >> 3, m2 = (l8 & 7) * 8;
        const int l0 = l8 * 8;
        const bf16_t* z2 = p.vvT + (size_t)c * 16384 + b * 2048;
        const bf16_t* zv = p.vvT + (size_t)(1024 + c) * 16384 + b * 2048;
        const uint4 u2 = *(const uint4*)(z2 + l0), uv = *(const uint4*)(zv + l0);
        float e2[10], ev[10];
        const int lp = l0 > 0 ? l0 - 1 : 0, ln = l0 + 8 < 2048 ? l0 + 8 : 2047;
        const float pm = l0 > 0 ? 1.f : 0.f, nm = l0 + 8 < 2048 ? 1.f : 0.f;
        const bf16_t q2p = z2[lp], qvp = zv[lp], q2n = z2[ln], qvn = zv[ln];
        e2[0] = bf2f(q2p) * pm; ev[0] = bf2f(qvp) * pm;
        e2[9] = bf2f(q2n) * nm; ev[9] = bf2f(qvn) * nm;
        const unsigned w2[4] = {u2.x, u2.y, u2.z, u2.w}, wv[4] = {uv.x, uv.y, uv.z, uv.w};
#pragma unroll
        for (int j = 0; j < 4; ++j) {
          e2[1 + 2 * j] = __uint_as_float(w2[j] << 16); e2[2 + 2 * j] = __uint_as_float(w2[j] & 0xffff0000u);
          ev[1 + 2 * j] = __uint_as_float(wv[j] << 16); ev[2 + 2 * j] = __uint_as_float(wv[j] & 0xffff0000u);
        }
        unsigned o[4];
#pragma unroll
        for (int j = 0; j < 4; ++j) {
          const float xa = a0 * e2[2 * j] + a1 * e2[2 * j + 1] + a2 * e2[2 * j + 2] + ab;
          const float xb = a0 * e2[2 * j + 1] + a1 * e2[2 * j + 2] + a2 * e2[2 * j + 3] + ab;
          const float ya = v0 * ev[2 * j] + v1 * ev[2 * j + 1] + v2 * ev[2 * j + 2] + vb;
          const float yb = v0 * ev[2 * j + 1] + v1 * ev[2 * j + 2] + v2 * ev[2 * j + 3] + vb;
          o[j] = pack2(xa * ya, xb * yb);
        }
        uint4 ou; ou.x = o[0]; ou.y = o[1]; ou.z = o[2]; ou.w = o[3];
        *(uint4*)(Vl + (8 + m1 * 8 + b) * 80 + m2) = ou;
      }
    }
    if (tid < 144) {
      const int colp = tid / 9, part = tid - colp * 9;
      const int col = colp < 8 ? colp : 256 + colp;
      uint4 zz; zz.x = 0; zz.y = 0; zz.z = 0; zz.w = 0;
      *(uint4*)(Vl + col * 80 + part * 8) = zz;
    }
    __syncthreads();
#pragma unroll
    for (int s = 1; s < 4; ++s)
#pragma unroll
      for (int i = 0; i < 2; ++i) {
        const int ch = tid + 256 * i;
        unsigned e[8];
#pragma unroll
        for (int j = 0; j < 8; ++j) { const int idx = 8 * ch + s + j; e[j] = idx < 4096 ? (unsigned)cp[idx] : 0u; }
        uint4 u; u.x = e[0] | (e[1] << 16); u.y = e[2] | (e[3] << 16); u.z = e[4] | (e[5] << 16); u.w = e[6] | (e[7] << 16);
        *(uint4*)(cp + s * 4128 + 8 * ch) = u;
      }
    __syncthreads();
    const bf16_t* abase = cp + si * 4128 + (2048 - i16 - si + 8 * g4);
    f32x4 acc[4][4];
#pragma unroll
    for (int m = 0; m < 4; ++m)
#pragma unroll
      for (int n = 0; n < 4; ++n) acc[m][n] = (f32x4){0.f, 0.f, 0.f, 0.f};
    for (int dl = -31; dl <= 31; ++dl) {
      bf16x8 af[4][2];
#pragma unroll
      for (int mt = 0; mt < 4; ++mt)
#pragma unroll
        for (int kk = 0; kk < 2; ++kk) {
          const bf16_t* ap = abase - 64 * dl - 16 * mt + 32 * kk;
          const uint2 lo = *(const uint2*)ap, hi = *(const uint2*)(ap + 4);
          union { uint4 u; bf16x8 v; } cv; cv.u.x = lo.x; cv.u.y = lo.y; cv.u.z = hi.x; cv.u.w = hi.y;
          af[mt][kk] = cv.v;
        }
#pragma unroll
      for (int jt = 0; jt < 4; ++jt) {
        const int in0 = ocb + 16 * jt - 8 * dl;
        if (in0 >= -8 && in0 <= 248) {
          const bf16_t* bp = Vl + (in0 + 8 + i16) * 80 + 8 * g4;
          const bf16x8 b0 = *(const bf16x8*)bp, b1 = *(const bf16x8*)(bp + 32);
#pragma unroll
          for (int mt = 0; mt < 4; ++mt) {
            acc[mt][jt] = __builtin_amdgcn_mfma_f32_16x16x32_bf16(af[mt][0], b0, acc[mt][jt], 0, 0, 0);
            acc[mt][jt] = __builtin_amdgcn_mfma_f32_16x16x32_bf16(af[mt][1], b1, acc[mt][jt], 0, 0, 0);
          }
        }
      }
    }
    const float db = p.hy_d_bias[c];
#pragma unroll
    for (int mt = 0; mt < 4; ++mt)
#pragma unroll
      for (int jt = 0; jt < 4; ++jt) {
        const int col = ocb + 16 * jt + i16;
        const int n1 = col >> 3, b = col & 7;
        const int n2 = 16 * mt + 4 * g4;
        const uint2 vv = *(const uint2*)(Vl + (col + 8) * 80 + n2);
        const float y0 = acc[mt][jt][0] + bf2f((bf16_t)(vv.x & 0xffff)) * db;
        const float y1 = acc[mt][jt][1] + bf2f((bf16_t)(vv.x >> 16)) * db;
        const float y2 = acc[mt][jt][2] + bf2f((bf16_t)(vv.y & 0xffff)) * db;
        const float y3 = acc[mt][jt][3] + bf2f((bf16_t)(vv.y >> 16)) * db;
        uint2 u; u.x = pack2(y0, y1); u.y = pack2(y2, y3);
        *(uint2*)(p.Yp + (size_t)c * 16384 + b * 2048 + n1 * 64 + n2) = u;
      }
  }
}

__device__ __forceinline__ void phase_transmul(CP& p, char* smem) {
  bf16_t* tl = (bf16_t*)smem;
  const int tid = get_tid();
  for (int it = get_bid(); it < 4096; it += VGRID) {
    const int ct = it & 15, rt = it >> 4;
    const int c0 = ct * 64, r0 = rt * 64;
    __syncthreads();
#pragma unroll
    for (int i = 0; i < 2; ++i) {
      const int ci = tid + 256 * i; const int cc = ci >> 3, ch = ci & 7;
      const uint4 u = *(const uint4*)(p.Yp + (size_t)(c0 + cc) * 16384 + r0 + ch * 8);
      unsigned* d = (unsigned*)(tl + cc * 66 + ch * 8);
      d[0] = u.x; d[1] = u.y; d[2] = u.z; d[3] = u.w;
    }
    __syncthreads();
    const int row = tid >> 2, cq = tid & 3;
    const int grow = r0 + row, pos = grow & 2047;
    const int cbase = c0 + cq * 16;
    const bf16_t* xp = p.x1h + (size_t)grow * 1024 + cbase;
    uint4 zero4; zero4.x = 0; zero4.y = 0; zero4.z = 0; zero4.w = 0;
    const uint4 xa = *(const uint4*)xp, xb = *(const uint4*)(xp + 8);
    const bf16_t* xpp = pos > 0 ? xp - 1024 : xp;
    const bf16_t* xpn = pos < 2047 ? xp + 1024 : xp;
    const float pmk = pos > 0 ? 1.f : 0.f, nmk = pos < 2047 ? 1.f : 0.f;
    const uint4 pa = *(const uint4*)xpp, pb = *(const uint4*)(xpp + 8);
    const uint4 na = *(const uint4*)xpn, nb = *(const uint4*)(xpn + 8);
    (void)zero4;
    const unsigned xs[8] = {xa.x, xa.y, xa.z, xa.w, xb.x, xb.y, xb.z, xb.w};
    const unsigned ps[8] = {pa.x, pa.y, pa.z, pa.w, pb.x, pb.y, pb.z, pb.w};
    const unsigned ns[8] = {na.x, na.y, na.z, na.w, nb.x, nb.y, nb.z, nb.w};
    unsigned o[8];
#pragma unroll
    for (int j4 = 0; j4 < 4; ++j4) {
      const f32x4 w0 = *(const f32x4*)(p.hy_conv_w + cbase + 4 * j4) * pmk, w1 = *(const f32x4*)(p.hy_conv_w + 3072 + cbase + 4 * j4);
      const f32x4 w2 = *(const f32x4*)(p.hy_conv_w + 2 * 3072 + cbase + 4 * j4) * nmk, wb = *(const f32x4*)(p.hy_conv_b + cbase + 4 * j4);
#pragma unroll
      for (int jj = 0; jj < 2; ++jj) {
        const int j = 2 * j4 + jj;
        const float x0 = w0[2 * jj] * __uint_as_float(ps[j] << 16) + w1[2 * jj] * __uint_as_float(xs[j] << 16) + w2[2 * jj] * __uint_as_float(ns[j] << 16) + wb[2 * jj];
        const float x1 = w0[2 * jj + 1] * __uint_as_float(ps[j] & 0xffff0000u) + w1[2 * jj + 1] * __uint_as_float(xs[j] & 0xffff0000u) + w2[2 * jj + 1] * __uint_as_float(ns[j] & 0xffff0000u) + wb[2 * jj + 1];
        const float y0 = bf2f(tl[(cq * 16 + 2 * j) * 66 + row]) * x0;
        const float y1 = bf2f(tl[(cq * 16 + 2 * j + 1) * 66 + row]) * x1;
        o[j] = pack2(y0, y1);
      }
    }
    bf16_t* op = p.hxc + (size_t)(r0 + row) * 1024 + c0 + cq * 16;
    uint4 oa; oa.x = o[0]; oa.y = o[1]; oa.z = o[2]; oa.w = o[3];
    uint4 ob; ob.x = o[4]; ob.y = o[5]; ob.z = o[6]; ob.w = o[7];
    *(uint4*)op = oa; *(uint4*)(op + 8) = ob;
  }
}

__global__ void __launch_bounds__(512, 2) mega(P p_arg) {
  __shared__ __attribute__((aligned(16))) char smem[LDS_BYTES];
  cg::grid_group grid = cg::this_grid();
  const int G = gridDim.x;
  CP* pp = (CP*)__builtin_amdgcn_kernarg_segment_ptr();
  const int ph0 = pp->ph0, ph1 = pp->ph1;
  volatile LAS unsigned* xst = (volatile LAS unsigned*)(smem + LDS_BYTES - 16);
  if (threadIdx.x == 0) { xst[0] = 0u; xst[1] = 0u; }
  __syncthreads();
  const XcdBarrier xb = xcd_barrier_post(pp->bar, xst);
  if (ph0 <= 0 && 0 < ph1) {
    asm volatile("" : "+s"(pp));
    CP& p = *pp;
    const int bid = get_rbid();
    const int vid0 = (G & 7) ? bid : ((bid & 7) * (G >> 3) + (bid >> 3));
    const int hb = get_hb();
    char* smem_h = smem + hb * HALF_LDS; (void)smem_h;
    const float* mv0 = p.modv; const float* mv1 = p.modv + (size_t)9 * 6144;
    (void)mv0; (void)mv1; (void)vid0;
    phase_prep(p, smem_h);
    if (0 + 1 < ph1) { if (ph1 > 1000) grid.sync(); else xcd_barrier(xb); }
  }
  if (ph0 <= 1 && 1 < ph1) {
    asm volatile("" : "+s"(pp));
    CP& p = *pp;
    const int bid = get_rbid();
    const int vid0 = (G & 7) ? bid : ((bid & 7) * (G >> 3) + (bid >> 3));
    const int hb = get_hb();
    char* smem_h = smem + hb * HALF_LDS; (void)smem_h;
    const float* mv0 = p.modv; const float* mv1 = p.modv + (size_t)9 * 6144;
    (void)mv0; (void)mv1; (void)vid0;
    phase_normmod_kv(p);
    if (1 + 1 < ph1) { if (ph1 > 1000) grid.sync(); else xcd_barrier(xb); }
  }
  if (ph0 <= 2 && 2 < ph1) {
    asm volatile("" : "+s"(pp));
    CP& p = *pp;
    const int bid = get_rbid();
    const int vid0 = (G & 7) ? bid : ((bid & 7) * (G >> 3) + (bid >> 3));
    const int hb = get_hb();
    char* smem_h = smem + hb * HALF_LDS; (void)smem_h;
    const float* mv0 = p.modv; const float* mv1 = p.modv + (size_t)9 * 6144;
    (void)mv0; (void)mv1; (void)vid0;
    {
        EpiDown e1{p.cq, 512, 2048, p.rq, 4, nullptr, 1 << 30};
        gemm_job<true>(smem, p.hxc, 1024, p.wt_dq, 1024, 512, 16, 2304, 256, 128, 0, 2048, 128, 0, vid0, G, e1);
        EpiDown e2{p.kv, 288, 2304, p.rkv, 2, nullptr, 1 << 30};
        gemm_job<true>(smem, p.hxc, 1024, p.wt_dkv, 1024, 256, 18, 2304, 0, 128, 0, 2304, 144, 128, vid0, G, e2);
        EpiFilt e3{p.Rf, p.hy_decay};
        gemm_job<false>(smem, p.h2bf, 64, p.wt_f3, 64, 2048, 16, 0, 0, 128, 0, 2048, 16, 128 + 72, vid0, G, e3);
        EpiDown e4{p.kv, 288, 2304, p.rkv, 0, p.kpe, 0};
        gemm_job<true, EpiDown, true>(smem, p.hxc, 1024, p.wt_dkv + (size_t)256 * 1024, 1024, 32, 18, 2304, 0, 128, 0, 2304, 144, 128 + 72 + 64, vid0, G, e4);
      }
    if (2 + 1 < ph1) { if (ph1 > 1000) grid.sync(); else xcd_barrier(xb); }
  }
  if (ph0 <= 4 && 4 < ph1) {
    asm volatile("" : "+s"(pp));
    CP& p = *pp;
    const int bid = get_rbid();
    const int vid0 = (G & 7) ? bid : ((bid & 7) * (G >> 3) + (bid >> 3));
    const int hb = get_hb();
    char* smem_h = smem + hb * HALF_LDS; (void)smem_h;
    const float* mv0 = p.modv; const float* mv1 = p.modv + (size_t)9 * 6144;
    (void)mv0; (void)mv1; (void)vid0;
    {
        EpiStore<4> e1{p.Q, 1536, 2048, p.rq, 16384, 1.0f / 512.0f};
        gemm_job<true>(smem, p.cq, 512, p.wt_uq, 512, 1536, 16, 2048, 0, 128, 0, 2048, 128, 0, vid0, G, e1);
        EpiStore<2> e2{p.Kn, 1024, 2304, p.rkv, 18432, 1.0f / 256.0f};
        gemm_job<true>(smem, p.kv, 288, p.wt_uk, 256, 1024, 18, 2304, 0, 128, 0, 2304, 144, 64 * 6, vid0, G, e2);
        EpiVt e3{p.Vt, p.rkv};
        gemm_job<false>(smem, p.kv, 288, p.wt_uv, 256, 1024, 18, 2304, 0, 128, 0, 2304, 144, 64 * 6 + 72 * 4, vid0, G, e3);
      }
    if (4 + 1 < ph1) { if (ph1 > 1000) grid.sync(); else xcd_barrier(xb); }
  }
  if (ph0 <= 5 && 5 < ph1) {
    asm volatile("" : "+s"(pp));
    CP& p = *pp;
    const int bid = get_rbid();
    const int vid0 = (G & 7) ? bid : ((bid & 7) * (G >> 3) + (bid >> 3));
    const int hb = get_hb();
    char* smem_h = smem + hb * HALF_LDS; (void)smem_h;
    const float* mv0 = p.modv; const float* mv1 = p.modv + (size_t)9 * 6144;
    (void)mv0; (void)mv1; (void)vid0;
    phase_attn(p, smem, vid0, G);
    if (5 + 1 < ph1) { if (ph1 > 1000) grid.sync(); else xcd_barrier(xb); }
  }
  if (ph0 <= 6 && 6 < ph1) {
    asm volatile("" : "+s"(pp));
    CP& p = *pp;
    const int bid = get_rbid();
    const int vid0 = (G & 7) ? bid : ((bid & 7) * (G >> 3) + (bid >> 3));
    const int hb = get_hb();
    char* smem_h = smem + hb * HALF_LDS; (void)smem_h;
    const float* mv0 = p.modv; const float* mv1 = p.modv + (size_t)9 * 6144;
    (void)mv0; (void)mv1; (void)vid0;
    {
        EpiResid<true> e{p.X16, p.x, mv0 + 2 * 1024, nullptr};
        gemm_job<true>(smem, p.hxc, 1024, p.wt_o, 1024, 1024, 16, 2048, 0, 128, 0, 2048, 128, 0, vid0, G, e);
      }
    if (6 + 1 < ph1) { if (ph1 > 1000) grid.sync(); else xcd_barrier(xb); }
  }
  if (ph0 <= 7 && 7 < ph1) {
    asm volatile("" : "+s"(pp));
    CP& p = *pp;
    const int bid = get_rbid();
    const int vid0 = (G & 7) ? bid : ((bid & 7) * (G >> 3) + (bid >> 3));
    const int hb = get_hb();
    char* smem_h = smem + hb * HALF_LDS; (void)smem_h;
    const float* mv0 = p.modv; const float* mv1 = p.modv + (size_t)9 * 6144;
    (void)mv0; (void)mv1; (void)vid0;
    phase_normmod_x(p, p.norm_ffn_g, 0, 3);
    if (7 + 1 < ph1) { if (ph1 > 1000) grid.sync(); else xcd_barrier(xb); }
  }
  if (ph0 <= 8 && 8 < ph1) {
    asm volatile("" : "+s"(pp));
    CP& p = *pp;
    const int bid = get_rbid();
    const int vid0 = (G & 7) ? bid : ((bid & 7) * (G >> 3) + (bid >> 3));
    const int hb = get_hb();
    char* smem_h = smem + hb * HALF_LDS; (void)smem_h;
    const float* mv0 = p.modv; const float* mv1 = p.modv + (size_t)9 * 6144;
    (void)mv0; (void)mv1; (void)vid0;
    {
        EpiConv<0> e{p.ffn_conv_w, p.ffn_conv_b, 5632, nullptr, p.act, nullptr};
        gemm_job<true>(smem, p.hxc, 1024, p.wt_up0, 1024, 5632, 17, 2048, 0, 126, 1, 2048, 136, 0, vid0, G, e);
      }
    if (8 + 1 < ph1) { if (ph1 > 1000) grid.sync(); else xcd_barrier(xb); }
  }
  if (ph0 <= 9 && 9 < ph1) {
    asm volatile("" : "+s"(pp));
    CP& p = *pp;
    const int bid = get_rbid();
    const int vid0 = (G & 7) ? bid : ((bid & 7) * (G >> 3) + (bid >> 3));
    const int hb = get_hb();
    char* smem_h = smem + hb * HALF_LDS; (void)smem_h;
    const float* mv0 = p.modv; const float* mv1 = p.modv + (size_t)9 * 6144;
    (void)mv0; (void)mv1; (void)vid0;
    {
        EpiResid<false> e{p.X16, p.X16, mv0 + 5 * 1024, nullptr};
        gemm_job<true>(smem, p.act, 2816, p.wt_dn0, 2816, 1024, 16, 2048, 0, 128, 0, 2048, 128, 0, vid0, G, e);
      }
    if (9 + 1 < ph1) { if (ph1 > 1000) grid.sync(); else xcd_barrier(xb); }
  }
  if (ph0 <= 10 && 10 < ph1) {
    asm volatile("" : "+s"(pp));
    CP& p = *pp;
    const int bid = get_rbid();
    const int vid0 = (G & 7) ? bid : ((bid & 7) * (G >> 3) + (bid >> 3));
    const int hb = get_hb();
    char* smem_h = smem + hb * HALF_LDS; (void)smem_h;
    const float* mv0 = p.modv; const float* mv1 = p.modv + (size_t)9 * 6144;
    (void)mv0; (void)mv1; (void)vid0;
    phase_normmod_x(p, p.norm_mix_g + 1024, 1, 0);
    if (10 + 1 < ph1) { if (ph1 > 1000) grid.sync(); else xcd_barrier(xb); }
  }
  if (ph0 <= 11 && 11 < ph1) {
    asm volatile("" : "+s"(pp));
    CP& p = *pp;
    const int bid = get_rbid();
    const int vid0 = (G & 7) ? bid : ((bid & 7) * (G >> 3) + (bid >> 3));
    const int hb = get_hb();
    char* smem_h = smem + hb * HALF_LDS; (void)smem_h;
    const float* mv0 = p.modv; const float* mv1 = p.modv + (size_t)9 * 6144;
    (void)mv0; (void)mv1; (void)vid0;
    {
        EpiBiasStore e1{p.x1h, 1024, p.hy_b_in};
        gemm_job<true>(smem, p.hxc, 1024, p.wt_hin, 1024, 1024, 16, 2048, 0, 128, 0, 2048, 128, 0, vid0, G, e1);
        EpiBiasT e2{p.vvT, p.hy_b_in + 1024};
        gemm_job<false>(smem, p.hxc, 1024, p.wt_hin + (size_t)1024 * 1024, 1024, 2048, 16, 2048, 0, 128, 0, 2048, 128, 64 * 4, vid0, G, e2);
      }
    if (11 + 1 < ph1) { if (ph1 > 1000) grid.sync(); else xcd_barrier(xb); }
  }
  if (ph0 <= 12 && 12 < ph1) {
    asm volatile("" : "+s"(pp));
    CP& p = *pp;
    const int bid = get_rbid();
    const int vid0 = (G & 7) ? bid : ((bid & 7) * (G >> 3) + (bid >> 3));
    const int hb = get_hb();
    char* smem_h = smem + hb * HALF_LDS; (void)smem_h;
    const float* mv0 = p.modv; const float* mv1 = p.modv + (size_t)9 * 6144;
    (void)mv0; (void)mv1; (void)vid0;
    phase_hyconv(p, smem_h);
    if (12 + 1 < ph1) { if (ph1 > 1000) grid.sync(); else xcd_barrier(xb); }
  }
  if (ph0 <= 13 && 13 < ph1) {
    asm volatile("" : "+s"(pp));
    CP& p = *pp;
    const int bid = get_rbid();
    const int vid0 = (G & 7) ? bid : ((bid & 7) * (G >> 3) + (bid >> 3));
    const int hb = get_hb();
    char* smem_h = smem + hb * HALF_LDS; (void)smem_h;
    const float* mv0 = p.modv; const float* mv1 = p.modv + (size_t)9 * 6144;
    (void)mv0; (void)mv1; (void)vid0;
    phase_transmul(p, smem_h);
    if (13 + 1 < ph1) { if (ph1 > 1000) grid.sync(); else xcd_barrier(xb); }
  }
  if (ph0 <= 14 && 14 < ph1) {
    asm volatile("" : "+s"(pp));
    CP& p = *pp;
    const int bid = get_rbid();
    const int vid0 = (G & 7) ? bid : ((bid & 7) * (G >> 3) + (bid >> 3));
    const int hb = get_hb();
    char* smem_h = smem + hb * HALF_LDS; (void)smem_h;
    const float* mv0 = p.modv; const float* mv1 = p.modv + (size_t)9 * 6144;
    (void)mv0; (void)mv1; (void)vid0;
    {
        EpiResid<false> e{p.X16, p.X16, mv1 + 2 * 1024, p.hy_b_out};
        gemm_job<true>(smem, p.hxc, 1024, p.wt_hout, 1024, 1024, 16, 2048, 0, 128, 0, 2048, 128, 0, vid0, G, e);
      }
    if (14 + 1 < ph1) { if (ph1 > 1000) grid.sync(); else xcd_barrier(xb); }
  }
  if (ph0 <= 15 && 15 < ph1) {
    asm volatile("" : "+s"(pp));
    CP& p = *pp;
    const int bid = get_rbid();
    const int vid0 = (G & 7) ? bid : ((bid & 7) * (G >> 3) + (bid >> 3));
    const int hb = get_hb();
    char* smem_h = smem + hb * HALF_LDS; (void)smem_h;
    const float* mv0 = p.modv; const float* mv1 = p.modv + (size_t)9 * 6144;
    (void)mv0; (void)mv1; (void)vid0;
    phase_normmod_x(p, p.norm_ffn_g + 1024, 1, 3);
    if (15 + 1 < ph1) { if (ph1 > 1000) grid.sync(); else xcd_barrier(xb); }
  }
  if (ph0 <= 16 && 16 < ph1) {
    asm volatile("" : "+s"(pp));
    CP& p = *pp;
    const int bid = get_rbid();
    const int vid0 = (G & 7) ? bid : ((bid & 7) * (G >> 3) + (bid >> 3));
    const int hb = get_hb();
    char* smem_h = smem + hb * HALF_LDS; (void)smem_h;
    const float* mv0 = p.modv; const float* mv1 = p.modv + (size_t)9 * 6144;
    (void)mv0; (void)mv1; (void)vid0;
    {
        EpiConv<0> e{p.ffn_conv_w + (size_t)3 * 5632, p.ffn_conv_b + 5632, 5632, nullptr, p.act, nullptr};
        gemm_job<true>(smem, p.hxc, 1024, p.wt_up1, 1024, 5632, 17, 2048, 0, 126, 1, 2048, 136, 0, vid0, G, e);
      }
    if (16 + 1 < ph1) { if (ph1 > 1000) grid.sync(); else xcd_barrier(xb); }
  }
  if (ph0 <= 17 && 17 < ph1) {
    asm volatile("" : "+s"(pp));
    CP& p = *pp;
    const int bid = get_rbid();
    const int vid0 = (G & 7) ? bid : ((bid & 7) * (G >> 3) + (bid >> 3));
    const int hb = get_hb();
    char* smem_h = smem + hb * HALF_LDS; (void)smem_h;
    const float* mv0 = p.modv; const float* mv1 = p.modv + (size_t)9 * 6144;
    (void)mv0; (void)mv1; (void)vid0;
    {
        EpiResid<false> e{p.X16, p.X16, mv1 + 5 * 1024, nullptr};
        gemm_job<true>(smem, p.act, 2816, p.wt_dn1, 2816, 1024, 16, 2048, 0, 128, 0, 2048, 128, 0, vid0, G, e);
      }
    if (17 + 1 < ph1) { if (ph1 > 1000) grid.sync(); else xcd_barrier(xb); }
  }
  if (ph0 <= 18 && 18 < ph1) {
    asm volatile("" : "+s"(pp));
    CP& p = *pp;
    const int bid = get_rbid();
    const int vid0 = (G & 7) ? bid : ((bid & 7) * (G >> 3) + (bid >> 3));
    const int hb = get_hb();
    char* smem_h = smem + hb * HALF_LDS; (void)smem_h;
    const float* mv0 = p.modv; const float* mv1 = p.modv + (size_t)9 * 6144;
    (void)mv0; (void)mv1; (void)vid0;
    phase_final_norm(p);
    if (18 + 1 < ph1) { if (ph1 > 1000) grid.sync(); else xcd_barrier(xb); }
  }
}

extern "C" void kernel_launch(void* const* d_in, const int* in_sizes, int n_in, void* d_out, int out_size, void* d_ws, size_t ws_size, hipStream_t stream) {
  static int grid_blocks = 0;
  if (!grid_blocks) {
    int dev = 0, cus = 0, per_cu = 0;
    hipGetDevice(&dev);
    hipDeviceGetAttribute(&cus, hipDeviceAttributeMultiprocessorCount, dev);
    hipOccupancyMaxActiveBlocksPerMultiprocessor(&per_cu, (const void*)mega, 512, 0);
    per_cu = 1;
    grid_blocks = cus * per_cu;
  }
  P p{};
  const float** in = (const float**)&p;
  for (int i = 0; i < 36; ++i) in[i] = (const float*)d_in[i];
  p.X = (float*)d_out;
  char* ws = (char*)d_ws; size_t off = 0;
  auto take = [&](size_t bytes) { char* r = ws + off; off += (bytes + 255) & ~(size_t)255; return r; };
  p.wt_dq = (bf16_t*)take((size_t)512 * 1024 * 2);
  p.wt_dkv = (bf16_t*)take((size_t)288 * 1024 * 2);
  p.wt_uq = (bf16_t*)take((size_t)1536 * 512 * 2);
  p.wt_uk = (bf16_t*)take((size_t)1024 * 256 * 2);
  p.wt_uv = (bf16_t*)take((size_t)1024 * 256 * 2);
  p.wt_o = (bf16_t*)take((size_t)1024 * 1024 * 2);
  p.wt_hin = (bf16_t*)take((size_t)3072 * 1024 * 2);
  p.wt_hout = (bf16_t*)take((size_t)1024 * 1024 * 2);
  p.wt_up0 = (bf16_t*)take((size_t)5632 * 1024 * 2);
  p.wt_up1 = (bf16_t*)take((size_t)5632 * 1024 * 2);
  p.wt_dn0 = (bf16_t*)take((size_t)1024 * 2816 * 2);
  p.wt_dn1 = (bf16_t*)take((size_t)1024 * 2816 * 2);
  p.modv = (float*)take((size_t)2 * 9 * 6144 * 4);
  p.rq = (float*)take((size_t)4 * 16384 * 4);
  p.rkv = (float*)take((size_t)2 * 18432 * 4);
  p.modp = (float*)take((size_t)4 * 110592 * 4);
  p.bar = (unsigned*)take((size_t)XCD_BAR_WORDS * 4);
  p.wt_f3 = (bf16_t*)take((size_t)2048 * 64 * 2);
  p.h2bf = (bf16_t*)take((size_t)2048 * 64 * 2);
  p.Rf = (bf16_t*)take((size_t)1024 * 4096 * 2);
  p.kpe = (bf16_t*)take((size_t)18432 * 32 * 2);
  p.hxc = (bf16_t*)take((size_t)18432 * 1024 * 2);
  const size_t ubase = off;
  p.cq = (bf16_t*)take((size_t)16384 * 512 * 2);
  p.kv = (bf16_t*)take((size_t)18432 * 288 * 2);
  p.Q = (bf16_t*)take((size_t)16384 * 1536 * 2);
  p.Kn = (bf16_t*)take((size_t)18432 * 1024 * 2);
  p.Vt = (bf16_t*)take((size_t)18432 * 1024 * 2);
  const size_t uend1 = off;
  p.X16 = (bf16_t*)(ws + ubase + (size_t)104857600);
  off = ubase;
  p.act = (bf16_t*)take((size_t)16384 * 2816 * 2);
  off = ubase;
  p.x1h = (bf16_t*)take((size_t)16384 * 1024 * 2);
  p.vvT = (bf16_t*)take((size_t)2 * 16384 * 1024 * 2);
  p.Yp = p.vvT;
  if (uend1 > ws_size) { fprintf(stderr, "workspace too small: need %zu have %zu\n", uend1, ws_size); return; }
  p.ph0 = 0; p.ph1 = NPHASE;
  if (hipMemsetAsync(p.bar, 0, (size_t)XCD_BAR_WORDS * 4, stream) != hipSuccess) { fprintf(stderr, "memset failed\n"); return; }
  void* args[] = {&p};
  hipError_t e = hipLaunchCooperativeKernel((const void*)mega, dim3(grid_blocks), dim3(512), args, 0, stream);
  if (e != hipSuccess) fprintf(stderr, "cooperative launch failed: %s (grid %d)\n", hipGetErrorString(e), grid_blocks);
}
```

```cpp
#include <hip/hip_runtime.h>
#include <hip/hip_cooperative_groups.h>
#include <cstdio>
namespace cg = cooperative_groups;

typedef unsigned short bf16_t;
typedef short bf16x8 __attribute__((ext_vector_type(8)));
typedef float f32x4 __attribute__((ext_vector_type(4)));
typedef float f32x16 __attribute__((ext_vector_type(16)));

#define LDS_BYTES 163840
#define HALF_LDS 81920
#define NPHASE 19

struct P {
  const float *x, *c, *ctx, *c_ctx, *mod_w, *mod_b, *norm_mix_g, *norm_ffn_g;
  const float *w_dq, *g_q, *w_uq, *w_dkv, *g_kv, *w_uk, *w_uv, *w_o;
  const float *hy_w_in, *hy_b_in, *hy_conv_w, *hy_conv_b, *f_w1, *f_b1, *f_freq1, *f_w2, *f_b2, *f_freq2, *f_w3, *hy_decay, *hy_d_bias, *hy_w_out, *hy_b_out;
  const float *ffn_w_up, *ffn_conv_w, *ffn_conv_b, *ffn_w_down, *final_g;
  float* X;
  bf16_t *wt_dq, *wt_dkv, *wt_uq, *wt_uk, *wt_uv, *wt_o, *wt_hin, *wt_hout, *wt_up0, *wt_up1, *wt_dn0, *wt_dn1;
  float *modv, *rq, *rkv, *modp;
  unsigned* bar;
  bf16_t *wt_f3, *h2bf, *X16;
  bf16_t *Rf, *kpe, *hxc, *cq, *kv, *Q, *Kn, *Vt, *act, *x1h, *vvT, *Yp;
  int ph0, ph1;
};

typedef const __attribute__((address_space(4))) P CP;
__device__ __forceinline__ int get_tid512() { int t = threadIdx.x; asm volatile("" : "+v"(t)); return t; }
__device__ __forceinline__ int get_tid() { int t = threadIdx.x & 255; asm volatile("" : "+v"(t)); return t; }
__device__ __forceinline__ int get_hb() { int t = __builtin_amdgcn_readfirstlane((int)(threadIdx.x >> 8)); asm volatile("" : "+s"(t)); return t; }
__device__ __forceinline__ int get_rbid() { int t = blockIdx.x; asm volatile("" : "+s"(t)); return t; }
__device__ __forceinline__ int get_bid() { return 2 * get_rbid() + get_hb(); }
#define VGRID (2 * (int)gridDim.x)

__device__ __forceinline__ unsigned pack2(float a, float b) { unsigned r; asm("v_cvt_pk_bf16_f32 %0, %1, %2" : "=v"(r) : "v"(a), "v"(b)); return r; }
__device__ __forceinline__ bf16_t f2bf(float f) { return (bf16_t)(pack2(f, f) & 0xffffu); }
__device__ __forceinline__ float bf2f(bf16_t h) { return __uint_as_float(((unsigned)h) << 16); }
__device__ __forceinline__ float wave_sum(float v) {
#pragma unroll
  for (int o = 32; o; o >>= 1) v += __shfl_xor(v, o);
  return v;
}


#define XB_TMO      128
#define XB_XCNT(j)  (256  + 64 * (j))
#define XB_XSUB(j)  (1280 + 64 * (j))
#define XB_XGEN(j)  (2304 + 64 * (j))
#define XB_TOP      3328
#define XB_TOPGEN   3392
#define XCD_BAR_WORDS 3456
#define XB_SPIN_CAP (1u << 18)
#define LAS __attribute__((address_space(3)))
__device__ __forceinline__ unsigned xb_ld(unsigned* p)              { return __hip_atomic_load(p, __ATOMIC_RELAXED, __HIP_MEMORY_SCOPE_AGENT); }
__device__ __forceinline__ unsigned xb_add(unsigned* p, unsigned v) { return __hip_atomic_fetch_add(p, v, __ATOMIC_RELAXED, __HIP_MEMORY_SCOPE_AGENT); }
__device__ __forceinline__ unsigned xb_xcc_id() { return (unsigned)__builtin_amdgcn_s_getreg((3 << 11) | 20) & 0xFu; }
#define XB_SPIN(cond, bar) do { unsigned _sp = 0; while (cond) { __builtin_amdgcn_s_sleep(1); \
    if ((++_sp & 255u) == 0u) { if (xb_ld(&(bar)[XB_TMO])) break; if (_sp > XB_SPIN_CAP) { atomicAdd(&(bar)[XB_TMO], 1u); break; } } } } while (0)
struct XcdBarrier { unsigned* bar; unsigned x; volatile LAS unsigned* st; };
__device__ __forceinline__ XcdBarrier xcd_barrier_post(unsigned* bar, volatile LAS unsigned* st) {
    XcdBarrier b; b.bar = bar; b.x = xb_xcc_id(); b.st = st;
    if (threadIdx.x == 0) (void)xb_add(&bar[XB_XCNT(b.x)], 1u);
    return b;
}
__device__ __forceinline__ void xcd_barrier_complete(unsigned* bar, unsigned x, unsigned& nloc, unsigned& nx) {
    const unsigned G = gridDim.x * gridDim.y * gridDim.z;
    unsigned sum, cnt, mine, sp = 0u;
    for (;;) {
        sum = 0u; cnt = 0u; mine = 0u;
#pragma unroll
        for (unsigned j = 0; j < 16; ++j) { const unsigned c = xb_ld(&bar[XB_XCNT(j)]); sum += c; cnt += (c > 0u) ? 1u : 0u; mine = (j == x) ? c : mine; }
        if (sum == G) break;
        __builtin_amdgcn_s_sleep(1);
        if ((++sp & 255u) == 0u) { if (xb_ld(&bar[XB_TMO])) break; if (sp > XB_SPIN_CAP) { atomicAdd(&bar[XB_TMO], 1u); break; } }
    }
    nloc = mine > 0u ? mine : 1u; nx = cnt > 0u ? cnt : 1u;
}
__device__ __forceinline__ void xcd_barrier(const XcdBarrier& b) {
    asm volatile("s_waitcnt vmcnt(0)" ::: "memory");
    __syncthreads();
    if (threadIdx.x == 0) {
        unsigned* bar = b.bar;
        __builtin_amdgcn_s_waitcnt(0);
        unsigned nloc = b.st[0], nx = b.st[1];
        if (nloc == 0u) { xcd_barrier_complete(bar, b.x, nloc, nx); b.st[0] = nloc; b.st[1] = nx; }
        const unsigned old = xb_add(&bar[XB_XSUB(b.x)], 1u);
        const unsigned gen = old / nloc;
        if (old + 1u == (gen + 1u) * nloc) {
            __builtin_amdgcn_fence(__ATOMIC_RELEASE, "agent");
            asm volatile("s_waitcnt vmcnt(0)" ::: "memory");
            const unsigned og = xb_add(&bar[XB_TOP], 1u);
            const unsigned tg = og / nx;
            if (og + 1u == (tg + 1u) * nx) xb_add(&bar[XB_TOPGEN], 1u);
            else XB_SPIN(xb_ld(&bar[XB_TOPGEN]) == tg, bar);
            __builtin_amdgcn_fence(__ATOMIC_ACQUIRE, "agent");
            xb_add(&bar[XB_XGEN(b.x)], 1u);
            asm volatile("s_waitcnt vmcnt(0)" ::: "memory");
        } else {
            XB_SPIN(xb_ld(&bar[XB_XGEN(b.x)]) == gen, bar);
            __builtin_amdgcn_fence(__ATOMIC_ACQUIRE, "agent");
            asm volatile("s_waitcnt vmcnt(0)" ::: "memory");
        }
    }
    __syncthreads();
}

__device__ __forceinline__ void prep_weight_tile(CP& p, char* smem, int wt) {
  const int tid = get_tid();
  int id = 0;
  {
    const int cnt[13] = {64, 40, 96, 32, 32, 128, 384, 128, 704, 704, 352, 352, 32};
#pragma unroll
    for (int i = 0; i < 12; ++i) { if (id == i && wt >= cnt[i]) { wt -= cnt[i]; id = i + 1; } }
  }
  const float* src; int K, N; bf16_t* dst; const float* scale = nullptr; int perm = 0;
  switch (id) {
    case 0: src = p.w_dq; K = 1024; N = 512; dst = p.wt_dq; break;
    case 1: src = p.w_dkv; K = 1024; N = 288; dst = p.wt_dkv; break;
    case 2: src = p.w_uq; K = 512; N = 1536; dst = p.wt_uq; scale = p.g_q; break;
    case 3: src = p.w_uk; K = 256; N = 1024; dst = p.wt_uk; scale = p.g_kv; break;
    case 4: src = p.w_uv; K = 256; N = 1024; dst = p.wt_uv; scale = p.g_kv; break;
    case 5: src = p.w_o; K = 1024; N = 1024; dst = p.wt_o; break;
    case 6: src = p.hy_w_in; K = 1024; N = 3072; dst = p.wt_hin; break;
    case 7: src = p.hy_w_out; K = 1024; N = 1024; dst = p.wt_hout; break;
    case 8: src = p.ffn_w_up; K = 1024; N = 5632; dst = p.wt_up0; perm = 1; break;
    case 9: src = p.ffn_w_up + (size_t)1024 * 5632; K = 1024; N = 5632; dst = p.wt_up1; perm = 1; break;
    case 10: src = p.ffn_w_down; K = 2816; N = 1024; dst = p.wt_dn0; break;
    case 11: src = p.ffn_w_down + (size_t)2816 * 1024; K = 2816; N = 1024; dst = p.wt_dn1; break;
    default: src = p.f_w3; K = 64; N = 2048; dst = p.wt_f3; break;
  }
  const int ntn = (N + 63) >> 6;
  const int kt = wt / ntn, nt = wt - kt * ntn;
  const int k0 = kt * 128, n0 = nt * 64;
  int np0;
  if (perm == 1) { const int half = n0 / 2816, f = n0 - half * 2816; np0 = (f >> 6) * 128 + half * 64; }
  else if (perm == 2) { if (n0 < 1024) np0 = n0; else { const int m = n0 - 1024, half = m >> 10, f = m & 1023; np0 = 1024 + (f >> 6) * 128 + half * 64; } }
  else np0 = n0;
  bf16_t* t16 = (bf16_t*)smem;
  f32x4 v[8];
#pragma unroll
  for (int i = 0; i < 8; ++i) {
    const int idx = tid + 256 * i; const int kr = idx >> 4, c4 = idx & 15;
    v[i] = (f32x4){0.f, 0.f, 0.f, 0.f};
    if (n0 + 4 * c4 < N && k0 + kr < K) v[i] = __builtin_nontemporal_load((const f32x4*)(src + (size_t)(k0 + kr) * N + n0 + 4 * c4));
  }
#pragma unroll
  for (int i = 0; i < 8; ++i) {
    const int idx = tid + 256 * i; const int kr = idx >> 4, c4 = idx & 15;
    const float sc = (scale && k0 + kr < K) ? scale[k0 + kr] : 1.f;
#pragma unroll
    for (int j = 0; j < 4; ++j) t16[(4 * c4 + j) * 136 + kr] = f2bf(v[i][j] * sc);
  }
  __syncthreads();
#pragma unroll
  for (int i = 0; i < 4; ++i) {
    const int idx = tid + 256 * i; const int n = idx >> 4, ch = idx & 15;
    if (n0 + n < N && k0 + ch * 8 < K) *(uint4*)(dst + (size_t)(np0 + n) * K + k0 + ch * 8) = *(const uint4*)(t16 + n * 136 + ch * 8);
  }
  __syncthreads();
}

__device__ __forceinline__ void prep_modvec(CP& p, char* smem, int it) {
  const int tid = get_tid();
  const int layer = it / 384, rem = it - layer * 384, cb = rem >> 2, ks = rem & 3;
  float* s_lds = (float*)smem;
  float* red = (float*)(smem + 12288);
  const int kbase = ks * 256;
  for (int idx = tid; idx < 9 * 256; idx += 256) {
    const int r = idx >> 8, k = idx & 255;
    const float v = r < 8 ? p.c[r * 1024 + kbase + k] : p.c_ctx[kbase + k];
    s_lds[k * 12 + r] = v / (1.f + __expf(-v));
  }
  __syncthreads();
  const int col = cb * 64 + (tid & 63), kg = tid >> 6;
  const float* W = p.mod_w + (size_t)layer * 1024 * 6144 + (size_t)kbase * 6144 + col;
  float acc[9];
#pragma unroll
  for (int r = 0; r < 9; ++r) acc[r] = 0.f;
#pragma unroll
  for (int kb = 0; kb < 4; ++kb) {
    float w[16];
#pragma unroll
    for (int u = 0; u < 16; ++u) w[u] = __builtin_nontemporal_load(W + (size_t)(kg * 64 + kb * 16 + u) * 6144);
#pragma unroll
    for (int u = 0; u < 16; ++u) {
      const int k = kg * 64 + kb * 16 + u;
      const f32x4 s0 = *(const f32x4*)(s_lds + k * 12), s1 = *(const f32x4*)(s_lds + k * 12 + 4);
      const float s2 = s_lds[k * 12 + 8];
      acc[0] += s0[0] * w[u]; acc[1] += s0[1] * w[u]; acc[2] += s0[2] * w[u]; acc[3] += s0[3] * w[u];
      acc[4] += s1[0] * w[u]; acc[5] += s1[1] * w[u]; acc[6] += s1[2] * w[u]; acc[7] += s1[3] * w[u];
      acc[8] += s2 * w[u];
    }
  }
#pragma unroll
  for (int r = 0; r < 9; ++r) red[(kg * 9 + r) * 64 + (tid & 63)] = acc[r];
  __syncthreads();
  for (int o = tid; o < 9 * 64; o += 256) {
    const int r = o >> 6, cl = o & 63;
    const float sm = red[(0 * 9 + r) * 64 + cl] + red[(1 * 9 + r) * 64 + cl] + red[(2 * 9 + r) * 64 + cl] + red[(3 * 9 + r) * 64 + cl];
    p.modp[(size_t)ks * 110592 + (size_t)(layer * 9 + r) * 6144 + cb * 64 + cl] = sm;
  }
  __syncthreads();
}

__device__ __forceinline__ void prep_filter(CP& p, char* smem, int it) {
  const int tid = get_tid();
  float* z = (float*)smem;
  float* h1 = z + 8 * 33;
  float* h2 = h1 + 8 * 64;
  const int t0 = it * 8;
  for (int idx = tid; idx < 8 * 33; idx += 256) {
    const int pp = idx / 33, i = idx - pp * 33;
    const int t = t0 + pp;
    float v;
    if (i == 0) v = (float)t * (1.0f / 2047.0f);
    else {
      const int k = (i - 1) & 15;
      const float w = (6.283185307179586f * (float)t) / 2048.0f;
      const float f = 1e-4f + (float)k * ((15.0f - 1e-4f) / 15.0f);
      const float a = w * f;
      v = (i <= 16) ? __cosf(a) : -__sinf(a);
    }
    z[idx] = v;
  }
  __syncthreads();
  for (int idx = tid; idx < 8 * 64; idx += 256) {
    const int pp = idx >> 6, j = idx & 63;
    float s = p.f_b1[j];
#pragma unroll
    for (int i = 0; i < 33; ++i) s += z[pp * 33 + i] * p.f_w1[i * 64 + j];
    h1[idx] = __sinf(p.f_freq1[j] * s);
  }
  __syncthreads();
  for (int idx = tid; idx < 8 * 64; idx += 256) {
    const int pp = idx >> 6, j = idx & 63;
    float s = p.f_b2[j];
#pragma unroll 16
    for (int i = 0; i < 64; ++i) s += h1[pp * 64 + i] * p.f_w2[i * 64 + j];
    h2[idx] = __sinf(p.f_freq2[j] * s);
  }
  __syncthreads();
  for (int idx = tid; idx < 8 * 64; idx += 256) p.h2bf[(size_t)t0 * 64 + idx] = f2bf(h2[idx]);
  __syncthreads();
}

__device__ __forceinline__ void phase_prep(CP& p, char* smem) {
  const int total = 768 + 256 + 3048;
  for (int it = get_bid(); it < total; it += VGRID) {
    if (it < 768) prep_modvec(p, smem, it);
    else if (it < 1024) prep_filter(p, smem, it - 768);
    else prep_weight_tile(p, smem, it - 1024);
  }
}

__device__ __forceinline__ f32x4 ld4_bf16(const bf16_t* p) {
  const uint2 u = *(const uint2*)p;
  f32x4 r; r[0] = bf2f((bf16_t)(u.x & 0xffff)); r[1] = bf2f((bf16_t)(u.x >> 16)); r[2] = bf2f((bf16_t)(u.y & 0xffff)); r[3] = bf2f((bf16_t)(u.y >> 16));
  return r;
}
template <bool PART, bool SRC16 = false>
__device__ __forceinline__ void normmod_row2(const void* __restrict__ srcv, const float* __restrict__ g, const float* __restrict__ sh, const float* __restrict__ sc, bf16_t* __restrict__ dst, int lane, const float* __restrict__ bsh = nullptr) {
  f32x4 v[2][4]; float ss0 = 0.f, ss1 = 0.f;
#pragma unroll
  for (int i = 0; i < 4; ++i) {
    if (SRC16) { v[0][i] = ld4_bf16((const bf16_t*)srcv + lane * 4 + 256 * i); v[1][i] = ld4_bf16((const bf16_t*)srcv + 1024 + lane * 4 + 256 * i); }
    else { v[0][i] = *(const f32x4*)((const float*)srcv + lane * 4 + 256 * i); v[1][i] = *(const f32x4*)((const float*)srcv + 1024 + lane * 4 + 256 * i); }
  }
#pragma unroll
  for (int i = 0; i < 4; ++i) {
    ss0 += v[0][i][0] * v[0][i][0] + v[0][i][1] * v[0][i][1] + v[0][i][2] * v[0][i][2] + v[0][i][3] * v[0][i][3];
    ss1 += v[1][i][0] * v[1][i][0] + v[1][i][1] * v[1][i][1] + v[1][i][2] * v[1][i][2] + v[1][i][3] * v[1][i][3];
  }
  ss0 = wave_sum(ss0); ss1 = wave_sum(ss1);
  const float r0 = rsqrtf(ss0 * (1.0f / 1024.0f) + 1e-6f), r1 = rsqrtf(ss1 * (1.0f / 1024.0f) + 1e-6f);
#pragma unroll
  for (int i = 0; i < 4; ++i) {
    const int k = lane * 4 + 256 * i;
    const f32x4 g4 = *(const f32x4*)(g + k);
    f32x4 s4 = *(const f32x4*)(sh + k), c4 = *(const f32x4*)(sc + k);
    if (PART) {
#pragma unroll
      for (int q = 1; q < 4; ++q) { s4 += *(const f32x4*)(sh + (size_t)q * 110592 + k); c4 += *(const f32x4*)(sc + (size_t)q * 110592 + k); }
      s4 += *(const f32x4*)(bsh + k); c4 += *(const f32x4*)(bsh + 1024 + k);
    }
    float y[4], z[4];
#pragma unroll
    for (int j = 0; j < 4; ++j) { const float gm = g4[j] * (1.f + c4[j]); y[j] = (v[0][i][j] * r0) * gm + s4[j]; z[j] = (v[1][i][j] * r1) * gm + s4[j]; }
    uint2 u; u.x = pack2(y[0], y[1]); u.y = pack2(y[2], y[3]);
    *(uint2*)(dst + k) = u;
    u.x = pack2(z[0], z[1]); u.y = pack2(z[2], z[3]);
    *(uint2*)(dst + 1024 + k) = u;
  }
}

__device__ __forceinline__ void phase_normmod_kv(CP& p) {
  const int lane = get_tid() & 63, wv = get_tid() >> 6;
  const float* g = p.norm_mix_g;
  for (int idx = get_bid() * 256 + get_tid(); idx < 110592; idx += VGRID * 256) {
    const int lr = idx / 6144; const int n = idx - lr * 6144; const int layer = lr / 9;
    p.modv[idx] = p.modp[idx] + p.modp[110592 + idx] + p.modp[2 * 110592 + idx] + p.modp[3 * 110592 + idx] + p.mod_b[layer * 6144 + n];
  }
  for (int r = (get_bid() * 4 + wv) * 2; r < 18432; r += VGRID * 8) {
    const int b = r / 2304, pp = r - b * 2304;
    const float* src; const float* mv;
    if (pp < 256) { src = p.ctx + ((size_t)b * 256 + pp) * 1024; mv = p.modp + (size_t)8 * 6144; }
    else { src = p.x + ((size_t)b * 2048 + pp - 256) * 1024; mv = p.modp + (size_t)b * 6144; }
    normmod_row2<true>(src, g, mv, mv + 1024, p.hxc + (size_t)r * 1024, lane, p.mod_b);
  }
}
__device__ __forceinline__ void phase_normmod_x(CP& p, const float* g, int layer, int chunk) {
  const int lane = get_tid() & 63, wv = get_tid() >> 6;
  for (int r = (get_bid() * 4 + wv) * 2; r < 16384; r += VGRID * 8) {
    const int b = r >> 11;
    const float* mv = p.modv + (size_t)(layer * 9 + b) * 6144 + chunk * 1024;
    normmod_row2<false, true>(p.X16 + (size_t)r * 1024, g, mv, mv + 1024, p.hxc + (size_t)r * 1024, lane);
  }
}
__device__ __forceinline__ void phase_final_norm(CP& p) {
  const int lane = get_tid() & 63, wv = get_tid() >> 6;
  for (int r = get_bid() * 4 + wv; r < 16384; r += VGRID * 4) {
    const bf16_t* srow = p.X16 + (size_t)r * 1024;
    float* row = p.X + (size_t)r * 1024;
    f32x4 v[4]; float ss = 0.f;
#pragma unroll
    for (int i = 0; i < 4; ++i) { v[i] = ld4_bf16(srow + lane * 4 + 256 * i); ss += v[i][0] * v[i][0] + v[i][1] * v[i][1] + v[i][2] * v[i][2] + v[i][3] * v[i][3]; }
    ss = wave_sum(ss);
    const float rr = rsqrtf(ss * (1.0f / 1024.0f) + 1e-6f);
#pragma unroll
    for (int i = 0; i < 4; ++i) {
      const int k = lane * 4 + 256 * i;
      const f32x4 g4 = *(const f32x4*)(p.final_g + k);
      f32x4 o; o[0] = v[i][0] * rr * g4[0]; o[1] = v[i][1] * rr * g4[1]; o[2] = v[i][2] * rr * g4[2]; o[3] = v[i][3] * rr * g4[3];
      *(f32x4*)(row + k) = o;
    }
  }
}

__device__ __forceinline__ void phase_rowstat(CP& p) {
  const int lane = get_tid() & 63, wv = get_tid() >> 6;
  for (int r = get_bid() * 4 + wv; r < 18432; r += VGRID * 4) {
    const int b = r / 2304, pp = r - b * 2304;
    const bf16_t* kvr = p.kv + (size_t)r * 288;
    {
      const uint2 u = *(const uint2*)(kvr + lane * 4);
      const float a0 = bf2f((bf16_t)(u.x & 0xffff)), a1 = bf2f((bf16_t)(u.x >> 16)), a2 = bf2f((bf16_t)(u.y & 0xffff)), a3 = bf2f((bf16_t)(u.y >> 16));
      float ss = a0 * a0 + a1 * a1 + a2 * a2 + a3 * a3;
      ss = wave_sum(ss);
      if (lane == 0) p.rkv[r] = rsqrtf(ss * (1.0f / 256.0f) + 1e-6f);
    }
    {
      const int i = lane & 31;
      const float xv = bf2f(kvr[256 + i]);
      const float ov = __shfl_xor(xv, 8);
      float res = xv;
      if (pp >= 256) {
        const int t = pp - 256;
        const int quarter = i >> 3, idx = i & 7;
        const float pos = (quarter < 2) ? (float)(t >> 6) : (float)(t & 63);
        const float inv = exp2f(-(float)idx * (13.287712379549449f / 8.0f));
        const float ang = pos * inv;
        const float cs = __cosf(ang), sn = __sinf(ang);
        res = xv * cs + ((quarter & 1) ? ov : -ov) * sn;
      }
      if (lane < 32) p.kpe[(size_t)r * 32 + i] = f2bf(res);
    }
    if (pp >= 256) {
      const int xr = b * 2048 + pp - 256;
      const uint4 u = *(const uint4*)(p.cq + (size_t)xr * 512 + lane * 8);
      const unsigned uu[4] = {u.x, u.y, u.z, u.w};
      float ss = 0.f;
#pragma unroll
      for (int j = 0; j < 4; ++j) { const float a = bf2f((bf16_t)(uu[j] & 0xffff)), bb = bf2f((bf16_t)(uu[j] >> 16)); ss += a * a + bb * bb; }
      ss = wave_sum(ss);
      if (lane == 0) p.rq[xr] = rsqrtf(ss * (1.0f / 512.0f) + 1e-6f);
    }
  }
}

template <int NP>
struct EpiStore {
  static constexpr int KIND = 0; static constexpr bool ROWSUM = false;
  bf16_t* out; int ld; int ostride; const float* part; int pstride; float inv_n;
  __device__ __forceinline__ void c4(int g, int rig, int col, f32x4 v) const {
    const size_t row = (size_t)g * ostride + rig;
    float s = 1.f;
    if (NP > 0) {
      float t = 0.f;
#pragma unroll
      for (int q = 0; q < NP; ++q) t += part[(size_t)q * pstride + row];
      s = rsqrtf(t * inv_n + 1e-6f);
    }
    uint2 u; u.x = pack2(v[0] * s, v[1] * s); u.y = pack2(v[2] * s, v[3] * s);
    *(uint2*)(out + row * ld + col) = u;
  }
};
struct EpiDown {
  static constexpr int KIND = 0; static constexpr bool ROWSUM = true;
  bf16_t* out; int ld; int ostride; float* part; int nslots; bf16_t* kpe; int ropecol;
  __device__ __forceinline__ float c4(int g, int rig, int col, f32x4 v) const {
    const size_t row = (size_t)g * ostride + rig;
    if (kpe && col >= ropecol) {
      const int i0 = col - ropecol;
      f32x4 o = v;
      const float p0 = __shfl_xor(v[0], 32), p1 = __shfl_xor(v[1], 32), p2 = __shfl_xor(v[2], 32), p3 = __shfl_xor(v[3], 32);
      const float pv[4] = {p0, p1, p2, p3};
      if (rig >= 256) {
        const int t = rig - 256;
        const int quarter = i0 >> 3;
        const float pos = (quarter < 2) ? (float)(t >> 6) : (float)(t & 63);
#pragma unroll
        for (int j = 0; j < 4; ++j) {
          const int idx = (i0 & 7) + j;
          const float inv = exp2f(-(float)idx * (13.287712379549449f / 8.0f));
          const float ang = pos * inv;
          const float cs = __cosf(ang), sn = __sinf(ang);
          o[j] = v[j] * cs + ((quarter & 1) ? pv[j] : -pv[j]) * sn;
        }
      }
      uint2 u; u.x = pack2(o[0], o[1]); u.y = pack2(o[2], o[3]);
      *(uint2*)(kpe + row * 32 + i0) = u;
      return 0.f;
    }
    uint2 u; u.x = pack2(v[0], v[1]); u.y = pack2(v[2], v[3]);
    *(uint2*)(out + row * ld + col) = u;
    return v[0] * v[0] + v[1] * v[1] + v[2] * v[2] + v[3] * v[3];
  }
  __device__ __forceinline__ void rowsum(int g, int rig, int slot, float ss) const {
    if (slot < nslots) part[(size_t)slot * ((size_t)8 * ostride) + (size_t)g * ostride + rig] = ss;
  }
};
struct EpiVt {
  static constexpr int KIND = 1;
  bf16_t* out; const float* part;
  __device__ __forceinline__ void r4(int g, int rig, int col, f32x4 v) const {
    const size_t row = (size_t)g * 2304 + rig;
    const f32x4 t = *(const f32x4*)(part + row) + *(const f32x4*)(part + 18432 + row);
    f32x4 s;
#pragma unroll
    for (int j = 0; j < 4; ++j) s[j] = rsqrtf(t[j] * (1.0f / 256.0f) + 1e-6f);
    uint2 u; u.x = pack2(v[0] * s[0], v[1] * s[1]); u.y = pack2(v[2] * s[2], v[3] * s[3]);
    *(uint2*)(out + ((size_t)g * 1024 + col) * 2304 + rig) = u;
  }
};
struct EpiBiasStore {
  static constexpr int KIND = 0; static constexpr bool ROWSUM = false;
  bf16_t* out; int ld; const float* bias;
  __device__ __forceinline__ void c4(int g, int rig, int col, f32x4 v) const {
    const size_t row = (size_t)g * 2048 + rig;
    const f32x4 b4 = *(const f32x4*)(bias + col);
    uint2 u; u.x = pack2(v[0] + b4[0], v[1] + b4[1]); u.y = pack2(v[2] + b4[2], v[3] + b4[3]);
    *(uint2*)(out + row * ld + col) = u;
  }
};
struct EpiBiasT {
  static constexpr int KIND = 1;
  bf16_t* out; const float* bias;
  __device__ __forceinline__ void r4(int g, int rig, int col, f32x4 v) const {
    const float b = bias[col];
    uint2 u; u.x = pack2(v[0] + b, v[1] + b); u.y = pack2(v[2] + b, v[3] + b);
    *(uint2*)(out + (size_t)col * 16384 + (size_t)g * 2048 + rig) = u;
  }
};
struct EpiFilt {
  static constexpr int KIND = 1;
  bf16_t* Rf; const float* decay;
  __device__ __forceinline__ void r4(int g, int rig, int col, f32x4 v) const {
    const int c = col & 1023; const bool bwd = col >= 1024;
    const float dec = fabsf(decay[c]);
    bf16_t* rp = Rf + (size_t)c * 4096;
#pragma unroll
    for (int j = 0; j < 4; ++j) {
      const int t = rig + j;
      const float val = v[j] * __expf(-(float)t * (1.0f / 2047.0f) * dec);
      if (!bwd) rp[2048 - t] = f2bf(val);
      else if (t > 0) rp[2048 + t] = f2bf(val);
      else rp[0] = 0;
    }
  }
};
template <bool BASE_F32>
struct EpiResid {
  static constexpr int KIND = 0; static constexpr bool ROWSUM = false;
  bf16_t* X16; const void* base; const float* gate; const float* bias;
  __device__ __forceinline__ void c4(int g, int rig, int col, f32x4 v) const {
    const size_t o = ((size_t)g * 2048 + rig) * 1024 + col;
    f32x4 bs;
    if (BASE_F32) bs = *(const f32x4*)((const float*)base + o);
    else {
      const uint2 u = *(const uint2*)((const bf16_t*)base + o);
      bs[0] = bf2f((bf16_t)(u.x & 0xffff)); bs[1] = bf2f((bf16_t)(u.x >> 16)); bs[2] = bf2f((bf16_t)(u.y & 0xffff)); bs[3] = bf2f((bf16_t)(u.y >> 16));
    }
    const f32x4 gt = *(const f32x4*)(gate + (size_t)g * 6144 + col);
    f32x4 bi = {0.f, 0.f, 0.f, 0.f};
    if (bias) bi = *(const f32x4*)(bias + col);
    f32x4 r;
#pragma unroll
    for (int j = 0; j < 4; ++j) r[j] = bs[j] + gt[j] * (v[j] + bi[j]);
    uint2 w; w.x = pack2(r[0], r[1]); w.y = pack2(r[2], r[3]);
    *(uint2*)(X16 + o) = w;
  }
};
template <int MODE>
struct EpiConv {
  static constexpr int KIND = 2;
  const float* cw; const float* cb; int NC; const float* pre_bias;
  bf16_t* o0; bf16_t* o1;
  __device__ __forceinline__ int norig(int nt, int cl) const {
    if (MODE == 0) return (cl >> 6) * 2816 + nt * 64 + (cl & 63);
    if (nt < 8) return nt * 128 + cl;
    return 1024 + (cl >> 6) * 1024 + (nt - 8) * 64 + (cl & 63);
  }
  typedef float f32x2_t __attribute__((ext_vector_type(2)));
  static __device__ __forceinline__ f32x2_t ldz(const bf16_t* Z, int row, int col) {
    const unsigned u = *(const unsigned*)(Z + row * 132 + col);
    f32x2_t r; r[0] = __uint_as_float(u << 16); r[1] = __uint_as_float(u & 0xffff0000u); return r;
  }
  template <class F>
  __device__ __forceinline__ void finish(const bf16_t* Z, int g, int rig0, int nt, F&& pre) const {
    typedef f32x2_t f32x2;
    const int tid = get_tid();
    if (MODE == 0 || nt < 8) {
      if (MODE == 0) {
        const int f2 = (tid & 31) * 2, q8 = tid >> 5;
        const int q0 = 1 + 16 * q8, q1 = (q0 + 16 < 127) ? q0 + 16 : 127;
        const int na = norig(nt, f2), ng = norig(nt, 64 + f2);
        const f32x2 a0 = *(const f32x2*)(cw + na), a1 = *(const f32x2*)(cw + NC + na), a2 = *(const f32x2*)(cw + 2 * NC + na), ab = *(const f32x2*)(cb + na);
        const f32x2 g0 = *(const f32x2*)(cw + ng), g1 = *(const f32x2*)(cw + NC + ng), g2 = *(const f32x2*)(cw + 2 * NC + ng), gb = *(const f32x2*)(cb + ng);
        pre();
        f32x2 am = ldz(Z, q0 - 1, f2), ac = ldz(Z, q0, f2);
        f32x2 gm = ldz(Z, q0 - 1, 64 + f2), gc = ldz(Z, q0, 64 + f2);
#pragma unroll 4
        for (int pl = q0; pl < q1; ++pl) {
          const f32x2 an = ldz(Z, pl + 1, f2), gn = ldz(Z, pl + 1, 64 + f2);
          const int pos = rig0 + pl;
          if (pos < 2048) {
            const f32x2 av = a0 * am + a1 * ac + a2 * an + ab;
            const f32x2 gv = g0 * gm + g1 * gc + g2 * gn + gb;
            const float s0 = av[0] * gv[0] * __builtin_amdgcn_rcpf(1.f + __expf(-gv[0]));
            const float s1 = av[1] * gv[1] * __builtin_amdgcn_rcpf(1.f + __expf(-gv[1]));
            *(unsigned*)(o0 + ((size_t)g * 2048 + pos) * 2816 + nt * 64 + f2) = pack2(s0, s1);
          }
          am = ac; ac = an; gm = gc; gc = gn;
        }
      } else {
        const int cl = (tid & 63) * 2, q = tid >> 6;
        const int p0 = 1 + 32 * q, p1 = (p0 + 32 < 127) ? p0 + 32 : 127;
        const int na = norig(nt, cl);
        const f32x2 a0 = *(const f32x2*)(cw + na), a1 = *(const f32x2*)(cw + NC + na), a2 = *(const f32x2*)(cw + 2 * NC + na), ab = *(const f32x2*)(cb + na);
        pre();
        f32x2 am = ldz(Z, p0 - 1, cl), ac = ldz(Z, p0, cl);
#pragma unroll 2
        for (int pl = p0; pl < p1; ++pl) {
          const f32x2 an = ldz(Z, pl + 1, cl);
          const int pos = rig0 + pl;
          if (pos < 2048) {
            const f32x2 av = a0 * am + a1 * ac + a2 * an + ab;
            *(unsigned*)(o0 + ((size_t)g * 2048 + pos) * 1024 + nt * 128 + cl) = pack2(av[0], av[1]);
          }
          am = ac; ac = an;
        }
      }
    } else {
      pre();
      const int pl = tid & 127, fh = tid >> 7;
      const int pos = rig0 + pl;
      if (pl >= 1 && pl <= 126 && pos < 2048) {
        const int fb = nt - 8;
#pragma unroll 2
        for (int f = fh * 32; f < fh * 32 + 32; f += 2) {
          const int na = norig(nt, f), nb = norig(nt, 64 + f);
          const f32x2 va = *(const f32x2*)(cw + na) * ldz(Z, pl - 1, f) + *(const f32x2*)(cw + NC + na) * ldz(Z, pl, f)
                         + *(const f32x2*)(cw + 2 * NC + na) * ldz(Z, pl + 1, f) + *(const f32x2*)(cb + na);
          const f32x2 vb = *(const f32x2*)(cw + nb) * ldz(Z, pl - 1, 64 + f) + *(const f32x2*)(cw + NC + nb) * ldz(Z, pl, 64 + f)
                         + *(const f32x2*)(cw + 2 * NC + nb) * ldz(Z, pl + 1, 64 + f) + *(const f32x2*)(cb + nb);
          bf16_t* op = o1 + (size_t)(fb * 64 + f) * 16384 + g * 2048 + pos;
          op[0] = f2bf(va[0] * vb[0]);
          op[16384] = f2bf(va[1] * vb[1]);
        }
      }
    }
  }
};

#define GLDS16(gp, lp) __builtin_amdgcn_global_load_lds((const unsigned*)(gp), (__attribute__((address_space(3))) unsigned*)(lp), 16, 0, 0)

template <bool SWAP, class Epi, bool THIN = false>
__device__ __forceinline__ void gemm_job(char* smem, const bf16_t* __restrict__ A, int lda, const bf16_t* __restrict__ Bt, int K, int N,
                                         int tpg, int a_gstride, int a_goff, int step, int halo, int grows, int MTS, int voff, int vid0, int grid, const Epi& epi) {
  const int tid = get_tid512(), lane = tid & 63, wid = tid >> 6, wr = wid >> 1, wc = wid & 1, fr = lane & 15, fq = lane >> 4;
  const int NT = (N + 255) >> 8, MT = MTS >> 1, ntiles = MT * NT, ns = K >> 6;
  const int full = MT >> 3;
  int v = vid0;
  if (v < voff) v += ((voff - v + grid - 1) / grid) * grid;
  const int swz = (fr >> 1) & 7;
  bool pre_issued = false;
  for (; v < voff + ntiles; v += grid) {
    const int w = v - voff;
    int mt, nt;
    if (w < full * 8 * NT) { const int sr = w / (8 * NT), rem = w - sr * 8 * NT; nt = rem >> 3; mt = sr * 8 + (rem & 7); }
    else { const int w2 = w - full * 8 * NT, rl = MT - full * 8; nt = w2 / rl; mt = full * 8 + (w2 - nt * rl); }
    unsigned ap[4], bp[4];
#pragma unroll
    for (int i = 0; i < 4; ++i) {
      const int r = (tid >> 3) + 64 * i;
      const int cs = tid & 7;
      const int c = ((cs ^ ((r >> 1) & 7)) << 3);
      const int sub = 2 * mt + (r >> 7);
      const int g = sub / tpg, ti = sub - g * tpg;
      int rig = ti * step - halo + (r & 127); rig = rig < 0 ? 0 : (rig > grows - 1 ? grows - 1 : rig);
      ap[i] = (unsigned)((g * a_gstride + a_goff + rig) * lda + c);
      int br = nt * 256 + r; br = br > N - 1 ? N - 1 : br;
      bp[i] = (unsigned)(br * K + c);
    }
    const bool have_next = false;
    f32x4 acc[4][8];
#pragma unroll
    for (int m = 0; m < 4; ++m)
#pragma unroll
      for (int n = 0; n < 8; ++n) acc[m][n] = (f32x4){0.f, 0.f, 0.f, 0.f};
    if (!pre_issued) {
#pragma unroll
      for (int i = 0; i < 4; ++i) { GLDS16(A + (size_t)ap[i], smem + tid * 16 + i * 8192); GLDS16(Bt + (size_t)bp[i], smem + 32768 + tid * 16 + i * 8192); }
    }
    pre_issued = have_next;
    for (int st = 0; st < ns; ++st) {
      asm volatile("s_waitcnt vmcnt(0)" ::: "memory");
      __builtin_amdgcn_s_barrier();
      asm volatile("" ::: "memory");
      if (st + 1 < ns) {
        char* nb = smem + ((st + 1) & 1) * 65536;
        const int ko = (st + 1) * 64;
#pragma unroll
        for (int i = 0; i < 4; ++i) { GLDS16(A + (size_t)(ap[i] + ko), nb + tid * 16 + i * 8192); GLDS16(Bt + (size_t)(bp[i] + ko), nb + 32768 + tid * 16 + i * 8192); }
      }
      const char* sa = smem + (st & 1) * 65536 + (wr * 64 + fr) * 128;
      const char* sb = smem + (st & 1) * 65536 + 32768 + (wc * 128 + fr) * 128;
      if constexpr (THIN) {
        if (wc == 0) {
#pragma unroll
          for (int ks = 0; ks < 2; ++ks) {
            bf16x8 af[4], bf[2];
#pragma unroll
            for (int m = 0; m < 4; ++m) af[m] = *(const bf16x8*)(sa + m * 2048 + (((ks * 4 + fq) ^ swz) << 4));
#pragma unroll
            for (int n = 0; n < 2; ++n) bf[n] = *(const bf16x8*)(sb + n * 2048 + (((ks * 4 + fq) ^ swz) << 4));
#pragma unroll
            for (int m = 0; m < 4; ++m)
#pragma unroll
              for (int n = 0; n < 2; ++n)
                acc[m][n] = SWAP ? __builtin_amdgcn_mfma_f32_16x16x32_bf16(bf[n], af[m], acc[m][n], 0, 0, 0)
                                 : __builtin_amdgcn_mfma_f32_16x16x32_bf16(af[m], bf[n], acc[m][n], 0, 0, 0);
          }
        }
      } else {
      bf16x8 afA[4], afB[4], bfb[2][2];
#pragma unroll
      for (int m = 0; m < 4; ++m) afA[m] = *(const bf16x8*)(sa + m * 2048 + ((fq ^ swz) << 4));
#pragma unroll
      for (int n = 0; n < 2; ++n) bfb[0][n] = *(const bf16x8*)(sb + n * 2048 + ((fq ^ swz) << 4));
#pragma unroll
      for (int gq = 0; gq < 8; ++gq) {
        const int ks = gq >> 2, nh = gq & 3;
        if (gq < 7) {
          const int ks2 = (gq + 1) >> 2, nh2 = (gq + 1) & 3;
#pragma unroll
          for (int n = 0; n < 2; ++n) bfb[(gq + 1) & 1][n] = *(const bf16x8*)(sb + (nh2 * 2 + n) * 2048 + (((ks2 * 4 + fq) ^ swz) << 4));
        }
        if (gq == 3) {
#pragma unroll
          for (int m = 0; m < 4; ++m) afB[m] = *(const bf16x8*)(sa + m * 2048 + (((4 + fq) ^ swz) << 4));
        }
        __builtin_amdgcn_sched_barrier(0);
#pragma unroll
        for (int m = 0; m < 4; ++m)
#pragma unroll
          for (int n = 0; n < 2; ++n) {
            const bf16x8 av = ks ? afB[m] : afA[m];
            acc[m][nh * 2 + n] = SWAP ? __builtin_amdgcn_mfma_f32_16x16x32_bf16(bfb[gq & 1][n], av, acc[m][nh * 2 + n], 0, 0, 0)
                                      : __builtin_amdgcn_mfma_f32_16x16x32_bf16(av, bfb[gq & 1][n], acc[m][nh * 2 + n], 0, 0, 0);
          }
      }
      }
    }
    __syncthreads();
    const int te = get_tid512();
    const int fr_e = te & 15, fq_e = (te & 63) >> 4, wr_e = te >> 7, wc_e = (te >> 6) & 1;
    const int sub = 2 * mt + (wr_e >> 1);
    const int g = sub / tpg, ti = sub - g * tpg;
    const int rig0 = ti * step - halo;
    const int rw = (wr_e & 1) * 64;
    if constexpr (Epi::KIND == 0) {
#pragma unroll
      for (int m = 0; m < 4; ++m) {
        const int rig = rig0 + rw + m * 16 + fr_e;
        if constexpr (Epi::ROWSUM) {
          float ss = 0.f;
#pragma unroll
          for (int n = 0; n < 8; ++n) {
            const int col = nt * 256 + wc_e * 128 + n * 16 + fq_e * 4;
            if (col < N) ss += epi.c4(g, rig, col, acc[m][n]);
          }
          ss += __shfl_xor(ss, 16); ss += __shfl_xor(ss, 32);
          if (fq_e == 0) epi.rowsum(g, rig, nt * 2 + wc_e, ss);
        } else {
#pragma unroll
          for (int n = 0; n < 8; ++n) {
            const int col = nt * 256 + wc_e * 128 + n * 16 + fq_e * 4;
            if (col < N) epi.c4(g, rig, col, acc[m][n]);
          }
        }
      }
    } else if constexpr (Epi::KIND == 1) {
#pragma unroll
      for (int m = 0; m < 4; ++m) {
        const int rig = rig0 + rw + m * 16 + fq_e * 4;
#pragma unroll
        for (int n = 0; n < 8; ++n) {
          const int col = nt * 256 + wc_e * 128 + n * 16 + fr_e;
          if (col < N) epi.r4(g, rig, col, acc[m][n]);
        }
      }
    } else {
      bf16_t* Zw = (bf16_t*)smem + ((wr_e >> 1) * 2 + wc_e) * (128 * 132);
      const int nt2w = nt * 2 + wc_e;
#pragma unroll
      for (int n = 0; n < 8; ++n) {
        const int cl = n * 16 + fq_e * 4;
        f32x4 b4 = {0.f, 0.f, 0.f, 0.f};
        if (epi.pre_bias) b4 = *(const f32x4*)(epi.pre_bias + epi.norig(nt2w, cl));
#pragma unroll
        for (int m = 0; m < 4; ++m) {
          const int rl = rw + m * 16 + fr_e;
          const int pos = rig0 + rl;
          const bool ok = pos >= 0 && pos < grows;
          f32x4 vv = acc[m][n] + b4;
          if (!ok) vv = (f32x4){0.f, 0.f, 0.f, 0.f};
          uint2 u; u.x = pack2(vv[0], vv[1]); u.y = pack2(vv[2], vv[3]);
          *(uint2*)(Zw + rl * 132 + cl) = u;
        }
      }
      __syncthreads();
      {
        auto no_pre = []() {};
        const bf16_t* Zr = (const bf16_t*)smem + ((wr_e >> 1) * 2) * (128 * 132);
        epi.finish(Zr, g, rig0, nt * 2, no_pre);
        epi.finish(Zr + 128 * 132, g, rig0, nt * 2 + 1, no_pre);
      }
      __syncthreads();
    }
    asm volatile("s_waitcnt vmcnt(0)" ::: "memory");
    __syncthreads();
  }
}

__device__ __forceinline__ void phase_attn(CP& p, char* smem, int vid0, int grid) {
  bf16_t* Ks = (bf16_t*)smem;
  bf16_t* Vs = (bf16_t*)(smem + 64 * 104 * 2);
  const int tid = get_tid512(), lane = tid & 63, w = tid >> 6, r = lane & 31, hh = lane >> 5;
  const float cs = 1.4426950408889634f * 0.10206207261596577f;
  for (int it = vid0; it < 1024; it += grid) {
    const int qt = it & 7, h = (it >> 3) & 15, b = it >> 7;
    const int t = qt * 256 + w * 32 + r;
    const size_t xrow = (size_t)b * 2048 + t;
    const bf16_t* qp = p.Q + xrow * 1536 + h * 96;
    bf16x8 qf[6];
#pragma unroll
    for (int kk = 0; kk < 4; ++kk) qf[kk] = *(const bf16x8*)(qp + 16 * kk + 8 * hh);
#pragma unroll
    for (int part = 0; part < 2; ++part) {
      const bf16_t* pp = qp + 64 + 16 * part;
      const bf16x8 mine = *(const bf16x8*)(pp + 8 * hh), oth = *(const bf16x8*)(pp + 8 * (1 - hh));
      const float posf = part == 0 ? (float)(t >> 6) : (float)(t & 63);
      union { unsigned u[4]; bf16x8 v; } o;
      float res[8];
#pragma unroll
      for (int j = 0; j < 8; ++j) {
        const float inv = exp2f(-(float)j * (13.287712379549449f / 8.0f));
        const float ang = posf * inv;
        const float c = __cosf(ang), s = __sinf(ang);
        const float m = bf2f((bf16_t)mine[j]), ov = bf2f((bf16_t)oth[j]);
        res[j] = m * c + (hh ? ov : -ov) * s;
      }
#pragma unroll
      for (int j = 0; j < 4; ++j) o.u[j] = pack2(res[2 * j], res[2 * j + 1]);
      qf[4 + part] = o.v;
    }
    f32x16 oacc[2];
#pragma unroll
    for (int i = 0; i < 16; ++i) { oacc[0][i] = 0.f; oacc[1][i] = 0.f; }
    float mrun = -INFINITY, lrun = 0.f;
    const size_t kvrow0 = (size_t)b * 2304;
    const bf16_t* kn_base = p.Kn + kvrow0 * 1024 + h * 64;
    const bf16_t* kpe_base = p.kpe + kvrow0 * 32;
    const bf16_t* vt_base = p.Vt + ((size_t)(b * 16 + h) * 64) * 2304;
    uint4 rk0, rp, rv0;
    rp.x = 0; rp.y = 0; rp.z = 0; rp.w = 0;
    const int srow = tid >> 3, sch = tid & 7;
#define ATT_GLOAD(kt) do { \
      rk0 = *(const uint4*)(kn_base + (size_t)((kt) * 64 + srow) * 1024 + sch * 8); \
      rv0 = *(const uint4*)(vt_base + (size_t)srow * 2304 + (kt) * 64 + sch * 8); \
      if (tid < 256) rp = *(const uint4*)(kpe_base + (size_t)((kt) * 64 + (tid >> 2)) * 32 + (tid & 3) * 8); } while (0)
    ATT_GLOAD(0);
    for (int kt = 0; kt < 36; ++kt) {
      __syncthreads();
      {
        *(uint4*)(Ks + srow * 104 + sch * 8) = rk0;
        uint2 lo, hi;
        lo.x = rv0.x; lo.y = rv0.y; hi.x = rv0.z; hi.y = rv0.w;
        *(uint2*)(Vs + srow * 72 + (sch >> 1) * 16 + (sch & 1) * 4) = lo; *(uint2*)(Vs + srow * 72 + (sch >> 1) * 16 + 8 + (sch & 1) * 4) = hi;
      }
      if (tid < 256) *(uint4*)(Ks + (tid >> 2) * 104 + 64 + (tid & 3) * 8) = rp;
      __syncthreads();
      if (kt + 1 < 36) ATT_GLOAD(kt + 1);
      f32x16 s[2];
#pragma unroll
      for (int t2 = 0; t2 < 2; ++t2) {
#pragma unroll
        for (int i = 0; i < 16; ++i) s[t2][i] = 0.f;
#pragma unroll
        for (int kk = 0; kk < 6; ++kk) {
          const bf16x8 a = *(const bf16x8*)(Ks + (32 * t2 + r) * 104 + 16 * kk + 8 * hh);
          s[t2] = __builtin_amdgcn_mfma_f32_32x32x16_bf16(a, qf[kk], s[t2], 0, 0, 0);
        }
      }
      float mx = s[0][0];
#pragma unroll
      for (int i = 1; i < 16; ++i) mx = fmaxf(mx, s[0][i]);
#pragma unroll
      for (int i = 0; i < 16; ++i) mx = fmaxf(mx, s[1][i]);
      mx = fmaxf(mx, __shfl_xor(mx, 32));
      const float mcand = mx * cs;
      if (__builtin_amdgcn_ballot_w64(mcand > mrun + 6.0f) != 0ull) {
        const float mnew_ = fmaxf(mrun, mcand);
        const float alpha = __builtin_amdgcn_exp2f(mrun - mnew_);
        mrun = mnew_;
        lrun *= alpha;
#pragma unroll
        for (int i = 0; i < 16; ++i) { oacc[0][i] *= alpha; oacc[1][i] *= alpha; }
      }
      const float mnew = mrun;
      float psum = 0.f;
      bf16x8 pf[4];
#pragma unroll
      for (int t2 = 0; t2 < 2; ++t2)
#pragma unroll
        for (int hf = 0; hf < 2; ++hf) {
          union { unsigned u[4]; bf16x8 v; } cvp;
#pragma unroll
          for (int i = 0; i < 4; ++i) {
            const float p0 = __builtin_amdgcn_exp2f(s[t2][hf * 8 + 2 * i] * cs - mnew);
            const float p1 = __builtin_amdgcn_exp2f(s[t2][hf * 8 + 2 * i + 1] * cs - mnew);
            psum += p0 + p1;
            cvp.u[i] = pack2(p0, p1);
          }
          pf[t2 * 2 + hf] = cvp.v;
        }
      lrun += psum;
#pragma unroll
      for (int dt = 0; dt < 2; ++dt)
#pragma unroll
        for (int s4 = 0; s4 < 4; ++s4) {
          const bf16x8 vfr = *(const bf16x8*)(Vs + (32 * dt + r) * 72 + 16 * s4 + 8 * hh);
          oacc[dt] = __builtin_amdgcn_mfma_f32_32x32x16_bf16(vfr, pf[s4], oacc[dt], 0, 0, 0);
        }
    }
    const float ltot = lrun + __shfl_xor(lrun, 32);
    const float inv = 1.f / ltot;
    bf16_t* op = p.hxc + xrow * 1024 + h * 64;
#pragma unroll
    for (int dt = 0; dt < 2; ++dt)
#pragma unroll
      for (int i4 = 0; i4 < 4; ++i4) {
        const int d = 32 * dt + 8 * i4 + 4 * hh;
        uint2 u; u.x = pack2(oacc[dt][4 * i4] * inv, oacc[dt][4 * i4 + 1] * inv); u.y = pack2(oacc[dt][4 * i4 + 2] * inv, oacc[dt][4 * i4 + 3] * inv);
        *(uint2*)(op + d) = u;
      }
  }
}

__device__ __forceinline__ void phase_hyconv(CP& p, char* smem) {
  bf16_t* cp = (bf16_t*)smem;
  bf16_t* Vl = (bf16_t*)(smem + 4 * 8256);
  const int tid = get_tid(), lane = tid & 63, w = tid >> 6, i16 = lane & 15, g4 = lane >> 4;
  const int si = (-i16) & 3;
  const int ocb = 64 * w;
  for (int c = get_bid(); c < 1024; c += VGRID) {
    __syncthreads();
#pragma unroll
    for (int i = 0; i < 2; ++i) { const int ch = tid + 256 * i; *(uint4*)(cp + ch * 8) = *(const uint4*)(p.Rf + (size_t)c * 4096 + ch * 8); }
    {
      const float a0 = p.hy_conv_w[1024 + c], a1 = p.hy_conv_w[3072 + 1024 + c], a2 = p.hy_conv_w[2 * 3072 + 1024 + c], ab = p.hy_conv_b[1024 + c];
      const float v0 = p.hy_conv_w[2048 + c], v1 = p.hy_conv_w[3072 + 2048 + c], v2 = p.hy_conv_w[2 * 3072 + 2048 + c], vb = p.hy_conv_b[2048 + c];
#pragma unroll 2
      for (int i = 0; i < 8; ++i) {
        const int q = tid + 256 * i; const int b = q >> 8, l8 = q & 255; const int m1 = l8 >> 3, m2 = (l8 & 7) * 8;
        const int l0 = l8 * 8;
        const bf16_t* z2 = p.vvT + (size_t)c * 16384 + b * 2048;
        const bf16_t* zv = p.vvT + (size_t)(1024 + c) * 16384 + b * 2048;
        const uint4 u2 = *(const uint4*)(z2 + l0), uv = *(const uint4*)(zv + l0);
        float e2[10], ev[10];
        const int lp = l0 > 0 ? l0 - 1 : 0, ln = l0 + 8 < 2048 ? l0 + 8 : 2047;
        const float pm = l0 > 0 ? 1.f : 0.f, nm = l0 + 8 < 2048 ? 1.f : 0.f;
        const bf16_t q2p = z2[lp], qvp = zv[lp], q2n = z2[ln], qvn = zv[ln];
        e2[0] = bf2f(q2p) * pm; ev[0] = bf2f(qvp) * pm;
        e2[9] = bf2f(q2n) * nm; ev[9] = bf2f(qvn) * nm;
        const unsigned w2[4] = {u2.x, u2.y, u2.z, u2.w}, wv[4] = {uv.x, uv.y, uv.z, uv.w};
#pragma unroll
        for (int j = 0; j < 4; ++j) {
          e2[1 + 2 * j] = __uint_as_float(w2[j] << 16); e2[2 + 2 * j] = __uint_as_float(w2[j] & 0xffff0000u);
          ev[1 + 2 * j] = __uint_as_float(wv[j] << 16); ev[2 + 2 * j] = __uint_as_float(wv[j] & 0xffff0000u);
        }
        unsigned o[4];
#pragma unroll
        for (int j = 0; j < 4; ++j) {
          const float xa = a0 * e2[2 * j] + a1 * e2[2 * j + 1] + a2 * e2[2 * j + 2] + ab;
          const float xb = a0 * e2[2 * j + 1] + a1 * e2[2 * j + 2] + a2 * e2[2 * j + 3] + ab;
          const float ya = v0 * ev[2 * j] + v1 * ev[2 * j + 1] + v2 * ev[2 * j + 2] + vb;
          const float yb = v0 * ev[2 * j + 1] + v1 * ev[2 * j + 2] + v2 * ev[2 * j + 3] + vb;
          o[j] = pack2(xa * ya, xb * yb);
        }
        uint4 ou; ou.x = o[0]; ou.y = o[1]; ou.z = o[2]; ou.w = o[3];
        *(uint4*)(Vl + (8 + m1 * 8 + b) * 80 + m2) = ou;
      }
    }
    if (tid < 144) {
      const int colp = tid / 9, part = tid - colp * 9;
      const int col = colp < 8 ? colp : 256 + colp;
      uint4 zz; zz.x = 0; zz.y = 0; zz.z = 0; zz.w = 0;
      *(uint4*)(Vl + col * 80 + part * 8) = zz;
    }
    __syncthreads();
#pragma unroll
    for (int s = 1; s < 4; ++s)
#pragma unroll
      for (int i = 0; i < 2; ++i) {
        const int ch = tid + 256 * i;
        unsigned e[8];
#pragma unroll
        for (int j = 0; j < 8; ++j) { const int idx = 8 * ch + s + j; e[j] = idx < 4096 ? (unsigned)cp[idx] : 0u; }
        uint4 u; u.x = e[0] | (e[1] << 16); u.y = e[2] | (e[3] << 16); u.z = e[4] | (e[5] << 16); u.w = e[6] | (e[7] << 16);
        *(uint4*)(cp + s * 4128 + 8 * ch) = u;
      }
    __syncthreads();
    const bf16_t* abase = cp + si * 4128 + (2048 - i16 - si + 8 * g4);
    f32x4 acc[4][4];
#pragma unroll
    for (int m = 0; m < 4; ++m)
#pragma unroll
      for (int n = 0; n < 4; ++n) acc[m][n] = (f32x4){0.f, 0.f, 0.f, 0.f};
    for (int dl = -31; dl <= 31; ++dl) {
      bf16x8 af[4][2];
#pragma unroll
      for (int mt = 0; mt < 4; ++mt)
#pragma unroll
        for (int kk = 0; kk < 2; ++kk) {
          const bf16_t* ap = abase - 64 * dl - 16 * mt + 32 * kk;
          const uint2 lo = *(const uint2*)ap, hi = *(const uint2*)(ap + 4);
          union { uint4 u; bf16x8 v; } cv; cv.u.x = lo.x; cv.u.y = lo.y; cv.u.z = hi.x; cv.u.w = hi.y;
          af[mt][kk] = cv.v;
        }
#pragma unroll
      for (int jt = 0; jt < 4; ++jt) {
        const int in0 = ocb + 16 * jt - 8 * dl;
        if (in0 >= -8 && in0 <= 248) {
          const bf16_t* bp = Vl + (in0 + 8 + i16) * 80 + 8 * g4;
          const bf16x8 b0 = *(const bf16x8*)bp, b1 = *(const bf16x8*)(bp + 32);
#pragma unroll
          for (int mt = 0; mt < 4; ++mt) {
            acc[mt][jt] = __builtin_amdgcn_mfma_f32_16x16x32_bf16(af[mt][0], b0, acc[mt][jt], 0, 0, 0);
            acc[mt][jt] = __builtin_amdgcn_mfma_f32_16x16x32_bf16(af[mt][1], b1, acc[mt][jt], 0, 0, 0);
          }
        }
      }
    }
    const float db = p.hy_d_bias[c];
#pragma unroll
    for (int mt = 0; mt < 4; ++mt)
#pragma unroll
      for (int jt = 0; jt < 4; ++jt) {
        const int col = ocb + 16 * jt + i16;
        const int n1 = col >> 3, b = col & 7;
        const int n2 = 16 * mt + 4 * g4;
        const uint2 vv = *(const uint2*)(Vl + (col + 8) * 80 + n2);
        const float y0 = acc[mt][jt][0] + bf2f((bf16_t)(vv.x & 0xffff)) * db;
        const float y1 = acc[mt][jt][1] + bf2f((bf16_t)(vv.x >> 16)) * db;
        const float y2 = acc[mt][jt][2] + bf2f((bf16_t)(vv.y & 0xffff)) * db;
        const float y3 = acc[mt][jt][3] + bf2f((bf16_t)(vv.y >> 16)) * db;
        uint2 u; u.x = pack2(y0, y1); u.y = pack2(y2, y3);
        *(uint2*)(p.Yp + (size_t)c * 16384 + b * 2048 + n1 * 64 + n2) = u;
      }
  }
}

__device__ __forceinline__ void phase_transmul(CP& p, char* smem) {
  bf16_t* tl = (bf16_t*)smem;
  const int tid = get_tid();
  for (int it = get_bid(); it < 4096; it += VGRID) {
    const int ct = it & 15, rt = it >> 4;
    const int c0 = ct * 64, r0 = rt * 64;
    __syncthreads();
#pragma unroll
    for (int i = 0; i < 2; ++i) {
      const int ci = tid + 256 * i; const int cc = ci >> 3, ch = ci & 7;
      const uint4 u = *(const uint4*)(p.Yp + (size_t)(c0 + cc) * 16384 + r0 + ch * 8);
      unsigned* d = (unsigned*)(tl + cc * 66 + ch * 8);
      d[0] = u.x; d[1] = u.y; d[2] = u.z; d[3] = u.w;
    }
    __syncthreads();
    const int row = tid >> 2, cq = tid & 3;
    const int grow = r0 + row, pos = grow & 2047;
    const int cbase = c0 + cq * 16;
    const bf16_t* xp = p.x1h + (size_t)grow * 1024 + cbase;
    uint4 zero4; zero4.x = 0; zero4.y = 0; zero4.z = 0; zero4.w = 0;
    const uint4 xa = *(const uint4*)xp, xb = *(const uint4*)(xp + 8);
    const bf16_t* xpp = pos > 0 ? xp - 1024 : xp;
    const bf16_t* xpn = pos < 2047 ? xp + 1024 : xp;
    const float pmk = pos > 0 ? 1.f : 0.f, nmk = pos < 2047 ? 1.f : 0.f;
    const uint4 pa = *(const uint4*)xpp, pb = *(const uint4*)(xpp + 8);
    const uint4 na = *(const uint4*)xpn, nb = *(const uint4*)(xpn + 8);
    (void)zero4;
    const unsigned xs[8] = {xa.x, xa.y, xa.z, xa.w, xb.x, xb.y, xb.z, xb.w};
    const unsigned ps[8] = {pa.x, pa.y, pa.z, pa.w, pb.x, pb.y, pb.z, pb.w};
    const unsigned ns[8] = {na.x, na.y, na.z, na.w, nb.x, nb.y, nb.z, nb.w};
    unsigned o[8];
#pragma unroll
    for (int j4 = 0; j4 < 4; ++j4) {
      const f32x4 w0 = *(const f32x4*)(p.hy_conv_w + cbase + 4 * j4) * pmk, w1 = *(const f32x4*)(p.hy_conv_w + 3072 + cbase + 4 * j4);
      const f32x4 w2 = *(const f32x4*)(p.hy_conv_w + 2 * 3072 + cbase + 4 * j4) * nmk, wb = *(const f32x4*)(p.hy_conv_b + cbase + 4 * j4);
#pragma unroll
      for (int jj = 0; jj < 2; ++jj) {
        const int j = 2 * j4 + jj;
        const float x0 = w0[2 * jj] * __uint_as_float(ps[j] << 16) + w1[2 * jj] * __uint_as_float(xs[j] << 16) + w2[2 * jj] * __uint_as_float(ns[j] << 16) + wb[2 * jj];
        const float x1 = w0[2 * jj + 1] * __uint_as_float(ps[j] & 0xffff0000u) + w1[2 * jj + 1] * __uint_as_float(xs[j] & 0xffff0000u) + w2[2 * jj + 1] * __uint_as_float(ns[j] & 0xffff0000u) + wb[2 * jj + 1];
        const float y0 = bf2f(tl[(cq * 16 + 2 * j) * 66 + row]) * x0;
        const float y1 = bf2f(tl[(cq * 16 + 2 * j + 1) * 66 + row]) * x1;
        o[j] = pack2(y0, y1);
      }
    }
    bf16_t* op = p.hxc + (size_t)(r0 + row) * 1024 + c0 + cq * 16;
    uint4 oa; oa.x = o[0]; oa.y = o[1]; oa.z = o[2]; oa.w = o[3];
    uint4 ob; ob.x = o[4]; ob.y = o[5]; ob.z = o[6]; ob.w = o[7];
    *(uint4*)op = oa; *(uint4*)(op + 8) = ob;
  }
}

__global__ void __launch_bounds__(512, 2) mega(P p_arg) {
  __shared__ __attribute__((aligned(16))) char smem[LDS_BYTES];
  cg::grid_group grid = cg::this_grid();
  const int G = gridDim.x;
  CP* pp = (CP*)__builtin_amdgcn_kernarg_segment_ptr();
  const int ph0 = pp->ph0, ph1 = pp->ph1;
  volatile LAS unsigned* xst = (volatile LAS unsigned*)(smem + LDS_BYTES - 16);
  if (threadIdx.x == 0) { xst[0] = 0u; xst[1] = 0u; }
  __syncthreads();
  const XcdBarrier xb = xcd_barrier_post(pp->bar, xst);
  if (ph0 <= 0 && 0 < ph1) {
    asm volatile("" : "+s"(pp));
    CP& p = *pp;
    const int bid = get_rbid();
    const int vid0 = (G & 7) ? bid : ((bid & 7) * (G >> 3) + (bid >> 3));
    const int hb = get_hb();
    char* smem_h = smem + hb * HALF_LDS; (void)smem_h;
    const float* mv0 = p.modv; const float* mv1 = p.modv + (size_t)9 * 6144;
    (void)mv0; (void)mv1; (void)vid0;
    phase_prep(p, smem_h);
    if (0 + 1 < ph1) { if (ph1 > 1000) grid.sync(); else xcd_barrier(xb); }
  }
  if (ph0 <= 1 && 1 < ph1) {
    asm volatile("" : "+s"(pp));
    CP& p = *pp;
    const int bid = get_rbid();
    const int vid0 = (G & 7) ? bid : ((bid & 7) * (G >> 3) + (bid >> 3));
    const int hb = get_hb();
    char* smem_h = smem + hb * HALF_LDS; (void)smem_h;
    const float* mv0 = p.modv; const float* mv1 = p.modv + (size_t)9 * 6144;
    (void)mv0; (void)mv1; (void)vid0;
    phase_normmod_kv(p);
    if (1 + 1 < ph1) { if (ph1 > 1000) grid.sync(); else xcd_barrier(xb); }
  }
  if (ph0 <= 2 && 2 < ph1) {
    asm volatile("" : "+s"(pp));
    CP& p = *pp;
    const int bid = get_rbid();
    const int vid0 = (G & 7) ? bid : ((bid & 7) * (G >> 3) + (bid >> 3));
    const int hb = get_hb();
    char* smem_h = smem + hb * HALF_LDS; (void)smem_h;
    const float* mv0 = p.modv; const float* mv1 = p.modv + (size_t)9 * 6144;
    (void)mv0; (void)mv1; (void)vid0;
    {
        EpiDown e1{p.cq, 512, 2048, p.rq, 4, nullptr, 1 << 30};
        gemm_job<true>(smem, p.hxc, 1024, p.wt_dq, 1024, 512, 16, 2304, 256, 128, 0, 2048, 128, 0, vid0, G, e1);
        EpiDown e2{p.kv, 288, 2304, p.rkv, 2, nullptr, 1 << 30};
        gemm_job<true>(smem, p.hxc, 1024, p.wt_dkv, 1024, 256, 18, 2304, 0, 128, 0, 2304, 144, 128, vid0, G, e2);
        EpiFilt e3{p.Rf, p.hy_decay};
        gemm_job<false>(smem, p.h2bf, 64, p.wt_f3, 64, 2048, 16, 0, 0, 128, 0, 2048, 16, 128 + 72, vid0, G, e3);
        EpiDown e4{p.kv, 288, 2304, p.rkv, 0, p.kpe, 0};
        gemm_job<true, EpiDown, true>(smem, p.hxc, 1024, p.wt_dkv + (size_t)256 * 1024, 1024, 32, 18, 2304, 0, 128, 0, 2304, 144, 128 + 72 + 64, vid0, G, e4);
      }
    if (2 + 1 < ph1) { if (ph1 > 1000) grid.sync(); else xcd_barrier(xb); }
  }
  if (ph0 <= 4 && 4 < ph1) {
    asm volatile("" : "+s"(pp));
    CP& p = *pp;
    const int bid = get_rbid();
    const int vid0 = (G & 7) ? bid : ((bid & 7) * (G >> 3) + (bid >> 3));
    const int hb = get_hb();
    char* smem_h = smem + hb * HALF_LDS; (void)smem_h;
    const float* mv0 = p.modv; const float* mv1 = p.modv + (size_t)9 * 6144;
    (void)mv0; (void)mv1; (void)vid0;
    {
        EpiStore<4> e1{p.Q, 1536, 2048, p.rq, 16384, 1.0f / 512.0f};
        gemm_job<true>(smem, p.cq, 512, p.wt_uq, 512, 1536, 16, 2048, 0, 128, 0, 2048, 128, 0, vid0, G, e1);
        EpiStore<2> e2{p.Kn, 1024, 2304, p.rkv, 18432, 1.0f / 256.0f};
        gemm_job<true>(smem, p.kv, 288, p.wt_uk, 256, 1024, 18, 2304, 0, 128, 0, 2304, 144, 64 * 6, vid0, G, e2);
        EpiVt e3{p.Vt, p.rkv};
        gemm_job<false>(smem, p.kv, 288, p.wt_uv, 256, 1024, 18, 2304, 0, 128, 0, 2304, 144, 64 * 6 + 72 * 4, vid0, G, e3);
      }
    if (4 + 1 < ph1) { if (ph1 > 1000) grid.sync(); else xcd_barrier(xb); }
  }
  if (ph0 <= 5 && 5 < ph1) {
    asm volatile("" : "+s"(pp));
    CP& p = *pp;
    const int bid = get_rbid();
    const int vid0 = (G & 7) ? bid : ((bid & 7) * (G >> 3) + (bid >> 3));
    const int hb = get_hb();
    char* smem_h = smem + hb * HALF_LDS; (void)smem_h;
    const float* mv0 = p.modv; const float* mv1 = p.modv + (size_t)9 * 6144;
    (void)mv0; (void)mv1; (void)vid0;
    phase_attn(p, smem, vid0, G);
    if (5 + 1 < ph1) { if (ph1 > 1000) grid.sync(); else xcd_barrier(xb); }
  }
  if (ph0 <= 6 && 6 < ph1) {
    asm volatile("" : "+s"(pp));
    CP& p = *pp;
    const int bid = get_rbid();
    const int vid0 = (G & 7) ? bid : ((bid & 7) * (G >> 3) + (bid >> 3));
    const int hb = get_hb();
    char* smem_h = smem + hb * HALF_LDS; (void)smem_h;
    const float* mv0 = p.modv; const float* mv1 = p.modv + (size_t)9 * 6144;
    (void)mv0; (void)mv1; (void)vid0;
    {
        EpiResid<true> e{p.X16, p.x, mv0 + 2 * 1024, nullptr};
        gemm_job<true>(smem, p.hxc, 1024, p.wt_o, 1024, 1024, 16, 2048, 0, 128, 0, 2048, 128, 0, vid0, G, e);
      }
    if (6 + 1 < ph1) { if (ph1 > 1000) grid.sync(); else xcd_barrier(xb); }
  }
  if (ph0 <= 7 && 7 < ph1) {
    asm volatile("" : "+s"(pp));
    CP& p = *pp;
    const int bid = get_rbid();
    const int vid0 = (G & 7) ? bid : ((bid & 7) * (G >> 3) + (bid >> 3));
    const int hb = get_hb();
    char* smem_h = smem + hb * HALF_LDS; (void)smem_h;
    const float* mv0 = p.modv; const float* mv1 = p.modv + (size_t)9 * 6144;
    (void)mv0; (void)mv1; (void)vid0;
    phase_normmod_x(p, p.norm_ffn_g, 0, 3);
    if (7 + 1 < ph1) { if (ph1 > 1000) grid.sync(); else xcd_barrier(xb); }
  }
  if (ph0 <= 8 && 8 < ph1) {
    asm volatile("" : "+s"(pp));
    CP& p = *pp;
    const int bid = get_rbid();
    const int vid0 = (G & 7) ? bid : ((bid & 7) * (G >> 3) + (bid >> 3));
    const int hb = get_hb();
    char* smem_h = smem + hb * HALF_LDS; (void)smem_h;
    const float* mv0 = p.modv; const float* mv1 = p.modv + (size_t)9 * 6144;
    (void)mv0; (void)mv1; (void)vid0;
    {
        EpiConv<0> e{p.ffn_conv_w, p.ffn_conv_b, 5632, nullptr, p.act, nullptr};
        gemm_job<true>(smem, p.hxc, 1024, p.wt_up0, 1024, 5632, 17, 2048, 0, 126, 1, 2048, 136, 0, vid0, G, e);
      }
    if (8 + 1 < ph1) { if (ph1 > 1000) grid.sync(); else xcd_barrier(xb); }
  }
  if (ph0 <= 9 && 9 < ph1) {
    asm volatile("" : "+s"(pp));
    CP& p = *pp;
    const int bid = get_rbid();
    const int vid0 = (G & 7) ? bid : ((bid & 7) * (G >> 3) + (bid >> 3));
    const int hb = get_hb();
    char* smem_h = smem + hb * HALF_LDS; (void)smem_h;
    const float* mv0 = p.modv; const float* mv1 = p.modv + (size_t)9 * 6144;
    (void)mv0; (void)mv1; (void)vid0;
    {
        EpiResid<false> e{p.X16, p.X16, mv0 + 5 * 1024, nullptr};
        gemm_job<true>(smem, p.act, 2816, p.wt_dn0, 2816, 1024, 16, 2048, 0, 128, 0, 2048, 128, 0, vid0, G, e);
      }
    if (9 + 1 < ph1) { if (ph1 > 1000) grid.sync(); else xcd_barrier(xb); }
  }
  if (ph0 <= 10 && 10 < ph1) {
    asm volatile("" : "+s"(pp));
    CP& p = *pp;
    const int bid = get_rbid();
    const int vid0 = (G & 7) ? bid : ((bid & 7) * (G >> 3) + (bid >> 3));
    const int hb = get_hb();
    char* smem_h = smem + hb * HALF_LDS; (void)smem_h;
    const float* mv0 = p.modv; const float* mv1 = p.modv + (size_t)9 * 6144;
    (void)mv0; (void)mv1; (void)vid0;
    phase_normmod_x(p, p.norm_mix_g + 1024, 1, 0);
    if (10 + 1 < ph1) { if (ph1 > 1000) grid.sync(); else xcd_barrier(xb); }
  }
  if (ph0 <= 11 && 11 < ph1) {
    asm volatile("" : "+s"(pp));
    CP& p = *pp;
    const int bid = get_rbid();
    const int vid0 = (G & 7) ? bid : ((bid & 7) * (G >> 3) + (bid >> 3));
    const int hb = get_hb();
    char* smem_h = smem + hb * HALF_LDS; (void)smem_h;
    const float* mv0 = p.modv; const float* mv1 = p.modv + (size_t)9 * 6144;
    (void)mv0; (void)mv1; (void)vid0;
    {
        EpiBiasStore e1{p.x1h, 1024, p.hy_b_in};
        gemm_job<true>(smem, p.hxc, 1024, p.wt_hin, 1024, 1024, 16, 2048, 0, 128, 0, 2048, 128, 0, vid0, G, e1);
        EpiBiasT e2{p.vvT, p.hy_b_in + 1024};
        gemm_job<false>(smem, p.hxc, 1024, p.wt_hin + (size_t)1024 * 1024, 1024, 2048, 16, 2048, 0, 128, 0, 2048, 128, 64 * 4, vid0, G, e2);
      }
    if (11 + 1 < ph1) { if (ph1 > 1000) grid.sync(); else xcd_barrier(xb); }
  }
  if (ph0 <= 12 && 12 < ph1) {
    asm volatile("" : "+s"(pp));
    CP& p = *pp;
    const int bid = get_rbid();
    const int vid0 = (G & 7) ? bid : ((bid & 7) * (G >> 3) + (bid >> 3));
    const int hb = get_hb();
    char* smem_h = smem + hb * HALF_LDS; (void)smem_h;
    const float* mv0 = p.modv; const float* mv1 = p.modv + (size_t)9 * 6144;
    (void)mv0; (void)mv1; (void)vid0;
    phase_hyconv(p, smem_h);
    if (12 + 1 < ph1) { if (ph1 > 1000) grid.sync(); else xcd_barrier(xb); }
  }
  if (ph0 <= 13 && 13 < ph1) {
    asm volatile("" : "+s"(pp));
    CP& p = *pp;
    const int bid = get_rbid();
    const int vid0 = (G & 7) ? bid : ((bid & 7) * (G >> 3) + (bid >> 3));
    const int hb = get_hb();
    char* smem_h = smem + hb * HALF_LDS; (void)smem_h;
    const float* mv0 = p.modv; const float* mv1 = p.modv + (size_t)9 * 6144;
    (void)mv0; (void)mv1; (void)vid0;
    phase_transmul(p, smem_h);
    if (13 + 1 < ph1) { if (ph1 > 1000) grid.sync(); else xcd_barrier(xb); }
  }
  if (ph0 <= 14 && 14 < ph1) {
    asm volatile("" : "+s"(pp));
    CP& p = *pp;
    const int bid = get_rbid();
    const int vid0 = (G & 7) ? bid : ((bid & 7) * (G >> 3) + (bid >> 3));
    const int hb = get_hb();
    char* smem_h = smem + hb * HALF_LDS; (void)smem_h;
    const float* mv0 = p.modv; const float* mv1 = p.modv + (size_t)9 * 6144;
    (void)mv0; (void)mv1; (void)vid0;
    {
        EpiResid<false> e{p.X16, p.X16, mv1 + 2 * 1024, p.hy_b_out};
        gemm_job<true>(smem, p.hxc, 1024, p.wt_hout, 1024, 1024, 16, 2048, 0, 128, 0, 2048, 128, 0, vid0, G, e);
      }
    if (14 + 1 < ph1) { if (ph1 > 1000) grid.sync(); else xcd_barrier(xb); }
  }
  if (ph0 <= 15 && 15 < ph1) {
    asm volatile("" : "+s"(pp));
    CP& p = *pp;
    const int bid = get_rbid();
    const int vid0 = (G & 7) ? bid : ((bid & 7) * (G >> 3) + (bid >> 3));
    const int hb = get_hb();
    char* smem_h = smem + hb * HALF_LDS; (void)smem_h;
    const float* mv0 = p.modv; const float* mv1 = p.modv + (size_t)9 * 6144;
    (void)mv0; (void)mv1; (void)vid0;
    phase_normmod_x(p, p.norm_ffn_g + 1024, 1, 3);
    if (15 + 1 < ph1) { if (ph1 > 1000) grid.sync(); else xcd_barrier(xb); }
  }
  if (ph0 <= 16 && 16 < ph1) {
    asm volatile("" : "+s"(pp));
    CP& p = *pp;
    const int bid = get_rbid();
    const int vid0 = (G & 7) ? bid : ((bid & 7) * (G >> 3) + (bid >> 3));
    const int hb = get_hb();
    char* smem_h = smem + hb * HALF_LDS; (void)smem_h;
    const float* mv0 = p.modv; const float* mv1 = p.modv + (size_t)9 * 6144;
    (void)mv0; (void)mv1; (void)vid0;
    {
        EpiConv<0> e{p.ffn_conv_w + (size_t)3 * 5632, p.ffn_conv_b + 5632, 5632, nullptr, p.act, nullptr};
        gemm_job<true>(smem, p.hxc, 1024, p.wt_up1, 1024, 5632, 17, 2048, 0, 126, 1, 2048, 136, 0, vid0, G, e);
      }
    if (16 + 1 < ph1) { if (ph1 > 1000) grid.sync(); else xcd_barrier(xb); }
  }
  if (ph0 <= 17 && 17 < ph1) {
    asm volatile("" : "+s"(pp));
    CP& p = *pp;
    const int bid = get_rbid();
    const int vid0 = (G & 7) ? bid : ((bid & 7) * (G >> 3) + (bid >> 3));
    const int hb = get_hb();
    char* smem_h = smem + hb * HALF_LDS; (void)smem_h;
    const float* mv0 = p.modv; const float* mv1 = p.modv + (size_t)9 * 6144;
    (void)mv0; (void)mv1; (void)vid0;
    {
        EpiResid<false> e{p.X16, p.X16, mv1 + 5 * 1024, nullptr};
        gemm_job<true>(smem, p.act, 2816, p.wt_dn1, 2816, 1024, 16, 2048, 0, 128, 0, 2048, 128, 0, vid0, G, e);
      }
    if (17 + 1 < ph1) { if (ph1 > 1000) grid.sync(); else xcd_barrier(xb); }
  }
  if (ph0 <= 18 && 18 < ph1) {
    asm volatile("" : "+s"(pp));
    CP& p = *pp;
    const int bid = get_rbid();
    const int vid0 = (G & 7) ? bid : ((bid & 7) * (G >> 3) + (bid >> 3));
    const int hb = get_hb();
    char* smem_h = smem + hb * HALF_LDS; (void)smem_h;
    const float* mv0 = p.modv; const float* mv1 = p.modv + (size_t)9 * 6144;
    (void)mv0; (void)mv1; (void)vid0;
    phase_final_norm(p);
    if (18 + 1 < ph1) { if (ph1 > 1000) grid.sync(); else xcd_barrier(xb); }
  }
}

extern "C" void kernel_launch(void* const* d_in, const int* in_sizes, int n_in, void* d_out, int out_size, void* d_ws, size_t ws_size, hipStream_t stream) {
  static int grid_blocks = 0;
  if (!grid_blocks) {
    int dev = 0, cus = 0, per_cu = 0;
    hipGetDevice(&dev);
    hipDeviceGetAttribute(&cus, hipDeviceAttributeMultiprocessorCount, dev);
    hipOccupancyMaxActiveBlocksPerMultiprocessor(&per_cu, (const void*)mega, 512, 0);
    per_cu = 1;
    grid_blocks = cus * per_cu;
  }
  P p{};
  const float** in = (const float**)&p;
  for (int i = 0; i < 36; ++i) in[i] = (const float*)d_in[i];
  p.X = (float*)d_out;
  char* ws = (char*)d_ws; size_t off = 0;
  auto take = [&](size_t bytes) { char* r = ws + off; off += (bytes + 255) & ~(size_t)255; return r; };
  p.wt_dq = (bf16_t*)take((size_t)512 * 1024 * 2);
  p.wt_dkv = (bf16_t*)take((size_t)288 * 1024 * 2);
  p.wt_uq = (bf16_t*)take((size_t)1536 * 512 * 2);
  p.wt_uk = (bf16_t*)take((size_t)1024 * 256 * 2);
  p.wt_uv = (bf16_t*)take((size_t)1024 * 256 * 2);
  p.wt_o = (bf16_t*)take((size_t)1024 * 1024 * 2);
  p.wt_hin = (bf16_t*)take((size_t)3072 * 1024 * 2);
  p.wt_hout = (bf16_t*)take((size_t)1024 * 1024 * 2);
  p.wt_up0 = (bf16_t*)take((size_t)5632 * 1024 * 2);
  p.wt_up1 = (bf16_t*)take((size_t)5632 * 1024 * 2);
  p.wt_dn0 = (bf16_t*)take((size_t)1024 * 2816 * 2);
  p.wt_dn1 = (bf16_t*)take((size_t)1024 * 2816 * 2);
  p.modv = (float*)take((size_t)2 * 9 * 6144 * 4);
  p.rq = (float*)take((size_t)4 * 16384 * 4);
  p.rkv = (float*)take((size_t)2 * 18432 * 4);
  p.modp = (float*)take((size_t)4 * 110592 * 4);
  p.bar = (unsigned*)take((size_t)XCD_BAR_WORDS * 4);
  p.wt_f3 = (bf16_t*)take((size_t)2048 * 64 * 2);
  p.h2bf = (bf16_t*)take((size_t)2048 * 64 * 2);
  p.Rf = (bf16_t*)take((size_t)1024 * 4096 * 2);
  p.kpe = (bf16_t*)take((size_t)18432 * 32 * 2);
  p.hxc = (bf16_t*)take((size_t)18432 * 1024 * 2);
  const size_t ubase = off;
  p.cq = (bf16_t*)take((size_t)16384 * 512 * 2);
  p.kv = (bf16_t*)take((size_t)18432 * 288 * 2);
  p.Q = (bf16_t*)take((size_t)16384 * 1536 * 2);
  p.Kn = (bf16_t*)take((size_t)18432 * 1024 * 2);
  p.Vt = (bf16_t*)take((size_t)18432 * 1024 * 2);
  const size_t uend1 = off;
  p.X16 = (bf16_t*)(ws + ubase + (size_t)104857600);
  off = ubase;
  p.act = (bf16_t*)take((size_t)16384 * 2816 * 2);
  off = ubase;
  p.x1h = (bf16_t*)take((size_t)16384 * 1024 * 2);
  p.vvT = (bf16_t*)take((size_t)2 * 16384 * 1024 * 2);
  p.Yp = p.vvT;
  if (uend1 > ws_size) { fprintf(stderr, "workspace too small: need %zu have %zu\n", uend1, ws_size); return; }
  p.ph0 = 0; p.ph1 = NPHASE;
  if (hipMemsetAsync(p.bar, 0, (size_t)XCD_BAR_WORDS * 4, stream) != hipSuccess) { fprintf(stderr, "memset failed\n"); return; }
  void* args[] = {&p};
  hipError_t e = hipLaunchCooperativeKernel((const void*)mega, dim3(grid_blocks), dim3(512), args, 0, stream);
  if (e != hipSuccess) fprintf(stderr, "cooperative launch failed: %s (grid %d)\n", hipGetErrorString(e), grid_blocks);
}
```

```cpp
#include <hip/hip_runtime.h>
#include <hip/hip_cooperative_groups.h>
#include <cstdio>
namespace cg = cooperative_groups;

typedef unsigned short bf16_t;
typedef short bf16x8 __attribute__((ext_vector_type(8)));
typedef float f32x4 __attribute__((ext_vector_type(4)));
typedef float f32x16 __attribute__((ext_vector_type(16)));

#define LDS_BYTES 163840
#define HALF_LDS 81920
#define NPHASE 19

struct P {
  const float *x, *c, *ctx, *c_ctx, *mod_w, *mod_b, *norm_mix_g, *norm_ffn_g;
  const float *w_dq, *g_q, *w_uq, *w_dkv, *g_kv, *w_uk, *w_uv, *w_o;
  const float *hy_w_in, *hy_b_in, *hy_conv_w, *hy_conv_b, *f_w1, *f_b1, *f_freq1, *f_w2, *f_b2, *f_freq2, *f_w3, *hy_decay, *hy_d_bias, *hy_w_out, *hy_b_out;
  const float *ffn_w_up, *ffn_conv_w, *ffn_conv_b, *ffn_w_down, *final_g;
  float* X;
  bf16_t *wt_dq, *wt_dkv, *wt_uq, *wt_uk, *wt_uv, *wt_o, *wt_hin, *wt_hout, *wt_up0, *wt_up1, *wt_dn0, *wt_dn1;
  float *modv, *rq, *rkv, *modp;
  unsigned* bar;
  bf16_t *wt_f3, *h2bf, *X16;
  bf16_t *Rf, *kpe, *hxc, *cq, *kv, *Q, *Kn, *Vt, *act, *x1h, *vvT, *Yp;
  int ph0, ph1;
};

typedef const __attribute__((address_space(4))) P CP;
__device__ __forceinline__ int get_tid512() { int t = threadIdx.x; asm volatile("" : "+v"(t)); return t; }
__device__ __forceinline__ int get_tid() { int t = threadIdx.x & 255; asm volatile("" : "+v"(t)); return t; }
__device__ __forceinline__ int get_hb() { int t = __builtin_amdgcn_readfirstlane((int)(threadIdx.x >> 8)); asm volatile("" : "+s"(t)); return t; }
__device__ __forceinline__ int get_rbid() { int t = blockIdx.x; asm volatile("" : "+s"(t)); return t; }
__device__ __forceinline__ int get_bid() { return 2 * get_rbid() + get_hb(); }
#define VGRID (2 * (int)gridDim.x)

__device__ __forceinline__ unsigned pack2(float a, float b) { unsigned r; asm("v_cvt_pk_bf16_f32 %0, %1, %2" : "=v"(r) : "v"(a), "v"(b)); return r; }
__device__ __forceinline__ bf16_t f2bf(float f) { return (bf16_t)(pack2(f, f) & 0xffffu); }
__device__ __forceinline__ float bf2f(bf16_t h) { return __uint_as_float(((unsigned)h) << 16); }
__device__ __forceinline__ float wave_sum(float v) {
#pragma unroll
  for (int o = 32; o; o >>= 1) v += __shfl_xor(v, o);
  return v;
}


#define XB_TMO      128
#define XB_XCNT(j)  (256  + 64 * (j))
#define XB_XSUB(j)  (1280 + 64 * (j))
#define XB_XGEN(j)  (2304 + 64 * (j))
#define XB_TOP      3328
#define XB_TOPGEN   3392
#define XCD_BAR_WORDS 3456
#define XB_SPIN_CAP (1u << 18)
#define LAS __attribute__((address_space(3)))
__device__ __forceinline__ unsigned xb_ld(unsigned* p)              { return __hip_atomic_load(p, __ATOMIC_RELAXED, __HIP_MEMORY_SCOPE_AGENT); }
__device__ __forceinline__ unsigned xb_add(unsigned* p, unsigned v) { return __hip_atomic_fetch_add(p, v, __ATOMIC_RELAXED, __HIP_MEMORY_SCOPE_AGENT); }
__device__ __forceinline__ unsigned xb_xcc_id() { return (unsigned)__builtin_amdgcn_s_getreg((3 << 11) | 20) & 0xFu; }
#define XB_SPIN(cond, bar) do { unsigned _sp = 0; while (cond) { __builtin_amdgcn_s_sleep(1); \
    if ((++_sp & 255u) == 0u) { if (xb_ld(&(bar)[XB_TMO])) break; if (_sp > XB_SPIN_CAP) { atomicAdd(&(bar)[XB_TMO], 1u); break; } } } } while (0)
struct XcdBarrier { unsigned* bar; unsigned x; volatile LAS unsigned* st; };
__device__ __forceinline__ XcdBarrier xcd_barrier_post(unsigned* bar, volatile LAS unsigned* st) {
    XcdBarrier b; b.bar = bar; b.x = xb_xcc_id(); b.st = st;
    if (threadIdx.x == 0) (void)xb_add(&bar[XB_XCNT(b.x)], 1u);
    return b;
}
__device__ __forceinline__ void xcd_barrier_complete(unsigned* bar, unsigned x, unsigned& nloc, unsigned& nx) {
    const unsigned G = gridDim.x * gridDim.y * gridDim.z;
    unsigned sum, cnt, mine, sp = 0u;
    for (;;) {
        sum = 0u; cnt = 0u; mine = 0u;
#pragma unroll
        for (unsigned j = 0; j < 16; ++j) { const unsigned c = xb_ld(&bar[XB_XCNT(j)]); sum += c; cnt += (c > 0u) ? 1u : 0u; mine = (j == x) ? c : mine; }
        if (sum == G) break;
        __builtin_amdgcn_s_sleep(1);
        if ((++sp & 255u) == 0u) { if (xb_ld(&bar[XB_TMO])) break; if (sp > XB_SPIN_CAP) { atomicAdd(&bar[XB_TMO], 1u); break; } }
    }
    nloc = mine > 0u ? mine : 1u; nx = cnt > 0u ? cnt : 1u;
}
__device__ __forceinline__ void xcd_barrier(const XcdBarrier& b) {
    asm volatile("s_waitcnt vmcnt(0)" ::: "memory");
    __syncthreads();
    if (threadIdx.x == 0) {
        unsigned* bar = b.bar;
        __builtin_amdgcn_s_waitcnt(0);
        unsigned nloc = b.st[0], nx = b.st[1];
        if (nloc == 0u) { xcd_barrier_complete(bar, b.x, nloc, nx); b.st[0] = nloc; b.st[1] = nx; }
        const unsigned old = xb_add(&bar[XB_XSUB(b.x)], 1u);
        const unsigned gen = old / nloc;
        if (old + 1u == (gen + 1u) * nloc) {
            __builtin_amdgcn_fence(__ATOMIC_RELEASE, "agent");
            asm volatile("s_waitcnt vmcnt(0)" ::: "memory");
            const unsigned og = xb_add(&bar[XB_TOP], 1u);
            const unsigned tg = og / nx;
            if (og + 1u == (tg + 1u) * nx) xb_add(&bar[XB_TOPGEN], 1u);
            else XB_SPIN(xb_ld(&bar[XB_TOPGEN]) == tg, bar);
            __builtin_amdgcn_fence(__ATOMIC_ACQUIRE, "agent");
            xb_add(&bar[XB_XGEN(b.x)], 1u);
            asm volatile("s_waitcnt vmcnt(0)" ::: "memory");
        } else {
            XB_SPIN(xb_ld(&bar[XB_XGEN(b.x)]) == gen, bar);
            __builtin_amdgcn_fence(__ATOMIC_ACQUIRE, "agent");
            asm volatile("s_waitcnt vmcnt(0)" ::: "memory");
        }
    }
    __syncthreads();
}

__device__ __forceinline__ void prep_weight_tile(CP& p, char* smem, int wt) {
  const int tid = get_tid();
  int id = 0;
  {
    const int cnt[13] = {64, 40, 96, 32, 32, 128, 384, 128, 704, 704, 352, 352, 32};
#pragma unroll
    for (int i = 0; i < 12; ++i) { if (id == i && wt >= cnt[i]) { wt -= cnt[i]; id = i + 1; } }
  }
  const float* src; int K, N; bf16_t* dst; const float* scale = nullptr; int perm = 0;
  switch (id) {
    case 0: src = p.w_dq; K = 1024; N = 512; dst = p.wt_dq; break;
    case 1: src = p.w_dkv; K = 1024; N = 288; dst = p.wt_dkv; break;
    case 2: src = p.w_uq; K = 512; N = 1536; dst = p.wt_uq; scale = p.g_q; break;
    case 3: src = p.w_uk; K = 256; N = 1024; dst = p.wt_uk; scale = p.g_kv; break;
    case 4: src = p.w_uv; K = 256; N = 1024; dst = p.wt_uv; scale = p.g_kv; break;
    case 5: src = p.w_o; K = 1024; N = 1024; dst = p.wt_o; break;
    case 6: src = p.hy_w_in; K = 1024; N = 3072; dst = p.wt_hin; break;
    case 7: src = p.hy_w_out; K = 1024; N = 1024; dst = p.wt_hout; break;
    case 8: src = p.ffn_w_up; K = 1024; N = 5632; dst = p.wt_up0; perm = 1; break;
    case 9: src = p.ffn_w_up + (size_t)1024 * 5632; K = 1024; N = 5632; dst = p.wt_up1; perm = 1; break;
    case 10: src = p.ffn_w_down; K = 2816; N = 1024; dst = p.wt_dn0; break;
    case 11: src = p.ffn_w_down + (size_t)2816 * 1024; K = 2816; N = 1024; dst = p.wt_dn1; break;
    default: src = p.f_w3; K = 64; N = 2048; dst = p.wt_f3; break;
  }
  const int ntn = (N + 63) >> 6;
  const int kt = wt / ntn, nt = wt - kt * ntn;
  const int k0 = kt * 128, n0 = nt * 64;
  int np0;
  if (perm == 1) { const int half = n0 / 2816, f = n0 - half * 2816; np0 = (f >> 6) * 128 + half * 64; }
  else if (perm == 2) { if (n0 < 1024) np0 = n0; else { const int m = n0 - 1024, half = m >> 10, f = m & 1023; np0 = 1024 + (f >> 6) * 128 + half * 64; } }
  else np0 = n0;
  bf16_t* t16 = (bf16_t*)smem;
  f32x4 v[8];
#pragma unroll
  for (int i = 0; i < 8; ++i) {
    const int idx = tid + 256 * i; const int kr = idx >> 4, c4 = idx & 15;
    v[i] = (f32x4){0.f, 0.f, 0.f, 0.f};
    if (n0 + 4 * c4 < N && k0 + kr < K) v[i] = __builtin_nontemporal_load((const f32x4*)(src + (size_t)(k0 + kr) * N + n0 + 4 * c4));
  }
#pragma unroll
  for (int i = 0; i < 8; ++i) {
    const int idx = tid + 256 * i; const int kr = idx >> 4, c4 = idx & 15;
    const float sc = (scale && k0 + kr < K) ? scale[k0 + kr] : 1.f;
#pragma unroll
    for (int j = 0; j < 4; ++j) t16[(4 * c4 + j) * 136 + kr] = f2bf(v[i][j] * sc);
  }
  __syncthreads();
#pragma unroll
  for (int i = 0; i < 4; ++i) {
    const int idx = tid + 256 * i; const int n = idx >> 4, ch = idx & 15;
    if (n0 + n < N && k0 + ch * 8 < K) *(uint4*)(dst + (size_t)(np0 + n) * K + k0 + ch * 8) = *(const uint4*)(t16 + n * 136 + ch * 8);
  }
  __syncthreads();
}

__device__ __forceinline__ void prep_modvec(CP& p, char* smem, int it) {
  const int tid = get_tid();
  const int layer = it / 384, rem = it - layer * 384, cb = rem >> 2, ks = rem & 3;
  float* s_lds = (float*)smem;
  float* red = (float*)(smem + 12288);
  const int kbase = ks * 256;
  for (int idx = tid; idx < 9 * 256; idx += 256) {
    const int r = idx >> 8, k = idx & 255;
    const float v = r < 8 ? p.c[r * 1024 + kbase + k] : p.c_ctx[kbase + k];
    s_lds[k * 12 + r] = v / (1.f + __expf(-v));
  }
  __syncthreads();
  const int col = cb * 64 + (tid & 63), kg = tid >> 6;
  const float* W = p.mod_w + (size_t)layer * 1024 * 6144 + (size_t)kbase * 6144 + col;
  float acc[9];
#pragma unroll
  for (int r = 0; r < 9; ++r) acc[r] = 0.f;
#pragma unroll
  for (int kb = 0; kb < 4; ++kb) {
    float w[16];
#pragma unroll
    for (int u = 0; u < 16; ++u) w[u] = __builtin_nontemporal_load(W + (size_t)(kg * 64 + kb * 16 + u) * 6144);
#pragma unroll
    for (int u = 0; u < 16; ++u) {
      const int k = kg * 64 + kb * 16 + u;
      const f32x4 s0 = *(const f32x4*)(s_lds + k * 12), s1 = *(const f32x4*)(s_lds + k * 12 + 4);
      const float s2 = s_lds[k * 12 + 8];
      acc[0] += s0[0] * w[u]; acc[1] += s0[1] * w[u]; acc[2] += s0[2] * w[u]; acc[3] += s0[3] * w[u];
      acc[4] += s1[0] * w[u]; acc[5] += s1[1] * w[u]; acc[6] += s1[2] * w[u]; acc[7] += s1[3] * w[u];
      acc[8] += s2 * w[u];
    }
  }
#pragma unroll
  for (int r = 0; r < 9; ++r) red[(kg * 9 + r) * 64 + (tid & 63)] = acc[r];
  __syncthreads();
  for (int o = tid; o < 9 * 64; o += 256) {
    const int r = o >> 6, cl = o & 63;
    const float sm = red[(0 * 9 + r) * 64 + cl] + red[(1 * 9 + r) * 64 + cl] + red[(2 * 9 + r) * 64 + cl] + red[(3 * 9 + r) * 64 + cl];
    p.modp[(size_t)ks * 110592 + (size_t)(layer * 9 + r) * 6144 + cb * 64 + cl] = sm;
  }
  __syncthreads();
}

__device__ __forceinline__ void prep_filter(CP& p, char* smem, int it) {
  const int tid = get_tid();
  float* z = (float*)smem;
  float* h1 = z + 8 * 33;
  float* h2 = h1 + 8 * 64;
  const int t0 = it * 8;
  for (int idx = tid; idx < 8 * 33; idx += 256) {
    const int pp = idx / 33, i = idx - pp * 33;
    const int t = t0 + pp;
    float v;
    if (i == 0) v = (float)t * (1.0f / 2047.0f);
    else {
      const int k = (i - 1) & 15;
      const float w = (6.283185307179586f * (float)t) / 2048.0f;
      const float f = 1e-4f + (float)k * ((15.0f - 1e-4f) / 15.0f);
      const float a = w * f;
      v = (i <= 16) ? __cosf(a) : -__sinf(a);
    }
    z[idx] = v;
  }
  __syncthreads();
  for (int idx = tid; idx < 8 * 64; idx += 256) {
    const int pp = idx >> 6, j = idx & 63;
    float s = p.f_b1[j];
#pragma unroll
    for (int i = 0; i < 33; ++i) s += z[pp * 33 + i] * p.f_w1[i * 64 + j];
    h1[idx] = __sinf(p.f_freq1[j] * s);
  }
  __syncthreads();
  for (int idx = tid; idx < 8 * 64; idx += 256) {
    const int pp = idx >> 6, j = idx & 63;
    float s = p.f_b2[j];
#pragma unroll 16
    for (int i = 0; i < 64; ++i) s += h1[pp * 64 + i] * p.f_w2[i * 64 + j];
    h2[idx] = __sinf(p.f_freq2[j] * s);
  }
  __syncthreads();
  for (int idx = tid; idx < 8 * 64; idx += 256) p.h2bf[(size_t)t0 * 64 + idx] = f2bf(h2[idx]);
  __syncthreads();
}

__device__ __forceinline__ void phase_prep(CP& p, char* smem) {
  const int total = 768 + 256 + 3048;
  for (int it = get_bid(); it < total; it += VGRID) {
    if (it < 768) prep_modvec(p, smem, it);
    else if (it < 1024) prep_filter(p, smem, it - 768);
    else prep_weight_tile(p, smem, it - 1024);
  }
}

__device__ __forceinline__ f32x4 ld4_bf16(const bf16_t* p) {
  const uint2 u = *(const uint2*)p;
  f32x4 r; r[0] = bf2f((bf16_t)(u.x & 0xffff)); r[1] = bf2f((bf16_t)(u.x >> 16)); r[2] = bf2f((bf16_t)(u.y & 0xffff)); r[3] = bf2f((bf16_t)(u.y >> 16));
  return r;
}
template <bool PART, bool SRC16 = false>
__device__ __forceinline__ void normmod_row2(const void* __restrict__ srcv, const float* __restrict__ g, const float* __restrict__ sh, const float* __restrict__ sc, bf16_t* __restrict__ dst, int lane, const float* __restrict__ bsh = nullptr) {
  f32x4 v[2][4]; float ss0 = 0.f, ss1 = 0.f;
#pragma unroll
  for (int i = 0; i < 4; ++i) {
    if (SRC16) { v[0][i] = ld4_bf16((const bf16_t*)srcv + lane * 4 + 256 * i); v[1][i] = ld4_bf16((const bf16_t*)srcv + 1024 + lane * 4 + 256 * i); }
    else { v[0][i] = __builtin_nontemporal_load((const f32x4*)((const float*)srcv + lane * 4 + 256 * i)); v[1][i] = __builtin_nontemporal_load((const f32x4*)((const float*)srcv + 1024 + lane * 4 + 256 * i)); }
  }
#pragma unroll
  for (int i = 0; i < 4; ++i) {
    ss0 += v[0][i][0] * v[0][i][0] + v[0][i][1] * v[0][i][1] + v[0][i][2] * v[0][i][2] + v[0][i][3] * v[0][i][3];
    ss1 += v[1][i][0] * v[1][i][0] + v[1][i][1] * v[1][i][1] + v[1][i][2] * v[1][i][2] + v[1][i][3] * v[1][i][3];
  }
  ss0 = wave_sum(ss0); ss1 = wave_sum(ss1);
  const float r0 = rsqrtf(ss0 * (1.0f / 1024.0f) + 1e-6f), r1 = rsqrtf(ss1 * (1.0f / 1024.0f) + 1e-6f);
#pragma unroll
  for (int i = 0; i < 4; ++i) {
    const int k = lane * 4 + 256 * i;
    const f32x4 g4 = *(const f32x4*)(g + k);
    f32x4 s4 = *(const f32x4*)(sh + k), c4 = *(const f32x4*)(sc + k);
    if (PART) {
#pragma unroll
      for (int q = 1; q < 4; ++q) { s4 += *(const f32x4*)(sh + (size_t)q * 110592 + k); c4 += *(const f32x4*)(sc + (size_t)q * 110592 + k); }
      s4 += *(const f32x4*)(bsh + k); c4 += *(const f32x4*)(bsh + 1024 + k);
    }
    float y[4], z[4];
#pragma unroll
    for (int j = 0; j < 4; ++j) { const float gm = g4[j] * (1.f + c4[j]); y[j] = (v[0][i][j] * r0) * gm + s4[j]; z[j] = (v[1][i][j] * r1) * gm + s4[j]; }
    uint2 u; u.x = pack2(y[0], y[1]); u.y = pack2(y[2], y[3]);
    *(uint2*)(dst + k) = u;
    u.x = pack2(z[0], z[1]); u.y = pack2(z[2], z[3]);
    *(uint2*)(dst + 1024 + k) = u;
  }
}

__device__ __forceinline__ void phase_normmod_kv(CP& p) {
  const int lane = get_tid() & 63, wv = get_tid() >> 6;
  const float* g = p.norm_mix_g;
  for (int idx = get_bid() * 256 + get_tid(); idx < 110592; idx += VGRID * 256) {
    const int lr = idx / 6144; const int n = idx - lr * 6144; const int layer = lr / 9;
    p.modv[idx] = p.modp[idx] + p.modp[110592 + idx] + p.modp[2 * 110592 + idx] + p.modp[3 * 110592 + idx] + p.mod_b[layer * 6144 + n];
  }
  for (int r = (get_bid() * 4 + wv) * 2; r < 18432; r += VGRID * 8) {
    const int b = r / 2304, pp = r - b * 2304;
    const float* src; const float* mv;
    if (pp < 256) { src = p.ctx + ((size_t)b * 256 + pp) * 1024; mv = p.modp + (size_t)8 * 6144; }
    else { src = p.x + ((size_t)b * 2048 + pp - 256) * 1024; mv = p.modp + (size_t)b * 6144; }
    normmod_row2<true>(src, g, mv, mv + 1024, p.hxc + (size_t)r * 1024, lane, p.mod_b);
  }
}
__device__ __forceinline__ void phase_normmod_x(CP& p, const float* g, int layer, int chunk) {
  const int lane = get_tid() & 63, wv = get_tid() >> 6;
  for (int r = (get_bid() * 4 + wv) * 2; r < 16384; r += VGRID * 8) {
    const int b = r >> 11;
    const float* mv = p.modv + (size_t)(layer * 9 + b) * 6144 + chunk * 1024;
    normmod_row2<false, true>(p.X16 + (size_t)r * 1024, g, mv, mv + 1024, p.hxc + (size_t)r * 1024, lane);
  }
}
__device__ __forceinline__ void phase_final_norm(CP& p) {
  const int lane = get_tid() & 63, wv = get_tid() >> 6;
  for (int r = get_bid() * 4 + wv; r < 16384; r += VGRID * 4) {
    const bf16_t* srow = p.X16 + (size_t)r * 1024;
    float* row = p.X + (size_t)r * 1024;
    f32x4 v[4]; float ss = 0.f;
#pragma unroll
    for (int i = 0; i < 4; ++i) { v[i] = ld4_bf16(srow + lane * 4 + 256 * i); ss += v[i][0] * v[i][0] + v[i][1] * v[i][1] + v[i][2] * v[i][2] + v[i][3] * v[i][3]; }
    ss = wave_sum(ss);
    const float rr = rsqrtf(ss * (1.0f / 1024.0f) + 1e-6f);
#pragma unroll
    for (int i = 0; i < 4; ++i) {
      const int k = lane * 4 + 256 * i;
      const f32x4 g4 = *(const f32x4*)(p.final_g + k);
      f32x4 o; o[0] = v[i][0] * rr * g4[0]; o[1] = v[i][1] * rr * g4[1]; o[2] = v[i][2] * rr * g4[2]; o[3] = v[i][3] * rr * g4[3];
      __builtin_nontemporal_store(o, (f32x4*)(row + k));
    }
  }
}

__device__ __forceinline__ void phase_rowstat(CP& p) {
  const int lane = get_tid() & 63, wv = get_tid() >> 6;
  for (int r = get_bid() * 4 + wv; r < 18432; r += VGRID * 4) {
    const int b = r / 2304, pp = r - b * 2304;
    const bf16_t* kvr = p.kv + (size_t)r * 288;
    {
      const uint2 u = *(const uint2*)(kvr + lane * 4);
      const float a0 = bf2f((bf16_t)(u.x & 0xffff)), a1 = bf2f((bf16_t)(u.x >> 16)), a2 = bf2f((bf16_t)(u.y & 0xffff)), a3 = bf2f((bf16_t)(u.y >> 16));
      float ss = a0 * a0 + a1 * a1 + a2 * a2 + a3 * a3;
      ss = wave_sum(ss);
      if (lane == 0) p.rkv[r] = rsqrtf(ss * (1.0f / 256.0f) + 1e-6f);
    }
    {
      const int i = lane & 31;
      const float xv = bf2f(kvr[256 + i]);
      const float ov = __shfl_xor(xv, 8);
      float res = xv;
      if (pp >= 256) {
        const int t = pp - 256;
        const int quarter = i >> 3, idx = i & 7;
        const float pos = (quarter < 2) ? (float)(t >> 6) : (float)(t & 63);
        const float inv = exp2f(-(float)idx * (13.287712379549449f / 8.0f));
        const float ang = pos * inv;
        const float cs = __cosf(ang), sn = __sinf(ang);
        res = xv * cs + ((quarter & 1) ? ov : -ov) * sn;
      }
      if (lane < 32) p.kpe[(size_t)r * 32 + i] = f2bf(res);
    }
    if (pp >= 256) {
      const int xr = b * 2048 + pp - 256;
      const uint4 u = *(const uint4*)(p.cq + (size_t)xr * 512 + lane * 8);
      const unsigned uu[4] = {u.x, u.y, u.z, u.w};
      float ss = 0.f;
#pragma unroll
      for (int j = 0; j < 4; ++j) { const float a = bf2f((bf16_t)(uu[j] & 0xffff)), bb = bf2f((bf16_t)(uu[j] >> 16)); ss += a * a + bb * bb; }
      ss = wave_sum(ss);
      if (lane == 0) p.rq[xr] = rsqrtf(ss * (1.0f / 512.0f) + 1e-6f);
    }
  }
}

template <int NP>
struct EpiStore {
  static constexpr int KIND = 0; static constexpr bool ROWSUM = false;
  bf16_t* out; int ld; int ostride; const float* part; int pstride; float inv_n;
  __device__ __forceinline__ void c4(int g, int rig, int col, f32x4 v) const {
    const size_t row = (size_t)g * ostride + rig;
    float s = 1.f;
    if (NP > 0) {
      float t = 0.f;
#pragma unroll
      for (int q = 0; q < NP; ++q) t += part[(size_t)q * pstride + row];
      s = rsqrtf(t * inv_n + 1e-6f);
    }
    uint2 u; u.x = pack2(v[0] * s, v[1] * s); u.y = pack2(v[2] * s, v[3] * s);
    *(uint2*)(out + row * ld + col) = u;
  }
};
struct EpiDown {
  static constexpr int KIND = 0; static constexpr bool ROWSUM = true;
  bf16_t* out; int ld; int ostride; float* part; int nslots; bf16_t* kpe; int ropecol;
  __device__ __forceinline__ float c4(int g, int rig, int col, f32x4 v) const {
    const size_t row = (size_t)g * ostride + rig;
    if (kpe && col >= ropecol) {
      const int i0 = col - ropecol;
      f32x4 o = v;
      const float p0 = __shfl_xor(v[0], 32), p1 = __shfl_xor(v[1], 32), p2 = __shfl_xor(v[2], 32), p3 = __shfl_xor(v[3], 32);
      const float pv[4] = {p0, p1, p2, p3};
      if (rig >= 256) {
        const int t = rig - 256;
        const int quarter = i0 >> 3;
        const float pos = (quarter < 2) ? (float)(t >> 6) : (float)(t & 63);
#pragma unroll
        for (int j = 0; j < 4; ++j) {
          const int idx = (i0 & 7) + j;
          const float inv = exp2f(-(float)idx * (13.287712379549449f / 8.0f));
          const float ang = pos * inv;
          const float cs = __cosf(ang), sn = __sinf(ang);
          o[j] = v[j] * cs + ((quarter & 1) ? pv[j] : -pv[j]) * sn;
        }
      }
      uint2 u; u.x = pack2(o[0], o[1]); u.y = pack2(o[2], o[3]);
      *(uint2*)(kpe + row * 32 + i0) = u;
      return 0.f;
    }
    uint2 u; u.x = pack2(v[0], v[1]); u.y = pack2(v[2], v[3]);
    *(uint2*)(out + row * ld + col) = u;
    return v[0] * v[0] + v[1] * v[1] + v[2] * v[2] + v[3] * v[3];
  }
  __device__ __forceinline__ void rowsum(int g, int rig, int slot, float ss) const {
    if (slot < nslots) part[(size_t)slot * ((size_t)8 * ostride) + (size_t)g * ostride + rig] = ss;
  }
};
struct EpiVt {
  static constexpr int KIND = 1;
  bf16_t* out; const float* part;
  __device__ __forceinline__ void r4(int g, int rig, int col, f32x4 v) const {
    const size_t row = (size_t)g * 2304 + rig;
    const f32x4 t = *(const f32x4*)(part + row) + *(const f32x4*)(part + 18432 + row);
    f32x4 s;
#pragma unroll
    for (int j = 0; j < 4; ++j) s[j] = rsqrtf(t[j] * (1.0f / 256.0f) + 1e-6f);
    uint2 u; u.x = pack2(v[0] * s[0], v[1] * s[1]); u.y = pack2(v[2] * s[2], v[3] * s[3]);
    *(uint2*)(out + ((size_t)g * 1024 + col) * 2304 + rig) = u;
  }
};
struct EpiBiasStore {
  static constexpr int KIND = 0; static constexpr bool ROWSUM = false;
  bf16_t* out; int ld; const float* bias;
  __device__ __forceinline__ void c4(int g, int rig, int col, f32x4 v) const {
    const size_t row = (size_t)g * 2048 + rig;
    const f32x4 b4 = *(const f32x4*)(bias + col);
    uint2 u; u.x = pack2(v[0] + b4[0], v[1] + b4[1]); u.y = pack2(v[2] + b4[2], v[3] + b4[3]);
    *(uint2*)(out + row * ld + col) = u;
  }
};
struct EpiBiasT {
  static constexpr int KIND = 1;
  bf16_t* out; const float* bias;
  __device__ __forceinline__ void r4(int g, int rig, int col, f32x4 v) const {
    const float b = bias[col];
    uint2 u; u.x = pack2(v[0] + b, v[1] + b); u.y = pack2(v[2] + b, v[3] + b);
    *(uint2*)(out + (size_t)col * 16384 + (size_t)g * 2048 + rig) = u;
  }
};
struct EpiFilt {
  static constexpr int KIND = 1;
  bf16_t* Rf; const float* decay;
  __device__ __forceinline__ void r4(int g, int rig, int col, f32x4 v) const {
    const int c = col & 1023; const bool bwd = col >= 1024;
    const float dec = fabsf(decay[c]);
    bf16_t* rp = Rf + (size_t)c * 4096;
#pragma unroll
    for (int j = 0; j < 4; ++j) {
      const int t = rig + j;
      const float val = v[j] * __expf(-(float)t * (1.0f / 2047.0f) * dec);
      if (!bwd) rp[2048 - t] = f2bf(val);
      else if (t > 0) rp[2048 + t] = f2bf(val);
      else rp[0] = 0;
    }
  }
};
template <bool BASE_F32>
struct EpiResid {
  static constexpr int KIND = 0; static constexpr bool ROWSUM = false;
  bf16_t* X16; const void* base; const float* gate; const float* bias;
  __device__ __forceinline__ void c4(int g, int rig, int col, f32x4 v) const {
    const size_t o = ((size_t)g * 2048 + rig) * 1024 + col;
    f32x4 bs;
    if (BASE_F32) bs = __builtin_nontemporal_load((const f32x4*)((const float*)base + o));
    else {
      const uint2 u = *(const uint2*)((const bf16_t*)base + o);
      bs[0] = bf2f((bf16_t)(u.x & 0xffff)); bs[1] = bf2f((bf16_t)(u.x >> 16)); bs[2] = bf2f((bf16_t)(u.y & 0xffff)); bs[3] = bf2f((bf16_t)(u.y >> 16));
    }
    const f32x4 gt = *(const f32x4*)(gate + (size_t)g * 6144 + col);
    f32x4 bi = {0.f, 0.f, 0.f, 0.f};
    if (bias) bi = *(const f32x4*)(bias + col);
    f32x4 r;
#pragma unroll
    for (int j = 0; j < 4; ++j) r[j] = bs[j] + gt[j] * (v[j] + bi[j]);
    uint2 w; w.x = pack2(r[0], r[1]); w.y = pack2(r[2], r[3]);
    *(uint2*)(X16 + o) = w;
  }
};
template <int MODE>
struct EpiConv {
  static constexpr int KIND = 2;
  const float* cw; const float* cb; int NC; const float* pre_bias;
  bf16_t* o0; bf16_t* o1;
  __device__ __forceinline__ int norig(int nt, int cl) const {
    if (MODE == 0) return (cl >> 6) * 2816 + nt * 64 + (cl & 63);
    if (nt < 8) return nt * 128 + cl;
    return 1024 + (cl >> 6) * 1024 + (nt - 8) * 64 + (cl & 63);
  }
  typedef float f32x2_t __attribute__((ext_vector_type(2)));
  static __device__ __forceinline__ f32x2_t ldz(const bf16_t* Z, int row, int col) {
    const unsigned u = *(const unsigned*)(Z + row * 132 + col);
    f32x2_t r; r[0] = __uint_as_float(u << 16); r[1] = __uint_as_float(u & 0xffff0000u); return r;
  }
  template <class F>
  __device__ __forceinline__ void finish(const bf16_t* Z, int g, int rig0, int nt, F&& pre) const {
    typedef f32x2_t f32x2;
    const int tid = get_tid();
    if (MODE == 0 || nt < 8) {
      if (MODE == 0) {
        const int f2 = (tid & 31) * 2, q8 = tid >> 5;
        const int q0 = 1 + 16 * q8, q1 = (q0 + 16 < 127) ? q0 + 16 : 127;
        const int na = norig(nt, f2), ng = norig(nt, 64 + f2);
        const f32x2 a0 = *(const f32x2*)(cw + na), a1 = *(const f32x2*)(cw + NC + na), a2 = *(const f32x2*)(cw + 2 * NC + na), ab = *(const f32x2*)(cb + na);
        const f32x2 g0 = *(const f32x2*)(cw + ng), g1 = *(const f32x2*)(cw + NC + ng), g2 = *(const f32x2*)(cw + 2 * NC + ng), gb = *(const f32x2*)(cb + ng);
        pre();
        f32x2 am = ldz(Z, q0 - 1, f2), ac = ldz(Z, q0, f2);
        f32x2 gm = ldz(Z, q0 - 1, 64 + f2), gc = ldz(Z, q0, 64 + f2);
#pragma unroll 4
        for (int pl = q0; pl < q1; ++pl) {
          const f32x2 an = ldz(Z, pl + 1, f2), gn = ldz(Z, pl + 1, 64 + f2);
          const int pos = rig0 + pl;
          if (pos < 2048) {
            const f32x2 av = a0 * am + a1 * ac + a2 * an + ab;
            const f32x2 gv = g0 * gm + g1 * gc + g2 * gn + gb;
            const float s0 = av[0] * gv[0] * __builtin_amdgcn_rcpf(1.f + __expf(-gv[0]));
            const float s1 = av[1] * gv[1] * __builtin_amdgcn_rcpf(1.f + __expf(-gv[1]));
            *(unsigned*)(o0 + ((size_t)g * 2048 + pos) * 2816 + nt * 64 + f2) = pack2(s0, s1);
          }
          am = ac; ac = an; gm = gc; gc = gn;
        }
      } else {
        const int cl = (tid & 63) * 2, q = tid >> 6;
        const int p0 = 1 + 32 * q, p1 = (p0 + 32 < 127) ? p0 + 32 : 127;
        const int na = norig(nt, cl);
        const f32x2 a0 = *(const f32x2*)(cw + na), a1 = *(const f32x2*)(cw + NC + na), a2 = *(const f32x2*)(cw + 2 * NC + na), ab = *(const f32x2*)(cb + na);
        pre();
        f32x2 am = ldz(Z, p0 - 1, cl), ac = ldz(Z, p0, cl);
#pragma unroll 2
        for (int pl = p0; pl < p1; ++pl) {
          const f32x2 an = ldz(Z, pl + 1, cl);
          const int pos = rig0 + pl;
          if (pos < 2048) {
            const f32x2 av = a0 * am + a1 * ac + a2 * an + ab;
            *(unsigned*)(o0 + ((size_t)g * 2048 + pos) * 1024 + nt * 128 + cl) = pack2(av[0], av[1]);
          }
          am = ac; ac = an;
        }
      }
    } else {
      pre();
      const int pl = tid & 127, fh = tid >> 7;
      const int pos = rig0 + pl;
      if (pl >= 1 && pl <= 126 && pos < 2048) {
        const int fb = nt - 8;
#pragma unroll 2
        for (int f = fh * 32; f < fh * 32 + 32; f += 2) {
          const int na = norig(nt, f), nb = norig(nt, 64 + f);
          const f32x2 va = *(const f32x2*)(cw + na) * ldz(Z, pl - 1, f) + *(const f32x2*)(cw + NC + na) * ldz(Z, pl, f)
                         + *(const f32x2*)(cw + 2 * NC + na) * ldz(Z, pl + 1, f) + *(const f32x2*)(cb + na);
          const f32x2 vb = *(const f32x2*)(cw + nb) * ldz(Z, pl - 1, 64 + f) + *(const f32x2*)(cw + NC + nb) * ldz(Z, pl, 64 + f)
                         + *(const f32x2*)(cw + 2 * NC + nb) * ldz(Z, pl + 1, 64 + f) + *(const f32x2*)(cb + nb);
          bf16_t* op = o1 + (size_t)(fb * 64 + f) * 16384 + g * 2048 + pos;
          op[0] = f2bf(va[0] * vb[0]);
          op[16384] = f2bf(va[1] * vb[1]);
        }
      }
    }
  }
};

#define GLDS16(gp, lp) __builtin_amdgcn_global_load_lds((const unsigned*)(gp), (__attribute__((address_space(3))) unsigned*)(lp), 16, 0, 0)

template <bool SWAP, class Epi, bool THIN = false>
__device__ __forceinline__ void gemm_job(char* smem, const bf16_t* __restrict__ A, int lda, const bf16_t* __restrict__ Bt, int K, int N,
                                         int tpg, int a_gstride, int a_goff, int step, int halo, int grows, int MTS, int voff, int vid0, int grid, const Epi& epi) {
  const int tid = get_tid512(), lane = tid & 63, wid = tid >> 6, wr = wid >> 1, wc = wid & 1, fr = lane & 15, fq = lane >> 4;
  const int NT = (N + 255) >> 8, MT = MTS >> 1, ntiles = MT * NT, ns = K >> 6;
  const int full = MT >> 3;
  int v = vid0;
  if (v < voff) v += ((voff - v + grid - 1) / grid) * grid;
  const int swz = (fr >> 1) & 7;
  bool pre_issued = false;
  for (; v < voff + ntiles; v += grid) {
    const int w = v - voff;
    int mt, nt;
    if (w < full * 8 * NT) { const int sr = w / (8 * NT), rem = w - sr * 8 * NT; nt = rem >> 3; mt = sr * 8 + (rem & 7); }
    else { const int w2 = w - full * 8 * NT, rl = MT - full * 8; nt = w2 / rl; mt = full * 8 + (w2 - nt * rl); }
    unsigned ap[4], bp[4];
#pragma unroll
    for (int i = 0; i < 4; ++i) {
      const int r = (tid >> 3) + 64 * i;
      const int cs = tid & 7;
      const int c = ((cs ^ ((r >> 1) & 7)) << 3);
      const int sub = 2 * mt + (r >> 7);
      const int g = sub / tpg, ti = sub - g * tpg;
      int rig = ti * step - halo + (r & 127); rig = rig < 0 ? 0 : (rig > grows - 1 ? grows - 1 : rig);
      ap[i] = (unsigned)((g * a_gstride + a_goff + rig) * lda + c);
      int br = nt * 256 + r; br = br > N - 1 ? N - 1 : br;
      bp[i] = (unsigned)(br * K + c);
    }
    const bool have_next = false;
    f32x4 acc[4][8];
#pragma unroll
    for (int m = 0; m < 4; ++m)
#pragma unroll
      for (int n = 0; n < 8; ++n) acc[m][n] = (f32x4){0.f, 0.f, 0.f, 0.f};
    if (!pre_issued) {
#pragma unroll
      for (int i = 0; i < 4; ++i) { GLDS16(A + (size_t)ap[i], smem + tid * 16 + i * 8192); GLDS16(Bt + (size_t)bp[i], smem + 32768 + tid * 16 + i * 8192); }
    }
    pre_issued = have_next;
    for (int st = 0; st < ns; ++st) {
      asm volatile("s_waitcnt vmcnt(0)" ::: "memory");
      __builtin_amdgcn_s_barrier();
      asm volatile("" ::: "memory");
      if (st + 1 < ns) {
        char* nb = smem + ((st + 1) & 1) * 65536;
        const int ko = (st + 1) * 64;
#pragma unroll
        for (int i = 0; i < 4; ++i) { GLDS16(A + (size_t)(ap[i] + ko), nb + tid * 16 + i * 8192); GLDS16(Bt + (size_t)(bp[i] + ko), nb + 32768 + tid * 16 + i * 8192); }
      }
      const char* sa = smem + (st & 1) * 65536 + (wr * 64 + fr) * 128;
      const char* sb = smem + (st & 1) * 65536 + 32768 + (wc * 128 + fr) * 128;
      if constexpr (THIN) {
        if (wc == 0) {
#pragma unroll
          for (int ks = 0; ks < 2; ++ks) {
            bf16x8 af[4], bf[2];
#pragma unroll
            for (int m = 0; m < 4; ++m) af[m] = *(const bf16x8*)(sa + m * 2048 + (((ks * 4 + fq) ^ swz) << 4));
#pragma unroll
            for (int n = 0; n < 2; ++n) bf[n] = *(const bf16x8*)(sb + n * 2048 + (((ks * 4 + fq) ^ swz) << 4));
#pragma unroll
            for (int m = 0; m < 4; ++m)
#pragma unroll
              for (int n = 0; n < 2; ++n)
                acc[m][n] = SWAP ? __builtin_amdgcn_mfma_f32_16x16x32_bf16(bf[n], af[m], acc[m][n], 0, 0, 0)
                                 : __builtin_amdgcn_mfma_f32_16x16x32_bf16(af[m], bf[n], acc[m][n], 0, 0, 0);
          }
        }
      } else {
      bf16x8 afA[4], afB[4], bfb[2][2];
#pragma unroll
      for (int m = 0; m < 4; ++m) afA[m] = *(const bf16x8*)(sa + m * 2048 + ((fq ^ swz) << 4));
#pragma unroll
      for (int n = 0; n < 2; ++n) bfb[0][n] = *(const bf16x8*)(sb + n * 2048 + ((fq ^ swz) << 4));
#pragma unroll
      for (int gq = 0; gq < 8; ++gq) {
        const int ks = gq >> 2, nh = gq & 3;
        if (gq < 7) {
          const int ks2 = (gq + 1) >> 2, nh2 = (gq + 1) & 3;
#pragma unroll
          for (int n = 0; n < 2; ++n) bfb[(gq + 1) & 1][n] = *(const bf16x8*)(sb + (nh2 * 2 + n) * 2048 + (((ks2 * 4 + fq) ^ swz) << 4));
        }
        if (gq == 3) {
#pragma unroll
          for (int m = 0; m < 4; ++m) afB[m] = *(const bf16x8*)(sa + m * 2048 + (((4 + fq) ^ swz) << 4));
        }
        __builtin_amdgcn_sched_barrier(0);
#pragma unroll
        for (int m = 0; m < 4; ++m)
#pragma unroll
          for (int n = 0; n < 2; ++n) {
            const bf16x8 av = ks ? afB[m] : afA[m];
            acc[m][nh * 2 + n] = SWAP ? __builtin_amdgcn_mfma_f32_16x16x32_bf16(bfb[gq & 1][n], av, acc[m][nh * 2 + n], 0, 0, 0)
                                      : __builtin_amdgcn_mfma_f32_16x16x32_bf16(av, bfb[gq & 1][n], acc[m][nh * 2 + n], 0, 0, 0);
          }
      }
      }
    }
    __syncthreads();
    const int te = get_tid512();
    const int fr_e = te & 15, fq_e = (te & 63) >> 4, wr_e = te >> 7, wc_e = (te >> 6) & 1;
    const int sub = 2 * mt + (wr_e >> 1);
    const int g = sub / tpg, ti = sub - g * tpg;
    const int rig0 = ti * step - halo;
    const int rw = (wr_e & 1) * 64;
    if constexpr (Epi::KIND == 0) {
#pragma unroll
      for (int m = 0; m < 4; ++m) {
        const int rig = rig0 + rw + m * 16 + fr_e;
        if constexpr (Epi::ROWSUM) {
          float ss = 0.f;
#pragma unroll
          for (int n = 0; n < 8; ++n) {
            const int col = nt * 256 + wc_e * 128 + n * 16 + fq_e * 4;
            if (col < N) ss += epi.c4(g, rig, col, acc[m][n]);
          }
          ss += __shfl_xor(ss, 16); ss += __shfl_xor(ss, 32);
          if (fq_e == 0) epi.rowsum(g, rig, nt * 2 + wc_e, ss);
        } else {
#pragma unroll
          for (int n = 0; n < 8; ++n) {
            const int col = nt * 256 + wc_e * 128 + n * 16 + fq_e * 4;
            if (col < N) epi.c4(g, rig, col, acc[m][n]);
          }
        }
      }
    } else if constexpr (Epi::KIND == 1) {
#pragma unroll
      for (int m = 0; m < 4; ++m) {
        const int rig = rig0 + rw + m * 16 + fq_e * 4;
#pragma unroll
        for (int n = 0; n < 8; ++n) {
          const int col = nt * 256 + wc_e * 128 + n * 16 + fr_e;
          if (col < N) epi.r4(g, rig, col, acc[m][n]);
        }
      }
    } else {
      bf16_t* Zw = (bf16_t*)smem + ((wr_e >> 1) * 2 + wc_e) * (128 * 132);
      const int nt2w = nt * 2 + wc_e;
#pragma unroll
      for (int n = 0; n < 8; ++n) {
        const int cl = n * 16 + fq_e * 4;
        f32x4 b4 = {0.f, 0.f, 0.f, 0.f};
        if (epi.pre_bias) b4 = *(const f32x4*)(epi.pre_bias + epi.norig(nt2w, cl));
#pragma unroll
        for (int m = 0; m < 4; ++m) {
          const int rl = rw + m * 16 + fr_e;
          const int pos = rig0 + rl;
          const bool ok = pos >= 0 && pos < grows;
          f32x4 vv = acc[m][n] + b4;
          if (!ok) vv = (f32x4){0.f, 0.f, 0.f, 0.f};
          uint2 u; u.x = pack2(vv[0], vv[1]); u.y = pack2(vv[2], vv[3]);
          *(uint2*)(Zw + rl * 132 + cl) = u;
        }
      }
      __syncthreads();
      {
        auto no_pre = []() {};
        const bf16_t* Zr = (const bf16_t*)smem + ((wr_e >> 1) * 2) * (128 * 132);
        epi.finish(Zr, g, rig0, nt * 2, no_pre);
        epi.finish(Zr + 128 * 132, g, rig0, nt * 2 + 1, no_pre);
      }
      __syncthreads();
    }
    asm volatile("s_waitcnt vmcnt(0)" ::: "memory");
    __syncthreads();
  }
}

__device__ __forceinline__ void phase_attn(CP& p, char* smem, int vid0, int grid) {
  bf16_t* Ks = (bf16_t*)smem;
  bf16_t* Vs = (bf16_t*)(smem + 64 * 104 * 2);
  const int tid = get_tid512(), lane = tid & 63, w = tid >> 6, r = lane & 31, hh = lane >> 5;
  const float cs = 1.4426950408889634f * 0.10206207261596577f;
  for (int it = vid0; it < 1024; it += grid) {
    const int qt = it & 7, h = (it >> 3) & 15, b = it >> 7;
    const int t = qt * 256 + w * 32 + r;
    const size_t xrow = (size_t)b * 2048 + t;
    const bf16_t* qp = p.Q + xrow * 1536 + h * 96;
    bf16x8 qf[6];
#pragma unroll
    for (int kk = 0; kk < 4; ++kk) qf[kk] = __builtin_nontemporal_load((const bf16x8*)(qp + 16 * kk + 8 * hh));
#pragma unroll
    for (int part = 0; part < 2; ++part) {
      const bf16_t* pp = qp + 64 + 16 * part;
      const bf16x8 mine = *(const bf16x8*)(pp + 8 * hh), oth = *(const bf16x8*)(pp + 8 * (1 - hh));
      const float posf = part == 0 ? (float)(t >> 6) : (float)(t & 63);
      union { unsigned u[4]; bf16x8 v; } o;
      float res[8];
#pragma unroll
      for (int j = 0; j < 8; ++j) {
        const float inv = exp2f(-(float)j * (13.287712379549449f / 8.0f));
        const float ang = posf * inv;
        const float c = __cosf(ang), s = __sinf(ang);
        const float m = bf2f((bf16_t)mine[j]), ov = bf2f((bf16_t)oth[j]);
        res[j] = m * c + (hh ? ov : -ov) * s;
      }
#pragma unroll
      for (int j = 0; j < 4; ++j) o.u[j] = pack2(res[2 * j], res[2 * j + 1]);
      qf[4 + part] = o.v;
    }
    f32x16 oacc[2];
#pragma unroll
    for (int i = 0; i < 16; ++i) { oacc[0][i] = 0.f; oacc[1][i] = 0.f; }
    float mrun = -INFINITY, lrun = 0.f;
    const size_t kvrow0 = (size_t)b * 2304;
    const bf16_t* kn_base = p.Kn + kvrow0 * 1024 + h * 64;
    const bf16_t* kpe_base = p.kpe + kvrow0 * 32;
    const bf16_t* vt_base = p.Vt + ((size_t)(b * 16 + h) * 64) * 2304;
    uint4 rk0, rp, rv0;
    rp.x = 0; rp.y = 0; rp.z = 0; rp.w = 0;
    const int srow = tid >> 3, sch = tid & 7;
#define ATT_GLOAD(kt) do { \
      rk0 = *(const uint4*)(kn_base + (size_t)((kt) * 64 + srow) * 1024 + sch * 8); \
      rv0 = *(const uint4*)(vt_base + (size_t)srow * 2304 + (kt) * 64 + sch * 8); \
      if (tid < 256) rp = *(const uint4*)(kpe_base + (size_t)((kt) * 64 + (tid >> 2)) * 32 + (tid & 3) * 8); } while (0)
    ATT_GLOAD(0);
    for (int kt = 0; kt < 36; ++kt) {
      __syncthreads();
      {
        *(uint4*)(Ks + srow * 104 + sch * 8) = rk0;
        uint2 lo, hi;
        lo.x = rv0.x; lo.y = rv0.y; hi.x = rv0.z; hi.y = rv0.w;
        *(uint2*)(Vs + srow * 72 + (sch >> 1) * 16 + (sch & 1) * 4) = lo; *(uint2*)(Vs + srow * 72 + (sch >> 1) * 16 + 8 + (sch & 1) * 4) = hi;
      }
      if (tid < 256) *(uint4*)(Ks + (tid >> 2) * 104 + 64 + (tid & 3) * 8) = rp;
      __syncthreads();
      if (kt + 1 < 36) ATT_GLOAD(kt + 1);
      f32x16 s[2];
#pragma unroll
      for (int t2 = 0; t2 < 2; ++t2) {
#pragma unroll
        for (int i = 0; i < 16; ++i) s[t2][i] = 0.f;
#pragma unroll
        for (int kk = 0; kk < 6; ++kk) {
          const bf16x8 a = *(const bf16x8*)(Ks + (32 * t2 + r) * 104 + 16 * kk + 8 * hh);
          s[t2] = __builtin_amdgcn_mfma_f32_32x32x16_bf16(a, qf[kk], s[t2], 0, 0, 0);
        }
      }
      float mx = s[0][0];
#pragma unroll
      for (int i = 1; i < 16; ++i) mx = fmaxf(mx, s[0][i]);
#pragma unroll
      for (int i = 0; i < 16; ++i) mx = fmaxf(mx, s[1][i]);
      mx = fmaxf(mx, __shfl_xor(mx, 32));
      const float mcand = mx * cs;
      if (__builtin_amdgcn_ballot_w64(mcand > mrun + 6.0f) != 0ull) {
        const float mnew_ = fmaxf(mrun, mcand);
        const float alpha = __builtin_amdgcn_exp2f(mrun - mnew_);
        mrun = mnew_;
        lrun *= alpha;
#pragma unroll
        for (int i = 0; i < 16; ++i) { oacc[0][i] *= alpha; oacc[1][i] *= alpha; }
      }
      const float mnew = mrun;
      float psum = 0.f;
      bf16x8 pf[4];
#pragma unroll
      for (int t2 = 0; t2 < 2; ++t2)
#pragma unroll
        for (int hf = 0; hf < 2; ++hf) {
          union { unsigned u[4]; bf16x8 v; } cvp;
#pragma unroll
          for (int i = 0; i < 4; ++i) {
            const float p0 = __builtin_amdgcn_exp2f(s[t2][hf * 8 + 2 * i] * cs - mnew);
            const float p1 = __builtin_amdgcn_exp2f(s[t2][hf * 8 + 2 * i + 1] * cs - mnew);
            psum += p0 + p1;
            cvp.u[i] = pack2(p0, p1);
          }
          pf[t2 * 2 + hf] = cvp.v;
        }
      lrun += psum;
#pragma unroll
      for (int dt = 0; dt < 2; ++dt)
#pragma unroll
        for (int s4 = 0; s4 < 4; ++s4) {
          const bf16x8 vfr = *(const bf16x8*)(Vs + (32 * dt + r) * 72 + 16 * s4 + 8 * hh);
          oacc[dt] = __builtin_amdgcn_mfma_f32_32x32x16_bf16(vfr, pf[s4], oacc[dt], 0, 0, 0);
        }
    }
    const float ltot = lrun + __shfl_xor(lrun, 32);
    const float inv = 1.f / ltot;
    bf16_t* op = p.hxc + xrow * 1024 + h * 64;
#pragma unroll
    for (int dt = 0; dt < 2; ++dt)
#pragma unroll
      for (int i4 = 0; i4 < 4; ++i4) {
        const int d = 32 * dt + 8 * i4 + 4 * hh;
        uint2 u; u.x = pack2(oacc[dt][4 * i4] * inv, oacc[dt][4 * i4 + 1] * inv); u.y = pack2(oacc[dt][4 * i4 + 2] * inv, oacc[dt][4 * i4 + 3] * inv);
        *(uint2*)(op + d) = u;
      }
  }
}

__device__ __forceinline__ void phase_hyconv(CP& p, char* smem) {
  bf16_t* cp = (bf16_t*)smem;
  bf16_t* Vl = (bf16_t*)(smem + 4 * 8256);
  const int tid = get_tid(), lane = tid & 63, w = tid >> 6, i16 = lane & 15, g4 = lane >> 4;
  const int si = (-i16) & 3;
  const int ocb = 64 * w;
  for (int c = get_bid(); c < 1024; c += VGRID) {
    __syncthreads();
#pragma unroll
    for (int i = 0; i < 2; ++i) { const int ch = tid + 256 * i; *(uint4*)(cp + ch * 8) = *(const uint4*)(p.Rf + (size_t)c * 4096 + ch * 8); }
    {
      const float a0 = p.hy_conv_w[1024 + c], a1 = p.hy_conv_w[3072 + 1024 + c], a2 = p.hy_conv_w[2 * 3072 + 1024 + c], ab = p.hy_conv_b[1024 + c];
      const float v0 = p.hy_conv_w[2048 + c], v1 = p.hy_conv_w[3072 + 2048 + c], v2 = p.hy_conv_w[2 * 3072 + 2048 + c], vb = p.hy_conv_b[2048 + c];
#pragma unroll 2
      for (int i = 0; i < 8; ++i) {
        const int q = tid + 256 * i; const int b = q >> 8, l8 = q & 255; const int m1 = l8 >> 3, m2 = (l8 & 7) * 8;
        const int l0 = l8 * 8;
        const bf16_t* z2 = p.vvT + (size_t)c * 16384 + b * 2048;
        const bf16_t* zv = p.vvT + (size_t)(1024 + c) * 16384 + b * 2048;
        const uint4 u2 = *(const uint4*)(z2 + l0), uv = *(const uint4*)(zv + l0);
        float e2[10], ev[10];
        const int lp = l0 > 0 ? l0 - 1 : 0, ln = l0 + 8 < 2048 ? l0 + 8 : 2047;
        const float pm = l0 > 0 ? 1.f : 0.f, nm = l0 + 8 < 2048 ? 1.f : 0.f;
        const bf16_t q2p = z2[lp], qvp = zv[lp], q2n = z2[ln], qvn = zv[ln];
        e2[0] = bf2f(q2p) * pm; ev[0] = bf2f(qvp) * pm;
        e2[9] = bf2f(q2n) * nm; ev[9] = bf2f(qvn) * nm;
        const unsigned w2[4] = {u2.x, u2.y, u2.z, u2.w}, wv[4] = {uv.x, uv.y, uv.z, uv.w};
#pragma unroll
        for (int j = 0; j < 4; ++j) {
          e2[1 + 2 * j] = __uint_as_float(w2[j] << 16); e2[2 + 2 * j] = __uint_as_float(w2[j] & 0xffff0000u);
          ev[1 + 2 * j] = __uint_as_float(wv[j] << 16); ev[2 + 2 * j] = __uint_as_float(wv[j] & 0xffff0000u);
        }
        unsigned o[4];
#pragma unroll
        for (int j = 0; j < 4; ++j) {
          const float xa = a0 * e2[2 * j] + a1 * e2[2 * j + 1] + a2 * e2[2 * j + 2] + ab;
          const float xb = a0 * e2[2 * j + 1] + a1 * e2[2 * j + 2] + a2 * e2[2 * j + 3] + ab;
          const float ya = v0 * ev[2 * j] + v1 * ev[2 * j + 1] + v2 * ev[2 * j + 2] + vb;
          const float yb = v0 * ev[2 * j + 1] + v1 * ev[2 * j + 2] + v2 * ev[2 * j + 3] + vb;
          o[j] = pack2(xa * ya, xb * yb);
        }
        uint4 ou; ou.x = o[0]; ou.y = o[1]; ou.z = o[2]; ou.w = o[3];
        *(uint4*)(Vl + (8 + m1 * 8 + b) * 80 + m2) = ou;
      }
    }
    if (tid < 144) {
      const int colp = tid / 9, part = tid - colp * 9;
      const int col = colp < 8 ? colp : 256 + colp;
      uint4 zz; zz.x = 0; zz.y = 0; zz.z = 0; zz.w = 0;
      *(uint4*)(Vl + col * 80 + part * 8) = zz;
    }
    __syncthreads();
#pragma unroll
    for (int s = 1; s < 4; ++s)
#pragma unroll
      for (int i = 0; i < 2; ++i) {
        const int ch = tid + 256 * i;
        unsigned e[8];
#pragma unroll
        for (int j = 0; j < 8; ++j) { const int idx = 8 * ch + s + j; e[j] = idx < 4096 ? (unsigned)cp[idx] : 0u; }
        uint4 u; u.x = e[0] | (e[1] << 16); u.y = e[2] | (e[3] << 16); u.z = e[4] | (e[5] << 16); u.w = e[6] | (e[7] << 16);
        *(uint4*)(cp + s * 4128 + 8 * ch) = u;
      }
    __syncthreads();
    const bf16_t* abase = cp + si * 4128 + (2048 - i16 - si + 8 * g4);
    f32x4 acc[4][4];
#pragma unroll
    for (int m = 0; m < 4; ++m)
#pragma unroll
      for (int n = 0; n < 4; ++n) acc[m][n] = (f32x4){0.f, 0.f, 0.f, 0.f};
    for (int dl = -31; dl <= 31; ++dl) {
      bf16x8 af[4][2];
#pragma unroll
      for (int mt = 0; mt < 4; ++mt)
#pragma unroll
        for (int kk = 0; kk < 2; ++kk) {
          const bf16_t* ap = abase - 64 * dl - 16 * mt + 32 * kk;
          const uint2 lo = *(const uint2*)ap, hi = *(const uint2*)(ap + 4);
          union { uint4 u; bf16x8 v; } cv; cv.u.x = lo.x; cv.u.y = lo.y; cv.u.z = hi.x; cv.u.w = hi.y;
          af[mt][kk] = cv.v;
        }
#pragma unroll
      for (int jt = 0; jt < 4; ++jt) {
        const int in0 = ocb + 16 * jt - 8 * dl;
        if (in0 >= -8 && in0 <= 248) {
          const bf16_t* bp = Vl + (in0 + 8 + i16) * 80 + 8 * g4;
          const bf16x8 b0 = *(const bf16x8*)bp, b1 = *(const bf16x8*)(bp + 32);
#pragma unroll
          for (int mt = 0; mt < 4; ++mt) {
            acc[mt][jt] = __builtin_amdgcn_mfma_f32_16x16x32_bf16(af[mt][0], b0, acc[mt][jt], 0, 0, 0);
            acc[mt][jt] = __builtin_amdgcn_mfma_f32_16x16x32_bf16(af[mt][1], b1, acc[mt][jt], 0, 0, 0);
          }
        }
      }
    }
    const float db = p.hy_d_bias[c];
#pragma unroll
    for (int mt = 0; mt < 4; ++mt)
#pragma unroll
      for (int jt = 0; jt < 4; ++jt) {
        const int col = ocb + 16 * jt + i16;
        const int n1 = col >> 3, b = col & 7;
        const int n2 = 16 * mt + 4 * g4;
        const uint2 vv = *(const uint2*)(Vl + (col + 8) * 80 + n2);
        const float y0 = acc[mt][jt][0] + bf2f((bf16_t)(vv.x & 0xffff)) * db;
        const float y1 = acc[mt][jt][1] + bf2f((bf16_t)(vv.x >> 16)) * db;
        const float y2 = acc[mt][jt][2] + bf2f((bf16_t)(vv.y & 0xffff)) * db;
        const float y3 = acc[mt][jt][3] + bf2f((bf16_t)(vv.y >> 16)) * db;
        uint2 u; u.x = pack2(y0, y1); u.y = pack2(y2, y3);
        *(uint2*)(p.Yp + (size_t)c * 16384 + b * 2048 + n1 * 64 + n2) = u;
      }
  }
}

__device__ __forceinline__ void phase_transmul(CP& p, char* smem) {
  bf16_t* tl = (bf16_t*)smem;
  const int tid = get_tid();
  for (int it = get_bid(); it < 4096; it += VGRID) {
    const int ct = it & 15, rt = it >> 4;
    const int c0 = ct * 64, r0 = rt * 64;
    __syncthreads();
#pragma unroll
    for (int i = 0; i < 2; ++i) {
      const int ci = tid + 256 * i; const int cc = ci >> 3, ch = ci & 7;
      const uint4 u = *(const uint4*)(p.Yp + (size_t)(c0 + cc) * 16384 + r0 + ch * 8);
      unsigned* d = (unsigned*)(tl + cc * 66 + ch * 8);
      d[0] = u.x; d[1] = u.y; d[2] = u.z; d[3] = u.w;
    }
    __syncthreads();
    const int row = tid >> 2, cq = tid & 3;
    const int grow = r0 + row, pos = grow & 2047;
    const int cbase = c0 + cq * 16;
    const bf16_t* xp = p.x1h + (size_t)grow * 1024 + cbase;
    uint4 zero4; zero4.x = 0; zero4.y = 0; zero4.z = 0; zero4.w = 0;
    const uint4 xa = *(const uint4*)xp, xb = *(const uint4*)(xp + 8);
    const bf16_t* xpp = pos > 0 ? xp - 1024 : xp;
    const bf16_t* xpn = pos < 2047 ? xp + 1024 : xp;
    const float pmk = pos > 0 ? 1.f : 0.f, nmk = pos < 2047 ? 1.f : 0.f;
    const uint4 pa = *(const uint4*)xpp, pb = *(const uint4*)(xpp + 8);
    const uint4 na = *(const uint4*)xpn, nb = *(const uint4*)(xpn + 8);
    (void)zero4;
    const unsigned xs[8] = {xa.x, xa.y, xa.z, xa.w, xb.x, xb.y, xb.z, xb.w};
    const unsigned ps[8] = {pa.x, pa.y, pa.z, pa.w, pb.x, pb.y, pb.z, pb.w};
    const unsigned ns[8] = {na.x, na.y, na.z, na.w, nb.x, nb.y, nb.z, nb.w};
    unsigned o[8];
#pragma unroll
    for (int j4 = 0; j4 < 4; ++j4) {
      const f32x4 w0 = *(const f32x4*)(p.hy_conv_w + cbase + 4 * j4) * pmk, w1 = *(const f32x4*)(p.hy_conv_w + 3072 + cbase + 4 * j4);
      const f32x4 w2 = *(const f32x4*)(p.hy_conv_w + 2 * 3072 + cbase + 4 * j4) * nmk, wb = *(const f32x4*)(p.hy_conv_b + cbase + 4 * j4);
#pragma unroll
      for (int jj = 0; jj < 2; ++jj) {
        const int j = 2 * j4 + jj;
        const float x0 = w0[2 * jj] * __uint_as_float(ps[j] << 16) + w1[2 * jj] * __uint_as_float(xs[j] << 16) + w2[2 * jj] * __uint_as_float(ns[j] << 16) + wb[2 * jj];
        const float x1 = w0[2 * jj + 1] * __uint_as_float(ps[j] & 0xffff0000u) + w1[2 * jj + 1] * __uint_as_float(xs[j] & 0xffff0000u) + w2[2 * jj + 1] * __uint_as_float(ns[j] & 0xffff0000u) + wb[2 * jj + 1];
        const float y0 = bf2f(tl[(cq * 16 + 2 * j) * 66 + row]) * x0;
        const float y1 = bf2f(tl[(cq * 16 + 2 * j + 1) * 66 + row]) * x1;
        o[j] = pack2(y0, y1);
      }
    }
    bf16_t* op = p.hxc + (size_t)(r0 + row) * 1024 + c0 + cq * 16;
    uint4 oa; oa.x = o[0]; oa.y = o[1]; oa.z = o[2]; oa.w = o[3];
    uint4 ob; ob.x = o[4]; ob.y = o[5]; ob.z = o[6]; ob.w = o[7];
    *(uint4*)op = oa; *(uint4*)(op + 8) = ob;
  }
}

__global__ void __launch_bounds__(512, 2) mega(P p_arg) {
  __shared__ __attribute__((aligned(16))) char smem[LDS_BYTES];
  cg::grid_group grid = cg::this_grid();
  const int G = gridDim.x;
  CP* pp = (CP*)__builtin_amdgcn_kernarg_segment_ptr();
  const int ph0 = pp->ph0, ph1 = pp->ph1;
  volatile LAS unsigned* xst = (volatile LAS unsigned*)(smem + LDS_BYTES - 16);
  if (threadIdx.x == 0) { xst[0] = 0u; xst[1] = 0u; }
  __syncthreads();
  const XcdBarrier xb = xcd_barrier_post(pp->bar, xst);
  if (ph0 <= 0 && 0 < ph1) {
    asm volatile("" : "+s"(pp));
    CP& p = *pp;
    const int bid = get_rbid();
    const int vid0 = (G & 7) ? bid : ((bid & 7) * (G >> 3) + (bid >> 3));
    const int hb = get_hb();
    char* smem_h = smem + hb * HALF_LDS; (void)smem_h;
    const float* mv0 = p.modv; const float* mv1 = p.modv + (size_t)9 * 6144;
    (void)mv0; (void)mv1; (void)vid0;
    phase_prep(p, smem_h);
    if (0 + 1 < ph1) { if (ph1 > 1000) grid.sync(); else xcd_barrier(xb); }
  }
  if (ph0 <= 1 && 1 < ph1) {
    asm volatile("" : "+s"(pp));
    CP& p = *pp;
    const int bid = get_rbid();
    const int vid0 = (G & 7) ? bid : ((bid & 7) * (G >> 3) + (bid >> 3));
    const int hb = get_hb();
    char* smem_h = smem + hb * HALF_LDS; (void)smem_h;
    const float* mv0 = p.modv; const float* mv1 = p.modv + (size_t)9 * 6144;
    (void)mv0; (void)mv1; (void)vid0;
    phase_normmod_kv(p);
    if (1 + 1 < ph1) { if (ph1 > 1000) grid.sync(); else xcd_barrier(xb); }
  }
  if (ph0 <= 2 && 2 < ph1) {
    asm volatile("" : "+s"(pp));
    CP& p = *pp;
    const int bid = get_rbid();
    const int vid0 = (G & 7) ? bid : ((bid & 7) * (G >> 3) + (bid >> 3));
    const int hb = get_hb();
    char* smem_h = smem + hb * HALF_LDS; (void)smem_h;
    const float* mv0 = p.modv; const float* mv1 = p.modv + (size_t)9 * 6144;
    (void)mv0; (void)mv1; (void)vid0;
    {
        EpiDown e1{p.cq, 512, 2048, p.rq, 4, nullptr, 1 << 30};
        gemm_job<true>(smem, p.hxc, 1024, p.wt_dq, 1024, 512, 16, 2304, 256, 128, 0, 2048, 128, 0, vid0, G, e1);
        EpiDown e2{p.kv, 288, 2304, p.rkv, 2, nullptr, 1 << 30};
        gemm_job<true>(smem, p.hxc, 1024, p.wt_dkv, 1024, 256, 18, 2304, 0, 128, 0, 2304, 144, 128, vid0, G, e2);
        EpiFilt e3{p.Rf, p.hy_decay};
        gemm_job<false>(smem, p.h2bf, 64, p.wt_f3, 64, 2048, 16, 0, 0, 128, 0, 2048, 16, 128 + 72, vid0, G, e3);
        EpiDown e4{p.kv, 288, 2304, p.rkv, 0, p.kpe, 0};
        gemm_job<true, EpiDown, true>(smem, p.hxc, 1024, p.wt_dkv + (size_t)256 * 1024, 1024, 32, 18, 2304, 0, 128, 0, 2304, 144, 128 + 72 + 64, vid0, G, e4);
      }
    if (2 + 1 < ph1) { if (ph1 > 1000) grid.sync(); else xcd_barrier(xb); }
  }
  if (ph0 <= 4 && 4 < ph1) {
    asm volatile("" : "+s"(pp));
    CP& p = *pp;
    const int bid = get_rbid();
    const int vid0 = (G & 7) ? bid : ((bid & 7) * (G >> 3) + (bid >> 3));
    const int hb = get_hb();
    char* smem_h = smem + hb * HALF_LDS; (void)smem_h;
    const float* mv0 = p.modv; const float* mv1 = p.modv + (size_t)9 * 6144;
    (void)mv0; (void)mv1; (void)vid0;
    {
        EpiStore<4> e1{p.Q, 1536, 2048, p.rq, 16384, 1.0f / 512.0f};
        gemm_job<true>(smem, p.cq, 512, p.wt_uq, 512, 1536, 16, 2048, 0, 128, 0, 2048, 128, 0, vid0, G, e1);
        EpiStore<2> e2{p.Kn, 1024, 2304, p.rkv, 18432, 1.0f / 256.0f};
        gemm_job<true>(smem, p.kv, 288, p.wt_uk, 256, 1024, 18, 2304, 0, 128, 0, 2304, 144, 64 * 6, vid0, G, e2);
        EpiVt e3{p.Vt, p.rkv};
        gemm_job<false>(smem, p.kv, 288, p.wt_uv, 256, 1024, 18, 2304, 0, 128, 0, 2304, 144, 64 * 6 + 72 * 4, vid0, G, e3);
      }
    if (4 + 1 < ph1) { if (ph1 > 1000) grid.sync(); else xcd_barrier(xb); }
  }
  if (ph0 <= 5 && 5 < ph1) {
    asm volatile("" : "+s"(pp));
    CP& p = *pp;
    const int bid = get_rbid();
    const int vid0 = (G & 7) ? bid : ((bid & 7) * (G >> 3) + (bid >> 3));
    const int hb = get_hb();
    char* smem_h = smem + hb * HALF_LDS; (void)smem_h;
    const float* mv0 = p.modv; const float* mv1 = p.modv + (size_t)9 * 6144;
    (void)mv0; (void)mv1; (void)vid0;
    phase_attn(p, smem, vid0, G);
    if (5 + 1 < ph1) { if (ph1 > 1000) grid.sync(); else xcd_barrier(xb); }
  }
  if (ph0 <= 6 && 6 < ph1) {
    asm volatile("" : "+s"(pp));
    CP& p = *pp;
    const int bid = get_rbid();
    const int vid0 = (G & 7) ? bid : ((bid & 7) * (G >> 3) + (bid >> 3));
    const int hb = get_hb();
    char* smem_h = smem + hb * HALF_LDS; (void)smem_h;
    const float* mv0 = p.modv; const float* mv1 = p.modv + (size_t)9 * 6144;
    (void)mv0; (void)mv1; (void)vid0;
    {
        EpiResid<true> e{p.X16, p.x, mv0 + 2 * 1024, nullptr};
        gemm_job<true>(smem, p.hxc, 1024, p.wt_o, 1024, 1024, 16, 2048, 0, 128, 0, 2048, 128, 0, vid0, G, e);
      }
    if (6 + 1 < ph1) { if (ph1 > 1000) grid.sync(); else xcd_barrier(xb); }
  }
  if (ph0 <= 7 && 7 < ph1) {
    asm volatile("" : "+s"(pp));
    CP& p = *pp;
    const int bid = get_rbid();
    const int vid0 = (G & 7) ? bid : ((bid & 7) * (G >> 3) + (bid >> 3));
    const int hb = get_hb();
    char* smem_h = smem + hb * HALF_LDS; (void)smem_h;
    const float* mv0 = p.modv; const float* mv1 = p.modv + (size_t)9 * 6144;
    (void)mv0; (void)mv1; (void)vid0;
    phase_normmod_x(p, p.norm_ffn_g, 0, 3);
    if (7 + 1 < ph1) { if (ph1 > 1000) grid.sync(); else xcd_barrier(xb); }
  }
  if (ph0 <= 8 && 8 < ph1) {
    asm volatile("" : "+s"(pp));
    CP& p = *pp;
    const int bid = get_rbid();
    const int vid0 = (G & 7) ? bid : ((bid & 7) * (G >> 3) + (bid >> 3));
    const int hb = get_hb();
    char* smem_h = smem + hb * HALF_LDS; (void)smem_h;
    const float* mv0 = p.modv; const float* mv1 = p.modv + (size_t)9 * 6144;
    (void)mv0; (void)mv1; (void)vid0;
    {
        EpiConv<0> e{p.ffn_conv_w, p.ffn_conv_b, 5632, nullptr, p.act, nullptr};
        gemm_job<true>(smem, p.hxc, 1024, p.wt_up0, 1024, 5632, 17, 2048, 0, 126, 1, 2048, 136, 0, vid0, G, e);
      }
    if (8 + 1 < ph1) { if (ph1 > 1000) grid.sync(); else xcd_barrier(xb); }
  }
  if (ph0 <= 9 && 9 < ph1) {
    asm volatile("" : "+s"(pp));
    CP& p = *pp;
    const int bid = get_rbid();
    const int vid0 = (G & 7) ? bid : ((bid & 7) * (G >> 3) + (bid >> 3));
    const int hb = get_hb();
    char* smem_h = smem + hb * HALF_LDS; (void)smem_h;
    const float* mv0 = p.modv; const float* mv1 = p.modv + (size_t)9 * 6144;
    (void)mv0; (void)mv1; (void)vid0;
    {
        EpiResid<false> e{p.X16, p.X16, mv0 + 5 * 1024, nullptr};
        gemm_job<true>(smem, p.act, 2816, p.wt_dn0, 2816, 1024, 16, 2048, 0, 128, 0, 2048, 128, 0, vid0, G, e);
      }
    if (9 + 1 < ph1) { if (ph1 > 1000) grid.sync(); else xcd_barrier(xb); }
  }
  if (ph0 <= 10 && 10 < ph1) {
    asm volatile("" : "+s"(pp));
    CP& p = *pp;
    const int bid = get_rbid();
    const int vid0 = (G & 7) ? bid : ((bid & 7) * (G >> 3) + (bid >> 3));
    const int hb = get_hb();
    char* smem_h = smem + hb * HALF_LDS; (void)smem_h;
    const float* mv0 = p.modv; const float* mv1 = p.modv + (size_t)9 * 6144;
    (void)mv0; (void)mv1; (void)vid0;
    phase_normmod_x(p, p.norm_mix_g + 1024, 1, 0);
    if (10 + 1 < ph1) { if (ph1 > 1000) grid.sync(); else xcd_barrier(xb); }
  }
  if (ph0 <= 11 && 11 < ph1) {
    asm volatile("" : "+s"(pp));
    CP& p = *pp;
    const int bid = get_rbid();
    const int vid0 = (G & 7) ? bid : ((bid & 7) * (G >> 3) + (bid >> 3));
    const int hb = get_hb();
    char* smem_h = smem + hb * HALF_LDS; (void)smem_h;
    const float* mv0 = p.modv; const float* mv1 = p.modv + (size_t)9 * 6144;
    (void)mv0; (void)mv1; (void)vid0;
    {
        EpiBiasStore e1{p.x1h, 1024, p.hy_b_in};
        gemm_job<true>(smem, p.hxc, 1024, p.wt_hin, 1024, 1024, 16, 2048, 0, 128, 0, 2048, 128, 0, vid0, G, e1);
        EpiBiasT e2{p.vvT, p.hy_b_in + 1024};
        gemm_job<false>(smem, p.hxc, 1024, p.wt_hin + (size_t)1024 * 1024, 1024, 2048, 16, 2048, 0, 128, 0, 2048, 128, 64 * 4, vid0, G, e2);
      }
    if (11 + 1 < ph1) { if (ph1 > 1000) grid.sync(); else xcd_barrier(xb); }
  }
  if (ph0 <= 12 && 12 < ph1) {
    asm volatile("" : "+s"(pp));
    CP& p = *pp;
    const int bid = get_rbid();
    const int vid0 = (G & 7) ? bid : ((bid & 7) * (G >> 3) + (bid >> 3));
    const int hb = get_hb();
    char* smem_h = smem + hb * HALF_LDS; (void)smem_h;
    const float* mv0 = p.modv; const float* mv1 = p.modv + (size_t)9 * 6144;
    (void)mv0; (void)mv1; (void)vid0;
    phase_hyconv(p, smem_h);
    if (12 + 1 < ph1) { if (ph1 > 1000) grid.sync(); else xcd_barrier(xb); }
  }
  if (ph0 <= 13 && 13 < ph1) {
    asm volatile("" : "+s"(pp));
    CP& p = *pp;
    const int bid = get_rbid();
    const int vid0 = (G & 7) ? bid : ((bid & 7) * (G >> 3) + (bid >> 3));
    const int hb = get_hb();
    char* smem_h = smem + hb * HALF_LDS; (void)smem_h;
    const float* mv0 = p.modv; const float* mv1 = p.modv + (size_t)9 * 6144;
    (void)mv0; (void)mv1; (void)vid0;
    phase_transmul(p, smem_h);
    if (13 + 1 < ph1) { if (ph1 > 1000) grid.sync(); else xcd_barrier(xb); }
  }
  if (ph0 <= 14 && 14 < ph1) {
    asm volatile("" : "+s"(pp));
    CP& p = *pp;
    const int bid = get_rbid();
    const int vid0 = (G & 7) ? bid : ((bid & 7) * (G >> 3) + (bid >> 3));
    const int hb = get_hb();
    char* smem_h = smem + hb * HALF_LDS; (void)smem_h;
    const float* mv0 = p.modv; const float* mv1 = p.modv + (size_t)9 * 6144;
    (void)mv0; (void)mv1; (void)vid0;
    {
        EpiResid<false> e{p.X16, p.X16, mv1 + 2 * 1024, p.hy_b_out};
        gemm_job<true>(smem, p.hxc, 1024, p.wt_hout, 1024, 1024, 16, 2048, 0, 128, 0, 2048, 128, 0, vid0, G, e);
      }
    if (14 + 1 < ph1) { if (ph1 > 1000) grid.sync(); else xcd_barrier(xb); }
  }
  if (ph0 <= 15 && 15 < ph1) {
    asm volatile("" : "+s"(pp));
    CP& p = *pp;
    const int bid = get_rbid();
    const int vid0 = (G & 7) ? bid : ((bid & 7) * (G >> 3) + (bid >> 3));
    const int hb = get_hb();
    char* smem_h = smem + hb * HALF_LDS; (void)smem_h;
    const float* mv0 = p.modv; const float* mv1 = p.modv + (size_t)9 * 6144;
    (void)mv0; (void)mv1; (void)vid0;
    phase_normmod_x(p, p.norm_ffn_g + 1024, 1, 3);
    if (15 + 1 < ph1) { if (ph1 > 1000) grid.sync(); else xcd_barrier(xb); }
  }
  if (ph0 <= 16 && 16 < ph1) {
    asm volatile("" : "+s"(pp));
    CP& p = *pp;
    const int bid = get_rbid();
    const int vid0 = (G & 7) ? bid : ((bid & 7) * (G >> 3) + (bid >> 3));
    const int hb = get_hb();
    char* smem_h = smem + hb * HALF_LDS; (void)smem_h;
    const float* mv0 = p.modv; const float* mv1 = p.modv + (size_t)9 * 6144;
    (void)mv0; (void)mv1; (void)vid0;
    {
        EpiConv<0> e{p.ffn_conv_w + (size_t)3 * 5632, p.ffn_conv_b + 5632, 5632, nullptr, p.act, nullptr};
        gemm_job<true>(smem, p.hxc, 1024, p.wt_up1, 1024, 5632, 17, 2048, 0, 126, 1, 2048, 136, 0, vid0, G, e);
      }
    if (16 + 1 < ph1) { if (ph1 > 1000) grid.sync(); else xcd_barrier(xb); }
  }
  if (ph0 <= 17 && 17 < ph1) {
    asm volatile("" : "+s"(pp));
    CP& p = *pp;
    const int bid = get_rbid();
    const int vid0 = (G & 7) ? bid : ((bid & 7) * (G >> 3) + (bid >> 3));
    const int hb = get_hb();
    char* smem_h = smem + hb * HALF_LDS; (void)smem_h;
    const float* mv0 = p.modv; const float* mv1 = p.modv + (size_t)9 * 6144;
    (void)mv0; (void)mv1; (void)vid0;
    {
        EpiResid<false> e{p.X16, p.X16, mv1 + 5 * 1024, nullptr};
        gemm_job<true>(smem, p.act, 2816, p.wt_dn1, 2816, 1024, 16, 2048, 0, 128, 0, 2048, 128, 0, vid0, G, e);
      }
    if (17 + 1 < ph1) { if (ph1 > 1000) grid.sync(); else xcd_barrier(xb); }
  }
  if (ph0 <= 18 && 18 < ph1) {
    asm volatile("" : "+s"(pp));
    CP& p = *pp;
    const int bid = get_rbid();
    const int vid0 = (G & 7) ? bid : ((bid & 7) * (G >> 3) + (bid >> 3));
    const int hb = get_hb();
    char* smem_h = smem + hb * HALF_LDS; (void)smem_h;
    const float* mv0 = p.modv; const float* mv1 = p.modv + (size_t)9 * 6144;
    (void)mv0; (void)mv1; (void)vid0;
    phase_final_norm(p);
    if (18 + 1 < ph1) { if (ph1 > 1000) grid.sync(); else xcd_barrier(xb); }
  }
}

extern "C" void kernel_launch(void* const* d_in, const int* in_sizes, int n_in, void* d_out, int out_size, void* d_ws, size_t ws_size, hipStream_t stream) {
  static int grid_blocks = 0;
  if (!grid_blocks) {
    int dev = 0, cus = 0, per_cu = 0;
    hipGetDevice(&dev);
    hipDeviceGetAttribute(&cus, hipDeviceAttributeMultiprocessorCount, dev);
    hipOccupancyMaxActiveBlocksPerMultiprocessor(&per_cu, (const void*)mega, 512, 0);
    per_cu = 1;
    grid_blocks = cus * per_cu;
  }
  P p{};
  const float** in = (const float**)&p;
  for (int i = 0; i < 36; ++i) in[i] = (const float*)d_in[i];
  p.X = (float*)d_out;
  char* ws = (char*)d_ws; size_t off = 0;
  auto take = [&](size_t bytes) { char* r = ws + off; off += (bytes + 255) & ~(size_t)255; return r; };
  p.wt_dq = (bf16_t*)take((size_t)512 * 1024 * 2);
  p.wt_dkv = (bf16_t*)take((size_t)288 * 1024 * 2);
  p.wt_uq = (bf16_t*)take((size_t)1536 * 512 * 2);
  p.wt_uk = (bf16_t*)take((size_t)1024 * 256 * 2);
  p.wt_uv = (bf16_t*)take((size_t)1024 * 256 * 2);
  p.wt_o = (bf16_t*)take((size_t)1024 * 1024 * 2);
  p.wt_hin = (bf16_t*)take((size_t)3072 * 1024 * 2);
  p.wt_hout = (bf16_t*)take((size_t)1024 * 1024 * 2);
  p.wt_up0 = (bf16_t*)take((size_t)5632 * 1024 * 2);
  p.wt_up1 = (bf16_t*)take((size_t)5632 * 1024 * 2);
  p.wt_dn0 = (bf16_t*)take((size_t)1024 * 2816 * 2);
  p.wt_dn1 = (bf16_t*)take((size_t)1024 * 2816 * 2);
  p.modv = (float*)take((size_t)2 * 9 * 6144 * 4);
  p.rq = (float*)take((size_t)4 * 16384 * 4);
  p.rkv = (float*)take((size_t)2 * 18432 * 4);
  p.modp = (float*)take((size_t)4 * 110592 * 4);
  p.bar = (unsigned*)take((size_t)XCD_BAR_WORDS * 4);
  p.wt_f3 = (bf16_t*)take((size_t)2048 * 64 * 2);
  p.h2bf = (bf16_t*)take((size_t)2048 * 64 * 2);
  p.Rf = (bf16_t*)take((size_t)1024 * 4096 * 2);
  p.kpe = (bf16_t*)take((size_t)18432 * 32 * 2);
  p.hxc = (bf16_t*)take((size_t)18432 * 1024 * 2);
  const size_t ubase = off;
  p.cq = (bf16_t*)take((size_t)16384 * 512 * 2);
  p.kv = (bf16_t*)take((size_t)18432 * 288 * 2);
  p.Q = (bf16_t*)take((size_t)16384 * 1536 * 2);
  p.Kn = (bf16_t*)take((size_t)18432 * 1024 * 2);
  p.Vt = (bf16_t*)take((size_t)18432 * 1024 * 2);
  const size_t uend1 = off;
  p.X16 = (bf16_t*)(ws + ubase + (size_t)104857600);
  off = ubase;
  p.act = (bf16_t*)take((size_t)16384 * 2816 * 2);
  off = ubase;
  p.x1h = (bf16_t*)take((size_t)16384 * 1024 * 2);
  p.vvT = (bf16_t*)take((size_t)2 * 16384 * 1024 * 2);
  p.Yp = p.vvT;
  if (uend1 > ws_size) { fprintf(stderr, "workspace too small: need %zu have %zu\n", uend1, ws_size); return; }
  p.ph0 = 0; p.ph1 = NPHASE;
  if (hipMemsetAsync(p.bar, 0, (size_t)XCD_BAR_WORDS * 4, stream) != hipSuccess) { fprintf(stderr, "memset failed\n"); return; }
  void* args[] = {&p};
  hipError_t e = hipLaunchCooperativeKernel((const void*)mega, dim3(grid_blocks), dim3(512), args, 0, stream);
  if (e != hipSuccess) fprintf(stderr, "cooperative launch failed: %s (grid %d)\n", hipGetErrorString(e), grid_blocks);
}
```
